# Optimizing an MI355X kernel written in HIP

```python
import jax, jax.numpy as jnp
from jax import lax
import numpy as np

D_MODEL = 1024
BATCH = 4
SEQ = 4096
DEPTH = 1

MEM_LEN = 256
EPS = 1e-5
NEG = -1e30

RET_HEADS = 4
RET_DK = 64
RET_DV = 128
RET_CHUNK = 128
MOBA_HEADS = 8
MOBA_HD = 64
MOBA_BLOCK = 256
MOBA_TOPK = 3
MOBA_QCHUNK = 32
MEM_HEADS = 4
MEM_HD = 128
N_BRANCH = 3
N_EXPERTS = 32
TOP_K = 4
D_FF = D_MODEL
SWIGLU_LIMIT = 7.0
SWIGLU_ALPHA = 1.702
MOE_BLOCK = 256

RET_Q = RET_HEADS * RET_DK
RET_V = RET_HEADS * RET_DV
MOBA_W = MOBA_HEADS * MOBA_HD
MEM_W = MEM_HEADS * MEM_HD
IN_SPLITS = (RET_Q, RET_Q, RET_V, RET_V, MOBA_W, MOBA_W, MOBA_W, MEM_W, N_BRANCH * D_MODEL)
D_IN = sum(IN_SPLITS)
SPLIT_POINTS = tuple(int(v) for v in np.cumsum(IN_SPLITS)[:-1])

kernel_name = "hybrid_retention_moba_memory_moe"


def rms_norm(x, g):
    xf = x.astype(jnp.float32)
    y = xf * lax.rsqrt(jnp.mean(xf * xf, axis=-1, keepdims=True) + EPS)
    return (y * g.astype(jnp.float32)).astype(x.dtype)


def retention(q, k, v):
    B, S, H, dk = q.shape
    dv = v.shape[-1]
    C = RET_CHUNK
    nc = S // C
    log_g = jnp.log1p(-jnp.exp2(-5.0 - jnp.arange(H, dtype=jnp.float32)))
    i = jnp.arange(C, dtype=jnp.float32)
    diff = i[:, None] - i[None, :]
    decay_in = jnp.where(diff >= 0, jnp.exp(jnp.maximum(diff, 0.0)[None] * log_g[:, None, None]), 0.0).astype(q.dtype)
    decay_k = jnp.exp((C - 1 - i)[:, None] * log_g[None, :]).astype(q.dtype)
    decay_q = jnp.exp((i + 1)[:, None] * log_g[None, :]).astype(q.dtype)
    decay_chunk = jnp.exp(C * log_g).astype(v.dtype)
    qc = q.reshape(B, nc, C, H, dk)
    kc = k.reshape(B, nc, C, H, dk)
    vc = v.reshape(B, nc, C, H, dv)
    scores = jnp.einsum("bnihd,bnjhd->bnhij", qc, kc) * decay_in
    intra = jnp.einsum("bnhij,bnjhe->bnihe", scores, vc)
    upd = jnp.einsum("bnjhd,bnjhe->nbhde", kc * decay_k[:, :, None], vc)

    def step(state, u):
        return decay_chunk[None, :, None, None] * state + u, state

    _, prev = lax.scan(step, jnp.zeros((B, H, dk, dv), v.dtype), upd)
    cross = jnp.einsum("bnihd,nbhde->bnihe", qc * decay_q[:, :, None], prev)
    return (intra + cross).reshape(B, S, H, dv)


def moba_attention(q, k, v):
    B, H, S, d = q.shape
    BS = MOBA_BLOCK
    QC = MOBA_QCHUNK
    nb = -(-S // BS)
    n_sel = min(MOBA_TOPK, nb)
    pad = ((0, 0), (0, 0), (0, nb * BS - S), (0, 0))
    kb = jnp.pad(k, pad).reshape(B, H, nb, BS, d)
    vb = jnp.pad(v, pad).reshape(B, H, nb, BS, d)
    k_mean = jnp.mean(kb.astype(jnp.float32), axis=3)
    q_blk = jnp.arange(S) // BS
    gate = jnp.einsum("bhsd,bhnd->bhsn", q.astype(jnp.float32), k_mean)
    past = jnp.arange(nb)[None, :] < q_blk[:, None]
    gate = jnp.where(past, gate, -jnp.inf)
    _, idx = lax.top_k(gate, n_sel)
    valid = idx < q_blk[:, None]
    slopes = jnp.exp2(-8.0 * (jnp.arange(H, dtype=jnp.float32) + 1.0) / H)
    scale = d ** -0.5
    nq = S // QC
    q_ch = q.reshape(B, H, nq, QC, d).transpose(2, 0, 1, 3, 4)
    idx_ch = idx.reshape(B, H, nq, QC, n_sel).transpose(2, 0, 1, 3, 4)
    valid_ch = valid.reshape(B, H, nq, QC, n_sel).transpose(2, 0, 1, 3, 4)
    starts = jnp.arange(nq, dtype=jnp.int32) * QC
    bi = jnp.arange(B)[:, None, None, None]
    hi = jnp.arange(H)[None, :, None, None]
    kpos = jnp.arange(BS)

    def chunk(args):
        qc, idc, vld, start = args
        t = start + jnp.arange(QC)
        bid = start // BS
        k_own = lax.dynamic_index_in_dim(kb, bid, axis=2, keepdims=False)
        v_own = lax.dynamic_index_in_dim(vb, bid, axis=2, keepdims=False)
        dist_own = (t[:, None] - (bid * BS + kpos)[None, :]).astype(jnp.float32)
        sc_own = jnp.einsum("bhqd,bhkd->bhqk", qc, k_own).astype(jnp.float32) * scale - slopes[:, None, None] * dist_own
        sc_own = jnp.where(dist_own >= 0, sc_own, NEG)
        k_sel = kb[bi, hi, idc]
        v_sel = vb[bi, hi, idc]
        dist_sel = (t[None, None, :, None, None] - (idc[..., None] * BS + kpos)).astype(jnp.float32)
        sc_sel = jnp.einsum("bhqd,bhqjkd->bhqjk", qc, k_sel).astype(jnp.float32) * scale - slopes[None, :, None, None, None] * dist_sel
        sc_sel = jnp.where(vld[..., None], sc_sel, NEG)
        sc = jnp.concatenate([sc_own, sc_sel.reshape(B, H, QC, n_sel * BS)], axis=-1)
        p = jax.nn.softmax(sc, axis=-1).astype(v.dtype)
        p_own = p[..., :BS]
        p_sel = p[..., BS:].reshape(B, H, QC, n_sel, BS)
        return jnp.einsum("bhqk,bhkd->bhqd", p_own, v_own) + jnp.einsum("bhqjk,bhqjkd->bhqd", p_sel, v_sel)

    out = lax.map(chunk, (q_ch, idx_ch, valid_ch, starts))
    return out.transpose(1, 0, 3, 2, 4).reshape(B, S, H * d)


def hybrid_mixer(x, mem, g_mix, w_in, b_gate, g_ret_out, g_moba_q, g_moba_k, g_mem, w_mem_kv, g_mem_q, g_mem_k, w_br_ret, w_br_moba, w_br_mem, w_out):
    B, S, D = x.shape
    h = rms_norm(x, g_mix)
    rq, rk, rv, rg, mq, mk, mv, cq, gl = jnp.split(h @ w_in, SPLIT_POINTS, axis=-1)
    o_ret = retention(rq.reshape(B, S, RET_HEADS, RET_DK), rk.reshape(B, S, RET_HEADS, RET_DK) * (RET_DK ** -0.5), rv.reshape(B, S, RET_HEADS, RET_DV))
    o_ret = (rms_norm(o_ret, g_ret_out) * jax.nn.silu(rg.reshape(B, S, RET_HEADS, RET_DV))).reshape(B, S, RET_V)
    qm = rms_norm(mq.reshape(B, S, MOBA_HEADS, MOBA_HD), g_moba_q).transpose(0, 2, 1, 3)
    km = rms_norm(mk.reshape(B, S, MOBA_HEADS, MOBA_HD), g_moba_k).transpose(0, 2, 1, 3)
    vm = mv.reshape(B, S, MOBA_HEADS, MOBA_HD).transpose(0, 2, 1, 3)
    o_moba = moba_attention(qm, km, vm)
    M = mem.shape[1]
    mk_, mv_ = jnp.split(rms_norm(mem, g_mem) @ w_mem_kv, 2, axis=-1)
    qc = rms_norm(cq.reshape(B, S, MEM_HEADS, MEM_HD), g_mem_q)
    kc = rms_norm(mk_.reshape(B, M, MEM_HEADS, MEM_HD), g_mem_k)
    vc = mv_.reshape(B, M, MEM_HEADS, MEM_HD)
    sc = jnp.einsum("bshd,bmhd->bhsm", qc, kc).astype(jnp.float32) * (MEM_HD ** -0.5)
    p = jax.nn.softmax(sc, axis=-1).astype(vc.dtype)
    o_mem = jnp.einsum("bhsm,bmhd->bshd", p, vc).reshape(B, S, MEM_W)
    gates = jax.nn.sigmoid((gl + b_gate).astype(jnp.float32)).astype(x.dtype).reshape(B, S, N_BRANCH, D)
    y = gates[:, :, 0] * (o_ret @ w_br_ret) + gates[:, :, 1] * (o_moba @ w_br_moba) + gates[:, :, 2] * (o_mem @ w_br_mem)
    return x + y @ w_out


def moe_ffn(x, g_ffn, w_router, b_router, w_mlp1, b_mlp1, w_mlp2, b_mlp2):
    B, S, D = x.shape
    N = B * S
    xt = rms_norm(x, g_ffn).reshape(N, D)
    logits = (xt @ w_router + b_router).astype(jnp.float32)
    top_v, top_e = lax.top_k(logits, TOP_K)
    wts = jax.nn.softmax(top_v, axis=-1).astype(x.dtype)
    P = N * TOP_K
    T = MOE_BLOCK
    e_flat = top_e.reshape(P)
    tok_flat = jnp.arange(P, dtype=jnp.int32) // TOP_K
    w_flat = wts.reshape(P)
    order = jnp.argsort(e_flat)
    e_sorted = e_flat[order]
    tok_sorted = tok_flat[order]
    w_sorted = w_flat[order]
    counts = jnp.bincount(e_flat, length=N_EXPERTS)
    starts = jnp.cumsum(counts) - counts
    padded = ((counts + T - 1) // T) * T
    pad_ends = jnp.cumsum(padded)
    pad_starts = pad_ends - padded
    dest = pad_starts[e_sorted] + (jnp.arange(P) - starts[e_sorted])
    NB = -(-P // T) + N_EXPERTS
    R = NB * T
    slot_tok = jnp.full((R,), N, dtype=jnp.int32).at[dest].set(tok_sorted)
    slot_w = jnp.zeros((R,), x.dtype).at[dest].set(w_sorted)
    block_e = jnp.minimum(jnp.searchsorted(pad_ends, jnp.arange(NB) * T, side="right"), N_EXPERTS - 1)
    x_pad = jnp.concatenate([xt, jnp.zeros((1, D), xt.dtype)], axis=0)
    xb = x_pad[slot_tok].reshape(NB, T, D)

    def expert_block(args):
        xblk, e = args
        hdn = xblk @ w_mlp1[e] + b_mlp1[e]
        x_glu = jnp.minimum(hdn[:, ::2], SWIGLU_LIMIT)
        x_lin = jnp.clip(hdn[:, 1::2], -SWIGLU_LIMIT, SWIGLU_LIMIT)
        act = x_glu * jax.nn.sigmoid(SWIGLU_ALPHA * x_glu) * (x_lin + 1.0)
        return act @ w_mlp2[e] + b_mlp2[e]

    yb = lax.map(expert_block, (xb, block_e)).reshape(R, D) * slot_w[:, None]
    y = jnp.zeros((N + 1, D), x.dtype).at[slot_tok].add(yb)[:N]
    return x + y.reshape(B, S, D)


def setup_inputs(seed: int = 0) -> dict:
    key = jax.random.key(seed)
    ks = jax.random.split(key, 24)
    f32 = jnp.float32

    def nrm(k, shape, fan_in):
        return jax.random.normal(k, shape, f32) * (fan_in ** -0.5)

    def gain(k, shape):
        return 1.0 + 0.02 * jax.random.normal(k, shape, f32)

    L = DEPTH
    return {
        "x": jax.random.normal(ks[0], (BATCH, SEQ, D_MODEL), f32),
        "mem": jax.random.normal(ks[1], (BATCH, MEM_LEN, D_MODEL), f32),
        "g_mix": gain(ks[2], (L, D_MODEL)),
        "w_in": nrm(ks[3], (L, D_MODEL, D_IN), D_MODEL),
        "b_gate": 0.01 * jax.random.normal(ks[4], (L, N_BRANCH * D_MODEL), f32),
        "g_ret_out": gain(ks[5], (L, RET_DV)),
        "g_moba_q": gain(ks[6], (L, MOBA_HD)),
        "g_moba_k": gain(ks[7], (L, MOBA_HD)),
        "g_mem": gain(ks[8], (L, D_MODEL)),
        "w_mem_kv": nrm(ks[9], (L, D_MODEL, 2 * MEM_W), D_MODEL),
        "g_mem_q": gain(ks[10], (L, MEM_HD)),
        "g_mem_k": gain(ks[11], (L, MEM_HD)),
        "w_br_ret": nrm(ks[12], (L, RET_V, D_MODEL), RET_V),
        "w_br_moba": nrm(ks[13], (L, MOBA_W, D_MODEL), MOBA_W),
        "w_br_mem": nrm(ks[14], (L, MEM_W, D_MODEL), MEM_W),
        "w_out": nrm(ks[15], (L, D_MODEL, D_MODEL), D_MODEL),
        "g_ffn": gain(ks[16], (L, D_MODEL)),
        "w_router": nrm(ks[17], (L, D_MODEL, N_EXPERTS), D_MODEL),
        "b_router": 0.01 * jax.random.normal(ks[18], (L, N_EXPERTS), f32),
        "w_mlp1": nrm(ks[19], (L, N_EXPERTS, D_MODEL, 2 * D_FF), D_MODEL),
        "b_mlp1": 0.01 * jax.random.normal(ks[20], (L, N_EXPERTS, 2 * D_FF), f32),
        "w_mlp2": nrm(ks[21], (L, N_EXPERTS, D_FF, D_MODEL), D_FF),
        "b_mlp2": 0.01 * jax.random.normal(ks[22], (L, N_EXPERTS, D_MODEL), f32),
    }


def reference(x, mem, g_mix, w_in, b_gate, g_ret_out, g_moba_q, g_moba_k, g_mem, w_mem_kv, g_mem_q, g_mem_k, w_br_ret, w_br_moba, w_br_mem, w_out, g_ffn, w_router, b_router, w_mlp1, b_mlp1, w_mlp2, b_mlp2):
    for l in range(DEPTH):
        x = hybrid_mixer(x, mem, g_mix[l], w_in[l], b_gate[l], g_ret_out[l], g_moba_q[l], g_moba_k[l], g_mem[l], w_mem_kv[l], g_mem_q[l], g_mem_k[l], w_br_ret[l], w_br_moba[l], w_br_mem[l], w_out[l])
        x = moe_ffn(x, g_ffn[l], w_router[l], b_router[l], w_mlp1[l], b_mlp1[l], w_mlp2[l], b_mlp2[l])
    return x
```

```cpp
#include <hip/hip_runtime.h>
#include <cstdio>
#include <cstdint>
#include <cstring>
typedef unsigned short bf16_t;
__host__ __device__ inline float bf2f(bf16_t v) { unsigned u = ((unsigned)v) << 16; float f; __builtin_memcpy(&f, &u, 4); return f; }
__host__ __device__ inline bf16_t f2bf(float f) { unsigned u; __builtin_memcpy(&u, &f, 4); u += 0x7fffu + ((u >> 16) & 1u); return (bf16_t)(u >> 16); }
constexpr int NTOK = 16384, SEQ = 4096, NB = 4, DM = 1024, DIN = 6656, MEMLEN = 256, NEXP = 32;
constexpr size_t MiB = (size_t)1 << 20;
constexpr size_t WS_CTL = 0;
constexpr size_t WS_WIN = 1 * MiB;
constexpr size_t WS_WMEMKV = 14 * MiB;
constexpr size_t WS_WBR = 16 * MiB;
constexpr size_t WS_WOUT = 19 * MiB;
constexpr size_t WS_W1 = 21 * MiB;
constexpr size_t WS_W2 = 149 * MiB;
constexpr size_t WS_HB = 213 * MiB;
constexpr size_t WS_HM = 245 * MiB;
constexpr size_t WS_RQ = 247 * MiB, WS_RK = 255 * MiB, WS_RV = 263 * MiB, WS_RG = 279 * MiB, WS_MQ = 295 * MiB, WS_MK = 311 * MiB, WS_MV = 327 * MiB, WS_CQ = 343 * MiB, WS_GT = 359 * MiB;
constexpr size_t WS_MEMK = 455 * MiB, WS_MEMV = 456 * MiB, WS_KMEAN = 457 * MiB, WS_MEMKSS = 457 * MiB + 512 * 1024;
constexpr size_t WS_ORET = 458 * MiB, WS_OMOBA = 474 * MiB, WS_OMEM = 490 * MiB;
constexpr size_t WS_Y = 506 * MiB, WS_XT = 538 * MiB;
constexpr size_t WS_TOPE = 570 * MiB, WS_TOPW = 570 * MiB + 256 * 1024, WS_LISTS = 571 * MiB;
constexpr size_t WS_ACT = 574 * MiB;
constexpr size_t WS_YS = 703 * MiB;
constexpr size_t WS_RETST = 959 * MiB;
constexpr size_t WS_END = 1024 * MiB;
constexpr size_t WS_PROJ = 574 * MiB;
constexpr size_t WS_PM = 990 * MiB;
constexpr size_t WS_ORAW = 574 * MiB;
constexpr size_t WS_T0 = 703 * MiB, WS_T1 = 767 * MiB, WS_T2 = 831 * MiB;
constexpr int CW_COUNTS = 64;
namespace nv {
struct NGemm {
    const bf16_t* A; const int* arow; const float* W; const int* Mdev; size_t w_zstride;
    int lda, arow_zstride, ashift, ldw, M, N, K, pad;
};
static inline NGemm mk_gemm(const bf16_t* A, int lda, const int* arow, int arow_zstride, int ashift, const float* W, int ldw, size_t w_zstride, int M, const int* Mdev, int N, int K) {
    NGemm g; memset(&g, 0, sizeof g); g.A = A; g.arow = arow; g.W = W; g.Mdev = Mdev; g.w_zstride = w_zstride; g.lda = lda; g.arow_zstride = arow_zstride; g.ashift = ashift; g.ldw = ldw; g.M = M; g.N = N; g.K = K; return g; }
template <class Epi> __global__ __launch_bounds__(256) void nk_gemm(NGemm g, Epi epi) {
    __shared__ float As[16][68]; __shared__ float Ws[16][68];
    const int z = blockIdx.z; const int M = g.Mdev ? g.Mdev[z] : g.M; const int m0 = blockIdx.y * 64, n0 = blockIdx.x * 64; if (m0 >= M) return;
    const int tid = threadIdx.x, tx = tid & 15, ty = tid >> 4;
    const int* arow = g.arow ? g.arow + (size_t)z * g.arow_zstride : nullptr; const float* W = g.W + (size_t)z * g.w_zstride;
    const int lr = tid >> 2, lk = (tid & 3) * 4; int srow = -1, rid = -1;
    { const int m = m0 + lr; if (m < M) { rid = arow ? arow[m] : m; srow = arow ? (rid >> g.ashift) : m; } }
    float acc[4][4]; for (int i = 0; i < 4; ++i) for (int j = 0; j < 4; ++j) acc[i][j] = 0.f;
    for (int k0 = 0; k0 < g.K; k0 += 16) {
        float a4[4] = {0.f, 0.f, 0.f, 0.f};
        if (srow >= 0) { const bf16_t* p = g.A + (size_t)srow * g.lda + k0 + lk; for (int j = 0; j < 4; ++j) a4[j] = bf2f(p[j]); }
        for (int j = 0; j < 4; ++j) As[lk + j][lr] = a4[j];
        { const int wk = tid >> 4, wn = (tid & 15) * 4; const float* p = W + (size_t)(k0 + wk) * g.ldw + n0 + wn; for (int j = 0; j < 4; ++j) Ws[wk][wn + j] = p[j]; }
        __syncthreads();
#pragma unroll
        for (int kk = 0; kk < 16; ++kk) { float a[4], b[4]; for (int i = 0; i < 4; ++i) { a[i] = As[kk][ty * 4 + i]; b[i] = Ws[kk][tx * 4 + i]; }
            for (int i = 0; i < 4; ++i) for (int j = 0; j < 4; ++j) acc[i][j] += a[i] * b[j]; }
        __syncthreads();
    }
    for (int i = 0; i < 4; ++i) { const int m = m0 + ty * 4 + i; if (m < M) { const int id = arow ? arow[m] : m; epi(z, id, m, n0 + tx * 4, acc[i]); } }
}
struct EpiStoreF32 { float* C; int ldc; int pad; __device__ void operator()(int, int id, int, int n, const float* v) const { float* p = C + (size_t)id * ldc + n; for (int j = 0; j < 4; ++j) p[j] = v[j]; } };
struct EpiMoeAct { bf16_t* ACT; const float* b1; __device__ void operator()(int e, int id, int, int n, const float* v) const {
    const float* b = b1 + (size_t)e * 2048 + n;
    for (int p = 0; p < 2; ++p) { float gl = fminf(v[2 * p] + b[2 * p], 7.0f); float li = fminf(fmaxf(v[2 * p + 1] + b[2 * p + 1], -7.0f), 7.0f);
        float a = gl * (1.f / (1.f + expf(-1.702f * gl))) * (li + 1.f); ACT[(size_t)id * 1024 + (n >> 1) + p] = f2bf(a); } } };
struct EpiMoeOut { float* YS; const float* b2; __device__ void operator()(int e, int id, int, int n, const float* v) const {
    const float* b = b2 + (size_t)e * 1024 + n; float* p = YS + (size_t)id * 1024 + n; for (int j = 0; j < 4; ++j) p[j] = v[j] + b[j]; } };

__device__ inline float wave_sum(float v) { for (int o = 1; o < 64; o <<= 1) v += __shfl_xor(v, o); return v; }
__device__ inline float wave_max(float v) { for (int o = 1; o < 64; o <<= 1) v = fmaxf(v, __shfl_xor(v, o)); return v; }

__global__ __launch_bounds__(256) void nk_rmsnorm(const float* x, const float* g, bf16_t* out, int rows) {
    const int w = (blockIdx.x * 256 + threadIdx.x) >> 6, lane = threadIdx.x & 63; if (w >= rows) return;
    const float* xr = x + (size_t)w * 1024; float v[16]; float s = 0.f;
    for (int j = 0; j < 16; ++j) { v[j] = xr[lane + 64 * j]; s += v[j] * v[j]; }
    const float r = rsqrtf(wave_sum(s) * (1.f / 1024.f) + 1e-5f);
#pragma unroll
    for (int j = 0; j < 16; ++j) out[(size_t)w * 1024 + lane + 64 * j] = f2bf(v[j] * r * g[lane + 64 * j]);
}
struct PostProj { const float* P; const float* b_gate; const float* g_moba_q; const float* g_moba_k;
    bf16_t *RQ, *RK, *RV, *RG, *MQ, *MK, *MV, *CQ, *GT; };
__global__ __launch_bounds__(256) void nk_post_proj(PostProj a) {
    const int t = blockIdx.x, tid = threadIdx.x, lane = tid & 63, w = tid >> 6; const float* p = a.P + (size_t)t * 6656;
    for (int c = tid; c < 256; c += 256) { a.RQ[(size_t)t * 256 + c] = f2bf(p[c]); a.RK[(size_t)t * 256 + c] = f2bf(p[256 + c] * 0.125f); }
    for (int c = tid; c < 512; c += 256) { a.RV[(size_t)t * 512 + c] = f2bf(p[512 + c]); const float g = p[1024 + c]; a.RG[(size_t)t * 512 + c] = f2bf(g / (1.f + expf(-g)));
        a.MV[(size_t)t * 512 + c] = f2bf(p[2560 + c]); a.CQ[(size_t)t * 512 + c] = f2bf(p[3072 + c]); }
    for (int h = w; h < 8; h += 4) {
        float q = p[1536 + h * 64 + lane], k = p[2048 + h * 64 + lane];
        const float rq = rsqrtf(wave_sum(q * q) * (1.f / 64.f) + 1e-5f), rk = rsqrtf(wave_sum(k * k) * (1.f / 64.f) + 1e-5f);
        a.MQ[(size_t)t * 512 + h * 64 + lane] = f2bf(q * rq * a.g_moba_q[lane]); a.MK[(size_t)t * 512 + h * 64 + lane] = f2bf(k * rk * a.g_moba_k[lane]);
    }
    for (int c = tid; c < 3072; c += 256) { const float g = p[3584 + c] + a.b_gate[c]; a.GT[(size_t)t * 3072 + c] = f2bf(1.f / (1.f + expf(-g))); }
}
__global__ __launch_bounds__(256) void nk_post_mem(const float* PM, bf16_t* MEMK, float* MEMKSS, bf16_t* MEMV) {
    const int r = blockIdx.x, tid = threadIdx.x, lane = tid & 63, w = tid >> 6; const float* p = PM + (size_t)r * 1024;
    for (int c = tid; c < 512; c += 256) { MEMK[(size_t)r * 512 + c] = f2bf(p[c]); MEMV[(size_t)r * 512 + c] = f2bf(p[512 + c]); }
    { const float a = p[w * 128 + lane], b = p[w * 128 + 64 + lane]; const float s = wave_sum(a * a + b * b); if (lane == 0) MEMKSS[r * 4 + w] = s; }
}
__global__ __launch_bounds__(64) void nk_kmean(const bf16_t* MK, float* KMEAN) {
    const int bb = blockIdx.x, h = blockIdx.y, d = threadIdx.x; float s = 0.f;
    for (int r = 0; r < 256; ++r) s += bf2f(MK[((size_t)bb * 256 + r) * 512 + h * 64 + d]);
    KMEAN[((size_t)bb * 8 + h) * 64 + d] = s * (1.f / 256.f);
}
__global__ __launch_bounds__(256) void nk_retention(const bf16_t* RQ, const bf16_t* RK, const bf16_t* RV, float* ORAW) {
    const int b = blockIdx.x >> 2, h = blockIdx.x & 3, tid = threadIdx.x, e = tid & 127, hf = tid >> 7;
    const float gamma = 1.f - exp2f(-5.f - (float)h);
    __shared__ float qs[64], ks[64], part[256];
    float s[32];
#pragma unroll
    for (int i = 0; i < 32; ++i) s[i] = 0.f;
    for (int t = 0; t < 4096; ++t) { const size_t row = (size_t)b * 4096 + t;
        if (tid < 64) qs[tid] = bf2f(RQ[row * 256 + h * 64 + tid]); else if (tid < 128) ks[tid - 64] = bf2f(RK[row * 256 + h * 64 + tid - 64]);
        const float v = bf2f(RV[row * 512 + h * 128 + e]);
        __syncthreads();
        float o = 0.f;
#pragma unroll
        for (int i = 0; i < 32; ++i) { s[i] = gamma * s[i] + ks[hf * 32 + i] * v; o += qs[hf * 32 + i] * s[i]; }
        part[tid] = o; __syncthreads();
        if (tid < 128) ORAW[row * 512 + h * 128 + tid] = part[tid] + part[tid + 128];
    }
}
__global__ __launch_bounds__(256) void nk_ret_post(const float* ORAW, const float* g_ret_out, const bf16_t* RG, bf16_t* ORET) {
    const int w = (blockIdx.x * 256 + threadIdx.x) >> 6, lane = threadIdx.x & 63; const int t = w >> 2, h = w & 3;
    const float* p = ORAW + (size_t)t * 512 + h * 128; const float a = p[lane], b = p[lane + 64];
    const float r = rsqrtf(wave_sum(a * a + b * b) * (1.f / 128.f) + 1e-5f);
    ORET[(size_t)t * 512 + h * 128 + lane] = f2bf(a * r * g_ret_out[lane] * bf2f(RG[(size_t)t * 512 + h * 128 + lane]));
    ORET[(size_t)t * 512 + h * 128 + lane + 64] = f2bf(b * r * g_ret_out[lane + 64] * bf2f(RG[(size_t)t * 512 + h * 128 + lane + 64]));
}
__global__ __launch_bounds__(256) void nk_moba(const bf16_t* MQ, const bf16_t* MK, const bf16_t* MV, const float* KMEAN, bf16_t* OMOBA) {
    __shared__ float sc[4][1024]; __shared__ float qsh[4][64];
    const int wl = threadIdx.x >> 6, lane = threadIdx.x & 63; const int w = blockIdx.x * 4 + wl;
    const int t = w & 4095, h = (w >> 12) & 7, b = w >> 15; const int qb = t >> 8;
    const size_t row = (size_t)b * 4096 + t;
    qsh[wl][lane] = bf2f(MQ[row * 512 + h * 64 + lane]);
    __syncthreads();
    float q[64];
#pragma unroll
    for (int d = 0; d < 64; ++d) q[d] = qsh[wl][d];
    float gsc = -INFINITY; if (lane < qb) { const float* km = KMEAN + (((size_t)b * 16 + lane) * 8 + h) * 64; float s = 0.f;
#pragma unroll
        for (int d = 0; d < 64; ++d) s += q[d] * km[d];
        gsc = s; }
    int sel[4]; sel[0] = qb;
#pragma unroll
    for (int r = 0; r < 3; ++r) { const float m = wave_max(gsc); int j = -1; if (m != -INFINITY) { const unsigned long long bal = __ballot(gsc == m); j = __ffsll((long long)bal) - 1; } sel[r + 1] = j; if (lane == j) gsc = -INFINITY; }
    const float slope = exp2f(-(float)(h + 1));
    float mx = -INFINITY;
#pragma unroll
    for (int s = 0; s < 4; ++s) { const int blk = sel[s];
        for (int c = 0; c < 4; ++c) { const int kp = blk * 256 + c * 64 + lane; float v = -INFINITY;
            if (blk >= 0 && kp <= t) { const bf16_t* kr = MK + ((size_t)b * 4096 + kp) * 512 + h * 64; float d_ = 0.f;
#pragma unroll
                for (int d = 0; d < 64; ++d) d_ += q[d] * bf2f(kr[d]);
                v = d_ * 0.125f - slope * (float)(t - kp); }
            sc[wl][s * 256 + c * 64 + lane] = v; mx = fmaxf(mx, v); } }
    mx = wave_max(mx); float sum = 0.f;
    for (int i = lane; i < 1024; i += 64) { const float p = expf(sc[wl][i] - mx); sc[wl][i] = p; sum += p; }
    sum = wave_sum(sum);
    __syncthreads();
    float o = 0.f;
#pragma unroll
    for (int s = 0; s < 4; ++s) { const int blk = sel[s]; if (blk >= 0) for (int k = 0; k < 256; ++k) { const float p = sc[wl][s * 256 + k]; if (p != 0.f) o += p * bf2f(MV[((size_t)b * 4096 + blk * 256 + k) * 512 + h * 64 + lane]); } }
    OMOBA[row * 512 + h * 64 + lane] = f2bf(o / sum);
}
__global__ __launch_bounds__(256) void nk_memattn(const bf16_t* CQ, const bf16_t* MEMK, const float* MEMKSS, const bf16_t* MEMV, const float* g_mem_q, const float* g_mem_k, bf16_t* OMEM) {
    __shared__ float sc[4][256]; __shared__ float qsh[4][128];
    const int wl = threadIdx.x >> 6, lane = threadIdx.x & 63; const int w = blockIdx.x * 4 + wl;
    const int t = w & 4095, h = (w >> 12) & 3, b = w >> 14; const size_t row = (size_t)b * 4096 + t;
    const float q0 = bf2f(CQ[row * 512 + h * 128 + lane]), q1 = bf2f(CQ[row * 512 + h * 128 + 64 + lane]);
    const float rq = rsqrtf(wave_sum(q0 * q0 + q1 * q1) * (1.f / 128.f) + 1e-5f);
    qsh[wl][lane] = q0 * rq * g_mem_q[lane] * g_mem_k[lane]; qsh[wl][lane + 64] = q1 * rq * g_mem_q[lane + 64] * g_mem_k[lane + 64];
    __syncthreads();
    float mx = -INFINITY;
    for (int c = 0; c < 4; ++c) { const int m = c * 64 + lane; const bf16_t* kr = MEMK + ((size_t)b * 256 + m) * 512 + h * 128; float d_ = 0.f; for (int d = 0; d < 128; ++d) d_ += qsh[wl][d] * bf2f(kr[d]);
        const float rk = rsqrtf(MEMKSS[((size_t)b * 256 + m) * 4 + h] * (1.f / 128.f) + 1e-5f); const float v = d_ * rk * 0.08838834764831845f; sc[wl][m] = v; mx = fmaxf(mx, v); }
    mx = wave_max(mx); float sum = 0.f;
    for (int i = lane; i < 256; i += 64) { const float p = expf(sc[wl][i] - mx); sc[wl][i] = p; sum += p; }
    sum = wave_sum(sum); __syncthreads();
    float o0 = 0.f, o1 = 0.f;
    for (int k = 0; k < 256; ++k) { const float p = sc[wl][k]; const bf16_t* vr = MEMV + ((size_t)b * 256 + k) * 512 + h * 128; o0 += p * bf2f(vr[lane]); o1 += p * bf2f(vr[lane + 64]); }
    OMEM[row * 512 + h * 128 + lane] = f2bf(o0 / sum); OMEM[row * 512 + h * 128 + 64 + lane] = f2bf(o1 / sum);
}
__global__ __launch_bounds__(256) void nk_merge(const float* T0, const float* T1, const float* T2, const bf16_t* GT, bf16_t* Y) {
    const size_t i = (size_t)blockIdx.x * 256 + threadIdx.x; const size_t t = i >> 10; const int n = (int)(i & 1023);
    Y[i] = f2bf(bf2f(GT[t * 3072 + n]) * T0[i] + bf2f(GT[t * 3072 + 1024 + n]) * T1[i] + bf2f(GT[t * 3072 + 2048 + n]) * T2[i]);
}
__global__ __launch_bounds__(256) void nk_resid(const float* x, const float* T, float* X1) { const size_t i = (size_t)blockIdx.x * 256 + threadIdx.x; X1[i] = x[i] + T[i]; }
__global__ __launch_bounds__(256) void nk_router(const float* X1, const float* g_ffn, const float* w_router, const float* b_router, bf16_t* XT, int* TOPE, float* TOPW, int* COUNTS, int* LISTS) {
    const int t = (blockIdx.x * 256 + threadIdx.x) >> 6, lane = threadIdx.x & 63; const float* xr = X1 + (size_t)t * 1024; float v[16]; float s = 0.f;
    for (int j = 0; j < 16; ++j) { v[j] = xr[lane + 64 * j]; s += v[j] * v[j]; }
    const float r = rsqrtf(wave_sum(s) * (1.f / 1024.f) + 1e-5f);
#pragma unroll
    for (int j = 0; j < 16; ++j) { v[j] = v[j] * r * g_ffn[lane + 64 * j]; XT[(size_t)t * 1024 + lane + 64 * j] = f2bf(v[j]); }
    float lg = -INFINITY;
    for (int e = 0; e < 32; ++e) { float p = 0.f;
#pragma unroll
        for (int j = 0; j < 16; ++j) p += v[j] * w_router[(size_t)(lane + 64 * j) * 32 + e]; p = wave_sum(p); if (lane == e) lg = p + b_router[e]; }
    float tv[4]; int te[4];
#pragma unroll
    for (int k = 0; k < 4; ++k) { const float m = wave_max(lg); const unsigned long long bal = __ballot(lg == m); const int e = __ffsll((long long)bal) - 1; tv[k] = m; te[k] = e; if (lane == e) lg = -INFINITY; }
    float ex[4], se = 0.f;
#pragma unroll
    for (int k = 0; k < 4; ++k) { ex[k] = expf(tv[k] - tv[0]); se += ex[k]; }
    int e_l = te[0]; float w_l = ex[0];
#pragma unroll
    for (int k = 1; k < 4; ++k) if (lane == k) { e_l = te[k]; w_l = ex[k]; }
    if (lane < 4) { const int e = e_l; TOPE[t * 4 + lane] = e; TOPW[t * 4 + lane] = w_l / se; const int pos = atomicAdd(&COUNTS[e], 1); LISTS[(size_t)e * 16384 + pos] = t * 4 + lane; }
}
__global__ __launch_bounds__(256) void nk_combine(const float* X1, const float* YS, const float* TOPW, float* out) {
    const size_t i = (size_t)blockIdx.x * 256 + threadIdx.x; const size_t t = i >> 10; const int n = (int)(i & 1023); float a = X1[i];
    for (int k = 0; k < 4; ++k) a += TOPW[t * 4 + k] * YS[(t * 4 + k) * 1024 + n];
    out[i] = a;
}
}
extern "C" void kernel_launch(void* const* d_in, const int* in_sizes, int n_in, void* d_out, int out_size, void* d_ws, size_t ws_size, hipStream_t stream) {
    if (ws_size < WS_END) { fprintf(stderr, "kernel_launch: ws too small %zu < %zu\n", ws_size, (size_t)WS_END); return; }
    const float* x = (const float*)d_in[0]; const float* mem = (const float*)d_in[1]; const float* g_mix = (const float*)d_in[2]; const float* w_in = (const float*)d_in[3];
    const float* b_gate = (const float*)d_in[4]; const float* g_ret_out = (const float*)d_in[5]; const float* g_moba_q = (const float*)d_in[6]; const float* g_moba_k = (const float*)d_in[7];
    const float* g_mem = (const float*)d_in[8]; const float* w_mem_kv = (const float*)d_in[9]; const float* g_mem_q = (const float*)d_in[10]; const float* g_mem_k = (const float*)d_in[11];
    const float* w_br_ret = (const float*)d_in[12]; const float* w_br_moba = (const float*)d_in[13]; const float* w_br_mem = (const float*)d_in[14]; const float* w_out = (const float*)d_in[15];
    const float* g_ffn = (const float*)d_in[16]; const float* w_router = (const float*)d_in[17]; const float* b_router = (const float*)d_in[18];
    const float* w_mlp1 = (const float*)d_in[19]; const float* b_mlp1 = (const float*)d_in[20]; const float* w_mlp2 = (const float*)d_in[21]; const float* b_mlp2 = (const float*)d_in[22];
    unsigned char* ws = (unsigned char*)d_ws; float* out = (float*)d_out;
#define BF(off) ((bf16_t*)(ws + (off)))
#define F32(off) ((float*)(ws + (off)))
    int* CTL = (int*)(ws + WS_CTL); int* COUNTS = CTL + CW_COUNTS;
    (void)hipMemsetAsync(ws + WS_CTL, 0, 1 * MiB, stream);
    using namespace nv;
    nk_rmsnorm<<<NTOK / 4, 256, 0, stream>>>(x, g_mix, BF(WS_HB), NTOK);
    nk_rmsnorm<<<1024 / 4, 256, 0, stream>>>(mem, g_mem, BF(WS_HM), 1024);
    { NGemm g = mk_gemm(BF(WS_HB), 1024, nullptr, 0, 0, w_in, DIN, 0, NTOK, nullptr, DIN, 1024); nk_gemm<<<dim3(DIN / 64, NTOK / 64, 1), 256, 0, stream>>>(g, EpiStoreF32{F32(WS_PROJ), DIN, 0}); }
    { PostProj a{F32(WS_PROJ), b_gate, g_moba_q, g_moba_k, BF(WS_RQ), BF(WS_RK), BF(WS_RV), BF(WS_RG), BF(WS_MQ), BF(WS_MK), BF(WS_MV), BF(WS_CQ), BF(WS_GT)}; nk_post_proj<<<NTOK, 256, 0, stream>>>(a); }
    { NGemm g = mk_gemm(BF(WS_HM), 1024, nullptr, 0, 0, w_mem_kv, 1024, 0, 1024, nullptr, 1024, 1024); nk_gemm<<<dim3(16, 16, 1), 256, 0, stream>>>(g, EpiStoreF32{F32(WS_PM), 1024, 0}); }
    nk_post_mem<<<1024, 256, 0, stream>>>(F32(WS_PM), BF(WS_MEMK), F32(WS_MEMKSS), BF(WS_MEMV));
    nk_kmean<<<dim3(64, 8), 64, 0, stream>>>(BF(WS_MK), F32(WS_KMEAN));
    nk_retention<<<16, 256, 0, stream>>>(BF(WS_RQ), BF(WS_RK), BF(WS_RV), F32(WS_ORAW));
    nk_ret_post<<<NTOK, 256, 0, stream>>>(F32(WS_ORAW), g_ret_out, BF(WS_RG), BF(WS_ORET));
    nk_moba<<<NB * 8 * SEQ / 4, 256, 0, stream>>>(BF(WS_MQ), BF(WS_MK), BF(WS_MV), F32(WS_KMEAN), BF(WS_OMOBA));
    nk_memattn<<<NB * 4 * SEQ / 4, 256, 0, stream>>>(BF(WS_CQ), BF(WS_MEMK), F32(WS_MEMKSS), BF(WS_MEMV), g_mem_q, g_mem_k, BF(WS_OMEM));
    { NGemm g = mk_gemm(BF(WS_ORET), 512, nullptr, 0, 0, w_br_ret, 1024, 0, NTOK, nullptr, 1024, 512); nk_gemm<<<dim3(16, 256, 1), 256, 0, stream>>>(g, EpiStoreF32{F32(WS_T0), 1024, 0}); }
    { NGemm g = mk_gemm(BF(WS_OMOBA), 512, nullptr, 0, 0, w_br_moba, 1024, 0, NTOK, nullptr, 1024, 512); nk_gemm<<<dim3(16, 256, 1), 256, 0, stream>>>(g, EpiStoreF32{F32(WS_T1), 1024, 0}); }
    { NGemm g = mk_gemm(BF(WS_OMEM), 512, nullptr, 0, 0, w_br_mem, 1024, 0, NTOK, nullptr, 1024, 512); nk_gemm<<<dim3(16, 256, 1), 256, 0, stream>>>(g, EpiStoreF32{F32(WS_T2), 1024, 0}); }
    nk_merge<<<NTOK * 1024 / 256, 256, 0, stream>>>(F32(WS_T0), F32(WS_T1), F32(WS_T2), BF(WS_GT), BF(WS_Y));
    { NGemm g = mk_gemm(BF(WS_Y), 1024, nullptr, 0, 0, w_out, 1024, 0, NTOK, nullptr, 1024, 1024); nk_gemm<<<dim3(16, 256, 1), 256, 0, stream>>>(g, EpiStoreF32{F32(WS_T0), 1024, 0}); }
    nk_resid<<<NTOK * 1024 / 256, 256, 0, stream>>>(x, F32(WS_T0), out);
    nk_router<<<NTOK / 4, 256, 0, stream>>>(out, g_ffn, w_router, b_router, BF(WS_XT), (int*)(ws + WS_TOPE), F32(WS_TOPW), COUNTS, (int*)(ws + WS_LISTS));
    { NGemm g = mk_gemm(BF(WS_XT), 1024, (const int*)(ws + WS_LISTS), 16384, 2, w_mlp1, 2048, (size_t)1024 * 2048, 0, COUNTS, 2048, 1024); nk_gemm<<<dim3(32, 256, 32), 256, 0, stream>>>(g, EpiMoeAct{BF(WS_ACT), b_mlp1}); }
    { NGemm g = mk_gemm(BF(WS_ACT), 1024, (const int*)(ws + WS_LISTS), 16384, 0, w_mlp2, 1024, (size_t)1024 * 1024, 0, COUNTS, 1024, 1024); nk_gemm<<<dim3(16, 256, 32), 256, 0, stream>>>(g, EpiMoeOut{F32(WS_YS), b_mlp2}); }
    nk_combine<<<NTOK * 1024 / 256, 256, 0, stream>>>(out, F32(WS_YS), F32(WS_TOPW), out);
}
```

```cpp
#include <hip/hip_runtime.h>
#include <cstdio>
#include <cstdint>
#include <cstring>
typedef unsigned short bf16_t;
__host__ __device__ inline float bf2f(bf16_t v) { unsigned u = ((unsigned)v) << 16; float f; __builtin_memcpy(&f, &u, 4); return f; }
__host__ __device__ inline bf16_t f2bf(float f) { unsigned u; __builtin_memcpy(&u, &f, 4); u += 0x7fffu + ((u >> 16) & 1u); return (bf16_t)(u >> 16); }
constexpr int NTOK = 16384, SEQ = 4096, NB = 4, DM = 1024, DIN = 6656, MEMLEN = 256, NEXP = 32;
constexpr size_t MiB = (size_t)1 << 20;
constexpr size_t WS_CTL = 0;
constexpr size_t WS_WIN = 1 * MiB;
constexpr size_t WS_WMEMKV = 14 * MiB;
constexpr size_t WS_WBR = 16 * MiB;
constexpr size_t WS_WOUT = 19 * MiB;
constexpr size_t WS_W1 = 21 * MiB;
constexpr size_t WS_W2 = 149 * MiB;
constexpr size_t WS_HB = 213 * MiB;
constexpr size_t WS_HM = 245 * MiB;
constexpr size_t WS_RQ = 247 * MiB, WS_RK = 255 * MiB, WS_RV = 263 * MiB, WS_RG = 279 * MiB, WS_MQ = 295 * MiB, WS_MK = 311 * MiB, WS_MV = 327 * MiB, WS_CQ = 343 * MiB, WS_GT = 359 * MiB;
constexpr size_t WS_MEMK = 455 * MiB, WS_MEMV = 456 * MiB, WS_KMEAN = 457 * MiB, WS_MEMKSS = 457 * MiB + 512 * 1024;
constexpr size_t WS_GTAB = 457 * MiB + 768 * 1024;
constexpr size_t WS_ORET = 458 * MiB, WS_OMOBA = 474 * MiB, WS_OMEM = 490 * MiB;
constexpr size_t WS_Y = 506 * MiB, WS_XT = 538 * MiB;
constexpr size_t WS_TOPE = 570 * MiB, WS_TOPW = 570 * MiB + 256 * 1024, WS_LISTS = 571 * MiB;
constexpr size_t WS_ACT = 574 * MiB;
constexpr size_t WS_YS = 703 * MiB;
constexpr size_t WS_RETST = 959 * MiB;
constexpr size_t WS_END = 1024 * MiB;
constexpr size_t WS_PROJ = 574 * MiB;
constexpr size_t WS_PM = 990 * MiB;
constexpr size_t WS_ORAW = 574 * MiB;
constexpr size_t WS_T0 = 703 * MiB, WS_T1 = 767 * MiB, WS_T2 = 831 * MiB;
constexpr int CW_COUNTS = 64;
namespace nv {
struct NGemm {
    const bf16_t* A; const int* arow; const float* W; const int* Mdev; size_t w_zstride;
    int lda, arow_zstride, ashift, ldw, M, N, K, pad;
};
static inline NGemm mk_gemm(const bf16_t* A, int lda, const int* arow, int arow_zstride, int ashift, const float* W, int ldw, size_t w_zstride, int M, const int* Mdev, int N, int K) {
    NGemm g; memset(&g, 0, sizeof g); g.A = A; g.arow = arow; g.W = W; g.Mdev = Mdev; g.w_zstride = w_zstride; g.lda = lda; g.arow_zstride = arow_zstride; g.ashift = ashift; g.ldw = ldw; g.M = M; g.N = N; g.K = K; return g; }
template <class Epi> __global__ __launch_bounds__(256) void nk_gemm(NGemm g, Epi epi) {
    __shared__ float As[16][68]; __shared__ float Ws[16][68];
    const int z = blockIdx.z; const int M = g.Mdev ? g.Mdev[z] : g.M; const int m0 = blockIdx.y * 64, n0 = blockIdx.x * 64; if (m0 >= M) return;
    const int tid = threadIdx.x, tx = tid & 15, ty = tid >> 4;
    const int* arow = g.arow ? g.arow + (size_t)z * g.arow_zstride : nullptr; const float* W = g.W + (size_t)z * g.w_zstride;
    const int lr = tid >> 2, lk = (tid & 3) * 4; int srow = -1, rid = -1;
    { const int m = m0 + lr; if (m < M) { rid = arow ? arow[m] : m; srow = arow ? (rid >> g.ashift) : m; } }
    float acc[4][4]; for (int i = 0; i < 4; ++i) for (int j = 0; j < 4; ++j) acc[i][j] = 0.f;
    for (int k0 = 0; k0 < g.K; k0 += 16) {
        float a4[4] = {0.f, 0.f, 0.f, 0.f};
        if (srow >= 0) { const bf16_t* p = g.A + (size_t)srow * g.lda + k0 + lk; for (int j = 0; j < 4; ++j) a4[j] = bf2f(p[j]); }
        for (int j = 0; j < 4; ++j) As[lk + j][lr] = a4[j];
        { const int wk = tid >> 4, wn = (tid & 15) * 4; const float* p = W + (size_t)(k0 + wk) * g.ldw + n0 + wn; for (int j = 0; j < 4; ++j) Ws[wk][wn + j] = p[j]; }
        __syncthreads();
#pragma unroll
        for (int kk = 0; kk < 16; ++kk) { float a[4], b[4]; for (int i = 0; i < 4; ++i) { a[i] = As[kk][ty * 4 + i]; b[i] = Ws[kk][tx * 4 + i]; }
            for (int i = 0; i < 4; ++i) for (int j = 0; j < 4; ++j) acc[i][j] += a[i] * b[j]; }
        __syncthreads();
    }
    for (int i = 0; i < 4; ++i) { const int m = m0 + ty * 4 + i; if (m < M) { const int id = arow ? arow[m] : m; epi(z, id, m, n0 + tx * 4, acc[i]); } }
}
struct EpiStoreF32 { float* C; int ldc; int pad; __device__ void operator()(int, int id, int, int n, const float* v) const { float* p = C + (size_t)id * ldc + n; for (int j = 0; j < 4; ++j) p[j] = v[j]; } };
struct EpiMoeAct { bf16_t* ACT; const float* b1; __device__ void operator()(int e, int id, int, int n, const float* v) const {
    const float* b = b1 + (size_t)e * 2048 + n;
    for (int p = 0; p < 2; ++p) { float gl = fminf(v[2 * p] + b[2 * p], 7.0f); float li = fminf(fmaxf(v[2 * p + 1] + b[2 * p + 1], -7.0f), 7.0f);
        float a = gl * (1.f / (1.f + expf(-1.702f * gl))) * (li + 1.f); ACT[(size_t)id * 1024 + (n >> 1) + p] = f2bf(a); } } };
struct EpiMoeOut { float* YS; const float* b2; __device__ void operator()(int e, int id, int, int n, const float* v) const {
    const float* b = b2 + (size_t)e * 1024 + n; float* p = YS + (size_t)id * 1024 + n; for (int j = 0; j < 4; ++j) p[j] = v[j] + b[j]; } };

__device__ inline float wave_sum(float v) { for (int o = 1; o < 64; o <<= 1) v += __shfl_xor(v, o); return v; }
__device__ inline float wave_max(float v) { for (int o = 1; o < 64; o <<= 1) v = fmaxf(v, __shfl_xor(v, o)); return v; }

__global__ __launch_bounds__(256) void nk_rmsnorm(const float* x, const float* g, bf16_t* out, int rows) {
    const int w = (blockIdx.x * 256 + threadIdx.x) >> 6, lane = threadIdx.x & 63; if (w >= rows) return;
    const float* xr = x + (size_t)w * 1024; float v[16]; float s = 0.f;
    for (int j = 0; j < 16; ++j) { v[j] = xr[lane + 64 * j]; s += v[j] * v[j]; }
    const float r = rsqrtf(wave_sum(s) * (1.f / 1024.f) + 1e-5f);
#pragma unroll
    for (int j = 0; j < 16; ++j) out[(size_t)w * 1024 + lane + 64 * j] = f2bf(v[j] * r * g[lane + 64 * j]);
}
struct PostProj { const float* P; const float* b_gate; const float* g_moba_q; const float* g_moba_k;
    bf16_t *RQ, *RK, *RV, *RG, *MQ, *MK, *MV, *CQ, *GT; };
__global__ __launch_bounds__(256) void nk_post_proj(PostProj a) {
    const int t = blockIdx.x, tid = threadIdx.x, lane = tid & 63, w = tid >> 6; const float* p = a.P + (size_t)t * 6656;
    for (int c = tid; c < 256; c += 256) { a.RQ[(size_t)t * 256 + c] = f2bf(p[c]); a.RK[(size_t)t * 256 + c] = f2bf(p[256 + c] * 0.125f); }
    for (int c = tid; c < 512; c += 256) { a.RV[(size_t)t * 512 + c] = f2bf(p[512 + c]); const float g = p[1024 + c]; a.RG[(size_t)t * 512 + c] = f2bf(g / (1.f + expf(-g)));
        a.MV[(size_t)t * 512 + c] = f2bf(p[2560 + c]); a.CQ[(size_t)t * 512 + c] = f2bf(p[3072 + c]); }
    for (int h = w; h < 8; h += 4) {
        float q = p[1536 + h * 64 + lane], k = p[2048 + h * 64 + lane];
        const float rq = rsqrtf(wave_sum(q * q) * (1.f / 64.f) + 1e-5f), rk = rsqrtf(wave_sum(k * k) * (1.f / 64.f) + 1e-5f);
        a.MQ[(size_t)t * 512 + h * 64 + lane] = f2bf(q * rq * a.g_moba_q[lane]); a.MK[(size_t)t * 512 + h * 64 + lane] = f2bf(k * rk * a.g_moba_k[lane]);
    }
    for (int c = tid; c < 3072; c += 256) { const float g = p[3584 + c] + a.b_gate[c]; a.GT[(size_t)t * 3072 + c] = f2bf(1.f / (1.f + expf(-g))); }
}
__global__ __launch_bounds__(256) void nk_post_mem(const float* PM, bf16_t* MEMK, float* MEMKSS, bf16_t* MEMV) {
    const int r = blockIdx.x, tid = threadIdx.x, lane = tid & 63, w = tid >> 6; const float* p = PM + (size_t)r * 1024;
    for (int c = tid; c < 512; c += 256) { MEMK[(size_t)r * 512 + c] = f2bf(p[c]); MEMV[(size_t)r * 512 + c] = f2bf(p[512 + c]); }
    { const float a = p[w * 128 + lane], b = p[w * 128 + 64 + lane]; const float s = wave_sum(a * a + b * b); if (lane == 0) MEMKSS[r * 4 + w] = s; }
}
__global__ __launch_bounds__(256) void nk_memkss(const bf16_t* MEMK, float* MEMKSS) {
    const int r = blockIdx.x, lane = threadIdx.x & 63, w = threadIdx.x >> 6; const float a = bf2f(MEMK[(size_t)r * 512 + w * 128 + lane]), b = bf2f(MEMK[(size_t)r * 512 + w * 128 + 64 + lane]);
    const float s = wave_sum(a * a + b * b); if (lane == 0) MEMKSS[r * 4 + w] = s;
}
__global__ __launch_bounds__(64) void nk_kmean(const bf16_t* MK, float* KMEAN) {
    const int bb = blockIdx.x, h = blockIdx.y, d = threadIdx.x; float s = 0.f;
    for (int r = 0; r < 256; ++r) s += bf2f(MK[((size_t)bb * 256 + r) * 512 + h * 64 + d]);
    KMEAN[((size_t)bb * 8 + h) * 64 + d] = s * (1.f / 256.f);
}
__global__ __launch_bounds__(256) void nk_retention(const bf16_t* RQ, const bf16_t* RK, const bf16_t* RV, float* ORAW) {
    const int b = blockIdx.x >> 2, h = blockIdx.x & 3, tid = threadIdx.x, e = tid & 127, hf = tid >> 7;
    const float gamma = 1.f - exp2f(-5.f - (float)h);
    __shared__ float qs[64], ks[64], part[256];
    float s[32];
#pragma unroll
    for (int i = 0; i < 32; ++i) s[i] = 0.f;
    for (int t = 0; t < 4096; ++t) { const size_t row = (size_t)b * 4096 + t;
        if (tid < 64) qs[tid] = bf2f(RQ[row * 256 + h * 64 + tid]); else if (tid < 128) ks[tid - 64] = bf2f(RK[row * 256 + h * 64 + tid - 64]);
        const float v = bf2f(RV[row * 512 + h * 128 + e]);
        __syncthreads();
        float o = 0.f;
#pragma unroll
        for (int i = 0; i < 32; ++i) { s[i] = gamma * s[i] + ks[hf * 32 + i] * v; o += qs[hf * 32 + i] * s[i]; }
        part[tid] = o; __syncthreads();
        if (tid < 128) ORAW[row * 512 + h * 128 + tid] = part[tid] + part[tid + 128];
    }
}
__global__ __launch_bounds__(256) void nk_ret_post(const float* ORAW, const float* g_ret_out, const bf16_t* RG, bf16_t* ORET) {
    const int w = (blockIdx.x * 256 + threadIdx.x) >> 6, lane = threadIdx.x & 63; const int t = w >> 2, h = w & 3;
    const float* p = ORAW + (size_t)t * 512 + h * 128; const float a = p[lane], b = p[lane + 64];
    const float r = rsqrtf(wave_sum(a * a + b * b) * (1.f / 128.f) + 1e-5f);
    ORET[(size_t)t * 512 + h * 128 + lane] = f2bf(a * r * g_ret_out[lane] * bf2f(RG[(size_t)t * 512 + h * 128 + lane]));
    ORET[(size_t)t * 512 + h * 128 + lane + 64] = f2bf(b * r * g_ret_out[lane + 64] * bf2f(RG[(size_t)t * 512 + h * 128 + lane + 64]));
}
__global__ __launch_bounds__(256) void nk_moba(const bf16_t* MQ, const bf16_t* MK, const bf16_t* MV, const float* KMEAN, bf16_t* OMOBA) {
    __shared__ float sc[4][1024]; __shared__ float qsh[4][64];
    const int wl = threadIdx.x >> 6, lane = threadIdx.x & 63; const int w = blockIdx.x * 4 + wl;
    const int t = w & 4095, h = (w >> 12) & 7, b = w >> 15; const int qb = t >> 8;
    const size_t row = (size_t)b * 4096 + t;
    qsh[wl][lane] = bf2f(MQ[row * 512 + h * 64 + lane]);
    __syncthreads();
    float q[64];
#pragma unroll
    for (int d = 0; d < 64; ++d) q[d] = qsh[wl][d];
    float gsc = -INFINITY; if (lane < qb) { const float* km = KMEAN + (((size_t)b * 16 + lane) * 8 + h) * 64; float s = 0.f;
#pragma unroll
        for (int d = 0; d < 64; ++d) s += q[d] * km[d];
        gsc = s; }
    int sel[4]; sel[0] = qb;
#pragma unroll
    for (int r = 0; r < 3; ++r) { const float m = wave_max(gsc); int j = -1; if (m != -INFINITY) { const unsigned long long bal = __ballot(gsc == m); j = __ffsll((long long)bal) - 1; } sel[r + 1] = j; if (lane == j) gsc = -INFINITY; }
    const float slope = exp2f(-(float)(h + 1));
    float mx = -INFINITY;
#pragma unroll
    for (int s = 0; s < 4; ++s) { const int blk = sel[s];
        for (int c = 0; c < 4; ++c) { const int kp = blk * 256 + c * 64 + lane; float v = -INFINITY;
            if (blk >= 0 && kp <= t) { const bf16_t* kr = MK + ((size_t)b * 4096 + kp) * 512 + h * 64; float d_ = 0.f;
#pragma unroll
                for (int d = 0; d < 64; ++d) d_ += q[d] * bf2f(kr[d]);
                v = d_ * 0.125f - slope * (float)(t - kp); }
            sc[wl][s * 256 + c * 64 + lane] = v; mx = fmaxf(mx, v); } }
    mx = wave_max(mx); float sum = 0.f;
    for (int i = lane; i < 1024; i += 64) { const float p = expf(sc[wl][i] - mx); sc[wl][i] = p; sum += p; }
    sum = wave_sum(sum);
    __syncthreads();
    float o = 0.f;
#pragma unroll
    for (int s = 0; s < 4; ++s) { const int blk = sel[s]; if (blk >= 0) for (int k = 0; k < 256; ++k) { const float p = sc[wl][s * 256 + k]; if (p != 0.f) o += p * bf2f(MV[((size_t)b * 4096 + blk * 256 + k) * 512 + h * 64 + lane]); } }
    OMOBA[row * 512 + h * 64 + lane] = f2bf(o / sum);
}
__global__ __launch_bounds__(256) void nk_memattn(const bf16_t* CQ, const bf16_t* MEMK, const float* MEMKSS, const bf16_t* MEMV, const float* g_mem_q, const float* g_mem_k, bf16_t* OMEM) {
    __shared__ float sc[4][256]; __shared__ float qsh[4][128];
    const int wl = threadIdx.x >> 6, lane = threadIdx.x & 63; const int w = blockIdx.x * 4 + wl;
    const int t = w & 4095, h = (w >> 12) & 3, b = w >> 14; const size_t row = (size_t)b * 4096 + t;
    const float q0 = bf2f(CQ[row * 512 + h * 128 + lane]), q1 = bf2f(CQ[row * 512 + h * 128 + 64 + lane]);
    const float rq = rsqrtf(wave_sum(q0 * q0 + q1 * q1) * (1.f / 128.f) + 1e-5f);
    qsh[wl][lane] = q0 * rq * g_mem_q[lane] * g_mem_k[lane]; qsh[wl][lane + 64] = q1 * rq * g_mem_q[lane + 64] * g_mem_k[lane + 64];
    __syncthreads();
    float mx = -INFINITY;
    for (int c = 0; c < 4; ++c) { const int m = c * 64 + lane; const bf16_t* kr = MEMK + ((size_t)b * 256 + m) * 512 + h * 128; float d_ = 0.f; for (int d = 0; d < 128; ++d) d_ += qsh[wl][d] * bf2f(kr[d]);
        const float rk = rsqrtf(MEMKSS[((size_t)b * 256 + m) * 4 + h] * (1.f / 128.f) + 1e-5f); const float v = d_ * rk * 0.08838834764831845f; sc[wl][m] = v; mx = fmaxf(mx, v); }
    mx = wave_max(mx); float sum = 0.f;
    for (int i = lane; i < 256; i += 64) { const float p = expf(sc[wl][i] - mx); sc[wl][i] = p; sum += p; }
    sum = wave_sum(sum); __syncthreads();
    float o0 = 0.f, o1 = 0.f;
    for (int k = 0; k < 256; ++k) { const float p = sc[wl][k]; const bf16_t* vr = MEMV + ((size_t)b * 256 + k) * 512 + h * 128; o0 += p * bf2f(vr[lane]); o1 += p * bf2f(vr[lane + 64]); }
    OMEM[row * 512 + h * 128 + lane] = f2bf(o0 / sum); OMEM[row * 512 + h * 128 + 64 + lane] = f2bf(o1 / sum);
}
__global__ __launch_bounds__(256) void nk_merge(const float* T0, const float* T1, const float* T2, const bf16_t* GT, bf16_t* Y) {
    const size_t i = (size_t)blockIdx.x * 256 + threadIdx.x; const size_t t = i >> 10; const int n = (int)(i & 1023);
    Y[i] = f2bf(bf2f(GT[t * 3072 + n]) * T0[i] + bf2f(GT[t * 3072 + 1024 + n]) * T1[i] + bf2f(GT[t * 3072 + 2048 + n]) * T2[i]);
}
__global__ __launch_bounds__(256) void nk_resid(const float* x, const float* T, float* X1) { const size_t i = (size_t)blockIdx.x * 256 + threadIdx.x; X1[i] = x[i] + T[i]; }
__global__ __launch_bounds__(256) void nk_router(const float* X1, const float* g_ffn, const float* w_router, const float* b_router, bf16_t* XT, int* TOPE, float* TOPW, int* COUNTS, int* LISTS) {
    const int t = (blockIdx.x * 256 + threadIdx.x) >> 6, lane = threadIdx.x & 63; const float* xr = X1 + (size_t)t * 1024; float v[16]; float s = 0.f;
    for (int j = 0; j < 16; ++j) { v[j] = xr[lane + 64 * j]; s += v[j] * v[j]; }
    const float r = rsqrtf(wave_sum(s) * (1.f / 1024.f) + 1e-5f);
#pragma unroll
    for (int j = 0; j < 16; ++j) { v[j] = v[j] * r * g_ffn[lane + 64 * j]; XT[(size_t)t * 1024 + lane + 64 * j] = f2bf(v[j]); }
    float lg = -INFINITY;
    for (int e = 0; e < 32; ++e) { float p = 0.f;
#pragma unroll
        for (int j = 0; j < 16; ++j) p += v[j] * w_router[(size_t)(lane + 64 * j) * 32 + e]; p = wave_sum(p); if (lane == e) lg = p + b_router[e]; }
    float tv[4]; int te[4];
#pragma unroll
    for (int k = 0; k < 4; ++k) { const float m = wave_max(lg); const unsigned long long bal = __ballot(lg == m); const int e = __ffsll((long long)bal) - 1; tv[k] = m; te[k] = e; if (lane == e) lg = -INFINITY; }
    float ex[4], se = 0.f;
#pragma unroll
    for (int k = 0; k < 4; ++k) { ex[k] = expf(tv[k] - tv[0]); se += ex[k]; }
    int e_l = te[0]; float w_l = ex[0];
#pragma unroll
    for (int k = 1; k < 4; ++k) if (lane == k) { e_l = te[k]; w_l = ex[k]; }
    if (lane < 4) { const int e = e_l; TOPE[t * 4 + lane] = e; TOPW[t * 4 + lane] = w_l / se; const int pos = atomicAdd(&COUNTS[e], 1); LISTS[(size_t)e * 16384 + pos] = t * 4 + lane; }
}
__global__ __launch_bounds__(256) void nk_combine(const float* X1, const float* YS, const float* TOPW, float* out) {
    const size_t i = (size_t)blockIdx.x * 256 + threadIdx.x; const size_t t = i >> 10; const int n = (int)(i & 1023); float a = X1[i];
    for (int k = 0; k < 4; ++k) a += TOPW[t * 4 + k] * YS[(t * 4 + k) * 1024 + n];
    out[i] = a;
}
}
namespace pg8 {
#define PG8_LAS __attribute__((address_space(3)))
typedef unsigned short bf16_t;
typedef short bf16x8 __attribute__((ext_vector_type(8)));
typedef float f32x4 __attribute__((ext_vector_type(4)));
typedef unsigned u32x4 __attribute__((ext_vector_type(4)));
constexpr int BM = 256, BK = 64, HALF = 128, HTB = HALF * BK * 2  , STAGE_BYTES = 8 * HTB, NXCD = 8, WGM = 8;

__host__ __device__ __forceinline__ int lds_byte(int r, int c) { const int st = (r >> 4) * 2 + (c >> 5), rr = r & 15, cc = c & 31, ob = rr * 64 + cc * 2; return st * 1024 + (ob ^ (((ob >> 9) & 1) << 5)); }
__host__ __device__ __forceinline__ void stage_rc(int b, int& R, int& C) { const int st = b / 1024, sb = b % 1024, swz = sb ^ (((sb >> 9) & 1) << 5); R = (st >> 1) * 16 + swz / 64; C = (st & 1) * 32 + (swz % 64) / 2; }
__host__ __device__ __forceinline__ int perm32(int rho) { const int n = rho >> 4, i = rho & 15; return 8 * (i >> 2) + 4 * n + (i & 3); }

struct Unit { int pm, pn; };
struct Gemm { const bf16_t* A; const bf16_t* Bt; int M, N, K; };
struct StaticOrder {
    int nM, nN, nwg, G, c;
    __host__ __device__ void init(int M, int N, int G_, int c_) { nM = M / BM; nN = N / BM; nwg = nM * nN; G = G_; c = c_; }
    __host__ __device__ bool next(int i, Unit& u) const {
        const long L = (long)i * G + c; if (L >= nwg) return false;
        int wgid = (int)L; { const int q = nwg / NXCD, r = nwg % NXCD, xcd = wgid % NXCD, off = wgid / NXCD; wgid = (xcd < r ? xcd * (q + 1) : r * (q + 1) + (xcd - r) * q) + off; }
        const int nig = WGM * nN, gid = wgid / nig, fm = gid * WGM, gsz = (nM - fm) < WGM ? (nM - fm) : WGM;
        u.pm = fm + ((wgid % nig) % gsz); u.pn = (wgid % nig) / gsz; return true;
    }
    __device__ __forceinline__ void a_ready(const Unit&) const {}
    __device__ __forceinline__ void done(const Unit&) const {}
};
__device__ __forceinline__ unsigned cvt_pk_bf16(float lo, float hi) { unsigned r; asm volatile("v_cvt_pk_bf16_f32 %0, %1, %2" : "=v"(r) : "v"(lo), "v"(hi)); return r; }
typedef float f32x2 __attribute__((ext_vector_type(2)));
template <class Epi, class Sched, bool ALIGN_EPI = false, bool SP2 = false>
__device__ __forceinline__ void gemm_phase(PG8_LAS unsigned char* lds, const Gemm g, const Sched& S, const Epi& E) {
    const int tid = threadIdx.x, wid = __builtin_amdgcn_readfirstlane(tid >> 6), lane = tid & 63, wr = wid >> 2, wc = wid & 3, fr = lane & 15, fq = lane >> 4;
    const int K = g.K, nt = K / BK;
    unsigned voffA[2], voffB[2];
#pragma unroll
    for (int i = 0; i < 2; ++i) { int R, C; stage_rc(tid * 16 + i * 8192, R, C); const int Rb = Epi::PERM ? ((R & ~31) + perm32(R & 31)) : R;
        voffA[i] = (unsigned)(R * K + C) * 2u; voffB[i] = (unsigned)(Rb * K + C) * 2u; }
    const size_t kstep = (size_t)(BK * 2);
    const size_t hstep = (size_t)HALF * K * 2;
    const size_t tstep = 2 * hstep;
    const unsigned ldsw = (unsigned)wid * 1024u;
    const int aoff = lds_byte(wr * 64 + fr, fq * 8), boff = lds_byte(wc * 32 + fr, fq * 8);
#define PG8_SA(b, h) (((b) * 2 + (h)) * HTB)
#define PG8_SB(b, h) ((4 + (b) * 2 + (h)) * HTB)
#define PG8_STAGE(bufoff, gbase, voff) do { _Pragma("unroll") for (int _i = 0; _i < 2; ++_i) \
        __builtin_amdgcn_global_load_lds((const unsigned*)((const char*)(gbase) + (voff)[_i]), (PG8_LAS unsigned*)(lds + (bufoff) + ldsw + _i * 8192), 16, 0, 0); } while (0)
#define PG8_LDA(dst, b, h) do { _Pragma("unroll") for (int m = 0; m < 4; ++m) _Pragma("unroll") for (int k = 0; k < 2; ++k) dst[m][k] = *(const PG8_LAS bf16x8*)(lds + PG8_SA(b, h) + aoff + m * 2048 + k * 1024); } while (0)
#define PG8_LDB(dst, b, h) do { _Pragma("unroll") for (int n = 0; n < 2; ++n) _Pragma("unroll") for (int k = 0; k < 2; ++k) dst[n][k] = *(const PG8_LAS bf16x8*)(lds + PG8_SB(b, h) + boff + n * 2048 + k * 1024); } while (0)
#define PG8_MMA(ai, bj, At, Bt) do { __builtin_amdgcn_s_setprio(1); _Pragma("unroll") for (int m = 0; m < 4; ++m) _Pragma("unroll") for (int n = 0; n < 2; ++n) _Pragma("unroll") for (int k = 0; k < 2; ++k) \
        acc[ai][bj][m][n] = __builtin_amdgcn_mfma_f32_16x16x32_bf16(Bt[n][k], At[m][k], acc[ai][bj][m][n], 0, 0, 0); __builtin_amdgcn_s_setprio(0); } while (0)
#define PG8_WAIT_V(n) asm volatile("s_waitcnt vmcnt(" #n ")" ::: "memory")
#define PG8_WAIT_L(n) asm volatile("s_waitcnt lgkmcnt(" #n ")" ::: "memory")
#define PG8_BAR __builtin_amdgcn_s_barrier()
#define PG8_SCHED __builtin_amdgcn_sched_barrier(0)
    Unit cur, nxt; int ui = 0;
    if (!S.next(0, cur)) return;
    f32x4 acc[2][2][4][2];
#pragma unroll
    for (int a = 0; a < 2; ++a)
#pragma unroll
        for (int b = 0; b < 2; ++b)
#pragma unroll
            for (int m = 0; m < 4; ++m)
#pragma unroll
                for (int n = 0; n < 2; ++n) acc[a][b][m][n] = (f32x4){0.f, 0.f, 0.f, 0.f};
    bf16x8 At[4][2], B0[2][2], B1[2][2];
    const char* cA = (const char*)g.A + (size_t)cur.pm * tstep; const char* cB = (const char*)g.Bt + (size_t)cur.pn * tstep;
    S.a_ready(cur);
    if constexpr (SP2) {
        PG8_STAGE(PG8_SB(0, 0), cB, voffB); PG8_STAGE(PG8_SB(0, 1), cB + hstep, voffB); PG8_STAGE(PG8_SA(0, 0), cA, voffA); PG8_STAGE(PG8_SA(0, 1), cA + hstep, voffA);
        if (wr == 1) PG8_BAR;
        PG8_WAIT_V(2); PG8_BAR;
        PG8_STAGE(PG8_SB(1, 0), cB + kstep, voffB); PG8_STAGE(PG8_SA(1, 0), cA + kstep, voffA); PG8_STAGE(PG8_SB(1, 1), cB + hstep + kstep, voffB);
        PG8_WAIT_V(6); PG8_BAR;
    } else {
        PG8_STAGE(PG8_SB(0, 0), cB, voffB); PG8_STAGE(PG8_SA(0, 0), cA, voffA); PG8_STAGE(PG8_SB(0, 1), cB + hstep, voffB); PG8_STAGE(PG8_SA(0, 1), cA + hstep, voffA);
        if (wr == 1) PG8_BAR;
        PG8_WAIT_V(4); PG8_BAR;
        PG8_STAGE(PG8_SB(1, 0), cB + kstep, voffB); PG8_STAGE(PG8_SA(1, 0), cA + kstep, voffA); PG8_STAGE(PG8_SB(1, 1), cB + hstep + kstep, voffB);
        PG8_WAIT_V(6); PG8_BAR;
    }
    for (;;) {
        const bool has_next = S.next(ui + 1, nxt);
        const char* nA = has_next ? (const char*)g.A + (size_t)nxt.pm * tstep : cA; const char* nB = has_next ? (const char*)g.Bt + (size_t)nxt.pn * tstep : cB;
        for (int t = 0; t < nt; t += 2) {
            const bool last = (t == nt - 2);
            const char* a1 = cA + (size_t)(t + 1) * kstep;
            const char* a2 = last ? nA : cA + (size_t)(t + 2) * kstep; const char* b2 = last ? nB : cB + (size_t)(t + 2) * kstep;
            const char* a3 = a2 + kstep; const char* b3 = b2 + kstep;
            if (last && has_next) S.a_ready(nxt);
            if constexpr (SP2) {
            PG8_LDB(B0, 0, 0); PG8_LDB(B1, 0, 1); PG8_SCHED; PG8_LDA(At, 0, 0); PG8_STAGE(PG8_SA(1, 1), a1 + hstep, voffA);
            PG8_WAIT_V(8); PG8_WAIT_L(0); PG8_BAR; PG8_MMA(0, 0, At, B0); PG8_MMA(0, 1, At, B1); PG8_BAR; PG8_SCHED;
            PG8_LDA(At, 0, 1); PG8_STAGE(PG8_SB(0, 0), b2, voffB); PG8_STAGE(PG8_SB(0, 1), b2 + hstep, voffB); PG8_STAGE(PG8_SA(0, 0), a2, voffA);
            PG8_WAIT_V(8); PG8_WAIT_L(0); PG8_BAR; PG8_MMA(1, 0, At, B0); PG8_MMA(1, 1, At, B1); PG8_BAR; PG8_SCHED;
            PG8_LDB(B0, 1, 0); PG8_LDB(B1, 1, 1); PG8_SCHED; PG8_LDA(At, 1, 0); PG8_STAGE(PG8_SA(0, 1), a2 + hstep, voffA);
            PG8_WAIT_V(8); PG8_WAIT_L(0); PG8_BAR; PG8_MMA(0, 0, At, B0); PG8_MMA(0, 1, At, B1); PG8_BAR; PG8_SCHED;
            PG8_LDA(At, 1, 1); PG8_STAGE(PG8_SB(1, 0), b3, voffB); PG8_STAGE(PG8_SB(1, 1), b3 + hstep, voffB); PG8_STAGE(PG8_SA(1, 0), a3, voffA);
            PG8_WAIT_V(8); PG8_WAIT_L(0); PG8_BAR; PG8_MMA(1, 0, At, B0); PG8_MMA(1, 1, At, B1); PG8_BAR; PG8_SCHED;
            } else {
            PG8_LDB(B0, 0, 0); PG8_SCHED; PG8_LDA(At, 0, 0); PG8_STAGE(PG8_SA(1, 1), a1 + hstep, voffA);
            PG8_WAIT_L(8); PG8_BAR; PG8_WAIT_L(0); PG8_MMA(0, 0, At, B0); PG8_BAR; PG8_SCHED;
            PG8_LDB(B1, 0, 1); PG8_STAGE(PG8_SB(0, 0), b2, voffB);
            PG8_BAR; PG8_WAIT_L(0); PG8_MMA(0, 1, At, B1); PG8_BAR;
            PG8_LDA(At, 0, 1); PG8_STAGE(PG8_SA(0, 0), a2, voffA);
            PG8_BAR; PG8_WAIT_L(0); PG8_MMA(1, 0, At, B0); PG8_BAR; PG8_SCHED;
            PG8_STAGE(PG8_SB(0, 1), b2 + hstep, voffB);
            PG8_WAIT_V(6); PG8_BAR; PG8_MMA(1, 1, At, B1); PG8_BAR;
            PG8_LDB(B0, 1, 0); PG8_SCHED; PG8_LDA(At, 1, 0); PG8_STAGE(PG8_SA(0, 1), a2 + hstep, voffA);
            PG8_WAIT_L(8); PG8_BAR; PG8_WAIT_L(0); PG8_MMA(0, 0, At, B0); PG8_BAR; PG8_SCHED;
            PG8_LDB(B1, 1, 1); PG8_STAGE(PG8_SB(1, 0), b3, voffB);
            PG8_BAR; PG8_WAIT_L(0); PG8_MMA(0, 1, At, B1); PG8_BAR;
            PG8_LDA(At, 1, 1); PG8_STAGE(PG8_SA(1, 0), a3, voffA);
            PG8_BAR; PG8_WAIT_L(0); PG8_MMA(1, 0, At, B0); PG8_BAR; PG8_SCHED;
            PG8_STAGE(PG8_SB(1, 1), b3 + hstep, voffB);
            PG8_WAIT_V(6); PG8_BAR; PG8_MMA(1, 1, At, B1); PG8_BAR;
            }
        }
        if constexpr (ALIGN_EPI) { if (wr == 0) PG8_BAR; }
        if constexpr (!Epi::AFTER_DRAIN) { E(acc, cur, wr, wc, fr, fq); S.done(cur); }
        if (!has_next) break;
#pragma unroll
        for (int a = 0; a < 2; ++a)
#pragma unroll
            for (int b = 0; b < 2; ++b)
#pragma unroll
                for (int m = 0; m < 4; ++m)
#pragma unroll
                    for (int n = 0; n < 2; ++n) acc[a][b][m][n] = (f32x4){0.f, 0.f, 0.f, 0.f};
        cur = nxt; cA = nA; cB = nB; ++ui;
        if constexpr (ALIGN_EPI) { if (wr == 1) PG8_BAR; }
    }
    PG8_WAIT_V(0);
    if constexpr (!ALIGN_EPI) { if (wr == 0) PG8_BAR; }
    PG8_BAR;
    if constexpr (Epi::AFTER_DRAIN) { E.fused(acc, cur, wr, wc, fr, fq, lds, wid, lane); S.done(cur); }
#undef PG8_SA
#undef PG8_SB
#undef PG8_STAGE
#undef PG8_LDA
#undef PG8_LDB
#undef PG8_MMA
#undef PG8_WAIT_V
#undef PG8_WAIT_L
#undef PG8_BAR
#undef PG8_SCHED
}
}
namespace pg9 {
using pg8::bf16x8; using pg8::f32x4; using pg8::u32x4; using pg8::lds_byte; using pg8::stage_rc; using pg8::perm32;
constexpr int BK = 64, HALF = 128, HTB = HALF * BK * 2;
struct Unit { int pm, pn, aux, cnt; };
template <class Epi, class Sched, bool GATHER>
__device__ __forceinline__ void gemm_phase(PG8_LAS unsigned char* lds, const int K, const int lda, const int ldb, const Sched& S, const Epi& E) {
    const int tid = threadIdx.x, wid = __builtin_amdgcn_readfirstlane(tid >> 6), lane = tid & 63, wr = wid >> 2, wc = wid & 3, fr = lane & 15, fq = lane >> 4;
    const int nt = K / BK;
    unsigned offA[2][2], offAn[2][2], offB[2][2]; int RA[2], CA[2];
#pragma unroll
    for (int i = 0; i < 2; ++i) { int R, C; stage_rc(tid * 16 + i * 8192, R, C); const int Rb = Epi::PERM ? ((R & ~31) + perm32(R & 31)) : R; RA[i] = R; CA[i] = C * 2;
#pragma unroll
        for (int h = 0; h < 2; ++h) { offB[h][i] = (unsigned)((Rb + 128 * h) * ldb + C) * 2u; offA[h][i] = (unsigned)((R + 128 * h) * lda + C) * 2u; offAn[h][i] = offA[h][i]; } }
    const size_t kstep = (size_t)(BK * 2);
    const unsigned ldsw = (unsigned)wid * 1024u;
    const int aoff = lds_byte(wr * 64 + fr, fq * 8), boff = lds_byte(wc * 32 + fr, fq * 8);
#define PG9_SA(b, h) (((b) * 2 + (h)) * HTB)
#define PG9_SB(b, h) ((4 + (b) * 2 + (h)) * HTB)
#define PG9_STAGE(bufoff, gbase, voff) do { _Pragma("unroll") for (int _i = 0; _i < 2; ++_i) \
        __builtin_amdgcn_global_load_lds((const unsigned*)((const char*)(gbase) + (voff)[_i]), (PG8_LAS unsigned*)(lds + (bufoff) + ldsw + _i * 8192), 16, 0, 0); } while (0)
#define PG9_LDA(dst, b, h) do { _Pragma("unroll") for (int m = 0; m < 4; ++m) _Pragma("unroll") for (int k = 0; k < 2; ++k) dst[m][k] = *(const PG8_LAS bf16x8*)(lds + PG9_SA(b, h) + aoff + m * 2048 + k * 1024); } while (0)
#define PG9_LDB(dst, b, h) do { _Pragma("unroll") for (int n = 0; n < 2; ++n) _Pragma("unroll") for (int k = 0; k < 2; ++k) dst[n][k] = *(const PG8_LAS bf16x8*)(lds + PG9_SB(b, h) + boff + n * 2048 + k * 1024); } while (0)
#define PG9_MMA(ai, bj, At, Bt) do { __builtin_amdgcn_s_setprio(1); _Pragma("unroll") for (int m = 0; m < 4; ++m) _Pragma("unroll") for (int n = 0; n < 2; ++n) _Pragma("unroll") for (int k = 0; k < 2; ++k) \
        acc[ai][bj][m][n] = __builtin_amdgcn_mfma_f32_16x16x32_bf16(Bt[n][k], At[m][k], acc[ai][bj][m][n], 0, 0, 0); __builtin_amdgcn_s_setprio(0); } while (0)
#define PG9_WAIT_V(n) asm volatile("s_waitcnt vmcnt(" #n ")" ::: "memory")
#define PG9_WAIT_L(n) asm volatile("s_waitcnt lgkmcnt(" #n ")" ::: "memory")
#define PG9_BAR __builtin_amdgcn_s_barrier()
#define PG9_SCHED __builtin_amdgcn_sched_barrier(0)
    Unit cur, nxt; int ui = 0;
    if (!S.next(0, cur)) return;
    f32x4 acc[2][2][4][2];
#pragma unroll
    for (int a = 0; a < 2; ++a)
#pragma unroll
        for (int b = 0; b < 2; ++b)
#pragma unroll
            for (int m = 0; m < 4; ++m)
#pragma unroll
                for (int n = 0; n < 2; ++n) acc[a][b][m][n] = (f32x4){0.f, 0.f, 0.f, 0.f};
    bf16x8 At[4][2], B0[2][2], B1[2][2];
    const char* cA = S.a_base(cur); const char* cB = S.b_base(cur);
    if constexpr (GATHER) {
#pragma unroll
        for (int h = 0; h < 2; ++h)
#pragma unroll
            for (int i = 0; i < 2; ++i) offA[h][i] = S.a_row_off(cur, RA[i] + 128 * h) + (unsigned)CA[i];
    }
    PG9_STAGE(PG9_SB(0, 0), cB, offB[0]); PG9_STAGE(PG9_SB(0, 1), cB, offB[1]); PG9_STAGE(PG9_SA(0, 0), cA, offA[0]); PG9_STAGE(PG9_SA(0, 1), cA, offA[1]);
    if (wr == 1) PG9_BAR;
    PG9_WAIT_V(2); PG9_BAR;
    PG9_STAGE(PG9_SB(1, 0), cB + kstep, offB[0]); PG9_STAGE(PG9_SA(1, 0), cA + kstep, offA[0]); PG9_STAGE(PG9_SB(1, 1), cB + kstep, offB[1]);
    PG9_WAIT_V(6); PG9_BAR;
    for (;;) {
        const bool has_next = S.next(ui + 1, nxt);
        const char* nA = has_next ? S.a_base(nxt) : cA; const char* nB = has_next ? S.b_base(nxt) : cB;
        if constexpr (GATHER) {
#pragma unroll
            for (int h = 0; h < 2; ++h)
#pragma unroll
                for (int i = 0; i < 2; ++i) offAn[h][i] = has_next ? (S.a_row_off(nxt, RA[i] + 128 * h) + (unsigned)CA[i]) : offA[h][i];
        }
        for (int t = 0; t < nt; t += 2) {
            const bool last = (t == nt - 2);
            const char* a1 = cA + (size_t)(t + 1) * kstep;
            const char* a2 = last ? nA : cA + (size_t)(t + 2) * kstep; const char* b2 = last ? nB : cB + (size_t)(t + 2) * kstep;
            const char* a3 = a2 + kstep; const char* b3 = b2 + kstep;
            unsigned oA2[2][2];
#pragma unroll
            for (int h = 0; h < 2; ++h)
#pragma unroll
                for (int i = 0; i < 2; ++i) oA2[h][i] = (GATHER && last) ? offAn[h][i] : offA[h][i];
            PG9_LDB(B0, 0, 0); PG9_LDB(B1, 0, 1); PG9_SCHED; PG9_LDA(At, 0, 0); PG9_STAGE(PG9_SA(1, 1), a1, offA[1]);
            PG9_WAIT_V(8); PG9_WAIT_L(0); PG9_BAR; PG9_MMA(0, 0, At, B0); PG9_MMA(0, 1, At, B1); PG9_BAR; PG9_SCHED;
            PG9_LDA(At, 0, 1); PG9_STAGE(PG9_SB(0, 0), b2, offB[0]); PG9_STAGE(PG9_SB(0, 1), b2, offB[1]); PG9_STAGE(PG9_SA(0, 0), a2, oA2[0]);
            PG9_WAIT_V(8); PG9_WAIT_L(0); PG9_BAR; PG9_MMA(1, 0, At, B0); PG9_MMA(1, 1, At, B1); PG9_BAR; PG9_SCHED;
            PG9_LDB(B0, 1, 0); PG9_LDB(B1, 1, 1); PG9_SCHED; PG9_LDA(At, 1, 0); PG9_STAGE(PG9_SA(0, 1), a2, oA2[1]);
            PG9_WAIT_V(8); PG9_WAIT_L(0); PG9_BAR; PG9_MMA(0, 0, At, B0); PG9_MMA(0, 1, At, B1); PG9_BAR; PG9_SCHED;
            PG9_LDA(At, 1, 1); PG9_STAGE(PG9_SB(1, 0), b3, offB[0]); PG9_STAGE(PG9_SB(1, 1), b3, offB[1]); PG9_STAGE(PG9_SA(1, 0), a3, oA2[0]);
            PG9_WAIT_V(8); PG9_WAIT_L(0); PG9_BAR; PG9_MMA(1, 0, At, B0); PG9_MMA(1, 1, At, B1); PG9_BAR; PG9_SCHED;
        }
        if (wr == 0) PG9_BAR;
        bool keep = false;
        if constexpr (Epi::CHAIN) keep = E.chain_more(cur);
        if (keep) { if constexpr (Epi::CHAIN) E.rescale(acc, cur, wr, wc, fr, fq); }
        else E(acc, cur, wr, wc, fr, fq);
        if (!has_next) break;
        if (!keep) {
#pragma unroll
            for (int a = 0; a < 2; ++a)
#pragma unroll
                for (int b = 0; b < 2; ++b)
#pragma unroll
                    for (int m = 0; m < 4; ++m)
#pragma unroll
                        for (int n = 0; n < 2; ++n) acc[a][b][m][n] = (f32x4){0.f, 0.f, 0.f, 0.f};
        }
        cur = nxt; cA = nA; cB = nB; ++ui;
        if constexpr (GATHER) {
#pragma unroll
            for (int h = 0; h < 2; ++h)
#pragma unroll
                for (int i = 0; i < 2; ++i) offA[h][i] = offAn[h][i];
        }
        if (wr == 1) PG9_BAR;
    }
    PG9_WAIT_V(0);
    PG9_BAR;
#undef PG9_SA
#undef PG9_SB
#undef PG9_STAGE
#undef PG9_LDA
#undef PG9_LDB
#undef PG9_MMA
#undef PG9_WAIT_V
#undef PG9_WAIT_L
#undef PG9_BAR
#undef PG9_SCHED
}
}
#define GAS __attribute__((address_space(1)))
#define LAS __attribute__((address_space(3)))
typedef unsigned short bf16;
typedef unsigned v4u __attribute__((ext_vector_type(4)));
typedef float f32x4 __attribute__((ext_vector_type(4)));
typedef short bf16x8 __attribute__((ext_vector_type(8)));
typedef GAS unsigned gu32;
typedef GAS unsigned long long gu64;
#define RLX_AGENT __ATOMIC_RELAXED, __HIP_MEMORY_SCOPE_AGENT
#define LDS_WAIT() asm volatile("s_waitcnt lgkmcnt(0)" ::: "memory")
#define VM_WAIT() asm volatile("s_waitcnt vmcnt(0)" ::: "memory")
__device__ __forceinline__ unsigned long long rt() { return __builtin_amdgcn_s_memrealtime(); }
__device__ __forceinline__ unsigned f2bfu(float f) { unsigned u = __builtin_bit_cast(unsigned, f); return (u + 0x7fffu + ((u >> 16) & 1u)) >> 16; }
__device__ __forceinline__ unsigned pk2(float lo, float hi) { return f2bfu(lo) | (f2bfu(hi) << 16); }
#define XB_TMO      128
#define XB_XCNT(j)  (256  + 64 * (j))
#define XB_XSUB(j)  (1280 + 64 * (j))
#define XB_XGEN(j)  (2304 + 64 * (j))
#define XB_TOP      3328
#define XB_TOPGEN   3392
#define XCD_BAR_WORDS 3456
#define XB_SPIN_CAP (1u << 18)

__device__ __forceinline__ unsigned xb_ld(unsigned* p)              { return __hip_atomic_load(p, __ATOMIC_RELAXED, __HIP_MEMORY_SCOPE_AGENT); }
__device__ __forceinline__ unsigned xb_add(unsigned* p, unsigned v) { return __hip_atomic_fetch_add(p, v, __ATOMIC_RELAXED, __HIP_MEMORY_SCOPE_AGENT); }
__device__ __forceinline__ unsigned xb_xcc_id() { return (unsigned)__builtin_amdgcn_s_getreg((3 << 11) | 20) & 0xFu; }
#define XB_SPIN(cond, bar) do { unsigned _sp = 0; while (cond) { __builtin_amdgcn_s_sleep(1); \
    if ((++_sp & 255u) == 0u) { if (xb_ld(&(bar)[XB_TMO])) break; if (_sp > XB_SPIN_CAP) { atomicAdd(&(bar)[XB_TMO], 1u); break; } } } } while (0)

struct XcdBarrier {
    unsigned* bar; unsigned x;
    volatile LAS unsigned* st;
};

__device__ __forceinline__ XcdBarrier xcd_barrier_post(unsigned* bar, volatile LAS unsigned* st) {
    XcdBarrier b; b.bar = bar; b.x = xb_xcc_id(); b.st = st;
    if (threadIdx.x == 0) (void)xb_add(&bar[XB_XCNT(b.x)], 1u);
    return b;
}
__device__ __forceinline__ void xcd_barrier_complete(unsigned* bar, unsigned x, unsigned& nloc, unsigned& nx) {
    const unsigned G = gridDim.x * gridDim.y * gridDim.z;
    unsigned sum, cnt, mine, sp = 0u;
    for (;;) {
        sum = 0u; cnt = 0u; mine = 0u;
#pragma unroll
        for (unsigned j = 0; j < 16; ++j) { const unsigned c = xb_ld(&bar[XB_XCNT(j)]); sum += c; cnt += (c > 0u) ? 1u : 0u; mine = (j == x) ? c : mine; }
        if (sum == G) break;
        __builtin_amdgcn_s_sleep(1);
        if ((++sp & 255u) == 0u) { if (xb_ld(&bar[XB_TMO])) break; if (sp > XB_SPIN_CAP) { atomicAdd(&bar[XB_TMO], 1u); break; } }
    }
    nloc = mine > 0u ? mine : 1u; nx = cnt > 0u ? cnt : 1u;
}

__device__ __forceinline__ void xcd_barrier(const XcdBarrier& b) {
    asm volatile("s_waitcnt vmcnt(0)" ::: "memory");
    __syncthreads();
    if (threadIdx.x == 0) {
        unsigned* bar = b.bar;
        __builtin_amdgcn_s_waitcnt(0);
        unsigned nloc = b.st[0], nx = b.st[1];
        if (nloc == 0u) { xcd_barrier_complete(bar, b.x, nloc, nx); b.st[0] = nloc; b.st[1] = nx; }
        const unsigned old = xb_add(&bar[XB_XSUB(b.x)], 1u);
        const unsigned gen = old / nloc;
        if (old + 1u == (gen + 1u) * nloc) {
            __builtin_amdgcn_fence(__ATOMIC_RELEASE, "agent");
            asm volatile("s_waitcnt vmcnt(0)" ::: "memory");
            const unsigned og = xb_add(&bar[XB_TOP], 1u);
            const unsigned tg = og / nx;
            if (og + 1u == (tg + 1u) * nx) xb_add(&bar[XB_TOPGEN], 1u);
            else XB_SPIN(xb_ld(&bar[XB_TOPGEN]) == tg, bar);
            __builtin_amdgcn_fence(__ATOMIC_ACQUIRE, "agent");
            xb_add(&bar[XB_XGEN(b.x)], 1u);
            asm volatile("s_waitcnt vmcnt(0)" ::: "memory");
        } else {
            XB_SPIN(xb_ld(&bar[XB_XGEN(b.x)]) == gen, bar);
            __builtin_amdgcn_fence(__ATOMIC_ACQUIRE, "agent");
            asm volatile("s_waitcnt vmcnt(0)" ::: "memory");
        }
    }
    __syncthreads();
}
constexpr int NWAVES = 8;
constexpr int RING_OFF = 0, RING_BYTES = 131072;
constexpr int LDSCTL_OFF = RING_BYTES, MISC_OFF = LDSCTL_OFF + 320;
constexpr int LDS_BYTES = 147456;
constexpr int CW_BAR = 4096;
constexpr int CW_KMEAN = 32768;
constexpr int CW_MEMKSS = 65536;
static_assert((CW_MEMKSS + 4096) * 4 <= (int)MiB && CW_BAR + 4 * 3456 <= CW_KMEAN, "ctl map");

struct Frame {
    LAS unsigned char* lds; volatile LAS unsigned* MISC; gu32* ctl;
    int tid, lane, wave, vcu, G;
    unsigned char* ws; float* out;
};
__device__ __forceinline__ float wave_sum64(float v) {
#pragma unroll
    for (int o = 1; o < 64; o <<= 1) v += __shfl_xor(v, o);
    return v;
}
template <bool HEADPERM> __device__ __forceinline__ void p0_transpose_item(const float* W, int K, int N, bf16* WT, int row_off, LAS float* scr, int item, int lane) {
    const int nblk = N / 32, kb = item / nblk, nb = item % nblk, k0 = 64 * kb, n0 = 32 * nb;
    int p0 = n0; if (HEADPERM) { const int lg = (n0 >> 5) & 7; p0 = (n0 & ~255) + 32 * (4 * (lg & 1) + (lg >> 1)); }
#pragma unroll 8
    for (int i = 0; i < 32; ++i) { const int kk = 2 * i + (lane >> 5); scr[kk * 33 + (lane & 31)] = W[(size_t)(k0 + kk) * N + n0 + (lane & 31)]; }
    LDS_WAIT(); asm volatile("" ::: "memory");
    const int c = lane & 7;
#pragma unroll
    for (int j = 0; j < 4; ++j) { const int n = (lane >> 3) + 8 * j; const LAS float* s = scr + (8 * c) * 33 + n;
        v4u o; o.x = pk2(s[0 * 33], s[1 * 33]); o.y = pk2(s[2 * 33], s[3 * 33]); o.z = pk2(s[4 * 33], s[5 * 33]); o.w = pk2(s[6 * 33], s[7 * 33]);
        *(GAS v4u*)(WT + (size_t)(row_off + p0 + n) * K + k0 + 8 * c) = o; }
    LDS_WAIT(); asm volatile("" ::: "memory");
}
__device__ __forceinline__ void rms_row_to_bf16(int lane, const float* xrow, const float* g, bf16* orow) {
    const GAS f32x4* xr = (const GAS f32x4*)xrow + lane; const GAS f32x4* gr = (const GAS f32x4*)g + lane;
    f32x4 v[4]; float s = 0.f;
#pragma unroll
    for (int j = 0; j < 4; ++j) { v[j] = xr[64 * j]; s += (v[j].x * v[j].x + v[j].y * v[j].y) + (v[j].z * v[j].z + v[j].w * v[j].w); }
    const float r = 1.f / sqrtf(wave_sum64(s) * (1.f / 1024.f) + 1e-5f);
    GAS unsigned long long* o8 = (GAS unsigned long long*)orow + lane;
#pragma unroll
    for (int j = 0; j < 4; ++j) { const f32x4 gg = gr[64 * j]; o8[64 * j] = (unsigned long long)pk2(v[j].x * r * gg.x, v[j].y * r * gg.y) | ((unsigned long long)pk2(v[j].z * r * gg.z, v[j].w * r * gg.w) << 32); }
}
struct Args { const float* in[23]; float* out; unsigned char* ws; int ph_lo, ph_hi, li, pad; };
__device__ __forceinline__ void p0_prologue(Frame& F, const Args& A) {
    LAS float* scr = (LAS float*)(F.lds + RING_OFF + F.wave * 16384);
    const int gw = F.vcu * NWAVES + F.wave, NGW = F.G * NWAVES;
    constexpr int I_IN = 16 * (DIN / 32), I_MKV = 16 * 32, I_BR = 8 * 32, I_OUT = 16 * 32, I_W1 = 16 * 64, I_W2 = 16 * 32;
    constexpr int NITEMS = I_IN + I_MKV + 3 * I_BR + I_OUT + NEXP * (I_W1 + I_W2);
    for (int it = gw; it < NITEMS; it += NGW) {
        int r = it;
        if (r < I_IN) { p0_transpose_item<true>(A.in[3], 1024, DIN, (bf16*)(F.ws + WS_WIN), 0, scr, r, F.lane); continue; } r -= I_IN;
        if (r < I_MKV) { p0_transpose_item<true>(A.in[9], 1024, 1024, (bf16*)(F.ws + WS_WMEMKV), 0, scr, r, F.lane); continue; } r -= I_MKV;
        if (r < 3 * I_BR) { const int w = r / I_BR; p0_transpose_item<false>(w == 0 ? A.in[12] : (w == 1 ? A.in[13] : A.in[14]), 512, 1024, (bf16*)(F.ws + WS_WBR) + (size_t)w * 1024 * 512, 0, scr, r % I_BR, F.lane); continue; } r -= 3 * I_BR;
        if (r < I_OUT) { p0_transpose_item<false>(A.in[15], 1024, 1024, (bf16*)(F.ws + WS_WOUT), 0, scr, r, F.lane); continue; } r -= I_OUT;
        if (r < NEXP * I_W1) { const int e = r / I_W1; p0_transpose_item<false>(A.in[19] + (size_t)e * 1024 * 2048, 1024, 2048, (bf16*)(F.ws + WS_W1) + (size_t)e * 2048 * 1024, 0, scr, r % I_W1, F.lane); continue; } r -= NEXP * I_W1;
        { const int e = r / I_W2; p0_transpose_item<false>(A.in[21] + (size_t)e * 1024 * 1024, 1024, 1024, (bf16*)(F.ws + WS_W2) + (size_t)e * 1024 * 1024, 0, scr, r % I_W2, F.lane); }
    }
    if (gw == 0) { ((float*)(F.ws + WS_GTAB))[F.lane] = A.in[6][F.lane]; ((float*)(F.ws + WS_GTAB))[64 + F.lane] = A.in[7][F.lane]; }
    for (int m = gw; m < NTOK; m += NGW) rms_row_to_bf16(F.lane, A.in[0] + (size_t)m * DM, A.in[2], (bf16*)(F.ws + WS_HB) + (size_t)m * DM);
    for (int m = gw; m < NB * MEMLEN; m += NGW) rms_row_to_bf16(F.lane, A.in[1] + (size_t)m * DM, A.in[8], (bf16*)(F.ws + WS_HM) + (size_t)m * DM);
}

struct P1Order {
    pg8::StaticOrder so; int G, c;
    __device__ void init(int G_, int c_) { so.init(NTOK, DIN, G_, 0); G = G_; c = c_; }
    __device__ bool next(int i, pg8::Unit& u) const {
        long L = (long)i * G + c;
        if (L < 1664) { pg8::StaticOrder t = so; t.G = 1; t.c = 0; return t.next((int)L, u); }
        L -= 1664; if (L >= 16) return false;
        u.pm = 64 + (int)(L >> 2); u.pn = 26 + (int)(L & 3); return true;
    }
    __device__ __forceinline__ void a_ready(const pg8::Unit&) const {}
    __device__ __forceinline__ void done(const pg8::Unit&) const {}
};
__device__ __forceinline__ float sigmoid_f(float x) { return __builtin_amdgcn_rcpf(1.f + __expf(-x)); }
typedef float f32x2_t __attribute__((ext_vector_type(2))); typedef __bf16 bf16x2_t __attribute__((ext_vector_type(2)));
__device__ __forceinline__ unsigned cvt_pk_bf16(float lo, float hi) { f32x2_t v = {lo, hi}; bf16x2_t b = __builtin_convertvector(v, bf16x2_t); return __builtin_bit_cast(unsigned, b); }
struct EpiP1 {
    static constexpr bool PERM = true, AFTER_DRAIN = false;
    unsigned char* ws; const float* b_gate; const float* gtab; float* KMEAN; float* MEMKSS;
    __device__ __forceinline__ void operator()(const pg8::f32x4 (&acc)[2][2][4][2], const pg8::Unit& u, int wr, int wc, int fr, int fq) const {
        using pg8::f32x4; using pg8::u32x4;
        const int pn = u.pn; int type, ldc, cb; size_t off; int row0 = u.pm * 256;
        if (pn == 0) { type = 0; off = WS_RQ; ldc = 256; cb = 0; }
        else if (pn == 1) { type = 1; off = WS_RK; ldc = 256; cb = 0; }
        else if (pn < 4) { type = 0; off = WS_RV; ldc = 512; cb = (pn - 2) * 256; }
        else if (pn < 6) { type = 2; off = WS_RG; ldc = 512; cb = (pn - 4) * 256; }
        else if (pn < 8) { type = 3; off = WS_MQ; ldc = 512; cb = (pn - 6) * 256; }
        else if (pn < 10) { type = 4; off = WS_MK; ldc = 512; cb = (pn - 8) * 256; }
        else if (pn < 12) { type = 0; off = WS_MV; ldc = 512; cb = (pn - 10) * 256; }
        else if (pn < 14) { type = 0; off = WS_CQ; ldc = 512; cb = (pn - 12) * 256; }
        else if (pn < 26) { type = 5; off = WS_GT; ldc = 3072; cb = (pn - 14) * 256; }
        else if (pn < 28) { type = 6; off = WS_MEMK; ldc = 512; cb = (pn - 26) * 256; row0 = (u.pm - 64) * 256; }
        else { type = 0; off = WS_MEMV; ldc = 512; cb = (pn - 28) * 256; row0 = (u.pm - 64) * 256; }
        bf16_t* base = (bf16_t*)(ws + off) + cb + 64 * wc + 8 * fq;
        const int rbase = row0 + 64 * wr + fr;
#define P1_STORE(rowp, bj, v0, v1) do { u32x4 w_; w_.x = cvt_pk_bf16((v0)[0], (v0)[1]); w_.y = cvt_pk_bf16((v0)[2], (v0)[3]); w_.z = cvt_pk_bf16((v1)[0], (v1)[1]); w_.w = cvt_pk_bf16((v1)[2], (v1)[3]); *(u32x4*)((rowp) + 32 * (bj)) = w_; } while (0)
        if (type <= 1) {
            const float sc = type == 1 ? 0.125f : 1.f;
#pragma unroll
            for (int ai = 0; ai < 2; ++ai)
#pragma unroll
                for (int m = 0; m < 4; ++m) { bf16_t* rowp = base + (size_t)(rbase + 128 * ai + 16 * m) * ldc;
#pragma unroll
                    for (int bj = 0; bj < 2; ++bj) { const f32x4 v0 = acc[ai][bj][m][0] * sc, v1 = acc[ai][bj][m][1] * sc; P1_STORE(rowp, bj, v0, v1); } }
        } else if (type == 2) {
#pragma unroll
            for (int ai = 0; ai < 2; ++ai)
#pragma unroll
                for (int m = 0; m < 4; ++m) { bf16_t* rowp = base + (size_t)(rbase + 128 * ai + 16 * m) * ldc;
#pragma unroll
                    for (int bj = 0; bj < 2; ++bj) { f32x4 v0 = acc[ai][bj][m][0], v1 = acc[ai][bj][m][1];
#pragma unroll
                        for (int j = 0; j < 4; ++j) { v0[j] = v0[j] * sigmoid_f(v0[j]); v1[j] = v1[j] * sigmoid_f(v1[j]); }
                        P1_STORE(rowp, bj, v0, v1); } }
        } else if (type == 5) {
            f32x4 bv[2][2];
#pragma unroll
            for (int bj = 0; bj < 2; ++bj)
#pragma unroll
                for (int n = 0; n < 2; ++n) bv[bj][n] = *(const f32x4*)(b_gate + cb + 64 * wc + 32 * bj + 8 * fq + 4 * n);
#pragma unroll
            for (int ai = 0; ai < 2; ++ai)
#pragma unroll
                for (int m = 0; m < 4; ++m) { bf16_t* rowp = base + (size_t)(rbase + 128 * ai + 16 * m) * ldc;
#pragma unroll
                    for (int bj = 0; bj < 2; ++bj) { f32x4 v0 = acc[ai][bj][m][0] + bv[bj][0], v1 = acc[ai][bj][m][1] + bv[bj][1];
#pragma unroll
                        for (int j = 0; j < 4; ++j) { v0[j] = sigmoid_f(v0[j]); v1[j] = sigmoid_f(v1[j]); }
                        P1_STORE(rowp, bj, v0, v1); } }
        } else if (type == 6) {
#pragma unroll
            for (int ai = 0; ai < 2; ++ai)
#pragma unroll
                for (int m = 0; m < 4; ++m) { const int row = rbase + 128 * ai + 16 * m; bf16_t* rowp = base + (size_t)row * ldc; float ss = 0.f;
#pragma unroll
                    for (int bj = 0; bj < 2; ++bj) { const f32x4 v0 = acc[ai][bj][m][0], v1 = acc[ai][bj][m][1];
                        ss += (v0[0] * v0[0] + v0[1] * v0[1]) + (v0[2] * v0[2] + v0[3] * v0[3]) + (v1[0] * v1[0] + v1[1] * v1[1]) + (v1[2] * v1[2] + v1[3] * v1[3]);
                        P1_STORE(rowp, bj, v0, v1); }
                    ss += __shfl_xor(ss, 16); ss += __shfl_xor(ss, 32);
                    if (fq == 0) atomicAdd(MEMKSS + (size_t)row * 4 + (cb >> 7) + (wc >> 1), ss);
                    }
        } else {
            const float* g = gtab + (type == 3 ? 0 : 64);
            f32x4 gv[2][2]; float rr[2][4];
#pragma unroll
            for (int bj = 0; bj < 2; ++bj)
#pragma unroll
                for (int n = 0; n < 2; ++n) gv[bj][n] = *(const f32x4*)(g + 32 * bj + 8 * fq + 4 * n);
#pragma unroll
            for (int ai = 0; ai < 2; ++ai)
#pragma unroll
                for (int m = 0; m < 4; ++m) { bf16_t* rowp = base + (size_t)(rbase + 128 * ai + 16 * m) * ldc; float ss = 0.f;
#pragma unroll
                    for (int bj = 0; bj < 2; ++bj) { const f32x4 v0 = acc[ai][bj][m][0], v1 = acc[ai][bj][m][1];
                        ss += (v0[0] * v0[0] + v0[1] * v0[1]) + (v0[2] * v0[2] + v0[3] * v0[3]) + (v1[0] * v1[0] + v1[1] * v1[1]) + (v1[2] * v1[2] + v1[3] * v1[3]); }
                    ss += __shfl_xor(ss, 16); ss += __shfl_xor(ss, 32);
                    const float r = 1.f / sqrtf(ss * (1.f / 64.f) + 1e-5f); rr[ai][m] = r;
#pragma unroll
                    for (int bj = 0; bj < 2; ++bj) { const f32x4 v0 = acc[ai][bj][m][0] * r * gv[bj][0], v1 = acc[ai][bj][m][1] * r * gv[bj][1];
                        P1_STORE(rowp, bj, v0, v1); }
                    asm volatile("" ::: "memory"); }
            if (type == 4) {
                float* km = KMEAN + ((size_t)u.pm * 8 + (cb >> 6) + wc) * 64 + 8 * fq;
#pragma unroll
                for (int bj = 0; bj < 2; ++bj)
#pragma unroll
                    for (int n = 0; n < 2; ++n)
#pragma unroll
                        for (int j = 0; j < 4; ++j) { float s = 0.f;
#pragma unroll
                            for (int ai = 0; ai < 2; ++ai)
#pragma unroll
                                for (int m = 0; m < 4; ++m) s += acc[ai][bj][m][n][j] * rr[ai][m];
                            s += __shfl_xor(s, 1); s += __shfl_xor(s, 2); s += __shfl_xor(s, 4); s += __shfl_xor(s, 8);
                            if (fr == 0) atomicAdd(km + 32 * bj + 4 * n + j, s * gv[bj][n][j] * (1.f / 256.f)); }
            }
        }
#undef P1_STORE
    }
};

constexpr int TB_OFF = LDSCTL_OFF + 1024;
__device__ __forceinline__ unsigned cvt_pk(float lo, float hi) { return cvt_pk_bf16(lo, hi); }

struct P3Order {
    pg8::StaticOrder so; int G, c; const unsigned char* ws;
    __device__ void init(int G_, int c_, const unsigned char* ws_) { so.init(NTOK, 1024, 1, 0); G = G_; c = c_; ws = ws_; }
    __device__ bool next(int i, pg9::Unit& u) const {
        const int tl = (i / 3) * G + c; if (tl >= 256) return false; pg8::Unit t; so.next(tl, t); u.pm = t.pm; u.pn = t.pn; u.aux = i % 3; u.cnt = 256; return true; }
    __device__ __forceinline__ const char* a_base(const pg9::Unit& u) const { return (const char*)(ws + WS_ORET) + (size_t)u.aux * (WS_OMOBA - WS_ORET) + (size_t)u.pm * 256 * 512 * 2; }
    __device__ __forceinline__ const char* b_base(const pg9::Unit& u) const { return (const char*)(ws + WS_WBR) + (size_t)u.aux * 1024 * 512 * 2 + (size_t)u.pn * 256 * 512 * 2; }
};
struct EpiP3 {
    static constexpr bool PERM = true, CHAIN = true;
    const bf16_t* GT; bf16_t* Y;
    __device__ __forceinline__ bool chain_more(const pg9::Unit& u) const { return u.aux < 2; }
    __device__ __forceinline__ void rescale(pg8::f32x4 (&acc)[2][2][4][2], const pg9::Unit& u, int wr, int wc, int fr, int fq) const {
        const int s = u.aux;
#pragma unroll
        for (int ai = 0; ai < 2; ++ai)
#pragma unroll
            for (int m = 0; m < 4; ++m) { const bf16_t* gp = GT + (size_t)(u.pm * 256 + 128 * ai + 64 * wr + 16 * m + fr) * 3072 + s * 1024 + u.pn * 256 + 32 * wc + 8 * fq;
#pragma unroll
                for (int bj = 0; bj < 2; ++bj) { const pg8::u32x4 ga = *(const pg8::u32x4*)(gp + 128 * bj), gb = *(const pg8::u32x4*)(gp + 1024 + 128 * bj);
#pragma unroll
                    for (int n = 0; n < 2; ++n)
#pragma unroll
                        for (int j = 0; j < 4; ++j) { const int e = 4 * n + j; const unsigned wa = ga[e >> 1], wb = gb[e >> 1];
                            const float fa = __uint_as_float((e & 1) ? (wa & 0xffff0000u) : (wa << 16)), fb = __uint_as_float((e & 1) ? (wb & 0xffff0000u) : (wb << 16));
                            acc[ai][bj][m][n][j] *= fa * __builtin_amdgcn_rcpf(fmaxf(fb, 1e-20f)); } }
                asm volatile("" ::: "memory"); }
    }
    __device__ __forceinline__ void operator()(const pg8::f32x4 (&acc)[2][2][4][2], const pg9::Unit& u, int wr, int wc, int fr, int fq) const {
#pragma unroll
        for (int ai = 0; ai < 2; ++ai)
#pragma unroll
            for (int m = 0; m < 4; ++m) { const size_t row = (size_t)(u.pm * 256 + 128 * ai + 64 * wr + 16 * m + fr); const bf16_t* gp = GT + row * 3072 + 2048 + u.pn * 256 + 32 * wc + 8 * fq; bf16_t* yp = Y + row * 1024 + u.pn * 256 + 32 * wc + 8 * fq;
#pragma unroll
                for (int bj = 0; bj < 2; ++bj) { const pg8::u32x4 ga = *(const pg8::u32x4*)(gp + 128 * bj); float v[8];
#pragma unroll
                    for (int n = 0; n < 2; ++n)
#pragma unroll
                        for (int j = 0; j < 4; ++j) { const int e = 4 * n + j; const unsigned wa = ga[e >> 1]; v[e] = acc[ai][bj][m][n][j] * __uint_as_float((e & 1) ? (wa & 0xffff0000u) : (wa << 16)); }
                    pg8::u32x4 w; w.x = cvt_pk(v[0], v[1]); w.y = cvt_pk(v[2], v[3]); w.z = cvt_pk(v[4], v[5]); w.w = cvt_pk(v[6], v[7]); *(pg8::u32x4*)(yp + 128 * bj) = w; }
                asm volatile("" ::: "memory"); }
    }
};
struct P4Order {
    pg8::StaticOrder so; int G, c; const unsigned char* ws;
    __device__ void init(int G_, int c_, const unsigned char* ws_) { so.init(NTOK, 1024, 1, 0); G = G_; c = c_; ws = ws_; }
    __device__ bool next(int i, pg9::Unit& u) const { const int tl = i * G + c; if (tl >= 256) return false; pg8::Unit t; so.next(tl, t); u.pm = t.pm; u.pn = t.pn; u.aux = 0; u.cnt = 256; return true; }
    __device__ __forceinline__ const char* a_base(const pg9::Unit& u) const { return (const char*)(ws + WS_Y) + (size_t)u.pm * 256 * 1024 * 2; }
    __device__ __forceinline__ const char* b_base(const pg9::Unit& u) const { return (const char*)(ws + WS_WOUT) + (size_t)u.pn * 256 * 1024 * 2; }
};
struct EpiP4 {
    static constexpr bool PERM = false, CHAIN = false;
    const float* x; float* out;
    __device__ __forceinline__ void operator()(const pg8::f32x4 (&acc)[2][2][4][2], const pg9::Unit& u, int wr, int wc, int fr, int fq) const {
#pragma unroll
        for (int ai = 0; ai < 2; ++ai)
#pragma unroll
            for (int m = 0; m < 4; ++m) { const size_t off = (size_t)(u.pm * 256 + 128 * ai + 64 * wr + 16 * m + fr) * 1024 + u.pn * 256 + 32 * wc + 4 * fq;
#pragma unroll
                for (int bj = 0; bj < 2; ++bj)
#pragma unroll
                    for (int n = 0; n < 2; ++n) { const pg8::f32x4 xv = *(const pg8::f32x4*)(x + off + 128 * bj + 16 * n); *(pg8::f32x4*)(out + off + 128 * bj + 16 * n) = xv + acc[ai][bj][m][n]; }
                if (m & 1) asm volatile("" ::: "memory"); }
    }
};
__device__ __forceinline__ float wave_max64(float v) {
#pragma unroll
    for (int o = 1; o < 64; o <<= 1) v = fmaxf(v, __shfl_xor(v, o));
    return v;
}
__device__ __forceinline__ void p5_router(Frame& F, const float* X1, const float* g_ffn, const float* w_router, const float* b_router) {
    bf16_t* XT = (bf16_t*)(F.ws + WS_XT); int* TOPE = (int*)(F.ws + WS_TOPE); float* TOPW = (float*)(F.ws + WS_TOPW); int* COUNTS = (int*)F.ctl + CW_COUNTS; int* LISTS = (int*)(F.ws + WS_LISTS);
    const int gw = F.vcu * NWAVES + F.wave, NGW = F.G * NWAVES, lane = F.lane;
    for (int t = gw; t < NTOK; t += NGW) {
        const float* xr = X1 + (size_t)t * 1024; float v[16]; float s = 0.f;
#pragma unroll
        for (int j = 0; j < 16; ++j) { v[j] = xr[lane + 64 * j]; s += v[j] * v[j]; }
        const float r = 1.f / sqrtf(wave_sum64(s) * (1.f / 1024.f) + 1e-5f);
#pragma unroll
        for (int j = 0; j < 16; ++j) { v[j] = v[j] * r * g_ffn[lane + 64 * j]; XT[(size_t)t * 1024 + lane + 64 * j] = f2bf(v[j]); }
        float lg = -INFINITY;
        for (int e = 0; e < 32; ++e) { float p = 0.f;
#pragma unroll
            for (int j = 0; j < 16; ++j) p += v[j] * w_router[(size_t)(lane + 64 * j) * 32 + e];
            p = wave_sum64(p); if (lane == e) lg = p + b_router[e]; }
        float tv[4]; int te[4];
#pragma unroll
        for (int k = 0; k < 4; ++k) { const float m = wave_max64(lg); const unsigned long long bal = __ballot(lg == m); const int e = __ffsll((long long)bal) - 1; tv[k] = m; te[k] = e; if (lane == e) lg = -INFINITY; }
        float ex[4], se = 0.f;
#pragma unroll
        for (int k = 0; k < 4; ++k) { ex[k] = __expf(tv[k] - tv[0]); se += ex[k]; }
        int e_l = te[0]; float w_l = ex[0];
#pragma unroll
        for (int k = 1; k < 4; ++k) if (lane == k) { e_l = te[k]; w_l = ex[k]; }
        if (lane < 4) { TOPE[t * 4 + lane] = e_l; TOPW[t * 4 + lane] = w_l / se; const int pos = atomicAdd(&COUNTS[e_l], 1); LISTS[(size_t)e_l * 16384 + pos] = t * 4 + lane; }
    }
}
__device__ __forceinline__ void moe_tables(Frame& F) {
    volatile LAS int* TB = (volatile LAS int*)(F.lds + TB_OFF);
    if (F.tid == 0) { const int* COUNTS = (const int*)F.ctl + CW_COUNTS; int acc = 0; for (int e = 0; e < 32; ++e) { const int c = __hip_atomic_load(COUNTS + e, __ATOMIC_RELAXED, __HIP_MEMORY_SCOPE_AGENT); TB[e] = acc; TB[33 + e] = c; acc += (c + 255) >> 8; } TB[32] = acc; }
    __syncthreads();
}
template <int NPN_LOG2, size_t WOFF, int NROWS_B, int ASHIFT, size_t AOFF> struct MoeOrder {
    int G, c; const unsigned char* ws; const LAS int* TB; const int* LISTS;
    __device__ void init(int G_, int c_, const unsigned char* ws_, const LAS int* TB_) { G = G_; c = c_; ws = ws_; TB = TB_; LISTS = (const int*)(ws_ + WS_LISTS); }
    __device__ bool next(int i, pg9::Unit& u) const {
        const int L = i * G + c; const int mt = L >> NPN_LOG2; if (mt >= TB[32]) return false;
        int e = 0;
#pragma unroll 1
        for (int k = 16; k >= 1; k >>= 1) if (TB[e + k] <= mt) e += k;
        u.aux = e; u.pm = mt - TB[e]; u.pn = L & ((1 << NPN_LOG2) - 1); u.cnt = TB[33 + e] - u.pm * 256; return true;
    }
    __device__ __forceinline__ const char* a_base(const pg9::Unit&) const { return (const char*)(ws + AOFF); }
    __device__ __forceinline__ const char* b_base(const pg9::Unit& u) const { return (const char*)(ws + WOFF) + ((size_t)u.aux * NROWS_B + (size_t)u.pn * 256) * 1024 * 2; }
    __device__ __forceinline__ unsigned a_row_off(const pg9::Unit& u, int r) const { const int rr = r < u.cnt ? r : u.cnt - 1; const int id = LISTS[(size_t)u.aux * 16384 + u.pm * 256 + rr]; return (unsigned)(id >> ASHIFT) * 2048u; }
};
struct EpiMoe1 {
    static constexpr bool PERM = true, CHAIN = false;
    const int* LISTS; const float* b1; bf16_t* ACT;
    __device__ __forceinline__ void operator()(const pg8::f32x4 (&acc)[2][2][4][2], const pg9::Unit& u, int wr, int wc, int fr, int fq) const {
        const int e = u.aux; const int c0 = u.pn * 256 + 32 * wc + 8 * fq;
        pg8::f32x4 bv[2][2];
#pragma unroll
        for (int bj = 0; bj < 2; ++bj)
#pragma unroll
            for (int n = 0; n < 2; ++n) bv[bj][n] = *(const pg8::f32x4*)(b1 + (size_t)e * 2048 + c0 + 128 * bj + 4 * n);
#pragma unroll
        for (int ai = 0; ai < 2; ++ai)
#pragma unroll
            for (int m = 0; m < 4; ++m) { const int r = 128 * ai + 64 * wr + 16 * m + fr; const bool ok = r < u.cnt; const int id = ok ? LISTS[(size_t)e * 16384 + u.pm * 256 + r] : 0;
#pragma unroll
                for (int bj = 0; bj < 2; ++bj) { float a[4];
#pragma unroll
                    for (int n = 0; n < 2; ++n)
#pragma unroll
                        for (int p = 0; p < 2; ++p) { const float gl = fminf(acc[ai][bj][m][n][2 * p] + bv[bj][n][2 * p], 7.0f); const float li = fminf(fmaxf(acc[ai][bj][m][n][2 * p + 1] + bv[bj][n][2 * p + 1], -7.0f), 7.0f);
                            a[2 * n + p] = gl * sigmoid_f(1.702f * gl) * (li + 1.f); }
                    if (ok) { uint2 w; w.x = cvt_pk(a[0], a[1]); w.y = cvt_pk(a[2], a[3]); *(uint2*)(ACT + (size_t)id * 1024 + ((c0 + 128 * bj) >> 1)) = w; } }
                asm volatile("" ::: "memory"); }
    }
};
struct EpiMoe2 {
    static constexpr bool PERM = true, CHAIN = false;
    const int* LISTS; const float* b2; bf16_t* YS;
    __device__ __forceinline__ void operator()(const pg8::f32x4 (&acc)[2][2][4][2], const pg9::Unit& u, int wr, int wc, int fr, int fq) const {
        const int e = u.aux; const int c0 = u.pn * 256 + 32 * wc + 8 * fq;
        pg8::f32x4 bv[2][2];
#pragma unroll
        for (int bj = 0; bj < 2; ++bj)
#pragma unroll
            for (int n = 0; n < 2; ++n) bv[bj][n] = *(const pg8::f32x4*)(b2 + (size_t)e * 1024 + c0 + 128 * bj + 4 * n);
#pragma unroll
        for (int ai = 0; ai < 2; ++ai)
#pragma unroll
            for (int m = 0; m < 4; ++m) { const int r = 128 * ai + 64 * wr + 16 * m + fr; const bool ok = r < u.cnt; const int id = ok ? LISTS[(size_t)e * 16384 + u.pm * 256 + r] : 0;
#pragma unroll
                for (int bj = 0; bj < 2; ++bj) { const pg8::f32x4 v0 = acc[ai][bj][m][0] + bv[bj][0], v1 = acc[ai][bj][m][1] + bv[bj][1];
                    if (ok) { pg8::u32x4 w; w.x = cvt_pk(v0[0], v0[1]); w.y = cvt_pk(v0[2], v0[3]); w.z = cvt_pk(v1[0], v1[1]); w.w = cvt_pk(v1[2], v1[3]); *(pg8::u32x4*)(YS + (size_t)id * 1024 + c0 + 128 * bj) = w; } }
                asm volatile("" ::: "memory"); }
    }
};
__device__ __forceinline__ void p8_combine(Frame& F, float* out) {
    const bf16_t* YS = (const bf16_t*)(F.ws + WS_YS); const float* TOPW = (const float*)(F.ws + WS_TOPW);
    const int gw = F.vcu * NWAVES + F.wave, NGW = F.G * NWAVES, lane = F.lane;
    for (int t = gw; t < NTOK; t += NGW) {
        const f32x4 w4 = *(const f32x4*)(TOPW + (size_t)t * 4);
#pragma unroll
        for (int j = 0; j < 2; ++j) {
            const int c = 8 * lane + 512 * j; f32x4 a0 = *(const f32x4*)(out + (size_t)t * 1024 + c), a1 = *(const f32x4*)(out + (size_t)t * 1024 + c + 4);
#pragma unroll
            for (int k = 0; k < 4; ++k) { const v4u y = *(const v4u*)(YS + ((size_t)t * 4 + k) * 1024 + c); const float wk = w4[k];
                a0.x += wk * __uint_as_float(y.x << 16); a0.y += wk * __uint_as_float(y.x & 0xffff0000u); a0.z += wk * __uint_as_float(y.y << 16); a0.w += wk * __uint_as_float(y.y & 0xffff0000u);
                a1.x += wk * __uint_as_float(y.z << 16); a1.y += wk * __uint_as_float(y.z & 0xffff0000u); a1.z += wk * __uint_as_float(y.w << 16); a1.w += wk * __uint_as_float(y.w & 0xffff0000u); }
            *(f32x4*)(out + (size_t)t * 1024 + c) = a0; *(f32x4*)(out + (size_t)t * 1024 + c + 4) = a1; }
    }
}
#define WAVE_LDS_FENCE() do { asm volatile("s_waitcnt lgkmcnt(0)" ::: "memory"); } while (0)
__device__ __forceinline__ void p2_moba_slow(Frame& F) {
    const bf16_t* MQ = (const bf16_t*)(F.ws + WS_MQ); const bf16_t* MK = (const bf16_t*)(F.ws + WS_MK); const bf16_t* MV = (const bf16_t*)(F.ws + WS_MV); const float* KMEAN = (const float*)(F.ctl + CW_KMEAN); bf16_t* OMOBA = (bf16_t*)(F.ws + WS_OMOBA);
    LAS float* sc = (LAS float*)(F.lds) + F.wave * 1152; LAS float* qsh = sc + 1024;
    const int gw = F.vcu * NWAVES + F.wave, NGW = F.G * NWAVES, lane = F.lane;
    for (int w = gw; w < NB * 8 * SEQ; w += NGW) {
        const int t = w & 4095, h = (w >> 12) & 7, b = w >> 15; const int qb = t >> 8; const size_t row = (size_t)b * 4096 + t;
        qsh[lane] = bf2f(MQ[row * 512 + h * 64 + lane]);
        WAVE_LDS_FENCE();
        float q[64];
#pragma unroll
        for (int d = 0; d < 64; ++d) q[d] = qsh[d];
        float gsc = -INFINITY; if (lane < qb) { const float* km = KMEAN + (((size_t)b * 16 + lane) * 8 + h) * 64; float s = 0.f;
#pragma unroll
            for (int d = 0; d < 64; ++d) s += q[d] * km[d];
            gsc = s; }
        int sel[4]; sel[0] = qb;
#pragma unroll
        for (int r = 0; r < 3; ++r) { const float m = wave_max64(gsc); int j = -1; if (m != -INFINITY) { const unsigned long long bal = __ballot(gsc == m); j = __ffsll((long long)bal) - 1; } sel[r + 1] = j; if (lane == j) gsc = -INFINITY; }
        const float slope = exp2f(-(float)(h + 1)); float mx = -INFINITY;
#pragma unroll
        for (int s = 0; s < 4; ++s) { const int blk = sel[s];
            for (int c = 0; c < 4; ++c) { const int kp = blk * 256 + c * 64 + lane; float v = -INFINITY;
                if (blk >= 0 && kp <= t) { const bf16_t* kr = MK + ((size_t)b * 4096 + kp) * 512 + h * 64; float d_ = 0.f;
#pragma unroll
                    for (int d = 0; d < 64; ++d) d_ += q[d] * bf2f(kr[d]);
                    v = d_ * 0.125f - slope * (float)(t - kp); }
                sc[s * 256 + c * 64 + lane] = v; mx = fmaxf(mx, v); } }
        mx = wave_max64(mx); float sum = 0.f;
        for (int i = lane; i < 1024; i += 64) { const float p = __expf(sc[i] - mx); sc[i] = p; sum += p; }
        sum = wave_sum64(sum);
        WAVE_LDS_FENCE();
        float o = 0.f;
#pragma unroll
        for (int s = 0; s < 4; ++s) { const int blk = sel[s]; if (blk >= 0) for (int k = 0; k < 256; ++k) { const float p = sc[s * 256 + k]; if (p != 0.f) o += p * bf2f(MV[((size_t)b * 4096 + blk * 256 + k) * 512 + h * 64 + lane]); } }
        OMOBA[row * 512 + h * 64 + lane] = f2bf(o / sum);
        WAVE_LDS_FENCE();
    }
}
__device__ __forceinline__ void p2_mem_slow(Frame& F, const float* g_mem_q, const float* g_mem_k) {
    const bf16_t* CQ = (const bf16_t*)(F.ws + WS_CQ); const bf16_t* MEMK = (const bf16_t*)(F.ws + WS_MEMK); const bf16_t* MEMV = (const bf16_t*)(F.ws + WS_MEMV); const float* MEMKSS = (const float*)(F.ctl + CW_MEMKSS); bf16_t* OMEM = (bf16_t*)(F.ws + WS_OMEM);
    LAS float* sc = (LAS float*)(F.lds) + F.wave * 1152; LAS float* qsh = sc + 1024;
    const int gw = F.vcu * NWAVES + F.wave, NGW = F.G * NWAVES, lane = F.lane;
    for (int w = gw; w < NB * 4 * SEQ; w += NGW) {
        const int t = w & 4095, h = (w >> 12) & 3, b = w >> 14; const size_t row = (size_t)b * 4096 + t;
        const float q0 = bf2f(CQ[row * 512 + h * 128 + lane]), q1 = bf2f(CQ[row * 512 + h * 128 + 64 + lane]);
        const float rq = 1.f / sqrtf(wave_sum64(q0 * q0 + q1 * q1) * (1.f / 128.f) + 1e-5f);
        qsh[lane] = q0 * rq * g_mem_q[lane] * g_mem_k[lane]; qsh[lane + 64] = q1 * rq * g_mem_q[lane + 64] * g_mem_k[lane + 64];
        WAVE_LDS_FENCE();
        float mx = -INFINITY;
        for (int c = 0; c < 4; ++c) { const int m = c * 64 + lane; const bf16_t* kr = MEMK + ((size_t)b * 256 + m) * 512 + h * 128; float d_ = 0.f; for (int d = 0; d < 128; ++d) d_ += qsh[d] * bf2f(kr[d]);
            const float rk = 1.f / sqrtf(MEMKSS[((size_t)b * 256 + m) * 4 + h] * (1.f / 128.f) + 1e-5f); const float v = d_ * rk * 0.08838834764831845f; sc[m] = v; mx = fmaxf(mx, v); }
        mx = wave_max64(mx); float sum = 0.f;
        for (int i = lane; i < 256; i += 64) { const float p = __expf(sc[i] - mx); sc[i] = p; sum += p; }
        sum = wave_sum64(sum); WAVE_LDS_FENCE();
        float o0 = 0.f, o1 = 0.f;
        for (int k = 0; k < 256; ++k) { const float p = sc[k]; const bf16_t* vr = MEMV + ((size_t)b * 256 + k) * 512 + h * 128; o0 += p * bf2f(vr[lane]); o1 += p * bf2f(vr[lane + 64]); }
        OMEM[row * 512 + h * 128 + lane] = f2bf(o0 / sum); OMEM[row * 512 + h * 128 + 64 + lane] = f2bf(o1 / sum);
        WAVE_LDS_FENCE();
    }
}
__device__ __forceinline__ void p2_ret_slow(Frame& F, const float* g_ret_out) {
    const bf16_t* RQ = (const bf16_t*)(F.ws + WS_RQ); const bf16_t* RK = (const bf16_t*)(F.ws + WS_RK); const bf16_t* RV = (const bf16_t*)(F.ws + WS_RV); const bf16_t* RG = (const bf16_t*)(F.ws + WS_RG); bf16_t* ORET = (bf16_t*)(F.ws + WS_ORET);
    LAS float* qs = (LAS float*)(F.lds) + 16384; LAS float* ks = qs + 64; LAS float* part = ks + 64; LAS float* red = part + 256;
    const int tid = F.tid, e = tid & 127, hf = (tid >> 7) & 1;
    for (int it = F.vcu; it < 16; it += F.G) {
        const int b = it >> 2, h = it & 3; const float gamma = 1.f - exp2f(-5.f - (float)h);
        float s[32];
#pragma unroll
        for (int i = 0; i < 32; ++i) s[i] = 0.f;
        for (int t = 0; t < 4096; ++t) { const size_t row = (size_t)b * 4096 + t;
            if (tid < 64) qs[tid] = bf2f(RQ[row * 256 + h * 64 + tid]); else if (tid < 128) ks[tid - 64] = bf2f(RK[row * 256 + h * 64 + tid - 64]);
            const float v = bf2f(RV[row * 512 + h * 128 + e]);
            __syncthreads();
            float o = 0.f;
            if (tid < 256) {
#pragma unroll
                for (int i = 0; i < 32; ++i) { s[i] = gamma * s[i] + ks[hf * 32 + i] * v; o += qs[hf * 32 + i] * s[i]; }
                part[tid] = o; }
            __syncthreads();
            float ov = 0.f;
            if (tid < 128) { ov = part[tid] + part[tid + 128]; const float ss = wave_sum64(ov * ov); if ((tid & 63) == 0) red[tid >> 6] = ss; }
            __syncthreads();
            if (tid < 128) { const float r = 1.f / sqrtf((red[0] + red[1]) * (1.f / 128.f) + 1e-5f); ORET[row * 512 + h * 128 + tid] = f2bf(ov * r * g_ret_out[tid] * bf2f(RG[row * 512 + h * 128 + tid])); }
        }
    }
}
constexpr int N_PHASES = 9;
__global__ void __launch_bounds__(NWAVES * 64, 2) mega(Args args) {
    extern __shared__ __attribute__((aligned(16))) unsigned char lds[];
    Frame F;
    F.lds = (LAS unsigned char*)lds; F.MISC = (volatile LAS unsigned*)(F.lds + MISC_OFF);
    F.tid = threadIdx.x; F.lane = F.tid & 63; F.wave = __builtin_amdgcn_readfirstlane(F.tid >> 6);
    F.G = gridDim.x; { const int bx = blockIdx.x; F.vcu = (F.G % 8 == 0) ? (bx % 8) * (F.G / 8) + bx / 8 : bx; }
    F.ws = args.ws; F.out = args.out; F.ctl = (gu32*)(args.ws + WS_CTL);
    for (int u = F.tid; u < (LDS_BYTES - LDSCTL_OFF) / 4; u += NWAVES * 64) ((LAS unsigned*)(F.lds + LDSCTL_OFF))[u] = 0u;
    __syncthreads();
    XcdBarrier bar = xcd_barrier_post((unsigned*)(F.ctl + CW_BAR) + args.li * XCD_BAR_WORDS, F.MISC + 8);
    const int lo = args.ph_lo, hi = args.ph_hi;
#define IN(k) (lo <= (k) && (k) < hi)
#define BOTH(k) (IN(k) && IN((k) + 1))
    if (IN(0)) { p0_prologue(F, args); if (BOTH(0)) xcd_barrier(bar); }
    if (IN(1)) {
        pg8::Gemm g{(const pg8::bf16_t*)(F.ws + WS_HB), (const pg8::bf16_t*)(F.ws + WS_WIN), NTOK + 1024, DIN + 1024, 1024};
        P1Order S; S.init(F.G, (int)blockIdx.x);
        EpiP1 E{F.ws, args.in[4], (const float*)(F.ws + WS_GTAB), (float*)(F.ctl + CW_KMEAN), (float*)(F.ctl + CW_MEMKSS)};
        pg8::gemm_phase<EpiP1, P1Order, true, true>(F.lds + RING_OFF, g, S, E);
        if (BOTH(1)) xcd_barrier(bar);
    }
    if (IN(2)) {
        p2_ret_slow(F, args.in[5]);
        p2_moba_slow(F);
        p2_mem_slow(F, args.in[10], args.in[11]);
        if (BOTH(2)) xcd_barrier(bar);
    }
    if (IN(3)) {
        P3Order S; S.init(F.G, (int)blockIdx.x, F.ws); EpiP3 E{(const bf16_t*)(F.ws + WS_GT), (bf16_t*)(F.ws + WS_Y)};
        pg9::gemm_phase<EpiP3, P3Order, false>(F.lds + RING_OFF, 512, 512, 512, S, E);
        if (BOTH(3)) xcd_barrier(bar);
    }
    if (IN(4)) {
        P4Order S; S.init(F.G, (int)blockIdx.x, F.ws); EpiP4 E{args.in[0], F.out};
        pg9::gemm_phase<EpiP4, P4Order, false>(F.lds + RING_OFF, 1024, 1024, 1024, S, E);
        if (BOTH(4)) xcd_barrier(bar);
    }
    if (IN(5)) { p5_router(F, F.out, args.in[16], args.in[17], args.in[18]); if (BOTH(5)) xcd_barrier(bar); }
    if (IN(6)) {
        moe_tables(F);
        MoeOrder<3, WS_W1, 2048, 2, WS_XT> S; S.init(F.G, (int)blockIdx.x, F.ws, (const LAS int*)(F.lds + TB_OFF));
        EpiMoe1 E{(const int*)(F.ws + WS_LISTS), args.in[20], (bf16_t*)(F.ws + WS_ACT)};
        pg9::gemm_phase<EpiMoe1, MoeOrder<3, WS_W1, 2048, 2, WS_XT>, true>(F.lds + RING_OFF, 1024, 1024, 1024, S, E);
        if (BOTH(6)) xcd_barrier(bar);
    }
    if (IN(7)) {
        moe_tables(F);
        MoeOrder<2, WS_W2, 1024, 0, WS_ACT> S; S.init(F.G, (int)blockIdx.x, F.ws, (const LAS int*)(F.lds + TB_OFF));
        EpiMoe2 E{(const int*)(F.ws + WS_LISTS), args.in[22], (bf16_t*)(F.ws + WS_YS)};
        pg9::gemm_phase<EpiMoe2, MoeOrder<2, WS_W2, 1024, 0, WS_ACT>, true>(F.lds + RING_OFF, 1024, 1024, 1024, S, E);
        if (BOTH(7)) xcd_barrier(bar);
    }
    if (IN(8)) { p8_combine(F, F.out); }
#undef IN
#undef BOTH
}
#ifndef MK_ONE_LAUNCH
#define MK_ONE_LAUNCH 1
#endif
extern "C" void kernel_launch(void* const* d_in, const int* in_sizes, int n_in, void* d_out, int out_size, void* d_ws, size_t ws_size, hipStream_t stream) {
    if (ws_size < WS_END) { fprintf(stderr, "kernel_launch: ws too small %zu < %zu\n", ws_size, (size_t)WS_END); return; }
    unsigned char* ws = (unsigned char*)d_ws; float* out = (float*)d_out;
    static int grid = 0;
    if (grid == 0) {
        int dev = 0, cus = 0; if (hipGetDevice(&dev) != hipSuccess || hipDeviceGetAttribute(&cus, hipDeviceAttributeMultiprocessorCount, dev) != hipSuccess) { fprintf(stderr, "kernel_launch: device query failed\n"); grid = -1; return; }
        if (hipFuncSetAttribute((const void*)mega, hipFuncAttributeMaxDynamicSharedMemorySize, LDS_BYTES) != hipSuccess) { fprintf(stderr, "kernel_launch: hipFuncSetAttribute failed\n"); grid = -1; return; }
        (void)hipGetLastError(); grid = cus;
    }
    if (grid < 0) return;
    (void)hipMemsetAsync(ws + WS_CTL, 0, 1 * MiB, stream);
    Args a; memset(&a, 0, sizeof a); for (int i = 0; i < 23; ++i) a.in[i] = (const float*)d_in[i]; a.out = out; a.ws = ws; a.li = 0;
#if MK_ONE_LAUNCH
    a.ph_lo = 0; a.ph_hi = N_PHASES;
    hipLaunchKernelGGL(mega, dim3(grid), dim3(NWAVES * 64), LDS_BYTES, stream, a);
#else
    for (int p = 0; p < N_PHASES; ++p) { a.ph_lo = p; a.ph_hi = p + 1; hipLaunchKernelGGL(mega, dim3(grid), dim3(NWAVES * 64), LDS_BYTES, stream, a); }
#endif
}
```

```cpp
#include <hip/hip_runtime.h>
#include <cstdio>
#include <cstdint>
#include <cstring>
typedef unsigned short bf16_t;
__host__ __device__ inline float bf2f(bf16_t v) { unsigned u = ((unsigned)v) << 16; float f; __builtin_memcpy(&f, &u, 4); return f; }
__host__ __device__ inline bf16_t f2bf(float f) { unsigned u; __builtin_memcpy(&u, &f, 4); u += 0x7fffu + ((u >> 16) & 1u); return (bf16_t)(u >> 16); }
constexpr int NTOK = 16384, SEQ = 4096, NB = 4, DM = 1024, DIN = 6656, MEMLEN = 256, NEXP = 32;
constexpr size_t MiB = (size_t)1 << 20;
constexpr size_t WS_CTL = 0;
constexpr size_t WS_WIN = 1 * MiB;
constexpr size_t WS_WMEMKV = 14 * MiB;
constexpr size_t WS_WBR = 16 * MiB;
constexpr size_t WS_WOUT = 19 * MiB;
constexpr size_t WS_W1 = 21 * MiB;
constexpr size_t WS_W2 = 149 * MiB;
constexpr size_t WS_HB = 213 * MiB;
constexpr size_t WS_HM = 245 * MiB;
constexpr size_t WS_RQ = 247 * MiB, WS_RK = 255 * MiB, WS_RV = 263 * MiB, WS_RG = 279 * MiB, WS_MQ = 295 * MiB, WS_MK = 311 * MiB, WS_MV = 327 * MiB, WS_CQ = 343 * MiB, WS_GT = 359 * MiB;
constexpr size_t WS_MEMK = 455 * MiB, WS_MEMV = 456 * MiB, WS_KMEAN = 457 * MiB, WS_MEMKSS = 457 * MiB + 512 * 1024;
constexpr size_t WS_GTAB = 457 * MiB + 768 * 1024;
constexpr size_t WS_ORET = 458 * MiB, WS_OMOBA = 474 * MiB, WS_OMEM = 490 * MiB;
constexpr size_t WS_Y = 506 * MiB, WS_XT = 538 * MiB;
constexpr size_t WS_TOPE = 570 * MiB, WS_TOPW = 570 * MiB + 256 * 1024, WS_LISTS = 571 * MiB;
constexpr size_t WS_ACT = 574 * MiB;
constexpr size_t WS_YS = 703 * MiB;
constexpr size_t WS_RETST = 959 * MiB;
constexpr size_t WS_END = 1024 * MiB;
constexpr size_t WS_PROJ = 574 * MiB;
constexpr size_t WS_PM = 990 * MiB;
constexpr size_t WS_ORAW = 574 * MiB;
constexpr size_t WS_T0 = 703 * MiB, WS_T1 = 767 * MiB, WS_T2 = 831 * MiB;
constexpr int CW_COUNTS = 64;
namespace nv {
struct NGemm {
    const bf16_t* A; const int* arow; const float* W; const int* Mdev; size_t w_zstride;
    int lda, arow_zstride, ashift, ldw, M, N, K, pad;
};
static inline NGemm mk_gemm(const bf16_t* A, int lda, const int* arow, int arow_zstride, int ashift, const float* W, int ldw, size_t w_zstride, int M, const int* Mdev, int N, int K) {
    NGemm g; memset(&g, 0, sizeof g); g.A = A; g.arow = arow; g.W = W; g.Mdev = Mdev; g.w_zstride = w_zstride; g.lda = lda; g.arow_zstride = arow_zstride; g.ashift = ashift; g.ldw = ldw; g.M = M; g.N = N; g.K = K; return g; }
template <class Epi> __global__ __launch_bounds__(256) void nk_gemm(NGemm g, Epi epi) {
    __shared__ float As[16][68]; __shared__ float Ws[16][68];
    const int z = blockIdx.z; const int M = g.Mdev ? g.Mdev[z] : g.M; const int m0 = blockIdx.y * 64, n0 = blockIdx.x * 64; if (m0 >= M) return;
    const int tid = threadIdx.x, tx = tid & 15, ty = tid >> 4;
    const int* arow = g.arow ? g.arow + (size_t)z * g.arow_zstride : nullptr; const float* W = g.W + (size_t)z * g.w_zstride;
    const int lr = tid >> 2, lk = (tid & 3) * 4; int srow = -1, rid = -1;
    { const int m = m0 + lr; if (m < M) { rid = arow ? arow[m] : m; srow = arow ? (rid >> g.ashift) : m; } }
    float acc[4][4]; for (int i = 0; i < 4; ++i) for (int j = 0; j < 4; ++j) acc[i][j] = 0.f;
    for (int k0 = 0; k0 < g.K; k0 += 16) {
        float a4[4] = {0.f, 0.f, 0.f, 0.f};
        if (srow >= 0) { const bf16_t* p = g.A + (size_t)srow * g.lda + k0 + lk; for (int j = 0; j < 4; ++j) a4[j] = bf2f(p[j]); }
        for (int j = 0; j < 4; ++j) As[lk + j][lr] = a4[j];
        { const int wk = tid >> 4, wn = (tid & 15) * 4; const float* p = W + (size_t)(k0 + wk) * g.ldw + n0 + wn; for (int j = 0; j < 4; ++j) Ws[wk][wn + j] = p[j]; }
        __syncthreads();
#pragma unroll
        for (int kk = 0; kk < 16; ++kk) { float a[4], b[4]; for (int i = 0; i < 4; ++i) { a[i] = As[kk][ty * 4 + i]; b[i] = Ws[kk][tx * 4 + i]; }
            for (int i = 0; i < 4; ++i) for (int j = 0; j < 4; ++j) acc[i][j] += a[i] * b[j]; }
        __syncthreads();
    }
    for (int i = 0; i < 4; ++i) { const int m = m0 + ty * 4 + i; if (m < M) { const int id = arow ? arow[m] : m; epi(z, id, m, n0 + tx * 4, acc[i]); } }
}
struct EpiStoreF32 { float* C; int ldc; int pad; __device__ void operator()(int, int id, int, int n, const float* v) const { float* p = C + (size_t)id * ldc + n; for (int j = 0; j < 4; ++j) p[j] = v[j]; } };
struct EpiMoeAct { bf16_t* ACT; const float* b1; __device__ void operator()(int e, int id, int, int n, const float* v) const {
    const float* b = b1 + (size_t)e * 2048 + n;
    for (int p = 0; p < 2; ++p) { float gl = fminf(v[2 * p] + b[2 * p], 7.0f); float li = fminf(fmaxf(v[2 * p + 1] + b[2 * p + 1], -7.0f), 7.0f);
        float a = gl * (1.f / (1.f + expf(-1.702f * gl))) * (li + 1.f); ACT[(size_t)id * 1024 + (n >> 1) + p] = f2bf(a); } } };
struct EpiMoeOut { float* YS; const float* b2; __device__ void operator()(int e, int id, int, int n, const float* v) const {
    const float* b = b2 + (size_t)e * 1024 + n; float* p = YS + (size_t)id * 1024 + n; for (int j = 0; j < 4; ++j) p[j] = v[j] + b[j]; } };

__device__ inline float wave_sum(float v) { for (int o = 1; o < 64; o <<= 1) v += __shfl_xor(v, o); return v; }
__device__ inline float wave_max(float v) { for (int o = 1; o < 64; o <<= 1) v = fmaxf(v, __shfl_xor(v, o)); return v; }

__global__ __launch_bounds__(256) void nk_rmsnorm(const float* x, const float* g, bf16_t* out, int rows) {
    const int w = (blockIdx.x * 256 + threadIdx.x) >> 6, lane = threadIdx.x & 63; if (w >= rows) return;
    const float* xr = x + (size_t)w * 1024; float v[16]; float s = 0.f;
    for (int j = 0; j < 16; ++j) { v[j] = xr[lane + 64 * j]; s += v[j] * v[j]; }
    const float r = rsqrtf(wave_sum(s) * (1.f / 1024.f) + 1e-5f);
#pragma unroll
    for (int j = 0; j < 16; ++j) out[(size_t)w * 1024 + lane + 64 * j] = f2bf(v[j] * r * g[lane + 64 * j]);
}
struct PostProj { const float* P; const float* b_gate; const float* g_moba_q; const float* g_moba_k;
    bf16_t *RQ, *RK, *RV, *RG, *MQ, *MK, *MV, *CQ, *GT; };
__global__ __launch_bounds__(256) void nk_post_proj(PostProj a) {
    const int t = blockIdx.x, tid = threadIdx.x, lane = tid & 63, w = tid >> 6; const float* p = a.P + (size_t)t * 6656;
    for (int c = tid; c < 256; c += 256) { a.RQ[(size_t)t * 256 + c] = f2bf(p[c]); a.RK[(size_t)t * 256 + c] = f2bf(p[256 + c] * 0.125f); }
    for (int c = tid; c < 512; c += 256) { a.RV[(size_t)t * 512 + c] = f2bf(p[512 + c]); const float g = p[1024 + c]; a.RG[(size_t)t * 512 + c] = f2bf(g / (1.f + expf(-g)));
        a.MV[(size_t)t * 512 + c] = f2bf(p[2560 + c]); a.CQ[(size_t)t * 512 + c] = f2bf(p[3072 + c]); }
    for (int h = w; h < 8; h += 4) {
        float q = p[1536 + h * 64 + lane], k = p[2048 + h * 64 + lane];
        const float rq = rsqrtf(wave_sum(q * q) * (1.f / 64.f) + 1e-5f), rk = rsqrtf(wave_sum(k * k) * (1.f / 64.f) + 1e-5f);
        a.MQ[(size_t)t * 512 + h * 64 + lane] = f2bf(q * rq * a.g_moba_q[lane]); a.MK[(size_t)t * 512 + h * 64 + lane] = f2bf(k * rk * a.g_moba_k[lane]);
    }
    for (int c = tid; c < 3072; c += 256) { const float g = p[3584 + c] + a.b_gate[c]; a.GT[(size_t)t * 3072 + c] = f2bf(1.f / (1.f + expf(-g))); }
}
__global__ __launch_bounds__(256) void nk_post_mem(const float* PM, bf16_t* MEMK, float* MEMKSS, bf16_t* MEMV) {
    const int r = blockIdx.x, tid = threadIdx.x, lane = tid & 63, w = tid >> 6; const float* p = PM + (size_t)r * 1024;
    for (int c = tid; c < 512; c += 256) { MEMK[(size_t)r * 512 + c] = f2bf(p[c]); MEMV[(size_t)r * 512 + c] = f2bf(p[512 + c]); }
    { const float a = p[w * 128 + lane], b = p[w * 128 + 64 + lane]; const float s = wave_sum(a * a + b * b); if (lane == 0) MEMKSS[r * 4 + w] = s; }
}
__global__ __launch_bounds__(256) void nk_memkss(const bf16_t* MEMK, float* MEMKSS) {
    const int r = blockIdx.x, lane = threadIdx.x & 63, w = threadIdx.x >> 6; const float a = bf2f(MEMK[(size_t)r * 512 + w * 128 + lane]), b = bf2f(MEMK[(size_t)r * 512 + w * 128 + 64 + lane]);
    const float s = wave_sum(a * a + b * b); if (lane == 0) MEMKSS[r * 4 + w] = s;
}
__global__ __launch_bounds__(64) void nk_kmean(const bf16_t* MK, float* KMEAN) {
    const int bb = blockIdx.x, h = blockIdx.y, d = threadIdx.x; float s = 0.f;
    for (int r = 0; r < 256; ++r) s += bf2f(MK[((size_t)bb * 256 + r) * 512 + h * 64 + d]);
    KMEAN[((size_t)bb * 8 + h) * 64 + d] = s * (1.f / 256.f);
}
__global__ __launch_bounds__(256) void nk_retention(const bf16_t* RQ, const bf16_t* RK, const bf16_t* RV, float* ORAW) {
    const int b = blockIdx.x >> 2, h = blockIdx.x & 3, tid = threadIdx.x, e = tid & 127, hf = tid >> 7;
    const float gamma = 1.f - exp2f(-5.f - (float)h);
    __shared__ float qs[64], ks[64], part[256];
    float s[32];
#pragma unroll
    for (int i = 0; i < 32; ++i) s[i] = 0.f;
    for (int t = 0; t < 4096; ++t) { const size_t row = (size_t)b * 4096 + t;
        if (tid < 64) qs[tid] = bf2f(RQ[row * 256 + h * 64 + tid]); else if (tid < 128) ks[tid - 64] = bf2f(RK[row * 256 + h * 64 + tid - 64]);
        const float v = bf2f(RV[row * 512 + h * 128 + e]);
        __syncthreads();
        float o = 0.f;
#pragma unroll
        for (int i = 0; i < 32; ++i) { s[i] = gamma * s[i] + ks[hf * 32 + i] * v; o += qs[hf * 32 + i] * s[i]; }
        part[tid] = o; __syncthreads();
        if (tid < 128) ORAW[row * 512 + h * 128 + tid] = part[tid] + part[tid + 128];
    }
}
__global__ __launch_bounds__(256) void nk_ret_post(const float* ORAW, const float* g_ret_out, const bf16_t* RG, bf16_t* ORET) {
    const int w = (blockIdx.x * 256 + threadIdx.x) >> 6, lane = threadIdx.x & 63; const int t = w >> 2, h = w & 3;
    const float* p = ORAW + (size_t)t * 512 + h * 128; const float a = p[lane], b = p[lane + 64];
    const float r = rsqrtf(wave_sum(a * a + b * b) * (1.f / 128.f) + 1e-5f);
    ORET[(size_t)t * 512 + h * 128 + lane] = f2bf(a * r * g_ret_out[lane] * bf2f(RG[(size_t)t * 512 + h * 128 + lane]));
    ORET[(size_t)t * 512 + h * 128 + lane + 64] = f2bf(b * r * g_ret_out[lane + 64] * bf2f(RG[(size_t)t * 512 + h * 128 + lane + 64]));
}
__global__ __launch_bounds__(256) void nk_moba(const bf16_t* MQ, const bf16_t* MK, const bf16_t* MV, const float* KMEAN, bf16_t* OMOBA) {
    __shared__ float sc[4][1024]; __shared__ float qsh[4][64];
    const int wl = threadIdx.x >> 6, lane = threadIdx.x & 63; const int w = blockIdx.x * 4 + wl;
    const int t = w & 4095, h = (w >> 12) & 7, b = w >> 15; const int qb = t >> 8;
    const size_t row = (size_t)b * 4096 + t;
    qsh[wl][lane] = bf2f(MQ[row * 512 + h * 64 + lane]);
    __syncthreads();
    float q[64];
#pragma unroll
    for (int d = 0; d < 64; ++d) q[d] = qsh[wl][d];
    float gsc = -INFINITY; if (lane < qb) { const float* km = KMEAN + (((size_t)b * 16 + lane) * 8 + h) * 64; float s = 0.f;
#pragma unroll
        for (int d = 0; d < 64; ++d) s += q[d] * km[d];
        gsc = s; }
    int sel[4]; sel[0] = qb;
#pragma unroll
    for (int r = 0; r < 3; ++r) { const float m = wave_max(gsc); int j = -1; if (m != -INFINITY) { const unsigned long long bal = __ballot(gsc == m); j = __ffsll((long long)bal) - 1; } sel[r + 1] = j; if (lane == j) gsc = -INFINITY; }
    const float slope = exp2f(-(float)(h + 1));
    float mx = -INFINITY;
#pragma unroll
    for (int s = 0; s < 4; ++s) { const int blk = sel[s];
        for (int c = 0; c < 4; ++c) { const int kp = blk * 256 + c * 64 + lane; float v = -INFINITY;
            if (blk >= 0 && kp <= t) { const bf16_t* kr = MK + ((size_t)b * 4096 + kp) * 512 + h * 64; float d_ = 0.f;
#pragma unroll
                for (int d = 0; d < 64; ++d) d_ += q[d] * bf2f(kr[d]);
                v = d_ * 0.125f - slope * (float)(t - kp); }
            sc[wl][s * 256 + c * 64 + lane] = v; mx = fmaxf(mx, v); } }
    mx = wave_max(mx); float sum = 0.f;
    for (int i = lane; i < 1024; i += 64) { const float p = expf(sc[wl][i] - mx); sc[wl][i] = p; sum += p; }
    sum = wave_sum(sum);
    __syncthreads();
    float o = 0.f;
#pragma unroll
    for (int s = 0; s < 4; ++s) { const int blk = sel[s]; if (blk >= 0) for (int k = 0; k < 256; ++k) { const float p = sc[wl][s * 256 + k]; if (p != 0.f) o += p * bf2f(MV[((size_t)b * 4096 + blk * 256 + k) * 512 + h * 64 + lane]); } }
    OMOBA[row * 512 + h * 64 + lane] = f2bf(o / sum);
}
__global__ __launch_bounds__(256) void nk_memattn(const bf16_t* CQ, const bf16_t* MEMK, const float* MEMKSS, const bf16_t* MEMV, const float* g_mem_q, const float* g_mem_k, bf16_t* OMEM) {
    __shared__ float sc[4][256]; __shared__ float qsh[4][128];
    const int wl = threadIdx.x >> 6, lane = threadIdx.x & 63; const int w = blockIdx.x * 4 + wl;
    const int t = w & 4095, h = (w >> 12) & 3, b = w >> 14; const size_t row = (size_t)b * 4096 + t;
    const float q0 = bf2f(CQ[row * 512 + h * 128 + lane]), q1 = bf2f(CQ[row * 512 + h * 128 + 64 + lane]);
    const float rq = rsqrtf(wave_sum(q0 * q0 + q1 * q1) * (1.f / 128.f) + 1e-5f);
    qsh[wl][lane] = q0 * rq * g_mem_q[lane] * g_mem_k[lane]; qsh[wl][lane + 64] = q1 * rq * g_mem_q[lane + 64] * g_mem_k[lane + 64];
    __syncthreads();
    float mx = -INFINITY;
    for (int c = 0; c < 4; ++c) { const int m = c * 64 + lane; const bf16_t* kr = MEMK + ((size_t)b * 256 + m) * 512 + h * 128; float d_ = 0.f; for (int d = 0; d < 128; ++d) d_ += qsh[wl][d] * bf2f(kr[d]);
        const float rk = rsqrtf(MEMKSS[((size_t)b * 256 + m) * 4 + h] * (1.f / 128.f) + 1e-5f); const float v = d_ * rk * 0.08838834764831845f; sc[wl][m] = v; mx = fmaxf(mx, v); }
    mx = wave_max(mx); float sum = 0.f;
    for (int i = lane; i < 256; i += 64) { const float p = expf(sc[wl][i] - mx); sc[wl][i] = p; sum += p; }
    sum = wave_sum(sum); __syncthreads();
    float o0 = 0.f, o1 = 0.f;
    for (int k = 0; k < 256; ++k) { const float p = sc[wl][k]; const bf16_t* vr = MEMV + ((size_t)b * 256 + k) * 512 + h * 128; o0 += p * bf2f(vr[lane]); o1 += p * bf2f(vr[lane + 64]); }
    OMEM[row * 512 + h * 128 + lane] = f2bf(o0 / sum); OMEM[row * 512 + h * 128 + 64 + lane] = f2bf(o1 / sum);
}
__global__ __launch_bounds__(256) void nk_merge(const float* T0, const float* T1, const float* T2, const bf16_t* GT, bf16_t* Y) {
    const size_t i = (size_t)blockIdx.x * 256 + threadIdx.x; const size_t t = i >> 10; const int n = (int)(i & 1023);
    Y[i] = f2bf(bf2f(GT[t * 3072 + n]) * T0[i] + bf2f(GT[t * 3072 + 1024 + n]) * T1[i] + bf2f(GT[t * 3072 + 2048 + n]) * T2[i]);
}
__global__ __launch_bounds__(256) void nk_resid(const float* x, const float* T, float* X1) { const size_t i = (size_t)blockIdx.x * 256 + threadIdx.x; X1[i] = x[i] + T[i]; }
__global__ __launch_bounds__(256) void nk_router(const float* X1, const float* g_ffn, const float* w_router, const float* b_router, bf16_t* XT, int* TOPE, float* TOPW, int* COUNTS, int* LISTS) {
    const int t = (blockIdx.x * 256 + threadIdx.x) >> 6, lane = threadIdx.x & 63; const float* xr = X1 + (size_t)t * 1024; float v[16]; float s = 0.f;
    for (int j = 0; j < 16; ++j) { v[j] = xr[lane + 64 * j]; s += v[j] * v[j]; }
    const float r = rsqrtf(wave_sum(s) * (1.f / 1024.f) + 1e-5f);
#pragma unroll
    for (int j = 0; j < 16; ++j) { v[j] = v[j] * r * g_ffn[lane + 64 * j]; XT[(size_t)t * 1024 + lane + 64 * j] = f2bf(v[j]); }
    float lg = -INFINITY;
    for (int e = 0; e < 32; ++e) { float p = 0.f;
#pragma unroll
        for (int j = 0; j < 16; ++j) p += v[j] * w_router[(size_t)(lane + 64 * j) * 32 + e]; p = wave_sum(p); if (lane == e) lg = p + b_router[e]; }
    float tv[4]; int te[4];
#pragma unroll
    for (int k = 0; k < 4; ++k) { const float m = wave_max(lg); const unsigned long long bal = __ballot(lg == m); const int e = __ffsll((long long)bal) - 1; tv[k] = m; te[k] = e; if (lane == e) lg = -INFINITY; }
    float ex[4], se = 0.f;
#pragma unroll
    for (int k = 0; k < 4; ++k) { ex[k] = expf(tv[k] - tv[0]); se += ex[k]; }
    int e_l = te[0]; float w_l = ex[0];
#pragma unroll
    for (int k = 1; k < 4; ++k) if (lane == k) { e_l = te[k]; w_l = ex[k]; }
    if (lane < 4) { const int e = e_l; TOPE[t * 4 + lane] = e; TOPW[t * 4 + lane] = w_l / se; const int pos = atomicAdd(&COUNTS[e], 1); LISTS[(size_t)e * 16384 + pos] = t * 4 + lane; }
}
__global__ __launch_bounds__(256) void nk_combine(const float* X1, const float* YS, const float* TOPW, float* out) {
    const size_t i = (size_t)blockIdx.x * 256 + threadIdx.x; const size_t t = i >> 10; const int n = (int)(i & 1023); float a = X1[i];
    for (int k = 0; k < 4; ++k) a += TOPW[t * 4 + k] * YS[(t * 4 + k) * 1024 + n];
    out[i] = a;
}
}
namespace pg8 {
#define PG8_LAS __attribute__((address_space(3)))
typedef unsigned short bf16_t;
typedef short bf16x8 __attribute__((ext_vector_type(8)));
typedef float f32x4 __attribute__((ext_vector_type(4)));
typedef unsigned u32x4 __attribute__((ext_vector_type(4)));
constexpr int BM = 256, BK = 64, HALF = 128, HTB = HALF * BK * 2  , STAGE_BYTES = 8 * HTB, NXCD = 8, WGM = 8;

__host__ __device__ __forceinline__ int lds_byte(int r, int c) { const int st = (r >> 4) * 2 + (c >> 5), rr = r & 15, cc = c & 31, ob = rr * 64 + cc * 2; return st * 1024 + (ob ^ (((ob >> 9) & 1) << 5)); }
__host__ __device__ __forceinline__ void stage_rc(int b, int& R, int& C) { const int st = b / 1024, sb = b % 1024, swz = sb ^ (((sb >> 9) & 1) << 5); R = (st >> 1) * 16 + swz / 64; C = (st & 1) * 32 + (swz % 64) / 2; }
__host__ __device__ __forceinline__ int perm32(int rho) { const int n = rho >> 4, i = rho & 15; return 8 * (i >> 2) + 4 * n + (i & 3); }

struct Unit { int pm, pn; };
struct Gemm { const bf16_t* A; const bf16_t* Bt; int M, N, K; };
struct StaticOrder {
    int nM, nN, nwg, G, c;
    __host__ __device__ void init(int M, int N, int G_, int c_) { nM = M / BM; nN = N / BM; nwg = nM * nN; G = G_; c = c_; }
    __host__ __device__ bool next(int i, Unit& u) const {
        const long L = (long)i * G + c; if (L >= nwg) return false;
        int wgid = (int)L; { const int q = nwg / NXCD, r = nwg % NXCD, xcd = wgid % NXCD, off = wgid / NXCD; wgid = (xcd < r ? xcd * (q + 1) : r * (q + 1) + (xcd - r) * q) + off; }
        const int nig = WGM * nN, gid = wgid / nig, fm = gid * WGM, gsz = (nM - fm) < WGM ? (nM - fm) : WGM;
        u.pm = fm + ((wgid % nig) % gsz); u.pn = (wgid % nig) / gsz; return true;
    }
    __device__ __forceinline__ void a_ready(const Unit&) const {}
    __device__ __forceinline__ void done(const Unit&) const {}
};
__device__ __forceinline__ unsigned cvt_pk_bf16(float lo, float hi) { unsigned r; asm volatile("v_cvt_pk_bf16_f32 %0, %1, %2" : "=v"(r) : "v"(lo), "v"(hi)); return r; }
typedef float f32x2 __attribute__((ext_vector_type(2)));
template <class Epi, class Sched, bool ALIGN_EPI = false, bool SP2 = false>
__device__ __forceinline__ void gemm_phase(PG8_LAS unsigned char* lds, const Gemm g, const Sched& S, const Epi& E) {
    const int tid = threadIdx.x, wid = __builtin_amdgcn_readfirstlane(tid >> 6), lane = tid & 63, wr = wid >> 2, wc = wid & 3, fr = lane & 15, fq = lane >> 4;
    const int K = g.K, nt = K / BK;
    unsigned voffA[2], voffB[2];
#pragma unroll
    for (int i = 0; i < 2; ++i) { int R, C; stage_rc(tid * 16 + i * 8192, R, C); const int Rb = Epi::PERM ? ((R & ~31) + perm32(R & 31)) : R;
        voffA[i] = (unsigned)(R * K + C) * 2u; voffB[i] = (unsigned)(Rb * K + C) * 2u; }
    const size_t kstep = (size_t)(BK * 2);
    const size_t hstep = (size_t)HALF * K * 2;
    const size_t tstep = 2 * hstep;
    const unsigned ldsw = (unsigned)wid * 1024u;
    const int aoff = lds_byte(wr * 64 + fr, fq * 8), boff = lds_byte(wc * 32 + fr, fq * 8);
#define PG8_SA(b, h) (((b) * 2 + (h)) * HTB)
#define PG8_SB(b, h) ((4 + (b) * 2 + (h)) * HTB)
#define PG8_STAGE(bufoff, gbase, voff) do { _Pragma("unroll") for (int _i = 0; _i < 2; ++_i) \
        __builtin_amdgcn_global_load_lds((const unsigned*)((const char*)(gbase) + (voff)[_i]), (PG8_LAS unsigned*)(lds + (bufoff) + ldsw + _i * 8192), 16, 0, 0); } while (0)
#define PG8_LDA(dst, b, h) do { _Pragma("unroll") for (int m = 0; m < 4; ++m) _Pragma("unroll") for (int k = 0; k < 2; ++k) dst[m][k] = *(const PG8_LAS bf16x8*)(lds + PG8_SA(b, h) + aoff + m * 2048 + k * 1024); } while (0)
#define PG8_LDB(dst, b, h) do { _Pragma("unroll") for (int n = 0; n < 2; ++n) _Pragma("unroll") for (int k = 0; k < 2; ++k) dst[n][k] = *(const PG8_LAS bf16x8*)(lds + PG8_SB(b, h) + boff + n * 2048 + k * 1024); } while (0)
#define PG8_MMA(ai, bj, At, Bt) do { __builtin_amdgcn_s_setprio(1); _Pragma("unroll") for (int m = 0; m < 4; ++m) _Pragma("unroll") for (int n = 0; n < 2; ++n) _Pragma("unroll") for (int k = 0; k < 2; ++k) \
        acc[ai][bj][m][n] = __builtin_amdgcn_mfma_f32_16x16x32_bf16(Bt[n][k], At[m][k], acc[ai][bj][m][n], 0, 0, 0); __builtin_amdgcn_s_setprio(0); } while (0)
#define PG8_WAIT_V(n) asm volatile("s_waitcnt vmcnt(" #n ")" ::: "memory")
#define PG8_WAIT_L(n) asm volatile("s_waitcnt lgkmcnt(" #n ")" ::: "memory")
#define PG8_BAR __builtin_amdgcn_s_barrier()
#define PG8_SCHED __builtin_amdgcn_sched_barrier(0)
    Unit cur, nxt; int ui = 0;
    if (!S.next(0, cur)) return;
    f32x4 acc[2][2][4][2];
#pragma unroll
    for (int a = 0; a < 2; ++a)
#pragma unroll
        for (int b = 0; b < 2; ++b)
#pragma unroll
            for (int m = 0; m < 4; ++m)
#pragma unroll
                for (int n = 0; n < 2; ++n) acc[a][b][m][n] = (f32x4){0.f, 0.f, 0.f, 0.f};
    bf16x8 At[4][2], B0[2][2], B1[2][2];
    const char* cA = (const char*)g.A + (size_t)cur.pm * tstep; const char* cB = (const char*)g.Bt + (size_t)cur.pn * tstep;
    S.a_ready(cur);
    if constexpr (SP2) {
        PG8_STAGE(PG8_SB(0, 0), cB, voffB); PG8_STAGE(PG8_SB(0, 1), cB + hstep, voffB); PG8_STAGE(PG8_SA(0, 0), cA, voffA); PG8_STAGE(PG8_SA(0, 1), cA + hstep, voffA);
        if (wr == 1) PG8_BAR;
        PG8_WAIT_V(2); PG8_BAR;
        PG8_STAGE(PG8_SB(1, 0), cB + kstep, voffB); PG8_STAGE(PG8_SA(1, 0), cA + kstep, voffA); PG8_STAGE(PG8_SB(1, 1), cB + hstep + kstep, voffB);
        PG8_WAIT_V(6); PG8_BAR;
    } else {
        PG8_STAGE(PG8_SB(0, 0), cB, voffB); PG8_STAGE(PG8_SA(0, 0), cA, voffA); PG8_STAGE(PG8_SB(0, 1), cB + hstep, voffB); PG8_STAGE(PG8_SA(0, 1), cA + hstep, voffA);
        if (wr == 1) PG8_BAR;
        PG8_WAIT_V(4); PG8_BAR;
        PG8_STAGE(PG8_SB(1, 0), cB + kstep, voffB); PG8_STAGE(PG8_SA(1, 0), cA + kstep, voffA); PG8_STAGE(PG8_SB(1, 1), cB + hstep + kstep, voffB);
        PG8_WAIT_V(6); PG8_BAR;
    }
    for (;;) {
        const bool has_next = S.next(ui + 1, nxt);
        const char* nA = has_next ? (const char*)g.A + (size_t)nxt.pm * tstep : cA; const char* nB = has_next ? (const char*)g.Bt + (size_t)nxt.pn * tstep : cB;
        for (int t = 0; t < nt; t += 2) {
            const bool last = (t == nt - 2);
            const char* a1 = cA + (size_t)(t + 1) * kstep;
            const char* a2 = last ? nA : cA + (size_t)(t + 2) * kstep; const char* b2 = last ? nB : cB + (size_t)(t + 2) * kstep;
            const char* a3 = a2 + kstep; const char* b3 = b2 + kstep;
            if (last && has_next) S.a_ready(nxt);
            if constexpr (SP2) {
            PG8_LDB(B0, 0, 0); PG8_LDB(B1, 0, 1); PG8_SCHED; PG8_LDA(At, 0, 0); PG8_STAGE(PG8_SA(1, 1), a1 + hstep, voffA);
            PG8_WAIT_V(8); PG8_WAIT_L(0); PG8_BAR; PG8_MMA(0, 0, At, B0); PG8_MMA(0, 1, At, B1); PG8_BAR; PG8_SCHED;
            PG8_LDA(At, 0, 1); PG8_STAGE(PG8_SB(0, 0), b2, voffB); PG8_STAGE(PG8_SB(0, 1), b2 + hstep, voffB); PG8_STAGE(PG8_SA(0, 0), a2, voffA);
            PG8_WAIT_V(8); PG8_WAIT_L(0); PG8_BAR; PG8_MMA(1, 0, At, B0); PG8_MMA(1, 1, At, B1); PG8_BAR; PG8_SCHED;
            PG8_LDB(B0, 1, 0); PG8_LDB(B1, 1, 1); PG8_SCHED; PG8_LDA(At, 1, 0); PG8_STAGE(PG8_SA(0, 1), a2 + hstep, voffA);
            PG8_WAIT_V(8); PG8_WAIT_L(0); PG8_BAR; PG8_MMA(0, 0, At, B0); PG8_MMA(0, 1, At, B1); PG8_BAR; PG8_SCHED;
            PG8_LDA(At, 1, 1); PG8_STAGE(PG8_SB(1, 0), b3, voffB); PG8_STAGE(PG8_SB(1, 1), b3 + hstep, voffB); PG8_STAGE(PG8_SA(1, 0), a3, voffA);
            PG8_WAIT_V(8); PG8_WAIT_L(0); PG8_BAR; PG8_MMA(1, 0, At, B0); PG8_MMA(1, 1, At, B1); PG8_BAR; PG8_SCHED;
            } else {
            PG8_LDB(B0, 0, 0); PG8_SCHED; PG8_LDA(At, 0, 0); PG8_STAGE(PG8_SA(1, 1), a1 + hstep, voffA);
            PG8_WAIT_L(8); PG8_BAR; PG8_WAIT_L(0); PG8_MMA(0, 0, At, B0); PG8_BAR; PG8_SCHED;
            PG8_LDB(B1, 0, 1); PG8_STAGE(PG8_SB(0, 0), b2, voffB);
            PG8_BAR; PG8_WAIT_L(0); PG8_MMA(0, 1, At, B1); PG8_BAR;
            PG8_LDA(At, 0, 1); PG8_STAGE(PG8_SA(0, 0), a2, voffA);
            PG8_BAR; PG8_WAIT_L(0); PG8_MMA(1, 0, At, B0); PG8_BAR; PG8_SCHED;
            PG8_STAGE(PG8_SB(0, 1), b2 + hstep, voffB);
            PG8_WAIT_V(6); PG8_BAR; PG8_MMA(1, 1, At, B1); PG8_BAR;
            PG8_LDB(B0, 1, 0); PG8_SCHED; PG8_LDA(At, 1, 0); PG8_STAGE(PG8_SA(0, 1), a2 + hstep, voffA);
            PG8_WAIT_L(8); PG8_BAR; PG8_WAIT_L(0); PG8_MMA(0, 0, At, B0); PG8_BAR; PG8_SCHED;
            PG8_LDB(B1, 1, 1); PG8_STAGE(PG8_SB(1, 0), b3, voffB);
            PG8_BAR; PG8_WAIT_L(0); PG8_MMA(0, 1, At, B1); PG8_BAR;
            PG8_LDA(At, 1, 1); PG8_STAGE(PG8_SA(1, 0), a3, voffA);
            PG8_BAR; PG8_WAIT_L(0); PG8_MMA(1, 0, At, B0); PG8_BAR; PG8_SCHED;
            PG8_STAGE(PG8_SB(1, 1), b3 + hstep, voffB);
            PG8_WAIT_V(6); PG8_BAR; PG8_MMA(1, 1, At, B1); PG8_BAR;
            }
        }
        if constexpr (ALIGN_EPI) { if (wr == 0) PG8_BAR; }
        if constexpr (!Epi::AFTER_DRAIN) { E(acc, cur, wr, wc, fr, fq); S.done(cur); }
        if (!has_next) break;
#pragma unroll
        for (int a = 0; a < 2; ++a)
#pragma unroll
            for (int b = 0; b < 2; ++b)
#pragma unroll
                for (int m = 0; m < 4; ++m)
#pragma unroll
                    for (int n = 0; n < 2; ++n) acc[a][b][m][n] = (f32x4){0.f, 0.f, 0.f, 0.f};
        cur = nxt; cA = nA; cB = nB; ++ui;
        if constexpr (ALIGN_EPI) { if (wr == 1) PG8_BAR; }
    }
    PG8_WAIT_V(0);
    if constexpr (!ALIGN_EPI) { if (wr == 0) PG8_BAR; }
    PG8_BAR;
    if constexpr (Epi::AFTER_DRAIN) { E.fused(acc, cur, wr, wc, fr, fq, lds, wid, lane); S.done(cur); }
#undef PG8_SA
#undef PG8_SB
#undef PG8_STAGE
#undef PG8_LDA
#undef PG8_LDB
#undef PG8_MMA
#undef PG8_WAIT_V
#undef PG8_WAIT_L
#undef PG8_BAR
#undef PG8_SCHED
}
}
namespace pg9 {
using pg8::bf16x8; using pg8::f32x4; using pg8::u32x4; using pg8::lds_byte; using pg8::stage_rc; using pg8::perm32;
constexpr int BK = 64, HALF = 128, HTB = HALF * BK * 2;
struct Unit { int pm, pn, aux, cnt; };
template <class Epi, class Sched, bool GATHER>
__device__ __forceinline__ void gemm_phase(PG8_LAS unsigned char* lds, const int K, const int lda, const int ldb, const Sched& S, const Epi& E) {
    const int tid = threadIdx.x, wid = __builtin_amdgcn_readfirstlane(tid >> 6), lane = tid & 63, wr = wid >> 2, wc = wid & 3, fr = lane & 15, fq = lane >> 4;
    const int nt = K / BK;
    unsigned offA[2][2], offAn[2][2], offB[2][2]; int RA[2], CA[2];
#pragma unroll
    for (int i = 0; i < 2; ++i) { int R, C; stage_rc(tid * 16 + i * 8192, R, C); const int Rb = Epi::PERM ? ((R & ~31) + perm32(R & 31)) : R; RA[i] = R; CA[i] = C * 2;
#pragma unroll
        for (int h = 0; h < 2; ++h) { offB[h][i] = (unsigned)((Rb + 128 * h) * ldb + C) * 2u; offA[h][i] = (unsigned)((R + 128 * h) * lda + C) * 2u; offAn[h][i] = offA[h][i]; } }
    const size_t kstep = (size_t)(BK * 2);
    const unsigned ldsw = (unsigned)wid * 1024u;
    const int aoff = lds_byte(wr * 64 + fr, fq * 8), boff = lds_byte(wc * 32 + fr, fq * 8);
#define PG9_SA(b, h) (((b) * 2 + (h)) * HTB)
#define PG9_SB(b, h) ((4 + (b) * 2 + (h)) * HTB)
#define PG9_STAGE(bufoff, gbase, voff) do { _Pragma("unroll") for (int _i = 0; _i < 2; ++_i) \
        __builtin_amdgcn_global_load_lds((const unsigned*)((const char*)(gbase) + (voff)[_i]), (PG8_LAS unsigned*)(lds + (bufoff) + ldsw + _i * 8192), 16, 0, 0); } while (0)
#define PG9_LDA(dst, b, h) do { _Pragma("unroll") for (int m = 0; m < 4; ++m) _Pragma("unroll") for (int k = 0; k < 2; ++k) dst[m][k] = *(const PG8_LAS bf16x8*)(lds + PG9_SA(b, h) + aoff + m * 2048 + k * 1024); } while (0)
#define PG9_LDB(dst, b, h) do { _Pragma("unroll") for (int n = 0; n < 2; ++n) _Pragma("unroll") for (int k = 0; k < 2; ++k) dst[n][k] = *(const PG8_LAS bf16x8*)(lds + PG9_SB(b, h) + boff + n * 2048 + k * 1024); } while (0)
#define PG9_MMA(ai, bj, At, Bt) do { __builtin_amdgcn_s_setprio(1); _Pragma("unroll") for (int m = 0; m < 4; ++m) _Pragma("unroll") for (int n = 0; n < 2; ++n) _Pragma("unroll") for (int k = 0; k < 2; ++k) \
        acc[ai][bj][m][n] = __builtin_amdgcn_mfma_f32_16x16x32_bf16(Bt[n][k], At[m][k], acc[ai][bj][m][n], 0, 0, 0); __builtin_amdgcn_s_setprio(0); } while (0)
#define PG9_WAIT_V(n) asm volatile("s_waitcnt vmcnt(" #n ")" ::: "memory")
#define PG9_WAIT_L(n) asm volatile("s_waitcnt lgkmcnt(" #n ")" ::: "memory")
#define PG9_BAR __builtin_amdgcn_s_barrier()
#define PG9_SCHED __builtin_amdgcn_sched_barrier(0)
    Unit cur, nxt; int ui = 0;
    if (!S.next(0, cur)) return;
    f32x4 acc[2][2][4][2];
#pragma unroll
    for (int a = 0; a < 2; ++a)
#pragma unroll
        for (int b = 0; b < 2; ++b)
#pragma unroll
            for (int m = 0; m < 4; ++m)
#pragma unroll
                for (int n = 0; n < 2; ++n) acc[a][b][m][n] = (f32x4){0.f, 0.f, 0.f, 0.f};
    bf16x8 At[4][2], B0[2][2], B1[2][2];
    const char* cA = S.a_base(cur); const char* cB = S.b_base(cur);
    if constexpr (GATHER) {
#pragma unroll
        for (int h = 0; h < 2; ++h)
#pragma unroll
            for (int i = 0; i < 2; ++i) offA[h][i] = S.a_row_off(cur, RA[i] + 128 * h) + (unsigned)CA[i];
    }
    PG9_STAGE(PG9_SB(0, 0), cB, offB[0]); PG9_STAGE(PG9_SB(0, 1), cB, offB[1]); PG9_STAGE(PG9_SA(0, 0), cA, offA[0]); PG9_STAGE(PG9_SA(0, 1), cA, offA[1]);
    if (wr == 1) PG9_BAR;
    PG9_WAIT_V(2); PG9_BAR;
    PG9_STAGE(PG9_SB(1, 0), cB + kstep, offB[0]); PG9_STAGE(PG9_SA(1, 0), cA + kstep, offA[0]); PG9_STAGE(PG9_SB(1, 1), cB + kstep, offB[1]);
    PG9_WAIT_V(6); PG9_BAR;
    for (;;) {
        const bool has_next = S.next(ui + 1, nxt);
        const char* nA = has_next ? S.a_base(nxt) : cA; const char* nB = has_next ? S.b_base(nxt) : cB;
        if constexpr (GATHER) {
#pragma unroll
            for (int h = 0; h < 2; ++h)
#pragma unroll
                for (int i = 0; i < 2; ++i) offAn[h][i] = has_next ? (S.a_row_off(nxt, RA[i] + 128 * h) + (unsigned)CA[i]) : offA[h][i];
        }
        for (int t = 0; t < nt; t += 2) {
            const bool last = (t == nt - 2);
            const char* a1 = cA + (size_t)(t + 1) * kstep;
            const char* a2 = last ? nA : cA + (size_t)(t + 2) * kstep; const char* b2 = last ? nB : cB + (size_t)(t + 2) * kstep;
            const char* a3 = a2 + kstep; const char* b3 = b2 + kstep;
            unsigned oA2[2][2];
#pragma unroll
            for (int h = 0; h < 2; ++h)
#pragma unroll
                for (int i = 0; i < 2; ++i) oA2[h][i] = (GATHER && last) ? offAn[h][i] : offA[h][i];
            PG9_LDB(B0, 0, 0); PG9_LDB(B1, 0, 1); PG9_SCHED; PG9_LDA(At, 0, 0); PG9_STAGE(PG9_SA(1, 1), a1, offA[1]);
            PG9_WAIT_V(8); PG9_WAIT_L(0); PG9_BAR; PG9_MMA(0, 0, At, B0); PG9_MMA(0, 1, At, B1); PG9_BAR; PG9_SCHED;
            PG9_LDA(At, 0, 1); PG9_STAGE(PG9_SB(0, 0), b2, offB[0]); PG9_STAGE(PG9_SB(0, 1), b2, offB[1]); PG9_STAGE(PG9_SA(0, 0), a2, oA2[0]);
            PG9_WAIT_V(8); PG9_WAIT_L(0); PG9_BAR; PG9_MMA(1, 0, At, B0); PG9_MMA(1, 1, At, B1); PG9_BAR; PG9_SCHED;
            PG9_LDB(B0, 1, 0); PG9_LDB(B1, 1, 1); PG9_SCHED; PG9_LDA(At, 1, 0); PG9_STAGE(PG9_SA(0, 1), a2, oA2[1]);
            PG9_WAIT_V(8); PG9_WAIT_L(0); PG9_BAR; PG9_MMA(0, 0, At, B0); PG9_MMA(0, 1, At, B1); PG9_BAR; PG9_SCHED;
            PG9_LDA(At, 1, 1); PG9_STAGE(PG9_SB(1, 0), b3, offB[0]); PG9_STAGE(PG9_SB(1, 1), b3, offB[1]); PG9_STAGE(PG9_SA(1, 0), a3, oA2[0]);
            PG9_WAIT_V(8); PG9_WAIT_L(0); PG9_BAR; PG9_MMA(1, 0, At, B0); PG9_MMA(1, 1, At, B1); PG9_BAR; PG9_SCHED;
        }
        if (wr == 0) PG9_BAR;
        bool keep = false;
        if constexpr (Epi::CHAIN) keep = E.chain_more(cur);
        if (keep) { if constexpr (Epi::CHAIN) E.rescale(acc, cur, wr, wc, fr, fq); }
        else E(acc, cur, wr, wc, fr, fq);
        if (!has_next) break;
        if (!keep) {
#pragma unroll
            for (int a = 0; a < 2; ++a)
#pragma unroll
                for (int b = 0; b < 2; ++b)
#pragma unroll
                    for (int m = 0; m < 4; ++m)
#pragma unroll
                        for (int n = 0; n < 2; ++n) acc[a][b][m][n] = (f32x4){0.f, 0.f, 0.f, 0.f};
        }
        cur = nxt; cA = nA; cB = nB; ++ui;
        if constexpr (GATHER) {
#pragma unroll
            for (int h = 0; h < 2; ++h)
#pragma unroll
                for (int i = 0; i < 2; ++i) offA[h][i] = offAn[h][i];
        }
        if (wr == 1) PG9_BAR;
    }
    PG9_WAIT_V(0);
    PG9_BAR;
#undef PG9_SA
#undef PG9_SB
#undef PG9_STAGE
#undef PG9_LDA
#undef PG9_LDB
#undef PG9_MMA
#undef PG9_WAIT_V
#undef PG9_WAIT_L
#undef PG9_BAR
#undef PG9_SCHED
}
}
#define GAS __attribute__((address_space(1)))
#define LAS __attribute__((address_space(3)))
typedef unsigned short bf16;
typedef unsigned v4u __attribute__((ext_vector_type(4)));
typedef float f32x4 __attribute__((ext_vector_type(4)));
typedef short bf16x8 __attribute__((ext_vector_type(8)));
typedef GAS unsigned gu32;
typedef GAS unsigned long long gu64;
#define RLX_AGENT __ATOMIC_RELAXED, __HIP_MEMORY_SCOPE_AGENT
#define LDS_WAIT() asm volatile("s_waitcnt lgkmcnt(0)" ::: "memory")
#define VM_WAIT() asm volatile("s_waitcnt vmcnt(0)" ::: "memory")
__device__ __forceinline__ unsigned long long rt() { return __builtin_amdgcn_s_memrealtime(); }
__device__ __forceinline__ unsigned f2bfu(float f) { unsigned u = __builtin_bit_cast(unsigned, f); return (u + 0x7fffu + ((u >> 16) & 1u)) >> 16; }
__device__ __forceinline__ unsigned pk2(float lo, float hi) { return f2bfu(lo) | (f2bfu(hi) << 16); }
#define XB_TMO      128
#define XB_XCNT(j)  (256  + 64 * (j))
#define XB_XSUB(j)  (1280 + 64 * (j))
#define XB_XGEN(j)  (2304 + 64 * (j))
#define XB_TOP      3328
#define XB_TOPGEN   3392
#define XCD_BAR_WORDS 3456
#define XB_SPIN_CAP (1u << 18)

__device__ __forceinline__ unsigned xb_ld(unsigned* p)              { return __hip_atomic_load(p, __ATOMIC_RELAXED, __HIP_MEMORY_SCOPE_AGENT); }
__device__ __forceinline__ unsigned xb_add(unsigned* p, unsigned v) { return __hip_atomic_fetch_add(p, v, __ATOMIC_RELAXED, __HIP_MEMORY_SCOPE_AGENT); }
__device__ __forceinline__ unsigned xb_xcc_id() { return (unsigned)__builtin_amdgcn_s_getreg((3 << 11) | 20) & 0xFu; }
#define XB_SPIN(cond, bar) do { unsigned _sp = 0; while (cond) { __builtin_amdgcn_s_sleep(1); \
    if ((++_sp & 255u) == 0u) { if (xb_ld(&(bar)[XB_TMO])) break; if (_sp > XB_SPIN_CAP) { atomicAdd(&(bar)[XB_TMO], 1u); break; } } } } while (0)

struct XcdBarrier {
    unsigned* bar; unsigned x;
    volatile LAS unsigned* st;
};

__device__ __forceinline__ XcdBarrier xcd_barrier_post(unsigned* bar, volatile LAS unsigned* st) {
    XcdBarrier b; b.bar = bar; b.x = xb_xcc_id(); b.st = st;
    if (threadIdx.x == 0) (void)xb_add(&bar[XB_XCNT(b.x)], 1u);
    return b;
}
__device__ __forceinline__ void xcd_barrier_complete(unsigned* bar, unsigned x, unsigned& nloc, unsigned& nx) {
    const unsigned G = gridDim.x * gridDim.y * gridDim.z;
    unsigned sum, cnt, mine, sp = 0u;
    for (;;) {
        sum = 0u; cnt = 0u; mine = 0u;
#pragma unroll
        for (unsigned j = 0; j < 16; ++j) { const unsigned c = xb_ld(&bar[XB_XCNT(j)]); sum += c; cnt += (c > 0u) ? 1u : 0u; mine = (j == x) ? c : mine; }
        if (sum == G) break;
        __builtin_amdgcn_s_sleep(1);
        if ((++sp & 255u) == 0u) { if (xb_ld(&bar[XB_TMO])) break; if (sp > XB_SPIN_CAP) { atomicAdd(&bar[XB_TMO], 1u); break; } }
    }
    nloc = mine > 0u ? mine : 1u; nx = cnt > 0u ? cnt : 1u;
}

__device__ __forceinline__ void xcd_barrier(const XcdBarrier& b) {
    asm volatile("s_waitcnt vmcnt(0)" ::: "memory");
    __syncthreads();
    if (threadIdx.x == 0) {
        unsigned* bar = b.bar;
        __builtin_amdgcn_s_waitcnt(0);
        unsigned nloc = b.st[0], nx = b.st[1];
        if (nloc == 0u) { xcd_barrier_complete(bar, b.x, nloc, nx); b.st[0] = nloc; b.st[1] = nx; }
        const unsigned old = xb_add(&bar[XB_XSUB(b.x)], 1u);
        const unsigned gen = old / nloc;
        if (old + 1u == (gen + 1u) * nloc) {
            __builtin_amdgcn_fence(__ATOMIC_RELEASE, "agent");
            asm volatile("s_waitcnt vmcnt(0)" ::: "memory");
            const unsigned og = xb_add(&bar[XB_TOP], 1u);
            const unsigned tg = og / nx;
            if (og + 1u == (tg + 1u) * nx) xb_add(&bar[XB_TOPGEN], 1u);
            else XB_SPIN(xb_ld(&bar[XB_TOPGEN]) == tg, bar);
            __builtin_amdgcn_fence(__ATOMIC_ACQUIRE, "agent");
            xb_add(&bar[XB_XGEN(b.x)], 1u);
            asm volatile("s_waitcnt vmcnt(0)" ::: "memory");
        } else {
            XB_SPIN(xb_ld(&bar[XB_XGEN(b.x)]) == gen, bar);
            __builtin_amdgcn_fence(__ATOMIC_ACQUIRE, "agent");
            asm volatile("s_waitcnt vmcnt(0)" ::: "memory");
        }
    }
    __syncthreads();
}
constexpr int NWAVES = 8;
constexpr int RING_OFF = 0, RING_BYTES = 131072;
constexpr int LDSCTL_OFF = RING_BYTES, MISC_OFF = LDSCTL_OFF + 320;
constexpr int LDS_BYTES = 147456;
constexpr int CW_BAR = 4096;
constexpr int CW_KMEAN = 32768;
constexpr int CW_MEMKSS = 65536;
static_assert((CW_MEMKSS + 4096) * 4 <= (int)MiB && CW_BAR + 4 * 3456 <= CW_KMEAN, "ctl map");

struct Frame {
    LAS unsigned char* lds; volatile LAS unsigned* MISC; gu32* ctl;
    int tid, lane, wave, vcu, G;
    unsigned char* ws; float* out;
};
__device__ __forceinline__ float wave_sum64(float v) {
#pragma unroll
    for (int o = 1; o < 64; o <<= 1) v += __shfl_xor(v, o);
    return v;
}
template <bool HEADPERM> __device__ __forceinline__ void p0_transpose_item(const float* W, int K, int N, bf16* WT, int row_off, LAS float* scr, int item, int lane) {
    const int nblk = N / 32, kb = item / nblk, nb = item % nblk, k0 = 64 * kb, n0 = 32 * nb;
    int p0 = n0; if (HEADPERM) { const int lg = (n0 >> 5) & 7; p0 = (n0 & ~255) + 32 * (4 * (lg & 1) + (lg >> 1)); }
#pragma unroll 8
    for (int i = 0; i < 32; ++i) { const int kk = 2 * i + (lane >> 5); scr[kk * 33 + (lane & 31)] = W[(size_t)(k0 + kk) * N + n0 + (lane & 31)]; }
    LDS_WAIT(); asm volatile("" ::: "memory");
    const int c = lane & 7;
#pragma unroll
    for (int j = 0; j < 4; ++j) { const int n = (lane >> 3) + 8 * j; const LAS float* s = scr + (8 * c) * 33 + n;
        v4u o; o.x = pk2(s[0 * 33], s[1 * 33]); o.y = pk2(s[2 * 33], s[3 * 33]); o.z = pk2(s[4 * 33], s[5 * 33]); o.w = pk2(s[6 * 33], s[7 * 33]);
        *(GAS v4u*)(WT + (size_t)(row_off + p0 + n) * K + k0 + 8 * c) = o; }
    LDS_WAIT(); asm volatile("" ::: "memory");
}
__device__ __forceinline__ void rms_row_to_bf16(int lane, const float* xrow, const float* g, bf16* orow) {
    const GAS f32x4* xr = (const GAS f32x4*)xrow + lane; const GAS f32x4* gr = (const GAS f32x4*)g + lane;
    f32x4 v[4]; float s = 0.f;
#pragma unroll
    for (int j = 0; j < 4; ++j) { v[j] = xr[64 * j]; s += (v[j].x * v[j].x + v[j].y * v[j].y) + (v[j].z * v[j].z + v[j].w * v[j].w); }
    const float r = 1.f / sqrtf(wave_sum64(s) * (1.f / 1024.f) + 1e-5f);
    GAS unsigned long long* o8 = (GAS unsigned long long*)orow + lane;
#pragma unroll
    for (int j = 0; j < 4; ++j) { const f32x4 gg = gr[64 * j]; o8[64 * j] = (unsigned long long)pk2(v[j].x * r * gg.x, v[j].y * r * gg.y) | ((unsigned long long)pk2(v[j].z * r * gg.z, v[j].w * r * gg.w) << 32); }
}
struct Args { const float* in[23]; float* out; unsigned char* ws; int ph_lo, ph_hi, li, pad; };
__device__ __forceinline__ void p0_prologue(Frame& F, const Args& A) {
    LAS float* scr = (LAS float*)(F.lds + RING_OFF + F.wave * 16384);
    const int gw = F.vcu * NWAVES + F.wave, NGW = F.G * NWAVES;
    constexpr int I_IN = 16 * (DIN / 32), I_MKV = 16 * 32, I_BR = 8 * 32, I_OUT = 16 * 32, I_W1 = 16 * 64, I_W2 = 16 * 32;
    constexpr int NITEMS = I_IN + I_MKV + 3 * I_BR + I_OUT + NEXP * (I_W1 + I_W2);
    for (int it = gw; it < NITEMS; it += NGW) {
        int r = it;
        if (r < I_IN) { p0_transpose_item<true>(A.in[3], 1024, DIN, (bf16*)(F.ws + WS_WIN), 0, scr, r, F.lane); continue; } r -= I_IN;
        if (r < I_MKV) { p0_transpose_item<true>(A.in[9], 1024, 1024, (bf16*)(F.ws + WS_WMEMKV), 0, scr, r, F.lane); continue; } r -= I_MKV;
        if (r < 3 * I_BR) { const int w = r / I_BR; p0_transpose_item<false>(w == 0 ? A.in[12] : (w == 1 ? A.in[13] : A.in[14]), 512, 1024, (bf16*)(F.ws + WS_WBR) + (size_t)w * 1024 * 512, 0, scr, r % I_BR, F.lane); continue; } r -= 3 * I_BR;
        if (r < I_OUT) { p0_transpose_item<false>(A.in[15], 1024, 1024, (bf16*)(F.ws + WS_WOUT), 0, scr, r, F.lane); continue; } r -= I_OUT;
        if (r < NEXP * I_W1) { const int e = r / I_W1; p0_transpose_item<false>(A.in[19] + (size_t)e * 1024 * 2048, 1024, 2048, (bf16*)(F.ws + WS_W1) + (size_t)e * 2048 * 1024, 0, scr, r % I_W1, F.lane); continue; } r -= NEXP * I_W1;
        { const int e = r / I_W2; p0_transpose_item<false>(A.in[21] + (size_t)e * 1024 * 1024, 1024, 1024, (bf16*)(F.ws + WS_W2) + (size_t)e * 1024 * 1024, 0, scr, r % I_W2, F.lane); }
    }
    if (gw == 0) { ((float*)(F.ws + WS_GTAB))[F.lane] = A.in[6][F.lane]; ((float*)(F.ws + WS_GTAB))[64 + F.lane] = A.in[7][F.lane]; }
    for (int m = gw; m < NTOK; m += NGW) rms_row_to_bf16(F.lane, A.in[0] + (size_t)m * DM, A.in[2], (bf16*)(F.ws + WS_HB) + (size_t)m * DM);
    for (int m = gw; m < NB * MEMLEN; m += NGW) rms_row_to_bf16(F.lane, A.in[1] + (size_t)m * DM, A.in[8], (bf16*)(F.ws + WS_HM) + (size_t)m * DM);
}

struct P1Order {
    pg8::StaticOrder so; int G, c;
    __device__ void init(int G_, int c_) { so.init(NTOK, DIN, G_, 0); G = G_; c = c_; }
    __device__ bool next(int i, pg8::Unit& u) const {
        long L = (long)i * G + c;
        if (L < 1664) { pg8::StaticOrder t = so; t.G = 1; t.c = 0; return t.next((int)L, u); }
        L -= 1664; if (L >= 16) return false;
        u.pm = 64 + (int)(L >> 2); u.pn = 26 + (int)(L & 3); return true;
    }
    __device__ __forceinline__ void a_ready(const pg8::Unit&) const {}
    __device__ __forceinline__ void done(const pg8::Unit&) const {}
};
__device__ __forceinline__ float sigmoid_f(float x) { return __builtin_amdgcn_rcpf(1.f + __expf(-x)); }
typedef float f32x2_t __attribute__((ext_vector_type(2))); typedef __bf16 bf16x2_t __attribute__((ext_vector_type(2)));
__device__ __forceinline__ unsigned cvt_pk_bf16(float lo, float hi) { f32x2_t v = {lo, hi}; bf16x2_t b = __builtin_convertvector(v, bf16x2_t); return __builtin_bit_cast(unsigned, b); }
struct EpiP1 {
    static constexpr bool PERM = true, AFTER_DRAIN = false;
    unsigned char* ws; const float* b_gate; const float* gtab; float* KMEAN; float* MEMKSS;
    __device__ __forceinline__ void operator()(const pg8::f32x4 (&acc)[2][2][4][2], const pg8::Unit& u, int wr, int wc, int fr, int fq) const {
        using pg8::f32x4; using pg8::u32x4;
        const int pn = u.pn; int type, ldc, cb; size_t off; int row0 = u.pm * 256;
        if (pn == 0) { type = 0; off = WS_RQ; ldc = 256; cb = 0; }
        else if (pn == 1) { type = 1; off = WS_RK; ldc = 256; cb = 0; }
        else if (pn < 4) { type = 0; off = WS_RV; ldc = 512; cb = (pn - 2) * 256; }
        else if (pn < 6) { type = 2; off = WS_RG; ldc = 512; cb = (pn - 4) * 256; }
        else if (pn < 8) { type = 3; off = WS_MQ; ldc = 512; cb = (pn - 6) * 256; }
        else if (pn < 10) { type = 4; off = WS_MK; ldc = 512; cb = (pn - 8) * 256; }
        else if (pn < 12) { type = 0; off = WS_MV; ldc = 512; cb = (pn - 10) * 256; }
        else if (pn < 14) { type = 0; off = WS_CQ; ldc = 512; cb = (pn - 12) * 256; }
        else if (pn < 26) { type = 5; off = WS_GT; ldc = 3072; cb = (pn - 14) * 256; }
        else if (pn < 28) { type = 6; off = WS_MEMK; ldc = 512; cb = (pn - 26) * 256; row0 = (u.pm - 64) * 256; }
        else { type = 0; off = WS_MEMV; ldc = 512; cb = (pn - 28) * 256; row0 = (u.pm - 64) * 256; }
        bf16_t* base = (bf16_t*)(ws + off) + cb + 64 * wc + 8 * fq;
        const int rbase = row0 + 64 * wr + fr;
#define P1_STORE(rowp, bj, v0, v1) do { u32x4 w_; w_.x = cvt_pk_bf16((v0)[0], (v0)[1]); w_.y = cvt_pk_bf16((v0)[2], (v0)[3]); w_.z = cvt_pk_bf16((v1)[0], (v1)[1]); w_.w = cvt_pk_bf16((v1)[2], (v1)[3]); *(u32x4*)((rowp) + 32 * (bj)) = w_; } while (0)
        if (type <= 1) {
            const float sc = type == 1 ? 0.125f : 1.f;
#pragma unroll
            for (int ai = 0; ai < 2; ++ai)
#pragma unroll
                for (int m = 0; m < 4; ++m) { bf16_t* rowp = base + (size_t)(rbase + 128 * ai + 16 * m) * ldc;
#pragma unroll
                    for (int bj = 0; bj < 2; ++bj) { const f32x4 v0 = acc[ai][bj][m][0] * sc, v1 = acc[ai][bj][m][1] * sc; P1_STORE(rowp, bj, v0, v1); } }
        } else if (type == 2) {
#pragma unroll
            for (int ai = 0; ai < 2; ++ai)
#pragma unroll
                for (int m = 0; m < 4; ++m) { bf16_t* rowp = base + (size_t)(rbase + 128 * ai + 16 * m) * ldc;
#pragma unroll
                    for (int bj = 0; bj < 2; ++bj) { f32x4 v0 = acc[ai][bj][m][0], v1 = acc[ai][bj][m][1];
#pragma unroll
                        for (int j = 0; j < 4; ++j) { v0[j] = v0[j] * sigmoid_f(v0[j]); v1[j] = v1[j] * sigmoid_f(v1[j]); }
                        P1_STORE(rowp, bj, v0, v1); } }
        } else if (type == 5) {
            f32x4 bv[2][2];
#pragma unroll
            for (int bj = 0; bj < 2; ++bj)
#pragma unroll
                for (int n = 0; n < 2; ++n) bv[bj][n] = *(const f32x4*)(b_gate + cb + 64 * wc + 32 * bj + 8 * fq + 4 * n);
#pragma unroll
            for (int ai = 0; ai < 2; ++ai)
#pragma unroll
                for (int m = 0; m < 4; ++m) { bf16_t* rowp = base + (size_t)(rbase + 128 * ai + 16 * m) * ldc;
#pragma unroll
                    for (int bj = 0; bj < 2; ++bj) { f32x4 v0 = acc[ai][bj][m][0] + bv[bj][0], v1 = acc[ai][bj][m][1] + bv[bj][1];
#pragma unroll
                        for (int j = 0; j < 4; ++j) { v0[j] = sigmoid_f(v0[j]); v1[j] = sigmoid_f(v1[j]); }
                        P1_STORE(rowp, bj, v0, v1); } }
        } else if (type == 6) {
#pragma unroll
            for (int ai = 0; ai < 2; ++ai)
#pragma unroll
                for (int m = 0; m < 4; ++m) { const int row = rbase + 128 * ai + 16 * m; bf16_t* rowp = base + (size_t)row * ldc; float ss = 0.f;
#pragma unroll
                    for (int bj = 0; bj < 2; ++bj) { const f32x4 v0 = acc[ai][bj][m][0], v1 = acc[ai][bj][m][1];
                        ss += (v0[0] * v0[0] + v0[1] * v0[1]) + (v0[2] * v0[2] + v0[3] * v0[3]) + (v1[0] * v1[0] + v1[1] * v1[1]) + (v1[2] * v1[2] + v1[3] * v1[3]);
                        P1_STORE(rowp, bj, v0, v1); }
                    ss += __shfl_xor(ss, 16); ss += __shfl_xor(ss, 32);
                    if (fq == 0) atomicAdd(MEMKSS + (size_t)row * 4 + (cb >> 7) + (wc >> 1), ss);
                    }
        } else {
            const float* g = gtab + (type == 3 ? 0 : 64);
            f32x4 gv[2][2]; float rr[2][4];
#pragma unroll
            for (int bj = 0; bj < 2; ++bj)
#pragma unroll
                for (int n = 0; n < 2; ++n) gv[bj][n] = *(const f32x4*)(g + 32 * bj + 8 * fq + 4 * n);
#pragma unroll
            for (int ai = 0; ai < 2; ++ai)
#pragma unroll
                for (int m = 0; m < 4; ++m) { bf16_t* rowp = base + (size_t)(rbase + 128 * ai + 16 * m) * ldc; float ss = 0.f;
#pragma unroll
                    for (int bj = 0; bj < 2; ++bj) { const f32x4 v0 = acc[ai][bj][m][0], v1 = acc[ai][bj][m][1];
                        ss += (v0[0] * v0[0] + v0[1] * v0[1]) + (v0[2] * v0[2] + v0[3] * v0[3]) + (v1[0] * v1[0] + v1[1] * v1[1]) + (v1[2] * v1[2] + v1[3] * v1[3]); }
                    ss += __shfl_xor(ss, 16); ss += __shfl_xor(ss, 32);
                    const float r = (1.f / sqrtf(ss * (1.f / 64.f) + 1e-5f)) * (type == 3 ? 0.18033688011112042f : 1.f); rr[ai][m] = r;
#pragma unroll
                    for (int bj = 0; bj < 2; ++bj) { const f32x4 v0 = acc[ai][bj][m][0] * r * gv[bj][0], v1 = acc[ai][bj][m][1] * r * gv[bj][1];
                        P1_STORE(rowp, bj, v0, v1); }
                    asm volatile("" ::: "memory"); }
            if (type == 4) {
                float* km = KMEAN + ((size_t)u.pm * 8 + (cb >> 6) + wc) * 64 + 8 * fq;
#pragma unroll
                for (int bj = 0; bj < 2; ++bj)
#pragma unroll
                    for (int n = 0; n < 2; ++n)
#pragma unroll
                        for (int j = 0; j < 4; ++j) { float s = 0.f;
#pragma unroll
                            for (int ai = 0; ai < 2; ++ai)
#pragma unroll
                                for (int m = 0; m < 4; ++m) s += acc[ai][bj][m][n][j] * rr[ai][m];
                            s += __shfl_xor(s, 1); s += __shfl_xor(s, 2); s += __shfl_xor(s, 4); s += __shfl_xor(s, 8);
                            if (fr == 0) atomicAdd(km + 32 * bj + 4 * n + j, s * gv[bj][n][j] * (1.f / 256.f)); }
            }
        }
#undef P1_STORE
    }
};

constexpr int TB_OFF = LDSCTL_OFF + 1024;
__device__ __forceinline__ unsigned cvt_pk(float lo, float hi) { return cvt_pk_bf16(lo, hi); }

struct P3Order {
    pg8::StaticOrder so; int G, c; const unsigned char* ws;
    __device__ void init(int G_, int c_, const unsigned char* ws_) { so.init(NTOK, 1024, 1, 0); G = G_; c = c_; ws = ws_; }
    __device__ bool next(int i, pg9::Unit& u) const {
        const int tl = (i / 3) * G + c; if (tl >= 256) return false; pg8::Unit t; so.next(tl, t); u.pm = t.pm; u.pn = t.pn; u.aux = i % 3; u.cnt = 256; return true; }
    __device__ __forceinline__ const char* a_base(const pg9::Unit& u) const { return (const char*)(ws + WS_ORET) + (size_t)u.aux * (WS_OMOBA - WS_ORET) + (size_t)u.pm * 256 * 512 * 2; }
    __device__ __forceinline__ const char* b_base(const pg9::Unit& u) const { return (const char*)(ws + WS_WBR) + (size_t)u.aux * 1024 * 512 * 2 + (size_t)u.pn * 256 * 512 * 2; }
};
struct EpiP3 {
    static constexpr bool PERM = true, CHAIN = true;
    const bf16_t* GT; bf16_t* Y;
    __device__ __forceinline__ bool chain_more(const pg9::Unit& u) const { return u.aux < 2; }
    __device__ __forceinline__ void rescale(pg8::f32x4 (&acc)[2][2][4][2], const pg9::Unit& u, int wr, int wc, int fr, int fq) const {
        const int s = u.aux;
#pragma unroll
        for (int ai = 0; ai < 2; ++ai)
#pragma unroll
            for (int m = 0; m < 4; ++m) { const bf16_t* gp = GT + (size_t)(u.pm * 256 + 128 * ai + 64 * wr + 16 * m + fr) * 3072 + s * 1024 + u.pn * 256 + 32 * wc + 8 * fq;
#pragma unroll
                for (int bj = 0; bj < 2; ++bj) { const pg8::u32x4 ga = *(const pg8::u32x4*)(gp + 128 * bj), gb = *(const pg8::u32x4*)(gp + 1024 + 128 * bj);
#pragma unroll
                    for (int n = 0; n < 2; ++n)
#pragma unroll
                        for (int j = 0; j < 4; ++j) { const int e = 4 * n + j; const unsigned wa = ga[e >> 1], wb = gb[e >> 1];
                            const float fa = __uint_as_float((e & 1) ? (wa & 0xffff0000u) : (wa << 16)), fb = __uint_as_float((e & 1) ? (wb & 0xffff0000u) : (wb << 16));
                            acc[ai][bj][m][n][j] *= fa * __builtin_amdgcn_rcpf(fmaxf(fb, 1e-20f)); } }
                asm volatile("" ::: "memory"); }
    }
    __device__ __forceinline__ void operator()(const pg8::f32x4 (&acc)[2][2][4][2], const pg9::Unit& u, int wr, int wc, int fr, int fq) const {
#pragma unroll
        for (int ai = 0; ai < 2; ++ai)
#pragma unroll
            for (int m = 0; m < 4; ++m) { const size_t row = (size_t)(u.pm * 256 + 128 * ai + 64 * wr + 16 * m + fr); const bf16_t* gp = GT + row * 3072 + 2048 + u.pn * 256 + 32 * wc + 8 * fq; bf16_t* yp = Y + row * 1024 + u.pn * 256 + 32 * wc + 8 * fq;
#pragma unroll
                for (int bj = 0; bj < 2; ++bj) { const pg8::u32x4 ga = *(const pg8::u32x4*)(gp + 128 * bj); float v[8];
#pragma unroll
                    for (int n = 0; n < 2; ++n)
#pragma unroll
                        for (int j = 0; j < 4; ++j) { const int e = 4 * n + j; const unsigned wa = ga[e >> 1]; v[e] = acc[ai][bj][m][n][j] * __uint_as_float((e & 1) ? (wa & 0xffff0000u) : (wa << 16)); }
                    pg8::u32x4 w; w.x = cvt_pk(v[0], v[1]); w.y = cvt_pk(v[2], v[3]); w.z = cvt_pk(v[4], v[5]); w.w = cvt_pk(v[6], v[7]); *(pg8::u32x4*)(yp + 128 * bj) = w; }
                asm volatile("" ::: "memory"); }
    }
};
struct P4Order {
    pg8::StaticOrder so; int G, c; const unsigned char* ws;
    __device__ void init(int G_, int c_, const unsigned char* ws_) { so.init(NTOK, 1024, 1, 0); G = G_; c = c_; ws = ws_; }
    __device__ bool next(int i, pg9::Unit& u) const { const int tl = i * G + c; if (tl >= 256) return false; pg8::Unit t; so.next(tl, t); u.pm = t.pm; u.pn = t.pn; u.aux = 0; u.cnt = 256; return true; }
    __device__ __forceinline__ const char* a_base(const pg9::Unit& u) const { return (const char*)(ws + WS_Y) + (size_t)u.pm * 256 * 1024 * 2; }
    __device__ __forceinline__ const char* b_base(const pg9::Unit& u) const { return (const char*)(ws + WS_WOUT) + (size_t)u.pn * 256 * 1024 * 2; }
};
struct EpiP4 {
    static constexpr bool PERM = false, CHAIN = false;
    const float* x; float* out;
    __device__ __forceinline__ void operator()(const pg8::f32x4 (&acc)[2][2][4][2], const pg9::Unit& u, int wr, int wc, int fr, int fq) const {
#pragma unroll
        for (int ai = 0; ai < 2; ++ai)
#pragma unroll
            for (int m = 0; m < 4; ++m) { const size_t off = (size_t)(u.pm * 256 + 128 * ai + 64 * wr + 16 * m + fr) * 1024 + u.pn * 256 + 32 * wc + 4 * fq;
#pragma unroll
                for (int bj = 0; bj < 2; ++bj)
#pragma unroll
                    for (int n = 0; n < 2; ++n) { const pg8::f32x4 xv = *(const pg8::f32x4*)(x + off + 128 * bj + 16 * n); *(pg8::f32x4*)(out + off + 128 * bj + 16 * n) = xv + acc[ai][bj][m][n]; }
                if (m & 1) asm volatile("" ::: "memory"); }
    }
};
__device__ __forceinline__ float wave_max64(float v) {
#pragma unroll
    for (int o = 1; o < 64; o <<= 1) v = fmaxf(v, __shfl_xor(v, o));
    return v;
}
__device__ __forceinline__ void p5_router(Frame& F, const float* X1, const float* g_ffn, const float* w_router, const float* b_router) {
    bf16_t* XT = (bf16_t*)(F.ws + WS_XT); int* TOPE = (int*)(F.ws + WS_TOPE); float* TOPW = (float*)(F.ws + WS_TOPW); int* COUNTS = (int*)F.ctl + CW_COUNTS; int* LISTS = (int*)(F.ws + WS_LISTS);
    const int gw = F.vcu * NWAVES + F.wave, NGW = F.G * NWAVES, lane = F.lane;
    for (int t = gw; t < NTOK; t += NGW) {
        const float* xr = X1 + (size_t)t * 1024; float v[16]; float s = 0.f;
#pragma unroll
        for (int j = 0; j < 16; ++j) { v[j] = xr[lane + 64 * j]; s += v[j] * v[j]; }
        const float r = 1.f / sqrtf(wave_sum64(s) * (1.f / 1024.f) + 1e-5f);
#pragma unroll
        for (int j = 0; j < 16; ++j) { v[j] = v[j] * r * g_ffn[lane + 64 * j]; XT[(size_t)t * 1024 + lane + 64 * j] = f2bf(v[j]); }
        float lg = -INFINITY;
        for (int e = 0; e < 32; ++e) { float p = 0.f;
#pragma unroll
            for (int j = 0; j < 16; ++j) p += v[j] * w_router[(size_t)(lane + 64 * j) * 32 + e];
            p = wave_sum64(p); if (lane == e) lg = p + b_router[e]; }
        float tv[4]; int te[4];
#pragma unroll
        for (int k = 0; k < 4; ++k) { const float m = wave_max64(lg); const unsigned long long bal = __ballot(lg == m); const int e = __ffsll((long long)bal) - 1; tv[k] = m; te[k] = e; if (lane == e) lg = -INFINITY; }
        float ex[4], se = 0.f;
#pragma unroll
        for (int k = 0; k < 4; ++k) { ex[k] = __expf(tv[k] - tv[0]); se += ex[k]; }
        int e_l = te[0]; float w_l = ex[0];
#pragma unroll
        for (int k = 1; k < 4; ++k) if (lane == k) { e_l = te[k]; w_l = ex[k]; }
        if (lane < 4) { TOPE[t * 4 + lane] = e_l; TOPW[t * 4 + lane] = w_l / se; const int pos = atomicAdd(&COUNTS[e_l], 1); LISTS[(size_t)e_l * 16384 + pos] = t * 4 + lane; }
    }
}
__device__ __forceinline__ void moe_tables(Frame& F) {
    volatile LAS int* TB = (volatile LAS int*)(F.lds + TB_OFF);
    if (F.tid == 0) { const int* COUNTS = (const int*)F.ctl + CW_COUNTS; int acc = 0; for (int e = 0; e < 32; ++e) { const int c = __hip_atomic_load(COUNTS + e, __ATOMIC_RELAXED, __HIP_MEMORY_SCOPE_AGENT); TB[e] = acc; TB[33 + e] = c; acc += (c + 255) >> 8; } TB[32] = acc; }
    __syncthreads();
}
template <int NPN_LOG2, size_t WOFF, int NROWS_B, int ASHIFT, size_t AOFF> struct MoeOrder {
    int G, c; const unsigned char* ws; const LAS int* TB; const int* LISTS;
    __device__ void init(int G_, int c_, const unsigned char* ws_, const LAS int* TB_) { G = G_; c = c_; ws = ws_; TB = TB_; LISTS = (const int*)(ws_ + WS_LISTS); }
    __device__ bool next(int i, pg9::Unit& u) const {
        const int L = i * G + c; const int mt = L >> NPN_LOG2; if (mt >= TB[32]) return false;
        int e = 0;
#pragma unroll 1
        for (int k = 16; k >= 1; k >>= 1) if (TB[e + k] <= mt) e += k;
        u.aux = e; u.pm = mt - TB[e]; u.pn = L & ((1 << NPN_LOG2) - 1); u.cnt = TB[33 + e] - u.pm * 256; return true;
    }
    __device__ __forceinline__ const char* a_base(const pg9::Unit&) const { return (const char*)(ws + AOFF); }
    __device__ __forceinline__ const char* b_base(const pg9::Unit& u) const { return (const char*)(ws + WOFF) + ((size_t)u.aux * NROWS_B + (size_t)u.pn * 256) * 1024 * 2; }
    __device__ __forceinline__ unsigned a_row_off(const pg9::Unit& u, int r) const { const int rr = r < u.cnt ? r : u.cnt - 1; const int id = LISTS[(size_t)u.aux * 16384 + u.pm * 256 + rr]; return (unsigned)(id >> ASHIFT) * 2048u; }
};
struct EpiMoe1 {
    static constexpr bool PERM = true, CHAIN = false;
    const int* LISTS; const float* b1; bf16_t* ACT;
    __device__ __forceinline__ void operator()(const pg8::f32x4 (&acc)[2][2][4][2], const pg9::Unit& u, int wr, int wc, int fr, int fq) const {
        const int e = u.aux; const int c0 = u.pn * 256 + 32 * wc + 8 * fq;
        pg8::f32x4 bv[2][2];
#pragma unroll
        for (int bj = 0; bj < 2; ++bj)
#pragma unroll
            for (int n = 0; n < 2; ++n) bv[bj][n] = *(const pg8::f32x4*)(b1 + (size_t)e * 2048 + c0 + 128 * bj + 4 * n);
#pragma unroll
        for (int ai = 0; ai < 2; ++ai)
#pragma unroll
            for (int m = 0; m < 4; ++m) { const int r = 128 * ai + 64 * wr + 16 * m + fr; const bool ok = r < u.cnt; const int id = ok ? LISTS[(size_t)e * 16384 + u.pm * 256 + r] : 0;
#pragma unroll
                for (int bj = 0; bj < 2; ++bj) { float a[4];
#pragma unroll
                    for (int n = 0; n < 2; ++n)
#pragma unroll
                        for (int p = 0; p < 2; ++p) { const float gl = fminf(acc[ai][bj][m][n][2 * p] + bv[bj][n][2 * p], 7.0f); const float li = fminf(fmaxf(acc[ai][bj][m][n][2 * p + 1] + bv[bj][n][2 * p + 1], -7.0f), 7.0f);
                            a[2 * n + p] = gl * sigmoid_f(1.702f * gl) * (li + 1.f); }
                    if (ok) { uint2 w; w.x = cvt_pk(a[0], a[1]); w.y = cvt_pk(a[2], a[3]); *(uint2*)(ACT + (size_t)id * 1024 + ((c0 + 128 * bj) >> 1)) = w; } }
                asm volatile("" ::: "memory"); }
    }
};
struct EpiMoe2 {
    static constexpr bool PERM = true, CHAIN = false;
    const int* LISTS; const float* b2; bf16_t* YS;
    __device__ __forceinline__ void operator()(const pg8::f32x4 (&acc)[2][2][4][2], const pg9::Unit& u, int wr, int wc, int fr, int fq) const {
        const int e = u.aux; const int c0 = u.pn * 256 + 32 * wc + 8 * fq;
        pg8::f32x4 bv[2][2];
#pragma unroll
        for (int bj = 0; bj < 2; ++bj)
#pragma unroll
            for (int n = 0; n < 2; ++n) bv[bj][n] = *(const pg8::f32x4*)(b2 + (size_t)e * 1024 + c0 + 128 * bj + 4 * n);
#pragma unroll
        for (int ai = 0; ai < 2; ++ai)
#pragma unroll
            for (int m = 0; m < 4; ++m) { const int r = 128 * ai + 64 * wr + 16 * m + fr; const bool ok = r < u.cnt; const int id = ok ? LISTS[(size_t)e * 16384 + u.pm * 256 + r] : 0;
#pragma unroll
                for (int bj = 0; bj < 2; ++bj) { const pg8::f32x4 v0 = acc[ai][bj][m][0] + bv[bj][0], v1 = acc[ai][bj][m][1] + bv[bj][1];
                    if (ok) { pg8::u32x4 w; w.x = cvt_pk(v0[0], v0[1]); w.y = cvt_pk(v0[2], v0[3]); w.z = cvt_pk(v1[0], v1[1]); w.w = cvt_pk(v1[2], v1[3]); *(pg8::u32x4*)(YS + (size_t)id * 1024 + c0 + 128 * bj) = w; } }
                asm volatile("" ::: "memory"); }
    }
};
__device__ __forceinline__ void p8_combine(Frame& F, float* out) {
    const bf16_t* YS = (const bf16_t*)(F.ws + WS_YS); const float* TOPW = (const float*)(F.ws + WS_TOPW);
    const int gw = F.vcu * NWAVES + F.wave, NGW = F.G * NWAVES, lane = F.lane;
    for (int t = gw; t < NTOK; t += NGW) {
        const f32x4 w4 = *(const f32x4*)(TOPW + (size_t)t * 4);
#pragma unroll
        for (int j = 0; j < 2; ++j) {
            const int c = 8 * lane + 512 * j; f32x4 a0 = *(const f32x4*)(out + (size_t)t * 1024 + c), a1 = *(const f32x4*)(out + (size_t)t * 1024 + c + 4);
#pragma unroll
            for (int k = 0; k < 4; ++k) { const v4u y = *(const v4u*)(YS + ((size_t)t * 4 + k) * 1024 + c); const float wk = w4[k];
                a0.x += wk * __uint_as_float(y.x << 16); a0.y += wk * __uint_as_float(y.x & 0xffff0000u); a0.z += wk * __uint_as_float(y.y << 16); a0.w += wk * __uint_as_float(y.y & 0xffff0000u);
                a1.x += wk * __uint_as_float(y.z << 16); a1.y += wk * __uint_as_float(y.z & 0xffff0000u); a1.z += wk * __uint_as_float(y.w << 16); a1.w += wk * __uint_as_float(y.w & 0xffff0000u); }
            *(f32x4*)(out + (size_t)t * 1024 + c) = a0; *(f32x4*)(out + (size_t)t * 1024 + c + 4) = a1; }
    }
}
namespace att {
typedef float f32x16 __attribute__((ext_vector_type(16)));
typedef short s16x4 __attribute__((ext_vector_type(4)));
typedef short v4i16_t __attribute__((ext_vector_type(4)));
using pg8::bf16x8;
constexpr float LOG2E = 1.4426950408889634f;
__device__ __forceinline__ constexpr int crow(int r, int hi) { return (r & 3) + 8 * (r >> 2) + 4 * hi; }
template <int D> __device__ __forceinline__ int kswz(int row) { return D == 64 ? ((row >> 1) & 7) : (row & 15); }
template <int D> __device__ __forceinline__ int vswz(int row) { return D == 64 ? (((row >> 1) & 1) << 2) : ((row & 3) << 2); }
__device__ __forceinline__ s16x4 vtr(const LAS unsigned char* p) { return __builtin_bit_cast(s16x4, __builtin_amdgcn_ds_read_tr16_b64_v4i16((LAS v4i16_t*)p)); }
__device__ __forceinline__ bf16x8 pack8(const f32x16& x, int s) {
    typedef unsigned u32x4_t __attribute__((ext_vector_type(4))); u32x4_t p;
    p[0] = cvt_pk_bf16(x[8 * s + 0], x[8 * s + 1]); p[1] = cvt_pk_bf16(x[8 * s + 2], x[8 * s + 3]); p[2] = cvt_pk_bf16(x[8 * s + 4], x[8 * s + 5]); p[3] = cvt_pk_bf16(x[8 * s + 6], x[8 * s + 7]);
    return __builtin_bit_cast(bf16x8, p);
}
__device__ __forceinline__ float bfl(unsigned w) { return __uint_as_float(w << 16); }
__device__ __forceinline__ float bfh(unsigned w) { return __uint_as_float(w & 0xffff0000u); }

template <bool MOBA> __device__ __forceinline__ int tile_kbase(int tt, int qb) { if (!MOBA) return 64 * tt; if (tt < 4) return qb * 256 + 64 * tt; const int u = tt - 4; return (u >> 2) * 256 + 64 * (u & 3); }
template <int D, bool MOBA>
__device__ __forceinline__ void attn_unit(Frame& F, const int b, const int h, const int qb,
                                          const bf16_t* Qg, const bf16_t* Kg, const bf16_t* Vg, bf16_t* Og, const int ld,
                                          const float* KMEAN, const float* KSS, const float* gq, const float* gk) {
    constexpr int KB = 64 * D * 2, NKS = D / 16, NDH = D / 32, CPR = D / 8  , NST = (64 * CPR) / 512  ;
    int tid = F.tid, lane = F.lane; asm volatile("" : "+v"(tid), "+v"(lane));
    const int wave = F.wave, r32 = lane & 31, hi = lane >> 5;
    LAS unsigned char* lds = F.lds;
    const size_t qrow = (size_t)b * SEQ + qb * 256 + wave * 32 + r32;
    bf16x8 qr[NKS];
#pragma unroll
    for (int ks = 0; ks < NKS; ++ks) qr[ks] = *(const bf16x8*)(Qg + qrow * ld + h * D + 16 * ks + 8 * hi);
    unsigned selmask = 0u;
    if constexpr (MOBA) {
        if (qb > 0) {
            float qf[NKS * 8];
#pragma unroll
            for (int ks = 0; ks < NKS; ++ks) { const pg8::u32x4 w = __builtin_bit_cast(pg8::u32x4, qr[ks]);
#pragma unroll
                for (int j = 0; j < 4; ++j) { qf[ks * 8 + 2 * j] = bfl(w[j]); qf[ks * 8 + 2 * j + 1] = bfh(w[j]); } }
            float v0 = -INFINITY, v1 = -INFINITY, v2 = -INFINITY; int i0 = -1, i1 = -1, i2 = -1;
#pragma unroll 1
            for (int j = 0; j < qb; ++j) { const float* km = KMEAN + (((size_t)b * 16 + j) * 8 + h) * 64 + 8 * hi; float s = 0.f;
#pragma unroll
                for (int ks = 0; ks < NKS; ++ks) { const f32x4 k0 = *(const f32x4*)(km + 16 * ks), k1 = *(const f32x4*)(km + 16 * ks + 4);
                    s += qf[ks * 8 + 0] * k0[0] + qf[ks * 8 + 1] * k0[1] + qf[ks * 8 + 2] * k0[2] + qf[ks * 8 + 3] * k0[3] + qf[ks * 8 + 4] * k1[0] + qf[ks * 8 + 5] * k1[1] + qf[ks * 8 + 6] * k1[2] + qf[ks * 8 + 7] * k1[3]; }
                s += __shfl_xor(s, 32);
                const bool c0 = s > v0, c1 = s > v1, c2 = s > v2;
                v2 = c1 ? v1 : (c2 ? s : v2); i2 = c1 ? i1 : (c2 ? j : i2);
                v1 = c0 ? v0 : (c1 ? s : v1); i1 = c0 ? i0 : (c1 ? j : i1);
                v0 = c0 ? s : v0; i0 = c0 ? j : i0; }
            selmask = (i0 >= 0 ? (1u << i0) : 0u) | (i1 >= 0 ? (1u << i1) : 0u) | (i2 >= 0 ? (1u << i2) : 0u);
        }
    } else {
        float qf[NKS * 8]; float ss = 0.f;
#pragma unroll
        for (int ks = 0; ks < NKS; ++ks) { const pg8::u32x4 w = __builtin_bit_cast(pg8::u32x4, qr[ks]);
#pragma unroll
            for (int j = 0; j < 4; ++j) { qf[ks * 8 + 2 * j] = bfl(w[j]); qf[ks * 8 + 2 * j + 1] = bfh(w[j]); ss += qf[ks * 8 + 2 * j] * qf[ks * 8 + 2 * j] + qf[ks * 8 + 2 * j + 1] * qf[ks * 8 + 2 * j + 1]; } }
        ss += __shfl_xor(ss, 32);
        const float rq = (1.f / sqrtf(ss * (1.f / D) + 1e-5f)) * (0.08838834764831845f * LOG2E);
#pragma unroll
        for (int ks = 0; ks < NKS; ++ks) { const float* g1 = gq + 16 * ks + 8 * hi; const float* g2 = gk + 16 * ks + 8 * hi; pg8::u32x4 w;
#pragma unroll
            for (int j = 0; j < 4; ++j) w[j] = cvt_pk_bf16(qf[ks * 8 + 2 * j] * rq * g1[2 * j] * g2[2 * j], qf[ks * 8 + 2 * j + 1] * rq * g1[2 * j + 1] * g2[2 * j + 1]);
            qr[ks] = __builtin_bit_cast(bf16x8, w); }
    }
    const int NT = MOBA ? 4 * (qb + 1) : 4;
    const float sl2 = MOBA ? exp2f(-(float)(h + 1)) * LOG2E : 0.f;
    v4u kreg[NST], vreg[NST];
#define ATT_LOAD(tt) do { const int kb_ = tile_kbase<MOBA>(tt, qb); _Pragma("unroll") for (int i_ = 0; i_ < NST; ++i_) { const int ci_ = tid + 512 * i_, row_ = ci_ / CPR, ch_ = ci_ % CPR; \
        const size_t g_ = (size_t)(kb_ + row_) * ld + h * D + 8 * ch_; kreg[i_] = *(const v4u*)(Kg + g_); vreg[i_] = *(const v4u*)(Vg + g_); \
        if (!MOBA) { const float rk_ = 1.f / sqrtf(KSS[(size_t)(kb_ + row_) * 4 + h] * (1.f / D) + 1e-5f); v4u k_ = kreg[i_]; \
            k_.x = cvt_pk_bf16(bfl(k_.x) * rk_, bfh(k_.x) * rk_); k_.y = cvt_pk_bf16(bfl(k_.y) * rk_, bfh(k_.y) * rk_); k_.z = cvt_pk_bf16(bfl(k_.z) * rk_, bfh(k_.z) * rk_); k_.w = cvt_pk_bf16(bfl(k_.w) * rk_, bfh(k_.w) * rk_); kreg[i_] = k_; } } } while (0)
#define ATT_WRITE(buf) do { _Pragma("unroll") for (int i_ = 0; i_ < NST; ++i_) { const int ci_ = tid + 512 * i_, row_ = ci_ / CPR, ch_ = ci_ % CPR; \
        *(LAS v4u*)(lds + (buf) * KB + row_ * (2 * D) + ((ch_ ^ kswz<D>(row_)) << 4)) = kreg[i_]; *(LAS v4u*)(lds + (2 + (buf)) * KB + row_ * (2 * D) + ((ch_ ^ vswz<D>(row_)) << 4)) = vreg[i_]; } } while (0)
    ATT_LOAD(0); ATT_WRITE(0);
    __syncthreads();
    float m = -1e30f, l = 0.f;
    f32x16 o[NDH];
#pragma unroll
    for (int dh = 0; dh < NDH; ++dh)
#pragma unroll
        for (int r = 0; r < 16; ++r) o[dh][r] = 0.f;
    const int qrel = wave * 32 + r32;
    const int i16 = lane & 15, blk = (lane >> 4) & 1, tq = i16 >> 2, tp = i16 & 3;
    for (int tt = 0; tt < NT; ++tt) {
        const int buf = tt & 1;
        if (tt + 1 < NT) ATT_LOAD(tt + 1);
        bool act = true; bool lane_sel = true; int pblk = -1;
        if constexpr (MOBA) { if (tt >= 4) { pblk = (tt - 4) >> 2; lane_sel = (selmask >> pblk) & 1u; act = __builtin_amdgcn_ballot_w64(lane_sel) != 0ull; }
            else act = (64 * tt <= wave * 32 + 31); }
        if (act) {
            f32x16 p0, p1;
#pragma unroll
            for (int r = 0; r < 16; ++r) { p0[r] = 0.f; p1[r] = 0.f; }
            const LAS unsigned char* Kb = lds + buf * KB;
#pragma unroll
            for (int ks = 0; ks < NKS; ++ks) {
                const bf16x8 a0 = *(const LAS bf16x8*)(Kb + r32 * (2 * D) + (((2 * ks + hi) ^ kswz<D>(r32)) << 4));
                const bf16x8 a1 = *(const LAS bf16x8*)(Kb + (32 + r32) * (2 * D) + (((2 * ks + hi) ^ kswz<D>(32 + r32)) << 4));
                p0 = __builtin_amdgcn_mfma_f32_32x32x16_bf16(a0, qr[ks], p0, 0, 0, 0);
                p1 = __builtin_amdgcn_mfma_f32_32x32x16_bf16(a1, qr[ks], p1, 0, 0, 0);
            }
            if constexpr (MOBA) {
                const int kb = tile_kbase<MOBA>(tt, qb); const float offl = sl2 * (float)(kb - qb * 256 + 4 * hi);
#pragma unroll
                for (int r = 0; r < 16; ++r) { p0[r] += sl2 * (float)((r & 3) + 8 * (r >> 2)) + offl; p1[r] += sl2 * (float)(32 + (r & 3) + 8 * (r >> 2)) + offl; }
                if (tt < 4) {
                    const int k0 = 64 * tt + 4 * hi;
#pragma unroll
                    for (int r = 0; r < 16; ++r) { const int kv = k0 + (r & 3) + 8 * (r >> 2); if (kv > qrel) p0[r] = -INFINITY; if (kv + 32 > qrel) p1[r] = -INFINITY; }
                } else if (!lane_sel) {
#pragma unroll
                    for (int r = 0; r < 16; ++r) { p0[r] = -INFINITY; p1[r] = -INFINITY; }
                }
            }
            float mx = fmaxf(p0[0], p1[0]);
#pragma unroll
            for (int r = 1; r < 16; ++r) mx = fmaxf(mx, fmaxf(p0[r], p1[r]));
            mx = fmaxf(mx, __shfl_xor(mx, 32));
            const float mnew = fmaxf(m, mx);
            if (__builtin_amdgcn_ballot_w64(mnew > m) != 0ull) { const float alpha = __builtin_amdgcn_exp2f(m - mnew); l *= alpha;
#pragma unroll
                for (int dh = 0; dh < NDH; ++dh)
#pragma unroll
                    for (int r = 0; r < 16; ++r) o[dh][r] *= alpha;
                m = mnew; }
            float ps = 0.f;
#pragma unroll
            for (int r = 0; r < 16; ++r) { p0[r] = __builtin_amdgcn_exp2f(p0[r] - m); p1[r] = __builtin_amdgcn_exp2f(p1[r] - m); ps += p0[r] + p1[r]; }
            l += ps;
            const LAS unsigned char* Vb = lds + (2 + buf) * KB;
#pragma unroll
            for (int kh = 0; kh < 2; ++kh)
#pragma unroll
                for (int s = 0; s < 2; ++s) {
                    const bf16x8 pb = pack8(kh ? p1 : p0, s);
#pragma unroll
                    for (int dh = 0; dh < NDH; ++dh) {
                        const int rowA = 32 * kh + 16 * s + 4 * hi + tq, rowB = rowA + 8, chv = 4 * dh + 2 * blk + (tp >> 1);
                        const s16x4 lo = vtr(Vb + rowA * (2 * D) + ((chv ^ vswz<D>(rowA)) << 4) + 8 * (tp & 1));
                        const s16x4 hh = vtr(Vb + rowB * (2 * D) + ((chv ^ vswz<D>(rowB)) << 4) + 8 * (tp & 1));
                        const bf16x8 va = (bf16x8){lo[0], lo[1], lo[2], lo[3], hh[0], hh[1], hh[2], hh[3]};
                        o[dh] = __builtin_amdgcn_mfma_f32_32x32x16_bf16(va, pb, o[dh], 0, 0, 0);
                    }
                }
        }
        if (tt + 1 < NT) ATT_WRITE(buf ^ 1);
        __syncthreads();
    }
    l += __shfl_xor(l, 32);
    const float inv = 1.f / l;
    bf16_t* orow = Og + qrow * ld + h * D;
#pragma unroll
    for (int dh = 0; dh < NDH; ++dh)
#pragma unroll
        for (int g = 0; g < 4; ++g) { uint2 w; w.x = cvt_pk_bf16(o[dh][4 * g] * inv, o[dh][4 * g + 1] * inv); w.y = cvt_pk_bf16(o[dh][4 * g + 2] * inv, o[dh][4 * g + 3] * inv);
            *(uint2*)(orow + 32 * dh + 8 * g + 4 * hi) = w; }
#undef ATT_LOAD
#undef ATT_WRITE
}
}
__device__ __forceinline__ void p2_moba(Frame& F) {
    const bf16_t* MQ = (const bf16_t*)(F.ws + WS_MQ); const bf16_t* MK = (const bf16_t*)(F.ws + WS_MK); const bf16_t* MV = (const bf16_t*)(F.ws + WS_MV); bf16_t* OM = (bf16_t*)(F.ws + WS_OMOBA);
    for (int pr = F.vcu; pr < 256; pr += F.G) { const int bh = pr >> 3, p = pr & 7, b = bh >> 3, h = bh & 7;
#pragma unroll 1
        for (int k = 0; k < 2; ++k) { const int qb = k ? 15 - p : p;
            att::attn_unit<64, true>(F, b, h, qb, MQ, MK + (size_t)b * SEQ * 512, MV + (size_t)b * SEQ * 512, OM, 512, (const float*)(F.ctl + CW_KMEAN), nullptr, nullptr, nullptr); } }
}
__device__ __forceinline__ void p2_mem(Frame& F, const float* g_mem_q, const float* g_mem_k) {
    const bf16_t* CQ = (const bf16_t*)(F.ws + WS_CQ); const bf16_t* MEMK = (const bf16_t*)(F.ws + WS_MEMK); const bf16_t* MEMV = (const bf16_t*)(F.ws + WS_MEMV); bf16_t* OM = (bf16_t*)(F.ws + WS_OMEM);
#pragma unroll 1
    for (int u = F.vcu; u < 256; u += F.G) { const int bh = u >> 4, qb = u & 15, b = bh >> 2, h = bh & 3;
        att::attn_unit<128, false>(F, b, h, qb, CQ, MEMK + (size_t)b * MEMLEN * 512, MEMV + (size_t)b * MEMLEN * 512, OM, 512, nullptr, (const float*)(F.ctl + CW_MEMKSS) + (size_t)b * MEMLEN * 4, g_mem_q, g_mem_k); }
}
namespace ret {
using att::f32x16; using att::s16x4; using att::vtr; using att::pack8; using att::kswz; using att::vswz; using att::crow; using pg8::bf16x8;
constexpr int L_KT = 0, L_KD = 16384, L_VT = 32768, L_SB = 65536, L_SS = 98304;
__device__ __forceinline__ void retention_item(Frame& F, const int b, const int h, const float* g_ret_out) {
    const bf16_t* RQ = (const bf16_t*)(F.ws + WS_RQ); const bf16_t* RK = (const bf16_t*)(F.ws + WS_RK); const bf16_t* RV = (const bf16_t*)(F.ws + WS_RV); const bf16_t* RG = (const bf16_t*)(F.ws + WS_RG); bf16_t* ORET = (bf16_t*)(F.ws + WS_ORET);
    int tid = F.tid, lane = F.lane; asm volatile("" : "+v"(tid), "+v"(lane));
    const int wave = F.wave;
    LAS unsigned char* lds = F.lds;
    const float lg2_o = log2f(1.f - exp2f(-5.f - (float)h)), g128 = exp2f(128.f * lg2_o);
    const size_t tok0 = (size_t)b * SEQ;
    v4u kreg[2], vreg[4];
#define RET_LOAD(n) do { _Pragma("unroll") for (int i_ = 0; i_ < 2; ++i_) { const int ci_ = tid + 512 * i_; kreg[i_] = *(const v4u*)(RK + (tok0 + (n) * 128 + (ci_ >> 3)) * 256 + h * 64 + 8 * (ci_ & 7)); } \
        _Pragma("unroll") for (int i_ = 0; i_ < 4; ++i_) { const int ci_ = tid + 512 * i_; vreg[i_] = *(const v4u*)(RV + (tok0 + (n) * 128 + (ci_ >> 4)) * 512 + h * 128 + 8 * (ci_ & 15)); } } while (0)
#define RET_WRITE() do { _Pragma("unroll") for (int i_ = 0; i_ < 2; ++i_) { const int ci_ = tid + 512 * i_, row_ = ci_ >> 3, ch_ = ci_ & 7; const v4u k_ = kreg[i_]; \
            *(LAS v4u*)(lds + L_KT + row_ * 128 + ((ch_ ^ kswz<64>(row_)) << 4)) = k_; const float dk_ = __builtin_amdgcn_exp2f(lg2 * (float)(127 - row_)); v4u d_; \
            d_.x = cvt_pk_bf16(att::bfl(k_.x) * dk_, att::bfh(k_.x) * dk_); d_.y = cvt_pk_bf16(att::bfl(k_.y) * dk_, att::bfh(k_.y) * dk_); d_.z = cvt_pk_bf16(att::bfl(k_.z) * dk_, att::bfh(k_.z) * dk_); d_.w = cvt_pk_bf16(att::bfl(k_.w) * dk_, att::bfh(k_.w) * dk_); \
            *(LAS v4u*)(lds + L_KD + row_ * 128 + ((ch_ ^ vswz<64>(row_)) << 4)) = d_; } \
        _Pragma("unroll") for (int i_ = 0; i_ < 4; ++i_) { const int ci_ = tid + 512 * i_, row_ = ci_ >> 4, ch_ = ci_ & 15; *(LAS v4u*)(lds + L_VT + row_ * 256 + ((ch_ ^ vswz<128>(row_)) << 4)) = vreg[i_]; } } while (0)
    { const float lg2 = lg2_o; RET_LOAD(0); RET_WRITE(); }
    { const v4u z = {0u, 0u, 0u, 0u}; *(LAS v4u*)(lds + L_SB + tid * 32) = z; *(LAS v4u*)(lds + L_SB + tid * 32 + 16) = z; }
    f32x16 st;
#pragma unroll
    for (int r = 0; r < 16; ++r) st[r] = 0.f;
    const int ib = wave & 3, e2 = wave >> 2;
    LAS float* ssb = (LAS float*)(lds + L_SS);
    __syncthreads();
    for (int n = 0; n < 32; ++n) {
        int lane_n = lane; float lg2 = lg2_o; asm volatile("" : "+v"(lane_n), "+v"(lg2));
        const int r32 = lane_n & 31, hi = lane_n >> 5, i16 = lane_n & 15, blk = (lane_n >> 4) & 1, tq = i16 >> 2, tp = i16 & 3;
        const LAS unsigned char* Sb = lds + L_SB + (n & 1) * 16384; LAS unsigned char* Sn = lds + L_SB + ((n + 1) & 1) * 16384;
        const size_t tokrow = tok0 + n * 128 + 32 * ib + r32;
        f32x16 o[2];
        {
            bf16x8 qr[4];
#pragma unroll
            for (int ks = 0; ks < 4; ++ks) qr[ks] = *(const bf16x8*)(RQ + tokrow * 256 + h * 64 + 16 * ks + 8 * hi);
#pragma unroll
            for (int q2 = 0; q2 < 2; ++q2) {
#pragma unroll
                for (int r = 0; r < 16; ++r) o[q2][r] = 0.f;
                const int e = 64 * e2 + 32 * q2 + r32;
#pragma unroll
                for (int ks = 0; ks < 4; ++ks) { const bf16x8 a = *(const LAS bf16x8*)(Sb + e * 128 + (((2 * ks + hi) ^ kswz<64>(e)) << 4)); o[q2] = __builtin_amdgcn_mfma_f32_32x32x16_bf16(a, qr[ks], o[q2], 0, 0, 0); } }
            const float gq = __builtin_amdgcn_exp2f(lg2 * (float)(32 * ib + r32 + 1));
#pragma unroll
            for (int q2 = 0; q2 < 2; ++q2)
#pragma unroll
                for (int r = 0; r < 16; ++r) o[q2][r] *= gq;
            __builtin_amdgcn_sched_barrier(0);
#pragma unroll 1
            for (int jb = 0; jb <= ib; ++jb) {
                f32x16 p;
#pragma unroll
                for (int r = 0; r < 16; ++r) p[r] = 0.f;
                const int krow_ = 32 * jb + r32;
#pragma unroll
                for (int ks = 0; ks < 4; ++ks) { const bf16x8 a = *(const LAS bf16x8*)(lds + L_KT + krow_ * 128 + (((2 * ks + hi) ^ kswz<64>(krow_)) << 4)); p = __builtin_amdgcn_mfma_f32_32x32x16_bf16(a, qr[ks], p, 0, 0, 0); }
                const float cl = __builtin_amdgcn_exp2f(lg2 * (float)(32 * (ib - jb) + r32 - 4 * hi));
                const bool diag = (jb == ib);
#pragma unroll
                for (int r = 0; r < 16; ++r) { float v = p[r] * (cl * __builtin_amdgcn_exp2f(-lg2 * (float)((r & 3) + 8 * (r >> 2)))); if (diag && ((r & 3) + 8 * (r >> 2) + 4 * hi) > r32) v = 0.f; p[r] = v; }
#pragma unroll
                for (int s = 0; s < 2; ++s) { const bf16x8 pb = pack8(p, s);
                    const int rowA = 32 * jb + 16 * s + 4 * hi + tq, rowB = rowA + 8;
#pragma unroll
                    for (int q2 = 0; q2 < 2; ++q2) { const int chv = 4 * (2 * e2 + q2) + 2 * blk + (tp >> 1);
                        const s16x4 lo = vtr(lds + L_VT + rowA * 256 + ((chv ^ vswz<128>(rowA)) << 4) + 8 * (tp & 1));
                        const s16x4 hh = vtr(lds + L_VT + rowB * 256 + ((chv ^ vswz<128>(rowB)) << 4) + 8 * (tp & 1));
                        const bf16x8 va = (bf16x8){lo[0], lo[1], lo[2], lo[3], hh[0], hh[1], hh[2], hh[3]};
                        o[q2] = __builtin_amdgcn_mfma_f32_32x32x16_bf16(va, pb, o[q2], 0, 0, 0); }
                    __builtin_amdgcn_sched_barrier(0); }
            }
        }
        __builtin_amdgcn_sched_barrier(0);
        { float ss = 0.f;
#pragma unroll
            for (int q2 = 0; q2 < 2; ++q2)
#pragma unroll
                for (int r = 0; r < 16; ++r) ss += o[q2][r] * o[q2][r];
            ss += __shfl_xor(ss, 32);
            if (hi == 0) ssb[e2 * 128 + 32 * ib + r32] = ss; }
        __builtin_amdgcn_sched_barrier(0);
        { const int eh = wave & 3, dh = wave >> 2;
#pragma unroll
            for (int r = 0; r < 16; ++r) st[r] *= g128;
#pragma unroll 1
            for (int kst = 0; kst < 8; ++kst) { const int rowA = 16 * kst + 4 * hi + tq, rowB = rowA + 8, chv = 4 * eh + 2 * blk + (tp >> 1), chk = 4 * dh + 2 * blk + (tp >> 1);
                const s16x4 lo = vtr(lds + L_VT + rowA * 256 + ((chv ^ vswz<128>(rowA)) << 4) + 8 * (tp & 1));
                const s16x4 hh = vtr(lds + L_VT + rowB * 256 + ((chv ^ vswz<128>(rowB)) << 4) + 8 * (tp & 1));
                const s16x4 kl = vtr(lds + L_KD + rowA * 128 + ((chk ^ vswz<64>(rowA)) << 4) + 8 * (tp & 1));
                const s16x4 kh = vtr(lds + L_KD + rowB * 128 + ((chk ^ vswz<64>(rowB)) << 4) + 8 * (tp & 1));
                const bf16x8 va = (bf16x8){lo[0], lo[1], lo[2], lo[3], hh[0], hh[1], hh[2], hh[3]};
                const bf16x8 kb = (bf16x8){kl[0], kl[1], kl[2], kl[3], kh[0], kh[1], kh[2], kh[3]};
                st = __builtin_amdgcn_mfma_f32_32x32x16_bf16(va, kb, st, 0, 0, 0); }
#pragma unroll
            for (int r = 0; r < 16; ++r) { const int e = 32 * eh + (r & 3) + 8 * (r >> 2) + 4 * hi, dd = 32 * dh + r32;
                *(LAS bf16_t*)(Sn + e * 128 + ((((dd >> 3) ^ kswz<64>(e))) << 4) + (dd & 7) * 2) = f2bf(st[r]); } }
        __builtin_amdgcn_sched_barrier(0);
        if (n + 1 < 32) RET_LOAD(n + 1);
        __syncthreads();
        { const float rn = 1.f / sqrtf((ssb[32 * ib + r32] + ssb[128 + 32 * ib + r32]) * (1.f / 128.f) + 1e-5f);
#pragma unroll
            for (int q2 = 0; q2 < 2; ++q2)
#pragma unroll
                for (int g = 0; g < 4; ++g) { const int e = 64 * e2 + 32 * q2 + 8 * g + 4 * hi; const f32x4 gg = *(const f32x4*)(g_ret_out + e); const uint2 rg = *(const uint2*)(RG + tokrow * 512 + h * 128 + e);
                    uint2 w; w.x = cvt_pk_bf16(o[q2][4 * g] * rn * gg[0] * att::bfl(rg.x), o[q2][4 * g + 1] * rn * gg[1] * att::bfh(rg.x)); w.y = cvt_pk_bf16(o[q2][4 * g + 2] * rn * gg[2] * att::bfl(rg.y), o[q2][4 * g + 3] * rn * gg[3] * att::bfh(rg.y));
                    *(uint2*)(ORET + tokrow * 512 + h * 128 + e) = w; } }
        if (n + 1 < 32) RET_WRITE();
        __syncthreads();
    }
#undef RET_LOAD
#undef RET_WRITE
}
}
constexpr int CW_QUEUE = 128;
__device__ __forceinline__ void p2_mixers(Frame& F, const float* g_ret_out, const float* g_mem_q, const float* g_mem_k) {
    volatile LAS int* slot = (volatile LAS int*)(F.lds + TB_OFF + 512);
    const bf16_t* MQ = (const bf16_t*)(F.ws + WS_MQ); const bf16_t* MK = (const bf16_t*)(F.ws + WS_MK); const bf16_t* MV = (const bf16_t*)(F.ws + WS_MV); bf16_t* OMO = (bf16_t*)(F.ws + WS_OMOBA);
    const bf16_t* CQ = (const bf16_t*)(F.ws + WS_CQ); const bf16_t* MEMK = (const bf16_t*)(F.ws + WS_MEMK); const bf16_t* MEMV = (const bf16_t*)(F.ws + WS_MEMV); bf16_t* OME = (bf16_t*)(F.ws + WS_OMEM);
    for (;;) {
        __syncthreads();
        if (F.tid == 0) slot[0] = (int)__hip_atomic_fetch_add((unsigned*)F.ctl + CW_QUEUE, 1u, __ATOMIC_RELAXED, __HIP_MEMORY_SCOPE_AGENT);
        __syncthreads();
        const int it = slot[0];
        if (it >= 16 + 512 + 256) break;
        if (it < 16) ret::retention_item(F, it >> 2, it & 3, g_ret_out);
        else if (it < 528) { const int u = it - 16, qb = 15 - (u >> 5), bh = u & 31, b = bh >> 3, h = bh & 7;
            att::attn_unit<64, true>(F, b, h, qb, MQ, MK + (size_t)b * SEQ * 512, MV + (size_t)b * SEQ * 512, OMO, 512, (const float*)(F.ctl + CW_KMEAN), nullptr, nullptr, nullptr); }
        else { const int u = it - 528, bh = u >> 4, qb = u & 15, b = bh >> 2, h = bh & 3;
            att::attn_unit<128, false>(F, b, h, qb, CQ, MEMK + (size_t)b * MEMLEN * 512, MEMV + (size_t)b * MEMLEN * 512, OME, 512, nullptr, (const float*)(F.ctl + CW_MEMKSS) + (size_t)b * MEMLEN * 4, g_mem_q, g_mem_k); }
    }
}
#define WAVE_LDS_FENCE() do { asm volatile("s_waitcnt lgkmcnt(0)" ::: "memory"); } while (0)
__device__ __forceinline__ void p2_moba_slow(Frame& F) {
    const bf16_t* MQ = (const bf16_t*)(F.ws + WS_MQ); const bf16_t* MK = (const bf16_t*)(F.ws + WS_MK); const bf16_t* MV = (const bf16_t*)(F.ws + WS_MV); const float* KMEAN = (const float*)(F.ctl + CW_KMEAN); bf16_t* OMOBA = (bf16_t*)(F.ws + WS_OMOBA);
    LAS float* sc = (LAS float*)(F.lds) + F.wave * 1152; LAS float* qsh = sc + 1024;
    const int gw = F.vcu * NWAVES + F.wave, NGW = F.G * NWAVES, lane = F.lane;
    for (int w = gw; w < NB * 8 * SEQ; w += NGW) {
        const int t = w & 4095, h = (w >> 12) & 7, b = w >> 15; const int qb = t >> 8; const size_t row = (size_t)b * 4096 + t;
        qsh[lane] = bf2f(MQ[row * 512 + h * 64 + lane]);
        WAVE_LDS_FENCE();
        float q[64];
#pragma unroll
        for (int d = 0; d < 64; ++d) q[d] = qsh[d];
        float gsc = -INFINITY; if (lane < qb) { const float* km = KMEAN + (((size_t)b * 16 + lane) * 8 + h) * 64; float s = 0.f;
#pragma unroll
            for (int d = 0; d < 64; ++d) s += q[d] * km[d];
            gsc = s; }
        int sel[4]; sel[0] = qb;
#pragma unroll
        for (int r = 0; r < 3; ++r) { const float m = wave_max64(gsc); int j = -1; if (m != -INFINITY) { const unsigned long long bal = __ballot(gsc == m); j = __ffsll((long long)bal) - 1; } sel[r + 1] = j; if (lane == j) gsc = -INFINITY; }
        const float slope = exp2f(-(float)(h + 1)); float mx = -INFINITY;
#pragma unroll
        for (int s = 0; s < 4; ++s) { const int blk = sel[s];
            for (int c = 0; c < 4; ++c) { const int kp = blk * 256 + c * 64 + lane; float v = -INFINITY;
                if (blk >= 0 && kp <= t) { const bf16_t* kr = MK + ((size_t)b * 4096 + kp) * 512 + h * 64; float d_ = 0.f;
#pragma unroll
                    for (int d = 0; d < 64; ++d) d_ += q[d] * bf2f(kr[d]);
                    v = d_ * 0.125f - slope * (float)(t - kp); }
                sc[s * 256 + c * 64 + lane] = v; mx = fmaxf(mx, v); } }
        mx = wave_max64(mx); float sum = 0.f;
        for (int i = lane; i < 1024; i += 64) { const float p = __expf(sc[i] - mx); sc[i] = p; sum += p; }
        sum = wave_sum64(sum);
        WAVE_LDS_FENCE();
        float o = 0.f;
#pragma unroll
        for (int s = 0; s < 4; ++s) { const int blk = sel[s]; if (blk >= 0) for (int k = 0; k < 256; ++k) { const float p = sc[s * 256 + k]; if (p != 0.f) o += p * bf2f(MV[((size_t)b * 4096 + blk * 256 + k) * 512 + h * 64 + lane]); } }
        OMOBA[row * 512 + h * 64 + lane] = f2bf(o / sum);
        WAVE_LDS_FENCE();
    }
}
__device__ __forceinline__ void p2_mem_slow(Frame& F, const float* g_mem_q, const float* g_mem_k) {
    const bf16_t* CQ = (const bf16_t*)(F.ws + WS_CQ); const bf16_t* MEMK = (const bf16_t*)(F.ws + WS_MEMK); const bf16_t* MEMV = (const bf16_t*)(F.ws + WS_MEMV); const float* MEMKSS = (const float*)(F.ctl + CW_MEMKSS); bf16_t* OMEM = (bf16_t*)(F.ws + WS_OMEM);
    LAS float* sc = (LAS float*)(F.lds) + F.wave * 1152; LAS float* qsh = sc + 1024;
    const int gw = F.vcu * NWAVES + F.wave, NGW = F.G * NWAVES, lane = F.lane;
    for (int w = gw; w < NB * 4 * SEQ; w += NGW) {
        const int t = w & 4095, h = (w >> 12) & 3, b = w >> 14; const size_t row = (size_t)b * 4096 + t;
        const float q0 = bf2f(CQ[row * 512 + h * 128 + lane]), q1 = bf2f(CQ[row * 512 + h * 128 + 64 + lane]);
        const float rq = 1.f / sqrtf(wave_sum64(q0 * q0 + q1 * q1) * (1.f / 128.f) + 1e-5f);
        qsh[lane] = q0 * rq * g_mem_q[lane] * g_mem_k[lane]; qsh[lane + 64] = q1 * rq * g_mem_q[lane + 64] * g_mem_k[lane + 64];
        WAVE_LDS_FENCE();
        float mx = -INFINITY;
        for (int c = 0; c < 4; ++c) { const int m = c * 64 + lane; const bf16_t* kr = MEMK + ((size_t)b * 256 + m) * 512 + h * 128; float d_ = 0.f; for (int d = 0; d < 128; ++d) d_ += qsh[d] * bf2f(kr[d]);
            const float rk = 1.f / sqrtf(MEMKSS[((size_t)b * 256 + m) * 4 + h] * (1.f / 128.f) + 1e-5f); const float v = d_ * rk * 0.08838834764831845f; sc[m] = v; mx = fmaxf(mx, v); }
        mx = wave_max64(mx); float sum = 0.f;
        for (int i = lane; i < 256; i += 64) { const float p = __expf(sc[i] - mx); sc[i] = p; sum += p; }
        sum = wave_sum64(sum); WAVE_LDS_FENCE();
        float o0 = 0.f, o1 = 0.f;
        for (int k = 0; k < 256; ++k) { const float p = sc[k]; const bf16_t* vr = MEMV + ((size_t)b * 256 + k) * 512 + h * 128; o0 += p * bf2f(vr[lane]); o1 += p * bf2f(vr[lane + 64]); }
        OMEM[row * 512 + h * 128 + lane] = f2bf(o0 / sum); OMEM[row * 512 + h * 128 + 64 + lane] = f2bf(o1 / sum);
        WAVE_LDS_FENCE();
    }
}
__device__ __forceinline__ void p2_ret_slow(Frame& F, const float* g_ret_out) {
    const bf16_t* RQ = (const bf16_t*)(F.ws + WS_RQ); const bf16_t* RK = (const bf16_t*)(F.ws + WS_RK); const bf16_t* RV = (const bf16_t*)(F.ws + WS_RV); const bf16_t* RG = (const bf16_t*)(F.ws + WS_RG); bf16_t* ORET = (bf16_t*)(F.ws + WS_ORET);
    LAS float* qs = (LAS float*)(F.lds) + 16384; LAS float* ks = qs + 64; LAS float* part = ks + 64; LAS float* red = part + 256;
    const int tid = F.tid, e = tid & 127, hf = (tid >> 7) & 1;
    for (int it = F.vcu; it < 16; it += F.G) {
        const int b = it >> 2, h = it & 3; const float gamma = 1.f - exp2f(-5.f - (float)h);
        float s[32];
#pragma unroll
        for (int i = 0; i < 32; ++i) s[i] = 0.f;
        for (int t = 0; t < 4096; ++t) { const size_t row = (size_t)b * 4096 + t;
            if (tid < 64) qs[tid] = bf2f(RQ[row * 256 + h * 64 + tid]); else if (tid < 128) ks[tid - 64] = bf2f(RK[row * 256 + h * 64 + tid - 64]);
            const float v = bf2f(RV[row * 512 + h * 128 + e]);
            __syncthreads();
            float o = 0.f;
            if (tid < 256) {
#pragma unroll
                for (int i = 0; i < 32; ++i) { s[i] = gamma * s[i] + ks[hf * 32 + i] * v; o += qs[hf * 32 + i] * s[i]; }
                part[tid] = o; }
            __syncthreads();
            float ov = 0.f;
            if (tid < 128) { ov = part[tid] + part[tid + 128]; const float ss = wave_sum64(ov * ov); if ((tid & 63) == 0) red[tid >> 6] = ss; }
            __syncthreads();
            if (tid < 128) { const float r = 1.f / sqrtf((red[0] + red[1]) * (1.f / 128.f) + 1e-5f); ORET[row * 512 + h * 128 + tid] = f2bf(ov * r * g_ret_out[tid] * bf2f(RG[row * 512 + h * 128 + tid])); }
        }
    }
}
constexpr int N_PHASES = 9;
__global__ void __launch_bounds__(NWAVES * 64, 2) mega(Args args) {
    extern __shared__ __attribute__((aligned(16))) unsigned char lds[];
    Frame F;
    F.lds = (LAS unsigned char*)lds; F.MISC = (volatile LAS unsigned*)(F.lds + MISC_OFF);
    F.tid = threadIdx.x; F.lane = F.tid & 63; F.wave = __builtin_amdgcn_readfirstlane(F.tid >> 6);
    F.G = gridDim.x; { const int bx = blockIdx.x; F.vcu = (F.G % 8 == 0) ? (bx % 8) * (F.G / 8) + bx / 8 : bx; }
    F.ws = args.ws; F.out = args.out; F.ctl = (gu32*)(args.ws + WS_CTL);
    for (int u = F.tid; u < (LDS_BYTES - LDSCTL_OFF) / 4; u += NWAVES * 64) ((LAS unsigned*)(F.lds + LDSCTL_OFF))[u] = 0u;
    __syncthreads();
    XcdBarrier bar = xcd_barrier_post((unsigned*)(F.ctl + CW_BAR) + args.li * XCD_BAR_WORDS, F.MISC + 8);
    const int lo = args.ph_lo, hi = args.ph_hi;
#define IN(k) (lo <= (k) && (k) < hi)
#define BOTH(k) (IN(k) && IN((k) + 1))
    if (IN(0)) { p0_prologue(F, args); if (BOTH(0)) xcd_barrier(bar); }
    if (IN(1)) {
        pg8::Gemm g{(const pg8::bf16_t*)(F.ws + WS_HB), (const pg8::bf16_t*)(F.ws + WS_WIN), NTOK + 1024, DIN + 1024, 1024};
        P1Order S; S.init(F.G, (int)blockIdx.x);
        EpiP1 E{F.ws, args.in[4], (const float*)(F.ws + WS_GTAB), (float*)(F.ctl + CW_KMEAN), (float*)(F.ctl + CW_MEMKSS)};
        pg8::gemm_phase<EpiP1, P1Order, true, true>(F.lds + RING_OFF, g, S, E);
        if (BOTH(1)) xcd_barrier(bar);
    }
    if (IN(2)) {
        p2_mixers(F, args.in[5], args.in[10], args.in[11]);
        if (BOTH(2)) xcd_barrier(bar);
    }
    if (IN(3)) {
        P3Order S; S.init(F.G, (int)blockIdx.x, F.ws); EpiP3 E{(const bf16_t*)(F.ws + WS_GT), (bf16_t*)(F.ws + WS_Y)};
        pg9::gemm_phase<EpiP3, P3Order, false>(F.lds + RING_OFF, 512, 512, 512, S, E);
        if (BOTH(3)) xcd_barrier(bar);
    }
    if (IN(4)) {
        P4Order S; S.init(F.G, (int)blockIdx.x, F.ws); EpiP4 E{args.in[0], F.out};
        pg9::gemm_phase<EpiP4, P4Order, false>(F.lds + RING_OFF, 1024, 1024, 1024, S, E);
        if (BOTH(4)) xcd_barrier(bar);
    }
    if (IN(5)) { p5_router(F, F.out, args.in[16], args.in[17], args.in[18]); if (BOTH(5)) xcd_barrier(bar); }
    if (IN(6)) {
        moe_tables(F);
        MoeOrder<3, WS_W1, 2048, 2, WS_XT> S; S.init(F.G, (int)blockIdx.x, F.ws, (const LAS int*)(F.lds + TB_OFF));
        EpiMoe1 E{(const int*)(F.ws + WS_LISTS), args.in[20], (bf16_t*)(F.ws + WS_ACT)};
        pg9::gemm_phase<EpiMoe1, MoeOrder<3, WS_W1, 2048, 2, WS_XT>, true>(F.lds + RING_OFF, 1024, 1024, 1024, S, E);
        if (BOTH(6)) xcd_barrier(bar);
    }
    if (IN(7)) {
        moe_tables(F);
        MoeOrder<2, WS_W2, 1024, 0, WS_ACT> S; S.init(F.G, (int)blockIdx.x, F.ws, (const LAS int*)(F.lds + TB_OFF));
        EpiMoe2 E{(const int*)(F.ws + WS_LISTS), args.in[22], (bf16_t*)(F.ws + WS_YS)};
        pg9::gemm_phase<EpiMoe2, MoeOrder<2, WS_W2, 1024, 0, WS_ACT>, true>(F.lds + RING_OFF, 1024, 1024, 1024, S, E);
        if (BOTH(7)) xcd_barrier(bar);
    }
    if (IN(8)) { p8_combine(F, F.out); }
#undef IN
#undef BOTH
}
#ifndef MK_ONE_LAUNCH
#define MK_ONE_LAUNCH 1
#endif
extern "C" void kernel_launch(void* const* d_in, const int* in_sizes, int n_in, void* d_out, int out_size, void* d_ws, size_t ws_size, hipStream_t stream) {
    if (ws_size < WS_END) { fprintf(stderr, "kernel_launch: ws too small %zu < %zu\n", ws_size, (size_t)WS_END); return; }
    unsigned char* ws = (unsigned char*)d_ws; float* out = (float*)d_out;
    static int grid = 0;
    if (grid == 0) {
        int dev = 0, cus = 0; if (hipGetDevice(&dev) != hipSuccess || hipDeviceGetAttribute(&cus, hipDeviceAttributeMultiprocessorCount, dev) != hipSuccess) { fprintf(stderr, "kernel_launch: device query failed\n"); grid = -1; return; }
        if (hipFuncSetAttribute((const void*)mega, hipFuncAttributeMaxDynamicSharedMemorySize, LDS_BYTES) != hipSuccess) { fprintf(stderr, "kernel_launch: hipFuncSetAttribute failed\n"); grid = -1; return; }
        (void)hipGetLastError(); grid = cus;
    }
    if (grid < 0) return;
    (void)hipMemsetAsync(ws + WS_CTL, 0, 1 * MiB, stream);
    Args a; memset(&a, 0, sizeof a); for (int i = 0; i < 23; ++i) a.in[i] = (const float*)d_in[i]; a.out = out; a.ws = ws; a.li = 0;
#if MK_ONE_LAUNCH
    a.ph_lo = 0; a.ph_hi = N_PHASES;
    hipLaunchKernelGGL(mega, dim3(grid), dim3(NWAVES * 64), LDS_BYTES, stream, a);
#else
    for (int p = 0; p < N_PHASES; ++p) { a.ph_lo = p; a.ph_hi = p + 1; hipLaunchKernelGGL(mega, dim3(grid), dim3(NWAVES * 64), LDS_BYTES, stream, a); }
#endif
}
```

```cpp
#include <hip/hip_runtime.h>
#include <cstdio>
#include <cstdint>
#include <cstring>
typedef unsigned short bf16_t;
__host__ __device__ inline float bf2f(bf16_t v) { unsigned u = ((unsigned)v) << 16; float f; __builtin_memcpy(&f, &u, 4); return f; }
__host__ __device__ inline bf16_t f2bf(float f) { unsigned u; __builtin_memcpy(&u, &f, 4); u += 0x7fffu + ((u >> 16) & 1u); return (bf16_t)(u >> 16); }
constexpr int NTOK = 16384, SEQ = 4096, NB = 4, DM = 1024, DIN = 6656, MEMLEN = 256, NEXP = 32;
constexpr size_t MiB = (size_t)1 << 20;
constexpr size_t WS_CTL = 0;
constexpr size_t WS_WIN = 1 * MiB;
constexpr size_t WS_WMEMKV = 14 * MiB;
constexpr size_t WS_WBR = 16 * MiB;
constexpr size_t WS_WOUT = 19 * MiB;
constexpr size_t WS_W1 = 21 * MiB;
constexpr size_t WS_W2 = 149 * MiB;
constexpr size_t WS_HB = 213 * MiB;
constexpr size_t WS_HM = 245 * MiB;
constexpr size_t WS_RQ = 247 * MiB, WS_RK = 255 * MiB, WS_RV = 263 * MiB, WS_RG = 279 * MiB, WS_MQ = 295 * MiB, WS_MK = 311 * MiB, WS_MV = 327 * MiB, WS_CQ = 343 * MiB, WS_GT = 359 * MiB;
constexpr size_t WS_MEMK = 455 * MiB, WS_MEMV = 456 * MiB, WS_KMEAN = 457 * MiB, WS_MEMKSS = 457 * MiB + 512 * 1024;
constexpr size_t WS_GTAB = 457 * MiB + 768 * 1024;
constexpr size_t WS_ORET = 458 * MiB, WS_OMOBA = 474 * MiB, WS_OMEM = 490 * MiB;
constexpr size_t WS_Y = 506 * MiB, WS_XT = 538 * MiB;
constexpr size_t WS_TOPE = 570 * MiB, WS_TOPW = 570 * MiB + 256 * 1024, WS_LISTS = 571 * MiB;
constexpr size_t WS_ACT = 574 * MiB;
constexpr size_t WS_YS = 703 * MiB;
constexpr size_t WS_RETST = 959 * MiB;
constexpr size_t WS_END = 1024 * MiB;
constexpr size_t WS_PROJ = 574 * MiB;
constexpr size_t WS_PM = 990 * MiB;
constexpr size_t WS_ORAW = 574 * MiB;
constexpr size_t WS_T0 = 703 * MiB, WS_T1 = 767 * MiB, WS_T2 = 831 * MiB;
constexpr int CW_COUNTS = 64;
namespace nv {
struct NGemm {
    const bf16_t* A; const int* arow; const float* W; const int* Mdev; size_t w_zstride;
    int lda, arow_zstride, ashift, ldw, M, N, K, pad;
};
static inline NGemm mk_gemm(const bf16_t* A, int lda, const int* arow, int arow_zstride, int ashift, const float* W, int ldw, size_t w_zstride, int M, const int* Mdev, int N, int K) {
    NGemm g; memset(&g, 0, sizeof g); g.A = A; g.arow = arow; g.W = W; g.Mdev = Mdev; g.w_zstride = w_zstride; g.lda = lda; g.arow_zstride = arow_zstride; g.ashift = ashift; g.ldw = ldw; g.M = M; g.N = N; g.K = K; return g; }
template <class Epi> __global__ __launch_bounds__(256) void nk_gemm(NGemm g, Epi epi) {
    __shared__ float As[16][68]; __shared__ float Ws[16][68];
    const int z = blockIdx.z; const int M = g.Mdev ? g.Mdev[z] : g.M; const int m0 = blockIdx.y * 64, n0 = blockIdx.x * 64; if (m0 >= M) return;
    const int tid = threadIdx.x, tx = tid & 15, ty = tid >> 4;
    const int* arow = g.arow ? g.arow + (size_t)z * g.arow_zstride : nullptr; const float* W = g.W + (size_t)z * g.w_zstride;
    const int lr = tid >> 2, lk = (tid & 3) * 4; int srow = -1, rid = -1;
    { const int m = m0 + lr; if (m < M) { rid = arow ? arow[m] : m; srow = arow ? (rid >> g.ashift) : m; } }
    float acc[4][4]; for (int i = 0; i < 4; ++i) for (int j = 0; j < 4; ++j) acc[i][j] = 0.f;
    for (int k0 = 0; k0 < g.K; k0 += 16) {
        float a4[4] = {0.f, 0.f, 0.f, 0.f};
        if (srow >= 0) { const bf16_t* p = g.A + (size_t)srow * g.lda + k0 + lk; for (int j = 0; j < 4; ++j) a4[j] = bf2f(p[j]); }
        for (int j = 0; j < 4; ++j) As[lk + j][lr] = a4[j];
        { const int wk = tid >> 4, wn = (tid & 15) * 4; const float* p = W + (size_t)(k0 + wk) * g.ldw + n0 + wn; for (int j = 0; j < 4; ++j) Ws[wk][wn + j] = p[j]; }
        __syncthreads();
#pragma unroll
        for (int kk = 0; kk < 16; ++kk) { float a[4], b[4]; for (int i = 0; i < 4; ++i) { a[i] = As[kk][ty * 4 + i]; b[i] = Ws[kk][tx * 4 + i]; }
            for (int i = 0; i < 4; ++i) for (int j = 0; j < 4; ++j) acc[i][j] += a[i] * b[j]; }
        __syncthreads();
    }
    for (int i = 0; i < 4; ++i) { const int m = m0 + ty * 4 + i; if (m < M) { const int id = arow ? arow[m] : m; epi(z, id, m, n0 + tx * 4, acc[i]); } }
}
struct EpiStoreF32 { float* C; int ldc; int pad; __device__ void operator()(int, int id, int, int n, const float* v) const { float* p = C + (size_t)id * ldc + n; for (int j = 0; j < 4; ++j) p[j] = v[j]; } };
struct EpiMoeAct { bf16_t* ACT; const float* b1; __device__ void operator()(int e, int id, int, int n, const float* v) const {
    const float* b = b1 + (size_t)e * 2048 + n;
    for (int p = 0; p < 2; ++p) { float gl = fminf(v[2 * p] + b[2 * p], 7.0f); float li = fminf(fmaxf(v[2 * p + 1] + b[2 * p + 1], -7.0f), 7.0f);
        float a = gl * (1.f / (1.f + expf(-1.702f * gl))) * (li + 1.f); ACT[(size_t)id * 1024 + (n >> 1) + p] = f2bf(a); } } };
struct EpiMoeOut { float* YS; const float* b2; __device__ void operator()(int e, int id, int, int n, const float* v) const {
    const float* b = b2 + (size_t)e * 1024 + n; float* p = YS + (size_t)id * 1024 + n; for (int j = 0; j < 4; ++j) p[j] = v[j] + b[j]; } };

__device__ inline float wave_sum(float v) { for (int o = 1; o < 64; o <<= 1) v += __shfl_xor(v, o); return v; }
__device__ inline float wave_max(float v) { for (int o = 1; o < 64; o <<= 1) v = fmaxf(v, __shfl_xor(v, o)); return v; }

__global__ __launch_bounds__(256) void nk_rmsnorm(const float* x, const float* g, bf16_t* out, int rows) {
    const int w = (blockIdx.x * 256 + threadIdx.x) >> 6, lane = threadIdx.x & 63; if (w >= rows) return;
    const float* xr = x + (size_t)w * 1024; float v[16]; float s = 0.f;
    for (int j = 0; j < 16; ++j) { v[j] = xr[lane + 64 * j]; s += v[j] * v[j]; }
    const float r = rsqrtf(wave_sum(s) * (1.f / 1024.f) + 1e-5f);
#pragma unroll
    for (int j = 0; j < 16; ++j) out[(size_t)w * 1024 + lane + 64 * j] = f2bf(v[j] * r * g[lane + 64 * j]);
}
struct PostProj { const float* P; const float* b_gate; const float* g_moba_q; const float* g_moba_k;
    bf16_t *RQ, *RK, *RV, *RG, *MQ, *MK, *MV, *CQ, *GT; };
__global__ __launch_bounds__(256) void nk_post_proj(PostProj a) {
    const int t = blockIdx.x, tid = threadIdx.x, lane = tid & 63, w = tid >> 6; const float* p = a.P + (size_t)t * 6656;
    for (int c = tid; c < 256; c += 256) { a.RQ[(size_t)t * 256 + c] = f2bf(p[c]); a.RK[(size_t)t * 256 + c] = f2bf(p[256 + c] * 0.125f); }
    for (int c = tid; c < 512; c += 256) { a.RV[(size_t)t * 512 + c] = f2bf(p[512 + c]); const float g = p[1024 + c]; a.RG[(size_t)t * 512 + c] = f2bf(g / (1.f + expf(-g)));
        a.MV[(size_t)t * 512 + c] = f2bf(p[2560 + c]); a.CQ[(size_t)t * 512 + c] = f2bf(p[3072 + c]); }
    for (int h = w; h < 8; h += 4) {
        float q = p[1536 + h * 64 + lane], k = p[2048 + h * 64 + lane];
        const float rq = rsqrtf(wave_sum(q * q) * (1.f / 64.f) + 1e-5f), rk = rsqrtf(wave_sum(k * k) * (1.f / 64.f) + 1e-5f);
        a.MQ[(size_t)t * 512 + h * 64 + lane] = f2bf(q * rq * a.g_moba_q[lane]); a.MK[(size_t)t * 512 + h * 64 + lane] = f2bf(k * rk * a.g_moba_k[lane]);
    }
    for (int c = tid; c < 3072; c += 256) { const float g = p[3584 + c] + a.b_gate[c]; a.GT[(size_t)t * 3072 + c] = f2bf(1.f / (1.f + expf(-g))); }
}
__global__ __launch_bounds__(256) void nk_post_mem(const float* PM, bf16_t* MEMK, float* MEMKSS, bf16_t* MEMV) {
    const int r = blockIdx.x, tid = threadIdx.x, lane = tid & 63, w = tid >> 6; const float* p = PM + (size_t)r * 1024;
    for (int c = tid; c < 512; c += 256) { MEMK[(size_t)r * 512 + c] = f2bf(p[c]); MEMV[(size_t)r * 512 + c] = f2bf(p[512 + c]); }
    { const float a = p[w * 128 + lane], b = p[w * 128 + 64 + lane]; const float s = wave_sum(a * a + b * b); if (lane == 0) MEMKSS[r * 4 + w] = s; }
}
__global__ __launch_bounds__(256) void nk_memkss(const bf16_t* MEMK, float* MEMKSS) {
    const int r = blockIdx.x, lane = threadIdx.x & 63, w = threadIdx.x >> 6; const float a = bf2f(MEMK[(size_t)r * 512 + w * 128 + lane]), b = bf2f(MEMK[(size_t)r * 512 + w * 128 + 64 + lane]);
    const float s = wave_sum(a * a + b * b); if (lane == 0) MEMKSS[r * 4 + w] = s;
}
__global__ __launch_bounds__(64) void nk_kmean(const bf16_t* MK, float* KMEAN) {
    const int bb = blockIdx.x, h = blockIdx.y, d = threadIdx.x; float s = 0.f;
    for (int r = 0; r < 256; ++r) s += bf2f(MK[((size_t)bb * 256 + r) * 512 + h * 64 + d]);
    KMEAN[((size_t)bb * 8 + h) * 64 + d] = s * (1.f / 256.f);
}
__global__ __launch_bounds__(256) void nk_retention(const bf16_t* RQ, const bf16_t* RK, const bf16_t* RV, float* ORAW) {
    const int b = blockIdx.x >> 2, h = blockIdx.x & 3, tid = threadIdx.x, e = tid & 127, hf = tid >> 7;
    const float gamma = 1.f - exp2f(-5.f - (float)h);
    __shared__ float qs[64], ks[64], part[256];
    float s[32];
#pragma unroll
    for (int i = 0; i < 32; ++i) s[i] = 0.f;
    for (int t = 0; t < 4096; ++t) { const size_t row = (size_t)b * 4096 + t;
        if (tid < 64) qs[tid] = bf2f(RQ[row * 256 + h * 64 + tid]); else if (tid < 128) ks[tid - 64] = bf2f(RK[row * 256 + h * 64 + tid - 64]);
        const float v = bf2f(RV[row * 512 + h * 128 + e]);
        __syncthreads();
        float o = 0.f;
#pragma unroll
        for (int i = 0; i < 32; ++i) { s[i] = gamma * s[i] + ks[hf * 32 + i] * v; o += qs[hf * 32 + i] * s[i]; }
        part[tid] = o; __syncthreads();
        if (tid < 128) ORAW[row * 512 + h * 128 + tid] = part[tid] + part[tid + 128];
    }
}
__global__ __launch_bounds__(256) void nk_ret_post(const float* ORAW, const float* g_ret_out, const bf16_t* RG, bf16_t* ORET) {
    const int w = (blockIdx.x * 256 + threadIdx.x) >> 6, lane = threadIdx.x & 63; const int t = w >> 2, h = w & 3;
    const float* p = ORAW + (size_t)t * 512 + h * 128; const float a = p[lane], b = p[lane + 64];
    const float r = rsqrtf(wave_sum(a * a + b * b) * (1.f / 128.f) + 1e-5f);
    ORET[(size_t)t * 512 + h * 128 + lane] = f2bf(a * r * g_ret_out[lane] * bf2f(RG[(size_t)t * 512 + h * 128 + lane]));
    ORET[(size_t)t * 512 + h * 128 + lane + 64] = f2bf(b * r * g_ret_out[lane + 64] * bf2f(RG[(size_t)t * 512 + h * 128 + lane + 64]));
}
__global__ __launch_bounds__(256) void nk_moba(const bf16_t* MQ, const bf16_t* MK, const bf16_t* MV, const float* KMEAN, bf16_t* OMOBA) {
    __shared__ float sc[4][1024]; __shared__ float qsh[4][64];
    const int wl = threadIdx.x >> 6, lane = threadIdx.x & 63; const int w = blockIdx.x * 4 + wl;
    const int t = w & 4095, h = (w >> 12) & 7, b = w >> 15; const int qb = t >> 8;
    const size_t row = (size_t)b * 4096 + t;
    qsh[wl][lane] = bf2f(MQ[row * 512 + h * 64 + lane]);
    __syncthreads();
    float q[64];
#pragma unroll
    for (int d = 0; d < 64; ++d) q[d] = qsh[wl][d];
    float gsc = -INFINITY; if (lane < qb) { const float* km = KMEAN + (((size_t)b * 16 + lane) * 8 + h) * 64; float s = 0.f;
#pragma unroll
        for (int d = 0; d < 64; ++d) s += q[d] * km[d];
        gsc = s; }
    int sel[4]; sel[0] = qb;
#pragma unroll
    for (int r = 0; r < 3; ++r) { const float m = wave_max(gsc); int j = -1; if (m != -INFINITY) { const unsigned long long bal = __ballot(gsc == m); j = __ffsll((long long)bal) - 1; } sel[r + 1] = j; if (lane == j) gsc = -INFINITY; }
    const float slope = exp2f(-(float)(h + 1));
    float mx = -INFINITY;
#pragma unroll
    for (int s = 0; s < 4; ++s) { const int blk = sel[s];
        for (int c = 0; c < 4; ++c) { const int kp = blk * 256 + c * 64 + lane; float v = -INFINITY;
            if (blk >= 0 && kp <= t) { const bf16_t* kr = MK + ((size_t)b * 4096 + kp) * 512 + h * 64; float d_ = 0.f;
#pragma unroll
                for (int d = 0; d < 64; ++d) d_ += q[d] * bf2f(kr[d]);
                v = d_ * 0.125f - slope * (float)(t - kp); }
            sc[wl][s * 256 + c * 64 + lane] = v; mx = fmaxf(mx, v); } }
    mx = wave_max(mx); float sum = 0.f;
    for (int i = lane; i < 1024; i += 64) { const float p = expf(sc[wl][i] - mx); sc[wl][i] = p; sum += p; }
    sum = wave_sum(sum);
    __syncthreads();
    float o = 0.f;
#pragma unroll
    for (int s = 0; s < 4; ++s) { const int blk = sel[s]; if (blk >= 0) for (int k = 0; k < 256; ++k) { const float p = sc[wl][s * 256 + k]; if (p != 0.f) o += p * bf2f(MV[((size_t)b * 4096 + blk * 256 + k) * 512 + h * 64 + lane]); } }
    OMOBA[row * 512 + h * 64 + lane] = f2bf(o / sum);
}
__global__ __launch_bounds__(256) void nk_memattn(const bf16_t* CQ, const bf16_t* MEMK, const float* MEMKSS, const bf16_t* MEMV, const float* g_mem_q, const float* g_mem_k, bf16_t* OMEM) {
    __shared__ float sc[4][256]; __shared__ float qsh[4][128];
    const int wl = threadIdx.x >> 6, lane = threadIdx.x & 63; const int w = blockIdx.x * 4 + wl;
    const int t = w & 4095, h = (w >> 12) & 3, b = w >> 14; const size_t row = (size_t)b * 4096 + t;
    const float q0 = bf2f(CQ[row * 512 + h * 128 + lane]), q1 = bf2f(CQ[row * 512 + h * 128 + 64 + lane]);
    const float rq = rsqrtf(wave_sum(q0 * q0 + q1 * q1) * (1.f / 128.f) + 1e-5f);
    qsh[wl][lane] = q0 * rq * g_mem_q[lane] * g_mem_k[lane]; qsh[wl][lane + 64] = q1 * rq * g_mem_q[lane + 64] * g_mem_k[lane + 64];
    __syncthreads();
    float mx = -INFINITY;
    for (int c = 0; c < 4; ++c) { const int m = c * 64 + lane; const bf16_t* kr = MEMK + ((size_t)b * 256 + m) * 512 + h * 128; float d_ = 0.f; for (int d = 0; d < 128; ++d) d_ += qsh[wl][d] * bf2f(kr[d]);
        const float rk = rsqrtf(MEMKSS[((size_t)b * 256 + m) * 4 + h] * (1.f / 128.f) + 1e-5f); const float v = d_ * rk * 0.08838834764831845f; sc[wl][m] = v; mx = fmaxf(mx, v); }
    mx = wave_max(mx); float sum = 0.f;
    for (int i = lane; i < 256; i += 64) { const float p = expf(sc[wl][i] - mx); sc[wl][i] = p; sum += p; }
    sum = wave_sum(sum); __syncthreads();
    float o0 = 0.f, o1 = 0.f;
    for (int k = 0; k < 256; ++k) { const float p = sc[wl][k]; const bf16_t* vr = MEMV + ((size_t)b * 256 + k) * 512 + h * 128; o0 += p * bf2f(vr[lane]); o1 += p * bf2f(vr[lane + 64]); }
    OMEM[row * 512 + h * 128 + lane] = f2bf(o0 / sum); OMEM[row * 512 + h * 128 + 64 + lane] = f2bf(o1 / sum);
}
__global__ __launch_bounds__(256) void nk_merge(const float* T0, const float* T1, const float* T2, const bf16_t* GT, bf16_t* Y) {
    const size_t i = (size_t)blockIdx.x * 256 + threadIdx.x; const size_t t = i >> 10; const int n = (int)(i & 1023);
    Y[i] = f2bf(bf2f(GT[t * 3072 + n]) * T0[i] + bf2f(GT[t * 3072 + 1024 + n]) * T1[i] + bf2f(GT[t * 3072 + 2048 + n]) * T2[i]);
}
__global__ __launch_bounds__(256) void nk_resid(const float* x, const float* T, float* X1) { const size_t i = (size_t)blockIdx.x * 256 + threadIdx.x; X1[i] = x[i] + T[i]; }
__global__ __launch_bounds__(256) void nk_router(const float* X1, const float* g_ffn, const float* w_router, const float* b_router, bf16_t* XT, int* TOPE, float* TOPW, int* COUNTS, int* LISTS) {
    const int t = (blockIdx.x * 256 + threadIdx.x) >> 6, lane = threadIdx.x & 63; const float* xr = X1 + (size_t)t * 1024; float v[16]; float s = 0.f;
    for (int j = 0; j < 16; ++j) { v[j] = xr[lane + 64 * j]; s += v[j] * v[j]; }
    const float r = rsqrtf(wave_sum(s) * (1.f / 1024.f) + 1e-5f);
#pragma unroll
    for (int j = 0; j < 16; ++j) { v[j] = v[j] * r * g_ffn[lane + 64 * j]; XT[(size_t)t * 1024 + lane + 64 * j] = f2bf(v[j]); }
    float lg = -INFINITY;
    for (int e = 0; e < 32; ++e) { float p = 0.f;
#pragma unroll
        for (int j = 0; j < 16; ++j) p += v[j] * w_router[(size_t)(lane + 64 * j) * 32 + e]; p = wave_sum(p); if (lane == e) lg = p + b_router[e]; }
    float tv[4]; int te[4];
#pragma unroll
    for (int k = 0; k < 4; ++k) { const float m = wave_max(lg); const unsigned long long bal = __ballot(lg == m); const int e = __ffsll((long long)bal) - 1; tv[k] = m; te[k] = e; if (lane == e) lg = -INFINITY; }
    float ex[4], se = 0.f;
#pragma unroll
    for (int k = 0; k < 4; ++k) { ex[k] = expf(tv[k] - tv[0]); se += ex[k]; }
    int e_l = te[0]; float w_l = ex[0];
#pragma unroll
    for (int k = 1; k < 4; ++k) if (lane == k) { e_l = te[k]; w_l = ex[k]; }
    if (lane < 4) { const int e = e_l; TOPE[t * 4 + lane] = e; TOPW[t * 4 + lane] = w_l / se; const int pos = atomicAdd(&COUNTS[e], 1); LISTS[(size_t)e * 16384 + pos] = t * 4 + lane; }
}
__global__ __launch_bounds__(256) void nk_combine(const float* X1, const float* YS, const float* TOPW, float* out) {
    const size_t i = (size_t)blockIdx.x * 256 + threadIdx.x; const size_t t = i >> 10; const int n = (int)(i & 1023); float a = X1[i];
    for (int k = 0; k < 4; ++k) a += TOPW[t * 4 + k] * YS[(t * 4 + k) * 1024 + n];
    out[i] = a;
}
}
namespace pg8 {
#define PG8_LAS __attribute__((address_space(3)))
typedef unsigned short bf16_t;
typedef short bf16x8 __attribute__((ext_vector_type(8)));
typedef float f32x4 __attribute__((ext_vector_type(4)));
typedef unsigned u32x4 __attribute__((ext_vector_type(4)));
constexpr int BM = 256, BK = 64, HALF = 128, HTB = HALF * BK * 2  , STAGE_BYTES = 8 * HTB, NXCD = 8, WGM = 8;

__host__ __device__ __forceinline__ int lds_byte(int r, int c) { const int st = (r >> 4) * 2 + (c >> 5), rr = r & 15, cc = c & 31, ob = rr * 64 + cc * 2; return st * 1024 + (ob ^ (((ob >> 9) & 1) << 5)); }
__host__ __device__ __forceinline__ void stage_rc(int b, int& R, int& C) { const int st = b / 1024, sb = b % 1024, swz = sb ^ (((sb >> 9) & 1) << 5); R = (st >> 1) * 16 + swz / 64; C = (st & 1) * 32 + (swz % 64) / 2; }
__host__ __device__ __forceinline__ int perm32(int rho) { const int n = rho >> 4, i = rho & 15; return 8 * (i >> 2) + 4 * n + (i & 3); }

struct Unit { int pm, pn; };
struct Gemm { const bf16_t* A; const bf16_t* Bt; int M, N, K; };
struct StaticOrder {
    int nM, nN, nwg, G, c;
    __host__ __device__ void init(int M, int N, int G_, int c_) { nM = M / BM; nN = N / BM; nwg = nM * nN; G = G_; c = c_; }
    __host__ __device__ bool next(int i, Unit& u) const {
        const long L = (long)i * G + c; if (L >= nwg) return false;
        int wgid = (int)L; { const int q = nwg / NXCD, r = nwg % NXCD, xcd = wgid % NXCD, off = wgid / NXCD; wgid = (xcd < r ? xcd * (q + 1) : r * (q + 1) + (xcd - r) * q) + off; }
        const int nig = WGM * nN, gid = wgid / nig, fm = gid * WGM, gsz = (nM - fm) < WGM ? (nM - fm) : WGM;
        u.pm = fm + ((wgid % nig) % gsz); u.pn = (wgid % nig) / gsz; return true;
    }
    __device__ __forceinline__ void a_ready(const Unit&) const {}
    __device__ __forceinline__ void done(const Unit&) const {}
};
__device__ __forceinline__ unsigned cvt_pk_bf16(float lo, float hi) { unsigned r; asm volatile("v_cvt_pk_bf16_f32 %0, %1, %2" : "=v"(r) : "v"(lo), "v"(hi)); return r; }
typedef float f32x2 __attribute__((ext_vector_type(2)));
template <class Epi, class Sched, bool ALIGN_EPI = false, bool SP2 = false>
__device__ __forceinline__ void gemm_phase(PG8_LAS unsigned char* lds, const Gemm g, const Sched& S, const Epi& E) {
    const int tid = threadIdx.x, wid = __builtin_amdgcn_readfirstlane(tid >> 6), lane = tid & 63, wr = wid >> 2, wc = wid & 3, fr = lane & 15, fq = lane >> 4;
    const int K = g.K, nt = K / BK;
    unsigned voffA[2], voffB[2];
#pragma unroll
    for (int i = 0; i < 2; ++i) { int R, C; stage_rc(tid * 16 + i * 8192, R, C); const int Rb = Epi::PERM ? ((R & ~31) + perm32(R & 31)) : R;
        voffA[i] = (unsigned)(R * K + C) * 2u; voffB[i] = (unsigned)(Rb * K + C) * 2u; }
    const size_t kstep = (size_t)(BK * 2);
    const size_t hstep = (size_t)HALF * K * 2;
    const size_t tstep = 2 * hstep;
    const unsigned ldsw = (unsigned)wid * 1024u;
    const int aoff = lds_byte(wr * 64 + fr, fq * 8), boff = lds_byte(wc * 32 + fr, fq * 8);
#define PG8_SA(b, h) (((b) * 2 + (h)) * HTB)
#define PG8_SB(b, h) ((4 + (b) * 2 + (h)) * HTB)
#define PG8_STAGE(bufoff, gbase, voff) do { _Pragma("unroll") for (int _i = 0; _i < 2; ++_i) \
        __builtin_amdgcn_global_load_lds((const unsigned*)((const char*)(gbase) + (voff)[_i]), (PG8_LAS unsigned*)(lds + (bufoff) + ldsw + _i * 8192), 16, 0, 0); } while (0)
#define PG8_LDA(dst, b, h) do { _Pragma("unroll") for (int m = 0; m < 4; ++m) _Pragma("unroll") for (int k = 0; k < 2; ++k) dst[m][k] = *(const PG8_LAS bf16x8*)(lds + PG8_SA(b, h) + aoff + m * 2048 + k * 1024); } while (0)
#define PG8_LDB(dst, b, h) do { _Pragma("unroll") for (int n = 0; n < 2; ++n) _Pragma("unroll") for (int k = 0; k < 2; ++k) dst[n][k] = *(const PG8_LAS bf16x8*)(lds + PG8_SB(b, h) + boff + n * 2048 + k * 1024); } while (0)
#define PG8_MMA(ai, bj, At, Bt) do { __builtin_amdgcn_s_setprio(1); _Pragma("unroll") for (int m = 0; m < 4; ++m) _Pragma("unroll") for (int n = 0; n < 2; ++n) _Pragma("unroll") for (int k = 0; k < 2; ++k) \
        acc[ai][bj][m][n] = __builtin_amdgcn_mfma_f32_16x16x32_bf16(Bt[n][k], At[m][k], acc[ai][bj][m][n], 0, 0, 0); __builtin_amdgcn_s_setprio(0); } while (0)
#define PG8_WAIT_V(n) asm volatile("s_waitcnt vmcnt(" #n ")" ::: "memory")
#define PG8_WAIT_L(n) asm volatile("s_waitcnt lgkmcnt(" #n ")" ::: "memory")
#define PG8_BAR __builtin_amdgcn_s_barrier()
#define PG8_SCHED __builtin_amdgcn_sched_barrier(0)
    Unit cur, nxt; int ui = 0;
    if (!S.next(0, cur)) return;
    f32x4 acc[2][2][4][2];
#pragma unroll
    for (int a = 0; a < 2; ++a)
#pragma unroll
        for (int b = 0; b < 2; ++b)
#pragma unroll
            for (int m = 0; m < 4; ++m)
#pragma unroll
                for (int n = 0; n < 2; ++n) acc[a][b][m][n] = (f32x4){0.f, 0.f, 0.f, 0.f};
    bf16x8 At[4][2], B0[2][2], B1[2][2];
    const char* cA = (const char*)g.A + (size_t)cur.pm * tstep; const char* cB = (const char*)g.Bt + (size_t)cur.pn * tstep;
    S.a_ready(cur);
    if constexpr (SP2) {
        PG8_STAGE(PG8_SB(0, 0), cB, voffB); PG8_STAGE(PG8_SB(0, 1), cB + hstep, voffB); PG8_STAGE(PG8_SA(0, 0), cA, voffA); PG8_STAGE(PG8_SA(0, 1), cA + hstep, voffA);
        if (wr == 1) PG8_BAR;
        PG8_WAIT_V(2); PG8_BAR;
        PG8_STAGE(PG8_SB(1, 0), cB + kstep, voffB); PG8_STAGE(PG8_SA(1, 0), cA + kstep, voffA); PG8_STAGE(PG8_SB(1, 1), cB + hstep + kstep, voffB);
        PG8_WAIT_V(6); PG8_BAR;
    } else {
        PG8_STAGE(PG8_SB(0, 0), cB, voffB); PG8_STAGE(PG8_SA(0, 0), cA, voffA); PG8_STAGE(PG8_SB(0, 1), cB + hstep, voffB); PG8_STAGE(PG8_SA(0, 1), cA + hstep, voffA);
        if (wr == 1) PG8_BAR;
        PG8_WAIT_V(4); PG8_BAR;
        PG8_STAGE(PG8_SB(1, 0), cB + kstep, voffB); PG8_STAGE(PG8_SA(1, 0), cA + kstep, voffA); PG8_STAGE(PG8_SB(1, 1), cB + hstep + kstep, voffB);
        PG8_WAIT_V(6); PG8_BAR;
    }
    for (;;) {
        const bool has_next = S.next(ui + 1, nxt);
        const char* nA = has_next ? (const char*)g.A + (size_t)nxt.pm * tstep : cA; const char* nB = has_next ? (const char*)g.Bt + (size_t)nxt.pn * tstep : cB;
        for (int t = 0; t < nt; t += 2) {
            const bool last = (t == nt - 2);
            const char* a1 = cA + (size_t)(t + 1) * kstep;
            const char* a2 = last ? nA : cA + (size_t)(t + 2) * kstep; const char* b2 = last ? nB : cB + (size_t)(t + 2) * kstep;
            const char* a3 = a2 + kstep; const char* b3 = b2 + kstep;
            if (last && has_next) S.a_ready(nxt);
            if constexpr (SP2) {
            PG8_LDB(B0, 0, 0); PG8_LDB(B1, 0, 1); PG8_SCHED; PG8_LDA(At, 0, 0); PG8_STAGE(PG8_SA(1, 1), a1 + hstep, voffA);
            PG8_WAIT_V(8); PG8_WAIT_L(0); PG8_BAR; PG8_MMA(0, 0, At, B0); PG8_MMA(0, 1, At, B1); PG8_BAR; PG8_SCHED;
            PG8_LDA(At, 0, 1); PG8_STAGE(PG8_SB(0, 0), b2, voffB); PG8_STAGE(PG8_SB(0, 1), b2 + hstep, voffB); PG8_STAGE(PG8_SA(0, 0), a2, voffA);
            PG8_WAIT_V(8); PG8_WAIT_L(0); PG8_BAR; PG8_MMA(1, 0, At, B0); PG8_MMA(1, 1, At, B1); PG8_BAR; PG8_SCHED;
            PG8_LDB(B0, 1, 0); PG8_LDB(B1, 1, 1); PG8_SCHED; PG8_LDA(At, 1, 0); PG8_STAGE(PG8_SA(0, 1), a2 + hstep, voffA);
            PG8_WAIT_V(8); PG8_WAIT_L(0); PG8_BAR; PG8_MMA(0, 0, At, B0); PG8_MMA(0, 1, At, B1); PG8_BAR; PG8_SCHED;
            PG8_LDA(At, 1, 1); PG8_STAGE(PG8_SB(1, 0), b3, voffB); PG8_STAGE(PG8_SB(1, 1), b3 + hstep, voffB); PG8_STAGE(PG8_SA(1, 0), a3, voffA);
            PG8_WAIT_V(8); PG8_WAIT_L(0); PG8_BAR; PG8_MMA(1, 0, At, B0); PG8_MMA(1, 1, At, B1); PG8_BAR; PG8_SCHED;
            } else {
            PG8_LDB(B0, 0, 0); PG8_SCHED; PG8_LDA(At, 0, 0); PG8_STAGE(PG8_SA(1, 1), a1 + hstep, voffA);
            PG8_WAIT_L(8); PG8_BAR; PG8_WAIT_L(0); PG8_MMA(0, 0, At, B0); PG8_BAR; PG8_SCHED;
            PG8_LDB(B1, 0, 1); PG8_STAGE(PG8_SB(0, 0), b2, voffB);
            PG8_BAR; PG8_WAIT_L(0); PG8_MMA(0, 1, At, B1); PG8_BAR;
            PG8_LDA(At, 0, 1); PG8_STAGE(PG8_SA(0, 0), a2, voffA);
            PG8_BAR; PG8_WAIT_L(0); PG8_MMA(1, 0, At, B0); PG8_BAR; PG8_SCHED;
            PG8_STAGE(PG8_SB(0, 1), b2 + hstep, voffB);
            PG8_WAIT_V(6); PG8_BAR; PG8_MMA(1, 1, At, B1); PG8_BAR;
            PG8_LDB(B0, 1, 0); PG8_SCHED; PG8_LDA(At, 1, 0); PG8_STAGE(PG8_SA(0, 1), a2 + hstep, voffA);
            PG8_WAIT_L(8); PG8_BAR; PG8_WAIT_L(0); PG8_MMA(0, 0, At, B0); PG8_BAR; PG8_SCHED;
            PG8_LDB(B1, 1, 1); PG8_STAGE(PG8_SB(1, 0), b3, voffB);
            PG8_BAR; PG8_WAIT_L(0); PG8_MMA(0, 1, At, B1); PG8_BAR;
            PG8_LDA(At, 1, 1); PG8_STAGE(PG8_SA(1, 0), a3, voffA);
            PG8_BAR; PG8_WAIT_L(0); PG8_MMA(1, 0, At, B0); PG8_BAR; PG8_SCHED;
            PG8_STAGE(PG8_SB(1, 1), b3 + hstep, voffB);
            PG8_WAIT_V(6); PG8_BAR; PG8_MMA(1, 1, At, B1); PG8_BAR;
            }
        }
        if constexpr (ALIGN_EPI) { if (wr == 0) PG8_BAR; }
        if constexpr (!Epi::AFTER_DRAIN) { E(acc, cur, wr, wc, fr, fq); S.done(cur); }
        if (!has_next) break;
#pragma unroll
        for (int a = 0; a < 2; ++a)
#pragma unroll
            for (int b = 0; b < 2; ++b)
#pragma unroll
                for (int m = 0; m < 4; ++m)
#pragma unroll
                    for (int n = 0; n < 2; ++n) acc[a][b][m][n] = (f32x4){0.f, 0.f, 0.f, 0.f};
        cur = nxt; cA = nA; cB = nB; ++ui;
        if constexpr (ALIGN_EPI) { if (wr == 1) PG8_BAR; }
    }
    PG8_WAIT_V(0);
    if constexpr (!ALIGN_EPI) { if (wr == 0) PG8_BAR; }
    PG8_BAR;
    if constexpr (Epi::AFTER_DRAIN) { E.fused(acc, cur, wr, wc, fr, fq, lds, wid, lane); S.done(cur); }
#undef PG8_SA
#undef PG8_SB
#undef PG8_STAGE
#undef PG8_LDA
#undef PG8_LDB
#undef PG8_MMA
#undef PG8_WAIT_V
#undef PG8_WAIT_L
#undef PG8_BAR
#undef PG8_SCHED
}
}
namespace pg9 {
using pg8::bf16x8; using pg8::f32x4; using pg8::u32x4; using pg8::lds_byte; using pg8::stage_rc; using pg8::perm32;
constexpr int BK = 64, HALF = 128, HTB = HALF * BK * 2;
struct Unit { int pm, pn, aux, cnt; };
template <class Epi, class Sched, bool GATHER>
__device__ __forceinline__ void gemm_phase(PG8_LAS unsigned char* lds, const int K, const int lda, const int ldb, const Sched& S, const Epi& E) {
    const int tid = threadIdx.x, wid = __builtin_amdgcn_readfirstlane(tid >> 6), lane = tid & 63, wr = wid >> 2, wc = wid & 3, fr = lane & 15, fq = lane >> 4;
    const int nt = K / BK;
    unsigned offA[2][2], offAn[2][2], offB[2][2]; int RA[2], CA[2];
#pragma unroll
    for (int i = 0; i < 2; ++i) { int R, C; stage_rc(tid * 16 + i * 8192, R, C); const int Rb = Epi::PERM ? ((R & ~31) + perm32(R & 31)) : R; RA[i] = R; CA[i] = C * 2;
#pragma unroll
        for (int h = 0; h < 2; ++h) { offB[h][i] = (unsigned)((Rb + 128 * h) * ldb + C) * 2u; offA[h][i] = (unsigned)((R + 128 * h) * lda + C) * 2u; offAn[h][i] = offA[h][i]; } }
    const size_t kstep = (size_t)(BK * 2);
    const unsigned ldsw = (unsigned)wid * 1024u;
    const int aoff = lds_byte(wr * 64 + fr, fq * 8), boff = lds_byte(wc * 32 + fr, fq * 8);
#define PG9_SA(b, h) (((b) * 2 + (h)) * HTB)
#define PG9_SB(b, h) ((4 + (b) * 2 + (h)) * HTB)
#define PG9_STAGE(bufoff, gbase, voff) do { _Pragma("unroll") for (int _i = 0; _i < 2; ++_i) \
        __builtin_amdgcn_global_load_lds((const unsigned*)((const char*)(gbase) + (voff)[_i]), (PG8_LAS unsigned*)(lds + (bufoff) + ldsw + _i * 8192), 16, 0, 0); } while (0)
#define PG9_LDA(dst, b, h) do { _Pragma("unroll") for (int m = 0; m < 4; ++m) _Pragma("unroll") for (int k = 0; k < 2; ++k) dst[m][k] = *(const PG8_LAS bf16x8*)(lds + PG9_SA(b, h) + aoff + m * 2048 + k * 1024); } while (0)
#define PG9_LDB(dst, b, h) do { _Pragma("unroll") for (int n = 0; n < 2; ++n) _Pragma("unroll") for (int k = 0; k < 2; ++k) dst[n][k] = *(const PG8_LAS bf16x8*)(lds + PG9_SB(b, h) + boff + n * 2048 + k * 1024); } while (0)
#define PG9_MMA(ai, bj, At, Bt) do { __builtin_amdgcn_s_setprio(1); _Pragma("unroll") for (int m = 0; m < 4; ++m) _Pragma("unroll") for (int n = 0; n < 2; ++n) _Pragma("unroll") for (int k = 0; k < 2; ++k) \
        acc[ai][bj][m][n] = __builtin_amdgcn_mfma_f32_16x16x32_bf16(Bt[n][k], At[m][k], acc[ai][bj][m][n], 0, 0, 0); __builtin_amdgcn_s_setprio(0); } while (0)
#define PG9_WAIT_V(n) asm volatile("s_waitcnt vmcnt(" #n ")" ::: "memory")
#define PG9_WAIT_L(n) asm volatile("s_waitcnt lgkmcnt(" #n ")" ::: "memory")
#define PG9_BAR __builtin_amdgcn_s_barrier()
#define PG9_SCHED __builtin_amdgcn_sched_barrier(0)
    Unit cur, nxt; int ui = 0;
    if (!S.next(0, cur)) return;
    f32x4 acc[2][2][4][2];
#pragma unroll
    for (int a = 0; a < 2; ++a)
#pragma unroll
        for (int b = 0; b < 2; ++b)
#pragma unroll
            for (int m = 0; m < 4; ++m)
#pragma unroll
                for (int n = 0; n < 2; ++n) acc[a][b][m][n] = (f32x4){0.f, 0.f, 0.f, 0.f};
    bf16x8 At[4][2], B0[2][2], B1[2][2];
    const char* cA = S.a_base(cur); const char* cB = S.b_base(cur);
    if constexpr (GATHER) {
#pragma unroll
        for (int h = 0; h < 2; ++h)
#pragma unroll
            for (int i = 0; i < 2; ++i) offA[h][i] = S.a_row_off(cur, RA[i] + 128 * h) + (unsigned)CA[i];
    }
    PG9_STAGE(PG9_SB(0, 0), cB, offB[0]); PG9_STAGE(PG9_SB(0, 1), cB, offB[1]); PG9_STAGE(PG9_SA(0, 0), cA, offA[0]); PG9_STAGE(PG9_SA(0, 1), cA, offA[1]);
    if (wr == 1) PG9_BAR;
    PG9_WAIT_V(2); PG9_BAR;
    PG9_STAGE(PG9_SB(1, 0), cB + kstep, offB[0]); PG9_STAGE(PG9_SA(1, 0), cA + kstep, offA[0]); PG9_STAGE(PG9_SB(1, 1), cB + kstep, offB[1]);
    PG9_WAIT_V(6); PG9_BAR;
    for (;;) {
        const bool has_next = S.next(ui + 1, nxt);
        const char* nA = has_next ? S.a_base(nxt) : cA; const char* nB = has_next ? S.b_base(nxt) : cB;
        if constexpr (GATHER) {
#pragma unroll
            for (int h = 0; h < 2; ++h)
#pragma unroll
                for (int i = 0; i < 2; ++i) offAn[h][i] = has_next ? (S.a_row_off(nxt, RA[i] + 128 * h) + (unsigned)CA[i]) : offA[h][i];
        }
        for (int t = 0; t < nt; t += 2) {
            const bool last = (t == nt - 2);
            const char* a1 = cA + (size_t)(t + 1) * kstep;
            const char* a2 = last ? nA : cA + (size_t)(t + 2) * kstep; const char* b2 = last ? nB : cB + (size_t)(t + 2) * kstep;
            const char* a3 = a2 + kstep; const char* b3 = b2 + kstep;
            unsigned oA2[2][2];
#pragma unroll
            for (int h = 0; h < 2; ++h)
#pragma unroll
                for (int i = 0; i < 2; ++i) oA2[h][i] = (GATHER && last) ? offAn[h][i] : offA[h][i];
            PG9_LDB(B0, 0, 0); PG9_LDB(B1, 0, 1); PG9_SCHED; PG9_LDA(At, 0, 0); PG9_STAGE(PG9_SA(1, 1), a1, offA[1]);
            PG9_WAIT_V(8); PG9_WAIT_L(0); PG9_BAR; PG9_MMA(0, 0, At, B0); PG9_MMA(0, 1, At, B1); PG9_BAR; PG9_SCHED;
            PG9_LDA(At, 0, 1); PG9_STAGE(PG9_SB(0, 0), b2, offB[0]); PG9_STAGE(PG9_SB(0, 1), b2, offB[1]); PG9_STAGE(PG9_SA(0, 0), a2, oA2[0]);
            PG9_WAIT_V(8); PG9_WAIT_L(0); PG9_BAR; PG9_MMA(1, 0, At, B0); PG9_MMA(1, 1, At, B1); PG9_BAR; PG9_SCHED;
            PG9_LDB(B0, 1, 0); PG9_LDB(B1, 1, 1); PG9_SCHED; PG9_LDA(At, 1, 0); PG9_STAGE(PG9_SA(0, 1), a2, oA2[1]);
            PG9_WAIT_V(8); PG9_WAIT_L(0); PG9_BAR; PG9_MMA(0, 0, At, B0); PG9_MMA(0, 1, At, B1); PG9_BAR; PG9_SCHED;
            PG9_LDA(At, 1, 1); PG9_STAGE(PG9_SB(1, 0), b3, offB[0]); PG9_STAGE(PG9_SB(1, 1), b3, offB[1]); PG9_STAGE(PG9_SA(1, 0), a3, oA2[0]);
            PG9_WAIT_V(8); PG9_WAIT_L(0); PG9_BAR; PG9_MMA(1, 0, At, B0); PG9_MMA(1, 1, At, B1); PG9_BAR; PG9_SCHED;
        }
        if (wr == 0) PG9_BAR;
        bool keep = false;
        if constexpr (Epi::CHAIN) keep = E.chain_more(cur);
        if (keep) { if constexpr (Epi::CHAIN) E.rescale(acc, cur, wr, wc, fr, fq); }
        else E(acc, cur, wr, wc, fr, fq);
        if (!has_next) break;
        if (!keep) {
#pragma unroll
            for (int a = 0; a < 2; ++a)
#pragma unroll
                for (int b = 0; b < 2; ++b)
#pragma unroll
                    for (int m = 0; m < 4; ++m)
#pragma unroll
                        for (int n = 0; n < 2; ++n) acc[a][b][m][n] = (f32x4){0.f, 0.f, 0.f, 0.f};
        }
        cur = nxt; cA = nA; cB = nB; ++ui;
        if constexpr (GATHER) {
#pragma unroll
            for (int h = 0; h < 2; ++h)
#pragma unroll
                for (int i = 0; i < 2; ++i) offA[h][i] = offAn[h][i];
        }
        if (wr == 1) PG9_BAR;
    }
    PG9_WAIT_V(0);
    PG9_BAR;
#undef PG9_SA
#undef PG9_SB
#undef PG9_STAGE
#undef PG9_LDA
#undef PG9_LDB
#undef PG9_MMA
#undef PG9_WAIT_V
#undef PG9_WAIT_L
#undef PG9_BAR
#undef PG9_SCHED
}
}
#define GAS __attribute__((address_space(1)))
#define LAS __attribute__((address_space(3)))
typedef unsigned short bf16;
typedef unsigned v4u __attribute__((ext_vector_type(4)));
typedef float f32x4 __attribute__((ext_vector_type(4)));
typedef short bf16x8 __attribute__((ext_vector_type(8)));
typedef GAS unsigned gu32;
typedef GAS unsigned long long gu64;
#define RLX_AGENT __ATOMIC_RELAXED, __HIP_MEMORY_SCOPE_AGENT
#define LDS_WAIT() asm volatile("s_waitcnt lgkmcnt(0)" ::: "memory")
#define VM_WAIT() asm volatile("s_waitcnt vmcnt(0)" ::: "memory")
__device__ __forceinline__ unsigned long long rt() { return __builtin_amdgcn_s_memrealtime(); }
__device__ __forceinline__ unsigned f2bfu(float f) { unsigned u = __builtin_bit_cast(unsigned, f); return (u + 0x7fffu + ((u >> 16) & 1u)) >> 16; }
__device__ __forceinline__ unsigned pk2(float lo, float hi) { return f2bfu(lo) | (f2bfu(hi) << 16); }
#define XB_TMO      128
#define XB_XCNT(j)  (256  + 64 * (j))
#define XB_XSUB(j)  (1280 + 64 * (j))
#define XB_XGEN(j)  (2304 + 64 * (j))
#define XB_TOP      3328
#define XB_TOPGEN   3392
#define XCD_BAR_WORDS 3456
#define XB_SPIN_CAP (1u << 18)

__device__ __forceinline__ unsigned xb_ld(unsigned* p)              { return __hip_atomic_load(p, __ATOMIC_RELAXED, __HIP_MEMORY_SCOPE_AGENT); }
__device__ __forceinline__ unsigned xb_add(unsigned* p, unsigned v) { return __hip_atomic_fetch_add(p, v, __ATOMIC_RELAXED, __HIP_MEMORY_SCOPE_AGENT); }
__device__ __forceinline__ unsigned xb_xcc_id() { return (unsigned)__builtin_amdgcn_s_getreg((3 << 11) | 20) & 0xFu; }
#define XB_SPIN(cond, bar) do { unsigned _sp = 0; while (cond) { __builtin_amdgcn_s_sleep(1); \
    if ((++_sp & 255u) == 0u) { if (xb_ld(&(bar)[XB_TMO])) break; if (_sp > XB_SPIN_CAP) { atomicAdd(&(bar)[XB_TMO], 1u); break; } } } } while (0)

struct XcdBarrier {
    unsigned* bar; unsigned x;
    volatile LAS unsigned* st;
};

__device__ __forceinline__ XcdBarrier xcd_barrier_post(unsigned* bar, volatile LAS unsigned* st) {
    XcdBarrier b; b.bar = bar; b.x = xb_xcc_id(); b.st = st;
    if (threadIdx.x == 0) (void)xb_add(&bar[XB_XCNT(b.x)], 1u);
    return b;
}
__device__ __forceinline__ void xcd_barrier_complete(unsigned* bar, unsigned x, unsigned& nloc, unsigned& nx) {
    const unsigned G = gridDim.x * gridDim.y * gridDim.z;
    unsigned sum, cnt, mine, sp = 0u;
    for (;;) {
        sum = 0u; cnt = 0u; mine = 0u;
#pragma unroll
        for (unsigned j = 0; j < 16; ++j) { const unsigned c = xb_ld(&bar[XB_XCNT(j)]); sum += c; cnt += (c > 0u) ? 1u : 0u; mine = (j == x) ? c : mine; }
        if (sum == G) break;
        __builtin_amdgcn_s_sleep(1);
        if ((++sp & 255u) == 0u) { if (xb_ld(&bar[XB_TMO])) break; if (sp > XB_SPIN_CAP) { atomicAdd(&bar[XB_TMO], 1u); break; } }
    }
    nloc = mine > 0u ? mine : 1u; nx = cnt > 0u ? cnt : 1u;
}

__device__ __forceinline__ void xcd_barrier(const XcdBarrier& b) {
    asm volatile("s_waitcnt vmcnt(0)" ::: "memory");
    __syncthreads();
    if (threadIdx.x == 0) {
        unsigned* bar = b.bar;
        __builtin_amdgcn_s_waitcnt(0);
        unsigned nloc = b.st[0], nx = b.st[1];
        if (nloc == 0u) { xcd_barrier_complete(bar, b.x, nloc, nx); b.st[0] = nloc; b.st[1] = nx; }
        const unsigned old = xb_add(&bar[XB_XSUB(b.x)], 1u);
        const unsigned gen = old / nloc;
        if (old + 1u == (gen + 1u) * nloc) {
            __builtin_amdgcn_fence(__ATOMIC_RELEASE, "agent");
            asm volatile("s_waitcnt vmcnt(0)" ::: "memory");
            const unsigned og = xb_add(&bar[XB_TOP], 1u);
            const unsigned tg = og / nx;
            if (og + 1u == (tg + 1u) * nx) xb_add(&bar[XB_TOPGEN], 1u);
            else XB_SPIN(xb_ld(&bar[XB_TOPGEN]) == tg, bar);
            __builtin_amdgcn_fence(__ATOMIC_ACQUIRE, "agent");
            xb_add(&bar[XB_XGEN(b.x)], 1u);
            asm volatile("s_waitcnt vmcnt(0)" ::: "memory");
        } else {
            XB_SPIN(xb_ld(&bar[XB_XGEN(b.x)]) == gen, bar);
            __builtin_amdgcn_fence(__ATOMIC_ACQUIRE, "agent");
            asm volatile("s_waitcnt vmcnt(0)" ::: "memory");
        }
    }
    __syncthreads();
}
constexpr int NWAVES = 8;
constexpr int RING_OFF = 0, RING_BYTES = 131072;
constexpr int LDSCTL_OFF = RING_BYTES, MISC_OFF = LDSCTL_OFF + 320;
constexpr int LDS_BYTES = 147456;
constexpr int CW_BAR = 4096;
constexpr int CW_KMEAN = 32768;
constexpr int CW_MEMKSS = 65536;
static_assert((CW_MEMKSS + 4096) * 4 <= (int)MiB && CW_BAR + 4 * 3456 <= CW_KMEAN, "ctl map");

struct Frame {
    LAS unsigned char* lds; volatile LAS unsigned* MISC; gu32* ctl;
    int tid, lane, wave, vcu, G;
    unsigned char* ws; float* out;
};
__device__ __forceinline__ float wave_sum64(float v) {
#pragma unroll
    for (int o = 1; o < 64; o <<= 1) v += __shfl_xor(v, o);
    return v;
}
template <bool HEADPERM> __device__ __forceinline__ void p0_transpose_item(const float* W, int K, int N, bf16* WT, int row_off, LAS float* scr, int item, int lane) {
    const int nblk = N / 32, kb = item / nblk, nb = item % nblk, k0 = 64 * kb, n0 = 32 * nb;
    int p0 = n0; if (HEADPERM) { const int lg = (n0 >> 5) & 7; p0 = (n0 & ~255) + 32 * (4 * (lg & 1) + (lg >> 1)); }
#pragma unroll 8
    for (int i = 0; i < 32; ++i) { const int kk = 2 * i + (lane >> 5); scr[kk * 33 + (lane & 31)] = W[(size_t)(k0 + kk) * N + n0 + (lane & 31)]; }
    LDS_WAIT(); asm volatile("" ::: "memory");
    const int c = lane & 7;
#pragma unroll
    for (int j = 0; j < 4; ++j) { const int n = (lane >> 3) + 8 * j; const LAS float* s = scr + (8 * c) * 33 + n;
        v4u o; o.x = pk2(s[0 * 33], s[1 * 33]); o.y = pk2(s[2 * 33], s[3 * 33]); o.z = pk2(s[4 * 33], s[5 * 33]); o.w = pk2(s[6 * 33], s[7 * 33]);
        *(GAS v4u*)(WT + (size_t)(row_off + p0 + n) * K + k0 + 8 * c) = o; }
    LDS_WAIT(); asm volatile("" ::: "memory");
}
__device__ __forceinline__ void rms_row_to_bf16(int lane, const float* xrow, const float* g, bf16* orow) {
    const GAS f32x4* xr = (const GAS f32x4*)xrow + lane; const GAS f32x4* gr = (const GAS f32x4*)g + lane;
    f32x4 v[4]; float s = 0.f;
#pragma unroll
    for (int j = 0; j < 4; ++j) { v[j] = xr[64 * j]; s += (v[j].x * v[j].x + v[j].y * v[j].y) + (v[j].z * v[j].z + v[j].w * v[j].w); }
    const float r = 1.f / sqrtf(wave_sum64(s) * (1.f / 1024.f) + 1e-5f);
    GAS unsigned long long* o8 = (GAS unsigned long long*)orow + lane;
#pragma unroll
    for (int j = 0; j < 4; ++j) { const f32x4 gg = gr[64 * j]; o8[64 * j] = (unsigned long long)pk2(v[j].x * r * gg.x, v[j].y * r * gg.y) | ((unsigned long long)pk2(v[j].z * r * gg.z, v[j].w * r * gg.w) << 32); }
}
struct Args { const float* in[23]; float* out; unsigned char* ws; int ph_lo, ph_hi, li, pad; };
__device__ __forceinline__ void p0_prologue(Frame& F, const Args& A) {
    LAS float* scr = (LAS float*)(F.lds + RING_OFF + F.wave * 16384);
    const int gw = F.vcu * NWAVES + F.wave, NGW = F.G * NWAVES;
    constexpr int I_IN = 16 * (DIN / 32), I_MKV = 16 * 32, I_BR = 8 * 32, I_OUT = 16 * 32, I_W1 = 16 * 64, I_W2 = 16 * 32;
    constexpr int NITEMS = I_IN + I_MKV + 3 * I_BR + I_OUT + NEXP * (I_W1 + I_W2);
    for (int it = gw; it < NITEMS; it += NGW) {
        int r = it;
        if (r < I_IN) { p0_transpose_item<true>(A.in[3], 1024, DIN, (bf16*)(F.ws + WS_WIN), 0, scr, r, F.lane); continue; } r -= I_IN;
        if (r < I_MKV) { p0_transpose_item<true>(A.in[9], 1024, 1024, (bf16*)(F.ws + WS_WMEMKV), 0, scr, r, F.lane); continue; } r -= I_MKV;
        if (r < 3 * I_BR) { const int w = r / I_BR; p0_transpose_item<false>(w == 0 ? A.in[12] : (w == 1 ? A.in[13] : A.in[14]), 512, 1024, (bf16*)(F.ws + WS_WBR) + (size_t)w * 1024 * 512, 0, scr, r % I_BR, F.lane); continue; } r -= 3 * I_BR;
        if (r < I_OUT) { p0_transpose_item<false>(A.in[15], 1024, 1024, (bf16*)(F.ws + WS_WOUT), 0, scr, r, F.lane); continue; } r -= I_OUT;
        if (r < NEXP * I_W1) { const int e = r / I_W1; p0_transpose_item<false>(A.in[19] + (size_t)e * 1024 * 2048, 1024, 2048, (bf16*)(F.ws + WS_W1) + (size_t)e * 2048 * 1024, 0, scr, r % I_W1, F.lane); continue; } r -= NEXP * I_W1;
        { const int e = r / I_W2; p0_transpose_item<false>(A.in[21] + (size_t)e * 1024 * 1024, 1024, 1024, (bf16*)(F.ws + WS_W2) + (size_t)e * 1024 * 1024, 0, scr, r % I_W2, F.lane); }
    }
    if (gw == 0) { ((float*)(F.ws + WS_GTAB))[F.lane] = A.in[6][F.lane]; ((float*)(F.ws + WS_GTAB))[64 + F.lane] = A.in[7][F.lane]; }
    for (int m = gw; m < NTOK; m += NGW) rms_row_to_bf16(F.lane, A.in[0] + (size_t)m * DM, A.in[2], (bf16*)(F.ws + WS_HB) + (size_t)m * DM);
    for (int m = gw; m < NB * MEMLEN; m += NGW) rms_row_to_bf16(F.lane, A.in[1] + (size_t)m * DM, A.in[8], (bf16*)(F.ws + WS_HM) + (size_t)m * DM);
}

struct P1Order {
    pg8::StaticOrder so; int G, c;
    __device__ void init(int G_, int c_) { so.init(NTOK, DIN, G_, 0); G = G_; c = c_; }
    __device__ bool next(int i, pg8::Unit& u) const {
        long L = (long)i * G + c;
        if (L < 1664) { pg8::StaticOrder t = so; t.G = 1; t.c = 0; return t.next((int)L, u); }
        L -= 1664; if (L >= 16) return false;
        u.pm = 64 + (int)(L >> 2); u.pn = 26 + (int)(L & 3); return true;
    }
    __device__ __forceinline__ void a_ready(const pg8::Unit&) const {}
    __device__ __forceinline__ void done(const pg8::Unit&) const {}
};
__device__ __forceinline__ float sigmoid_f(float x) { return __builtin_amdgcn_rcpf(1.f + __expf(-x)); }
typedef float f32x2_t __attribute__((ext_vector_type(2))); typedef __bf16 bf16x2_t __attribute__((ext_vector_type(2)));
__device__ __forceinline__ unsigned cvt_pk_bf16(float lo, float hi) { f32x2_t v = {lo, hi}; bf16x2_t b = __builtin_convertvector(v, bf16x2_t); return __builtin_bit_cast(unsigned, b); }
struct EpiP1 {
    static constexpr bool PERM = true, AFTER_DRAIN = false;
    unsigned char* ws; const float* b_gate; const float* gtab; float* KMEAN; float* MEMKSS;
    __device__ __forceinline__ void operator()(const pg8::f32x4 (&acc)[2][2][4][2], const pg8::Unit& u, int wr, int wc, int fr, int fq) const {
        using pg8::f32x4; using pg8::u32x4;
        const int pn = u.pn; int type, ldc, cb; size_t off; int row0 = u.pm * 256;
        if (pn == 0) { type = 0; off = WS_RQ; ldc = 256; cb = 0; }
        else if (pn == 1) { type = 1; off = WS_RK; ldc = 256; cb = 0; }
        else if (pn < 4) { type = 0; off = WS_RV; ldc = 512; cb = (pn - 2) * 256; }
        else if (pn < 6) { type = 2; off = WS_RG; ldc = 512; cb = (pn - 4) * 256; }
        else if (pn < 8) { type = 3; off = WS_MQ; ldc = 512; cb = (pn - 6) * 256; }
        else if (pn < 10) { type = 4; off = WS_MK; ldc = 512; cb = (pn - 8) * 256; }
        else if (pn < 12) { type = 0; off = WS_MV; ldc = 512; cb = (pn - 10) * 256; }
        else if (pn < 14) { type = 0; off = WS_CQ; ldc = 512; cb = (pn - 12) * 256; }
        else if (pn < 26) { type = 5; off = WS_GT; ldc = 3072; cb = (pn - 14) * 256; }
        else if (pn < 28) { type = 6; off = WS_MEMK; ldc = 512; cb = (pn - 26) * 256; row0 = (u.pm - 64) * 256; }
        else { type = 0; off = WS_MEMV; ldc = 512; cb = (pn - 28) * 256; row0 = (u.pm - 64) * 256; }
        bf16_t* base = (bf16_t*)(ws + off) + cb + 64 * wc + 8 * fq;
        const int rbase = row0 + 64 * wr + fr;
#define P1_STORE(rowp, bj, v0, v1) do { u32x4 w_; w_.x = cvt_pk_bf16((v0)[0], (v0)[1]); w_.y = cvt_pk_bf16((v0)[2], (v0)[3]); w_.z = cvt_pk_bf16((v1)[0], (v1)[1]); w_.w = cvt_pk_bf16((v1)[2], (v1)[3]); *(u32x4*)((rowp) + 32 * (bj)) = w_; } while (0)
        if (type <= 1) {
            const float sc = type == 1 ? 0.125f : 1.f;
#pragma unroll
            for (int ai = 0; ai < 2; ++ai)
#pragma unroll
                for (int m = 0; m < 4; ++m) { bf16_t* rowp = base + (size_t)(rbase + 128 * ai + 16 * m) * ldc;
#pragma unroll
                    for (int bj = 0; bj < 2; ++bj) { const f32x4 v0 = acc[ai][bj][m][0] * sc, v1 = acc[ai][bj][m][1] * sc; P1_STORE(rowp, bj, v0, v1); } }
        } else if (type == 2) {
#pragma unroll
            for (int ai = 0; ai < 2; ++ai)
#pragma unroll
                for (int m = 0; m < 4; ++m) { bf16_t* rowp = base + (size_t)(rbase + 128 * ai + 16 * m) * ldc;
#pragma unroll
                    for (int bj = 0; bj < 2; ++bj) { f32x4 v0 = acc[ai][bj][m][0], v1 = acc[ai][bj][m][1];
#pragma unroll
                        for (int j = 0; j < 4; ++j) { v0[j] = v0[j] * sigmoid_f(v0[j]); v1[j] = v1[j] * sigmoid_f(v1[j]); }
                        P1_STORE(rowp, bj, v0, v1); } }
        } else if (type == 5) {
            f32x4 bv[2][2];
#pragma unroll
            for (int bj = 0; bj < 2; ++bj)
#pragma unroll
                for (int n = 0; n < 2; ++n) bv[bj][n] = *(const f32x4*)(b_gate + cb + 64 * wc + 32 * bj + 8 * fq + 4 * n);
#pragma unroll
            for (int ai = 0; ai < 2; ++ai)
#pragma unroll
                for (int m = 0; m < 4; ++m) { bf16_t* rowp = base + (size_t)(rbase + 128 * ai + 16 * m) * ldc;
#pragma unroll
                    for (int bj = 0; bj < 2; ++bj) { f32x4 v0 = acc[ai][bj][m][0] + bv[bj][0], v1 = acc[ai][bj][m][1] + bv[bj][1];
#pragma unroll
                        for (int j = 0; j < 4; ++j) { v0[j] = sigmoid_f(v0[j]); v1[j] = sigmoid_f(v1[j]); }
                        P1_STORE(rowp, bj, v0, v1); } }
        } else if (type == 6) {
#pragma unroll
            for (int ai = 0; ai < 2; ++ai)
#pragma unroll
                for (int m = 0; m < 4; ++m) { const int row = rbase + 128 * ai + 16 * m; bf16_t* rowp = base + (size_t)row * ldc; float ss = 0.f;
#pragma unroll
                    for (int bj = 0; bj < 2; ++bj) { const f32x4 v0 = acc[ai][bj][m][0], v1 = acc[ai][bj][m][1];
                        ss += (v0[0] * v0[0] + v0[1] * v0[1]) + (v0[2] * v0[2] + v0[3] * v0[3]) + (v1[0] * v1[0] + v1[1] * v1[1]) + (v1[2] * v1[2] + v1[3] * v1[3]);
                        P1_STORE(rowp, bj, v0, v1); }
                    ss += __shfl_xor(ss, 16); ss += __shfl_xor(ss, 32);
                    if (fq == 0) atomicAdd(MEMKSS + (size_t)row * 4 + (cb >> 7) + (wc >> 1), ss);
                    }
        } else {
            const float* g = gtab + (type == 3 ? 0 : 64);
            f32x4 gv[2][2]; float rr[2][4];
#pragma unroll
            for (int bj = 0; bj < 2; ++bj)
#pragma unroll
                for (int n = 0; n < 2; ++n) gv[bj][n] = *(const f32x4*)(g + 32 * bj + 8 * fq + 4 * n);
#pragma unroll
            for (int ai = 0; ai < 2; ++ai)
#pragma unroll
                for (int m = 0; m < 4; ++m) { bf16_t* rowp = base + (size_t)(rbase + 128 * ai + 16 * m) * ldc; float ss = 0.f;
#pragma unroll
                    for (int bj = 0; bj < 2; ++bj) { const f32x4 v0 = acc[ai][bj][m][0], v1 = acc[ai][bj][m][1];
                        ss += (v0[0] * v0[0] + v0[1] * v0[1]) + (v0[2] * v0[2] + v0[3] * v0[3]) + (v1[0] * v1[0] + v1[1] * v1[1]) + (v1[2] * v1[2] + v1[3] * v1[3]); }
                    ss += __shfl_xor(ss, 16); ss += __shfl_xor(ss, 32);
                    const float r = (1.f / sqrtf(ss * (1.f / 64.f) + 1e-5f)) * (type == 3 ? 0.18033688011112042f : 1.f); rr[ai][m] = r;
#pragma unroll
                    for (int bj = 0; bj < 2; ++bj) { const f32x4 v0 = acc[ai][bj][m][0] * r * gv[bj][0], v1 = acc[ai][bj][m][1] * r * gv[bj][1];
                        P1_STORE(rowp, bj, v0, v1); }
                    asm volatile("" ::: "memory"); }
            if (type == 4) {
                float* km = KMEAN + ((size_t)u.pm * 8 + (cb >> 6) + wc) * 64 + 8 * fq;
#pragma unroll
                for (int bj = 0; bj < 2; ++bj)
#pragma unroll
                    for (int n = 0; n < 2; ++n)
#pragma unroll
                        for (int j = 0; j < 4; ++j) { float s = 0.f;
#pragma unroll
                            for (int ai = 0; ai < 2; ++ai)
#pragma unroll
                                for (int m = 0; m < 4; ++m) s += acc[ai][bj][m][n][j] * rr[ai][m];
                            s += __shfl_xor(s, 1); s += __shfl_xor(s, 2); s += __shfl_xor(s, 4); s += __shfl_xor(s, 8);
                            if (fr == 0) atomicAdd(km + 32 * bj + 4 * n + j, s * gv[bj][n][j] * (1.f / 256.f)); }
            }
        }
#undef P1_STORE
    }
};

constexpr int TB_OFF = LDSCTL_OFF + 1024;
__device__ __forceinline__ unsigned cvt_pk(float lo, float hi) { return cvt_pk_bf16(lo, hi); }

struct P3Order {
    pg8::StaticOrder so; int G, c; const unsigned char* ws;
    __device__ void init(int G_, int c_, const unsigned char* ws_) { so.init(NTOK, 1024, 1, 0); G = G_; c = c_; ws = ws_; }
    __device__ bool next(int i, pg9::Unit& u) const {
        const int tl = (i / 3) * G + c; if (tl >= 256) return false; pg8::Unit t; so.next(tl, t); u.pm = t.pm; u.pn = t.pn; u.aux = i % 3; u.cnt = 256; return true; }
    __device__ __forceinline__ const char* a_base(const pg9::Unit& u) const { return (const char*)(ws + WS_ORET) + (size_t)u.aux * (WS_OMOBA - WS_ORET) + (size_t)u.pm * 256 * 512 * 2; }
    __device__ __forceinline__ const char* b_base(const pg9::Unit& u) const { return (const char*)(ws + WS_WBR) + (size_t)u.aux * 1024 * 512 * 2 + (size_t)u.pn * 256 * 512 * 2; }
};
struct EpiP3 {
    static constexpr bool PERM = true, CHAIN = true;
    const bf16_t* GT; bf16_t* Y;
    __device__ __forceinline__ bool chain_more(const pg9::Unit& u) const { return u.aux < 2; }
    __device__ __forceinline__ void rescale(pg8::f32x4 (&acc)[2][2][4][2], const pg9::Unit& u, int wr, int wc, int fr, int fq) const {
        const int s = u.aux;
#pragma unroll
        for (int ai = 0; ai < 2; ++ai)
#pragma unroll
            for (int m = 0; m < 4; ++m) { const bf16_t* gp = GT + (size_t)(u.pm * 256 + 128 * ai + 64 * wr + 16 * m + fr) * 3072 + s * 1024 + u.pn * 256 + 32 * wc + 8 * fq;
#pragma unroll
                for (int bj = 0; bj < 2; ++bj) { const pg8::u32x4 ga = *(const pg8::u32x4*)(gp + 128 * bj), gb = *(const pg8::u32x4*)(gp + 1024 + 128 * bj);
#pragma unroll
                    for (int n = 0; n < 2; ++n)
#pragma unroll
                        for (int j = 0; j < 4; ++j) { const int e = 4 * n + j; const unsigned wa = ga[e >> 1], wb = gb[e >> 1];
                            const float fa = __uint_as_float((e & 1) ? (wa & 0xffff0000u) : (wa << 16)), fb = __uint_as_float((e & 1) ? (wb & 0xffff0000u) : (wb << 16));
                            acc[ai][bj][m][n][j] *= fa * __builtin_amdgcn_rcpf(fmaxf(fb, 1e-20f)); } }
                asm volatile("" ::: "memory"); }
    }
    __device__ __forceinline__ void operator()(const pg8::f32x4 (&acc)[2][2][4][2], const pg9::Unit& u, int wr, int wc, int fr, int fq) const {
#pragma unroll
        for (int ai = 0; ai < 2; ++ai)
#pragma unroll
            for (int m = 0; m < 4; ++m) { const size_t row = (size_t)(u.pm * 256 + 128 * ai + 64 * wr + 16 * m + fr); const bf16_t* gp = GT + row * 3072 + 2048 + u.pn * 256 + 32 * wc + 8 * fq; bf16_t* yp = Y + row * 1024 + u.pn * 256 + 32 * wc + 8 * fq;
#pragma unroll
                for (int bj = 0; bj < 2; ++bj) { const pg8::u32x4 ga = *(const pg8::u32x4*)(gp + 128 * bj); float v[8];
#pragma unroll
                    for (int n = 0; n < 2; ++n)
#pragma unroll
                        for (int j = 0; j < 4; ++j) { const int e = 4 * n + j; const unsigned wa = ga[e >> 1]; v[e] = acc[ai][bj][m][n][j] * __uint_as_float((e & 1) ? (wa & 0xffff0000u) : (wa << 16)); }
                    pg8::u32x4 w; w.x = cvt_pk(v[0], v[1]); w.y = cvt_pk(v[2], v[3]); w.z = cvt_pk(v[4], v[5]); w.w = cvt_pk(v[6], v[7]); *(pg8::u32x4*)(yp + 128 * bj) = w; }
                asm volatile("" ::: "memory"); }
    }
};
struct P4Order {
    pg8::StaticOrder so; int G, c; const unsigned char* ws;
    __device__ void init(int G_, int c_, const unsigned char* ws_) { so.init(NTOK, 1024, 1, 0); G = G_; c = c_; ws = ws_; }
    __device__ bool next(int i, pg9::Unit& u) const { const int tl = i * G + c; if (tl >= 256) return false; pg8::Unit t; so.next(tl, t); u.pm = t.pm; u.pn = t.pn; u.aux = 0; u.cnt = 256; return true; }
    __device__ __forceinline__ const char* a_base(const pg9::Unit& u) const { return (const char*)(ws + WS_Y) + (size_t)u.pm * 256 * 1024 * 2; }
    __device__ __forceinline__ const char* b_base(const pg9::Unit& u) const { return (const char*)(ws + WS_WOUT) + (size_t)u.pn * 256 * 1024 * 2; }
};
struct EpiP4 {
    static constexpr bool PERM = false, CHAIN = false;
    const float* x; float* out;
    __device__ __forceinline__ void operator()(const pg8::f32x4 (&acc)[2][2][4][2], const pg9::Unit& u, int wr, int wc, int fr, int fq) const {
#pragma unroll
        for (int ai = 0; ai < 2; ++ai)
#pragma unroll
            for (int m = 0; m < 4; ++m) { const size_t off = (size_t)(u.pm * 256 + 128 * ai + 64 * wr + 16 * m + fr) * 1024 + u.pn * 256 + 32 * wc + 4 * fq;
#pragma unroll
                for (int bj = 0; bj < 2; ++bj)
#pragma unroll
                    for (int n = 0; n < 2; ++n) { const pg8::f32x4 xv = *(const pg8::f32x4*)(x + off + 128 * bj + 16 * n); *(pg8::f32x4*)(out + off + 128 * bj + 16 * n) = xv + acc[ai][bj][m][n]; }
                if (m & 1) asm volatile("" ::: "memory"); }
    }
};
__device__ __forceinline__ float wave_max64(float v) {
#pragma unroll
    for (int o = 1; o < 64; o <<= 1) v = fmaxf(v, __shfl_xor(v, o));
    return v;
}
__device__ __forceinline__ void p5_router(Frame& F, const float* X1, const float* g_ffn, const float* w_router, const float* b_router) {
    bf16_t* XT = (bf16_t*)(F.ws + WS_XT); int* TOPE = (int*)(F.ws + WS_TOPE); float* TOPW = (float*)(F.ws + WS_TOPW); int* COUNTS = (int*)F.ctl + CW_COUNTS; int* LISTS = (int*)(F.ws + WS_LISTS);
    const int gw = F.vcu * NWAVES + F.wave, NGW = F.G * NWAVES, lane = F.lane, e = lane & 31, kh = lane >> 5;
    LAS float* xs = (LAS float*)(F.lds) + F.wave * 4096;
    for (int t0 = gw * 4; t0 < NTOK; t0 += NGW * 4) {
#pragma unroll 1
        for (int q = 0; q < 4; ++q) { const int t = t0 + q; const float* xr = X1 + (size_t)t * 1024; f32x4 v[4]; float s = 0.f;
#pragma unroll
            for (int j = 0; j < 4; ++j) { v[j] = *(const f32x4*)(xr + 4 * lane + 256 * j); s += (v[j].x * v[j].x + v[j].y * v[j].y) + (v[j].z * v[j].z + v[j].w * v[j].w); }
            const float r = 1.f / sqrtf(wave_sum64(s) * (1.f / 1024.f) + 1e-5f);
#pragma unroll
            for (int j = 0; j < 4; ++j) { const f32x4 g = *(const f32x4*)(g_ffn + 4 * lane + 256 * j); v[j] = v[j] * r * g; *(LAS f32x4*)(xs + q * 1024 + 4 * lane + 256 * j) = v[j];
                uint2 w; w.x = cvt_pk(v[j].x, v[j].y); w.y = cvt_pk(v[j].z, v[j].w); *(uint2*)(XT + (size_t)t * 1024 + 4 * lane + 256 * j) = w; } }
        asm volatile("s_waitcnt lgkmcnt(0)" ::: "memory");
        float acc[4] = {0.f, 0.f, 0.f, 0.f};
        const float* wp = w_router + (size_t)(512 * kh) * 32 + e;
#pragma unroll 2
        for (int k = 0; k < 512; k += 4) { const float w0 = wp[(k + 0) * 32], w1 = wp[(k + 1) * 32], w2 = wp[(k + 2) * 32], w3 = wp[(k + 3) * 32];
#pragma unroll
            for (int q = 0; q < 4; ++q) { const f32x4 x = *(const LAS f32x4*)(xs + q * 1024 + 512 * kh + k); acc[q] += x.x * w0 + x.y * w1 + x.z * w2 + x.w * w3; } }
        const float bias = b_router[e];
#pragma unroll
        for (int q = 0; q < 4; ++q) { const int t = t0 + q; float lg = acc[q] + __shfl_xor(acc[q], 32) + bias; if (lane >= 32) lg = -INFINITY;
            float tv[4]; int te[4];
#pragma unroll
            for (int k = 0; k < 4; ++k) { const float m = wave_max64(lg); const unsigned long long bal = __ballot(lg == m); const int ee = __ffsll((long long)bal) - 1; tv[k] = m; te[k] = ee; if (lane == ee) lg = -INFINITY; }
            float ex[4], se = 0.f;
#pragma unroll
            for (int k = 0; k < 4; ++k) { ex[k] = __expf(tv[k] - tv[0]); se += ex[k]; }
            int e_l = te[0]; float w_l = ex[0];
#pragma unroll
            for (int k = 1; k < 4; ++k) if (lane == k) { e_l = te[k]; w_l = ex[k]; }
            if (lane < 4) { TOPE[t * 4 + lane] = e_l; TOPW[t * 4 + lane] = w_l / se; const int pos = atomicAdd(&COUNTS[e_l], 1); LISTS[(size_t)e_l * 16384 + pos] = t * 4 + lane; } }
        asm volatile("s_waitcnt lgkmcnt(0)" ::: "memory");
    }
}
__device__ __forceinline__ void moe_tables(Frame& F) {
    volatile LAS int* TB = (volatile LAS int*)(F.lds + TB_OFF);
    if (F.tid == 0) { const int* COUNTS = (const int*)F.ctl + CW_COUNTS; int acc = 0; for (int e = 0; e < 32; ++e) { const int c = __hip_atomic_load(COUNTS + e, __ATOMIC_RELAXED, __HIP_MEMORY_SCOPE_AGENT); TB[e] = acc; TB[33 + e] = c; acc += (c + 255) >> 8; } TB[32] = acc; }
    __syncthreads();
}
template <int NPN_LOG2, size_t WOFF, int NROWS_B, int ASHIFT, size_t AOFF> struct MoeOrder {
    int G, c; const unsigned char* ws; const LAS int* TB; const int* LISTS;
    __device__ void init(int G_, int c_, const unsigned char* ws_, const LAS int* TB_) { G = G_; c = c_; ws = ws_; TB = TB_; LISTS = (const int*)(ws_ + WS_LISTS); }
    __device__ bool next(int i, pg9::Unit& u) const {
        const int L = i * G + c; const int mt = L >> NPN_LOG2; if (mt >= TB[32]) return false;
        int e = 0;
#pragma unroll 1
        for (int k = 16; k >= 1; k >>= 1) if (TB[e + k] <= mt) e += k;
        u.aux = e; u.pm = mt - TB[e]; u.pn = L & ((1 << NPN_LOG2) - 1); u.cnt = TB[33 + e] - u.pm * 256; return true;
    }
    __device__ __forceinline__ const char* a_base(const pg9::Unit&) const { return (const char*)(ws + AOFF); }
    __device__ __forceinline__ const char* b_base(const pg9::Unit& u) const { return (const char*)(ws + WOFF) + ((size_t)u.aux * NROWS_B + (size_t)u.pn * 256) * 1024 * 2; }
    __device__ __forceinline__ unsigned a_row_off(const pg9::Unit& u, int r) const { const int rr = r < u.cnt ? r : u.cnt - 1; const int id = LISTS[(size_t)u.aux * 16384 + u.pm * 256 + rr]; return (unsigned)(id >> ASHIFT) * 2048u; }
};
struct EpiMoe1 {
    static constexpr bool PERM = true, CHAIN = false;
    const int* LISTS; const float* b1; bf16_t* ACT;
    __device__ __forceinline__ void operator()(const pg8::f32x4 (&acc)[2][2][4][2], const pg9::Unit& u, int wr, int wc, int fr, int fq) const {
        const int e = u.aux; const int c0 = u.pn * 256 + 32 * wc + 8 * fq;
        pg8::f32x4 bv[2][2];
#pragma unroll
        for (int bj = 0; bj < 2; ++bj)
#pragma unroll
            for (int n = 0; n < 2; ++n) bv[bj][n] = *(const pg8::f32x4*)(b1 + (size_t)e * 2048 + c0 + 128 * bj + 4 * n);
#pragma unroll
        for (int ai = 0; ai < 2; ++ai)
#pragma unroll
            for (int m = 0; m < 4; ++m) { const int r = 128 * ai + 64 * wr + 16 * m + fr; const bool ok = r < u.cnt; const int id = ok ? LISTS[(size_t)e * 16384 + u.pm * 256 + r] : 0;
#pragma unroll
                for (int bj = 0; bj < 2; ++bj) { float a[4];
#pragma unroll
                    for (int n = 0; n < 2; ++n)
#pragma unroll
                        for (int p = 0; p < 2; ++p) { const float gl = fminf(acc[ai][bj][m][n][2 * p] + bv[bj][n][2 * p], 7.0f); const float li = fminf(fmaxf(acc[ai][bj][m][n][2 * p + 1] + bv[bj][n][2 * p + 1], -7.0f), 7.0f);
                            a[2 * n + p] = gl * sigmoid_f(1.702f * gl) * (li + 1.f); }
                    if (ok) { uint2 w; w.x = cvt_pk(a[0], a[1]); w.y = cvt_pk(a[2], a[3]); *(uint2*)(ACT + (size_t)id * 1024 + ((c0 + 128 * bj) >> 1)) = w; } }
                asm volatile("" ::: "memory"); }
    }
};
struct EpiMoe2 {
    static constexpr bool PERM = true, CHAIN = false;
    const int* LISTS; const float* b2; bf16_t* YS;
    __device__ __forceinline__ void operator()(const pg8::f32x4 (&acc)[2][2][4][2], const pg9::Unit& u, int wr, int wc, int fr, int fq) const {
        const int e = u.aux; const int c0 = u.pn * 256 + 32 * wc + 8 * fq;
        pg8::f32x4 bv[2][2];
#pragma unroll
        for (int bj = 0; bj < 2; ++bj)
#pragma unroll
            for (int n = 0; n < 2; ++n) bv[bj][n] = *(const pg8::f32x4*)(b2 + (size_t)e * 1024 + c0 + 128 * bj + 4 * n);
#pragma unroll
        for (int ai = 0; ai < 2; ++ai)
#pragma unroll
            for (int m = 0; m < 4; ++m) { const int r = 128 * ai + 64 * wr + 16 * m + fr; const bool ok = r < u.cnt; const int id = ok ? LISTS[(size_t)e * 16384 + u.pm * 256 + r] : 0;
#pragma unroll
                for (int bj = 0; bj < 2; ++bj) { const pg8::f32x4 v0 = acc[ai][bj][m][0] + bv[bj][0], v1 = acc[ai][bj][m][1] + bv[bj][1];
                    if (ok) { pg8::u32x4 w; w.x = cvt_pk(v0[0], v0[1]); w.y = cvt_pk(v0[2], v0[3]); w.z = cvt_pk(v1[0], v1[1]); w.w = cvt_pk(v1[2], v1[3]); *(pg8::u32x4*)(YS + (size_t)id * 1024 + c0 + 128 * bj) = w; } }
                asm volatile("" ::: "memory"); }
    }
};
__device__ __forceinline__ void p8_combine(Frame& F, float* out) {
    const bf16_t* YS = (const bf16_t*)(F.ws + WS_YS); const float* TOPW = (const float*)(F.ws + WS_TOPW);
    const int gw = F.vcu * NWAVES + F.wave, NGW = F.G * NWAVES, lane = F.lane;
    for (int t = gw; t < NTOK; t += NGW) {
        const f32x4 w4 = *(const f32x4*)(TOPW + (size_t)t * 4);
#pragma unroll
        for (int j = 0; j < 2; ++j) {
            const int c = 8 * lane + 512 * j; f32x4 a0 = *(const f32x4*)(out + (size_t)t * 1024 + c), a1 = *(const f32x4*)(out + (size_t)t * 1024 + c + 4);
#pragma unroll
            for (int k = 0; k < 4; ++k) { const v4u y = *(const v4u*)(YS + ((size_t)t * 4 + k) * 1024 + c); const float wk = w4[k];
                a0.x += wk * __uint_as_float(y.x << 16); a0.y += wk * __uint_as_float(y.x & 0xffff0000u); a0.z += wk * __uint_as_float(y.y << 16); a0.w += wk * __uint_as_float(y.y & 0xffff0000u);
                a1.x += wk * __uint_as_float(y.z << 16); a1.y += wk * __uint_as_float(y.z & 0xffff0000u); a1.z += wk * __uint_as_float(y.w << 16); a1.w += wk * __uint_as_float(y.w & 0xffff0000u); }
            *(f32x4*)(out + (size_t)t * 1024 + c) = a0; *(f32x4*)(out + (size_t)t * 1024 + c + 4) = a1; }
    }
}
namespace att {
typedef float f32x16 __attribute__((ext_vector_type(16)));
typedef short s16x4 __attribute__((ext_vector_type(4)));
typedef short v4i16_t __attribute__((ext_vector_type(4)));
using pg8::bf16x8;
constexpr float LOG2E = 1.4426950408889634f;
__device__ __forceinline__ constexpr int crow(int r, int hi) { return (r & 3) + 8 * (r >> 2) + 4 * hi; }
template <int D> __device__ __forceinline__ int kswz(int row) { return D == 64 ? ((row >> 1) & 7) : (row & 15); }
template <int D> __device__ __forceinline__ int vswz(int row) { return D == 64 ? (((row >> 1) & 1) << 2) : ((row & 3) << 2); }
__device__ __forceinline__ s16x4 vtr(const LAS unsigned char* p) { return __builtin_bit_cast(s16x4, __builtin_amdgcn_ds_read_tr16_b64_v4i16((LAS v4i16_t*)p)); }
__device__ __forceinline__ bf16x8 pack8(const f32x16& x, int s) {
    typedef unsigned u32x4_t __attribute__((ext_vector_type(4))); u32x4_t p;
    p[0] = cvt_pk_bf16(x[8 * s + 0], x[8 * s + 1]); p[1] = cvt_pk_bf16(x[8 * s + 2], x[8 * s + 3]); p[2] = cvt_pk_bf16(x[8 * s + 4], x[8 * s + 5]); p[3] = cvt_pk_bf16(x[8 * s + 6], x[8 * s + 7]);
    return __builtin_bit_cast(bf16x8, p);
}
__device__ __forceinline__ float bfl(unsigned w) { return __uint_as_float(w << 16); }
__device__ __forceinline__ float bfh(unsigned w) { return __uint_as_float(w & 0xffff0000u); }

template <bool MOBA> __device__ __forceinline__ int tile_kbase(int tt, int qb) { if (!MOBA) return 64 * tt; if (tt < 4) return qb * 256 + 64 * tt; const int u = tt - 4; return (u >> 2) * 256 + 64 * (u & 3); }
template <int D, bool MOBA>
__device__ __forceinline__ void attn_unit(Frame& F, const int b, const int h, const int qb,
                                          const bf16_t* Qg, const bf16_t* Kg, const bf16_t* Vg, bf16_t* Og, const int ld,
                                          const float* KMEAN, const float* KSS, const float* gq, const float* gk) {
    constexpr int KB = 64 * D * 2, NKS = D / 16, NDH = D / 32, CPR = D / 8  , NST = (64 * CPR) / 512  ;
    int tid = F.tid, lane = F.lane; asm volatile("" : "+v"(tid), "+v"(lane));
    const int wave = F.wave, r32 = lane & 31, hi = lane >> 5;
    LAS unsigned char* lds = F.lds;
    const size_t qrow = (size_t)b * SEQ + qb * 256 + wave * 32 + r32;
    bf16x8 qr[NKS];
#pragma unroll
    for (int ks = 0; ks < NKS; ++ks) qr[ks] = *(const bf16x8*)(Qg + qrow * ld + h * D + 16 * ks + 8 * hi);
    unsigned selmask = 0u;
    if constexpr (MOBA) {
        if (qb > 0) {
            float qf[NKS * 8];
#pragma unroll
            for (int ks = 0; ks < NKS; ++ks) { const pg8::u32x4 w = __builtin_bit_cast(pg8::u32x4, qr[ks]);
#pragma unroll
                for (int j = 0; j < 4; ++j) { qf[ks * 8 + 2 * j] = bfl(w[j]); qf[ks * 8 + 2 * j + 1] = bfh(w[j]); } }
            float v0 = -INFINITY, v1 = -INFINITY, v2 = -INFINITY; int i0 = -1, i1 = -1, i2 = -1;
#pragma unroll 1
            for (int j = 0; j < qb; ++j) { const float* km = KMEAN + (((size_t)b * 16 + j) * 8 + h) * 64 + 8 * hi; float s = 0.f;
#pragma unroll
                for (int ks = 0; ks < NKS; ++ks) { const f32x4 k0 = *(const f32x4*)(km + 16 * ks), k1 = *(const f32x4*)(km + 16 * ks + 4);
                    s += qf[ks * 8 + 0] * k0[0] + qf[ks * 8 + 1] * k0[1] + qf[ks * 8 + 2] * k0[2] + qf[ks * 8 + 3] * k0[3] + qf[ks * 8 + 4] * k1[0] + qf[ks * 8 + 5] * k1[1] + qf[ks * 8 + 6] * k1[2] + qf[ks * 8 + 7] * k1[3]; }
                s += __shfl_xor(s, 32);
                const bool c0 = s > v0, c1 = s > v1, c2 = s > v2;
                v2 = c1 ? v1 : (c2 ? s : v2); i2 = c1 ? i1 : (c2 ? j : i2);
                v1 = c0 ? v0 : (c1 ? s : v1); i1 = c0 ? i0 : (c1 ? j : i1);
                v0 = c0 ? s : v0; i0 = c0 ? j : i0; }
            selmask = (i0 >= 0 ? (1u << i0) : 0u) | (i1 >= 0 ? (1u << i1) : 0u) | (i2 >= 0 ? (1u << i2) : 0u);
        }
    } else {
        float qf[NKS * 8]; float ss = 0.f;
#pragma unroll
        for (int ks = 0; ks < NKS; ++ks) { const pg8::u32x4 w = __builtin_bit_cast(pg8::u32x4, qr[ks]);
#pragma unroll
            for (int j = 0; j < 4; ++j) { qf[ks * 8 + 2 * j] = bfl(w[j]); qf[ks * 8 + 2 * j + 1] = bfh(w[j]); ss += qf[ks * 8 + 2 * j] * qf[ks * 8 + 2 * j] + qf[ks * 8 + 2 * j + 1] * qf[ks * 8 + 2 * j + 1]; } }
        ss += __shfl_xor(ss, 32);
        const float rq = (1.f / sqrtf(ss * (1.f / D) + 1e-5f)) * (0.08838834764831845f * LOG2E);
#pragma unroll
        for (int ks = 0; ks < NKS; ++ks) { const float* g1 = gq + 16 * ks + 8 * hi; const float* g2 = gk + 16 * ks + 8 * hi; pg8::u32x4 w;
#pragma unroll
            for (int j = 0; j < 4; ++j) w[j] = cvt_pk_bf16(qf[ks * 8 + 2 * j] * rq * g1[2 * j] * g2[2 * j], qf[ks * 8 + 2 * j + 1] * rq * g1[2 * j + 1] * g2[2 * j + 1]);
            qr[ks] = __builtin_bit_cast(bf16x8, w); }
    }
    const int NT = MOBA ? 4 * (qb + 1) : 4;
    const float sl2 = MOBA ? exp2f(-(float)(h + 1)) * LOG2E : 0.f;
    v4u kreg[NST], vreg[NST];
#define ATT_LOAD(tt) do { const int kb_ = tile_kbase<MOBA>(tt, qb); _Pragma("unroll") for (int i_ = 0; i_ < NST; ++i_) { const int ci_ = tid + 512 * i_, row_ = ci_ / CPR, ch_ = ci_ % CPR; \
        const size_t g_ = (size_t)(kb_ + row_) * ld + h * D + 8 * ch_; kreg[i_] = *(const v4u*)(Kg + g_); vreg[i_] = *(const v4u*)(Vg + g_); \
        if (!MOBA) { const float rk_ = 1.f / sqrtf(KSS[(size_t)(kb_ + row_) * 4 + h] * (1.f / D) + 1e-5f); v4u k_ = kreg[i_]; \
            k_.x = cvt_pk_bf16(bfl(k_.x) * rk_, bfh(k_.x) * rk_); k_.y = cvt_pk_bf16(bfl(k_.y) * rk_, bfh(k_.y) * rk_); k_.z = cvt_pk_bf16(bfl(k_.z) * rk_, bfh(k_.z) * rk_); k_.w = cvt_pk_bf16(bfl(k_.w) * rk_, bfh(k_.w) * rk_); kreg[i_] = k_; } } } while (0)
#define ATT_WRITE(buf) do { _Pragma("unroll") for (int i_ = 0; i_ < NST; ++i_) { const int ci_ = tid + 512 * i_, row_ = ci_ / CPR, ch_ = ci_ % CPR; \
        *(LAS v4u*)(lds + (buf) * KB + row_ * (2 * D) + ((ch_ ^ kswz<D>(row_)) << 4)) = kreg[i_]; *(LAS v4u*)(lds + (2 + (buf)) * KB + row_ * (2 * D) + ((ch_ ^ vswz<D>(row_)) << 4)) = vreg[i_]; } } while (0)
    ATT_LOAD(0); ATT_WRITE(0);
    __syncthreads();
    float m = -1e30f, l = 0.f;
    f32x16 o[NDH];
#pragma unroll
    for (int dh = 0; dh < NDH; ++dh)
#pragma unroll
        for (int r = 0; r < 16; ++r) o[dh][r] = 0.f;
    const int qrel = wave * 32 + r32;
    const int i16 = lane & 15, blk = (lane >> 4) & 1, tq = i16 >> 2, tp = i16 & 3;
    for (int tt = 0; tt < NT; ++tt) {
        const int buf = tt & 1;
        if (tt + 1 < NT) ATT_LOAD(tt + 1);
        bool act = true; bool lane_sel = true; int pblk = -1;
        if constexpr (MOBA) { if (tt >= 4) { pblk = (tt - 4) >> 2; lane_sel = (selmask >> pblk) & 1u; act = __builtin_amdgcn_ballot_w64(lane_sel) != 0ull; }
            else act = (64 * tt <= wave * 32 + 31); }
        if (act) {
            f32x16 p0, p1;
#pragma unroll
            for (int r = 0; r < 16; ++r) { p0[r] = 0.f; p1[r] = 0.f; }
            const LAS unsigned char* Kb = lds + buf * KB;
#pragma unroll
            for (int ks = 0; ks < NKS; ++ks) {
                const bf16x8 a0 = *(const LAS bf16x8*)(Kb + r32 * (2 * D) + (((2 * ks + hi) ^ kswz<D>(r32)) << 4));
                const bf16x8 a1 = *(const LAS bf16x8*)(Kb + (32 + r32) * (2 * D) + (((2 * ks + hi) ^ kswz<D>(32 + r32)) << 4));
                p0 = __builtin_amdgcn_mfma_f32_32x32x16_bf16(a0, qr[ks], p0, 0, 0, 0);
                p1 = __builtin_amdgcn_mfma_f32_32x32x16_bf16(a1, qr[ks], p1, 0, 0, 0);
            }
            if constexpr (MOBA) {
                const int kb = tile_kbase<MOBA>(tt, qb); const float offl = sl2 * (float)(kb - qb * 256 + 4 * hi);
#pragma unroll
                for (int r = 0; r < 16; ++r) { p0[r] += sl2 * (float)((r & 3) + 8 * (r >> 2)) + offl; p1[r] += sl2 * (float)(32 + (r & 3) + 8 * (r >> 2)) + offl; }
                if (tt < 4) {
                    const int k0 = 64 * tt + 4 * hi;
#pragma unroll
                    for (int r = 0; r < 16; ++r) { const int kv = k0 + (r & 3) + 8 * (r >> 2); if (kv > qrel) p0[r] = -INFINITY; if (kv + 32 > qrel) p1[r] = -INFINITY; }
                } else if (!lane_sel) {
#pragma unroll
                    for (int r = 0; r < 16; ++r) { p0[r] = -INFINITY; p1[r] = -INFINITY; }
                }
            }
            float mx = fmaxf(p0[0], p1[0]);
#pragma unroll
            for (int r = 1; r < 16; ++r) mx = fmaxf(mx, fmaxf(p0[r], p1[r]));
            mx = fmaxf(mx, __shfl_xor(mx, 32));
            const float mnew = fmaxf(m, mx);
            if (__builtin_amdgcn_ballot_w64(mnew > m) != 0ull) { const float alpha = __builtin_amdgcn_exp2f(m - mnew); l *= alpha;
#pragma unroll
                for (int dh = 0; dh < NDH; ++dh)
#pragma unroll
                    for (int r = 0; r < 16; ++r) o[dh][r] *= alpha;
                m = mnew; }
            float ps = 0.f;
#pragma unroll
            for (int r = 0; r < 16; ++r) { p0[r] = __builtin_amdgcn_exp2f(p0[r] - m); p1[r] = __builtin_amdgcn_exp2f(p1[r] - m); ps += p0[r] + p1[r]; }
            l += ps;
            const LAS unsigned char* Vb = lds + (2 + buf) * KB;
#pragma unroll
            for (int kh = 0; kh < 2; ++kh)
#pragma unroll
                for (int s = 0; s < 2; ++s) {
                    const bf16x8 pb = pack8(kh ? p1 : p0, s);
#pragma unroll
                    for (int dh = 0; dh < NDH; ++dh) {
                        const int rowA = 32 * kh + 16 * s + 4 * hi + tq, rowB = rowA + 8, chv = 4 * dh + 2 * blk + (tp >> 1);
                        const s16x4 lo = vtr(Vb + rowA * (2 * D) + ((chv ^ vswz<D>(rowA)) << 4) + 8 * (tp & 1));
                        const s16x4 hh = vtr(Vb + rowB * (2 * D) + ((chv ^ vswz<D>(rowB)) << 4) + 8 * (tp & 1));
                        const bf16x8 va = (bf16x8){lo[0], lo[1], lo[2], lo[3], hh[0], hh[1], hh[2], hh[3]};
                        o[dh] = __builtin_amdgcn_mfma_f32_32x32x16_bf16(va, pb, o[dh], 0, 0, 0);
                    }
                }
        }
        if (tt + 1 < NT) ATT_WRITE(buf ^ 1);
        __syncthreads();
    }
    l += __shfl_xor(l, 32);
    const float inv = 1.f / l;
    bf16_t* orow = Og + qrow * ld + h * D;
#pragma unroll
    for (int dh = 0; dh < NDH; ++dh)
#pragma unroll
        for (int g = 0; g < 4; ++g) { uint2 w; w.x = cvt_pk_bf16(o[dh][4 * g] * inv, o[dh][4 * g + 1] * inv); w.y = cvt_pk_bf16(o[dh][4 * g + 2] * inv, o[dh][4 * g + 3] * inv);
            *(uint2*)(orow + 32 * dh + 8 * g + 4 * hi) = w; }
#undef ATT_LOAD
#undef ATT_WRITE
}
}
__device__ __forceinline__ void p2_moba(Frame& F) {
    const bf16_t* MQ = (const bf16_t*)(F.ws + WS_MQ); const bf16_t* MK = (const bf16_t*)(F.ws + WS_MK); const bf16_t* MV = (const bf16_t*)(F.ws + WS_MV); bf16_t* OM = (bf16_t*)(F.ws + WS_OMOBA);
    for (int pr = F.vcu; pr < 256; pr += F.G) { const int bh = pr >> 3, p = pr & 7, b = bh >> 3, h = bh & 7;
#pragma unroll 1
        for (int k = 0; k < 2; ++k) { const int qb = k ? 15 - p : p;
            att::attn_unit<64, true>(F, b, h, qb, MQ, MK + (size_t)b * SEQ * 512, MV + (size_t)b * SEQ * 512, OM, 512, (const float*)(F.ctl + CW_KMEAN), nullptr, nullptr, nullptr); } }
}
__device__ __forceinline__ void p2_mem(Frame& F, const float* g_mem_q, const float* g_mem_k) {
    const bf16_t* CQ = (const bf16_t*)(F.ws + WS_CQ); const bf16_t* MEMK = (const bf16_t*)(F.ws + WS_MEMK); const bf16_t* MEMV = (const bf16_t*)(F.ws + WS_MEMV); bf16_t* OM = (bf16_t*)(F.ws + WS_OMEM);
#pragma unroll 1
    for (int u = F.vcu; u < 256; u += F.G) { const int bh = u >> 4, qb = u & 15, b = bh >> 2, h = bh & 3;
        att::attn_unit<128, false>(F, b, h, qb, CQ, MEMK + (size_t)b * MEMLEN * 512, MEMV + (size_t)b * MEMLEN * 512, OM, 512, nullptr, (const float*)(F.ctl + CW_MEMKSS) + (size_t)b * MEMLEN * 4, g_mem_q, g_mem_k); }
}
namespace ret {
using att::f32x16; using att::s16x4; using att::vtr; using att::pack8; using att::kswz; using att::vswz; using att::crow; using pg8::bf16x8;
constexpr int L_KT = 0, L_KD = 16384, L_VT = 32768, L_SB = 65536, L_SS = 98304;
__device__ __forceinline__ void retention_item(Frame& F, const int b, const int h, const float* g_ret_out) {
    const bf16_t* RQ = (const bf16_t*)(F.ws + WS_RQ); const bf16_t* RK = (const bf16_t*)(F.ws + WS_RK); const bf16_t* RV = (const bf16_t*)(F.ws + WS_RV); const bf16_t* RG = (const bf16_t*)(F.ws + WS_RG); bf16_t* ORET = (bf16_t*)(F.ws + WS_ORET);
    int tid = F.tid, lane = F.lane; asm volatile("" : "+v"(tid), "+v"(lane));
    const int wave = F.wave;
    LAS unsigned char* lds = F.lds;
    const float lg2_o = log2f(1.f - exp2f(-5.f - (float)h)), g128 = exp2f(128.f * lg2_o);
    const size_t tok0 = (size_t)b * SEQ;
    v4u kreg[2], vreg[4];
#define RET_LOAD(n) do { _Pragma("unroll") for (int i_ = 0; i_ < 2; ++i_) { const int ci_ = tid + 512 * i_; kreg[i_] = *(const v4u*)(RK + (tok0 + (n) * 128 + (ci_ >> 3)) * 256 + h * 64 + 8 * (ci_ & 7)); } \
        _Pragma("unroll") for (int i_ = 0; i_ < 4; ++i_) { const int ci_ = tid + 512 * i_; vreg[i_] = *(const v4u*)(RV + (tok0 + (n) * 128 + (ci_ >> 4)) * 512 + h * 128 + 8 * (ci_ & 15)); } } while (0)
#define RET_WRITE() do { _Pragma("unroll") for (int i_ = 0; i_ < 2; ++i_) { const int ci_ = tid + 512 * i_, row_ = ci_ >> 3, ch_ = ci_ & 7; const v4u k_ = kreg[i_]; \
            *(LAS v4u*)(lds + L_KT + row_ * 128 + ((ch_ ^ kswz<64>(row_)) << 4)) = k_; const float dk_ = __builtin_amdgcn_exp2f(lg2 * (float)(127 - row_)); v4u d_; \
            d_.x = cvt_pk_bf16(att::bfl(k_.x) * dk_, att::bfh(k_.x) * dk_); d_.y = cvt_pk_bf16(att::bfl(k_.y) * dk_, att::bfh(k_.y) * dk_); d_.z = cvt_pk_bf16(att::bfl(k_.z) * dk_, att::bfh(k_.z) * dk_); d_.w = cvt_pk_bf16(att::bfl(k_.w) * dk_, att::bfh(k_.w) * dk_); \
            *(LAS v4u*)(lds + L_KD + row_ * 128 + ((ch_ ^ vswz<64>(row_)) << 4)) = d_; } \
        _Pragma("unroll") for (int i_ = 0; i_ < 4; ++i_) { const int ci_ = tid + 512 * i_, row_ = ci_ >> 4, ch_ = ci_ & 15; *(LAS v4u*)(lds + L_VT + row_ * 256 + ((ch_ ^ vswz<128>(row_)) << 4)) = vreg[i_]; } } while (0)
    { const float lg2 = lg2_o; RET_LOAD(0); RET_WRITE(); }
    { const v4u z = {0u, 0u, 0u, 0u}; *(LAS v4u*)(lds + L_SB + tid * 32) = z; *(LAS v4u*)(lds + L_SB + tid * 32 + 16) = z; }
    f32x16 st;
#pragma unroll
    for (int r = 0; r < 16; ++r) st[r] = 0.f;
    const int ib = wave & 3, e2 = wave >> 2;
    LAS float* ssb = (LAS float*)(lds + L_SS);
    __syncthreads();
    for (int n = 0; n < 32; ++n) {
        int lane_n = lane; float lg2 = lg2_o; asm volatile("" : "+v"(lane_n), "+v"(lg2));
        const int r32 = lane_n & 31, hi = lane_n >> 5, i16 = lane_n & 15, blk = (lane_n >> 4) & 1, tq = i16 >> 2, tp = i16 & 3;
        const LAS unsigned char* Sb = lds + L_SB + (n & 1) * 16384; LAS unsigned char* Sn = lds + L_SB + ((n + 1) & 1) * 16384;
        const size_t tokrow = tok0 + n * 128 + 32 * ib + r32;
        f32x16 o[2];
        {
            bf16x8 qr[4];
#pragma unroll
            for (int ks = 0; ks < 4; ++ks) qr[ks] = *(const bf16x8*)(RQ + tokrow * 256 + h * 64 + 16 * ks + 8 * hi);
#pragma unroll
            for (int q2 = 0; q2 < 2; ++q2) {
#pragma unroll
                for (int r = 0; r < 16; ++r) o[q2][r] = 0.f;
                const int e = 64 * e2 + 32 * q2 + r32;
#pragma unroll
                for (int ks = 0; ks < 4; ++ks) { const bf16x8 a = *(const LAS bf16x8*)(Sb + e * 128 + (((2 * ks + hi) ^ kswz<64>(e)) << 4)); o[q2] = __builtin_amdgcn_mfma_f32_32x32x16_bf16(a, qr[ks], o[q2], 0, 0, 0); } }
            const float gq = __builtin_amdgcn_exp2f(lg2 * (float)(32 * ib + r32 + 1));
#pragma unroll
            for (int q2 = 0; q2 < 2; ++q2)
#pragma unroll
                for (int r = 0; r < 16; ++r) o[q2][r] *= gq;
            __builtin_amdgcn_sched_barrier(0);
#pragma unroll 1
            for (int jb = 0; jb <= ib; ++jb) {
                f32x16 p;
#pragma unroll
                for (int r = 0; r < 16; ++r) p[r] = 0.f;
                const int krow_ = 32 * jb + r32;
#pragma unroll
                for (int ks = 0; ks < 4; ++ks) { const bf16x8 a = *(const LAS bf16x8*)(lds + L_KT + krow_ * 128 + (((2 * ks + hi) ^ kswz<64>(krow_)) << 4)); p = __builtin_amdgcn_mfma_f32_32x32x16_bf16(a, qr[ks], p, 0, 0, 0); }
                const float cl = __builtin_amdgcn_exp2f(lg2 * (float)(32 * (ib - jb) + r32 - 4 * hi));
                const bool diag = (jb == ib);
#pragma unroll
                for (int r = 0; r < 16; ++r) { float v = p[r] * (cl * __builtin_amdgcn_exp2f(-lg2 * (float)((r & 3) + 8 * (r >> 2)))); if (diag && ((r & 3) + 8 * (r >> 2) + 4 * hi) > r32) v = 0.f; p[r] = v; }
#pragma unroll
                for (int s = 0; s < 2; ++s) { const bf16x8 pb = pack8(p, s);
                    const int rowA = 32 * jb + 16 * s + 4 * hi + tq, rowB = rowA + 8;
#pragma unroll
                    for (int q2 = 0; q2 < 2; ++q2) { const int chv = 4 * (2 * e2 + q2) + 2 * blk + (tp >> 1);
                        const s16x4 lo = vtr(lds + L_VT + rowA * 256 + ((chv ^ vswz<128>(rowA)) << 4) + 8 * (tp & 1));
                        const s16x4 hh = vtr(lds + L_VT + rowB * 256 + ((chv ^ vswz<128>(rowB)) << 4) + 8 * (tp & 1));
                        const bf16x8 va = (bf16x8){lo[0], lo[1], lo[2], lo[3], hh[0], hh[1], hh[2], hh[3]};
                        o[q2] = __builtin_amdgcn_mfma_f32_32x32x16_bf16(va, pb, o[q2], 0, 0, 0); }
                    __builtin_amdgcn_sched_barrier(0); }
            }
        }
        __builtin_amdgcn_sched_barrier(0);
        { float ss = 0.f;
#pragma unroll
            for (int q2 = 0; q2 < 2; ++q2)
#pragma unroll
                for (int r = 0; r < 16; ++r) ss += o[q2][r] * o[q2][r];
            ss += __shfl_xor(ss, 32);
            if (hi == 0) ssb[e2 * 128 + 32 * ib + r32] = ss; }
        __builtin_amdgcn_sched_barrier(0);
        { const int eh = wave & 3, dh = wave >> 2;
#pragma unroll
            for (int r = 0; r < 16; ++r) st[r] *= g128;
#pragma unroll 1
            for (int kst = 0; kst < 8; ++kst) { const int rowA = 16 * kst + 4 * hi + tq, rowB = rowA + 8, chv = 4 * eh + 2 * blk + (tp >> 1), chk = 4 * dh + 2 * blk + (tp >> 1);
                const s16x4 lo = vtr(lds + L_VT + rowA * 256 + ((chv ^ vswz<128>(rowA)) << 4) + 8 * (tp & 1));
                const s16x4 hh = vtr(lds + L_VT + rowB * 256 + ((chv ^ vswz<128>(rowB)) << 4) + 8 * (tp & 1));
                const s16x4 kl = vtr(lds + L_KD + rowA * 128 + ((chk ^ vswz<64>(rowA)) << 4) + 8 * (tp & 1));
                const s16x4 kh = vtr(lds + L_KD + rowB * 128 + ((chk ^ vswz<64>(rowB)) << 4) + 8 * (tp & 1));
                const bf16x8 va = (bf16x8){lo[0], lo[1], lo[2], lo[3], hh[0], hh[1], hh[2], hh[3]};
                const bf16x8 kb = (bf16x8){kl[0], kl[1], kl[2], kl[3], kh[0], kh[1], kh[2], kh[3]};
                st = __builtin_amdgcn_mfma_f32_32x32x16_bf16(va, kb, st, 0, 0, 0); }
#pragma unroll
            for (int r = 0; r < 16; ++r) { const int e = 32 * eh + (r & 3) + 8 * (r >> 2) + 4 * hi, dd = 32 * dh + r32;
                *(LAS bf16_t*)(Sn + e * 128 + ((((dd >> 3) ^ kswz<64>(e))) << 4) + (dd & 7) * 2) = f2bf(st[r]); } }
        __builtin_amdgcn_sched_barrier(0);
        if (n + 1 < 32) RET_LOAD(n + 1);
        __syncthreads();
        { const float rn = 1.f / sqrtf((ssb[32 * ib + r32] + ssb[128 + 32 * ib + r32]) * (1.f / 128.f) + 1e-5f);
#pragma unroll
            for (int q2 = 0; q2 < 2; ++q2)
#pragma unroll
                for (int g = 0; g < 4; ++g) { const int e = 64 * e2 + 32 * q2 + 8 * g + 4 * hi; const f32x4 gg = *(const f32x4*)(g_ret_out + e); const uint2 rg = *(const uint2*)(RG + tokrow * 512 + h * 128 + e);
                    uint2 w; w.x = cvt_pk_bf16(o[q2][4 * g] * rn * gg[0] * att::bfl(rg.x), o[q2][4 * g + 1] * rn * gg[1] * att::bfh(rg.x)); w.y = cvt_pk_bf16(o[q2][4 * g + 2] * rn * gg[2] * att::bfl(rg.y), o[q2][4 * g + 3] * rn * gg[3] * att::bfh(rg.y));
                    *(uint2*)(ORET + tokrow * 512 + h * 128 + e) = w; } }
        if (n + 1 < 32) RET_WRITE();
        __syncthreads();
    }
#undef RET_LOAD
#undef RET_WRITE
}
}
constexpr int CW_QUEUE = 128;
__device__ __forceinline__ void p2_mixers(Frame& F, const float* g_ret_out, const float* g_mem_q, const float* g_mem_k) {
    volatile LAS int* slot = (volatile LAS int*)(F.lds + TB_OFF + 512);
    const bf16_t* MQ = (const bf16_t*)(F.ws + WS_MQ); const bf16_t* MK = (const bf16_t*)(F.ws + WS_MK); const bf16_t* MV = (const bf16_t*)(F.ws + WS_MV); bf16_t* OMO = (bf16_t*)(F.ws + WS_OMOBA);
    const bf16_t* CQ = (const bf16_t*)(F.ws + WS_CQ); const bf16_t* MEMK = (const bf16_t*)(F.ws + WS_MEMK); const bf16_t* MEMV = (const bf16_t*)(F.ws + WS_MEMV); bf16_t* OME = (bf16_t*)(F.ws + WS_OMEM);
    for (;;) {
        __syncthreads();
        if (F.tid == 0) slot[0] = (int)__hip_atomic_fetch_add((unsigned*)F.ctl + CW_QUEUE, 1u, __ATOMIC_RELAXED, __HIP_MEMORY_SCOPE_AGENT);
        __syncthreads();
        const int it = slot[0];
        if (it >= 16 + 512 + 256) break;
        if (it < 16) ret::retention_item(F, it >> 2, it & 3, g_ret_out);
        else if (it < 528) { const int u = it - 16, qb = 15 - (u >> 5), bh = u & 31, b = bh >> 3, h = bh & 7;
            att::attn_unit<64, true>(F, b, h, qb, MQ, MK + (size_t)b * SEQ * 512, MV + (size_t)b * SEQ * 512, OMO, 512, (const float*)(F.ctl + CW_KMEAN), nullptr, nullptr, nullptr); }
        else { const int u = it - 528, bh = u >> 4, qb = u & 15, b = bh >> 2, h = bh & 3;
            att::attn_unit<128, false>(F, b, h, qb, CQ, MEMK + (size_t)b * MEMLEN * 512, MEMV + (size_t)b * MEMLEN * 512, OME, 512, nullptr, (const float*)(F.ctl + CW_MEMKSS) + (size_t)b * MEMLEN * 4, g_mem_q, g_mem_k); }
    }
}
#define WAVE_LDS_FENCE() do { asm volatile("s_waitcnt lgkmcnt(0)" ::: "memory"); } while (0)
__device__ __forceinline__ void p2_moba_slow(Frame& F) {
    const bf16_t* MQ = (const bf16_t*)(F.ws + WS_MQ); const bf16_t* MK = (const bf16_t*)(F.ws + WS_MK); const bf16_t* MV = (const bf16_t*)(F.ws + WS_MV); const float* KMEAN = (const float*)(F.ctl + CW_KMEAN); bf16_t* OMOBA = (bf16_t*)(F.ws + WS_OMOBA);
    LAS float* sc = (LAS float*)(F.lds) + F.wave * 1152; LAS float* qsh = sc + 1024;
    const int gw = F.vcu * NWAVES + F.wave, NGW = F.G * NWAVES, lane = F.lane;
    for (int w = gw; w < NB * 8 * SEQ; w += NGW) {
        const int t = w & 4095, h = (w >> 12) & 7, b = w >> 15; const int qb = t >> 8; const size_t row = (size_t)b * 4096 + t;
        qsh[lane] = bf2f(MQ[row * 512 + h * 64 + lane]);
        WAVE_LDS_FENCE();
        float q[64];
#pragma unroll
        for (int d = 0; d < 64; ++d) q[d] = qsh[d];
        float gsc = -INFINITY; if (lane < qb) { const float* km = KMEAN + (((size_t)b * 16 + lane) * 8 + h) * 64; float s = 0.f;
#pragma unroll
            for (int d = 0; d < 64; ++d) s += q[d] * km[d];
            gsc = s; }
        int sel[4]; sel[0] = qb;
#pragma unroll
        for (int r = 0; r < 3; ++r) { const float m = wave_max64(gsc); int j = -1; if (m != -INFINITY) { const unsigned long long bal = __ballot(gsc == m); j = __ffsll((long long)bal) - 1; } sel[r + 1] = j; if (lane == j) gsc = -INFINITY; }
        const float slope = exp2f(-(float)(h + 1)); float mx = -INFINITY;
#pragma unroll
        for (int s = 0; s < 4; ++s) { const int blk = sel[s];
            for (int c = 0; c < 4; ++c) { const int kp = blk * 256 + c * 64 + lane; float v = -INFINITY;
                if (blk >= 0 && kp <= t) { const bf16_t* kr = MK + ((size_t)b * 4096 + kp) * 512 + h * 64; float d_ = 0.f;
#pragma unroll
                    for (int d = 0; d < 64; ++d) d_ += q[d] * bf2f(kr[d]);
                    v = d_ * 0.125f - slope * (float)(t - kp); }
                sc[s * 256 + c * 64 + lane] = v; mx = fmaxf(mx, v); } }
        mx = wave_max64(mx); float sum = 0.f;
        for (int i = lane; i < 1024; i += 64) { const float p = __expf(sc[i] - mx); sc[i] = p; sum += p; }
        sum = wave_sum64(sum);
        WAVE_LDS_FENCE();
        float o = 0.f;
#pragma unroll
        for (int s = 0; s < 4; ++s) { const int blk = sel[s]; if (blk >= 0) for (int k = 0; k < 256; ++k) { const float p = sc[s * 256 + k]; if (p != 0.f) o += p * bf2f(MV[((size_t)b * 4096 + blk * 256 + k) * 512 + h * 64 + lane]); } }
        OMOBA[row * 512 + h * 64 + lane] = f2bf(o / sum);
        WAVE_LDS_FENCE();
    }
}
__device__ __forceinline__ void p2_mem_slow(Frame& F, const float* g_mem_q, const float* g_mem_k) {
    const bf16_t* CQ = (const bf16_t*)(F.ws + WS_CQ); const bf16_t* MEMK = (const bf16_t*)(F.ws + WS_MEMK); const bf16_t* MEMV = (const bf16_t*)(F.ws + WS_MEMV); const float* MEMKSS = (const float*)(F.ctl + CW_MEMKSS); bf16_t* OMEM = (bf16_t*)(F.ws + WS_OMEM);
    LAS float* sc = (LAS float*)(F.lds) + F.wave * 1152; LAS float* qsh = sc + 1024;
    const int gw = F.vcu * NWAVES + F.wave, NGW = F.G * NWAVES, lane = F.lane;
    for (int w = gw; w < NB * 4 * SEQ; w += NGW) {
        const int t = w & 4095, h = (w >> 12) & 3, b = w >> 14; const size_t row = (size_t)b * 4096 + t;
        const float q0 = bf2f(CQ[row * 512 + h * 128 + lane]), q1 = bf2f(CQ[row * 512 + h * 128 + 64 + lane]);
        const float rq = 1.f / sqrtf(wave_sum64(q0 * q0 + q1 * q1) * (1.f / 128.f) + 1e-5f);
        qsh[lane] = q0 * rq * g_mem_q[lane] * g_mem_k[lane]; qsh[lane + 64] = q1 * rq * g_mem_q[lane + 64] * g_mem_k[lane + 64];
        WAVE_LDS_FENCE();
        float mx = -INFINITY;
        for (int c = 0; c < 4; ++c) { const int m = c * 64 + lane; const bf16_t* kr = MEMK + ((size_t)b * 256 + m) * 512 + h * 128; float d_ = 0.f; for (int d = 0; d < 128; ++d) d_ += qsh[d] * bf2f(kr[d]);
            const float rk = 1.f / sqrtf(MEMKSS[((size_t)b * 256 + m) * 4 + h] * (1.f / 128.f) + 1e-5f); const float v = d_ * rk * 0.08838834764831845f; sc[m] = v; mx = fmaxf(mx, v); }
        mx = wave_max64(mx); float sum = 0.f;
        for (int i = lane; i < 256; i += 64) { const float p = __expf(sc[i] - mx); sc[i] = p; sum += p; }
        sum = wave_sum64(sum); WAVE_LDS_FENCE();
        float o0 = 0.f, o1 = 0.f;
        for (int k = 0; k < 256; ++k) { const float p = sc[k]; const bf16_t* vr = MEMV + ((size_t)b * 256 + k) * 512 + h * 128; o0 += p * bf2f(vr[lane]); o1 += p * bf2f(vr[lane + 64]); }
        OMEM[row * 512 + h * 128 + lane] = f2bf(o0 / sum); OMEM[row * 512 + h * 128 + 64 + lane] = f2bf(o1 / sum);
        WAVE_LDS_FENCE();
    }
}
__device__ __forceinline__ void p2_ret_slow(Frame& F, const float* g_ret_out) {
    const bf16_t* RQ = (const bf16_t*)(F.ws + WS_RQ); const bf16_t* RK = (const bf16_t*)(F.ws + WS_RK); const bf16_t* RV = (const bf16_t*)(F.ws + WS_RV); const bf16_t* RG = (const bf16_t*)(F.ws + WS_RG); bf16_t* ORET = (bf16_t*)(F.ws + WS_ORET);
    LAS float* qs = (LAS float*)(F.lds) + 16384; LAS float* ks = qs + 64; LAS float* part = ks + 64; LAS float* red = part + 256;
    const int tid = F.tid, e = tid & 127, hf = (tid >> 7) & 1;
    for (int it = F.vcu; it < 16; it += F.G) {
        const int b = it >> 2, h = it & 3; const float gamma = 1.f - exp2f(-5.f - (float)h);
        float s[32];
#pragma unroll
        for (int i = 0; i < 32; ++i) s[i] = 0.f;
        for (int t = 0; t < 4096; ++t) { const size_t row = (size_t)b * 4096 + t;
            if (tid < 64) qs[tid] = bf2f(RQ[row * 256 + h * 64 + tid]); else if (tid < 128) ks[tid - 64] = bf2f(RK[row * 256 + h * 64 + tid - 64]);
            const float v = bf2f(RV[row * 512 + h * 128 + e]);
            __syncthreads();
            float o = 0.f;
            if (tid < 256) {
#pragma unroll
                for (int i = 0; i < 32; ++i) { s[i] = gamma * s[i] + ks[hf * 32 + i] * v; o += qs[hf * 32 + i] * s[i]; }
                part[tid] = o; }
            __syncthreads();
            float ov = 0.f;
            if (tid < 128) { ov = part[tid] + part[tid + 128]; const float ss = wave_sum64(ov * ov); if ((tid & 63) == 0) red[tid >> 6] = ss; }
            __syncthreads();
            if (tid < 128) { const float r = 1.f / sqrtf((red[0] + red[1]) * (1.f / 128.f) + 1e-5f); ORET[row * 512 + h * 128 + tid] = f2bf(ov * r * g_ret_out[tid] * bf2f(RG[row * 512 + h * 128 + tid])); }
        }
    }
}
constexpr int N_PHASES = 9;
__global__ void __launch_bounds__(NWAVES * 64, 2) mega(Args args) {
    extern __shared__ __attribute__((aligned(16))) unsigned char lds[];
    Frame F;
    F.lds = (LAS unsigned char*)lds; F.MISC = (volatile LAS unsigned*)(F.lds + MISC_OFF);
    F.tid = threadIdx.x; F.lane = F.tid & 63; F.wave = __builtin_amdgcn_readfirstlane(F.tid >> 6);
    F.G = gridDim.x; { const int bx = blockIdx.x; F.vcu = (F.G % 8 == 0) ? (bx % 8) * (F.G / 8) + bx / 8 : bx; }
    F.ws = args.ws; F.out = args.out; F.ctl = (gu32*)(args.ws + WS_CTL);
    for (int u = F.tid; u < (LDS_BYTES - LDSCTL_OFF) / 4; u += NWAVES * 64) ((LAS unsigned*)(F.lds + LDSCTL_OFF))[u] = 0u;
    __syncthreads();
    XcdBarrier bar = xcd_barrier_post((unsigned*)(F.ctl + CW_BAR) + args.li * XCD_BAR_WORDS, F.MISC + 8);
    const int lo = args.ph_lo, hi = args.ph_hi;
#define IN(k) (lo <= (k) && (k) < hi)
#define BOTH(k) (IN(k) && IN((k) + 1))
    if (IN(0)) { p0_prologue(F, args); if (BOTH(0)) xcd_barrier(bar); }
    if (IN(1)) {
        pg8::Gemm g{(const pg8::bf16_t*)(F.ws + WS_HB), (const pg8::bf16_t*)(F.ws + WS_WIN), NTOK + 1024, DIN + 1024, 1024};
        P1Order S; S.init(F.G, (int)blockIdx.x);
        EpiP1 E{F.ws, args.in[4], (const float*)(F.ws + WS_GTAB), (float*)(F.ctl + CW_KMEAN), (float*)(F.ctl + CW_MEMKSS)};
        pg8::gemm_phase<EpiP1, P1Order, true, true>(F.lds + RING_OFF, g, S, E);
        if (BOTH(1)) xcd_barrier(bar);
    }
    if (IN(2)) {
        p2_mixers(F, args.in[5], args.in[10], args.in[11]);
        if (BOTH(2)) xcd_barrier(bar);
    }
    if (IN(3)) {
        P3Order S; S.init(F.G, (int)blockIdx.x, F.ws); EpiP3 E{(const bf16_t*)(F.ws + WS_GT), (bf16_t*)(F.ws + WS_Y)};
        pg9::gemm_phase<EpiP3, P3Order, false>(F.lds + RING_OFF, 512, 512, 512, S, E);
        if (BOTH(3)) xcd_barrier(bar);
    }
    if (IN(4)) {
        P4Order S; S.init(F.G, (int)blockIdx.x, F.ws); EpiP4 E{args.in[0], F.out};
        pg9::gemm_phase<EpiP4, P4Order, false>(F.lds + RING_OFF, 1024, 1024, 1024, S, E);
        if (BOTH(4)) xcd_barrier(bar);
    }
    if (IN(5)) { p5_router(F, F.out, args.in[16], args.in[17], args.in[18]); if (BOTH(5)) xcd_barrier(bar); }
    if (IN(6)) {
        moe_tables(F);
        MoeOrder<3, WS_W1, 2048, 2, WS_XT> S; S.init(F.G, (int)blockIdx.x, F.ws, (const LAS int*)(F.lds + TB_OFF));
        EpiMoe1 E{(const int*)(F.ws + WS_LISTS), args.in[20], (bf16_t*)(F.ws + WS_ACT)};
        pg9::gemm_phase<EpiMoe1, MoeOrder<3, WS_W1, 2048, 2, WS_XT>, true>(F.lds + RING_OFF, 1024, 1024, 1024, S, E);
        if (BOTH(6)) xcd_barrier(bar);
    }
    if (IN(7)) {
        moe_tables(F);
        MoeOrder<2, WS_W2, 1024, 0, WS_ACT> S; S.init(F.G, (int)blockIdx.x, F.ws, (const LAS int*)(F.lds + TB_OFF));
        EpiMoe2 E{(const int*)(F.ws + WS_LISTS), args.in[22], (bf16_t*)(F.ws + WS_YS)};
        pg9::gemm_phase<EpiMoe2, MoeOrder<2, WS_W2, 1024, 0, WS_ACT>, true>(F.lds + RING_OFF, 1024, 1024, 1024, S, E);
        if (BOTH(7)) xcd_barrier(bar);
    }
    if (IN(8)) { p8_combine(F, F.out); }
#undef IN
#undef BOTH
}
#ifndef MK_ONE_LAUNCH
#define MK_ONE_LAUNCH 1
#endif
extern "C" void kernel_launch(void* const* d_in, const int* in_sizes, int n_in, void* d_out, int out_size, void* d_ws, size_t ws_size, hipStream_t stream) {
    if (ws_size < WS_END) { fprintf(stderr, "kernel_launch: ws too small %zu < %zu\n", ws_size, (size_t)WS_END); return; }
    unsigned char* ws = (unsigned char*)d_ws; float* out = (float*)d_out;
    static int grid = 0;
    if (grid == 0) {
        int dev = 0, cus = 0; if (hipGetDevice(&dev) != hipSuccess || hipDeviceGetAttribute(&cus, hipDeviceAttributeMultiprocessorCount, dev) != hipSuccess) { fprintf(stderr, "kernel_launch: device query failed\n"); grid = -1; return; }
        if (hipFuncSetAttribute((const void*)mega, hipFuncAttributeMaxDynamicSharedMemorySize, LDS_BYTES) != hipSuccess) { fprintf(stderr, "kernel_launch: hipFuncSetAttribute failed\n"); grid = -1; return; }
        (void)hipGetLastError(); grid = cus;
    }
    if (grid < 0) return;
    (void)hipMemsetAsync(ws + WS_CTL, 0, 1 * MiB, stream);
    Args a; memset(&a, 0, sizeof a); for (int i = 0; i < 23; ++i) a.in[i] = (const float*)d_in[i]; a.out = out; a.ws = ws; a.li = 0;
#if MK_ONE_LAUNCH
    a.ph_lo = 0; a.ph_hi = N_PHASES;
    hipLaunchKernelGGL(mega, dim3(grid), dim3(NWAVES * 64), LDS_BYTES, stream, a);
#else
    for (int p = 0; p < N_PHASES; ++p) { a.ph_lo = p; a.ph_hi = p + 1; hipLaunchKernelGGL(mega, dim3(grid), dim3(NWAVES * 64), LDS_BYTES, stream, a); }
#endif
}
```

```cpp
#define PROBE_MASK 0
#include <hip/hip_runtime.h>
#include <cstdio>
#include <cstdint>
#include <cstring>
typedef unsigned short bf16_t;
__host__ __device__ inline float bf2f(bf16_t v) { unsigned u = ((unsigned)v) << 16; float f; __builtin_memcpy(&f, &u, 4); return f; }
__host__ __device__ inline bf16_t f2bf(float f) { unsigned u; __builtin_memcpy(&u, &f, 4); u += 0x7fffu + ((u >> 16) & 1u); return (bf16_t)(u >> 16); }
constexpr int NTOK = 16384, SEQ = 4096, NB = 4, DM = 1024, DIN = 6656, MEMLEN = 256, NEXP = 32;
constexpr size_t MiB = (size_t)1 << 20;
constexpr size_t WS_CTL = 0;
constexpr size_t WS_WIN = 1 * MiB;
constexpr size_t WS_WMEMKV = 14 * MiB;
constexpr size_t WS_WBR = 16 * MiB;
constexpr size_t WS_WOUT = 19 * MiB;
constexpr size_t WS_W1 = 21 * MiB;
constexpr size_t WS_W2 = 149 * MiB;
constexpr size_t WS_HB = 213 * MiB;
constexpr size_t WS_HM = 245 * MiB;
constexpr size_t WS_RQ = 247 * MiB, WS_RK = 255 * MiB, WS_RV = 263 * MiB, WS_RG = 279 * MiB, WS_MQ = 295 * MiB, WS_MK = 311 * MiB, WS_MV = 327 * MiB, WS_CQ = 343 * MiB, WS_GT = 359 * MiB;
constexpr size_t WS_MEMK = 455 * MiB, WS_MEMV = 456 * MiB, WS_KMEAN = 457 * MiB, WS_MEMKSS = 457 * MiB + 512 * 1024;
constexpr size_t WS_GTAB = 457 * MiB + 768 * 1024;
constexpr size_t WS_ORET = 458 * MiB, WS_OMOBA = 474 * MiB, WS_OMEM = 490 * MiB;
constexpr size_t WS_Y = 506 * MiB, WS_XT = 538 * MiB;
constexpr size_t WS_TOPE = 570 * MiB, WS_TOPW = 570 * MiB + 256 * 1024, WS_LISTS = 571 * MiB;
constexpr size_t WS_ACT = 574 * MiB;
constexpr size_t WS_YS = 703 * MiB;
constexpr size_t WS_RETST = 959 * MiB;
constexpr size_t WS_END = 1024 * MiB;
constexpr size_t WS_PROJ = 574 * MiB;
constexpr size_t WS_PM = 990 * MiB;
constexpr size_t WS_ORAW = 574 * MiB;
constexpr size_t WS_T0 = 703 * MiB, WS_T1 = 767 * MiB, WS_T2 = 831 * MiB;
constexpr int CW_COUNTS = 64;
namespace nv {
struct NGemm {
    const bf16_t* A; const int* arow; const float* W; const int* Mdev; size_t w_zstride;
    int lda, arow_zstride, ashift, ldw, M, N, K, pad;
};
static inline NGemm mk_gemm(const bf16_t* A, int lda, const int* arow, int arow_zstride, int ashift, const float* W, int ldw, size_t w_zstride, int M, const int* Mdev, int N, int K) {
    NGemm g; memset(&g, 0, sizeof g); g.A = A; g.arow = arow; g.W = W; g.Mdev = Mdev; g.w_zstride = w_zstride; g.lda = lda; g.arow_zstride = arow_zstride; g.ashift = ashift; g.ldw = ldw; g.M = M; g.N = N; g.K = K; return g; }
template <class Epi> __global__ __launch_bounds__(256) void nk_gemm(NGemm g, Epi epi) {
    __shared__ float As[16][68]; __shared__ float Ws[16][68];
    const int z = blockIdx.z; const int M = g.Mdev ? g.Mdev[z] : g.M; const int m0 = blockIdx.y * 64, n0 = blockIdx.x * 64; if (m0 >= M) return;
    const int tid = threadIdx.x, tx = tid & 15, ty = tid >> 4;
    const int* arow = g.arow ? g.arow + (size_t)z * g.arow_zstride : nullptr; const float* W = g.W + (size_t)z * g.w_zstride;
    const int lr = tid >> 2, lk = (tid & 3) * 4; int srow = -1, rid = -1;
    { const int m = m0 + lr; if (m < M) { rid = arow ? arow[m] : m; srow = arow ? (rid >> g.ashift) : m; } }
    float acc[4][4]; for (int i = 0; i < 4; ++i) for (int j = 0; j < 4; ++j) acc[i][j] = 0.f;
    for (int k0 = 0; k0 < g.K; k0 += 16) {
        float a4[4] = {0.f, 0.f, 0.f, 0.f};
        if (srow >= 0) { const bf16_t* p = g.A + (size_t)srow * g.lda + k0 + lk; for (int j = 0; j < 4; ++j) a4[j] = bf2f(p[j]); }
        for (int j = 0; j < 4; ++j) As[lk + j][lr] = a4[j];
        { const int wk = tid >> 4, wn = (tid & 15) * 4; const float* p = W + (size_t)(k0 + wk) * g.ldw + n0 + wn; for (int j = 0; j < 4; ++j) Ws[wk][wn + j] = p[j]; }
        __syncthreads();
#pragma unroll
        for (int kk = 0; kk < 16; ++kk) { float a[4], b[4]; for (int i = 0; i < 4; ++i) { a[i] = As[kk][ty * 4 + i]; b[i] = Ws[kk][tx * 4 + i]; }
            for (int i = 0; i < 4; ++i) for (int j = 0; j < 4; ++j) acc[i][j] += a[i] * b[j]; }
        __syncthreads();
    }
    for (int i = 0; i < 4; ++i) { const int m = m0 + ty * 4 + i; if (m < M) { const int id = arow ? arow[m] : m; epi(z, id, m, n0 + tx * 4, acc[i]); } }
}
struct EpiStoreF32 { float* C; int ldc; int pad; __device__ void operator()(int, int id, int, int n, const float* v) const { float* p = C + (size_t)id * ldc + n; for (int j = 0; j < 4; ++j) p[j] = v[j]; } };
struct EpiMoeAct { bf16_t* ACT; const float* b1; __device__ void operator()(int e, int id, int, int n, const float* v) const {
    const float* b = b1 + (size_t)e * 2048 + n;
    for (int p = 0; p < 2; ++p) { float gl = fminf(v[2 * p] + b[2 * p], 7.0f); float li = fminf(fmaxf(v[2 * p + 1] + b[2 * p + 1], -7.0f), 7.0f);
        float a = gl * (1.f / (1.f + expf(-1.702f * gl))) * (li + 1.f); ACT[(size_t)id * 1024 + (n >> 1) + p] = f2bf(a); } } };
struct EpiMoeOut { float* YS; const float* b2; __device__ void operator()(int e, int id, int, int n, const float* v) const {
    const float* b = b2 + (size_t)e * 1024 + n; float* p = YS + (size_t)id * 1024 + n; for (int j = 0; j < 4; ++j) p[j] = v[j] + b[j]; } };

__device__ inline float wave_sum(float v) { for (int o = 1; o < 64; o <<= 1) v += __shfl_xor(v, o); return v; }
__device__ inline float wave_max(float v) { for (int o = 1; o < 64; o <<= 1) v = fmaxf(v, __shfl_xor(v, o)); return v; }

__global__ __launch_bounds__(256) void nk_rmsnorm(const float* x, const float* g, bf16_t* out, int rows) {
    const int w = (blockIdx.x * 256 + threadIdx.x) >> 6, lane = threadIdx.x & 63; if (w >= rows) return;
    const float* xr = x + (size_t)w * 1024; float v[16]; float s = 0.f;
    for (int j = 0; j < 16; ++j) { v[j] = xr[lane + 64 * j]; s += v[j] * v[j]; }
    const float r = rsqrtf(wave_sum(s) * (1.f / 1024.f) + 1e-5f);
#pragma unroll
    for (int j = 0; j < 16; ++j) out[(size_t)w * 1024 + lane + 64 * j] = f2bf(v[j] * r * g[lane + 64 * j]);
}
struct PostProj { const float* P; const float* b_gate; const float* g_moba_q; const float* g_moba_k;
    bf16_t *RQ, *RK, *RV, *RG, *MQ, *MK, *MV, *CQ, *GT; };
__global__ __launch_bounds__(256) void nk_post_proj(PostProj a) {
    const int t = blockIdx.x, tid = threadIdx.x, lane = tid & 63, w = tid >> 6; const float* p = a.P + (size_t)t * 6656;
    for (int c = tid; c < 256; c += 256) { a.RQ[(size_t)t * 256 + c] = f2bf(p[c]); a.RK[(size_t)t * 256 + c] = f2bf(p[256 + c] * 0.125f); }
    for (int c = tid; c < 512; c += 256) { a.RV[(size_t)t * 512 + c] = f2bf(p[512 + c]); const float g = p[1024 + c]; a.RG[(size_t)t * 512 + c] = f2bf(g / (1.f + expf(-g)));
        a.MV[(size_t)t * 512 + c] = f2bf(p[2560 + c]); a.CQ[(size_t)t * 512 + c] = f2bf(p[3072 + c]); }
    for (int h = w; h < 8; h += 4) {
        float q = p[1536 + h * 64 + lane], k = p[2048 + h * 64 + lane];
        const float rq = rsqrtf(wave_sum(q * q) * (1.f / 64.f) + 1e-5f), rk = rsqrtf(wave_sum(k * k) * (1.f / 64.f) + 1e-5f);
        a.MQ[(size_t)t * 512 + h * 64 + lane] = f2bf(q * rq * a.g_moba_q[lane]); a.MK[(size_t)t * 512 + h * 64 + lane] = f2bf(k * rk * a.g_moba_k[lane]);
    }
    for (int c = tid; c < 3072; c += 256) { const float g = p[3584 + c] + a.b_gate[c]; a.GT[(size_t)t * 3072 + c] = f2bf(1.f / (1.f + expf(-g))); }
}
__global__ __launch_bounds__(256) void nk_post_mem(const float* PM, bf16_t* MEMK, float* MEMKSS, bf16_t* MEMV) {
    const int r = blockIdx.x, tid = threadIdx.x, lane = tid & 63, w = tid >> 6; const float* p = PM + (size_t)r * 1024;
    for (int c = tid; c < 512; c += 256) { MEMK[(size_t)r * 512 + c] = f2bf(p[c]); MEMV[(size_t)r * 512 + c] = f2bf(p[512 + c]); }
    { const float a = p[w * 128 + lane], b = p[w * 128 + 64 + lane]; const float s = wave_sum(a * a + b * b); if (lane == 0) MEMKSS[r * 4 + w] = s; }
}
__global__ __launch_bounds__(256) void nk_memkss(const bf16_t* MEMK, float* MEMKSS) {
    const int r = blockIdx.x, lane = threadIdx.x & 63, w = threadIdx.x >> 6; const float a = bf2f(MEMK[(size_t)r * 512 + w * 128 + lane]), b = bf2f(MEMK[(size_t)r * 512 + w * 128 + 64 + lane]);
    const float s = wave_sum(a * a + b * b); if (lane == 0) MEMKSS[r * 4 + w] = s;
}
__global__ __launch_bounds__(64) void nk_kmean(const bf16_t* MK, float* KMEAN) {
    const int bb = blockIdx.x, h = blockIdx.y, d = threadIdx.x; float s = 0.f;
    for (int r = 0; r < 256; ++r) s += bf2f(MK[((size_t)bb * 256 + r) * 512 + h * 64 + d]);
    KMEAN[((size_t)bb * 8 + h) * 64 + d] = s * (1.f / 256.f);
}
__global__ __launch_bounds__(256) void nk_retention(const bf16_t* RQ, const bf16_t* RK, const bf16_t* RV, float* ORAW) {
    const int b = blockIdx.x >> 2, h = blockIdx.x & 3, tid = threadIdx.x, e = tid & 127, hf = tid >> 7;
    const float gamma = 1.f - exp2f(-5.f - (float)h);
    __shared__ float qs[64], ks[64], part[256];
    float s[32];
#pragma unroll
    for (int i = 0; i < 32; ++i) s[i] = 0.f;
    for (int t = 0; t < 4096; ++t) { const size_t row = (size_t)b * 4096 + t;
        if (tid < 64) qs[tid] = bf2f(RQ[row * 256 + h * 64 + tid]); else if (tid < 128) ks[tid - 64] = bf2f(RK[row * 256 + h * 64 + tid - 64]);
        const float v = bf2f(RV[row * 512 + h * 128 + e]);
        __syncthreads();
        float o = 0.f;
#pragma unroll
        for (int i = 0; i < 32; ++i) { s[i] = gamma * s[i] + ks[hf * 32 + i] * v; o += qs[hf * 32 + i] * s[i]; }
        part[tid] = o; __syncthreads();
        if (tid < 128) ORAW[row * 512 + h * 128 + tid] = part[tid] + part[tid + 128];
    }
}
__global__ __launch_bounds__(256) void nk_ret_post(const float* ORAW, const float* g_ret_out, const bf16_t* RG, bf16_t* ORET) {
    const int w = (blockIdx.x * 256 + threadIdx.x) >> 6, lane = threadIdx.x & 63; const int t = w >> 2, h = w & 3;
    const float* p = ORAW + (size_t)t * 512 + h * 128; const float a = p[lane], b = p[lane + 64];
    const float r = rsqrtf(wave_sum(a * a + b * b) * (1.f / 128.f) + 1e-5f);
    ORET[(size_t)t * 512 + h * 128 + lane] = f2bf(a * r * g_ret_out[lane] * bf2f(RG[(size_t)t * 512 + h * 128 + lane]));
    ORET[(size_t)t * 512 + h * 128 + lane + 64] = f2bf(b * r * g_ret_out[lane + 64] * bf2f(RG[(size_t)t * 512 + h * 128 + lane + 64]));
}
__global__ __launch_bounds__(256) void nk_moba(const bf16_t* MQ, const bf16_t* MK, const bf16_t* MV, const float* KMEAN, bf16_t* OMOBA) {
    __shared__ float sc[4][1024]; __shared__ float qsh[4][64];
    const int wl = threadIdx.x >> 6, lane = threadIdx.x & 63; const int w = blockIdx.x * 4 + wl;
    const int t = w & 4095, h = (w >> 12) & 7, b = w >> 15; const int qb = t >> 8;
    const size_t row = (size_t)b * 4096 + t;
    qsh[wl][lane] = bf2f(MQ[row * 512 + h * 64 + lane]);
    __syncthreads();
    float q[64];
#pragma unroll
    for (int d = 0; d < 64; ++d) q[d] = qsh[wl][d];
    float gsc = -INFINITY; if (lane < qb) { const float* km = KMEAN + (((size_t)b * 16 + lane) * 8 + h) * 64; float s = 0.f;
#pragma unroll
        for (int d = 0; d < 64; ++d) s += q[d] * km[d];
        gsc = s; }
    int sel[4]; sel[0] = qb;
#pragma unroll
    for (int r = 0; r < 3; ++r) { const float m = wave_max(gsc); int j = -1; if (m != -INFINITY) { const unsigned long long bal = __ballot(gsc == m); j = __ffsll((long long)bal) - 1; } sel[r + 1] = j; if (lane == j) gsc = -INFINITY; }
    const float slope = exp2f(-(float)(h + 1));
    float mx = -INFINITY;
#pragma unroll
    for (int s = 0; s < 4; ++s) { const int blk = sel[s];
        for (int c = 0; c < 4; ++c) { const int kp = blk * 256 + c * 64 + lane; float v = -INFINITY;
            if (blk >= 0 && kp <= t) { const bf16_t* kr = MK + ((size_t)b * 4096 + kp) * 512 + h * 64; float d_ = 0.f;
#pragma unroll
                for (int d = 0; d < 64; ++d) d_ += q[d] * bf2f(kr[d]);
                v = d_ * 0.125f - slope * (float)(t - kp); }
            sc[wl][s * 256 + c * 64 + lane] = v; mx = fmaxf(mx, v); } }
    mx = wave_max(mx); float sum = 0.f;
    for (int i = lane; i < 1024; i += 64) { const float p = expf(sc[wl][i] - mx); sc[wl][i] = p; sum += p; }
    sum = wave_sum(sum);
    __syncthreads();
    float o = 0.f;
#pragma unroll
    for (int s = 0; s < 4; ++s) { const int blk = sel[s]; if (blk >= 0) for (int k = 0; k < 256; ++k) { const float p = sc[wl][s * 256 + k]; if (p != 0.f) o += p * bf2f(MV[((size_t)b * 4096 + blk * 256 + k) * 512 + h * 64 + lane]); } }
    OMOBA[row * 512 + h * 64 + lane] = f2bf(o / sum);
}
__global__ __launch_bounds__(256) void nk_memattn(const bf16_t* CQ, const bf16_t* MEMK, const float* MEMKSS, const bf16_t* MEMV, const float* g_mem_q, const float* g_mem_k, bf16_t* OMEM) {
    __shared__ float sc[4][256]; __shared__ float qsh[4][128];
    const int wl = threadIdx.x >> 6, lane = threadIdx.x & 63; const int w = blockIdx.x * 4 + wl;
    const int t = w & 4095, h = (w >> 12) & 3, b = w >> 14; const size_t row = (size_t)b * 4096 + t;
    const float q0 = bf2f(CQ[row * 512 + h * 128 + lane]), q1 = bf2f(CQ[row * 512 + h * 128 + 64 + lane]);
    const float rq = rsqrtf(wave_sum(q0 * q0 + q1 * q1) * (1.f / 128.f) + 1e-5f);
    qsh[wl][lane] = q0 * rq * g_mem_q[lane] * g_mem_k[lane]; qsh[wl][lane + 64] = q1 * rq * g_mem_q[lane + 64] * g_mem_k[lane + 64];
    __syncthreads();
    float mx = -INFINITY;
    for (int c = 0; c < 4; ++c) { const int m = c * 64 + lane; const bf16_t* kr = MEMK + ((size_t)b * 256 + m) * 512 + h * 128; float d_ = 0.f; for (int d = 0; d < 128; ++d) d_ += qsh[wl][d] * bf2f(kr[d]);
        const float rk = rsqrtf(MEMKSS[((size_t)b * 256 + m) * 4 + h] * (1.f / 128.f) + 1e-5f); const float v = d_ * rk * 0.08838834764831845f; sc[wl][m] = v; mx = fmaxf(mx, v); }
    mx = wave_max(mx); float sum = 0.f;
    for (int i = lane; i < 256; i += 64) { const float p = expf(sc[wl][i] - mx); sc[wl][i] = p; sum += p; }
    sum = wave_sum(sum); __syncthreads();
    float o0 = 0.f, o1 = 0.f;
    for (int k = 0; k < 256; ++k) { const float p = sc[wl][k]; const bf16_t* vr = MEMV + ((size_t)b * 256 + k) * 512 + h * 128; o0 += p * bf2f(vr[lane]); o1 += p * bf2f(vr[lane + 64]); }
    OMEM[row * 512 + h * 128 + lane] = f2bf(o0 / sum); OMEM[row * 512 + h * 128 + 64 + lane] = f2bf(o1 / sum);
}
__global__ __launch_bounds__(256) void nk_merge(const float* T0, const float* T1, const float* T2, const bf16_t* GT, bf16_t* Y) {
    const size_t i = (size_t)blockIdx.x * 256 + threadIdx.x; const size_t t = i >> 10; const int n = (int)(i & 1023);
    Y[i] = f2bf(bf2f(GT[t * 3072 + n]) * T0[i] + bf2f(GT[t * 3072 + 1024 + n]) * T1[i] + bf2f(GT[t * 3072 + 2048 + n]) * T2[i]);
}
__global__ __launch_bounds__(256) void nk_resid(const float* x, const float* T, float* X1) { const size_t i = (size_t)blockIdx.x * 256 + threadIdx.x; X1[i] = x[i] + T[i]; }
__global__ __launch_bounds__(256) void nk_router(const float* X1, const float* g_ffn, const float* w_router, const float* b_router, bf16_t* XT, int* TOPE, float* TOPW, int* COUNTS, int* LISTS) {
    const int t = (blockIdx.x * 256 + threadIdx.x) >> 6, lane = threadIdx.x & 63; const float* xr = X1 + (size_t)t * 1024; float v[16]; float s = 0.f;
    for (int j = 0; j < 16; ++j) { v[j] = xr[lane + 64 * j]; s += v[j] * v[j]; }
    const float r = rsqrtf(wave_sum(s) * (1.f / 1024.f) + 1e-5f);
#pragma unroll
    for (int j = 0; j < 16; ++j) { v[j] = v[j] * r * g_ffn[lane + 64 * j]; XT[(size_t)t * 1024 + lane + 64 * j] = f2bf(v[j]); }
    float lg = -INFINITY;
    for (int e = 0; e < 32; ++e) { float p = 0.f;
#pragma unroll
        for (int j = 0; j < 16; ++j) p += v[j] * w_router[(size_t)(lane + 64 * j) * 32 + e]; p = wave_sum(p); if (lane == e) lg = p + b_router[e]; }
    float tv[4]; int te[4];
#pragma unroll
    for (int k = 0; k < 4; ++k) { const float m = wave_max(lg); const unsigned long long bal = __ballot(lg == m); const int e = __ffsll((long long)bal) - 1; tv[k] = m; te[k] = e; if (lane == e) lg = -INFINITY; }
    float ex[4], se = 0.f;
#pragma unroll
    for (int k = 0; k < 4; ++k) { ex[k] = expf(tv[k] - tv[0]); se += ex[k]; }
    int e_l = te[0]; float w_l = ex[0];
#pragma unroll
    for (int k = 1; k < 4; ++k) if (lane == k) { e_l = te[k]; w_l = ex[k]; }
    if (lane < 4) { const int e = e_l; TOPE[t * 4 + lane] = e; TOPW[t * 4 + lane] = w_l / se; const int pos = atomicAdd(&COUNTS[e], 1); LISTS[(size_t)e * 16384 + pos] = t * 4 + lane; }
}
__global__ __launch_bounds__(256) void nk_combine(const float* X1, const float* YS, const float* TOPW, float* out) {
    const size_t i = (size_t)blockIdx.x * 256 + threadIdx.x; const size_t t = i >> 10; const int n = (int)(i & 1023); float a = X1[i];
    for (int k = 0; k < 4; ++k) a += TOPW[t * 4 + k] * YS[(t * 4 + k) * 1024 + n];
    out[i] = a;
}
}
namespace pg8 {
#define PG8_LAS __attribute__((address_space(3)))
typedef unsigned short bf16_t;
typedef short bf16x8 __attribute__((ext_vector_type(8)));
typedef float f32x4 __attribute__((ext_vector_type(4)));
typedef unsigned u32x4 __attribute__((ext_vector_type(4)));
constexpr int BM = 256, BK = 64, HALF = 128, HTB = HALF * BK * 2  , STAGE_BYTES = 8 * HTB, NXCD = 8, WGM = 8;

__host__ __device__ __forceinline__ int lds_byte(int r, int c) { const int st = (r >> 4) * 2 + (c >> 5), rr = r & 15, cc = c & 31, ob = rr * 64 + cc * 2; return st * 1024 + (ob ^ (((ob >> 9) & 1) << 5)); }
__host__ __device__ __forceinline__ void stage_rc(int b, int& R, int& C) { const int st = b / 1024, sb = b % 1024, swz = sb ^ (((sb >> 9) & 1) << 5); R = (st >> 1) * 16 + swz / 64; C = (st & 1) * 32 + (swz % 64) / 2; }
__host__ __device__ __forceinline__ int perm32(int rho) { const int n = rho >> 4, i = rho & 15; return 8 * (i >> 2) + 4 * n + (i & 3); }

struct Unit { int pm, pn; };
struct Gemm { const bf16_t* A; const bf16_t* Bt; int M, N, K; };
struct StaticOrder {
    int nM, nN, nwg, G, c;
    __host__ __device__ void init(int M, int N, int G_, int c_) { nM = M / BM; nN = N / BM; nwg = nM * nN; G = G_; c = c_; }
    __host__ __device__ bool next(int i, Unit& u) const {
        const long L = (long)i * G + c; if (L >= nwg) return false;
        int wgid = (int)L; { const int q = nwg / NXCD, r = nwg % NXCD, xcd = wgid % NXCD, off = wgid / NXCD; wgid = (xcd < r ? xcd * (q + 1) : r * (q + 1) + (xcd - r) * q) + off; }
        const int nig = WGM * nN, gid = wgid / nig, fm = gid * WGM, gsz = (nM - fm) < WGM ? (nM - fm) : WGM;
        u.pm = fm + ((wgid % nig) % gsz); u.pn = (wgid % nig) / gsz; return true;
    }
    __device__ __forceinline__ void a_ready(const Unit&) const {}
    __device__ __forceinline__ void done(const Unit&) const {}
};
__device__ __forceinline__ unsigned cvt_pk_bf16(float lo, float hi) { unsigned r; asm volatile("v_cvt_pk_bf16_f32 %0, %1, %2" : "=v"(r) : "v"(lo), "v"(hi)); return r; }
typedef float f32x2 __attribute__((ext_vector_type(2)));
template <class Epi, class Sched, bool ALIGN_EPI = false, bool SP2 = false>
__device__ __forceinline__ void gemm_phase(PG8_LAS unsigned char* lds, const Gemm g, const Sched& S, const Epi& E) {
    const int tid = threadIdx.x, wid = __builtin_amdgcn_readfirstlane(tid >> 6), lane = tid & 63, wr = wid >> 2, wc = wid & 3, fr = lane & 15, fq = lane >> 4;
    const int K = g.K, nt = K / BK;
    unsigned voffA[2], voffB[2];
#pragma unroll
    for (int i = 0; i < 2; ++i) { int R, C; stage_rc(tid * 16 + i * 8192, R, C); const int Rb = Epi::PERM ? ((R & ~31) + perm32(R & 31)) : R;
        voffA[i] = (unsigned)(R * K + C) * 2u; voffB[i] = (unsigned)(Rb * K + C) * 2u; }
    const size_t kstep = (size_t)(BK * 2);
    const size_t hstep = (size_t)HALF * K * 2;
    const size_t tstep = 2 * hstep;
    const unsigned ldsw = (unsigned)wid * 1024u;
    const int aoff = lds_byte(wr * 64 + fr, fq * 8), boff = lds_byte(wc * 32 + fr, fq * 8);
#define PG8_SA(b, h) (((b) * 2 + (h)) * HTB)
#define PG8_SB(b, h) ((4 + (b) * 2 + (h)) * HTB)
#define PG8_STAGE(bufoff, gbase, voff) do { _Pragma("unroll") for (int _i = 0; _i < 2; ++_i) \
        __builtin_amdgcn_global_load_lds((const unsigned*)((const char*)(gbase) + (voff)[_i]), (PG8_LAS unsigned*)(lds + (bufoff) + ldsw + _i * 8192), 16, 0, 0); } while (0)
#define PG8_LDA(dst, b, h) do { _Pragma("unroll") for (int m = 0; m < 4; ++m) _Pragma("unroll") for (int k = 0; k < 2; ++k) dst[m][k] = *(const PG8_LAS bf16x8*)(lds + PG8_SA(b, h) + aoff + m * 2048 + k * 1024); } while (0)
#define PG8_LDB(dst, b, h) do { _Pragma("unroll") for (int n = 0; n < 2; ++n) _Pragma("unroll") for (int k = 0; k < 2; ++k) dst[n][k] = *(const PG8_LAS bf16x8*)(lds + PG8_SB(b, h) + boff + n * 2048 + k * 1024); } while (0)
#define PG8_MMA(ai, bj, At, Bt) do { __builtin_amdgcn_s_setprio(1); _Pragma("unroll") for (int m = 0; m < 4; ++m) _Pragma("unroll") for (int n = 0; n < 2; ++n) _Pragma("unroll") for (int k = 0; k < 2; ++k) \
        acc[ai][bj][m][n] = __builtin_amdgcn_mfma_f32_16x16x32_bf16(Bt[n][k], At[m][k], acc[ai][bj][m][n], 0, 0, 0); __builtin_amdgcn_s_setprio(0); } while (0)
#define PG8_WAIT_V(n) asm volatile("s_waitcnt vmcnt(" #n ")" ::: "memory")
#define PG8_WAIT_L(n) asm volatile("s_waitcnt lgkmcnt(" #n ")" ::: "memory")
#define PG8_BAR __builtin_amdgcn_s_barrier()
#define PG8_SCHED __builtin_amdgcn_sched_barrier(0)
    Unit cur, nxt; int ui = 0;
    if (!S.next(0, cur)) return;
    f32x4 acc[2][2][4][2];
#pragma unroll
    for (int a = 0; a < 2; ++a)
#pragma unroll
        for (int b = 0; b < 2; ++b)
#pragma unroll
            for (int m = 0; m < 4; ++m)
#pragma unroll
                for (int n = 0; n < 2; ++n) acc[a][b][m][n] = (f32x4){0.f, 0.f, 0.f, 0.f};
    bf16x8 At[4][2], B0[2][2], B1[2][2];
    const char* cA = (const char*)g.A + (size_t)cur.pm * tstep; const char* cB = (const char*)g.Bt + (size_t)cur.pn * tstep;
    S.a_ready(cur);
    if constexpr (SP2) {
        PG8_STAGE(PG8_SB(0, 0), cB, voffB); PG8_STAGE(PG8_SB(0, 1), cB + hstep, voffB); PG8_STAGE(PG8_SA(0, 0), cA, voffA); PG8_STAGE(PG8_SA(0, 1), cA + hstep, voffA);
        if (wr == 1) PG8_BAR;
        PG8_WAIT_V(2); PG8_BAR;
        PG8_STAGE(PG8_SB(1, 0), cB + kstep, voffB); PG8_STAGE(PG8_SA(1, 0), cA + kstep, voffA); PG8_STAGE(PG8_SB(1, 1), cB + hstep + kstep, voffB);
        PG8_WAIT_V(6); PG8_BAR;
    } else {
        PG8_STAGE(PG8_SB(0, 0), cB, voffB); PG8_STAGE(PG8_SA(0, 0), cA, voffA); PG8_STAGE(PG8_SB(0, 1), cB + hstep, voffB); PG8_STAGE(PG8_SA(0, 1), cA + hstep, voffA);
        if (wr == 1) PG8_BAR;
        PG8_WAIT_V(4); PG8_BAR;
        PG8_STAGE(PG8_SB(1, 0), cB + kstep, voffB); PG8_STAGE(PG8_SA(1, 0), cA + kstep, voffA); PG8_STAGE(PG8_SB(1, 1), cB + hstep + kstep, voffB);
        PG8_WAIT_V(6); PG8_BAR;
    }
    for (;;) {
        const bool has_next = S.next(ui + 1, nxt);
        const char* nA = has_next ? (const char*)g.A + (size_t)nxt.pm * tstep : cA; const char* nB = has_next ? (const char*)g.Bt + (size_t)nxt.pn * tstep : cB;
        for (int t = 0; t < nt; t += 2) {
            const bool last = (t == nt - 2);
            const char* a1 = cA + (size_t)(t + 1) * kstep;
            const char* a2 = last ? nA : cA + (size_t)(t + 2) * kstep; const char* b2 = last ? nB : cB + (size_t)(t + 2) * kstep;
            const char* a3 = a2 + kstep; const char* b3 = b2 + kstep;
            if (last && has_next) S.a_ready(nxt);
            if constexpr (SP2) {
            PG8_LDB(B0, 0, 0); PG8_LDB(B1, 0, 1); PG8_SCHED; PG8_LDA(At, 0, 0); PG8_STAGE(PG8_SA(1, 1), a1 + hstep, voffA);
            PG8_WAIT_V(8); PG8_WAIT_L(0); PG8_BAR; PG8_MMA(0, 0, At, B0); PG8_MMA(0, 1, At, B1); PG8_BAR; PG8_SCHED;
            PG8_LDA(At, 0, 1); PG8_STAGE(PG8_SB(0, 0), b2, voffB); PG8_STAGE(PG8_SB(0, 1), b2 + hstep, voffB); PG8_STAGE(PG8_SA(0, 0), a2, voffA);
            PG8_WAIT_V(8); PG8_WAIT_L(0); PG8_BAR; PG8_MMA(1, 0, At, B0); PG8_MMA(1, 1, At, B1); PG8_BAR; PG8_SCHED;
            PG8_LDB(B0, 1, 0); PG8_LDB(B1, 1, 1); PG8_SCHED; PG8_LDA(At, 1, 0); PG8_STAGE(PG8_SA(0, 1), a2 + hstep, voffA);
            PG8_WAIT_V(8); PG8_WAIT_L(0); PG8_BAR; PG8_MMA(0, 0, At, B0); PG8_MMA(0, 1, At, B1); PG8_BAR; PG8_SCHED;
            PG8_LDA(At, 1, 1); PG8_STAGE(PG8_SB(1, 0), b3, voffB); PG8_STAGE(PG8_SB(1, 1), b3 + hstep, voffB); PG8_STAGE(PG8_SA(1, 0), a3, voffA);
            PG8_WAIT_V(8); PG8_WAIT_L(0); PG8_BAR; PG8_MMA(1, 0, At, B0); PG8_MMA(1, 1, At, B1); PG8_BAR; PG8_SCHED;
            } else {
            PG8_LDB(B0, 0, 0); PG8_SCHED; PG8_LDA(At, 0, 0); PG8_STAGE(PG8_SA(1, 1), a1 + hstep, voffA);
            PG8_WAIT_L(8); PG8_BAR; PG8_WAIT_L(0); PG8_MMA(0, 0, At, B0); PG8_BAR; PG8_SCHED;
            PG8_LDB(B1, 0, 1); PG8_STAGE(PG8_SB(0, 0), b2, voffB);
            PG8_BAR; PG8_WAIT_L(0); PG8_MMA(0, 1, At, B1); PG8_BAR;
            PG8_LDA(At, 0, 1); PG8_STAGE(PG8_SA(0, 0), a2, voffA);
            PG8_BAR; PG8_WAIT_L(0); PG8_MMA(1, 0, At, B0); PG8_BAR; PG8_SCHED;
            PG8_STAGE(PG8_SB(0, 1), b2 + hstep, voffB);
            PG8_WAIT_V(6); PG8_BAR; PG8_MMA(1, 1, At, B1); PG8_BAR;
            PG8_LDB(B0, 1, 0); PG8_SCHED; PG8_LDA(At, 1, 0); PG8_STAGE(PG8_SA(0, 1), a2 + hstep, voffA);
            PG8_WAIT_L(8); PG8_BAR; PG8_WAIT_L(0); PG8_MMA(0, 0, At, B0); PG8_BAR; PG8_SCHED;
            PG8_LDB(B1, 1, 1); PG8_STAGE(PG8_SB(1, 0), b3, voffB);
            PG8_BAR; PG8_WAIT_L(0); PG8_MMA(0, 1, At, B1); PG8_BAR;
            PG8_LDA(At, 1, 1); PG8_STAGE(PG8_SA(1, 0), a3, voffA);
            PG8_BAR; PG8_WAIT_L(0); PG8_MMA(1, 0, At, B0); PG8_BAR; PG8_SCHED;
            PG8_STAGE(PG8_SB(1, 1), b3 + hstep, voffB);
            PG8_WAIT_V(6); PG8_BAR; PG8_MMA(1, 1, At, B1); PG8_BAR;
            }
        }
        if constexpr (ALIGN_EPI) { if (wr == 0) PG8_BAR; }
        if constexpr (!Epi::AFTER_DRAIN) { E(acc, cur, wr, wc, fr, fq); S.done(cur); }
        if (!has_next) break;
#pragma unroll
        for (int a = 0; a < 2; ++a)
#pragma unroll
            for (int b = 0; b < 2; ++b)
#pragma unroll
                for (int m = 0; m < 4; ++m)
#pragma unroll
                    for (int n = 0; n < 2; ++n) acc[a][b][m][n] = (f32x4){0.f, 0.f, 0.f, 0.f};
        cur = nxt; cA = nA; cB = nB; ++ui;
        if constexpr (ALIGN_EPI) { if (wr == 1) PG8_BAR; }
    }
    PG8_WAIT_V(0);
    if constexpr (!ALIGN_EPI) { if (wr == 0) PG8_BAR; }
    PG8_BAR;
    if constexpr (Epi::AFTER_DRAIN) { E.fused(acc, cur, wr, wc, fr, fq, lds, wid, lane); S.done(cur); }
#undef PG8_SA
#undef PG8_SB
#undef PG8_STAGE
#undef PG8_LDA
#undef PG8_LDB
#undef PG8_MMA
#undef PG8_WAIT_V
#undef PG8_WAIT_L
#undef PG8_BAR
#undef PG8_SCHED
}
}
namespace pg9 {
using pg8::bf16x8; using pg8::f32x4; using pg8::u32x4; using pg8::lds_byte; using pg8::stage_rc; using pg8::perm32;
constexpr int BK = 64, HALF = 128, HTB = HALF * BK * 2;
struct Unit { int pm, pn, aux, cnt; };
template <class Epi, class Sched, bool GATHER>
__device__ __forceinline__ void gemm_phase(PG8_LAS unsigned char* lds, const int K, const int lda, const int ldb, const Sched& S, const Epi& E) {
    const int tid = threadIdx.x, wid = __builtin_amdgcn_readfirstlane(tid >> 6), lane = tid & 63, wr = wid >> 2, wc = wid & 3, fr = lane & 15, fq = lane >> 4;
    const int nt = K / BK;
    unsigned offA[2][2], offAn[2][2], offB[2][2]; int RA[2], CA[2];
#pragma unroll
    for (int i = 0; i < 2; ++i) { int R, C; stage_rc(tid * 16 + i * 8192, R, C); const int Rb = Epi::PERM ? ((R & ~31) + perm32(R & 31)) : R; RA[i] = R; CA[i] = C * 2;
#pragma unroll
        for (int h = 0; h < 2; ++h) { offB[h][i] = (unsigned)((Rb + 128 * h) * ldb + C) * 2u; offA[h][i] = (unsigned)((R + 128 * h) * lda + C) * 2u; offAn[h][i] = offA[h][i]; } }
    const size_t kstep = (size_t)(BK * 2);
    const unsigned ldsw = (unsigned)wid * 1024u;
    const int aoff = lds_byte(wr * 64 + fr, fq * 8), boff = lds_byte(wc * 32 + fr, fq * 8);
#define PG9_SA(b, h) (((b) * 2 + (h)) * HTB)
#define PG9_SB(b, h) ((4 + (b) * 2 + (h)) * HTB)
#define PG9_STAGE(bufoff, gbase, voff) do { _Pragma("unroll") for (int _i = 0; _i < 2; ++_i) \
        __builtin_amdgcn_global_load_lds((const unsigned*)((const char*)(gbase) + (voff)[_i]), (PG8_LAS unsigned*)(lds + (bufoff) + ldsw + _i * 8192), 16, 0, 0); } while (0)
#define PG9_LDA(dst, b, h) do { _Pragma("unroll") for (int m = 0; m < 4; ++m) _Pragma("unroll") for (int k = 0; k < 2; ++k) dst[m][k] = *(const PG8_LAS bf16x8*)(lds + PG9_SA(b, h) + aoff + m * 2048 + k * 1024); } while (0)
#define PG9_LDB(dst, b, h) do { _Pragma("unroll") for (int n = 0; n < 2; ++n) _Pragma("unroll") for (int k = 0; k < 2; ++k) dst[n][k] = *(const PG8_LAS bf16x8*)(lds + PG9_SB(b, h) + boff + n * 2048 + k * 1024); } while (0)
#define PG9_MMA(ai, bj, At, Bt) do { __builtin_amdgcn_s_setprio(1); _Pragma("unroll") for (int m = 0; m < 4; ++m) _Pragma("unroll") for (int n = 0; n < 2; ++n) _Pragma("unroll") for (int k = 0; k < 2; ++k) \
        acc[ai][bj][m][n] = __builtin_amdgcn_mfma_f32_16x16x32_bf16(Bt[n][k], At[m][k], acc[ai][bj][m][n], 0, 0, 0); __builtin_amdgcn_s_setprio(0); } while (0)
#define PG9_WAIT_V(n) asm volatile("s_waitcnt vmcnt(" #n ")" ::: "memory")
#define PG9_WAIT_L(n) asm volatile("s_waitcnt lgkmcnt(" #n ")" ::: "memory")
#define PG9_BAR __builtin_amdgcn_s_barrier()
#define PG9_SCHED __builtin_amdgcn_sched_barrier(0)
    Unit cur, nxt; int ui = 0;
    if (!S.next(0, cur)) return;
    f32x4 acc[2][2][4][2];
#pragma unroll
    for (int a = 0; a < 2; ++a)
#pragma unroll
        for (int b = 0; b < 2; ++b)
#pragma unroll
            for (int m = 0; m < 4; ++m)
#pragma unroll
                for (int n = 0; n < 2; ++n) acc[a][b][m][n] = (f32x4){0.f, 0.f, 0.f, 0.f};
    bf16x8 At[4][2], B0[2][2], B1[2][2];
    const char* cA = S.a_base(cur); const char* cB = S.b_base(cur);
    if constexpr (GATHER) {
#pragma unroll
        for (int h = 0; h < 2; ++h)
#pragma unroll
            for (int i = 0; i < 2; ++i) offA[h][i] = S.a_row_off(cur, RA[i] + 128 * h) + (unsigned)CA[i];
    }
    PG9_STAGE(PG9_SB(0, 0), cB, offB[0]); PG9_STAGE(PG9_SB(0, 1), cB, offB[1]); PG9_STAGE(PG9_SA(0, 0), cA, offA[0]); PG9_STAGE(PG9_SA(0, 1), cA, offA[1]);
    if (wr == 1) PG9_BAR;
    PG9_WAIT_V(2); PG9_BAR;
    PG9_STAGE(PG9_SB(1, 0), cB + kstep, offB[0]); PG9_STAGE(PG9_SA(1, 0), cA + kstep, offA[0]); PG9_STAGE(PG9_SB(1, 1), cB + kstep, offB[1]);
    PG9_WAIT_V(6); PG9_BAR;
    for (;;) {
        const bool has_next = S.next(ui + 1, nxt);
        const char* nA = has_next ? S.a_base(nxt) : cA; const char* nB = has_next ? S.b_base(nxt) : cB;
        if constexpr (GATHER) {
#pragma unroll
            for (int h = 0; h < 2; ++h)
#pragma unroll
                for (int i = 0; i < 2; ++i) offAn[h][i] = has_next ? (S.a_row_off(nxt, RA[i] + 128 * h) + (unsigned)CA[i]) : offA[h][i];
        }
        for (int t = 0; t < nt; t += 2) {
            const bool last = (t == nt - 2);
            const char* a1 = cA + (size_t)(t + 1) * kstep;
            const char* a2 = last ? nA : cA + (size_t)(t + 2) * kstep; const char* b2 = last ? nB : cB + (size_t)(t + 2) * kstep;
            const char* a3 = a2 + kstep; const char* b3 = b2 + kstep;
            unsigned oA2[2][2];
#pragma unroll
            for (int h = 0; h < 2; ++h)
#pragma unroll
                for (int i = 0; i < 2; ++i) oA2[h][i] = (GATHER && last) ? offAn[h][i] : offA[h][i];
            PG9_LDB(B0, 0, 0); PG9_LDB(B1, 0, 1); PG9_SCHED; PG9_LDA(At, 0, 0); PG9_STAGE(PG9_SA(1, 1), a1, offA[1]);
            PG9_WAIT_V(8); PG9_WAIT_L(0); PG9_BAR; PG9_MMA(0, 0, At, B0); PG9_MMA(0, 1, At, B1); PG9_BAR; PG9_SCHED;
            PG9_LDA(At, 0, 1); PG9_STAGE(PG9_SB(0, 0), b2, offB[0]); PG9_STAGE(PG9_SB(0, 1), b2, offB[1]); PG9_STAGE(PG9_SA(0, 0), a2, oA2[0]);
            PG9_WAIT_V(8); PG9_WAIT_L(0); PG9_BAR; PG9_MMA(1, 0, At, B0); PG9_MMA(1, 1, At, B1); PG9_BAR; PG9_SCHED;
            PG9_LDB(B0, 1, 0); PG9_LDB(B1, 1, 1); PG9_SCHED; PG9_LDA(At, 1, 0); PG9_STAGE(PG9_SA(0, 1), a2, oA2[1]);
            PG9_WAIT_V(8); PG9_WAIT_L(0); PG9_BAR; PG9_MMA(0, 0, At, B0); PG9_MMA(0, 1, At, B1); PG9_BAR; PG9_SCHED;
            PG9_LDA(At, 1, 1); PG9_STAGE(PG9_SB(1, 0), b3, offB[0]); PG9_STAGE(PG9_SB(1, 1), b3, offB[1]); PG9_STAGE(PG9_SA(1, 0), a3, oA2[0]);
            PG9_WAIT_V(8); PG9_WAIT_L(0); PG9_BAR; PG9_MMA(1, 0, At, B0); PG9_MMA(1, 1, At, B1); PG9_BAR; PG9_SCHED;
        }
        if (wr == 0) PG9_BAR;
        bool keep = false;
        if constexpr (Epi::CHAIN) keep = E.chain_more(cur);
        if (keep) { if constexpr (Epi::CHAIN) E.rescale(acc, cur, wr, wc, fr, fq); }
        else E(acc, cur, wr, wc, fr, fq);
        if (!has_next) break;
        if (!keep) {
#pragma unroll
            for (int a = 0; a < 2; ++a)
#pragma unroll
                for (int b = 0; b < 2; ++b)
#pragma unroll
                    for (int m = 0; m < 4; ++m)
#pragma unroll
                        for (int n = 0; n < 2; ++n) acc[a][b][m][n] = (f32x4){0.f, 0.f, 0.f, 0.f};
        }
        cur = nxt; cA = nA; cB = nB; ++ui;
        if constexpr (GATHER) {
#pragma unroll
            for (int h = 0; h < 2; ++h)
#pragma unroll
                for (int i = 0; i < 2; ++i) offA[h][i] = offAn[h][i];
        }
        if (wr == 1) PG9_BAR;
    }
    PG9_WAIT_V(0);
    PG9_BAR;
#undef PG9_SA
#undef PG9_SB
#undef PG9_STAGE
#undef PG9_LDA
#undef PG9_LDB
#undef PG9_MMA
#undef PG9_WAIT_V
#undef PG9_WAIT_L
#undef PG9_BAR
#undef PG9_SCHED
}
}
#define GAS __attribute__((address_space(1)))
#define LAS __attribute__((address_space(3)))
typedef unsigned short bf16;
typedef unsigned v4u __attribute__((ext_vector_type(4)));
typedef float f32x4 __attribute__((ext_vector_type(4)));
typedef short bf16x8 __attribute__((ext_vector_type(8)));
typedef GAS unsigned gu32;
typedef GAS unsigned long long gu64;
#define RLX_AGENT __ATOMIC_RELAXED, __HIP_MEMORY_SCOPE_AGENT
#define LDS_WAIT() asm volatile("s_waitcnt lgkmcnt(0)" ::: "memory")
#define VM_WAIT() asm volatile("s_waitcnt vmcnt(0)" ::: "memory")
__device__ __forceinline__ unsigned long long rt() { return __builtin_amdgcn_s_memrealtime(); }
__device__ __forceinline__ unsigned f2bfu(float f) { unsigned u = __builtin_bit_cast(unsigned, f); return (u + 0x7fffu + ((u >> 16) & 1u)) >> 16; }
__device__ __forceinline__ unsigned pk2(float lo, float hi) { return f2bfu(lo) | (f2bfu(hi) << 16); }
#define XB_TMO      128
#define XB_XCNT(j)  (256  + 64 * (j))
#define XB_XSUB(j)  (1280 + 64 * (j))
#define XB_XGEN(j)  (2304 + 64 * (j))
#define XB_TOP      3328
#define XB_TOPGEN   3392
#define XCD_BAR_WORDS 3456
#define XB_SPIN_CAP (1u << 18)

__device__ __forceinline__ unsigned xb_ld(unsigned* p)              { return __hip_atomic_load(p, __ATOMIC_RELAXED, __HIP_MEMORY_SCOPE_AGENT); }
__device__ __forceinline__ unsigned xb_add(unsigned* p, unsigned v) { return __hip_atomic_fetch_add(p, v, __ATOMIC_RELAXED, __HIP_MEMORY_SCOPE_AGENT); }
__device__ __forceinline__ unsigned xb_xcc_id() { return (unsigned)__builtin_amdgcn_s_getreg((3 << 11) | 20) & 0xFu; }
#define XB_SPIN(cond, bar) do { unsigned _sp = 0; while (cond) { __builtin_amdgcn_s_sleep(1); \
    if ((++_sp & 255u) == 0u) { if (xb_ld(&(bar)[XB_TMO])) break; if (_sp > XB_SPIN_CAP) { atomicAdd(&(bar)[XB_TMO], 1u); break; } } } } while (0)

struct XcdBarrier {
    unsigned* bar; unsigned x;
    volatile LAS unsigned* st;
};

__device__ __forceinline__ XcdBarrier xcd_barrier_post(unsigned* bar, volatile LAS unsigned* st) {
    XcdBarrier b; b.bar = bar; b.x = xb_xcc_id(); b.st = st;
    if (threadIdx.x == 0) (void)xb_add(&bar[XB_XCNT(b.x)], 1u);
    return b;
}
__device__ __forceinline__ void xcd_barrier_complete(unsigned* bar, unsigned x, unsigned& nloc, unsigned& nx) {
    const unsigned G = gridDim.x * gridDim.y * gridDim.z;
    unsigned sum, cnt, mine, sp = 0u;
    for (;;) {
        sum = 0u; cnt = 0u; mine = 0u;
#pragma unroll
        for (unsigned j = 0; j < 16; ++j) { const unsigned c = xb_ld(&bar[XB_XCNT(j)]); sum += c; cnt += (c > 0u) ? 1u : 0u; mine = (j == x) ? c : mine; }
        if (sum == G) break;
        __builtin_amdgcn_s_sleep(1);
        if ((++sp & 255u) == 0u) { if (xb_ld(&bar[XB_TMO])) break; if (sp > XB_SPIN_CAP) { atomicAdd(&bar[XB_TMO], 1u); break; } }
    }
    nloc = mine > 0u ? mine : 1u; nx = cnt > 0u ? cnt : 1u;
}

__device__ __forceinline__ void xcd_barrier(const XcdBarrier& b) {
    asm volatile("s_waitcnt vmcnt(0)" ::: "memory");
    __syncthreads();
    if (threadIdx.x == 0) {
        unsigned* bar = b.bar;
        __builtin_amdgcn_s_waitcnt(0);
        unsigned nloc = b.st[0], nx = b.st[1];
        if (nloc == 0u) { xcd_barrier_complete(bar, b.x, nloc, nx); b.st[0] = nloc; b.st[1] = nx; }
        const unsigned old = xb_add(&bar[XB_XSUB(b.x)], 1u);
        const unsigned gen = old / nloc;
        if (old + 1u == (gen + 1u) * nloc) {
            __builtin_amdgcn_fence(__ATOMIC_RELEASE, "agent");
            asm volatile("s_waitcnt vmcnt(0)" ::: "memory");
            const unsigned og = xb_add(&bar[XB_TOP], 1u);
            const unsigned tg = og / nx;
            if (og + 1u == (tg + 1u) * nx) xb_add(&bar[XB_TOPGEN], 1u);
            else XB_SPIN(xb_ld(&bar[XB_TOPGEN]) == tg, bar);
            __builtin_amdgcn_fence(__ATOMIC_ACQUIRE, "agent");
            xb_add(&bar[XB_XGEN(b.x)], 1u);
            asm volatile("s_waitcnt vmcnt(0)" ::: "memory");
        } else {
            XB_SPIN(xb_ld(&bar[XB_XGEN(b.x)]) == gen, bar);
            __builtin_amdgcn_fence(__ATOMIC_ACQUIRE, "agent");
            asm volatile("s_waitcnt vmcnt(0)" ::: "memory");
        }
    }
    __syncthreads();
}
constexpr int NWAVES = 8;
constexpr int RING_OFF = 0, RING_BYTES = 131072;
constexpr int LDSCTL_OFF = RING_BYTES, MISC_OFF = LDSCTL_OFF + 320;
constexpr int LDS_BYTES = 147456;
constexpr int CW_BAR = 4096;
constexpr int CW_KMEAN = 32768;
constexpr int CW_MEMKSS = 65536;
static_assert((CW_MEMKSS + 4096) * 4 <= (int)MiB && CW_BAR + 4 * 3456 <= CW_KMEAN, "ctl map");

struct Frame {
    LAS unsigned char* lds; volatile LAS unsigned* MISC; gu32* ctl;
    int tid, lane, wave, vcu, G;
    unsigned char* ws; float* out;
};
__device__ __forceinline__ float wave_sum64(float v) {
#pragma unroll
    for (int o = 1; o < 64; o <<= 1) v += __shfl_xor(v, o);
    return v;
}
template <bool HEADPERM> __device__ __forceinline__ void p0_transpose_item(const float* W, int K, int N, bf16* WT, int row_off, LAS float* scr, int item, int lane) {
    const int nblk = N / 32, kb = item / nblk, nb = item % nblk, k0 = 64 * kb, n0 = 32 * nb;
    int p0 = n0; if (HEADPERM) { const int lg = (n0 >> 5) & 7; p0 = (n0 & ~255) + 32 * (4 * (lg & 1) + (lg >> 1)); }
    float wv[32];
#pragma unroll
    for (int i = 0; i < 32; ++i) wv[i] = W[(size_t)(k0 + 2 * i + (lane >> 5)) * N + n0 + (lane & 31)];
#pragma unroll
    for (int i = 0; i < 32; ++i) scr[(2 * i + (lane >> 5)) * 33 + (lane & 31)] = wv[i];
    LDS_WAIT(); asm volatile("" ::: "memory");
    const int c = lane & 7;
#pragma unroll
    for (int j = 0; j < 4; ++j) { const int n = (lane >> 3) + 8 * j; const LAS float* s = scr + (8 * c) * 33 + n;
        v4u o; o.x = pk2(s[0 * 33], s[1 * 33]); o.y = pk2(s[2 * 33], s[3 * 33]); o.z = pk2(s[4 * 33], s[5 * 33]); o.w = pk2(s[6 * 33], s[7 * 33]);
        *(GAS v4u*)(WT + (size_t)(row_off + p0 + n) * K + k0 + 8 * c) = o; }
    LDS_WAIT(); asm volatile("" ::: "memory");
}
__device__ __forceinline__ void rms_row_to_bf16(int lane, const float* xrow, const float* g, bf16* orow) {
    const GAS f32x4* xr = (const GAS f32x4*)xrow + lane; const GAS f32x4* gr = (const GAS f32x4*)g + lane;
    f32x4 v[4]; float s = 0.f;
#pragma unroll
    for (int j = 0; j < 4; ++j) { v[j] = xr[64 * j]; s += (v[j].x * v[j].x + v[j].y * v[j].y) + (v[j].z * v[j].z + v[j].w * v[j].w); }
    const float r = 1.f / sqrtf(wave_sum64(s) * (1.f / 1024.f) + 1e-5f);
    GAS unsigned long long* o8 = (GAS unsigned long long*)orow + lane;
#pragma unroll
    for (int j = 0; j < 4; ++j) { const f32x4 gg = gr[64 * j]; o8[64 * j] = (unsigned long long)pk2(v[j].x * r * gg.x, v[j].y * r * gg.y) | ((unsigned long long)pk2(v[j].z * r * gg.z, v[j].w * r * gg.w) << 32); }
}
struct Args { const float* in[23]; float* out; unsigned char* ws; int ph_lo, ph_hi, li, pad; };
__device__ __forceinline__ void p0_prologue(Frame& F, const Args& A) {
    LAS float* scr = (LAS float*)(F.lds + RING_OFF + F.wave * 16384);
    const int gw = F.vcu * NWAVES + F.wave, NGW = F.G * NWAVES;
    constexpr int I_IN = 16 * (DIN / 32), I_MKV = 16 * 32, I_BR = 8 * 32, I_OUT = 16 * 32;
    constexpr int NITEMS = I_IN + I_MKV + 3 * I_BR + I_OUT;
    for (int it = gw; it < NITEMS; it += NGW) {
        int r = it;
        if (r < I_IN) { p0_transpose_item<true>(A.in[3], 1024, DIN, (bf16*)(F.ws + WS_WIN), 0, scr, r, F.lane); continue; } r -= I_IN;
        if (r < I_MKV) { p0_transpose_item<true>(A.in[9], 1024, 1024, (bf16*)(F.ws + WS_WMEMKV), 0, scr, r, F.lane); continue; } r -= I_MKV;
        if (r < 3 * I_BR) { const int w = r / I_BR; p0_transpose_item<false>(w == 0 ? A.in[12] : (w == 1 ? A.in[13] : A.in[14]), 512, 1024, (bf16*)(F.ws + WS_WBR) + (size_t)w * 1024 * 512, 0, scr, r % I_BR, F.lane); continue; } r -= 3 * I_BR;
        p0_transpose_item<false>(A.in[15], 1024, 1024, (bf16*)(F.ws + WS_WOUT), 0, scr, r, F.lane);
    }
    if (gw == 0) { ((float*)(F.ws + WS_GTAB))[F.lane] = A.in[6][F.lane]; ((float*)(F.ws + WS_GTAB))[64 + F.lane] = A.in[7][F.lane]; }
    for (int m = gw; m < NTOK; m += NGW) rms_row_to_bf16(F.lane, A.in[0] + (size_t)m * DM, A.in[2], (bf16*)(F.ws + WS_HB) + (size_t)m * DM);
    for (int m = gw; m < NB * MEMLEN; m += NGW) rms_row_to_bf16(F.lane, A.in[1] + (size_t)m * DM, A.in[8], (bf16*)(F.ws + WS_HM) + (size_t)m * DM);
}

struct P1Order {
    pg8::StaticOrder so; int G, c;
    __device__ void init(int G_, int c_) { so.init(NTOK, DIN, G_, 0); G = G_; c = c_; }
    __device__ bool next(int i, pg8::Unit& u) const {
        long L = (long)i * G + c;
        if (L < 1664) { pg8::StaticOrder t = so; t.G = 1; t.c = 0; return t.next((int)L, u); }
        L -= 1664; if (L >= 16) return false;
        u.pm = 64 + (int)(L >> 2); u.pn = 26 + (int)(L & 3); return true;
    }
    __device__ __forceinline__ void a_ready(const pg8::Unit&) const {}
    __device__ __forceinline__ void done(const pg8::Unit&) const {}
};
__device__ __forceinline__ float sigmoid_f(float x) { return __builtin_amdgcn_rcpf(1.f + __expf(-x)); }
typedef float f32x2_t __attribute__((ext_vector_type(2))); typedef __bf16 bf16x2_t __attribute__((ext_vector_type(2)));
__device__ __forceinline__ unsigned cvt_pk_bf16(float lo, float hi) { f32x2_t v = {lo, hi}; bf16x2_t b = __builtin_convertvector(v, bf16x2_t); return __builtin_bit_cast(unsigned, b); }
struct EpiP1 {
    static constexpr bool PERM = true, AFTER_DRAIN = false;
    unsigned char* ws; const float* b_gate; const float* gtab; float* KMEAN; float* MEMKSS; int atom_on;
    __device__ __forceinline__ void operator()(const pg8::f32x4 (&acc)[2][2][4][2], const pg8::Unit& u, int wr, int wc, int fr, int fq) const {
        using pg8::f32x4; using pg8::u32x4;
        const int pn = u.pn; int type, ldc, cb; size_t off; int row0 = u.pm * 256;
        if (pn == 0) { type = 0; off = WS_RQ; ldc = 256; cb = 0; }
        else if (pn == 1) { type = 1; off = WS_RK; ldc = 256; cb = 0; }
        else if (pn < 4) { type = 0; off = WS_RV; ldc = 512; cb = (pn - 2) * 256; }
        else if (pn < 6) { type = 2; off = WS_RG; ldc = 512; cb = (pn - 4) * 256; }
        else if (pn < 8) { type = 3; off = WS_MQ; ldc = 512; cb = (pn - 6) * 256; }
        else if (pn < 10) { type = 4; off = WS_MK; ldc = 512; cb = (pn - 8) * 256; }
        else if (pn < 12) { type = 0; off = WS_MV; ldc = 512; cb = (pn - 10) * 256; }
        else if (pn < 14) { type = 0; off = WS_CQ; ldc = 512; cb = (pn - 12) * 256; }
        else if (pn < 26) { type = 5; off = WS_GT; ldc = 3072; cb = (pn - 14) * 256; }
        else if (pn < 28) { type = 6; off = WS_MEMK; ldc = 512; cb = (pn - 26) * 256; row0 = (u.pm - 64) * 256; }
        else { type = 0; off = WS_MEMV; ldc = 512; cb = (pn - 28) * 256; row0 = (u.pm - 64) * 256; }
        bf16_t* base = (bf16_t*)(ws + off) + cb + 64 * wc + 8 * fq;
        const int rbase = row0 + 64 * wr + fr;
#define P1_STORE(rowp, bj, v0, v1) do { u32x4 w_; w_.x = cvt_pk_bf16((v0)[0], (v0)[1]); w_.y = cvt_pk_bf16((v0)[2], (v0)[3]); w_.z = cvt_pk_bf16((v1)[0], (v1)[1]); w_.w = cvt_pk_bf16((v1)[2], (v1)[3]); *(u32x4*)((rowp) + 32 * (bj)) = w_; } while (0)
        if (type <= 1) {
            const float sc = type == 1 ? 0.125f : 1.f;
#pragma unroll
            for (int ai = 0; ai < 2; ++ai)
#pragma unroll
                for (int m = 0; m < 4; ++m) { bf16_t* rowp = base + (size_t)(rbase + 128 * ai + 16 * m) * ldc;
#pragma unroll
                    for (int bj = 0; bj < 2; ++bj) { const f32x4 v0 = acc[ai][bj][m][0] * sc, v1 = acc[ai][bj][m][1] * sc; P1_STORE(rowp, bj, v0, v1); } }
        } else if (type == 2) {
#pragma unroll
            for (int ai = 0; ai < 2; ++ai)
#pragma unroll
                for (int m = 0; m < 4; ++m) { bf16_t* rowp = base + (size_t)(rbase + 128 * ai + 16 * m) * ldc;
#pragma unroll
                    for (int bj = 0; bj < 2; ++bj) { f32x4 v0 = acc[ai][bj][m][0], v1 = acc[ai][bj][m][1];
#pragma unroll
                        for (int j = 0; j < 4; ++j) { v0[j] = v0[j] * sigmoid_f(v0[j]); v1[j] = v1[j] * sigmoid_f(v1[j]); }
                        P1_STORE(rowp, bj, v0, v1); } }
        } else if (type == 5) {
            f32x4 bv[2][2];
#pragma unroll
            for (int bj = 0; bj < 2; ++bj)
#pragma unroll
                for (int n = 0; n < 2; ++n) bv[bj][n] = *(const f32x4*)(b_gate + cb + 64 * wc + 32 * bj + 8 * fq + 4 * n);
#pragma unroll
            for (int ai = 0; ai < 2; ++ai)
#pragma unroll
                for (int m = 0; m < 4; ++m) { bf16_t* rowp = base + (size_t)(rbase + 128 * ai + 16 * m) * ldc;
#pragma unroll
                    for (int bj = 0; bj < 2; ++bj) { f32x4 v0 = acc[ai][bj][m][0] + bv[bj][0], v1 = acc[ai][bj][m][1] + bv[bj][1];
#pragma unroll
                        for (int j = 0; j < 4; ++j) { v0[j] = sigmoid_f(v0[j]); v1[j] = sigmoid_f(v1[j]); }
                        P1_STORE(rowp, bj, v0, v1); } }
        } else if (type == 6) {
#pragma unroll
            for (int ai = 0; ai < 2; ++ai)
#pragma unroll
                for (int m = 0; m < 4; ++m) { const int row = rbase + 128 * ai + 16 * m; bf16_t* rowp = base + (size_t)row * ldc; float ss = 0.f;
#pragma unroll
                    for (int bj = 0; bj < 2; ++bj) { const f32x4 v0 = acc[ai][bj][m][0], v1 = acc[ai][bj][m][1];
                        ss += (v0[0] * v0[0] + v0[1] * v0[1]) + (v0[2] * v0[2] + v0[3] * v0[3]) + (v1[0] * v1[0] + v1[1] * v1[1]) + (v1[2] * v1[2] + v1[3] * v1[3]);
                        P1_STORE(rowp, bj, v0, v1); }
                    ss += __shfl_xor(ss, 16); ss += __shfl_xor(ss, 32);
                    if (fq == 0 && atom_on) atomicAdd(MEMKSS + (size_t)row * 4 + (cb >> 7) + (wc >> 1), ss);
                    }
        } else {
            const float* g = gtab + (type == 3 ? 0 : 64);
            f32x4 gv[2][2]; float rr[2][4];
#pragma unroll
            for (int bj = 0; bj < 2; ++bj)
#pragma unroll
                for (int n = 0; n < 2; ++n) gv[bj][n] = *(const f32x4*)(g + 32 * bj + 8 * fq + 4 * n);
#pragma unroll
            for (int ai = 0; ai < 2; ++ai)
#pragma unroll
                for (int m = 0; m < 4; ++m) { bf16_t* rowp = base + (size_t)(rbase + 128 * ai + 16 * m) * ldc; float ss = 0.f;
#pragma unroll
                    for (int bj = 0; bj < 2; ++bj) { const f32x4 v0 = acc[ai][bj][m][0], v1 = acc[ai][bj][m][1];
                        ss += (v0[0] * v0[0] + v0[1] * v0[1]) + (v0[2] * v0[2] + v0[3] * v0[3]) + (v1[0] * v1[0] + v1[1] * v1[1]) + (v1[2] * v1[2] + v1[3] * v1[3]); }
                    ss += __shfl_xor(ss, 16); ss += __shfl_xor(ss, 32);
                    const float r = (1.f / sqrtf(ss * (1.f / 64.f) + 1e-5f)) * (type == 3 ? 0.18033688011112042f : 1.f); rr[ai][m] = r;
#pragma unroll
                    for (int bj = 0; bj < 2; ++bj) { const f32x4 v0 = acc[ai][bj][m][0] * r * gv[bj][0], v1 = acc[ai][bj][m][1] * r * gv[bj][1];
                        P1_STORE(rowp, bj, v0, v1); }
                    asm volatile("" ::: "memory"); }
            if (type == 4 && atom_on) {
                float* km = KMEAN + ((size_t)u.pm * 8 + (cb >> 6) + wc) * 64 + 8 * fq;
#pragma unroll
                for (int bj = 0; bj < 2; ++bj)
#pragma unroll
                    for (int n = 0; n < 2; ++n)
#pragma unroll
                        for (int j = 0; j < 4; ++j) { float s = 0.f;
#pragma unroll
                            for (int ai = 0; ai < 2; ++ai)
#pragma unroll
                                for (int m = 0; m < 4; ++m) s += acc[ai][bj][m][n][j] * rr[ai][m];
                            s += __shfl_xor(s, 1); s += __shfl_xor(s, 2); s += __shfl_xor(s, 4); s += __shfl_xor(s, 8);
                            if (fr == 0) atomicAdd(km + 32 * bj + 4 * n + j, s * gv[bj][n][j] * (1.f / 256.f)); }
            }
        }
#undef P1_STORE
    }
};

constexpr int TB_OFF = LDSCTL_OFF + 1024;
__device__ __forceinline__ unsigned cvt_pk(float lo, float hi) { return cvt_pk_bf16(lo, hi); }

struct P3Order {
    pg8::StaticOrder so; int G, c; const unsigned char* ws;
    __device__ void init(int G_, int c_, const unsigned char* ws_) { so.init(NTOK, 1024, 1, 0); G = G_; c = c_; ws = ws_; }
    __device__ bool next(int i, pg9::Unit& u) const {
        const int tl = (i / 3) * G + c; if (tl >= 256) return false; pg8::Unit t; so.next(tl, t); u.pm = t.pm; u.pn = t.pn; u.aux = i % 3; u.cnt = 256; return true; }
    __device__ __forceinline__ const char* a_base(const pg9::Unit& u) const { return (const char*)(ws + WS_ORET) + (size_t)u.aux * (WS_OMOBA - WS_ORET) + (size_t)u.pm * 256 * 512 * 2; }
    __device__ __forceinline__ const char* b_base(const pg9::Unit& u) const { return (const char*)(ws + WS_WBR) + (size_t)u.aux * 1024 * 512 * 2 + (size_t)u.pn * 256 * 512 * 2; }
};
struct EpiP3 {
    static constexpr bool PERM = true, CHAIN = true;
    const bf16_t* GT; bf16_t* Y;
    __device__ __forceinline__ bool chain_more(const pg9::Unit& u) const { return u.aux < 2; }
    __device__ __forceinline__ void rescale(pg8::f32x4 (&acc)[2][2][4][2], const pg9::Unit& u, int wr, int wc, int fr, int fq) const {
        const int s = u.aux;
#pragma unroll
        for (int ai = 0; ai < 2; ++ai)
#pragma unroll
            for (int m = 0; m < 4; ++m) { const bf16_t* gp = GT + (size_t)(u.pm * 256 + 128 * ai + 64 * wr + 16 * m + fr) * 3072 + s * 1024 + u.pn * 256 + 32 * wc + 8 * fq;
#pragma unroll
                for (int bj = 0; bj < 2; ++bj) { const pg8::u32x4 ga = *(const pg8::u32x4*)(gp + 128 * bj), gb = *(const pg8::u32x4*)(gp + 1024 + 128 * bj);
#pragma unroll
                    for (int n = 0; n < 2; ++n)
#pragma unroll
                        for (int j = 0; j < 4; ++j) { const int e = 4 * n + j; const unsigned wa = ga[e >> 1], wb = gb[e >> 1];
                            const float fa = __uint_as_float((e & 1) ? (wa & 0xffff0000u) : (wa << 16)), fb = __uint_as_float((e & 1) ? (wb & 0xffff0000u) : (wb << 16));
                            acc[ai][bj][m][n][j] *= fa * __builtin_amdgcn_rcpf(fmaxf(fb, 1e-20f)); } }
                asm volatile("" ::: "memory"); }
    }
    __device__ __forceinline__ void operator()(const pg8::f32x4 (&acc)[2][2][4][2], const pg9::Unit& u, int wr, int wc, int fr, int fq) const {
#pragma unroll
        for (int ai = 0; ai < 2; ++ai)
#pragma unroll
            for (int m = 0; m < 4; ++m) { const size_t row = (size_t)(u.pm * 256 + 128 * ai + 64 * wr + 16 * m + fr); const bf16_t* gp = GT + row * 3072 + 2048 + u.pn * 256 + 32 * wc + 8 * fq; bf16_t* yp = Y + row * 1024 + u.pn * 256 + 32 * wc + 8 * fq;
#pragma unroll
                for (int bj = 0; bj < 2; ++bj) { const pg8::u32x4 ga = *(const pg8::u32x4*)(gp + 128 * bj); float v[8];
#pragma unroll
                    for (int n = 0; n < 2; ++n)
#pragma unroll
                        for (int j = 0; j < 4; ++j) { const int e = 4 * n + j; const unsigned wa = ga[e >> 1]; v[e] = acc[ai][bj][m][n][j] * __uint_as_float((e & 1) ? (wa & 0xffff0000u) : (wa << 16)); }
                    pg8::u32x4 w; w.x = cvt_pk(v[0], v[1]); w.y = cvt_pk(v[2], v[3]); w.z = cvt_pk(v[4], v[5]); w.w = cvt_pk(v[6], v[7]); *(pg8::u32x4*)(yp + 128 * bj) = w; }
                asm volatile("" ::: "memory"); }
    }
};
struct P4Order {
    pg8::StaticOrder so; int G, c; const unsigned char* ws;
    __device__ void init(int G_, int c_, const unsigned char* ws_) { so.init(NTOK, 1024, 1, 0); G = G_; c = c_; ws = ws_; }
    __device__ bool next(int i, pg9::Unit& u) const { const int tl = i * G + c; if (tl >= 256) return false; pg8::Unit t; so.next(tl, t); u.pm = t.pm; u.pn = t.pn; u.aux = 0; u.cnt = 256; return true; }
    __device__ __forceinline__ const char* a_base(const pg9::Unit& u) const { return (const char*)(ws + WS_Y) + (size_t)u.pm * 256 * 1024 * 2; }
    __device__ __forceinline__ const char* b_base(const pg9::Unit& u) const { return (const char*)(ws + WS_WOUT) + (size_t)u.pn * 256 * 1024 * 2; }
};
struct EpiP4 {
    static constexpr bool PERM = false, CHAIN = false;
    const float* x; float* out;
    __device__ __forceinline__ void operator()(const pg8::f32x4 (&acc)[2][2][4][2], const pg9::Unit& u, int wr, int wc, int fr, int fq) const {
#pragma unroll
        for (int ai = 0; ai < 2; ++ai)
#pragma unroll
            for (int m = 0; m < 4; ++m) { const size_t off = (size_t)(u.pm * 256 + 128 * ai + 64 * wr + 16 * m + fr) * 1024 + u.pn * 256 + 32 * wc + 4 * fq;
#pragma unroll
                for (int bj = 0; bj < 2; ++bj)
#pragma unroll
                    for (int n = 0; n < 2; ++n) { const pg8::f32x4 xv = *(const pg8::f32x4*)(x + off + 128 * bj + 16 * n); *(pg8::f32x4*)(out + off + 128 * bj + 16 * n) = xv + acc[ai][bj][m][n]; }
                if (m & 1) asm volatile("" ::: "memory"); }
    }
};
__device__ __forceinline__ float wave_max64(float v) {
#pragma unroll
    for (int o = 1; o < 64; o <<= 1) v = fmaxf(v, __shfl_xor(v, o));
    return v;
}
__device__ __forceinline__ void p5_router(Frame& F, const float* X1, const float* g_ffn, const float* w_router, const float* b_router, int* COUNTS, int* LISTS) {
    bf16_t* XT = (bf16_t*)(F.ws + WS_XT); int* TOPE = (int*)(F.ws + WS_TOPE); float* TOPW = (float*)(F.ws + WS_TOPW);
    const int lane = F.lane, e = lane & 31, kq = lane >> 5, tid = F.tid;
    LAS float* wsh = (LAS float*)(F.lds);
    LAS float* xs = (LAS float*)(F.lds + 65536) + F.wave * 2048;
    for (int v = F.vcu; v < NTOK / 64; v += F.G) {
        const int tw = v * 64 + F.wave * 8;
        float acc[2][4]; float rr[2][4];
#pragma unroll
        for (int g = 0; g < 2; ++g)
#pragma unroll
            for (int q = 0; q < 4; ++q) { acc[g][q] = 0.f; rr[g][q] = 0.f; }
#pragma unroll
        for (int half = 0; half < 2; ++half) {
            __syncthreads();
#pragma unroll
            for (int i = 0; i < 8; ++i) { const int ci = tid + 512 * i; *(LAS f32x4*)(wsh + 4 * ci) = *(const f32x4*)(w_router + (size_t)half * 512 * 32 + 4 * ci); }
            __syncthreads();
#pragma unroll
            for (int g = 0; g < 2; ++g) {
#pragma unroll
                for (int q = 0; q < 4; ++q) { const int t = tw + 4 * g + q; const float* xr = X1 + (size_t)t * 1024;
                    if (half == 0) { f32x4 x4[4]; float s = 0.f;
#pragma unroll
                        for (int j = 0; j < 4; ++j) { x4[j] = *(const f32x4*)(xr + 4 * lane + 256 * j); s += (x4[j].x * x4[j].x + x4[j].y * x4[j].y) + (x4[j].z * x4[j].z + x4[j].w * x4[j].w); }
                        const float r = 1.f / sqrtf(wave_sum64(s) * (1.f / 1024.f) + 1e-5f); rr[g][q] = r;
#pragma unroll
                        for (int j = 0; j < 4; ++j) { const f32x4 gg = *(const f32x4*)(g_ffn + 4 * lane + 256 * j); const f32x4 xn = x4[j] * r * gg;
                            uint2 w; w.x = cvt_pk(xn.x, xn.y); w.y = cvt_pk(xn.z, xn.w); *(uint2*)(XT + (size_t)t * 1024 + 4 * lane + 256 * j) = w;
                            if (j < 2) *(LAS f32x4*)(xs + q * 512 + 4 * lane + 256 * j) = xn; }
                    } else {
#pragma unroll
                        for (int j = 0; j < 2; ++j) { const f32x4 gg = *(const f32x4*)(g_ffn + 512 + 4 * lane + 256 * j); const f32x4 xn = *(const f32x4*)(xr + 512 + 4 * lane + 256 * j) * rr[g][q] * gg; *(LAS f32x4*)(xs + q * 512 + 4 * lane + 256 * j) = xn; }
                    } }
                asm volatile("s_waitcnt lgkmcnt(0)" ::: "memory");
#pragma unroll 2
                for (int k = 256 * kq; k < 256 * kq + 256; k += 4) { const float w0 = wsh[(k + 0) * 32 + e], w1 = wsh[(k + 1) * 32 + e], w2 = wsh[(k + 2) * 32 + e], w3 = wsh[(k + 3) * 32 + e];
#pragma unroll
                    for (int q = 0; q < 4; ++q) { const f32x4 x = *(const LAS f32x4*)(xs + q * 512 + k); acc[g][q] += x.x * w0 + x.y * w1 + x.z * w2 + x.w * w3; } }
                asm volatile("s_waitcnt lgkmcnt(0)" ::: "memory");
            }
        }
        volatile LAS int* lcnt = (volatile LAS int*)(F.lds + TB_OFF);
        __syncthreads();
        if (tid < 32) lcnt[tid] = 0;
        __syncthreads();
        const float bias = b_router[e];
        int my_e[2][4], my_r[2][4];
#pragma unroll
        for (int g = 0; g < 2; ++g)
#pragma unroll
            for (int q = 0; q < 4; ++q) { const int t = tw + 4 * g + q; float lg = acc[g][q] + __shfl_xor(acc[g][q], 32) + bias; if (lane >= 32) lg = -INFINITY;
                float tv[4]; int te[4];
#pragma unroll
                for (int k = 0; k < 4; ++k) { const float m = wave_max64(lg); const unsigned long long bal = __ballot(lg == m); const int ee = __ffsll((long long)bal) - 1; tv[k] = m; te[k] = ee; if (lane == ee) lg = -INFINITY; }
                float ex[4], se = 0.f;
#pragma unroll
                for (int k = 0; k < 4; ++k) { ex[k] = __expf(tv[k] - tv[0]); se += ex[k]; }
                int e_l = te[0]; float w_l = ex[0];
#pragma unroll
                for (int k = 1; k < 4; ++k) if (lane == k) { e_l = te[k]; w_l = ex[k]; }
                my_e[g][q] = e_l; my_r[g][q] = 0;
                if (lane < 4) { TOPE[t * 4 + lane] = e_l; TOPW[t * 4 + lane] = w_l / se; my_r[g][q] = __hip_atomic_fetch_add((LAS int*)(F.lds + TB_OFF) + e_l, 1, __ATOMIC_RELAXED, __HIP_MEMORY_SCOPE_WORKGROUP); } }
        __syncthreads();
        if (tid < 32) { const int c = lcnt[tid]; lcnt[32 + tid] = c ? atomicAdd(&COUNTS[tid], c) : 0; }
        __syncthreads();
#pragma unroll
        for (int g = 0; g < 2; ++g)
#pragma unroll
            for (int q = 0; q < 4; ++q) if (lane < 4) { const int t = tw + 4 * g + q; LISTS[(size_t)my_e[g][q] * 16384 + lcnt[32 + my_e[g][q]] + my_r[g][q]] = t * 4 + lane; }
    }
}
__device__ __forceinline__ void moe_tables(Frame& F) {
    volatile LAS int* TB = (volatile LAS int*)(F.lds + TB_OFF);
    if (F.tid == 0) { const int* COUNTS = (const int*)F.ctl + CW_COUNTS; int acc = 0; for (int e = 0; e < 32; ++e) { const int c = __hip_atomic_load(COUNTS + e, __ATOMIC_RELAXED, __HIP_MEMORY_SCOPE_AGENT); TB[e] = acc; TB[33 + e] = c; acc += (c + 255) >> 8; } TB[32] = acc; }
    __syncthreads();
}
template <int NPN_LOG2, size_t WOFF, int NROWS_B, int ASHIFT, size_t AOFF> struct MoeOrder {
    int G, c; const unsigned char* ws; const LAS int* TB; const int* LISTS;
    __device__ void init(int G_, int c_, const unsigned char* ws_, const LAS int* TB_) { G = G_; c = c_; ws = ws_; TB = TB_; LISTS = (const int*)(ws_ + WS_LISTS); }
    __device__ bool next(int i, pg9::Unit& u) const {
        const int L = i * G + c; const int mt = L >> NPN_LOG2; if (mt >= TB[32]) return false;
        int e = 0;
#pragma unroll 1
        for (int k = 16; k >= 1; k >>= 1) if (TB[e + k] <= mt) e += k;
        u.aux = e; u.pm = mt - TB[e]; u.pn = L & ((1 << NPN_LOG2) - 1); u.cnt = TB[33 + e] - u.pm * 256; return true;
    }
    __device__ __forceinline__ const char* a_base(const pg9::Unit&) const { return (const char*)(ws + AOFF); }
    __device__ __forceinline__ const char* b_base(const pg9::Unit& u) const { return (const char*)(ws + WOFF) + ((size_t)u.aux * NROWS_B + (size_t)u.pn * 256) * 1024 * 2; }
    __device__ __forceinline__ unsigned a_row_off(const pg9::Unit& u, int r) const { const int rr = r < u.cnt ? r : u.cnt - 1; const int id = LISTS[(size_t)u.aux * 16384 + u.pm * 256 + rr]; return (unsigned)(id >> ASHIFT) * 2048u; }
};
struct EpiMoe1 {
    static constexpr bool PERM = true, CHAIN = false;
    const int* LISTS; const float* b1; bf16_t* ACT;
    __device__ __forceinline__ void operator()(const pg8::f32x4 (&acc)[2][2][4][2], const pg9::Unit& u, int wr, int wc, int fr, int fq) const {
        const int e = u.aux; const int c0 = u.pn * 256 + 32 * wc + 8 * fq;
        pg8::f32x4 bv[2][2];
#pragma unroll
        for (int bj = 0; bj < 2; ++bj)
#pragma unroll
            for (int n = 0; n < 2; ++n) bv[bj][n] = *(const pg8::f32x4*)(b1 + (size_t)e * 2048 + c0 + 128 * bj + 4 * n);
#pragma unroll
        for (int ai = 0; ai < 2; ++ai)
#pragma unroll
            for (int m = 0; m < 4; ++m) { const int r = 128 * ai + 64 * wr + 16 * m + fr; const bool ok = r < u.cnt; const int id = ok ? LISTS[(size_t)e * 16384 + u.pm * 256 + r] : 0;
#pragma unroll
                for (int bj = 0; bj < 2; ++bj) { float a[4];
#pragma unroll
                    for (int n = 0; n < 2; ++n)
#pragma unroll
                        for (int p = 0; p < 2; ++p) { const float gl = fminf(acc[ai][bj][m][n][2 * p] + bv[bj][n][2 * p], 7.0f); const float li = fminf(fmaxf(acc[ai][bj][m][n][2 * p + 1] + bv[bj][n][2 * p + 1], -7.0f), 7.0f);
                            a[2 * n + p] = gl * sigmoid_f(1.702f * gl) * (li + 1.f); }
                    if (ok) { uint2 w; w.x = cvt_pk(a[0], a[1]); w.y = cvt_pk(a[2], a[3]); *(uint2*)(ACT + (size_t)id * 1024 + ((c0 + 128 * bj) >> 1)) = w; } }
                asm volatile("" ::: "memory"); }
    }
};
struct EpiMoe2 {
    static constexpr bool PERM = true, CHAIN = false;
    const int* LISTS; const float* b2; bf16_t* YS;
    __device__ __forceinline__ void operator()(const pg8::f32x4 (&acc)[2][2][4][2], const pg9::Unit& u, int wr, int wc, int fr, int fq) const {
        const int e = u.aux; const int c0 = u.pn * 256 + 32 * wc + 8 * fq;
        pg8::f32x4 bv[2][2];
#pragma unroll
        for (int bj = 0; bj < 2; ++bj)
#pragma unroll
            for (int n = 0; n < 2; ++n) bv[bj][n] = *(const pg8::f32x4*)(b2 + (size_t)e * 1024 + c0 + 128 * bj + 4 * n);
#pragma unroll
        for (int ai = 0; ai < 2; ++ai)
#pragma unroll
            for (int m = 0; m < 4; ++m) { const int r = 128 * ai + 64 * wr + 16 * m + fr; const bool ok = r < u.cnt; const int id = ok ? LISTS[(size_t)e * 16384 + u.pm * 256 + r] : 0;
#pragma unroll
                for (int bj = 0; bj < 2; ++bj) { const pg8::f32x4 v0 = acc[ai][bj][m][0] + bv[bj][0], v1 = acc[ai][bj][m][1] + bv[bj][1];
                    if (ok) { pg8::u32x4 w; w.x = cvt_pk(v0[0], v0[1]); w.y = cvt_pk(v0[2], v0[3]); w.z = cvt_pk(v1[0], v1[1]); w.w = cvt_pk(v1[2], v1[3]); *(pg8::u32x4*)(YS + (size_t)id * 1024 + c0 + 128 * bj) = w; } }
                asm volatile("" ::: "memory"); }
    }
};
__device__ __forceinline__ void p8_combine(Frame& F, const float* src, float* out) {
    const bf16_t* YS = (const bf16_t*)(F.ws + WS_YS); const float* TOPW = (const float*)(F.ws + WS_TOPW);
    const int gw = F.vcu * NWAVES + F.wave, NGW = F.G * NWAVES, lane = F.lane;
    for (int t = gw; t < NTOK; t += NGW) {
        const f32x4 w4 = *(const f32x4*)(TOPW + (size_t)t * 4);
#pragma unroll
        for (int j = 0; j < 2; ++j) {
            const int c = 8 * lane + 512 * j; f32x4 a0 = *(const f32x4*)(src + (size_t)t * 1024 + c), a1 = *(const f32x4*)(src + (size_t)t * 1024 + c + 4);
#pragma unroll
            for (int k = 0; k < 4; ++k) { const v4u y = *(const v4u*)(YS + ((size_t)t * 4 + k) * 1024 + c); const float wk = w4[k];
                a0.x += wk * __uint_as_float(y.x << 16); a0.y += wk * __uint_as_float(y.x & 0xffff0000u); a0.z += wk * __uint_as_float(y.y << 16); a0.w += wk * __uint_as_float(y.y & 0xffff0000u);
                a1.x += wk * __uint_as_float(y.z << 16); a1.y += wk * __uint_as_float(y.z & 0xffff0000u); a1.z += wk * __uint_as_float(y.w << 16); a1.w += wk * __uint_as_float(y.w & 0xffff0000u); }
            *(f32x4*)(out + (size_t)t * 1024 + c) = a0; *(f32x4*)(out + (size_t)t * 1024 + c + 4) = a1; }
    }
}
namespace att {
typedef float f32x16 __attribute__((ext_vector_type(16)));
typedef short s16x4 __attribute__((ext_vector_type(4)));
typedef short v4i16_t __attribute__((ext_vector_type(4)));
using pg8::bf16x8;
constexpr float LOG2E = 1.4426950408889634f;
__device__ __forceinline__ constexpr int crow(int r, int hi) { return (r & 3) + 8 * (r >> 2) + 4 * hi; }
template <int D> __device__ __forceinline__ int kswz(int row) { return D == 64 ? ((row >> 1) & 7) : (row & 15); }
template <int D> __device__ __forceinline__ int vswz(int row) { return D == 64 ? (((row >> 1) & 1) << 2) : ((row & 3) << 2); }
__device__ __forceinline__ s16x4 vtr(const LAS unsigned char* p) { return __builtin_bit_cast(s16x4, __builtin_amdgcn_ds_read_tr16_b64_v4i16((LAS v4i16_t*)p)); }
__device__ __forceinline__ bf16x8 pack8(const f32x16& x, int s) {
    typedef unsigned u32x4_t __attribute__((ext_vector_type(4))); u32x4_t p;
    p[0] = cvt_pk_bf16(x[8 * s + 0], x[8 * s + 1]); p[1] = cvt_pk_bf16(x[8 * s + 2], x[8 * s + 3]); p[2] = cvt_pk_bf16(x[8 * s + 4], x[8 * s + 5]); p[3] = cvt_pk_bf16(x[8 * s + 6], x[8 * s + 7]);
    return __builtin_bit_cast(bf16x8, p);
}
__device__ __forceinline__ float bfl(unsigned w) { return __uint_as_float(w << 16); }
__device__ __forceinline__ float bfh(unsigned w) { return __uint_as_float(w & 0xffff0000u); }

template <bool MOBA> __device__ __forceinline__ int tile_kbase(int tt, int qb) { if (!MOBA) return 64 * tt; if (tt < 4) return qb * 256 + 64 * tt; const int u = tt - 4; return (u >> 2) * 256 + 64 * (u & 3); }
template <int D, bool MOBA>
__device__ __forceinline__ void attn_unit(Frame& F, const int b, const int h, const int qb,
                                          const bf16_t* Qg, const bf16_t* Kg, const bf16_t* Vg, bf16_t* Og, const int ld,
                                          const float* KMEAN, const float* KSS, const float* gq, const float* gk) {
    constexpr int KB = 64 * D * 2, NKS = D / 16, NDH = D / 32, CPR = D / 8  , NST = (64 * CPR) / 512  ;
    int tid = F.tid, lane = F.lane; asm volatile("" : "+v"(tid), "+v"(lane));
    const int wave = F.wave, r32 = lane & 31, hi = lane >> 5;
    LAS unsigned char* lds = F.lds;
    const size_t qrow = (size_t)b * SEQ + qb * 256 + wave * 32 + r32;
    bf16x8 qr[NKS];
#pragma unroll
    for (int ks = 0; ks < NKS; ++ks) qr[ks] = *(const bf16x8*)(Qg + qrow * ld + h * D + 16 * ks + 8 * hi);
    unsigned selmask = 0u;
    if constexpr (MOBA) {
        if (qb > 0) {
            float qf[NKS * 8];
#pragma unroll
            for (int ks = 0; ks < NKS; ++ks) { const pg8::u32x4 w = __builtin_bit_cast(pg8::u32x4, qr[ks]);
#pragma unroll
                for (int j = 0; j < 4; ++j) { qf[ks * 8 + 2 * j] = bfl(w[j]); qf[ks * 8 + 2 * j + 1] = bfh(w[j]); } }
            float v0 = -INFINITY, v1 = -INFINITY, v2 = -INFINITY; int i0 = -1, i1 = -1, i2 = -1;
#pragma unroll 1
            for (int j = 0; j < qb; ++j) { const float* km = KMEAN + (((size_t)b * 16 + j) * 8 + h) * 64 + 8 * hi; float s = 0.f;
#pragma unroll
                for (int ks = 0; ks < NKS; ++ks) { const f32x4 k0 = *(const f32x4*)(km + 16 * ks), k1 = *(const f32x4*)(km + 16 * ks + 4);
                    s += qf[ks * 8 + 0] * k0[0] + qf[ks * 8 + 1] * k0[1] + qf[ks * 8 + 2] * k0[2] + qf[ks * 8 + 3] * k0[3] + qf[ks * 8 + 4] * k1[0] + qf[ks * 8 + 5] * k1[1] + qf[ks * 8 + 6] * k1[2] + qf[ks * 8 + 7] * k1[3]; }
                s += __shfl_xor(s, 32);
                const bool c0 = s > v0, c1 = s > v1, c2 = s > v2;
                v2 = c1 ? v1 : (c2 ? s : v2); i2 = c1 ? i1 : (c2 ? j : i2);
                v1 = c0 ? v0 : (c1 ? s : v1); i1 = c0 ? i0 : (c1 ? j : i1);
                v0 = c0 ? s : v0; i0 = c0 ? j : i0; }
            selmask = (i0 >= 0 ? (1u << i0) : 0u) | (i1 >= 0 ? (1u << i1) : 0u) | (i2 >= 0 ? (1u << i2) : 0u);
        }
    } else {
        float qf[NKS * 8]; float ss = 0.f;
#pragma unroll
        for (int ks = 0; ks < NKS; ++ks) { const pg8::u32x4 w = __builtin_bit_cast(pg8::u32x4, qr[ks]);
#pragma unroll
            for (int j = 0; j < 4; ++j) { qf[ks * 8 + 2 * j] = bfl(w[j]); qf[ks * 8 + 2 * j + 1] = bfh(w[j]); ss += qf[ks * 8 + 2 * j] * qf[ks * 8 + 2 * j] + qf[ks * 8 + 2 * j + 1] * qf[ks * 8 + 2 * j + 1]; } }
        ss += __shfl_xor(ss, 32);
        const float rq = (1.f / sqrtf(ss * (1.f / D) + 1e-5f)) * (0.08838834764831845f * LOG2E);
#pragma unroll
        for (int ks = 0; ks < NKS; ++ks) { const float* g1 = gq + 16 * ks + 8 * hi; const float* g2 = gk + 16 * ks + 8 * hi; pg8::u32x4 w;
#pragma unroll
            for (int j = 0; j < 4; ++j) w[j] = cvt_pk_bf16(qf[ks * 8 + 2 * j] * rq * g1[2 * j] * g2[2 * j], qf[ks * 8 + 2 * j + 1] * rq * g1[2 * j + 1] * g2[2 * j + 1]);
            qr[ks] = __builtin_bit_cast(bf16x8, w); }
    }
    const int NT = MOBA ? 4 * (qb + 1) : 4;
    const float sl2 = MOBA ? exp2f(-(float)(h + 1)) * LOG2E : 0.f;
    v4u kreg[NST], vreg[NST];
#define ATT_LOAD(tt) do { const int kb_ = tile_kbase<MOBA>(tt, qb); _Pragma("unroll") for (int i_ = 0; i_ < NST; ++i_) { const int ci_ = tid + 512 * i_, row_ = ci_ / CPR, ch_ = ci_ % CPR; \
        const size_t g_ = (size_t)(kb_ + row_) * ld + h * D + 8 * ch_; kreg[i_] = *(const v4u*)(Kg + g_); vreg[i_] = *(const v4u*)(Vg + g_); \
        if (!MOBA) { const float rk_ = 1.f / sqrtf(KSS[(size_t)(kb_ + row_) * 4 + h] * (1.f / D) + 1e-5f); v4u k_ = kreg[i_]; \
            k_.x = cvt_pk_bf16(bfl(k_.x) * rk_, bfh(k_.x) * rk_); k_.y = cvt_pk_bf16(bfl(k_.y) * rk_, bfh(k_.y) * rk_); k_.z = cvt_pk_bf16(bfl(k_.z) * rk_, bfh(k_.z) * rk_); k_.w = cvt_pk_bf16(bfl(k_.w) * rk_, bfh(k_.w) * rk_); kreg[i_] = k_; } } } while (0)
#define ATT_WRITE(buf) do { _Pragma("unroll") for (int i_ = 0; i_ < NST; ++i_) { const int ci_ = tid + 512 * i_, row_ = ci_ / CPR, ch_ = ci_ % CPR; \
        *(LAS v4u*)(lds + (buf) * KB + row_ * (2 * D) + ((ch_ ^ kswz<D>(row_)) << 4)) = kreg[i_]; *(LAS v4u*)(lds + (2 + (buf)) * KB + row_ * (2 * D) + ((ch_ ^ vswz<D>(row_)) << 4)) = vreg[i_]; } } while (0)
    ATT_LOAD(0); ATT_WRITE(0);
    __syncthreads();
    float m = -1e30f, l = 0.f;
    f32x16 o[NDH];
#pragma unroll
    for (int dh = 0; dh < NDH; ++dh)
#pragma unroll
        for (int r = 0; r < 16; ++r) o[dh][r] = 0.f;
    const int qrel = wave * 32 + r32;
    const int i16 = lane & 15, blk = (lane >> 4) & 1, tq = i16 >> 2, tp = i16 & 3;
    for (int tt = 0; tt < NT; ++tt) {
        const int buf = tt & 1;
        if (tt + 1 < NT) ATT_LOAD(tt + 1);
        bool act = true; bool lane_sel = true; int pblk = -1;
        if constexpr (MOBA) { if (tt >= 4) { pblk = (tt - 4) >> 2; lane_sel = (selmask >> pblk) & 1u; act = __builtin_amdgcn_ballot_w64(lane_sel) != 0ull; }
            else act = (64 * tt <= wave * 32 + 31); }
        if (act) {
            f32x16 p0, p1;
#pragma unroll
            for (int r = 0; r < 16; ++r) { p0[r] = 0.f; p1[r] = 0.f; }
            const LAS unsigned char* Kb = lds + buf * KB;
#pragma unroll
            for (int ks = 0; ks < NKS; ++ks) {
                const bf16x8 a0 = *(const LAS bf16x8*)(Kb + r32 * (2 * D) + (((2 * ks + hi) ^ kswz<D>(r32)) << 4));
                const bf16x8 a1 = *(const LAS bf16x8*)(Kb + (32 + r32) * (2 * D) + (((2 * ks + hi) ^ kswz<D>(32 + r32)) << 4));
                p0 = __builtin_amdgcn_mfma_f32_32x32x16_bf16(a0, qr[ks], p0, 0, 0, 0);
                p1 = __builtin_amdgcn_mfma_f32_32x32x16_bf16(a1, qr[ks], p1, 0, 0, 0);
            }
            if constexpr (MOBA) {
                const int kb = tile_kbase<MOBA>(tt, qb); const float offl = sl2 * (float)(kb - qb * 256 + 4 * hi);
#pragma unroll
                for (int r = 0; r < 16; ++r) { p0[r] += sl2 * (float)((r & 3) + 8 * (r >> 2)) + offl; p1[r] += sl2 * (float)(32 + (r & 3) + 8 * (r >> 2)) + offl; }
                if (tt < 4) {
                    const int k0 = 64 * tt + 4 * hi;
#pragma unroll
                    for (int r = 0; r < 16; ++r) { const int kv = k0 + (r & 3) + 8 * (r >> 2); if (kv > qrel) p0[r] = -INFINITY; if (kv + 32 > qrel) p1[r] = -INFINITY; }
                } else if (!lane_sel) {
#pragma unroll
                    for (int r = 0; r < 16; ++r) { p0[r] = -INFINITY; p1[r] = -INFINITY; }
                }
            }
            float mx = fmaxf(p0[0], p1[0]);
#pragma unroll
            for (int r = 1; r < 16; ++r) mx = fmaxf(mx, fmaxf(p0[r], p1[r]));
            mx = fmaxf(mx, __shfl_xor(mx, 32));
            const float mnew = fmaxf(m, mx);
            if (__builtin_amdgcn_ballot_w64(mnew > m) != 0ull) { const float alpha = __builtin_amdgcn_exp2f(m - mnew); l *= alpha;
#pragma unroll
                for (int dh = 0; dh < NDH; ++dh)
#pragma unroll
                    for (int r = 0; r < 16; ++r) o[dh][r] *= alpha;
                m = mnew; }
            float ps = 0.f;
#pragma unroll
            for (int r = 0; r < 16; ++r) { p0[r] = __builtin_amdgcn_exp2f(p0[r] - m); p1[r] = __builtin_amdgcn_exp2f(p1[r] - m); ps += p0[r] + p1[r]; }
            l += ps;
            const LAS unsigned char* Vb = lds + (2 + buf) * KB;
#pragma unroll
            for (int kh = 0; kh < 2; ++kh)
#pragma unroll
                for (int s = 0; s < 2; ++s) {
                    const bf16x8 pb = pack8(kh ? p1 : p0, s);
#pragma unroll
                    for (int dh = 0; dh < NDH; ++dh) {
                        const int rowA = 32 * kh + 16 * s + 4 * hi + tq, rowB = rowA + 8, chv = 4 * dh + 2 * blk + (tp >> 1);
                        const s16x4 lo = vtr(Vb + rowA * (2 * D) + ((chv ^ vswz<D>(rowA)) << 4) + 8 * (tp & 1));
                        const s16x4 hh = vtr(Vb + rowB * (2 * D) + ((chv ^ vswz<D>(rowB)) << 4) + 8 * (tp & 1));
                        const bf16x8 va = (bf16x8){lo[0], lo[1], lo[2], lo[3], hh[0], hh[1], hh[2], hh[3]};
                        o[dh] = __builtin_amdgcn_mfma_f32_32x32x16_bf16(va, pb, o[dh], 0, 0, 0);
                    }
                }
        }
        if (tt + 1 < NT) ATT_WRITE(buf ^ 1);
        __syncthreads();
    }
    l += __shfl_xor(l, 32);
    const float inv = 1.f / l;
    bf16_t* orow = Og + qrow * ld + h * D;
#pragma unroll
    for (int dh = 0; dh < NDH; ++dh)
#pragma unroll
        for (int g = 0; g < 4; ++g) { uint2 w; w.x = cvt_pk_bf16(o[dh][4 * g] * inv, o[dh][4 * g + 1] * inv); w.y = cvt_pk_bf16(o[dh][4 * g + 2] * inv, o[dh][4 * g + 3] * inv);
            *(uint2*)(orow + 32 * dh + 8 * g + 4 * hi) = w; }
#undef ATT_LOAD
#undef ATT_WRITE
}
}
__device__ __forceinline__ void p2_moba(Frame& F) {
    const bf16_t* MQ = (const bf16_t*)(F.ws + WS_MQ); const bf16_t* MK = (const bf16_t*)(F.ws + WS_MK); const bf16_t* MV = (const bf16_t*)(F.ws + WS_MV); bf16_t* OM = (bf16_t*)(F.ws + WS_OMOBA);
    for (int pr = F.vcu; pr < 256; pr += F.G) { const int bh = pr >> 3, p = pr & 7, b = bh >> 3, h = bh & 7;
#pragma unroll 1
        for (int k = 0; k < 2; ++k) { const int qb = k ? 15 - p : p;
            att::attn_unit<64, true>(F, b, h, qb, MQ, MK + (size_t)b * SEQ * 512, MV + (size_t)b * SEQ * 512, OM, 512, (const float*)(F.ctl + CW_KMEAN), nullptr, nullptr, nullptr); } }
}
__device__ __forceinline__ void p2_mem(Frame& F, const float* g_mem_q, const float* g_mem_k) {
    const bf16_t* CQ = (const bf16_t*)(F.ws + WS_CQ); const bf16_t* MEMK = (const bf16_t*)(F.ws + WS_MEMK); const bf16_t* MEMV = (const bf16_t*)(F.ws + WS_MEMV); bf16_t* OM = (bf16_t*)(F.ws + WS_OMEM);
#pragma unroll 1
    for (int u = F.vcu; u < 256; u += F.G) { const int bh = u >> 4, qb = u & 15, b = bh >> 2, h = bh & 3;
        att::attn_unit<128, false>(F, b, h, qb, CQ, MEMK + (size_t)b * MEMLEN * 512, MEMV + (size_t)b * MEMLEN * 512, OM, 512, nullptr, (const float*)(F.ctl + CW_MEMKSS) + (size_t)b * MEMLEN * 4, g_mem_q, g_mem_k); }
}
namespace ret {
using att::f32x16; using att::s16x4; using att::vtr; using att::pack8; using att::kswz; using att::vswz; using att::crow; using pg8::bf16x8;
constexpr int L_KT = 0, L_KD = 16384, L_VT = 32768, L_SB = 65536, L_SS = 98304, L_G = 99328;
__device__ __forceinline__ void retention_item(Frame& F, const int b, const int h, const float* g_ret_out) {
    const bf16_t* RQ = (const bf16_t*)(F.ws + WS_RQ); const bf16_t* RK = (const bf16_t*)(F.ws + WS_RK); const bf16_t* RV = (const bf16_t*)(F.ws + WS_RV); const bf16_t* RG = (const bf16_t*)(F.ws + WS_RG); bf16_t* ORET = (bf16_t*)(F.ws + WS_ORET);
    int tid = F.tid, lane = F.lane; asm volatile("" : "+v"(tid), "+v"(lane));
    const int wave = F.wave;
    LAS unsigned char* lds = F.lds;
    const float lg2_o = log2f(1.f - exp2f(-5.f - (float)h)), g128 = exp2f(128.f * lg2_o);
    const size_t tok0 = (size_t)b * SEQ;
    v4u kreg[2], vreg[4];
#define RET_LOAD(n) do { _Pragma("unroll") for (int i_ = 0; i_ < 2; ++i_) { const int ci_ = tid + 512 * i_; kreg[i_] = *(const v4u*)(RK + (tok0 + (n) * 128 + (ci_ >> 3)) * 256 + h * 64 + 8 * (ci_ & 7)); } \
        _Pragma("unroll") for (int i_ = 0; i_ < 4; ++i_) { const int ci_ = tid + 512 * i_; vreg[i_] = *(const v4u*)(RV + (tok0 + (n) * 128 + (ci_ >> 4)) * 512 + h * 128 + 8 * (ci_ & 15)); } } while (0)
#define RET_WRITE() do { _Pragma("unroll") for (int i_ = 0; i_ < 2; ++i_) { const int ci_ = tid + 512 * i_, row_ = ci_ >> 3, ch_ = ci_ & 7; const v4u k_ = kreg[i_]; \
            *(LAS v4u*)(lds + L_KT + row_ * 128 + ((ch_ ^ kswz<64>(row_)) << 4)) = k_; const float dk_ = __builtin_amdgcn_exp2f(lg2 * (float)(127 - row_)); v4u d_; \
            d_.x = cvt_pk_bf16(att::bfl(k_.x) * dk_, att::bfh(k_.x) * dk_); d_.y = cvt_pk_bf16(att::bfl(k_.y) * dk_, att::bfh(k_.y) * dk_); d_.z = cvt_pk_bf16(att::bfl(k_.z) * dk_, att::bfh(k_.z) * dk_); d_.w = cvt_pk_bf16(att::bfl(k_.w) * dk_, att::bfh(k_.w) * dk_); \
            *(LAS v4u*)(lds + L_KD + row_ * 128 + ((ch_ ^ vswz<64>(row_)) << 4)) = d_; } \
        _Pragma("unroll") for (int i_ = 0; i_ < 4; ++i_) { const int ci_ = tid + 512 * i_, row_ = ci_ >> 4, ch_ = ci_ & 15; *(LAS v4u*)(lds + L_VT + row_ * 256 + ((ch_ ^ vswz<128>(row_)) << 4)) = vreg[i_]; } } while (0)
    { const float lg2 = lg2_o; RET_LOAD(0); RET_WRITE(); }
    { const v4u z = {0u, 0u, 0u, 0u}; *(LAS v4u*)(lds + L_SB + tid * 32) = z; *(LAS v4u*)(lds + L_SB + tid * 32 + 16) = z; }
    f32x16 st;
#pragma unroll
    for (int r = 0; r < 16; ++r) st[r] = 0.f;
    const int ib = wave & 3, e2 = wave >> 2;
    LAS float* ssb = (LAS float*)(lds + L_SS);
    if (tid < 128) ((LAS float*)(lds + L_G))[tid] = g_ret_out[tid];
    bf16x8 qn[4];
    { const size_t tr0 = tok0 + 32 * ib + (lane & 31);
#pragma unroll
      for (int ks = 0; ks < 4; ++ks) qn[ks] = *(const bf16x8*)(RQ + tr0 * 256 + h * 64 + 16 * ks + 8 * (lane >> 5)); }
    __syncthreads();
    for (int n = 0; n < 32; ++n) {
        int lane_n = lane; float lg2 = lg2_o; asm volatile("" : "+v"(lane_n), "+v"(lg2));
        const int r32 = lane_n & 31, hi = lane_n >> 5, i16 = lane_n & 15, blk = (lane_n >> 4) & 1, tq = i16 >> 2, tp = i16 & 3;
        if (n + 1 < 32) RET_LOAD(n + 1);
        const LAS unsigned char* Sb = lds + L_SB + (n & 1) * 16384; LAS unsigned char* Sn = lds + L_SB + ((n + 1) & 1) * 16384;
        const size_t tokrow = tok0 + n * 128 + 32 * ib + r32;
        f32x16 o[2];
        uint2 rgv[8];
#pragma unroll
        for (int q2 = 0; q2 < 2; ++q2)
#pragma unroll
            for (int g = 0; g < 4; ++g) rgv[q2 * 4 + g] = *(const uint2*)(RG + tokrow * 512 + h * 128 + 64 * e2 + 32 * q2 + 8 * g + 4 * hi);
        {
            bf16x8 qr[4];
#pragma unroll
            for (int ks = 0; ks < 4; ++ks) qr[ks] = qn[ks];
            if (n + 1 < 32) {
#pragma unroll
                for (int ks = 0; ks < 4; ++ks) qn[ks] = *(const bf16x8*)(RQ + (tokrow + 128) * 256 + h * 64 + 16 * ks + 8 * hi); }
#pragma unroll
            for (int q2 = 0; q2 < 2; ++q2) {
#pragma unroll
                for (int r = 0; r < 16; ++r) o[q2][r] = 0.f;
                const int e = 64 * e2 + 32 * q2 + r32;
#pragma unroll
                for (int ks = 0; ks < 4; ++ks) { const bf16x8 a = *(const LAS bf16x8*)(Sb + e * 128 + (((2 * ks + hi) ^ kswz<64>(e)) << 4)); o[q2] = __builtin_amdgcn_mfma_f32_32x32x16_bf16(a, qr[ks], o[q2], 0, 0, 0); } }
            const float gq = __builtin_amdgcn_exp2f(lg2 * (float)(32 * ib + r32 + 1));
#pragma unroll
            for (int q2 = 0; q2 < 2; ++q2)
#pragma unroll
                for (int r = 0; r < 16; ++r) o[q2][r] *= gq;
            __builtin_amdgcn_sched_barrier(0);
#pragma unroll 1
            for (int jb = 0; jb <= ib; ++jb) {
                f32x16 p;
#pragma unroll
                for (int r = 0; r < 16; ++r) p[r] = 0.f;
                const int krow_ = 32 * jb + r32;
#pragma unroll
                for (int ks = 0; ks < 4; ++ks) { const bf16x8 a = *(const LAS bf16x8*)(lds + L_KT + krow_ * 128 + (((2 * ks + hi) ^ kswz<64>(krow_)) << 4)); p = __builtin_amdgcn_mfma_f32_32x32x16_bf16(a, qr[ks], p, 0, 0, 0); }
                const float cl = __builtin_amdgcn_exp2f(lg2 * (float)(32 * (ib - jb) + r32 - 4 * hi));
                const bool diag = (jb == ib);
#pragma unroll
                for (int r = 0; r < 16; ++r) { float v = p[r] * (cl * __builtin_amdgcn_exp2f(-lg2 * (float)((r & 3) + 8 * (r >> 2)))); if (diag && ((r & 3) + 8 * (r >> 2) + 4 * hi) > r32) v = 0.f; p[r] = v; }
#pragma unroll
                for (int s = 0; s < 2; ++s) { const bf16x8 pb = pack8(p, s);
                    const int rowA = 32 * jb + 16 * s + 4 * hi + tq, rowB = rowA + 8;
#pragma unroll
                    for (int q2 = 0; q2 < 2; ++q2) { const int chv = 4 * (2 * e2 + q2) + 2 * blk + (tp >> 1);
                        const s16x4 lo = vtr(lds + L_VT + rowA * 256 + ((chv ^ vswz<128>(rowA)) << 4) + 8 * (tp & 1));
                        const s16x4 hh = vtr(lds + L_VT + rowB * 256 + ((chv ^ vswz<128>(rowB)) << 4) + 8 * (tp & 1));
                        const bf16x8 va = (bf16x8){lo[0], lo[1], lo[2], lo[3], hh[0], hh[1], hh[2], hh[3]};
                        o[q2] = __builtin_amdgcn_mfma_f32_32x32x16_bf16(va, pb, o[q2], 0, 0, 0); }
                    __builtin_amdgcn_sched_barrier(0); }
            }
        }
        __builtin_amdgcn_sched_barrier(0);
        { float ss = 0.f;
#pragma unroll
            for (int q2 = 0; q2 < 2; ++q2)
#pragma unroll
                for (int r = 0; r < 16; ++r) ss += o[q2][r] * o[q2][r];
            ss += __shfl_xor(ss, 32);
            if (hi == 0) ssb[e2 * 128 + 32 * ib + r32] = ss; }
        __builtin_amdgcn_sched_barrier(0);
        { const int eh = wave & 3, dh = wave >> 2;
#pragma unroll
            for (int r = 0; r < 16; ++r) st[r] *= g128;
#pragma unroll 1
            for (int kst = 0; kst < 8; ++kst) { const int rowA = 16 * kst + 4 * hi + tq, rowB = rowA + 8, chv = 4 * eh + 2 * blk + (tp >> 1), chk = 4 * dh + 2 * blk + (tp >> 1);
                const s16x4 lo = vtr(lds + L_VT + rowA * 256 + ((chv ^ vswz<128>(rowA)) << 4) + 8 * (tp & 1));
                const s16x4 hh = vtr(lds + L_VT + rowB * 256 + ((chv ^ vswz<128>(rowB)) << 4) + 8 * (tp & 1));
                const s16x4 kl = vtr(lds + L_KD + rowA * 128 + ((chk ^ vswz<64>(rowA)) << 4) + 8 * (tp & 1));
                const s16x4 kh = vtr(lds + L_KD + rowB * 128 + ((chk ^ vswz<64>(rowB)) << 4) + 8 * (tp & 1));
                const bf16x8 va = (bf16x8){lo[0], lo[1], lo[2], lo[3], hh[0], hh[1], hh[2], hh[3]};
                const bf16x8 kb = (bf16x8){kl[0], kl[1], kl[2], kl[3], kh[0], kh[1], kh[2], kh[3]};
                st = __builtin_amdgcn_mfma_f32_32x32x16_bf16(va, kb, st, 0, 0, 0); }
#pragma unroll
            for (int r = 0; r < 16; ++r) { const int e = 32 * eh + (r & 3) + 8 * (r >> 2) + 4 * hi, dd = 32 * dh + r32;
                *(LAS bf16_t*)(Sn + e * 128 + ((((dd >> 3) ^ kswz<64>(e))) << 4) + (dd & 7) * 2) = f2bf(st[r]); } }
        __builtin_amdgcn_sched_barrier(0);
        __syncthreads();
        { const float rn = 1.f / sqrtf((ssb[32 * ib + r32] + ssb[128 + 32 * ib + r32]) * (1.f / 128.f) + 1e-5f);
#pragma unroll
            for (int q2 = 0; q2 < 2; ++q2)
#pragma unroll
                for (int g = 0; g < 4; ++g) { const int e = 64 * e2 + 32 * q2 + 8 * g + 4 * hi; const f32x4 gg = *(const LAS f32x4*)(lds + L_G + 4 * e); const uint2 rg = rgv[q2 * 4 + g];
                    uint2 w; w.x = cvt_pk_bf16(o[q2][4 * g] * rn * gg[0] * att::bfl(rg.x), o[q2][4 * g + 1] * rn * gg[1] * att::bfh(rg.x)); w.y = cvt_pk_bf16(o[q2][4 * g + 2] * rn * gg[2] * att::bfl(rg.y), o[q2][4 * g + 3] * rn * gg[3] * att::bfh(rg.y));
                    *(uint2*)(ORET + tokrow * 512 + h * 128 + e) = w; } }
        if (n + 1 < 32) RET_WRITE();
        __syncthreads();
    }
#undef RET_LOAD
#undef RET_WRITE
}
}
constexpr int CW_QUEUE = 128;
__device__ __forceinline__ void p2_mixers(Frame& F, const float* g_ret_out, const float* g_mem_q, const float* g_mem_k, const float* w1, const float* w2, const int qword, const int qlo, const int qhi) {
    volatile LAS int* slot = (volatile LAS int*)(F.lds + TB_OFF + 512);
    const bf16_t* MQ = (const bf16_t*)(F.ws + WS_MQ); const bf16_t* MK = (const bf16_t*)(F.ws + WS_MK); const bf16_t* MV = (const bf16_t*)(F.ws + WS_MV); bf16_t* OMO = (bf16_t*)(F.ws + WS_OMOBA);
    const bf16_t* CQ = (const bf16_t*)(F.ws + WS_CQ); const bf16_t* MEMK = (const bf16_t*)(F.ws + WS_MEMK); const bf16_t* MEMV = (const bf16_t*)(F.ws + WS_MEMV); bf16_t* OME = (bf16_t*)(F.ws + WS_OMEM);
    for (;;) {
        __syncthreads();
        if (F.tid == 0) slot[0] = (int)__hip_atomic_fetch_add((unsigned*)F.ctl + qword, 1u, __ATOMIC_RELAXED, __HIP_MEMORY_SCOPE_AGENT);
        __syncthreads();
        const int it = slot[0] + qlo;
        if (it >= qhi) break;
        if (it < 16) { ret::retention_item(F, it >> 2, it & 3, g_ret_out); continue; }
        const int j = it - 16, grp = j / 7, pos = j % 7;
        if (pos & 1) { const int a = 3 * grp + (pos >> 1);
            if (a < 512) { const int qb = 15 - (a >> 5), bh = a & 31, b = bh >> 3, h = bh & 7;
                att::attn_unit<64, true>(F, b, h, qb, MQ, MK + (size_t)b * SEQ * 512, MV + (size_t)b * SEQ * 512, OMO, 512, (const float*)(F.ctl + CW_KMEAN), nullptr, nullptr, nullptr); }
            else { const int u = a - 512, bh = u >> 4, qb = u & 15, b = bh >> 2, h = bh & 3;
                att::attn_unit<128, false>(F, b, h, qb, CQ, MEMK + (size_t)b * MEMLEN * 512, MEMV + (size_t)b * MEMLEN * 512, OME, 512, nullptr, (const float*)(F.ctl + CW_MEMKSS) + (size_t)b * MEMLEN * 4, g_mem_q, g_mem_k); }
        } else { const int c = 4 * grp + (pos >> 1);
            LAS float* scr = (LAS float*)(F.lds + RING_OFF + F.wave * 16384);
            if (c < 512) { const int e = c >> 4, kb = c & 15;
#pragma unroll 1
                for (int nb = F.wave; nb < 64; nb += 8) p0_transpose_item<false>(w1 + (size_t)e * 1024 * 2048, 1024, 2048, (bf16*)(F.ws + WS_W1) + (size_t)e * 2048 * 1024, 0, scr, kb * 64 + nb, F.lane); }
            else { const int e = (c - 512) >> 4, kb = (c - 512) & 15;
#pragma unroll 1
                for (int nb = F.wave; nb < 32; nb += 8) p0_transpose_item<false>(w2 + (size_t)e * 1024 * 1024, 1024, 1024, (bf16*)(F.ws + WS_W2) + (size_t)e * 1024 * 1024, 0, scr, kb * 32 + nb, F.lane); }
        }
    }
}
#define WAVE_LDS_FENCE() do { asm volatile("s_waitcnt lgkmcnt(0)" ::: "memory"); } while (0)
__device__ __forceinline__ void p2_moba_slow(Frame& F) {
    const bf16_t* MQ = (const bf16_t*)(F.ws + WS_MQ); const bf16_t* MK = (const bf16_t*)(F.ws + WS_MK); const bf16_t* MV = (const bf16_t*)(F.ws + WS_MV); const float* KMEAN = (const float*)(F.ctl + CW_KMEAN); bf16_t* OMOBA = (bf16_t*)(F.ws + WS_OMOBA);
    LAS float* sc = (LAS float*)(F.lds) + F.wave * 1152; LAS float* qsh = sc + 1024;
    const int gw = F.vcu * NWAVES + F.wave, NGW = F.G * NWAVES, lane = F.lane;
    for (int w = gw; w < NB * 8 * SEQ; w += NGW) {
        const int t = w & 4095, h = (w >> 12) & 7, b = w >> 15; const int qb = t >> 8; const size_t row = (size_t)b * 4096 + t;
        qsh[lane] = bf2f(MQ[row * 512 + h * 64 + lane]);
        WAVE_LDS_FENCE();
        float q[64];
#pragma unroll
        for (int d = 0; d < 64; ++d) q[d] = qsh[d];
        float gsc = -INFINITY; if (lane < qb) { const float* km = KMEAN + (((size_t)b * 16 + lane) * 8 + h) * 64; float s = 0.f;
#pragma unroll
            for (int d = 0; d < 64; ++d) s += q[d] * km[d];
            gsc = s; }
        int sel[4]; sel[0] = qb;
#pragma unroll
        for (int r = 0; r < 3; ++r) { const float m = wave_max64(gsc); int j = -1; if (m != -INFINITY) { const unsigned long long bal = __ballot(gsc == m); j = __ffsll((long long)bal) - 1; } sel[r + 1] = j; if (lane == j) gsc = -INFINITY; }
        const float slope = exp2f(-(float)(h + 1)); float mx = -INFINITY;
#pragma unroll
        for (int s = 0; s < 4; ++s) { const int blk = sel[s];
            for (int c = 0; c < 4; ++c) { const int kp = blk * 256 + c * 64 + lane; float v = -INFINITY;
                if (blk >= 0 && kp <= t) { const bf16_t* kr = MK + ((size_t)b * 4096 + kp) * 512 + h * 64; float d_ = 0.f;
#pragma unroll
                    for (int d = 0; d < 64; ++d) d_ += q[d] * bf2f(kr[d]);
                    v = d_ * 0.125f - slope * (float)(t - kp); }
                sc[s * 256 + c * 64 + lane] = v; mx = fmaxf(mx, v); } }
        mx = wave_max64(mx); float sum = 0.f;
        for (int i = lane; i < 1024; i += 64) { const float p = __expf(sc[i] - mx); sc[i] = p; sum += p; }
        sum = wave_sum64(sum);
        WAVE_LDS_FENCE();
        float o = 0.f;
#pragma unroll
        for (int s = 0; s < 4; ++s) { const int blk = sel[s]; if (blk >= 0) for (int k = 0; k < 256; ++k) { const float p = sc[s * 256 + k]; if (p != 0.f) o += p * bf2f(MV[((size_t)b * 4096 + blk * 256 + k) * 512 + h * 64 + lane]); } }
        OMOBA[row * 512 + h * 64 + lane] = f2bf(o / sum);
        WAVE_LDS_FENCE();
    }
}
__device__ __forceinline__ void p2_mem_slow(Frame& F, const float* g_mem_q, const float* g_mem_k) {
    const bf16_t* CQ = (const bf16_t*)(F.ws + WS_CQ); const bf16_t* MEMK = (const bf16_t*)(F.ws + WS_MEMK); const bf16_t* MEMV = (const bf16_t*)(F.ws + WS_MEMV); const float* MEMKSS = (const float*)(F.ctl + CW_MEMKSS); bf16_t* OMEM = (bf16_t*)(F.ws + WS_OMEM);
    LAS float* sc = (LAS float*)(F.lds) + F.wave * 1152; LAS float* qsh = sc + 1024;
    const int gw = F.vcu * NWAVES + F.wave, NGW = F.G * NWAVES, lane = F.lane;
    for (int w = gw; w < NB * 4 * SEQ; w += NGW) {
        const int t = w & 4095, h = (w >> 12) & 3, b = w >> 14; const size_t row = (size_t)b * 4096 + t;
        const float q0 = bf2f(CQ[row * 512 + h * 128 + lane]), q1 = bf2f(CQ[row * 512 + h * 128 + 64 + lane]);
        const float rq = 1.f / sqrtf(wave_sum64(q0 * q0 + q1 * q1) * (1.f / 128.f) + 1e-5f);
        qsh[lane] = q0 * rq * g_mem_q[lane] * g_mem_k[lane]; qsh[lane + 64] = q1 * rq * g_mem_q[lane + 64] * g_mem_k[lane + 64];
        WAVE_LDS_FENCE();
        float mx = -INFINITY;
        for (int c = 0; c < 4; ++c) { const int m = c * 64 + lane; const bf16_t* kr = MEMK + ((size_t)b * 256 + m) * 512 + h * 128; float d_ = 0.f; for (int d = 0; d < 128; ++d) d_ += qsh[d] * bf2f(kr[d]);
            const float rk = 1.f / sqrtf(MEMKSS[((size_t)b * 256 + m) * 4 + h] * (1.f / 128.f) + 1e-5f); const float v = d_ * rk * 0.08838834764831845f; sc[m] = v; mx = fmaxf(mx, v); }
        mx = wave_max64(mx); float sum = 0.f;
        for (int i = lane; i < 256; i += 64) { const float p = __expf(sc[i] - mx); sc[i] = p; sum += p; }
        sum = wave_sum64(sum); WAVE_LDS_FENCE();
        float o0 = 0.f, o1 = 0.f;
        for (int k = 0; k < 256; ++k) { const float p = sc[k]; const bf16_t* vr = MEMV + ((size_t)b * 256 + k) * 512 + h * 128; o0 += p * bf2f(vr[lane]); o1 += p * bf2f(vr[lane + 64]); }
        OMEM[row * 512 + h * 128 + lane] = f2bf(o0 / sum); OMEM[row * 512 + h * 128 + 64 + lane] = f2bf(o1 / sum);
        WAVE_LDS_FENCE();
    }
}
__device__ __forceinline__ void p2_ret_slow(Frame& F, const float* g_ret_out) {
    const bf16_t* RQ = (const bf16_t*)(F.ws + WS_RQ); const bf16_t* RK = (const bf16_t*)(F.ws + WS_RK); const bf16_t* RV = (const bf16_t*)(F.ws + WS_RV); const bf16_t* RG = (const bf16_t*)(F.ws + WS_RG); bf16_t* ORET = (bf16_t*)(F.ws + WS_ORET);
    LAS float* qs = (LAS float*)(F.lds) + 16384; LAS float* ks = qs + 64; LAS float* part = ks + 64; LAS float* red = part + 256;
    const int tid = F.tid, e = tid & 127, hf = (tid >> 7) & 1;
    for (int it = F.vcu; it < 16; it += F.G) {
        const int b = it >> 2, h = it & 3; const float gamma = 1.f - exp2f(-5.f - (float)h);
        float s[32];
#pragma unroll
        for (int i = 0; i < 32; ++i) s[i] = 0.f;
        for (int t = 0; t < 4096; ++t) { const size_t row = (size_t)b * 4096 + t;
            if (tid < 64) qs[tid] = bf2f(RQ[row * 256 + h * 64 + tid]); else if (tid < 128) ks[tid - 64] = bf2f(RK[row * 256 + h * 64 + tid - 64]);
            const float v = bf2f(RV[row * 512 + h * 128 + e]);
            __syncthreads();
            float o = 0.f;
            if (tid < 256) {
#pragma unroll
                for (int i = 0; i < 32; ++i) { s[i] = gamma * s[i] + ks[hf * 32 + i] * v; o += qs[hf * 32 + i] * s[i]; }
                part[tid] = o; }
            __syncthreads();
            float ov = 0.f;
            if (tid < 128) { ov = part[tid] + part[tid + 128]; const float ss = wave_sum64(ov * ov); if ((tid & 63) == 0) red[tid >> 6] = ss; }
            __syncthreads();
            if (tid < 128) { const float r = 1.f / sqrtf((red[0] + red[1]) * (1.f / 128.f) + 1e-5f); ORET[row * 512 + h * 128 + tid] = f2bf(ov * r * g_ret_out[tid] * bf2f(RG[row * 512 + h * 128 + tid])); }
        }
    }
}
constexpr int N_PHASES = 9;
#ifndef PROBE_MASK
#define PROBE_MASK 0
#endif
constexpr int P2_NITEMS = 16 + 7 * 256;
#ifndef P2_LO
#define P2_LO 0
#define P2_HI P2_NITEMS
#endif
#define NREP(k) ((((PROBE_MASK) >> (k)) & 1) ? 2 : 1)
__global__ void __launch_bounds__(NWAVES * 64, 2) mega(Args args) {
    extern __shared__ __attribute__((aligned(16))) unsigned char lds[];
    Frame F;
    F.lds = (LAS unsigned char*)lds; F.MISC = (volatile LAS unsigned*)(F.lds + MISC_OFF);
    F.tid = threadIdx.x; F.lane = F.tid & 63; F.wave = __builtin_amdgcn_readfirstlane(F.tid >> 6);
    F.G = gridDim.x; { const int bx = blockIdx.x; F.vcu = (F.G % 8 == 0) ? (bx % 8) * (F.G / 8) + bx / 8 : bx; }
    F.ws = args.ws; F.out = args.out; F.ctl = (gu32*)(args.ws + WS_CTL);
    for (int u = F.tid; u < (LDS_BYTES - LDSCTL_OFF) / 4; u += NWAVES * 64) ((LAS unsigned*)(F.lds + LDSCTL_OFF))[u] = 0u;
    __syncthreads();
    XcdBarrier bar = xcd_barrier_post((unsigned*)(F.ctl + CW_BAR) + args.li * XCD_BAR_WORDS, F.MISC + 8);
    const int lo = args.ph_lo, hi = args.ph_hi;
#define IN(k) (lo <= (k) && (k) < hi)
#define BOTH(k) (IN(k) && IN((k) + 1))
    if (IN(0)) { for (int rep = 0; rep < NREP(0); ++rep) p0_prologue(F, args); if (BOTH(0)) xcd_barrier(bar); }
    if (IN(1)) {
        pg8::Gemm g{(const pg8::bf16_t*)(F.ws + WS_HB), (const pg8::bf16_t*)(F.ws + WS_WIN), NTOK + 1024, DIN + 1024, 1024};
        P1Order S; S.init(F.G, (int)blockIdx.x);
        EpiP1 E{F.ws, args.in[4], (const float*)(F.ws + WS_GTAB), (float*)(F.ctl + CW_KMEAN), (float*)(F.ctl + CW_MEMKSS), 1};
        pg8::gemm_phase<EpiP1, P1Order, true, true>(F.lds + RING_OFF, g, S, E);
        if (NREP(1) > 1) { E.atom_on = 0; pg8::gemm_phase<EpiP1, P1Order, true, true>(F.lds + RING_OFF, g, S, E); }
        if (BOTH(1)) xcd_barrier(bar);
    }
    if (IN(2)) {
        p2_mixers(F, args.in[5], args.in[10], args.in[11], args.in[19], args.in[21], CW_QUEUE, 0, P2_NITEMS);
        if (NREP(2) > 1) p2_mixers(F, args.in[5], args.in[10], args.in[11], args.in[19], args.in[21], CW_QUEUE + 64, P2_LO, P2_HI);
        if (BOTH(2)) xcd_barrier(bar);
    }
    if (IN(3)) {
        P3Order S; S.init(F.G, (int)blockIdx.x, F.ws); EpiP3 E{(const bf16_t*)(F.ws + WS_GT), (bf16_t*)(F.ws + WS_Y)};
        pg9::gemm_phase<EpiP3, P3Order, false>(F.lds + RING_OFF, 512, 512, 512, S, E);
        if (NREP(3) > 1) pg9::gemm_phase<EpiP3, P3Order, false>(F.lds + RING_OFF, 512, 512, 512, S, E);
        if (BOTH(3)) xcd_barrier(bar);
    }
    if (IN(4)) {
        P4Order S; S.init(F.G, (int)blockIdx.x, F.ws); EpiP4 E{args.in[0], F.out};
        pg9::gemm_phase<EpiP4, P4Order, false>(F.lds + RING_OFF, 1024, 1024, 1024, S, E);
        if (NREP(4) > 1) pg9::gemm_phase<EpiP4, P4Order, false>(F.lds + RING_OFF, 1024, 1024, 1024, S, E);
        if (BOTH(4)) xcd_barrier(bar);
    }
    if (IN(5)) { p5_router(F, F.out, args.in[16], args.in[17], args.in[18], (int*)F.ctl + CW_COUNTS, (int*)(F.ws + WS_LISTS));
        if (NREP(5) > 1) p5_router(F, F.out, args.in[16], args.in[17], args.in[18], (int*)F.ctl + CW_COUNTS + 256, (int*)(F.ws + WS_RETST));
        if (BOTH(5)) xcd_barrier(bar); }
    if (IN(6)) {
        moe_tables(F);
        MoeOrder<3, WS_W1, 2048, 2, WS_XT> S; S.init(F.G, (int)blockIdx.x, F.ws, (const LAS int*)(F.lds + TB_OFF));
        EpiMoe1 E{(const int*)(F.ws + WS_LISTS), args.in[20], (bf16_t*)(F.ws + WS_ACT)};
        pg9::gemm_phase<EpiMoe1, MoeOrder<3, WS_W1, 2048, 2, WS_XT>, true>(F.lds + RING_OFF, 1024, 1024, 1024, S, E);
        if (NREP(6) > 1) pg9::gemm_phase<EpiMoe1, MoeOrder<3, WS_W1, 2048, 2, WS_XT>, true>(F.lds + RING_OFF, 1024, 1024, 1024, S, E);
        if (BOTH(6)) xcd_barrier(bar);
    }
    if (IN(7)) {
        moe_tables(F);
        MoeOrder<2, WS_W2, 1024, 0, WS_ACT> S; S.init(F.G, (int)blockIdx.x, F.ws, (const LAS int*)(F.lds + TB_OFF));
        EpiMoe2 E{(const int*)(F.ws + WS_LISTS), args.in[22], (bf16_t*)(F.ws + WS_YS)};
        pg9::gemm_phase<EpiMoe2, MoeOrder<2, WS_W2, 1024, 0, WS_ACT>, true>(F.lds + RING_OFF, 1024, 1024, 1024, S, E);
        if (NREP(7) > 1) pg9::gemm_phase<EpiMoe2, MoeOrder<2, WS_W2, 1024, 0, WS_ACT>, true>(F.lds + RING_OFF, 1024, 1024, 1024, S, E);
        if (BOTH(7)) xcd_barrier(bar);
    }
    if (IN(8)) { p8_combine(F, F.out, F.out); if (NREP(8) > 1) p8_combine(F, F.out, (float*)(F.ws + WS_HB)); }
    if (NREP(9) > 1) { for (int i = 0; i < 16; ++i) xcd_barrier(bar); }
#undef IN
#undef BOTH
}
#ifndef MK_ONE_LAUNCH
#define MK_ONE_LAUNCH 1
#endif
extern "C" void kernel_launch(void* const* d_in, const int* in_sizes, int n_in, void* d_out, int out_size, void* d_ws, size_t ws_size, hipStream_t stream) {
    if (ws_size < WS_END) { fprintf(stderr, "kernel_launch: ws too small %zu < %zu\n", ws_size, (size_t)WS_END); return; }
    unsigned char* ws = (unsigned char*)d_ws; float* out = (float*)d_out;
    static int grid = 0;
    if (grid == 0) {
        int dev = 0, cus = 0; if (hipGetDevice(&dev) != hipSuccess || hipDeviceGetAttribute(&cus, hipDeviceAttributeMultiprocessorCount, dev) != hipSuccess) { fprintf(stderr, "kernel_launch: device query failed\n"); grid = -1; return; }
        if (hipFuncSetAttribute((const void*)mega, hipFuncAttributeMaxDynamicSharedMemorySize, LDS_BYTES) != hipSuccess) { fprintf(stderr, "kernel_launch: hipFuncSetAttribute failed\n"); grid = -1; return; }
        (void)hipGetLastError(); grid = cus;
    }
    if (grid < 0) return;
    (void)hipMemsetAsync(ws + WS_CTL, 0, 1 * MiB, stream);
    Args a; memset(&a, 0, sizeof a); for (int i = 0; i < 23; ++i) a.in[i] = (const float*)d_in[i]; a.out = out; a.ws = ws; a.li = 0;
#if MK_ONE_LAUNCH
    a.ph_lo = 0; a.ph_hi = N_PHASES;
    hipLaunchKernelGGL(mega, dim3(grid), dim3(NWAVES * 64), LDS_BYTES, stream, a);
#else
    for (int p = 0; p < N_PHASES; ++p) { a.ph_lo = p; a.ph_hi = p + 1; hipLaunchKernelGGL(mega, dim3(grid), dim3(NWAVES * 64), LDS_BYTES, stream, a); }
#endif
}
```

```cpp
#define PROBE_MASK 0
#include <hip/hip_runtime.h>
#include <cstdio>
#include <cstdint>
#include <cstring>
typedef unsigned short bf16_t;
__host__ __device__ inline float bf2f(bf16_t v) { unsigned u = ((unsigned)v) << 16; float f; __builtin_memcpy(&f, &u, 4); return f; }
__host__ __device__ inline bf16_t f2bf(float f) { unsigned u; __builtin_memcpy(&u, &f, 4); u += 0x7fffu + ((u >> 16) & 1u); return (bf16_t)(u >> 16); }
constexpr int NTOK = 16384, SEQ = 4096, NB = 4, DM = 1024, DIN = 6656, MEMLEN = 256, NEXP = 32;
constexpr size_t MiB = (size_t)1 << 20;
constexpr size_t WS_CTL = 0;
constexpr size_t WS_WIN = 1 * MiB;
constexpr size_t WS_WMEMKV = 14 * MiB;
constexpr size_t WS_WBR = 16 * MiB;
constexpr size_t WS_WOUT = 19 * MiB;
constexpr size_t WS_W1 = 21 * MiB;
constexpr size_t WS_W2 = 149 * MiB;
constexpr size_t WS_HB = 213 * MiB;
constexpr size_t WS_HM = 245 * MiB;
constexpr size_t WS_RQ = 247 * MiB, WS_RK = 255 * MiB, WS_RV = 263 * MiB, WS_RG = 279 * MiB, WS_MQ = 295 * MiB, WS_MK = 311 * MiB, WS_MV = 327 * MiB, WS_CQ = 343 * MiB, WS_GT = 359 * MiB;
constexpr size_t WS_MEMK = 455 * MiB, WS_MEMV = 456 * MiB, WS_KMEAN = 457 * MiB, WS_MEMKSS = 457 * MiB + 512 * 1024;
constexpr size_t WS_GTAB = 457 * MiB + 768 * 1024;
constexpr size_t WS_ORET = 458 * MiB, WS_OMOBA = 474 * MiB, WS_OMEM = 490 * MiB;
constexpr size_t WS_Y = 506 * MiB, WS_XT = 538 * MiB;
constexpr size_t WS_TOPE = 570 * MiB, WS_TOPW = 570 * MiB + 256 * 1024, WS_LISTS = 571 * MiB;
constexpr size_t WS_ACT = 574 * MiB;
constexpr size_t WS_YS = 703 * MiB;
constexpr size_t WS_RETST = 959 * MiB;
constexpr size_t WS_END = 832 * MiB;
constexpr size_t WS_PROJ = 574 * MiB;
constexpr size_t WS_PM = 990 * MiB;
constexpr size_t WS_ORAW = 574 * MiB;
constexpr size_t WS_T0 = 703 * MiB, WS_T1 = 767 * MiB, WS_T2 = 831 * MiB;
constexpr int CW_COUNTS = 64;
namespace pg8 {
#define PG8_LAS __attribute__((address_space(3)))
typedef unsigned short bf16_t;
typedef short bf16x8 __attribute__((ext_vector_type(8)));
typedef float f32x4 __attribute__((ext_vector_type(4)));
typedef unsigned u32x4 __attribute__((ext_vector_type(4)));
constexpr int BM = 256, BK = 64, HALF = 128, HTB = HALF * BK * 2  , STAGE_BYTES = 8 * HTB, NXCD = 8, WGM = 8;

__host__ __device__ __forceinline__ int lds_byte(int r, int c) { const int st = (r >> 4) * 2 + (c >> 5), rr = r & 15, cc = c & 31, ob = rr * 64 + cc * 2; return st * 1024 + (ob ^ (((ob >> 9) & 1) << 5)); }
__host__ __device__ __forceinline__ void stage_rc(int b, int& R, int& C) { const int st = b / 1024, sb = b % 1024, swz = sb ^ (((sb >> 9) & 1) << 5); R = (st >> 1) * 16 + swz / 64; C = (st & 1) * 32 + (swz % 64) / 2; }
__host__ __device__ __forceinline__ int perm32(int rho) { const int n = rho >> 4, i = rho & 15; return 8 * (i >> 2) + 4 * n + (i & 3); }

struct Unit { int pm, pn; };
struct Gemm { const bf16_t* A; const bf16_t* Bt; int M, N, K; };
struct StaticOrder {
    int nM, nN, nwg, G, c;
    __host__ __device__ void init(int M, int N, int G_, int c_) { nM = M / BM; nN = N / BM; nwg = nM * nN; G = G_; c = c_; }
    __host__ __device__ bool next(int i, Unit& u) const {
        const long L = (long)i * G + c; if (L >= nwg) return false;
        int wgid = (int)L; { const int q = nwg / NXCD, r = nwg % NXCD, xcd = wgid % NXCD, off = wgid / NXCD; wgid = (xcd < r ? xcd * (q + 1) : r * (q + 1) + (xcd - r) * q) + off; }
        const int nig = WGM * nN, gid = wgid / nig, fm = gid * WGM, gsz = (nM - fm) < WGM ? (nM - fm) : WGM;
        u.pm = fm + ((wgid % nig) % gsz); u.pn = (wgid % nig) / gsz; return true;
    }
    __device__ __forceinline__ void a_ready(const Unit&) const {}
    __device__ __forceinline__ void done(const Unit&) const {}
};
__device__ __forceinline__ unsigned cvt_pk_bf16(float lo, float hi) { unsigned r; asm volatile("v_cvt_pk_bf16_f32 %0, %1, %2" : "=v"(r) : "v"(lo), "v"(hi)); return r; }
typedef float f32x2 __attribute__((ext_vector_type(2)));
template <class Epi, class Sched, bool ALIGN_EPI = false, bool SP2 = false>
__device__ __forceinline__ void gemm_phase(PG8_LAS unsigned char* lds, const Gemm g, const Sched& S, const Epi& E) {
    const int tid = threadIdx.x, wid = __builtin_amdgcn_readfirstlane(tid >> 6), lane = tid & 63, wr = wid >> 2, wc = wid & 3, fr = lane & 15, fq = lane >> 4;
    const int K = g.K, nt = K / BK;
    unsigned voffA[2], voffB[2];
#pragma unroll
    for (int i = 0; i < 2; ++i) { int R, C; stage_rc(tid * 16 + i * 8192, R, C); const int Rb = Epi::PERM ? ((R & ~31) + perm32(R & 31)) : R;
        voffA[i] = (unsigned)(R * K + C) * 2u; voffB[i] = (unsigned)(Rb * K + C) * 2u; }
    const size_t kstep = (size_t)(BK * 2);
    const size_t hstep = (size_t)HALF * K * 2;
    const size_t tstep = 2 * hstep;
    const unsigned ldsw = (unsigned)wid * 1024u;
    const int aoff = lds_byte(wr * 64 + fr, fq * 8), boff = lds_byte(wc * 32 + fr, fq * 8);
#define PG8_SA(b, h) (((b) * 2 + (h)) * HTB)
#define PG8_SB(b, h) ((4 + (b) * 2 + (h)) * HTB)
#define PG8_STAGE(bufoff, gbase, voff) do { _Pragma("unroll") for (int _i = 0; _i < 2; ++_i) \
        __builtin_amdgcn_global_load_lds((const unsigned*)((const char*)(gbase) + (voff)[_i]), (PG8_LAS unsigned*)(lds + (bufoff) + ldsw + _i * 8192), 16, 0, 0); } while (0)
#define PG8_LDA(dst, b, h) do { _Pragma("unroll") for (int m = 0; m < 4; ++m) _Pragma("unroll") for (int k = 0; k < 2; ++k) dst[m][k] = *(const PG8_LAS bf16x8*)(lds + PG8_SA(b, h) + aoff + m * 2048 + k * 1024); } while (0)
#define PG8_LDB(dst, b, h) do { _Pragma("unroll") for (int n = 0; n < 2; ++n) _Pragma("unroll") for (int k = 0; k < 2; ++k) dst[n][k] = *(const PG8_LAS bf16x8*)(lds + PG8_SB(b, h) + boff + n * 2048 + k * 1024); } while (0)
#define PG8_MMA(ai, bj, At, Bt) do { __builtin_amdgcn_s_setprio(1); _Pragma("unroll") for (int m = 0; m < 4; ++m) _Pragma("unroll") for (int n = 0; n < 2; ++n) _Pragma("unroll") for (int k = 0; k < 2; ++k) \
        acc[ai][bj][m][n] = __builtin_amdgcn_mfma_f32_16x16x32_bf16(Bt[n][k], At[m][k], acc[ai][bj][m][n], 0, 0, 0); __builtin_amdgcn_s_setprio(0); } while (0)
#define PG8_WAIT_V(n) asm volatile("s_waitcnt vmcnt(" #n ")" ::: "memory")
#define PG8_WAIT_L(n) asm volatile("s_waitcnt lgkmcnt(" #n ")" ::: "memory")
#define PG8_BAR __builtin_amdgcn_s_barrier()
#define PG8_SCHED __builtin_amdgcn_sched_barrier(0)
    Unit cur, nxt; int ui = 0;
    if (!S.next(0, cur)) return;
    f32x4 acc[2][2][4][2];
#pragma unroll
    for (int a = 0; a < 2; ++a)
#pragma unroll
        for (int b = 0; b < 2; ++b)
#pragma unroll
            for (int m = 0; m < 4; ++m)
#pragma unroll
                for (int n = 0; n < 2; ++n) acc[a][b][m][n] = (f32x4){0.f, 0.f, 0.f, 0.f};
    bf16x8 At[4][2], B0[2][2], B1[2][2];
    const char* cA = (const char*)g.A + (size_t)cur.pm * tstep; const char* cB = (const char*)g.Bt + (size_t)cur.pn * tstep;
    S.a_ready(cur);
    if constexpr (SP2) {
        PG8_STAGE(PG8_SB(0, 0), cB, voffB); PG8_STAGE(PG8_SB(0, 1), cB + hstep, voffB); PG8_STAGE(PG8_SA(0, 0), cA, voffA); PG8_STAGE(PG8_SA(0, 1), cA + hstep, voffA);
        if (wr == 1) PG8_BAR;
        PG8_WAIT_V(2); PG8_BAR;
        PG8_STAGE(PG8_SB(1, 0), cB + kstep, voffB); PG8_STAGE(PG8_SA(1, 0), cA + kstep, voffA); PG8_STAGE(PG8_SB(1, 1), cB + hstep + kstep, voffB);
        PG8_WAIT_V(6); PG8_BAR;
    } else {
        PG8_STAGE(PG8_SB(0, 0), cB, voffB); PG8_STAGE(PG8_SA(0, 0), cA, voffA); PG8_STAGE(PG8_SB(0, 1), cB + hstep, voffB); PG8_STAGE(PG8_SA(0, 1), cA + hstep, voffA);
        if (wr == 1) PG8_BAR;
        PG8_WAIT_V(4); PG8_BAR;
        PG8_STAGE(PG8_SB(1, 0), cB + kstep, voffB); PG8_STAGE(PG8_SA(1, 0), cA + kstep, voffA); PG8_STAGE(PG8_SB(1, 1), cB + hstep + kstep, voffB);
        PG8_WAIT_V(6); PG8_BAR;
    }
    for (;;) {
        const bool has_next = S.next(ui + 1, nxt);
        const char* nA = has_next ? (const char*)g.A + (size_t)nxt.pm * tstep : cA; const char* nB = has_next ? (const char*)g.Bt + (size_t)nxt.pn * tstep : cB;
        for (int t = 0; t < nt; t += 2) {
            const bool last = (t == nt - 2);
            const char* a1 = cA + (size_t)(t + 1) * kstep;
            const char* a2 = last ? nA : cA + (size_t)(t + 2) * kstep; const char* b2 = last ? nB : cB + (size_t)(t + 2) * kstep;
            const char* a3 = a2 + kstep; const char* b3 = b2 + kstep;
            if (last && has_next) S.a_ready(nxt);
            if constexpr (SP2) {
            PG8_LDB(B0, 0, 0); PG8_LDB(B1, 0, 1); PG8_SCHED; PG8_LDA(At, 0, 0); PG8_STAGE(PG8_SA(1, 1), a1 + hstep, voffA);
            PG8_WAIT_V(8); PG8_WAIT_L(0); PG8_BAR; PG8_MMA(0, 0, At, B0); PG8_MMA(0, 1, At, B1); PG8_BAR; PG8_SCHED;
            PG8_LDA(At, 0, 1); PG8_STAGE(PG8_SB(0, 0), b2, voffB); PG8_STAGE(PG8_SB(0, 1), b2 + hstep, voffB); PG8_STAGE(PG8_SA(0, 0), a2, voffA);
            PG8_WAIT_V(8); PG8_WAIT_L(0); PG8_BAR; PG8_MMA(1, 0, At, B0); PG8_MMA(1, 1, At, B1); PG8_BAR; PG8_SCHED;
            PG8_LDB(B0, 1, 0); PG8_LDB(B1, 1, 1); PG8_SCHED; PG8_LDA(At, 1, 0); PG8_STAGE(PG8_SA(0, 1), a2 + hstep, voffA);
            PG8_WAIT_V(8); PG8_WAIT_L(0); PG8_BAR; PG8_MMA(0, 0, At, B0); PG8_MMA(0, 1, At, B1); PG8_BAR; PG8_SCHED;
            PG8_LDA(At, 1, 1); PG8_STAGE(PG8_SB(1, 0), b3, voffB); PG8_STAGE(PG8_SB(1, 1), b3 + hstep, voffB); PG8_STAGE(PG8_SA(1, 0), a3, voffA);
            PG8_WAIT_V(8); PG8_WAIT_L(0); PG8_BAR; PG8_MMA(1, 0, At, B0); PG8_MMA(1, 1, At, B1); PG8_BAR; PG8_SCHED;
            } else {
            PG8_LDB(B0, 0, 0); PG8_SCHED; PG8_LDA(At, 0, 0); PG8_STAGE(PG8_SA(1, 1), a1 + hstep, voffA);
            PG8_WAIT_L(8); PG8_BAR; PG8_WAIT_L(0); PG8_MMA(0, 0, At, B0); PG8_BAR; PG8_SCHED;
            PG8_LDB(B1, 0, 1); PG8_STAGE(PG8_SB(0, 0), b2, voffB);
            PG8_BAR; PG8_WAIT_L(0); PG8_MMA(0, 1, At, B1); PG8_BAR;
            PG8_LDA(At, 0, 1); PG8_STAGE(PG8_SA(0, 0), a2, voffA);
            PG8_BAR; PG8_WAIT_L(0); PG8_MMA(1, 0, At, B0); PG8_BAR; PG8_SCHED;
            PG8_STAGE(PG8_SB(0, 1), b2 + hstep, voffB);
            PG8_WAIT_V(6); PG8_BAR; PG8_MMA(1, 1, At, B1); PG8_BAR;
            PG8_LDB(B0, 1, 0); PG8_SCHED; PG8_LDA(At, 1, 0); PG8_STAGE(PG8_SA(0, 1), a2 + hstep, voffA);
            PG8_WAIT_L(8); PG8_BAR; PG8_WAIT_L(0); PG8_MMA(0, 0, At, B0); PG8_BAR; PG8_SCHED;
            PG8_LDB(B1, 1, 1); PG8_STAGE(PG8_SB(1, 0), b3, voffB);
            PG8_BAR; PG8_WAIT_L(0); PG8_MMA(0, 1, At, B1); PG8_BAR;
            PG8_LDA(At, 1, 1); PG8_STAGE(PG8_SA(1, 0), a3, voffA);
            PG8_BAR; PG8_WAIT_L(0); PG8_MMA(1, 0, At, B0); PG8_BAR; PG8_SCHED;
            PG8_STAGE(PG8_SB(1, 1), b3 + hstep, voffB);
            PG8_WAIT_V(6); PG8_BAR; PG8_MMA(1, 1, At, B1); PG8_BAR;
            }
        }
        if constexpr (ALIGN_EPI) { if (wr == 0) PG8_BAR; }
        if constexpr (!Epi::AFTER_DRAIN) { E(acc, cur, wr, wc, fr, fq); S.done(cur); }
        if (!has_next) break;
#pragma unroll
        for (int a = 0; a < 2; ++a)
#pragma unroll
            for (int b = 0; b < 2; ++b)
#pragma unroll
                for (int m = 0; m < 4; ++m)
#pragma unroll
                    for (int n = 0; n < 2; ++n) acc[a][b][m][n] = (f32x4){0.f, 0.f, 0.f, 0.f};
        cur = nxt; cA = nA; cB = nB; ++ui;
        if constexpr (ALIGN_EPI) { if (wr == 1) PG8_BAR; }
    }
    PG8_WAIT_V(0);
    if constexpr (!ALIGN_EPI) { if (wr == 0) PG8_BAR; }
    PG8_BAR;
    if constexpr (Epi::AFTER_DRAIN) { E.fused(acc, cur, wr, wc, fr, fq, lds, wid, lane); S.done(cur); }
#undef PG8_SA
#undef PG8_SB
#undef PG8_STAGE
#undef PG8_LDA
#undef PG8_LDB
#undef PG8_MMA
#undef PG8_WAIT_V
#undef PG8_WAIT_L
#undef PG8_BAR
#undef PG8_SCHED
}
}
namespace pg9 {
using pg8::bf16x8; using pg8::f32x4; using pg8::u32x4; using pg8::lds_byte; using pg8::stage_rc; using pg8::perm32;
constexpr int BK = 64, HALF = 128, HTB = HALF * BK * 2;
struct Unit { int pm, pn, aux, cnt; };
template <class Epi, class Sched, bool GATHER>
__device__ __forceinline__ void gemm_phase(PG8_LAS unsigned char* lds, const int K, const int lda, const int ldb, const Sched& S, const Epi& E) {
    const int tid = threadIdx.x, wid = __builtin_amdgcn_readfirstlane(tid >> 6), lane = tid & 63, wr = wid >> 2, wc = wid & 3, fr = lane & 15, fq = lane >> 4;
    const int nt = K / BK;
    unsigned offA[2][2], offAn[2][2], offB[2][2]; int RA[2], CA[2];
#pragma unroll
    for (int i = 0; i < 2; ++i) { int R, C; stage_rc(tid * 16 + i * 8192, R, C); const int Rb = Epi::PERM ? ((R & ~31) + perm32(R & 31)) : R; RA[i] = R; CA[i] = C * 2;
#pragma unroll
        for (int h = 0; h < 2; ++h) { offB[h][i] = (unsigned)((Rb + 128 * h) * ldb + C) * 2u; offA[h][i] = (unsigned)((R + 128 * h) * lda + C) * 2u; offAn[h][i] = offA[h][i]; } }
    const size_t kstep = (size_t)(BK * 2);
    const unsigned ldsw = (unsigned)wid * 1024u;
    const int aoff = lds_byte(wr * 64 + fr, fq * 8), boff = lds_byte(wc * 32 + fr, fq * 8);
#define PG9_SA(b, h) (((b) * 2 + (h)) * HTB)
#define PG9_SB(b, h) ((4 + (b) * 2 + (h)) * HTB)
#define PG9_STAGE(bufoff, gbase, voff) do { _Pragma("unroll") for (int _i = 0; _i < 2; ++_i) \
        __builtin_amdgcn_global_load_lds((const unsigned*)((const char*)(gbase) + (voff)[_i]), (PG8_LAS unsigned*)(lds + (bufoff) + ldsw + _i * 8192), 16, 0, 0); } while (0)
#define PG9_LDA(dst, b, h) do { _Pragma("unroll") for (int m = 0; m < 4; ++m) _Pragma("unroll") for (int k = 0; k < 2; ++k) dst[m][k] = *(const PG8_LAS bf16x8*)(lds + PG9_SA(b, h) + aoff + m * 2048 + k * 1024); } while (0)
#define PG9_LDB(dst, b, h) do { _Pragma("unroll") for (int n = 0; n < 2; ++n) _Pragma("unroll") for (int k = 0; k < 2; ++k) dst[n][k] = *(const PG8_LAS bf16x8*)(lds + PG9_SB(b, h) + boff + n * 2048 + k * 1024); } while (0)
#define PG9_MMA(ai, bj, At, Bt) do { __builtin_amdgcn_s_setprio(1); _Pragma("unroll") for (int m = 0; m < 4; ++m) _Pragma("unroll") for (int n = 0; n < 2; ++n) _Pragma("unroll") for (int k = 0; k < 2; ++k) \
        acc[ai][bj][m][n] = __builtin_amdgcn_mfma_f32_16x16x32_bf16(Bt[n][k], At[m][k], acc[ai][bj][m][n], 0, 0, 0); __builtin_amdgcn_s_setprio(0); } while (0)
#define PG9_WAIT_V(n) asm volatile("s_waitcnt vmcnt(" #n ")" ::: "memory")
#define PG9_WAIT_L(n) asm volatile("s_waitcnt lgkmcnt(" #n ")" ::: "memory")
#define PG9_BAR __builtin_amdgcn_s_barrier()
#define PG9_SCHED __builtin_amdgcn_sched_barrier(0)
    Unit cur, nxt; int ui = 0;
    if (!S.next(0, cur)) return;
    f32x4 acc[2][2][4][2];
#pragma unroll
    for (int a = 0; a < 2; ++a)
#pragma unroll
        for (int b = 0; b < 2; ++b)
#pragma unroll
            for (int m = 0; m < 4; ++m)
#pragma unroll
                for (int n = 0; n < 2; ++n) acc[a][b][m][n] = (f32x4){0.f, 0.f, 0.f, 0.f};
    bf16x8 At[4][2], B0[2][2], B1[2][2];
    const char* cA = S.a_base(cur); const char* cB = S.b_base(cur);
    if constexpr (GATHER) {
#pragma unroll
        for (int h = 0; h < 2; ++h)
#pragma unroll
            for (int i = 0; i < 2; ++i) offA[h][i] = S.a_row_off(cur, RA[i] + 128 * h) + (unsigned)CA[i];
    }
    PG9_STAGE(PG9_SB(0, 0), cB, offB[0]); PG9_STAGE(PG9_SB(0, 1), cB, offB[1]); PG9_STAGE(PG9_SA(0, 0), cA, offA[0]); PG9_STAGE(PG9_SA(0, 1), cA, offA[1]);
    if (wr == 1) PG9_BAR;
    PG9_WAIT_V(2); PG9_BAR;
    PG9_STAGE(PG9_SB(1, 0), cB + kstep, offB[0]); PG9_STAGE(PG9_SA(1, 0), cA + kstep, offA[0]); PG9_STAGE(PG9_SB(1, 1), cB + kstep, offB[1]);
    PG9_WAIT_V(6); PG9_BAR;
    for (;;) {
        const bool has_next = S.next(ui + 1, nxt);
        const char* nA = has_next ? S.a_base(nxt) : cA; const char* nB = has_next ? S.b_base(nxt) : cB;
        if constexpr (GATHER) {
#pragma unroll
            for (int h = 0; h < 2; ++h)
#pragma unroll
                for (int i = 0; i < 2; ++i) offAn[h][i] = has_next ? (S.a_row_off(nxt, RA[i] + 128 * h) + (unsigned)CA[i]) : offA[h][i];
        }
        for (int t = 0; t < nt; t += 2) {
            const bool last = (t == nt - 2);
            const char* a1 = cA + (size_t)(t + 1) * kstep;
            const char* a2 = last ? nA : cA + (size_t)(t + 2) * kstep; const char* b2 = last ? nB : cB + (size_t)(t + 2) * kstep;
            const char* a3 = a2 + kstep; const char* b3 = b2 + kstep;
            unsigned oA2[2][2];
#pragma unroll
            for (int h = 0; h < 2; ++h)
#pragma unroll
                for (int i = 0; i < 2; ++i) oA2[h][i] = (GATHER && last) ? offAn[h][i] : offA[h][i];
            PG9_LDB(B0, 0, 0); PG9_LDB(B1, 0, 1); PG9_SCHED; PG9_LDA(At, 0, 0); PG9_STAGE(PG9_SA(1, 1), a1, offA[1]);
            PG9_WAIT_V(8); PG9_WAIT_L(0); PG9_BAR; PG9_MMA(0, 0, At, B0); PG9_MMA(0, 1, At, B1); PG9_BAR; PG9_SCHED;
            PG9_LDA(At, 0, 1); PG9_STAGE(PG9_SB(0, 0), b2, offB[0]); PG9_STAGE(PG9_SB(0, 1), b2, offB[1]); PG9_STAGE(PG9_SA(0, 0), a2, oA2[0]);
            PG9_WAIT_V(8); PG9_WAIT_L(0); PG9_BAR; PG9_MMA(1, 0, At, B0); PG9_MMA(1, 1, At, B1); PG9_BAR; PG9_SCHED;
            PG9_LDB(B0, 1, 0); PG9_LDB(B1, 1, 1); PG9_SCHED; PG9_LDA(At, 1, 0); PG9_STAGE(PG9_SA(0, 1), a2, oA2[1]);
            PG9_WAIT_V(8); PG9_WAIT_L(0); PG9_BAR; PG9_MMA(0, 0, At, B0); PG9_MMA(0, 1, At, B1); PG9_BAR; PG9_SCHED;
            PG9_LDA(At, 1, 1); PG9_STAGE(PG9_SB(1, 0), b3, offB[0]); PG9_STAGE(PG9_SB(1, 1), b3, offB[1]); PG9_STAGE(PG9_SA(1, 0), a3, oA2[0]);
            PG9_WAIT_V(8); PG9_WAIT_L(0); PG9_BAR; PG9_MMA(1, 0, At, B0); PG9_MMA(1, 1, At, B1); PG9_BAR; PG9_SCHED;
        }
        if (wr == 0) PG9_BAR;
        bool keep = false;
        if constexpr (Epi::CHAIN) keep = E.chain_more(cur);
        if (keep) { if constexpr (Epi::CHAIN) E.rescale(acc, cur, wr, wc, fr, fq); }
        else E(acc, cur, wr, wc, fr, fq);
        if (!has_next) break;
        if (!keep) {
#pragma unroll
            for (int a = 0; a < 2; ++a)
#pragma unroll
                for (int b = 0; b < 2; ++b)
#pragma unroll
                    for (int m = 0; m < 4; ++m)
#pragma unroll
                        for (int n = 0; n < 2; ++n) acc[a][b][m][n] = (f32x4){0.f, 0.f, 0.f, 0.f};
        }
        cur = nxt; cA = nA; cB = nB; ++ui;
        if constexpr (GATHER) {
#pragma unroll
            for (int h = 0; h < 2; ++h)
#pragma unroll
                for (int i = 0; i < 2; ++i) offA[h][i] = offAn[h][i];
        }
        if (wr == 1) PG9_BAR;
    }
    PG9_WAIT_V(0);
    PG9_BAR;
#undef PG9_SA
#undef PG9_SB
#undef PG9_STAGE
#undef PG9_LDA
#undef PG9_LDB
#undef PG9_MMA
#undef PG9_WAIT_V
#undef PG9_WAIT_L
#undef PG9_BAR
#undef PG9_SCHED
}
}
#define GAS __attribute__((address_space(1)))
#define LAS __attribute__((address_space(3)))
typedef unsigned short bf16;
typedef unsigned v4u __attribute__((ext_vector_type(4)));
typedef float f32x4 __attribute__((ext_vector_type(4)));
typedef short bf16x8 __attribute__((ext_vector_type(8)));
typedef GAS unsigned gu32;
typedef GAS unsigned long long gu64;
#define RLX_AGENT __ATOMIC_RELAXED, __HIP_MEMORY_SCOPE_AGENT
#define LDS_WAIT() asm volatile("s_waitcnt lgkmcnt(0)" ::: "memory")
#define VM_WAIT() asm volatile("s_waitcnt vmcnt(0)" ::: "memory")
__device__ __forceinline__ unsigned long long rt() { return __builtin_amdgcn_s_memrealtime(); }
__device__ __forceinline__ unsigned f2bfu(float f) { unsigned u = __builtin_bit_cast(unsigned, f); return (u + 0x7fffu + ((u >> 16) & 1u)) >> 16; }
__device__ __forceinline__ unsigned pk2(float lo, float hi) { return f2bfu(lo) | (f2bfu(hi) << 16); }
#define XB_TMO      128
#define XB_XCNT(j)  (256  + 64 * (j))
#define XB_XSUB(j)  (1280 + 64 * (j))
#define XB_XGEN(j)  (2304 + 64 * (j))
#define XB_TOP      3328
#define XB_TOPGEN   3392
#define XCD_BAR_WORDS 3456
#define XB_SPIN_CAP (1u << 18)

__device__ __forceinline__ unsigned xb_ld(unsigned* p)              { return __hip_atomic_load(p, __ATOMIC_RELAXED, __HIP_MEMORY_SCOPE_AGENT); }
__device__ __forceinline__ unsigned xb_add(unsigned* p, unsigned v) { return __hip_atomic_fetch_add(p, v, __ATOMIC_RELAXED, __HIP_MEMORY_SCOPE_AGENT); }
__device__ __forceinline__ unsigned xb_xcc_id() { return (unsigned)__builtin_amdgcn_s_getreg((3 << 11) | 20) & 0xFu; }
#define XB_SPIN(cond, bar) do { unsigned _sp = 0; while (cond) { __builtin_amdgcn_s_sleep(1); \
    if ((++_sp & 255u) == 0u) { if (xb_ld(&(bar)[XB_TMO])) break; if (_sp > XB_SPIN_CAP) { atomicAdd(&(bar)[XB_TMO], 1u); break; } } } } while (0)

struct XcdBarrier {
    unsigned* bar; unsigned x;
    volatile LAS unsigned* st;
};

__device__ __forceinline__ XcdBarrier xcd_barrier_post(unsigned* bar, volatile LAS unsigned* st) {
    XcdBarrier b; b.bar = bar; b.x = xb_xcc_id(); b.st = st;
    if (threadIdx.x == 0) (void)xb_add(&bar[XB_XCNT(b.x)], 1u);
    return b;
}
__device__ __forceinline__ void xcd_barrier_complete(unsigned* bar, unsigned x, unsigned& nloc, unsigned& nx) {
    const unsigned G = gridDim.x * gridDim.y * gridDim.z;
    unsigned sum, cnt, mine, sp = 0u;
    for (;;) {
        sum = 0u; cnt = 0u; mine = 0u;
#pragma unroll
        for (unsigned j = 0; j < 16; ++j) { const unsigned c = xb_ld(&bar[XB_XCNT(j)]); sum += c; cnt += (c > 0u) ? 1u : 0u; mine = (j == x) ? c : mine; }
        if (sum == G) break;
        __builtin_amdgcn_s_sleep(1);
        if ((++sp & 255u) == 0u) { if (xb_ld(&bar[XB_TMO])) break; if (sp > XB_SPIN_CAP) { atomicAdd(&bar[XB_TMO], 1u); break; } }
    }
    nloc = mine > 0u ? mine : 1u; nx = cnt > 0u ? cnt : 1u;
}

__device__ __forceinline__ void xcd_barrier(const XcdBarrier& b) {
    asm volatile("s_waitcnt vmcnt(0)" ::: "memory");
    __syncthreads();
    if (threadIdx.x == 0) {
        unsigned* bar = b.bar;
        __builtin_amdgcn_s_waitcnt(0);
        unsigned nloc = b.st[0], nx = b.st[1];
        if (nloc == 0u) { xcd_barrier_complete(bar, b.x, nloc, nx); b.st[0] = nloc; b.st[1] = nx; }
        const unsigned old = xb_add(&bar[XB_XSUB(b.x)], 1u);
        const unsigned gen = old / nloc;
        if (old + 1u == (gen + 1u) * nloc) {
            __builtin_amdgcn_fence(__ATOMIC_RELEASE, "agent");
            asm volatile("s_waitcnt vmcnt(0)" ::: "memory");
            const unsigned og = xb_add(&bar[XB_TOP], 1u);
            const unsigned tg = og / nx;
            if (og + 1u == (tg + 1u) * nx) xb_add(&bar[XB_TOPGEN], 1u);
            else XB_SPIN(xb_ld(&bar[XB_TOPGEN]) == tg, bar);
            __builtin_amdgcn_fence(__ATOMIC_ACQUIRE, "agent");
            xb_add(&bar[XB_XGEN(b.x)], 1u);
            asm volatile("s_waitcnt vmcnt(0)" ::: "memory");
        } else {
            XB_SPIN(xb_ld(&bar[XB_XGEN(b.x)]) == gen, bar);
            __builtin_amdgcn_fence(__ATOMIC_ACQUIRE, "agent");
            asm volatile("s_waitcnt vmcnt(0)" ::: "memory");
        }
    }
    __syncthreads();
}
constexpr int NWAVES = 8;
constexpr int RING_OFF = 0, RING_BYTES = 131072;
constexpr int LDSCTL_OFF = RING_BYTES, MISC_OFF = LDSCTL_OFF + 320;
constexpr int LDS_BYTES = 147456;
constexpr int CW_BAR = 4096;
constexpr int CW_KMEAN = 32768;
constexpr int CW_MEMKSS = 65536;
static_assert((CW_MEMKSS + 4096) * 4 <= (int)MiB && CW_BAR + 4 * 3456 <= CW_KMEAN, "ctl map");

struct Frame {
    LAS unsigned char* lds; volatile LAS unsigned* MISC; gu32* ctl;
    int tid, lane, wave, vcu, G;
    unsigned char* ws; float* out;
};
typedef float f32x2_t __attribute__((ext_vector_type(2))); typedef __bf16 bf16x2_t __attribute__((ext_vector_type(2)));
__device__ __forceinline__ unsigned cvt_pk_bf16(float lo, float hi) { f32x2_t v = {lo, hi}; bf16x2_t b = __builtin_convertvector(v, bf16x2_t); return __builtin_bit_cast(unsigned, b); }
__device__ __forceinline__ float wave_sum64(float v) {
#pragma unroll
    for (int o = 1; o < 64; o <<= 1) v += __shfl_xor(v, o);
    return v;
}
template <bool HEADPERM> __device__ __forceinline__ void p0_transpose_item(const float* W, int K, int N, bf16* WT, int row_off, LAS float* scr, int item, int lane) {
    const int nblk = N / 32, kb = item / nblk, nb = item % nblk, k0 = 64 * kb, n0 = 32 * nb;
    int p0 = n0; if (HEADPERM) { const int lg = (n0 >> 5) & 7; p0 = (n0 & ~255) + 32 * (4 * (lg & 1) + (lg >> 1)); }
    float wv[32];
#pragma unroll
    for (int i = 0; i < 32; ++i) wv[i] = W[(size_t)(k0 + 2 * i + (lane >> 5)) * N + n0 + (lane & 31)];
#pragma unroll
    for (int i = 0; i < 32; ++i) scr[(2 * i + (lane >> 5)) * 33 + (lane & 31)] = wv[i];
    LDS_WAIT(); asm volatile("" ::: "memory");
    const int c = lane & 7;
#pragma unroll
    for (int j = 0; j < 4; ++j) { const int n = (lane >> 3) + 8 * j; const LAS float* s = scr + (8 * c) * 33 + n;
        v4u o; o.x = cvt_pk_bf16(s[0 * 33], s[1 * 33]); o.y = cvt_pk_bf16(s[2 * 33], s[3 * 33]); o.z = cvt_pk_bf16(s[4 * 33], s[5 * 33]); o.w = cvt_pk_bf16(s[6 * 33], s[7 * 33]);
        *(GAS v4u*)(WT + (size_t)(row_off + p0 + n) * K + k0 + 8 * c) = o; }
    LDS_WAIT(); asm volatile("" ::: "memory");
}
__device__ __forceinline__ void xp_load(float (&wv)[32], const float* W, int N, int nblk, int item, int lane) {
    const int kb = item / nblk, nb = item % nblk, k0 = 64 * kb, n0 = 32 * nb;
#pragma unroll
    for (int i = 0; i < 32; ++i) wv[i] = W[(size_t)(k0 + 2 * i + (lane >> 5)) * N + n0 + (lane & 31)];
}
__device__ __forceinline__ void xp_finish(const float (&wv)[32], int K, int nblk, bf16* WT, LAS float* scr, int item, int lane) {
    const int kb = item / nblk, nb = item % nblk, k0 = 64 * kb, n0 = 32 * nb;
#pragma unroll
    for (int i = 0; i < 32; ++i) scr[(2 * i + (lane >> 5)) * 33 + (lane & 31)] = wv[i];
    LDS_WAIT(); asm volatile("" ::: "memory");
    const int c = lane & 7;
#pragma unroll
    for (int j = 0; j < 4; ++j) { const int n = (lane >> 3) + 8 * j; const LAS float* s = scr + (8 * c) * 33 + n;
        v4u o; o.x = cvt_pk_bf16(s[0 * 33], s[1 * 33]); o.y = cvt_pk_bf16(s[2 * 33], s[3 * 33]); o.z = cvt_pk_bf16(s[4 * 33], s[5 * 33]); o.w = cvt_pk_bf16(s[6 * 33], s[7 * 33]);
        *(GAS v4u*)(WT + (size_t)(n0 + n) * K + k0 + 8 * c) = o; }
    LDS_WAIT(); asm volatile("" ::: "memory");
}
__device__ __forceinline__ void rms_row_to_bf16(int lane, const float* xrow, const float* g, bf16* orow) {
    const GAS f32x4* xr = (const GAS f32x4*)xrow + lane; const GAS f32x4* gr = (const GAS f32x4*)g + lane;
    f32x4 v[4]; float s = 0.f;
#pragma unroll
    for (int j = 0; j < 4; ++j) { v[j] = xr[64 * j]; s += (v[j].x * v[j].x + v[j].y * v[j].y) + (v[j].z * v[j].z + v[j].w * v[j].w); }
    const float r = 1.f / sqrtf(wave_sum64(s) * (1.f / 1024.f) + 1e-5f);
    GAS unsigned long long* o8 = (GAS unsigned long long*)orow + lane;
#pragma unroll
    for (int j = 0; j < 4; ++j) { const f32x4 gg = gr[64 * j]; o8[64 * j] = (unsigned long long)cvt_pk_bf16(v[j].x * r * gg.x, v[j].y * r * gg.y) | ((unsigned long long)cvt_pk_bf16(v[j].z * r * gg.z, v[j].w * r * gg.w) << 32); }
}
struct Args { const float* in[23]; float* out; unsigned char* ws; int ph_lo, ph_hi, li, pad; };
__device__ __forceinline__ void p0_prologue(Frame& F, const Args& A) {
    LAS float* scr = (LAS float*)(F.lds + RING_OFF + F.wave * 16384);
    const int gw = F.vcu * NWAVES + F.wave, NGW = F.G * NWAVES;
    constexpr int I_IN = 16 * (DIN / 32), I_MKV = 16 * 32, I_BR = 8 * 32, I_OUT = 16 * 32;
    constexpr int NITEMS = I_IN + I_MKV + 3 * I_BR + I_OUT;
    for (int it = gw; it < NITEMS; it += NGW) {
        int r = it;
        if (r < I_IN) { p0_transpose_item<true>(A.in[3], 1024, DIN, (bf16*)(F.ws + WS_WIN), 0, scr, r, F.lane); continue; } r -= I_IN;
        if (r < I_MKV) { p0_transpose_item<true>(A.in[9], 1024, 1024, (bf16*)(F.ws + WS_WMEMKV), 0, scr, r, F.lane); continue; } r -= I_MKV;
        if (r < 3 * I_BR) { const int w = r / I_BR; p0_transpose_item<false>(w == 0 ? A.in[12] : (w == 1 ? A.in[13] : A.in[14]), 512, 1024, (bf16*)(F.ws + WS_WBR) + (size_t)w * 1024 * 512, 0, scr, r % I_BR, F.lane); continue; } r -= 3 * I_BR;
        p0_transpose_item<false>(A.in[15], 1024, 1024, (bf16*)(F.ws + WS_WOUT), 0, scr, r, F.lane);
    }
    if (gw == 0) { ((float*)(F.ws + WS_GTAB))[F.lane] = A.in[6][F.lane]; ((float*)(F.ws + WS_GTAB))[64 + F.lane] = A.in[7][F.lane]; }
    for (int m = gw; m < NTOK; m += NGW) rms_row_to_bf16(F.lane, A.in[0] + (size_t)m * DM, A.in[2], (bf16*)(F.ws + WS_HB) + (size_t)m * DM);
    for (int m = gw; m < NB * MEMLEN; m += NGW) rms_row_to_bf16(F.lane, A.in[1] + (size_t)m * DM, A.in[8], (bf16*)(F.ws + WS_HM) + (size_t)m * DM);
}

struct P1Order {
    pg8::StaticOrder so; int G, c;
    __device__ void init(int G_, int c_) { so.init(NTOK, DIN, G_, 0); G = G_; c = c_; }
    __device__ bool next(int i, pg8::Unit& u) const {
        long L = (long)i * G + c;
        if (L < 1664) { pg8::StaticOrder t = so; t.G = 1; t.c = 0; return t.next((int)L, u); }
        L -= 1664; if (L >= 16) return false;
        u.pm = 64 + (int)(L >> 2); u.pn = 26 + (int)(L & 3); return true;
    }
    __device__ __forceinline__ void a_ready(const pg8::Unit&) const {}
    __device__ __forceinline__ void done(const pg8::Unit&) const {}
};
__device__ __forceinline__ float sigmoid_f(float x) { return __builtin_amdgcn_rcpf(1.f + __expf(-x)); }
struct EpiP1 {
    static constexpr bool PERM = true, AFTER_DRAIN = false;
    unsigned char* ws; const float* b_gate; const float* gtab; float* KMEAN; float* MEMKSS; int atom_on;
    __device__ __forceinline__ void operator()(const pg8::f32x4 (&acc)[2][2][4][2], const pg8::Unit& u, int wr, int wc, int fr, int fq) const {
        using pg8::f32x4; using pg8::u32x4;
        const int pn = u.pn; int type, ldc, cb; size_t off; int row0 = u.pm * 256;
        if (pn == 0) { type = 0; off = WS_RQ; ldc = 256; cb = 0; }
        else if (pn == 1) { type = 1; off = WS_RK; ldc = 256; cb = 0; }
        else if (pn < 4) { type = 0; off = WS_RV; ldc = 512; cb = (pn - 2) * 256; }
        else if (pn < 6) { type = 2; off = WS_RG; ldc = 512; cb = (pn - 4) * 256; }
        else if (pn < 8) { type = 3; off = WS_MQ; ldc = 512; cb = (pn - 6) * 256; }
        else if (pn < 10) { type = 4; off = WS_MK; ldc = 512; cb = (pn - 8) * 256; }
        else if (pn < 12) { type = 0; off = WS_MV; ldc = 512; cb = (pn - 10) * 256; }
        else if (pn < 14) { type = 0; off = WS_CQ; ldc = 512; cb = (pn - 12) * 256; }
        else if (pn < 26) { type = 5; off = WS_GT; ldc = 3072; cb = (pn - 14) * 256; }
        else if (pn < 28) { type = 6; off = WS_MEMK; ldc = 512; cb = (pn - 26) * 256; row0 = (u.pm - 64) * 256; }
        else { type = 0; off = WS_MEMV; ldc = 512; cb = (pn - 28) * 256; row0 = (u.pm - 64) * 256; }
        bf16_t* base = (bf16_t*)(ws + off) + cb + 64 * wc + 8 * fq;
        const int rbase = row0 + 64 * wr + fr;
#define P1_STORE(rowp, bj, v0, v1) do { u32x4 w_; w_.x = cvt_pk_bf16((v0)[0], (v0)[1]); w_.y = cvt_pk_bf16((v0)[2], (v0)[3]); w_.z = cvt_pk_bf16((v1)[0], (v1)[1]); w_.w = cvt_pk_bf16((v1)[2], (v1)[3]); *(u32x4*)((rowp) + 32 * (bj)) = w_; } while (0)
        if (type <= 1) {
            const float sc = type == 1 ? 0.125f : 1.f;
#pragma unroll
            for (int ai = 0; ai < 2; ++ai)
#pragma unroll
                for (int m = 0; m < 4; ++m) { bf16_t* rowp = base + (size_t)(rbase + 128 * ai + 16 * m) * ldc;
#pragma unroll
                    for (int bj = 0; bj < 2; ++bj) { const f32x4 v0 = acc[ai][bj][m][0] * sc, v1 = acc[ai][bj][m][1] * sc; P1_STORE(rowp, bj, v0, v1); } }
        } else if (type == 2) {
#pragma unroll
            for (int ai = 0; ai < 2; ++ai)
#pragma unroll
                for (int m = 0; m < 4; ++m) { bf16_t* rowp = base + (size_t)(rbase + 128 * ai + 16 * m) * ldc;
#pragma unroll
                    for (int bj = 0; bj < 2; ++bj) { f32x4 v0 = acc[ai][bj][m][0], v1 = acc[ai][bj][m][1];
#pragma unroll
                        for (int j = 0; j < 4; ++j) { v0[j] = v0[j] * sigmoid_f(v0[j]); v1[j] = v1[j] * sigmoid_f(v1[j]); }
                        P1_STORE(rowp, bj, v0, v1); } }
        } else if (type == 5) {
            f32x4 bv[2][2];
#pragma unroll
            for (int bj = 0; bj < 2; ++bj)
#pragma unroll
                for (int n = 0; n < 2; ++n) bv[bj][n] = *(const f32x4*)(b_gate + cb + 64 * wc + 32 * bj + 8 * fq + 4 * n);
#pragma unroll
            for (int ai = 0; ai < 2; ++ai)
#pragma unroll
                for (int m = 0; m < 4; ++m) { bf16_t* rowp = base + (size_t)(rbase + 128 * ai + 16 * m) * ldc;
#pragma unroll
                    for (int bj = 0; bj < 2; ++bj) { f32x4 v0 = acc[ai][bj][m][0] + bv[bj][0], v1 = acc[ai][bj][m][1] + bv[bj][1];
#pragma unroll
                        for (int j = 0; j < 4; ++j) { v0[j] = sigmoid_f(v0[j]); v1[j] = sigmoid_f(v1[j]); }
                        P1_STORE(rowp, bj, v0, v1); } }
        } else if (type == 6) {
#pragma unroll
            for (int ai = 0; ai < 2; ++ai)
#pragma unroll
                for (int m = 0; m < 4; ++m) { const int row = rbase + 128 * ai + 16 * m; bf16_t* rowp = base + (size_t)row * ldc; float ss = 0.f;
#pragma unroll
                    for (int bj = 0; bj < 2; ++bj) { const f32x4 v0 = acc[ai][bj][m][0], v1 = acc[ai][bj][m][1];
                        ss += (v0[0] * v0[0] + v0[1] * v0[1]) + (v0[2] * v0[2] + v0[3] * v0[3]) + (v1[0] * v1[0] + v1[1] * v1[1]) + (v1[2] * v1[2] + v1[3] * v1[3]);
                        P1_STORE(rowp, bj, v0, v1); }
                    ss += __shfl_xor(ss, 16); ss += __shfl_xor(ss, 32);
                    if (fq == 0 && atom_on) atomicAdd(MEMKSS + (size_t)row * 4 + (cb >> 7) + (wc >> 1), ss);
                    }
        } else {
            const float* g = gtab + (type == 3 ? 0 : 64);
            f32x4 gv[2][2]; float rr[2][4];
#pragma unroll
            for (int bj = 0; bj < 2; ++bj)
#pragma unroll
                for (int n = 0; n < 2; ++n) gv[bj][n] = *(const f32x4*)(g + 32 * bj + 8 * fq + 4 * n);
#pragma unroll
            for (int ai = 0; ai < 2; ++ai)
#pragma unroll
                for (int m = 0; m < 4; ++m) { bf16_t* rowp = base + (size_t)(rbase + 128 * ai + 16 * m) * ldc; float ss = 0.f;
#pragma unroll
                    for (int bj = 0; bj < 2; ++bj) { const f32x4 v0 = acc[ai][bj][m][0], v1 = acc[ai][bj][m][1];
                        ss += (v0[0] * v0[0] + v0[1] * v0[1]) + (v0[2] * v0[2] + v0[3] * v0[3]) + (v1[0] * v1[0] + v1[1] * v1[1]) + (v1[2] * v1[2] + v1[3] * v1[3]); }
                    ss += __shfl_xor(ss, 16); ss += __shfl_xor(ss, 32);
                    const float r = (1.f / sqrtf(ss * (1.f / 64.f) + 1e-5f)) * (type == 3 ? 0.18033688011112042f : 1.f); rr[ai][m] = r;
#pragma unroll
                    for (int bj = 0; bj < 2; ++bj) { const f32x4 v0 = acc[ai][bj][m][0] * r * gv[bj][0], v1 = acc[ai][bj][m][1] * r * gv[bj][1];
                        P1_STORE(rowp, bj, v0, v1); }
                    asm volatile("" ::: "memory"); }
            if (type == 4 && atom_on) {
                float* km = KMEAN + ((size_t)u.pm * 8 + (cb >> 6) + wc) * 64 + 8 * fq;
#pragma unroll
                for (int bj = 0; bj < 2; ++bj)
#pragma unroll
                    for (int n = 0; n < 2; ++n)
#pragma unroll
                        for (int j = 0; j < 4; ++j) { float s = 0.f;
#pragma unroll
                            for (int ai = 0; ai < 2; ++ai)
#pragma unroll
                                for (int m = 0; m < 4; ++m) s += acc[ai][bj][m][n][j] * rr[ai][m];
                            s += __shfl_xor(s, 1); s += __shfl_xor(s, 2); s += __shfl_xor(s, 4); s += __shfl_xor(s, 8);
                            if (fr == 0) atomicAdd(km + 32 * bj + 4 * n + j, s * gv[bj][n][j] * (1.f / 256.f)); }
            }
        }
#undef P1_STORE
    }
};

constexpr int TB_OFF = LDSCTL_OFF + 1024;
__device__ __forceinline__ unsigned cvt_pk(float lo, float hi) { return cvt_pk_bf16(lo, hi); }

struct P3Order {
    pg8::StaticOrder so; int G, c; const unsigned char* ws;
    __device__ void init(int G_, int c_, const unsigned char* ws_) { so.init(NTOK, 1024, 1, 0); G = G_; c = c_; ws = ws_; }
    __device__ bool next(int i, pg9::Unit& u) const {
        const int tl = (i / 3) * G + c; if (tl >= 256) return false; pg8::Unit t; so.next(tl, t); u.pm = t.pm; u.pn = t.pn; u.aux = i % 3; u.cnt = 256; return true; }
    __device__ __forceinline__ const char* a_base(const pg9::Unit& u) const { return (const char*)(ws + WS_ORET) + (size_t)u.aux * (WS_OMOBA - WS_ORET) + (size_t)u.pm * 256 * 512 * 2; }
    __device__ __forceinline__ const char* b_base(const pg9::Unit& u) const { return (const char*)(ws + WS_WBR) + (size_t)u.aux * 1024 * 512 * 2 + (size_t)u.pn * 256 * 512 * 2; }
};
struct EpiP3 {
    static constexpr bool PERM = true, CHAIN = true;
    const bf16_t* GT; bf16_t* Y;
    __device__ __forceinline__ bool chain_more(const pg9::Unit& u) const { return u.aux < 2; }
    __device__ __forceinline__ void rescale(pg8::f32x4 (&acc)[2][2][4][2], const pg9::Unit& u, int wr, int wc, int fr, int fq) const {
        const int s = u.aux;
#pragma unroll
        for (int ai = 0; ai < 2; ++ai)
#pragma unroll
            for (int m = 0; m < 4; ++m) { const bf16_t* gp = GT + (size_t)(u.pm * 256 + 128 * ai + 64 * wr + 16 * m + fr) * 3072 + s * 1024 + u.pn * 256 + 32 * wc + 8 * fq;
#pragma unroll
                for (int bj = 0; bj < 2; ++bj) { const pg8::u32x4 ga = *(const pg8::u32x4*)(gp + 128 * bj), gb = *(const pg8::u32x4*)(gp + 1024 + 128 * bj);
#pragma unroll
                    for (int n = 0; n < 2; ++n)
#pragma unroll
                        for (int j = 0; j < 4; ++j) { const int e = 4 * n + j; const unsigned wa = ga[e >> 1], wb = gb[e >> 1];
                            const float fa = __uint_as_float((e & 1) ? (wa & 0xffff0000u) : (wa << 16)), fb = __uint_as_float((e & 1) ? (wb & 0xffff0000u) : (wb << 16));
                            acc[ai][bj][m][n][j] *= fa * __builtin_amdgcn_rcpf(fmaxf(fb, 1e-20f)); } }
                asm volatile("" ::: "memory"); }
    }
    __device__ __forceinline__ void operator()(const pg8::f32x4 (&acc)[2][2][4][2], const pg9::Unit& u, int wr, int wc, int fr, int fq) const {
#pragma unroll
        for (int ai = 0; ai < 2; ++ai)
#pragma unroll
            for (int m = 0; m < 4; ++m) { const size_t row = (size_t)(u.pm * 256 + 128 * ai + 64 * wr + 16 * m + fr); const bf16_t* gp = GT + row * 3072 + 2048 + u.pn * 256 + 32 * wc + 8 * fq; bf16_t* yp = Y + row * 1024 + u.pn * 256 + 32 * wc + 8 * fq;
#pragma unroll
                for (int bj = 0; bj < 2; ++bj) { const pg8::u32x4 ga = *(const pg8::u32x4*)(gp + 128 * bj); float v[8];
#pragma unroll
                    for (int n = 0; n < 2; ++n)
#pragma unroll
                        for (int j = 0; j < 4; ++j) { const int e = 4 * n + j; const unsigned wa = ga[e >> 1]; v[e] = acc[ai][bj][m][n][j] * __uint_as_float((e & 1) ? (wa & 0xffff0000u) : (wa << 16)); }
                    pg8::u32x4 w; w.x = cvt_pk(v[0], v[1]); w.y = cvt_pk(v[2], v[3]); w.z = cvt_pk(v[4], v[5]); w.w = cvt_pk(v[6], v[7]); *(pg8::u32x4*)(yp + 128 * bj) = w; }
                asm volatile("" ::: "memory"); }
    }
};
struct P4Order {
    pg8::StaticOrder so; int G, c; const unsigned char* ws;
    __device__ void init(int G_, int c_, const unsigned char* ws_) { so.init(NTOK, 1024, 1, 0); G = G_; c = c_; ws = ws_; }
    __device__ bool next(int i, pg9::Unit& u) const { const int tl = i * G + c; if (tl >= 256) return false; pg8::Unit t; so.next(tl, t); u.pm = t.pm; u.pn = t.pn; u.aux = 0; u.cnt = 256; return true; }
    __device__ __forceinline__ const char* a_base(const pg9::Unit& u) const { return (const char*)(ws + WS_Y) + (size_t)u.pm * 256 * 1024 * 2; }
    __device__ __forceinline__ const char* b_base(const pg9::Unit& u) const { return (const char*)(ws + WS_WOUT) + (size_t)u.pn * 256 * 1024 * 2; }
};
struct EpiP4 {
    static constexpr bool PERM = false, CHAIN = false;
    const float* x; float* out;
    __device__ __forceinline__ void operator()(const pg8::f32x4 (&acc)[2][2][4][2], const pg9::Unit& u, int wr, int wc, int fr, int fq) const {
#pragma unroll
        for (int ai = 0; ai < 2; ++ai)
#pragma unroll
            for (int m = 0; m < 4; ++m) { const size_t off = (size_t)(u.pm * 256 + 128 * ai + 64 * wr + 16 * m + fr) * 1024 + u.pn * 256 + 32 * wc + 4 * fq;
#pragma unroll
                for (int bj = 0; bj < 2; ++bj)
#pragma unroll
                    for (int n = 0; n < 2; ++n) { const pg8::f32x4 xv = *(const pg8::f32x4*)(x + off + 128 * bj + 16 * n); *(pg8::f32x4*)(out + off + 128 * bj + 16 * n) = xv + acc[ai][bj][m][n]; }
                if (m & 1) asm volatile("" ::: "memory"); }
    }
};
__device__ __forceinline__ float wave_max64(float v) {
#pragma unroll
    for (int o = 1; o < 64; o <<= 1) v = fmaxf(v, __shfl_xor(v, o));
    return v;
}
__device__ __forceinline__ void p5_router(Frame& F, const float* X1, const float* g_ffn, const float* w_router, const float* b_router, int* COUNTS, int* LISTS) {
    bf16_t* XT = (bf16_t*)(F.ws + WS_XT); int* TOPE = (int*)(F.ws + WS_TOPE); float* TOPW = (float*)(F.ws + WS_TOPW);
    const int lane = F.lane, e = lane & 31, kq = lane >> 5, tid = F.tid;
    LAS float* wsh = (LAS float*)(F.lds);
    LAS float* xs = (LAS float*)(F.lds + 65536) + F.wave * 2048;
    for (int v = F.vcu; v < NTOK / 64; v += F.G) {
        const int tw = v * 64 + F.wave * 8;
        float acc[2][4]; float rr[2][4];
#pragma unroll
        for (int g = 0; g < 2; ++g)
#pragma unroll
            for (int q = 0; q < 4; ++q) { acc[g][q] = 0.f; rr[g][q] = 0.f; }
#pragma unroll
        for (int half = 0; half < 2; ++half) {
            __syncthreads();
#pragma unroll
            for (int i = 0; i < 8; ++i) { const int ci = tid + 512 * i; *(LAS f32x4*)(wsh + 4 * ci) = *(const f32x4*)(w_router + (size_t)half * 512 * 32 + 4 * ci); }
            __syncthreads();
#pragma unroll
            for (int g = 0; g < 2; ++g) {
                if (half == 0) {
                    f32x4 x4[4][4]; float s4[4];
#pragma unroll
                    for (int q = 0; q < 4; ++q) { const float* xr = X1 + (size_t)(tw + 4 * g + q) * 1024; s4[q] = 0.f;
#pragma unroll
                        for (int j = 0; j < 4; ++j) x4[q][j] = *(const f32x4*)(xr + 4 * lane + 256 * j); }
#pragma unroll
                    for (int q = 0; q < 4; ++q) {
#pragma unroll
                        for (int j = 0; j < 4; ++j) s4[q] += (x4[q][j].x * x4[q][j].x + x4[q][j].y * x4[q][j].y) + (x4[q][j].z * x4[q][j].z + x4[q][j].w * x4[q][j].w); }
#pragma unroll
                    for (int o_ = 1; o_ < 64; o_ <<= 1) {
#pragma unroll
                        for (int q = 0; q < 4; ++q) s4[q] += __shfl_xor(s4[q], o_); }
#pragma unroll
                    for (int q = 0; q < 4; ++q) { const int t = tw + 4 * g + q; const float r = 1.f / sqrtf(s4[q] * (1.f / 1024.f) + 1e-5f); rr[g][q] = r;
#pragma unroll
                        for (int j = 0; j < 4; ++j) { const f32x4 gg = *(const f32x4*)(g_ffn + 4 * lane + 256 * j); const f32x4 xn = x4[q][j] * r * gg;
                            uint2 w; w.x = cvt_pk(xn.x, xn.y); w.y = cvt_pk(xn.z, xn.w); *(uint2*)(XT + (size_t)t * 1024 + 4 * lane + 256 * j) = w;
                            if (j < 2) *(LAS f32x4*)(xs + q * 512 + 4 * lane + 256 * j) = xn; } }
                } else {
                    f32x4 x2[4][2];
#pragma unroll
                    for (int q = 0; q < 4; ++q)
#pragma unroll
                        for (int j = 0; j < 2; ++j) x2[q][j] = *(const f32x4*)(X1 + (size_t)(tw + 4 * g + q) * 1024 + 512 + 4 * lane + 256 * j);
#pragma unroll
                    for (int q = 0; q < 4; ++q)
#pragma unroll
                        for (int j = 0; j < 2; ++j) { const f32x4 gg = *(const f32x4*)(g_ffn + 512 + 4 * lane + 256 * j); *(LAS f32x4*)(xs + q * 512 + 4 * lane + 256 * j) = x2[q][j] * rr[g][q] * gg; }
                }
                asm volatile("s_waitcnt lgkmcnt(0)" ::: "memory");
#pragma unroll 2
                for (int k = 256 * kq; k < 256 * kq + 256; k += 4) { const float w0 = wsh[(k + 0) * 32 + e], w1 = wsh[(k + 1) * 32 + e], w2 = wsh[(k + 2) * 32 + e], w3 = wsh[(k + 3) * 32 + e];
#pragma unroll
                    for (int q = 0; q < 4; ++q) { const f32x4 x = *(const LAS f32x4*)(xs + q * 512 + k); acc[g][q] += x.x * w0 + x.y * w1 + x.z * w2 + x.w * w3; } }
                asm volatile("s_waitcnt lgkmcnt(0)" ::: "memory");
            }
        }
        volatile LAS int* lcnt = (volatile LAS int*)(F.lds + TB_OFF);
        __syncthreads();
        if (tid < 32) lcnt[tid] = 0;
        __syncthreads();
        const float bias = b_router[e];
        int my_e[2][4], my_r[2][4];
#pragma unroll
        for (int g = 0; g < 2; ++g)
#pragma unroll
            for (int q = 0; q < 4; ++q) { const int t = tw + 4 * g + q; float lg = acc[g][q] + __shfl_xor(acc[g][q], 32) + bias; if (lane >= 32) lg = -INFINITY;
                float tv[4]; int te[4];
#pragma unroll
                for (int k = 0; k < 4; ++k) { const float m = wave_max64(lg); const unsigned long long bal = __ballot(lg == m); const int ee = __ffsll((long long)bal) - 1; tv[k] = m; te[k] = ee; if (lane == ee) lg = -INFINITY; }
                float ex[4], se = 0.f;
#pragma unroll
                for (int k = 0; k < 4; ++k) { ex[k] = __expf(tv[k] - tv[0]); se += ex[k]; }
                int e_l = te[0]; float w_l = ex[0];
#pragma unroll
                for (int k = 1; k < 4; ++k) if (lane == k) { e_l = te[k]; w_l = ex[k]; }
                my_e[g][q] = e_l; my_r[g][q] = 0;
                if (lane < 4) { TOPE[t * 4 + lane] = e_l; TOPW[t * 4 + lane] = w_l / se; my_r[g][q] = __hip_atomic_fetch_add((LAS int*)(F.lds + TB_OFF) + e_l, 1, __ATOMIC_RELAXED, __HIP_MEMORY_SCOPE_WORKGROUP); } }
        __syncthreads();
        if (tid < 32) { const int c = lcnt[tid]; lcnt[32 + tid] = c ? atomicAdd(&COUNTS[tid], c) : 0; }
        __syncthreads();
#pragma unroll
        for (int g = 0; g < 2; ++g)
#pragma unroll
            for (int q = 0; q < 4; ++q) if (lane < 4) { const int t = tw + 4 * g + q; LISTS[(size_t)my_e[g][q] * 16384 + lcnt[32 + my_e[g][q]] + my_r[g][q]] = t * 4 + lane; }
    }
}
__device__ __forceinline__ void moe_tables(Frame& F) {
    volatile LAS int* TB = (volatile LAS int*)(F.lds + TB_OFF);
    if (F.tid == 0) { const int* COUNTS = (const int*)F.ctl + CW_COUNTS; int acc = 0; for (int e = 0; e < 32; ++e) { const int c = __hip_atomic_load(COUNTS + e, __ATOMIC_RELAXED, __HIP_MEMORY_SCOPE_AGENT); TB[e] = acc; TB[33 + e] = c; acc += (c + 255) >> 8; } TB[32] = acc; }
    __syncthreads();
}
template <int NPN_LOG2, size_t WOFF, int NROWS_B, int ASHIFT, size_t AOFF> struct MoeOrder {
    int perx, xcd, l; const unsigned char* ws; const LAS int* TB; const int* LISTS;
    __device__ void init(int G_, int vcu_, const unsigned char* ws_, const LAS int* TB_) { perx = G_ / 8; xcd = vcu_ / perx; l = vcu_ % perx; ws = ws_; TB = TB_; LISTS = (const int*)(ws_ + WS_LISTS); }
    __device__ bool next(int i, pg9::Unit& u) const {
        const int uidx = i * perx + l; const int mt = TB[4 * xcd] + (uidx >> NPN_LOG2); if (mt >= TB[4 * xcd + 4]) return false;
        int e = 4 * xcd;
#pragma unroll
        for (int k = 1; k < 4; ++k) if (TB[4 * xcd + k] <= mt) e = 4 * xcd + k;
        u.aux = e; u.pm = mt - TB[e]; u.pn = uidx & ((1 << NPN_LOG2) - 1); u.cnt = TB[33 + e] - u.pm * 256; return true;
    }
    __device__ __forceinline__ const char* a_base(const pg9::Unit&) const { return (const char*)(ws + AOFF); }
    __device__ __forceinline__ const char* b_base(const pg9::Unit& u) const { return (const char*)(ws + WOFF) + ((size_t)u.aux * NROWS_B + (size_t)u.pn * 256) * 1024 * 2; }
    __device__ __forceinline__ unsigned a_row_off(const pg9::Unit& u, int r) const { const int rr = r < u.cnt ? r : u.cnt - 1; const int id = LISTS[(size_t)u.aux * 16384 + u.pm * 256 + rr]; return (unsigned)(id >> ASHIFT) * 2048u; }
};
struct EpiMoe1 {
    static constexpr bool PERM = true, CHAIN = false;
    const int* LISTS; const float* b1; bf16_t* ACT;
    __device__ __forceinline__ void operator()(const pg8::f32x4 (&acc)[2][2][4][2], const pg9::Unit& u, int wr, int wc, int fr, int fq) const {
        const int e = u.aux; const int c0 = u.pn * 256 + 32 * wc + 8 * fq;
        pg8::f32x4 bv[2][2];
#pragma unroll
        for (int bj = 0; bj < 2; ++bj)
#pragma unroll
            for (int n = 0; n < 2; ++n) bv[bj][n] = *(const pg8::f32x4*)(b1 + (size_t)e * 2048 + c0 + 128 * bj + 4 * n);
#pragma unroll
        for (int ai = 0; ai < 2; ++ai)
#pragma unroll
            for (int m = 0; m < 4; ++m) { const int r = 128 * ai + 64 * wr + 16 * m + fr; const bool ok = r < u.cnt; const int id = ok ? LISTS[(size_t)e * 16384 + u.pm * 256 + r] : 0;
#pragma unroll
                for (int bj = 0; bj < 2; ++bj) { float a[4];
#pragma unroll
                    for (int n = 0; n < 2; ++n)
#pragma unroll
                        for (int p = 0; p < 2; ++p) { const float gl = fminf(acc[ai][bj][m][n][2 * p] + bv[bj][n][2 * p], 7.0f); const float li = fminf(fmaxf(acc[ai][bj][m][n][2 * p + 1] + bv[bj][n][2 * p + 1], -7.0f), 7.0f);
                            a[2 * n + p] = gl * sigmoid_f(1.702f * gl) * (li + 1.f); }
                    if (ok) { uint2 w; w.x = cvt_pk(a[0], a[1]); w.y = cvt_pk(a[2], a[3]); *(uint2*)(ACT + (size_t)id * 1024 + ((c0 + 128 * bj) >> 1)) = w; } }
                asm volatile("" ::: "memory"); }
    }
};
struct EpiMoe2 {
    static constexpr bool PERM = true, CHAIN = false;
    const int* LISTS; const float* b2; bf16_t* YS;
    __device__ __forceinline__ void operator()(const pg8::f32x4 (&acc)[2][2][4][2], const pg9::Unit& u, int wr, int wc, int fr, int fq) const {
        const int e = u.aux; const int c0 = u.pn * 256 + 32 * wc + 8 * fq;
        pg8::f32x4 bv[2][2];
#pragma unroll
        for (int bj = 0; bj < 2; ++bj)
#pragma unroll
            for (int n = 0; n < 2; ++n) bv[bj][n] = *(const pg8::f32x4*)(b2 + (size_t)e * 1024 + c0 + 128 * bj + 4 * n);
#pragma unroll
        for (int ai = 0; ai < 2; ++ai)
#pragma unroll
            for (int m = 0; m < 4; ++m) { const int r = 128 * ai + 64 * wr + 16 * m + fr; const bool ok = r < u.cnt; const int id = ok ? LISTS[(size_t)e * 16384 + u.pm * 256 + r] : 0;
#pragma unroll
                for (int bj = 0; bj < 2; ++bj) { const pg8::f32x4 v0 = acc[ai][bj][m][0] + bv[bj][0], v1 = acc[ai][bj][m][1] + bv[bj][1];
                    if (ok) { pg8::u32x4 w; w.x = cvt_pk(v0[0], v0[1]); w.y = cvt_pk(v0[2], v0[3]); w.z = cvt_pk(v1[0], v1[1]); w.w = cvt_pk(v1[2], v1[3]); *(pg8::u32x4*)(YS + (size_t)id * 1024 + c0 + 128 * bj) = w; } }
                asm volatile("" ::: "memory"); }
    }
};
__device__ __forceinline__ void p8_combine(Frame& F, const float* src, float* out) {
    const bf16_t* YS = (const bf16_t*)(F.ws + WS_YS); const float* TOPW = (const float*)(F.ws + WS_TOPW);
    const int gw = F.vcu * NWAVES + F.wave, NGW = F.G * NWAVES, lane = F.lane;
    for (int t = gw; t < NTOK; t += NGW) {
        const f32x4 w4 = *(const f32x4*)(TOPW + (size_t)t * 4);
#pragma unroll
        for (int j = 0; j < 2; ++j) {
            const int c = 8 * lane + 512 * j; f32x4 a0 = *(const f32x4*)(src + (size_t)t * 1024 + c), a1 = *(const f32x4*)(src + (size_t)t * 1024 + c + 4);
#pragma unroll
            for (int k = 0; k < 4; ++k) { const v4u y = *(const v4u*)(YS + ((size_t)t * 4 + k) * 1024 + c); const float wk = w4[k];
                a0.x += wk * __uint_as_float(y.x << 16); a0.y += wk * __uint_as_float(y.x & 0xffff0000u); a0.z += wk * __uint_as_float(y.y << 16); a0.w += wk * __uint_as_float(y.y & 0xffff0000u);
                a1.x += wk * __uint_as_float(y.z << 16); a1.y += wk * __uint_as_float(y.z & 0xffff0000u); a1.z += wk * __uint_as_float(y.w << 16); a1.w += wk * __uint_as_float(y.w & 0xffff0000u); }
            *(f32x4*)(out + (size_t)t * 1024 + c) = a0; *(f32x4*)(out + (size_t)t * 1024 + c + 4) = a1; }
    }
}
namespace att {
typedef float f32x16 __attribute__((ext_vector_type(16)));
typedef short s16x4 __attribute__((ext_vector_type(4)));
typedef short v4i16_t __attribute__((ext_vector_type(4)));
using pg8::bf16x8;
constexpr float LOG2E = 1.4426950408889634f;
__device__ __forceinline__ constexpr int crow(int r, int hi) { return (r & 3) + 8 * (r >> 2) + 4 * hi; }
template <int D> __device__ __forceinline__ int kswz(int row) { return D == 64 ? ((row >> 1) & 7) : (row & 15); }
template <int D> __device__ __forceinline__ int vswz(int row) { return D == 64 ? (((row >> 1) & 1) << 2) : ((row & 3) << 2); }
__device__ __forceinline__ s16x4 vtr(const LAS unsigned char* p) { return __builtin_bit_cast(s16x4, __builtin_amdgcn_ds_read_tr16_b64_v4i16((LAS v4i16_t*)p)); }
__device__ __forceinline__ bf16x8 pack8(const f32x16& x, int s) {
    typedef unsigned u32x4_t __attribute__((ext_vector_type(4))); u32x4_t p;
    p[0] = cvt_pk_bf16(x[8 * s + 0], x[8 * s + 1]); p[1] = cvt_pk_bf16(x[8 * s + 2], x[8 * s + 3]); p[2] = cvt_pk_bf16(x[8 * s + 4], x[8 * s + 5]); p[3] = cvt_pk_bf16(x[8 * s + 6], x[8 * s + 7]);
    return __builtin_bit_cast(bf16x8, p);
}
__device__ __forceinline__ float bfl(unsigned w) { return __uint_as_float(w << 16); }
__device__ __forceinline__ float bfh(unsigned w) { return __uint_as_float(w & 0xffff0000u); }

template <bool MOBA, int TK> __device__ __forceinline__ int tile_kbase(int tt, int qb) { constexpr int TPB = 256 / TK; if (!MOBA) return TK * tt; if (tt < TPB) return qb * 256 + TK * tt; const int u = tt - TPB; return (u / TPB) * 256 + TK * (u % TPB); }
template <int D, bool MOBA, int NSUB>
__device__ __forceinline__ void attn_unit(Frame& F, const int b, const int h, const int qb,
                                          const bf16_t* Qg, const bf16_t* Kg, const bf16_t* Vg, bf16_t* Og, const int ld,
                                          const float* KMEAN, const float* KSS, const float* gq, const float* gk) {
    constexpr int NKH = 2  , TK = 64 * NSUB  , KB = TK * D * 2, NKS = D / 16, NDH = D / 32, CPR = D / 8  , NST = (TK * CPR) / 512  ;
    int tid = F.tid, lane = F.lane; asm volatile("" : "+v"(tid), "+v"(lane));
    const int wave = F.wave, r32 = lane & 31, hi = lane >> 5;
    LAS unsigned char* lds = F.lds;
    const size_t qrow = (size_t)b * SEQ + qb * 256 + wave * 32 + r32;
    bf16x8 qr[NKS];
#pragma unroll
    for (int ks = 0; ks < NKS; ++ks) qr[ks] = *(const bf16x8*)(Qg + qrow * ld + h * D + 16 * ks + 8 * hi);
    unsigned selmask = 0u;
    if constexpr (MOBA) {
        if (qb > 0) {
            float qf[NKS * 8];
#pragma unroll
            for (int ks = 0; ks < NKS; ++ks) { const pg8::u32x4 w = __builtin_bit_cast(pg8::u32x4, qr[ks]);
#pragma unroll
                for (int j = 0; j < 4; ++j) { qf[ks * 8 + 2 * j] = bfl(w[j]); qf[ks * 8 + 2 * j + 1] = bfh(w[j]); } }
            float v0 = -INFINITY, v1 = -INFINITY, v2 = -INFINITY; int i0 = -1, i1 = -1, i2 = -1;
#pragma unroll 1
            for (int j = 0; j < qb; ++j) { const float* km = KMEAN + (((size_t)b * 16 + j) * 8 + h) * 64 + 8 * hi; float s = 0.f;
#pragma unroll
                for (int ks = 0; ks < NKS; ++ks) { const f32x4 k0 = *(const f32x4*)(km + 16 * ks), k1 = *(const f32x4*)(km + 16 * ks + 4);
                    s += qf[ks * 8 + 0] * k0[0] + qf[ks * 8 + 1] * k0[1] + qf[ks * 8 + 2] * k0[2] + qf[ks * 8 + 3] * k0[3] + qf[ks * 8 + 4] * k1[0] + qf[ks * 8 + 5] * k1[1] + qf[ks * 8 + 6] * k1[2] + qf[ks * 8 + 7] * k1[3]; }
                s += __shfl_xor(s, 32);
                const bool c0 = s > v0, c1 = s > v1, c2 = s > v2;
                v2 = c1 ? v1 : (c2 ? s : v2); i2 = c1 ? i1 : (c2 ? j : i2);
                v1 = c0 ? v0 : (c1 ? s : v1); i1 = c0 ? i0 : (c1 ? j : i1);
                v0 = c0 ? s : v0; i0 = c0 ? j : i0; }
            selmask = (i0 >= 0 ? (1u << i0) : 0u) | (i1 >= 0 ? (1u << i1) : 0u) | (i2 >= 0 ? (1u << i2) : 0u);
        }
    } else {
        float qf[NKS * 8]; float ss = 0.f;
#pragma unroll
        for (int ks = 0; ks < NKS; ++ks) { const pg8::u32x4 w = __builtin_bit_cast(pg8::u32x4, qr[ks]);
#pragma unroll
            for (int j = 0; j < 4; ++j) { qf[ks * 8 + 2 * j] = bfl(w[j]); qf[ks * 8 + 2 * j + 1] = bfh(w[j]); ss += qf[ks * 8 + 2 * j] * qf[ks * 8 + 2 * j] + qf[ks * 8 + 2 * j + 1] * qf[ks * 8 + 2 * j + 1]; } }
        ss += __shfl_xor(ss, 32);
        const float rq = (1.f / sqrtf(ss * (1.f / D) + 1e-5f)) * (0.08838834764831845f * LOG2E);
#pragma unroll
        for (int ks = 0; ks < NKS; ++ks) { const float* g1 = gq + 16 * ks + 8 * hi; const float* g2 = gk + 16 * ks + 8 * hi; pg8::u32x4 w;
#pragma unroll
            for (int j = 0; j < 4; ++j) w[j] = cvt_pk_bf16(qf[ks * 8 + 2 * j] * rq * g1[2 * j] * g2[2 * j], qf[ks * 8 + 2 * j + 1] * rq * g1[2 * j + 1] * g2[2 * j + 1]);
            qr[ks] = __builtin_bit_cast(bf16x8, w); }
    }
    constexpr int TPB = 256 / TK;
    const int NT = MOBA ? TPB * (qb + 1) : TPB;
    const float sl2 = MOBA ? exp2f(-(float)(h + 1)) * LOG2E : 0.f;
    v4u kreg[NST], vreg[NST];
#define ATT_LOAD(tt) do { const int kb_ = tile_kbase<MOBA, TK>(tt, qb); _Pragma("unroll") for (int i_ = 0; i_ < NST; ++i_) { const int ci_ = tid + 512 * i_, row_ = ci_ / CPR, ch_ = ci_ % CPR; \
        const size_t g_ = (size_t)(kb_ + row_) * ld + h * D + 8 * ch_; kreg[i_] = *(const v4u*)(Kg + g_); vreg[i_] = *(const v4u*)(Vg + g_); \
        if (!MOBA) { const float rk_ = 1.f / sqrtf(KSS[(size_t)(kb_ + row_) * 4 + h] * (1.f / D) + 1e-5f); v4u k_ = kreg[i_]; \
            k_.x = cvt_pk_bf16(bfl(k_.x) * rk_, bfh(k_.x) * rk_); k_.y = cvt_pk_bf16(bfl(k_.y) * rk_, bfh(k_.y) * rk_); k_.z = cvt_pk_bf16(bfl(k_.z) * rk_, bfh(k_.z) * rk_); k_.w = cvt_pk_bf16(bfl(k_.w) * rk_, bfh(k_.w) * rk_); kreg[i_] = k_; } } } while (0)
#define ATT_WRITE(buf) do { _Pragma("unroll") for (int i_ = 0; i_ < NST; ++i_) { const int ci_ = tid + 512 * i_, row_ = ci_ / CPR, ch_ = ci_ % CPR; \
        *(LAS v4u*)(lds + (buf) * KB + row_ * (2 * D) + ((ch_ ^ kswz<D>(row_)) << 4)) = kreg[i_]; *(LAS v4u*)(lds + (2 + (buf)) * KB + row_ * (2 * D) + ((ch_ ^ vswz<D>(row_)) << 4)) = vreg[i_]; } } while (0)
    ATT_LOAD(0); ATT_WRITE(0);
    __syncthreads();
    float m = -1e30f, l = 0.f;
    f32x16 o[NDH];
#pragma unroll
    for (int dh = 0; dh < NDH; ++dh)
#pragma unroll
        for (int r = 0; r < 16; ++r) o[dh][r] = 0.f;
    const int qrel = wave * 32 + r32;
    for (int tt = 0; tt < NT; ++tt) {
        int lane_t = lane; asm volatile("" : "+v"(lane_t));
        const int r32 = lane_t & 31, hi = lane_t >> 5, i16 = lane_t & 15, blk = (lane_t >> 4) & 1, tq = i16 >> 2, tp = i16 & 3;
        const int buf = tt & 1;
        if (tt + 1 < NT) ATT_LOAD(tt + 1);
#pragma unroll 1
        for (int sub = 0; sub < NSUB; ++sub) {
        bool act = true; bool lane_sel = true; int pblk = -1;
        if constexpr (MOBA) { if (tt >= TPB) { pblk = (tt - TPB) / TPB; lane_sel = (selmask >> pblk) & 1u; act = __builtin_amdgcn_ballot_w64(lane_sel) != 0ull; }
            else act = (TK * tt + 64 * sub <= wave * 32 + 31); }
        if (act) {
            f32x16 p[NKH];
#pragma unroll
            for (int kh = 0; kh < NKH; ++kh)
#pragma unroll
                for (int r = 0; r < 16; ++r) p[kh][r] = 0.f;
            const LAS unsigned char* Kb = lds + buf * KB + sub * 64 * (2 * D);
#pragma unroll
            for (int ks = 0; ks < NKS; ++ks) {
#pragma unroll
                for (int kh = 0; kh < NKH; ++kh) { const int row = 32 * kh + r32;
                    const bf16x8 a = *(const LAS bf16x8*)(Kb + row * (2 * D) + (((2 * ks + hi) ^ kswz<D>(row)) << 4));
                    p[kh] = __builtin_amdgcn_mfma_f32_32x32x16_bf16(a, qr[ks], p[kh], 0, 0, 0); }
            }
            if constexpr (MOBA) {
                const int kb = tile_kbase<MOBA, TK>(tt, qb) + 64 * sub; const float offl = sl2 * (float)(kb - qb * 256 + 4 * hi);
#pragma unroll
                for (int kh = 0; kh < NKH; ++kh)
#pragma unroll
                    for (int r = 0; r < 16; ++r) p[kh][r] += sl2 * (float)(32 * kh + (r & 3) + 8 * (r >> 2)) + offl;
                if (tt < TPB) {
                    const int k0 = TK * tt + 64 * sub + 4 * hi;
#pragma unroll
                    for (int kh = 0; kh < NKH; ++kh)
#pragma unroll
                        for (int r = 0; r < 16; ++r) { const int kv = k0 + 32 * kh + (r & 3) + 8 * (r >> 2); if (kv > qrel) p[kh][r] = -INFINITY; }
                } else if (!lane_sel) {
#pragma unroll
                    for (int kh = 0; kh < NKH; ++kh)
#pragma unroll
                        for (int r = 0; r < 16; ++r) p[kh][r] = -INFINITY;
                }
            }
            float mx = p[0][0];
#pragma unroll
            for (int kh = 0; kh < NKH; ++kh)
#pragma unroll
                for (int r = 0; r < 16; ++r) mx = fmaxf(mx, p[kh][r]);
            mx = fmaxf(mx, __shfl_xor(mx, 32));
            const float mnew = fmaxf(m, mx);
            if (__builtin_amdgcn_ballot_w64(mnew > m) != 0ull) { const float alpha = __builtin_amdgcn_exp2f(m - mnew); l *= alpha;
#pragma unroll
                for (int dh = 0; dh < NDH; ++dh)
#pragma unroll
                    for (int r = 0; r < 16; ++r) o[dh][r] *= alpha;
                m = mnew; }
            float ps = 0.f;
#pragma unroll
            for (int kh = 0; kh < NKH; ++kh)
#pragma unroll
                for (int r = 0; r < 16; ++r) { p[kh][r] = __builtin_amdgcn_exp2f(p[kh][r] - m); ps += p[kh][r]; }
            l += ps;
            const LAS unsigned char* Vb = lds + (2 + buf) * KB + sub * 64 * (2 * D);
#pragma unroll
            for (int kh = 0; kh < NKH; ++kh)
#pragma unroll
                for (int s = 0; s < 2; ++s) {
                    const bf16x8 pb = pack8(p[kh], s);
#pragma unroll
                    for (int dh = 0; dh < NDH; ++dh) {
                        const int rowA = 32 * kh + 16 * s + 4 * hi + tq, rowB = rowA + 8, chv = 4 * dh + 2 * blk + (tp >> 1);
                        const s16x4 lo = vtr(Vb + rowA * (2 * D) + ((chv ^ vswz<D>(rowA)) << 4) + 8 * (tp & 1));
                        const s16x4 hh = vtr(Vb + rowB * (2 * D) + ((chv ^ vswz<D>(rowB)) << 4) + 8 * (tp & 1));
                        const bf16x8 va = (bf16x8){lo[0], lo[1], lo[2], lo[3], hh[0], hh[1], hh[2], hh[3]};
                        o[dh] = __builtin_amdgcn_mfma_f32_32x32x16_bf16(va, pb, o[dh], 0, 0, 0);
                    }
                }
        }
        }
        if (tt + 1 < NT) ATT_WRITE(buf ^ 1);
        __syncthreads();
    }
    l += __shfl_xor(l, 32);
    const float inv = 1.f / l;
    bf16_t* orow = Og + qrow * ld + h * D;
#pragma unroll
    for (int dh = 0; dh < NDH; ++dh)
#pragma unroll
        for (int g = 0; g < 4; ++g) { uint2 w; w.x = cvt_pk_bf16(o[dh][4 * g] * inv, o[dh][4 * g + 1] * inv); w.y = cvt_pk_bf16(o[dh][4 * g + 2] * inv, o[dh][4 * g + 3] * inv);
            *(uint2*)(orow + 32 * dh + 8 * g + 4 * hi) = w; }
#undef ATT_LOAD
#undef ATT_WRITE
}
}
__device__ __forceinline__ void p2_moba(Frame& F) {
    const bf16_t* MQ = (const bf16_t*)(F.ws + WS_MQ); const bf16_t* MK = (const bf16_t*)(F.ws + WS_MK); const bf16_t* MV = (const bf16_t*)(F.ws + WS_MV); bf16_t* OM = (bf16_t*)(F.ws + WS_OMOBA);
    for (int pr = F.vcu; pr < 256; pr += F.G) { const int bh = pr >> 3, p = pr & 7, b = bh >> 3, h = bh & 7;
#pragma unroll 1
        for (int k = 0; k < 2; ++k) { const int qb = k ? 15 - p : p;
            att::attn_unit<64, true, 2>(F, b, h, qb, MQ, MK + (size_t)b * SEQ * 512, MV + (size_t)b * SEQ * 512, OM, 512, (const float*)(F.ctl + CW_KMEAN), nullptr, nullptr, nullptr); } }
}
__device__ __forceinline__ void p2_mem(Frame& F, const float* g_mem_q, const float* g_mem_k) {
    const bf16_t* CQ = (const bf16_t*)(F.ws + WS_CQ); const bf16_t* MEMK = (const bf16_t*)(F.ws + WS_MEMK); const bf16_t* MEMV = (const bf16_t*)(F.ws + WS_MEMV); bf16_t* OM = (bf16_t*)(F.ws + WS_OMEM);
#pragma unroll 1
    for (int u = F.vcu; u < 256; u += F.G) { const int bh = u >> 4, qb = u & 15, b = bh >> 2, h = bh & 3;
        att::attn_unit<128, false, 1>(F, b, h, qb, CQ, MEMK + (size_t)b * MEMLEN * 512, MEMV + (size_t)b * MEMLEN * 512, OM, 512, nullptr, (const float*)(F.ctl + CW_MEMKSS) + (size_t)b * MEMLEN * 4, g_mem_q, g_mem_k); }
}
namespace ret {
using att::f32x16; using att::s16x4; using att::vtr; using att::pack8; using att::kswz; using att::vswz; using att::crow; using pg8::bf16x8;
constexpr int L_KT = 0, L_KD = 16384, L_VT = 32768, L_SB = 65536, L_SS = 98304, L_G = 99328;
__device__ __forceinline__ void retention_item(Frame& F, const int b, const int h, const float* g_ret_out) {
    const bf16_t* RQ = (const bf16_t*)(F.ws + WS_RQ); const bf16_t* RK = (const bf16_t*)(F.ws + WS_RK); const bf16_t* RV = (const bf16_t*)(F.ws + WS_RV); const bf16_t* RG = (const bf16_t*)(F.ws + WS_RG); bf16_t* ORET = (bf16_t*)(F.ws + WS_ORET);
    int tid = F.tid, lane = F.lane; asm volatile("" : "+v"(tid), "+v"(lane));
    const int wave = F.wave;
    LAS unsigned char* lds = F.lds;
    const float lg2_o = log2f(1.f - exp2f(-5.f - (float)h)), g128 = exp2f(128.f * lg2_o);
    const size_t tok0 = (size_t)b * SEQ;
    v4u kreg[2], vreg[4];
#define RET_LOAD(n) do { _Pragma("unroll") for (int i_ = 0; i_ < 2; ++i_) { const int ci_ = tid + 512 * i_; kreg[i_] = *(const v4u*)(RK + (tok0 + (n) * 128 + (ci_ >> 3)) * 256 + h * 64 + 8 * (ci_ & 7)); } \
        _Pragma("unroll") for (int i_ = 0; i_ < 4; ++i_) { const int ci_ = tid + 512 * i_; vreg[i_] = *(const v4u*)(RV + (tok0 + (n) * 128 + (ci_ >> 4)) * 512 + h * 128 + 8 * (ci_ & 15)); } } while (0)
#define RET_WRITE() do { _Pragma("unroll") for (int i_ = 0; i_ < 2; ++i_) { const int ci_ = tid + 512 * i_, row_ = ci_ >> 3, ch_ = ci_ & 7; const v4u k_ = kreg[i_]; \
            *(LAS v4u*)(lds + L_KT + row_ * 128 + ((ch_ ^ kswz<64>(row_)) << 4)) = k_; const float dk_ = __builtin_amdgcn_exp2f(lg2 * (float)(127 - row_)); v4u d_; \
            d_.x = cvt_pk_bf16(att::bfl(k_.x) * dk_, att::bfh(k_.x) * dk_); d_.y = cvt_pk_bf16(att::bfl(k_.y) * dk_, att::bfh(k_.y) * dk_); d_.z = cvt_pk_bf16(att::bfl(k_.z) * dk_, att::bfh(k_.z) * dk_); d_.w = cvt_pk_bf16(att::bfl(k_.w) * dk_, att::bfh(k_.w) * dk_); \
            *(LAS v4u*)(lds + L_KD + row_ * 128 + ((ch_ ^ vswz<64>(row_)) << 4)) = d_; } \
        _Pragma("unroll") for (int i_ = 0; i_ < 4; ++i_) { const int ci_ = tid + 512 * i_, row_ = ci_ >> 4, ch_ = ci_ & 15; *(LAS v4u*)(lds + L_VT + row_ * 256 + ((ch_ ^ vswz<128>(row_)) << 4)) = vreg[i_]; } } while (0)
    { const float lg2 = lg2_o; RET_LOAD(0); RET_WRITE(); }
    { const v4u z = {0u, 0u, 0u, 0u}; *(LAS v4u*)(lds + L_SB + tid * 32) = z; *(LAS v4u*)(lds + L_SB + tid * 32 + 16) = z; }
    f32x16 st;
#pragma unroll
    for (int r = 0; r < 16; ++r) st[r] = 0.f;
    const int ib = wave & 3, e2 = wave >> 2;
    LAS float* ssb = (LAS float*)(lds + L_SS);
    if (tid < 128) ((LAS float*)(lds + L_G))[tid] = g_ret_out[tid];
    bf16x8 qn[4];
    { const size_t tr0 = tok0 + 32 * ib + (lane & 31);
#pragma unroll
      for (int ks = 0; ks < 4; ++ks) qn[ks] = *(const bf16x8*)(RQ + tr0 * 256 + h * 64 + 16 * ks + 8 * (lane >> 5)); }
    __syncthreads();
    for (int n = 0; n < 32; ++n) {
        int lane_n = lane; float lg2 = lg2_o; asm volatile("" : "+v"(lane_n), "+v"(lg2));
        const int r32 = lane_n & 31, hi = lane_n >> 5, i16 = lane_n & 15, blk = (lane_n >> 4) & 1, tq = i16 >> 2, tp = i16 & 3;
        if (n + 1 < 32) RET_LOAD(n + 1);
        const LAS unsigned char* Sb = lds + L_SB + (n & 1) * 16384; LAS unsigned char* Sn = lds + L_SB + ((n + 1) & 1) * 16384;
        const size_t tokrow = tok0 + n * 128 + 32 * ib + r32;
        f32x16 o[2];
        uint2 rgv[8];
#pragma unroll
        for (int q2 = 0; q2 < 2; ++q2)
#pragma unroll
            for (int g = 0; g < 4; ++g) rgv[q2 * 4 + g] = *(const uint2*)(RG + tokrow * 512 + h * 128 + 64 * e2 + 32 * q2 + 8 * g + 4 * hi);
        {
            bf16x8 qr[4];
#pragma unroll
            for (int ks = 0; ks < 4; ++ks) qr[ks] = qn[ks];
            if (n + 1 < 32) {
#pragma unroll
                for (int ks = 0; ks < 4; ++ks) qn[ks] = *(const bf16x8*)(RQ + (tokrow + 128) * 256 + h * 64 + 16 * ks + 8 * hi); }
#pragma unroll
            for (int q2 = 0; q2 < 2; ++q2) {
#pragma unroll
                for (int r = 0; r < 16; ++r) o[q2][r] = 0.f;
                const int e = 64 * e2 + 32 * q2 + r32;
#pragma unroll
                for (int ks = 0; ks < 4; ++ks) { const bf16x8 a = *(const LAS bf16x8*)(Sb + e * 128 + (((2 * ks + hi) ^ kswz<64>(e)) << 4)); o[q2] = __builtin_amdgcn_mfma_f32_32x32x16_bf16(a, qr[ks], o[q2], 0, 0, 0); } }
            const float gq = __builtin_amdgcn_exp2f(lg2 * (float)(32 * ib + r32 + 1));
#pragma unroll
            for (int q2 = 0; q2 < 2; ++q2)
#pragma unroll
                for (int r = 0; r < 16; ++r) o[q2][r] *= gq;
            __builtin_amdgcn_sched_barrier(0);
#pragma unroll 1
            for (int jb = 0; jb <= ib; ++jb) {
                f32x16 p;
#pragma unroll
                for (int r = 0; r < 16; ++r) p[r] = 0.f;
                const int krow_ = 32 * jb + r32;
#pragma unroll
                for (int ks = 0; ks < 4; ++ks) { const bf16x8 a = *(const LAS bf16x8*)(lds + L_KT + krow_ * 128 + (((2 * ks + hi) ^ kswz<64>(krow_)) << 4)); p = __builtin_amdgcn_mfma_f32_32x32x16_bf16(a, qr[ks], p, 0, 0, 0); }
                const float cl = __builtin_amdgcn_exp2f(lg2 * (float)(32 * (ib - jb) + r32 - 4 * hi));
                const bool diag = (jb == ib);
#pragma unroll
                for (int r = 0; r < 16; ++r) { float v = p[r] * (cl * __builtin_amdgcn_exp2f(-lg2 * (float)((r & 3) + 8 * (r >> 2)))); if (diag && ((r & 3) + 8 * (r >> 2) + 4 * hi) > r32) v = 0.f; p[r] = v; }
#pragma unroll
                for (int s = 0; s < 2; ++s) { const bf16x8 pb = pack8(p, s);
                    const int rowA = 32 * jb + 16 * s + 4 * hi + tq, rowB = rowA + 8;
#pragma unroll
                    for (int q2 = 0; q2 < 2; ++q2) { const int chv = 4 * (2 * e2 + q2) + 2 * blk + (tp >> 1);
                        const s16x4 lo = vtr(lds + L_VT + rowA * 256 + ((chv ^ vswz<128>(rowA)) << 4) + 8 * (tp & 1));
                        const s16x4 hh = vtr(lds + L_VT + rowB * 256 + ((chv ^ vswz<128>(rowB)) << 4) + 8 * (tp & 1));
                        const bf16x8 va = (bf16x8){lo[0], lo[1], lo[2], lo[3], hh[0], hh[1], hh[2], hh[3]};
                        o[q2] = __builtin_amdgcn_mfma_f32_32x32x16_bf16(va, pb, o[q2], 0, 0, 0); }
                    __builtin_amdgcn_sched_barrier(0); }
            }
        }
        __builtin_amdgcn_sched_barrier(0);
        { float ss = 0.f;
#pragma unroll
            for (int q2 = 0; q2 < 2; ++q2)
#pragma unroll
                for (int r = 0; r < 16; ++r) ss += o[q2][r] * o[q2][r];
            ss += __shfl_xor(ss, 32);
            if (hi == 0) ssb[e2 * 128 + 32 * ib + r32] = ss; }
        __builtin_amdgcn_sched_barrier(0);
        { const int eh = wave & 3, dh = wave >> 2;
#pragma unroll
            for (int r = 0; r < 16; ++r) st[r] *= g128;
#pragma unroll 1
            for (int kst = 0; kst < 8; ++kst) { const int rowA = 16 * kst + 4 * hi + tq, rowB = rowA + 8, chv = 4 * eh + 2 * blk + (tp >> 1), chk = 4 * dh + 2 * blk + (tp >> 1);
                const s16x4 lo = vtr(lds + L_VT + rowA * 256 + ((chv ^ vswz<128>(rowA)) << 4) + 8 * (tp & 1));
                const s16x4 hh = vtr(lds + L_VT + rowB * 256 + ((chv ^ vswz<128>(rowB)) << 4) + 8 * (tp & 1));
                const s16x4 kl = vtr(lds + L_KD + rowA * 128 + ((chk ^ vswz<64>(rowA)) << 4) + 8 * (tp & 1));
                const s16x4 kh = vtr(lds + L_KD + rowB * 128 + ((chk ^ vswz<64>(rowB)) << 4) + 8 * (tp & 1));
                const bf16x8 va = (bf16x8){lo[0], lo[1], lo[2], lo[3], hh[0], hh[1], hh[2], hh[3]};
                const bf16x8 kb = (bf16x8){kl[0], kl[1], kl[2], kl[3], kh[0], kh[1], kh[2], kh[3]};
                st = __builtin_amdgcn_mfma_f32_32x32x16_bf16(va, kb, st, 0, 0, 0); }
#pragma unroll
            for (int r = 0; r < 16; ++r) { const int e = 32 * eh + (r & 3) + 8 * (r >> 2) + 4 * hi, dd = 32 * dh + r32;
                *(LAS bf16_t*)(Sn + e * 128 + ((((dd >> 3) ^ kswz<64>(e))) << 4) + (dd & 7) * 2) = f2bf(st[r]); } }
        __builtin_amdgcn_sched_barrier(0);
        __syncthreads();
        { const float rn = 1.f / sqrtf((ssb[32 * ib + r32] + ssb[128 + 32 * ib + r32]) * (1.f / 128.f) + 1e-5f);
#pragma unroll
            for (int q2 = 0; q2 < 2; ++q2)
#pragma unroll
                for (int g = 0; g < 4; ++g) { const int e = 64 * e2 + 32 * q2 + 8 * g + 4 * hi; const f32x4 gg = *(const LAS f32x4*)(lds + L_G + 4 * e); const uint2 rg = rgv[q2 * 4 + g];
                    uint2 w; w.x = cvt_pk_bf16(o[q2][4 * g] * rn * gg[0] * att::bfl(rg.x), o[q2][4 * g + 1] * rn * gg[1] * att::bfh(rg.x)); w.y = cvt_pk_bf16(o[q2][4 * g + 2] * rn * gg[2] * att::bfl(rg.y), o[q2][4 * g + 3] * rn * gg[3] * att::bfh(rg.y));
                    *(uint2*)(ORET + tokrow * 512 + h * 128 + e) = w; } }
        if (n + 1 < 32) RET_WRITE();
        __syncthreads();
    }
#undef RET_LOAD
#undef RET_WRITE
}
}
constexpr int CW_QUEUE = 128;
__device__ __forceinline__ void p2_mixers(Frame& F, const float* g_ret_out, const float* g_mem_q, const float* g_mem_k, const float* w1, const float* w2, const int qword, const int qlo, const int qhi, const int tmask) {
    volatile LAS int* slot = (volatile LAS int*)(F.lds + TB_OFF + 512);
    const bf16_t* MQ = (const bf16_t*)(F.ws + WS_MQ); const bf16_t* MK = (const bf16_t*)(F.ws + WS_MK); const bf16_t* MV = (const bf16_t*)(F.ws + WS_MV); bf16_t* OMO = (bf16_t*)(F.ws + WS_OMOBA);
    const bf16_t* CQ = (const bf16_t*)(F.ws + WS_CQ); const bf16_t* MEMK = (const bf16_t*)(F.ws + WS_MEMK); const bf16_t* MEMV = (const bf16_t*)(F.ws + WS_MEMV); bf16_t* OME = (bf16_t*)(F.ws + WS_OMEM);
    for (;;) {
        __syncthreads();
        if (F.tid == 0) slot[0] = (int)__hip_atomic_fetch_add((unsigned*)F.ctl + qword, 1u, __ATOMIC_RELAXED, __HIP_MEMORY_SCOPE_AGENT);
        __syncthreads();
        const int it = slot[0] + qlo;
        if (it >= qhi) break;
        if (it < 16) { if (tmask & 1) ret::retention_item(F, it >> 2, it & 3, g_ret_out); continue; }
        const int j = it - 16, grp = j / 7, pos = j % 7;
        if (pos & 1) { const int a = 3 * grp + (pos >> 1);
            if (a < 512) { if (!(tmask & 2)) continue; const int qb = 15 - (a >> 5), bh = a & 31, b = bh >> 3, h = bh & 7;
                att::attn_unit<64, true, 2>(F, b, h, qb, MQ, MK + (size_t)b * SEQ * 512, MV + (size_t)b * SEQ * 512, OMO, 512, (const float*)(F.ctl + CW_KMEAN), nullptr, nullptr, nullptr); }
            else { if (!(tmask & 4)) continue; const int u = a - 512, bh = u >> 4, qb = u & 15, b = bh >> 2, h = bh & 3;
                att::attn_unit<128, false, 1>(F, b, h, qb, CQ, MEMK + (size_t)b * MEMLEN * 512, MEMV + (size_t)b * MEMLEN * 512, OME, 512, nullptr, (const float*)(F.ctl + CW_MEMKSS) + (size_t)b * MEMLEN * 4, g_mem_q, g_mem_k); }
        } else { if (!(tmask & 8)) continue; const int c = 4 * grp + (pos >> 1);
            LAS float* scr = (LAS float*)(F.lds + RING_OFF + F.wave * 16384);
            const bool isw1 = c < 512; const int cc = isw1 ? c : c - 512, e = cc >> 4, kb = cc & 15, nblk = isw1 ? 64 : 32, N = isw1 ? 2048 : 1024;
            const float* Wsrc = isw1 ? w1 + (size_t)e * 1024 * 2048 : w2 + (size_t)e * 1024 * 1024;
            bf16* WT = isw1 ? (bf16*)(F.ws + WS_W1) + (size_t)e * 2048 * 1024 : (bf16*)(F.ws + WS_W2) + (size_t)e * 1024 * 1024;
            float wa[32], wb[32];
            xp_load(wa, Wsrc, N, nblk, kb * nblk + F.wave, F.lane);
#pragma unroll 1
            for (int nb = F.wave; nb < nblk; nb += 16) {
                xp_load(wb, Wsrc, N, nblk, kb * nblk + nb + 8, F.lane);
                xp_finish(wa, 1024, nblk, WT, scr, kb * nblk + nb, F.lane);
                if (nb + 16 < nblk) xp_load(wa, Wsrc, N, nblk, kb * nblk + nb + 16, F.lane);
                xp_finish(wb, 1024, nblk, WT, scr, kb * nblk + nb + 8, F.lane);
            }
        }
    }
}
#define WAVE_LDS_FENCE() do { asm volatile("s_waitcnt lgkmcnt(0)" ::: "memory"); } while (0)
__device__ __forceinline__ void p2_moba_slow(Frame& F) {
    const bf16_t* MQ = (const bf16_t*)(F.ws + WS_MQ); const bf16_t* MK = (const bf16_t*)(F.ws + WS_MK); const bf16_t* MV = (const bf16_t*)(F.ws + WS_MV); const float* KMEAN = (const float*)(F.ctl + CW_KMEAN); bf16_t* OMOBA = (bf16_t*)(F.ws + WS_OMOBA);
    LAS float* sc = (LAS float*)(F.lds) + F.wave * 1152; LAS float* qsh = sc + 1024;
    const int gw = F.vcu * NWAVES + F.wave, NGW = F.G * NWAVES, lane = F.lane;
    for (int w = gw; w < NB * 8 * SEQ; w += NGW) {
        const int t = w & 4095, h = (w >> 12) & 7, b = w >> 15; const int qb = t >> 8; const size_t row = (size_t)b * 4096 + t;
        qsh[lane] = bf2f(MQ[row * 512 + h * 64 + lane]);
        WAVE_LDS_FENCE();
        float q[64];
#pragma unroll
        for (int d = 0; d < 64; ++d) q[d] = qsh[d];
        float gsc = -INFINITY; if (lane < qb) { const float* km = KMEAN + (((size_t)b * 16 + lane) * 8 + h) * 64; float s = 0.f;
#pragma unroll
            for (int d = 0; d < 64; ++d) s += q[d] * km[d];
            gsc = s; }
        int sel[4]; sel[0] = qb;
#pragma unroll
        for (int r = 0; r < 3; ++r) { const float m = wave_max64(gsc); int j = -1; if (m != -INFINITY) { const unsigned long long bal = __ballot(gsc == m); j = __ffsll((long long)bal) - 1; } sel[r + 1] = j; if (lane == j) gsc = -INFINITY; }
        const float slope = exp2f(-(float)(h + 1)); float mx = -INFINITY;
#pragma unroll
        for (int s = 0; s < 4; ++s) { const int blk = sel[s];
            for (int c = 0; c < 4; ++c) { const int kp = blk * 256 + c * 64 + lane; float v = -INFINITY;
                if (blk >= 0 && kp <= t) { const bf16_t* kr = MK + ((size_t)b * 4096 + kp) * 512 + h * 64; float d_ = 0.f;
#pragma unroll
                    for (int d = 0; d < 64; ++d) d_ += q[d] * bf2f(kr[d]);
                    v = d_ * 0.125f - slope * (float)(t - kp); }
                sc[s * 256 + c * 64 + lane] = v; mx = fmaxf(mx, v); } }
        mx = wave_max64(mx); float sum = 0.f;
        for (int i = lane; i < 1024; i += 64) { const float p = __expf(sc[i] - mx); sc[i] = p; sum += p; }
        sum = wave_sum64(sum);
        WAVE_LDS_FENCE();
        float o = 0.f;
#pragma unroll
        for (int s = 0; s < 4; ++s) { const int blk = sel[s]; if (blk >= 0) for (int k = 0; k < 256; ++k) { const float p = sc[s * 256 + k]; if (p != 0.f) o += p * bf2f(MV[((size_t)b * 4096 + blk * 256 + k) * 512 + h * 64 + lane]); } }
        OMOBA[row * 512 + h * 64 + lane] = f2bf(o / sum);
        WAVE_LDS_FENCE();
    }
}
__device__ __forceinline__ void p2_mem_slow(Frame& F, const float* g_mem_q, const float* g_mem_k) {
    const bf16_t* CQ = (const bf16_t*)(F.ws + WS_CQ); const bf16_t* MEMK = (const bf16_t*)(F.ws + WS_MEMK); const bf16_t* MEMV = (const bf16_t*)(F.ws + WS_MEMV); const float* MEMKSS = (const float*)(F.ctl + CW_MEMKSS); bf16_t* OMEM = (bf16_t*)(F.ws + WS_OMEM);
    LAS float* sc = (LAS float*)(F.lds) + F.wave * 1152; LAS float* qsh = sc + 1024;
    const int gw = F.vcu * NWAVES + F.wave, NGW = F.G * NWAVES, lane = F.lane;
    for (int w = gw; w < NB * 4 * SEQ; w += NGW) {
        const int t = w & 4095, h = (w >> 12) & 3, b = w >> 14; const size_t row = (size_t)b * 4096 + t;
        const float q0 = bf2f(CQ[row * 512 + h * 128 + lane]), q1 = bf2f(CQ[row * 512 + h * 128 + 64 + lane]);
        const float rq = 1.f / sqrtf(wave_sum64(q0 * q0 + q1 * q1) * (1.f / 128.f) + 1e-5f);
        qsh[lane] = q0 * rq * g_mem_q[lane] * g_mem_k[lane]; qsh[lane + 64] = q1 * rq * g_mem_q[lane + 64] * g_mem_k[lane + 64];
        WAVE_LDS_FENCE();
        float mx = -INFINITY;
        for (int c = 0; c < 4; ++c) { const int m = c * 64 + lane; const bf16_t* kr = MEMK + ((size_t)b * 256 + m) * 512 + h * 128; float d_ = 0.f; for (int d = 0; d < 128; ++d) d_ += qsh[d] * bf2f(kr[d]);
            const float rk = 1.f / sqrtf(MEMKSS[((size_t)b * 256 + m) * 4 + h] * (1.f / 128.f) + 1e-5f); const float v = d_ * rk * 0.08838834764831845f; sc[m] = v; mx = fmaxf(mx, v); }
        mx = wave_max64(mx); float sum = 0.f;
        for (int i = lane; i < 256; i += 64) { const float p = __expf(sc[i] - mx); sc[i] = p; sum += p; }
        sum = wave_sum64(sum); WAVE_LDS_FENCE();
        float o0 = 0.f, o1 = 0.f;
        for (int k = 0; k < 256; ++k) { const float p = sc[k]; const bf16_t* vr = MEMV + ((size_t)b * 256 + k) * 512 + h * 128; o0 += p * bf2f(vr[lane]); o1 += p * bf2f(vr[lane + 64]); }
        OMEM[row * 512 + h * 128 + lane] = f2bf(o0 / sum); OMEM[row * 512 + h * 128 + 64 + lane] = f2bf(o1 / sum);
        WAVE_LDS_FENCE();
    }
}
__device__ __forceinline__ void p2_ret_slow(Frame& F, const float* g_ret_out) {
    const bf16_t* RQ = (const bf16_t*)(F.ws + WS_RQ); const bf16_t* RK = (const bf16_t*)(F.ws + WS_RK); const bf16_t* RV = (const bf16_t*)(F.ws + WS_RV); const bf16_t* RG = (const bf16_t*)(F.ws + WS_RG); bf16_t* ORET = (bf16_t*)(F.ws + WS_ORET);
    LAS float* qs = (LAS float*)(F.lds) + 16384; LAS float* ks = qs + 64; LAS float* part = ks + 64; LAS float* red = part + 256;
    const int tid = F.tid, e = tid & 127, hf = (tid >> 7) & 1;
    for (int it = F.vcu; it < 16; it += F.G) {
        const int b = it >> 2, h = it & 3; const float gamma = 1.f - exp2f(-5.f - (float)h);
        float s[32];
#pragma unroll
        for (int i = 0; i < 32; ++i) s[i] = 0.f;
        for (int t = 0; t < 4096; ++t) { const size_t row = (size_t)b * 4096 + t;
            if (tid < 64) qs[tid] = bf2f(RQ[row * 256 + h * 64 + tid]); else if (tid < 128) ks[tid - 64] = bf2f(RK[row * 256 + h * 64 + tid - 64]);
            const float v = bf2f(RV[row * 512 + h * 128 + e]);
            __syncthreads();
            float o = 0.f;
            if (tid < 256) {
#pragma unroll
                for (int i = 0; i < 32; ++i) { s[i] = gamma * s[i] + ks[hf * 32 + i] * v; o += qs[hf * 32 + i] * s[i]; }
                part[tid] = o; }
            __syncthreads();
            float ov = 0.f;
            if (tid < 128) { ov = part[tid] + part[tid + 128]; const float ss = wave_sum64(ov * ov); if ((tid & 63) == 0) red[tid >> 6] = ss; }
            __syncthreads();
            if (tid < 128) { const float r = 1.f / sqrtf((red[0] + red[1]) * (1.f / 128.f) + 1e-5f); ORET[row * 512 + h * 128 + tid] = f2bf(ov * r * g_ret_out[tid] * bf2f(RG[row * 512 + h * 128 + tid])); }
        }
    }
}
constexpr int N_PHASES = 9;
#ifndef PROBE_MASK
#define PROBE_MASK 0
#endif
constexpr int P2_NITEMS = 16 + 7 * 256;
#ifndef P2_LO
#define P2_LO 0
#define P2_HI P2_NITEMS
#endif
#ifndef P2_TMASK
#define P2_TMASK 15
#endif
#define NREP(k) ((((PROBE_MASK) >> (k)) & 1) ? 2 : 1)
__global__ void __launch_bounds__(NWAVES * 64, 2) mega(Args args) {
    extern __shared__ __attribute__((aligned(16))) unsigned char lds[];
    Frame F;
    F.lds = (LAS unsigned char*)lds; F.MISC = (volatile LAS unsigned*)(F.lds + MISC_OFF);
    F.tid = threadIdx.x; F.lane = F.tid & 63; F.wave = __builtin_amdgcn_readfirstlane(F.tid >> 6);
    F.G = gridDim.x; { const int bx = blockIdx.x; F.vcu = (F.G % 8 == 0) ? (bx % 8) * (F.G / 8) + bx / 8 : bx; }
    F.ws = args.ws; F.out = args.out; F.ctl = (gu32*)(args.ws + WS_CTL);
    for (int u = F.tid; u < (LDS_BYTES - LDSCTL_OFF) / 4; u += NWAVES * 64) ((LAS unsigned*)(F.lds + LDSCTL_OFF))[u] = 0u;
    __syncthreads();
    XcdBarrier bar = xcd_barrier_post((unsigned*)(F.ctl + CW_BAR) + args.li * XCD_BAR_WORDS, F.MISC + 8);
    const int lo = args.ph_lo, hi = args.ph_hi;
#define IN(k) (lo <= (k) && (k) < hi)
#define BOTH(k) (IN(k) && IN((k) + 1))
    if (IN(0)) { for (int rep = 0; rep < NREP(0); ++rep) p0_prologue(F, args); if (BOTH(0)) xcd_barrier(bar); }
    if (IN(1)) {
        pg8::Gemm g{(const pg8::bf16_t*)(F.ws + WS_HB), (const pg8::bf16_t*)(F.ws + WS_WIN), NTOK + 1024, DIN + 1024, 1024};
        P1Order S; S.init(F.G, (int)blockIdx.x);
        EpiP1 E{F.ws, args.in[4], (const float*)(F.ws + WS_GTAB), (float*)(F.ctl + CW_KMEAN), (float*)(F.ctl + CW_MEMKSS), 1};
        pg8::gemm_phase<EpiP1, P1Order, true, true>(F.lds + RING_OFF, g, S, E);
        if (NREP(1) > 1) { xcd_barrier(bar); E.atom_on = 0; pg8::gemm_phase<EpiP1, P1Order, true, true>(F.lds + RING_OFF, g, S, E); }
        if (BOTH(1)) xcd_barrier(bar);
    }
    if (IN(2)) {
        p2_mixers(F, args.in[5], args.in[10], args.in[11], args.in[19], args.in[21], CW_QUEUE, 0, P2_NITEMS, 15);
        if (NREP(2) > 1) { xcd_barrier(bar); p2_mixers(F, args.in[5], args.in[10], args.in[11], args.in[19], args.in[21], CW_QUEUE + 64, P2_LO, P2_HI, P2_TMASK); }
        if (BOTH(2)) xcd_barrier(bar);
    }
    if (IN(3)) {
        P3Order S; S.init(F.G, (int)blockIdx.x, F.ws); EpiP3 E{(const bf16_t*)(F.ws + WS_GT), (bf16_t*)(F.ws + WS_Y)};
        pg9::gemm_phase<EpiP3, P3Order, false>(F.lds + RING_OFF, 512, 512, 512, S, E);
        if (NREP(3) > 1) pg9::gemm_phase<EpiP3, P3Order, false>(F.lds + RING_OFF, 512, 512, 512, S, E);
        if (BOTH(3)) xcd_barrier(bar);
    }
    if (IN(4)) {
        P4Order S; S.init(F.G, (int)blockIdx.x, F.ws); EpiP4 E{args.in[0], F.out};
        pg9::gemm_phase<EpiP4, P4Order, false>(F.lds + RING_OFF, 1024, 1024, 1024, S, E);
        if (NREP(4) > 1) pg9::gemm_phase<EpiP4, P4Order, false>(F.lds + RING_OFF, 1024, 1024, 1024, S, E);
        if (BOTH(4)) xcd_barrier(bar);
    }
    if (IN(5)) { p5_router(F, F.out, args.in[16], args.in[17], args.in[18], (int*)F.ctl + CW_COUNTS, (int*)(F.ws + WS_LISTS));
        if (NREP(5) > 1) p5_router(F, F.out, args.in[16], args.in[17], args.in[18], (int*)F.ctl + CW_COUNTS + 256, (int*)(F.ws + WS_RETST));
        if (BOTH(5)) xcd_barrier(bar); }
    if (IN(6)) {
        moe_tables(F);
        MoeOrder<3, WS_W1, 2048, 2, WS_XT> S; S.init(F.G, F.vcu, F.ws, (const LAS int*)(F.lds + TB_OFF));
        EpiMoe1 E{(const int*)(F.ws + WS_LISTS), args.in[20], (bf16_t*)(F.ws + WS_ACT)};
        pg9::gemm_phase<EpiMoe1, MoeOrder<3, WS_W1, 2048, 2, WS_XT>, true>(F.lds + RING_OFF, 1024, 1024, 1024, S, E);
        if (NREP(6) > 1) { xcd_barrier(bar); } if (NREP(6) > 1) pg9::gemm_phase<EpiMoe1, MoeOrder<3, WS_W1, 2048, 2, WS_XT>, true>(F.lds + RING_OFF, 1024, 1024, 1024, S, E);
        if (BOTH(6)) xcd_barrier(bar);
    }
    if (IN(7)) {
        moe_tables(F);
        MoeOrder<2, WS_W2, 1024, 0, WS_ACT> S; S.init(F.G, F.vcu, F.ws, (const LAS int*)(F.lds + TB_OFF));
        EpiMoe2 E{(const int*)(F.ws + WS_LISTS), args.in[22], (bf16_t*)(F.ws + WS_YS)};
        pg9::gemm_phase<EpiMoe2, MoeOrder<2, WS_W2, 1024, 0, WS_ACT>, true>(F.lds + RING_OFF, 1024, 1024, 1024, S, E);
        if (NREP(7) > 1) { xcd_barrier(bar); } if (NREP(7) > 1) pg9::gemm_phase<EpiMoe2, MoeOrder<2, WS_W2, 1024, 0, WS_ACT>, true>(F.lds + RING_OFF, 1024, 1024, 1024, S, E);
        if (BOTH(7)) xcd_barrier(bar);
    }
    if (IN(8)) { p8_combine(F, F.out, F.out); if (NREP(8) > 1) p8_combine(F, F.out, (float*)(F.ws + WS_HB)); }
    if (NREP(9) > 1) { for (int i = 0; i < 16; ++i) xcd_barrier(bar); }
#undef IN
#undef BOTH
}
#ifndef MK_ONE_LAUNCH
#define MK_ONE_LAUNCH 1
#endif
extern "C" void kernel_launch(void* const* d_in, const int* in_sizes, int n_in, void* d_out, int out_size, void* d_ws, size_t ws_size, hipStream_t stream) {
    if (ws_size < WS_END) { fprintf(stderr, "kernel_launch: ws too small %zu < %zu\n", ws_size, (size_t)WS_END); return; }
    unsigned char* ws = (unsigned char*)d_ws; float* out = (float*)d_out;
    static int grid = 0;
    if (grid == 0) {
        int dev = 0, cus = 0; if (hipGetDevice(&dev) != hipSuccess || hipDeviceGetAttribute(&cus, hipDeviceAttributeMultiprocessorCount, dev) != hipSuccess) { fprintf(stderr, "kernel_launch: device query failed\n"); grid = -1; return; }
        if (hipFuncSetAttribute((const void*)mega, hipFuncAttributeMaxDynamicSharedMemorySize, LDS_BYTES) != hipSuccess) { fprintf(stderr, "kernel_launch: hipFuncSetAttribute failed\n"); grid = -1; return; }
        (void)hipGetLastError(); grid = cus;
    }
    if (grid < 0) return;
    (void)hipMemsetAsync(ws + WS_CTL, 0, 1 * MiB, stream);
    Args a; memset(&a, 0, sizeof a); for (int i = 0; i < 23; ++i) a.in[i] = (const float*)d_in[i]; a.out = out; a.ws = ws; a.li = 0;
#if MK_ONE_LAUNCH
    a.ph_lo = 0; a.ph_hi = N_PHASES;
    hipLaunchKernelGGL(mega, dim3(grid), dim3(NWAVES * 64), LDS_BYTES, stream, a);
#else
    for (int p = 0; p < N_PHASES; ++p) { a.ph_lo = p; a.ph_hi = p + 1; hipLaunchKernelGGL(mega, dim3(grid), dim3(NWAVES * 64), LDS_BYTES, stream, a); }
#endif
}
```

```cpp
#define PROBE_MASK 0
#include <hip/hip_runtime.h>
#include <cstdio>
#include <cstdint>
#include <cstring>
typedef unsigned short bf16_t;
__host__ __device__ inline float bf2f(bf16_t v) { unsigned u = ((unsigned)v) << 16; float f; __builtin_memcpy(&f, &u, 4); return f; }
__host__ __device__ inline bf16_t f2bf(float f) { unsigned u; __builtin_memcpy(&u, &f, 4); u += 0x7fffu + ((u >> 16) & 1u); return (bf16_t)(u >> 16); }
constexpr int NTOK = 16384, SEQ = 4096, NB = 4, DM = 1024, DIN = 6656, MEMLEN = 256, NEXP = 32;
constexpr size_t MiB = (size_t)1 << 20;
constexpr size_t WS_CTL = 0;
constexpr size_t WS_WIN = 1 * MiB;
constexpr size_t WS_WMEMKV = 14 * MiB;
constexpr size_t WS_WBR = 16 * MiB;
constexpr size_t WS_WOUT = 19 * MiB;
constexpr size_t WS_W1 = 21 * MiB;
constexpr size_t WS_W2 = 149 * MiB;
constexpr size_t WS_HB = 213 * MiB;
constexpr size_t WS_HM = 245 * MiB;
constexpr size_t WS_RQ = 247 * MiB, WS_RK = 255 * MiB, WS_RV = 263 * MiB, WS_RG = 279 * MiB, WS_MQ = 295 * MiB, WS_MK = 311 * MiB, WS_MV = 327 * MiB, WS_CQ = 343 * MiB, WS_GT = 359 * MiB;
constexpr size_t WS_MEMK = 455 * MiB, WS_MEMV = 456 * MiB, WS_KMEAN = 457 * MiB, WS_MEMKSS = 457 * MiB + 512 * 1024;
constexpr size_t WS_GTAB = 457 * MiB + 768 * 1024;
constexpr size_t WS_ORET = 458 * MiB, WS_OMOBA = 474 * MiB, WS_OMEM = 490 * MiB;
constexpr size_t WS_Y = 506 * MiB, WS_XT = 538 * MiB;
constexpr size_t WS_TOPE = 570 * MiB, WS_TOPW = 570 * MiB + 256 * 1024, WS_LISTS = 571 * MiB;
constexpr size_t WS_ACT = 574 * MiB;
constexpr size_t WS_YS = 703 * MiB;
constexpr size_t WS_RETST = 959 * MiB;
constexpr size_t WS_END = 832 * MiB;
constexpr size_t WS_PROJ = 574 * MiB;
constexpr size_t WS_PM = 990 * MiB;
constexpr size_t WS_ORAW = 574 * MiB;
constexpr size_t WS_T0 = 703 * MiB, WS_T1 = 767 * MiB, WS_T2 = 831 * MiB;
constexpr int CW_COUNTS = 64;
namespace pg8 {
#define PG8_LAS __attribute__((address_space(3)))
typedef unsigned short bf16_t;
typedef short bf16x8 __attribute__((ext_vector_type(8)));
typedef float f32x4 __attribute__((ext_vector_type(4)));
typedef unsigned u32x4 __attribute__((ext_vector_type(4)));
constexpr int BM = 256, BK = 64, HALF = 128, HTB = HALF * BK * 2  , STAGE_BYTES = 8 * HTB, NXCD = 8, WGM = 8;

__host__ __device__ __forceinline__ int lds_byte(int r, int c) { const int st = (r >> 4) * 2 + (c >> 5), rr = r & 15, cc = c & 31, ob = rr * 64 + cc * 2; return st * 1024 + (ob ^ (((ob >> 9) & 1) << 5)); }
__host__ __device__ __forceinline__ void stage_rc(int b, int& R, int& C) { const int st = b / 1024, sb = b % 1024, swz = sb ^ (((sb >> 9) & 1) << 5); R = (st >> 1) * 16 + swz / 64; C = (st & 1) * 32 + (swz % 64) / 2; }
__host__ __device__ __forceinline__ int perm32(int rho) { const int n = rho >> 4, i = rho & 15; return 8 * (i >> 2) + 4 * n + (i & 3); }

struct Unit { int pm, pn; };
struct Gemm { const bf16_t* A; const bf16_t* Bt; int M, N, K; };
struct StaticOrder {
    int nM, nN, nwg, G, c;
    __host__ __device__ void init(int M, int N, int G_, int c_) { nM = M / BM; nN = N / BM; nwg = nM * nN; G = G_; c = c_; }
    __host__ __device__ bool next(int i, Unit& u) const {
        const long L = (long)i * G + c; if (L >= nwg) return false;
        int wgid = (int)L; { const int q = nwg / NXCD, r = nwg % NXCD, xcd = wgid % NXCD, off = wgid / NXCD; wgid = (xcd < r ? xcd * (q + 1) : r * (q + 1) + (xcd - r) * q) + off; }
        const int nig = WGM * nN, gid = wgid / nig, fm = gid * WGM, gsz = (nM - fm) < WGM ? (nM - fm) : WGM;
        u.pm = fm + ((wgid % nig) % gsz); u.pn = (wgid % nig) / gsz; return true;
    }
    __device__ __forceinline__ void a_ready(const Unit&) const {}
    __device__ __forceinline__ void done(const Unit&) const {}
};
__device__ __forceinline__ unsigned cvt_pk_bf16(float lo, float hi) { unsigned r; asm volatile("v_cvt_pk_bf16_f32 %0, %1, %2" : "=v"(r) : "v"(lo), "v"(hi)); return r; }
typedef float f32x2 __attribute__((ext_vector_type(2)));
template <class Epi, class Sched, bool ALIGN_EPI = false, bool SP2 = false>
__device__ __forceinline__ void gemm_phase(PG8_LAS unsigned char* lds, const Gemm g, const Sched& S, const Epi& E) {
    const int tid = threadIdx.x, wid = __builtin_amdgcn_readfirstlane(tid >> 6), lane = tid & 63, wr = wid >> 2, wc = wid & 3, fr = lane & 15, fq = lane >> 4;
    const int K = g.K, nt = K / BK;
    unsigned voffA[2], voffB[2];
#pragma unroll
    for (int i = 0; i < 2; ++i) { int R, C; stage_rc(tid * 16 + i * 8192, R, C); const int Rb = Epi::PERM ? ((R & ~31) + perm32(R & 31)) : R;
        voffA[i] = (unsigned)(R * K + C) * 2u; voffB[i] = (unsigned)(Rb * K + C) * 2u; }
    const size_t kstep = (size_t)(BK * 2);
    const size_t hstep = (size_t)HALF * K * 2;
    const size_t tstep = 2 * hstep;
    const unsigned ldsw = (unsigned)wid * 1024u;
    const int aoff = lds_byte(wr * 64 + fr, fq * 8), boff = lds_byte(wc * 32 + fr, fq * 8);
#define PG8_SA(b, h) (((b) * 2 + (h)) * HTB)
#define PG8_SB(b, h) ((4 + (b) * 2 + (h)) * HTB)
#define PG8_STAGE(bufoff, gbase, voff) do { _Pragma("unroll") for (int _i = 0; _i < 2; ++_i) \
        __builtin_amdgcn_global_load_lds((const unsigned*)((const char*)(gbase) + (voff)[_i]), (PG8_LAS unsigned*)(lds + (bufoff) + ldsw + _i * 8192), 16, 0, 0); } while (0)
#define PG8_LDA(dst, b, h) do { _Pragma("unroll") for (int m = 0; m < 4; ++m) _Pragma("unroll") for (int k = 0; k < 2; ++k) dst[m][k] = *(const PG8_LAS bf16x8*)(lds + PG8_SA(b, h) + aoff + m * 2048 + k * 1024); } while (0)
#define PG8_LDB(dst, b, h) do { _Pragma("unroll") for (int n = 0; n < 2; ++n) _Pragma("unroll") for (int k = 0; k < 2; ++k) dst[n][k] = *(const PG8_LAS bf16x8*)(lds + PG8_SB(b, h) + boff + n * 2048 + k * 1024); } while (0)
#define PG8_MMA(ai, bj, At, Bt) do { __builtin_amdgcn_s_setprio(1); _Pragma("unroll") for (int m = 0; m < 4; ++m) _Pragma("unroll") for (int n = 0; n < 2; ++n) _Pragma("unroll") for (int k = 0; k < 2; ++k) \
        acc[ai][bj][m][n] = __builtin_amdgcn_mfma_f32_16x16x32_bf16(Bt[n][k], At[m][k], acc[ai][bj][m][n], 0, 0, 0); __builtin_amdgcn_s_setprio(0); } while (0)
#define PG8_WAIT_V(n) asm volatile("s_waitcnt vmcnt(" #n ")" ::: "memory")
#define PG8_WAIT_L(n) asm volatile("s_waitcnt lgkmcnt(" #n ")" ::: "memory")
#define PG8_BAR __builtin_amdgcn_s_barrier()
#define PG8_SCHED __builtin_amdgcn_sched_barrier(0)
    Unit cur, nxt; int ui = 0;
    if (!S.next(0, cur)) return;
    f32x4 acc[2][2][4][2];
#pragma unroll
    for (int a = 0; a < 2; ++a)
#pragma unroll
        for (int b = 0; b < 2; ++b)
#pragma unroll
            for (int m = 0; m < 4; ++m)
#pragma unroll
                for (int n = 0; n < 2; ++n) acc[a][b][m][n] = (f32x4){0.f, 0.f, 0.f, 0.f};
    bf16x8 At[4][2], B0[2][2], B1[2][2];
    const char* cA = (const char*)g.A + (size_t)cur.pm * tstep; const char* cB = (const char*)g.Bt + (size_t)cur.pn * tstep;
    S.a_ready(cur);
    if constexpr (SP2) {
        PG8_STAGE(PG8_SB(0, 0), cB, voffB); PG8_STAGE(PG8_SB(0, 1), cB + hstep, voffB); PG8_STAGE(PG8_SA(0, 0), cA, voffA); PG8_STAGE(PG8_SA(0, 1), cA + hstep, voffA);
        if (wr == 1) PG8_BAR;
        PG8_WAIT_V(2); PG8_BAR;
        PG8_STAGE(PG8_SB(1, 0), cB + kstep, voffB); PG8_STAGE(PG8_SA(1, 0), cA + kstep, voffA); PG8_STAGE(PG8_SB(1, 1), cB + hstep + kstep, voffB);
        PG8_WAIT_V(6); PG8_BAR;
    } else {
        PG8_STAGE(PG8_SB(0, 0), cB, voffB); PG8_STAGE(PG8_SA(0, 0), cA, voffA); PG8_STAGE(PG8_SB(0, 1), cB + hstep, voffB); PG8_STAGE(PG8_SA(0, 1), cA + hstep, voffA);
        if (wr == 1) PG8_BAR;
        PG8_WAIT_V(4); PG8_BAR;
        PG8_STAGE(PG8_SB(1, 0), cB + kstep, voffB); PG8_STAGE(PG8_SA(1, 0), cA + kstep, voffA); PG8_STAGE(PG8_SB(1, 1), cB + hstep + kstep, voffB);
        PG8_WAIT_V(6); PG8_BAR;
    }
    for (;;) {
        const bool has_next = S.next(ui + 1, nxt);
        const char* nA = has_next ? (const char*)g.A + (size_t)nxt.pm * tstep : cA; const char* nB = has_next ? (const char*)g.Bt + (size_t)nxt.pn * tstep : cB;
        for (int t = 0; t < nt; t += 2) {
            const bool last = (t == nt - 2);
            const char* a1 = cA + (size_t)(t + 1) * kstep;
            const char* a2 = last ? nA : cA + (size_t)(t + 2) * kstep; const char* b2 = last ? nB : cB + (size_t)(t + 2) * kstep;
            const char* a3 = a2 + kstep; const char* b3 = b2 + kstep;
            if (last && has_next) S.a_ready(nxt);
            if constexpr (SP2) {
            PG8_LDB(B0, 0, 0); PG8_LDB(B1, 0, 1); PG8_SCHED; PG8_LDA(At, 0, 0); PG8_STAGE(PG8_SA(1, 1), a1 + hstep, voffA);
            PG8_WAIT_V(8); PG8_WAIT_L(0); PG8_BAR; PG8_MMA(0, 0, At, B0); PG8_MMA(0, 1, At, B1); PG8_BAR; PG8_SCHED;
            PG8_LDA(At, 0, 1); PG8_STAGE(PG8_SB(0, 0), b2, voffB); PG8_STAGE(PG8_SB(0, 1), b2 + hstep, voffB); PG8_STAGE(PG8_SA(0, 0), a2, voffA);
            PG8_WAIT_V(8); PG8_WAIT_L(0); PG8_BAR; PG8_MMA(1, 0, At, B0); PG8_MMA(1, 1, At, B1); PG8_BAR; PG8_SCHED;
            PG8_LDB(B0, 1, 0); PG8_LDB(B1, 1, 1); PG8_SCHED; PG8_LDA(At, 1, 0); PG8_STAGE(PG8_SA(0, 1), a2 + hstep, voffA);
            PG8_WAIT_V(8); PG8_WAIT_L(0); PG8_BAR; PG8_MMA(0, 0, At, B0); PG8_MMA(0, 1, At, B1); PG8_BAR; PG8_SCHED;
            PG8_LDA(At, 1, 1); PG8_STAGE(PG8_SB(1, 0), b3, voffB); PG8_STAGE(PG8_SB(1, 1), b3 + hstep, voffB); PG8_STAGE(PG8_SA(1, 0), a3, voffA);
            PG8_WAIT_V(8); PG8_WAIT_L(0); PG8_BAR; PG8_MMA(1, 0, At, B0); PG8_MMA(1, 1, At, B1); PG8_BAR; PG8_SCHED;
            } else {
            PG8_LDB(B0, 0, 0); PG8_SCHED; PG8_LDA(At, 0, 0); PG8_STAGE(PG8_SA(1, 1), a1 + hstep, voffA);
            PG8_WAIT_L(8); PG8_BAR; PG8_WAIT_L(0); PG8_MMA(0, 0, At, B0); PG8_BAR; PG8_SCHED;
            PG8_LDB(B1, 0, 1); PG8_STAGE(PG8_SB(0, 0), b2, voffB);
            PG8_BAR; PG8_WAIT_L(0); PG8_MMA(0, 1, At, B1); PG8_BAR;
            PG8_LDA(At, 0, 1); PG8_STAGE(PG8_SA(0, 0), a2, voffA);
            PG8_BAR; PG8_WAIT_L(0); PG8_MMA(1, 0, At, B0); PG8_BAR; PG8_SCHED;
            PG8_STAGE(PG8_SB(0, 1), b2 + hstep, voffB);
            PG8_WAIT_V(6); PG8_BAR; PG8_MMA(1, 1, At, B1); PG8_BAR;
            PG8_LDB(B0, 1, 0); PG8_SCHED; PG8_LDA(At, 1, 0); PG8_STAGE(PG8_SA(0, 1), a2 + hstep, voffA);
            PG8_WAIT_L(8); PG8_BAR; PG8_WAIT_L(0); PG8_MMA(0, 0, At, B0); PG8_BAR; PG8_SCHED;
            PG8_LDB(B1, 1, 1); PG8_STAGE(PG8_SB(1, 0), b3, voffB);
            PG8_BAR; PG8_WAIT_L(0); PG8_MMA(0, 1, At, B1); PG8_BAR;
            PG8_LDA(At, 1, 1); PG8_STAGE(PG8_SA(1, 0), a3, voffA);
            PG8_BAR; PG8_WAIT_L(0); PG8_MMA(1, 0, At, B0); PG8_BAR; PG8_SCHED;
            PG8_STAGE(PG8_SB(1, 1), b3 + hstep, voffB);
            PG8_WAIT_V(6); PG8_BAR; PG8_MMA(1, 1, At, B1); PG8_BAR;
            }
        }
        if constexpr (ALIGN_EPI) { if (wr == 0) PG8_BAR; }
        if constexpr (!Epi::AFTER_DRAIN) { E(acc, cur, wr, wc, fr, fq); S.done(cur); }
        if (!has_next) break;
#pragma unroll
        for (int a = 0; a < 2; ++a)
#pragma unroll
            for (int b = 0; b < 2; ++b)
#pragma unroll
                for (int m = 0; m < 4; ++m)
#pragma unroll
                    for (int n = 0; n < 2; ++n) acc[a][b][m][n] = (f32x4){0.f, 0.f, 0.f, 0.f};
        cur = nxt; cA = nA; cB = nB; ++ui;
        if constexpr (ALIGN_EPI) { if (wr == 1) PG8_BAR; }
    }
    PG8_WAIT_V(0);
    if constexpr (!ALIGN_EPI) { if (wr == 0) PG8_BAR; }
    PG8_BAR;
    if constexpr (Epi::AFTER_DRAIN) { E.fused(acc, cur, wr, wc, fr, fq, lds, wid, lane); S.done(cur); }
#undef PG8_SA
#undef PG8_SB
#undef PG8_STAGE
#undef PG8_LDA
#undef PG8_LDB
#undef PG8_MMA
#undef PG8_WAIT_V
#undef PG8_WAIT_L
#undef PG8_BAR
#undef PG8_SCHED
}
}
namespace pg9 {
using pg8::bf16x8; using pg8::f32x4; using pg8::u32x4; using pg8::lds_byte; using pg8::stage_rc; using pg8::perm32;
constexpr int BK = 64, HALF = 128, HTB = HALF * BK * 2;
struct Unit { int pm, pn, aux, cnt; };
template <class Epi, class Sched, bool GATHER>
__device__ __forceinline__ void gemm_phase(PG8_LAS unsigned char* lds, const int K, const int lda, const int ldb, const Sched& S, const Epi& E) {
    const int tid = threadIdx.x, wid = __builtin_amdgcn_readfirstlane(tid >> 6), lane = tid & 63, wr = wid >> 2, wc = wid & 3, fr = lane & 15, fq = lane >> 4;
    const int nt = K / BK;
    unsigned offA[2][2], offAn[2][2], offB[2][2]; int RA[2], CA[2];
#pragma unroll
    for (int i = 0; i < 2; ++i) { int R, C; stage_rc(tid * 16 + i * 8192, R, C); const int Rb = Epi::PERM ? ((R & ~31) + perm32(R & 31)) : R; RA[i] = R; CA[i] = C * 2;
#pragma unroll
        for (int h = 0; h < 2; ++h) { offB[h][i] = (unsigned)((Rb + 128 * h) * ldb + C) * 2u; offA[h][i] = (unsigned)((R + 128 * h) * lda + C) * 2u; offAn[h][i] = offA[h][i]; } }
    const size_t kstep = (size_t)(BK * 2);
    const unsigned ldsw = (unsigned)wid * 1024u;
    const int aoff = lds_byte(wr * 64 + fr, fq * 8), boff = lds_byte(wc * 32 + fr, fq * 8);
#define PG9_SA(b, h) (((b) * 2 + (h)) * HTB)
#define PG9_SB(b, h) ((4 + (b) * 2 + (h)) * HTB)
#define PG9_STAGE(bufoff, gbase, voff) do { _Pragma("unroll") for (int _i = 0; _i < 2; ++_i) \
        __builtin_amdgcn_global_load_lds((const unsigned*)((const char*)(gbase) + (voff)[_i]), (PG8_LAS unsigned*)(lds + (bufoff) + ldsw + _i * 8192), 16, 0, 0); } while (0)
#define PG9_LDA(dst, b, h) do { _Pragma("unroll") for (int m = 0; m < 4; ++m) _Pragma("unroll") for (int k = 0; k < 2; ++k) dst[m][k] = *(const PG8_LAS bf16x8*)(lds + PG9_SA(b, h) + aoff + m * 2048 + k * 1024); } while (0)
#define PG9_LDB(dst, b, h) do { _Pragma("unroll") for (int n = 0; n < 2; ++n) _Pragma("unroll") for (int k = 0; k < 2; ++k) dst[n][k] = *(const PG8_LAS bf16x8*)(lds + PG9_SB(b, h) + boff + n * 2048 + k * 1024); } while (0)
#define PG9_MMA(ai, bj, At, Bt) do { __builtin_amdgcn_s_setprio(1); _Pragma("unroll") for (int m = 0; m < 4; ++m) _Pragma("unroll") for (int n = 0; n < 2; ++n) _Pragma("unroll") for (int k = 0; k < 2; ++k) \
        acc[ai][bj][m][n] = __builtin_amdgcn_mfma_f32_16x16x32_bf16(Bt[n][k], At[m][k], acc[ai][bj][m][n], 0, 0, 0); __builtin_amdgcn_s_setprio(0); } while (0)
#define PG9_WAIT_V(n) asm volatile("s_waitcnt vmcnt(" #n ")" ::: "memory")
#define PG9_WAIT_L(n) asm volatile("s_waitcnt lgkmcnt(" #n ")" ::: "memory")
#define PG9_BAR __builtin_amdgcn_s_barrier()
#define PG9_SCHED __builtin_amdgcn_sched_barrier(0)
    Unit cur, nxt; int ui = 0;
    if (!S.next(0, cur)) return;
    f32x4 acc[2][2][4][2];
#pragma unroll
    for (int a = 0; a < 2; ++a)
#pragma unroll
        for (int b = 0; b < 2; ++b)
#pragma unroll
            for (int m = 0; m < 4; ++m)
#pragma unroll
                for (int n = 0; n < 2; ++n) acc[a][b][m][n] = (f32x4){0.f, 0.f, 0.f, 0.f};
    bf16x8 At[4][2], B0[2][2], B1[2][2];
    const char* cA = S.a_base(cur); const char* cB = S.b_base(cur);
    if constexpr (GATHER) {
#pragma unroll
        for (int h = 0; h < 2; ++h)
#pragma unroll
            for (int i = 0; i < 2; ++i) offA[h][i] = S.a_row_off(cur, RA[i] + 128 * h) + (unsigned)CA[i];
    }
    PG9_STAGE(PG9_SB(0, 0), cB, offB[0]); PG9_STAGE(PG9_SB(0, 1), cB, offB[1]); PG9_STAGE(PG9_SA(0, 0), cA, offA[0]); PG9_STAGE(PG9_SA(0, 1), cA, offA[1]);
    if (wr == 1) PG9_BAR;
    PG9_WAIT_V(2); PG9_BAR;
    PG9_STAGE(PG9_SB(1, 0), cB + kstep, offB[0]); PG9_STAGE(PG9_SA(1, 0), cA + kstep, offA[0]); PG9_STAGE(PG9_SB(1, 1), cB + kstep, offB[1]);
    PG9_WAIT_V(6); PG9_BAR;
    for (;;) {
        const bool has_next = S.next(ui + 1, nxt);
        const char* nA = has_next ? S.a_base(nxt) : cA; const char* nB = has_next ? S.b_base(nxt) : cB;
        if constexpr (GATHER) {
#pragma unroll
            for (int h = 0; h < 2; ++h)
#pragma unroll
                for (int i = 0; i < 2; ++i) offAn[h][i] = has_next ? (S.a_row_off(nxt, RA[i] + 128 * h) + (unsigned)CA[i]) : offA[h][i];
        }
        for (int t = 0; t < nt; t += 2) {
            const bool last = (t == nt - 2);
            const char* a1 = cA + (size_t)(t + 1) * kstep;
            const char* a2 = last ? nA : cA + (size_t)(t + 2) * kstep; const char* b2 = last ? nB : cB + (size_t)(t + 2) * kstep;
            const char* a3 = a2 + kstep; const char* b3 = b2 + kstep;
            unsigned oA2[2][2];
#pragma unroll
            for (int h = 0; h < 2; ++h)
#pragma unroll
                for (int i = 0; i < 2; ++i) oA2[h][i] = (GATHER && last) ? offAn[h][i] : offA[h][i];
            PG9_LDB(B0, 0, 0); PG9_LDB(B1, 0, 1); PG9_SCHED; PG9_LDA(At, 0, 0); PG9_STAGE(PG9_SA(1, 1), a1, offA[1]);
            PG9_WAIT_V(8); PG9_WAIT_L(0); PG9_BAR; PG9_MMA(0, 0, At, B0); PG9_MMA(0, 1, At, B1); PG9_BAR; PG9_SCHED;
            PG9_LDA(At, 0, 1); PG9_STAGE(PG9_SB(0, 0), b2, offB[0]); PG9_STAGE(PG9_SB(0, 1), b2, offB[1]); PG9_STAGE(PG9_SA(0, 0), a2, oA2[0]);
            PG9_WAIT_V(8); PG9_WAIT_L(0); PG9_BAR; PG9_MMA(1, 0, At, B0); PG9_MMA(1, 1, At, B1); PG9_BAR; PG9_SCHED;
            PG9_LDB(B0, 1, 0); PG9_LDB(B1, 1, 1); PG9_SCHED; PG9_LDA(At, 1, 0); PG9_STAGE(PG9_SA(0, 1), a2, oA2[1]);
            PG9_WAIT_V(8); PG9_WAIT_L(0); PG9_BAR; PG9_MMA(0, 0, At, B0); PG9_MMA(0, 1, At, B1); PG9_BAR; PG9_SCHED;
            PG9_LDA(At, 1, 1); PG9_STAGE(PG9_SB(1, 0), b3, offB[0]); PG9_STAGE(PG9_SB(1, 1), b3, offB[1]); PG9_STAGE(PG9_SA(1, 0), a3, oA2[0]);
            PG9_WAIT_V(8); PG9_WAIT_L(0); PG9_BAR; PG9_MMA(1, 0, At, B0); PG9_MMA(1, 1, At, B1); PG9_BAR; PG9_SCHED;
        }
        if (wr == 0) PG9_BAR;
        bool keep = false;
        if constexpr (Epi::CHAIN) keep = E.chain_more(cur);
        if (keep) { if constexpr (Epi::CHAIN) E.rescale(acc, cur, wr, wc, fr, fq); }
        else E(acc, cur, wr, wc, fr, fq);
        if (!has_next) break;
        if (!keep) {
#pragma unroll
            for (int a = 0; a < 2; ++a)
#pragma unroll
                for (int b = 0; b < 2; ++b)
#pragma unroll
                    for (int m = 0; m < 4; ++m)
#pragma unroll
                        for (int n = 0; n < 2; ++n) acc[a][b][m][n] = (f32x4){0.f, 0.f, 0.f, 0.f};
        }
        cur = nxt; cA = nA; cB = nB; ++ui;
        if constexpr (GATHER) {
#pragma unroll
            for (int h = 0; h < 2; ++h)
#pragma unroll
                for (int i = 0; i < 2; ++i) offA[h][i] = offAn[h][i];
        }
        if (wr == 1) PG9_BAR;
    }
    PG9_WAIT_V(0);
    PG9_BAR;
#undef PG9_SA
#undef PG9_SB
#undef PG9_STAGE
#undef PG9_LDA
#undef PG9_LDB
#undef PG9_MMA
#undef PG9_WAIT_V
#undef PG9_WAIT_L
#undef PG9_BAR
#undef PG9_SCHED
}
}
#define GAS __attribute__((address_space(1)))
#define LAS __attribute__((address_space(3)))
typedef unsigned short bf16;
typedef unsigned v4u __attribute__((ext_vector_type(4)));
typedef float f32x4 __attribute__((ext_vector_type(4)));
typedef short bf16x8 __attribute__((ext_vector_type(8)));
typedef GAS unsigned gu32;
typedef GAS unsigned long long gu64;
#define RLX_AGENT __ATOMIC_RELAXED, __HIP_MEMORY_SCOPE_AGENT
#define LDS_WAIT() asm volatile("s_waitcnt lgkmcnt(0)" ::: "memory")
#define VM_WAIT() asm volatile("s_waitcnt vmcnt(0)" ::: "memory")
__device__ __forceinline__ unsigned long long rt() { return __builtin_amdgcn_s_memrealtime(); }
__device__ __forceinline__ unsigned f2bfu(float f) { unsigned u = __builtin_bit_cast(unsigned, f); return (u + 0x7fffu + ((u >> 16) & 1u)) >> 16; }
__device__ __forceinline__ unsigned pk2(float lo, float hi) { return f2bfu(lo) | (f2bfu(hi) << 16); }
#define XB_TMO      128
#define XB_XCNT(j)  (256  + 64 * (j))
#define XB_XSUB(j)  (1280 + 64 * (j))
#define XB_XGEN(j)  (2304 + 64 * (j))
#define XB_TOP      3328
#define XB_TOPGEN   3392
#define XCD_BAR_WORDS 3456
#define XB_SPIN_CAP (1u << 18)

__device__ __forceinline__ unsigned xb_ld(unsigned* p)              { return __hip_atomic_load(p, __ATOMIC_RELAXED, __HIP_MEMORY_SCOPE_AGENT); }
__device__ __forceinline__ unsigned xb_add(unsigned* p, unsigned v) { return __hip_atomic_fetch_add(p, v, __ATOMIC_RELAXED, __HIP_MEMORY_SCOPE_AGENT); }
__device__ __forceinline__ unsigned xb_xcc_id() { return (unsigned)__builtin_amdgcn_s_getreg((3 << 11) | 20) & 0xFu; }
#define XB_SPIN(cond, bar) do { unsigned _sp = 0; while (cond) { __builtin_amdgcn_s_sleep(1); \
    if ((++_sp & 255u) == 0u) { if (xb_ld(&(bar)[XB_TMO])) break; if (_sp > XB_SPIN_CAP) { atomicAdd(&(bar)[XB_TMO], 1u); break; } } } } while (0)

struct XcdBarrier {
    unsigned* bar; unsigned x;
    volatile LAS unsigned* st;
};

__device__ __forceinline__ XcdBarrier xcd_barrier_post(unsigned* bar, volatile LAS unsigned* st) {
    XcdBarrier b; b.bar = bar; b.x = xb_xcc_id(); b.st = st;
    if (threadIdx.x == 0) (void)xb_add(&bar[XB_XCNT(b.x)], 1u);
    return b;
}
__device__ __forceinline__ void xcd_barrier_complete(unsigned* bar, unsigned x, unsigned& nloc, unsigned& nx) {
    const unsigned G = gridDim.x * gridDim.y * gridDim.z;
    unsigned sum, cnt, mine, sp = 0u;
    for (;;) {
        sum = 0u; cnt = 0u; mine = 0u;
#pragma unroll
        for (unsigned j = 0; j < 16; ++j) { const unsigned c = xb_ld(&bar[XB_XCNT(j)]); sum += c; cnt += (c > 0u) ? 1u : 0u; mine = (j == x) ? c : mine; }
        if (sum == G) break;
        __builtin_amdgcn_s_sleep(1);
        if ((++sp & 255u) == 0u) { if (xb_ld(&bar[XB_TMO])) break; if (sp > XB_SPIN_CAP) { atomicAdd(&bar[XB_TMO], 1u); break; } }
    }
    nloc = mine > 0u ? mine : 1u; nx = cnt > 0u ? cnt : 1u;
}

__device__ __forceinline__ void xcd_barrier(const XcdBarrier& b) {
    asm volatile("s_waitcnt vmcnt(0)" ::: "memory");
    __syncthreads();
    if (threadIdx.x == 0) {
        unsigned* bar = b.bar;
        __builtin_amdgcn_s_waitcnt(0);
        unsigned nloc = b.st[0], nx = b.st[1];
        if (nloc == 0u) { xcd_barrier_complete(bar, b.x, nloc, nx); b.st[0] = nloc; b.st[1] = nx; }
        const unsigned old = xb_add(&bar[XB_XSUB(b.x)], 1u);
        const unsigned gen = old / nloc;
        if (old + 1u == (gen + 1u) * nloc) {
            __builtin_amdgcn_fence(__ATOMIC_RELEASE, "agent");
            asm volatile("s_waitcnt vmcnt(0)" ::: "memory");
            const unsigned og = xb_add(&bar[XB_TOP], 1u);
            const unsigned tg = og / nx;
            if (og + 1u == (tg + 1u) * nx) xb_add(&bar[XB_TOPGEN], 1u);
            else XB_SPIN(xb_ld(&bar[XB_TOPGEN]) == tg, bar);
            __builtin_amdgcn_fence(__ATOMIC_ACQUIRE, "agent");
            xb_add(&bar[XB_XGEN(b.x)], 1u);
            asm volatile("s_waitcnt vmcnt(0)" ::: "memory");
        } else {
            XB_SPIN(xb_ld(&bar[XB_XGEN(b.x)]) == gen, bar);
            __builtin_amdgcn_fence(__ATOMIC_ACQUIRE, "agent");
            asm volatile("s_waitcnt vmcnt(0)" ::: "memory");
        }
    }
    __syncthreads();
}
constexpr int NWAVES = 8;
constexpr int RING_OFF = 0, RING_BYTES = 131072;
constexpr int LDSCTL_OFF = RING_BYTES, MISC_OFF = LDSCTL_OFF + 320;
constexpr int LDS_BYTES = 147456;
constexpr int CW_BAR = 4096;
constexpr int CW_KMEAN = 32768;
constexpr int CW_MEMKSS = 65536;
static_assert((CW_MEMKSS + 4096) * 4 <= (int)MiB && CW_BAR + 4 * 3456 <= CW_KMEAN, "ctl map");

struct Frame {
    LAS unsigned char* lds; volatile LAS unsigned* MISC; gu32* ctl;
    int tid, lane, wave, vcu, G;
    unsigned char* ws; float* out;
};
typedef float f32x2_t __attribute__((ext_vector_type(2))); typedef __bf16 bf16x2_t __attribute__((ext_vector_type(2)));
__device__ __forceinline__ unsigned cvt_pk_bf16(float lo, float hi) { f32x2_t v = {lo, hi}; bf16x2_t b = __builtin_convertvector(v, bf16x2_t); return __builtin_bit_cast(unsigned, b); }
__device__ __forceinline__ float wave_sum64(float v) {
#pragma unroll
    for (int o = 1; o < 64; o <<= 1) v += __shfl_xor(v, o);
    return v;
}
template <bool HEADPERM> __device__ __forceinline__ void p0_transpose_item(const float* W, int K, int N, bf16* WT, int row_off, LAS float* scr, int item, int lane) {
    const int nblk = N / 32, kb = item / nblk, nb = item % nblk, k0 = 64 * kb, n0 = 32 * nb;
    int p0 = n0; if (HEADPERM) { const int lg = (n0 >> 5) & 7; p0 = (n0 & ~255) + 32 * (4 * (lg & 1) + (lg >> 1)); }
    float wv[32];
#pragma unroll
    for (int i = 0; i < 32; ++i) wv[i] = W[(size_t)(k0 + 2 * i + (lane >> 5)) * N + n0 + (lane & 31)];
#pragma unroll
    for (int i = 0; i < 32; ++i) scr[(2 * i + (lane >> 5)) * 33 + (lane & 31)] = wv[i];
    LDS_WAIT(); asm volatile("" ::: "memory");
    const int c = lane & 7;
#pragma unroll
    for (int j = 0; j < 4; ++j) { const int n = (lane >> 3) + 8 * j; const LAS float* s = scr + (8 * c) * 33 + n;
        v4u o; o.x = cvt_pk_bf16(s[0 * 33], s[1 * 33]); o.y = cvt_pk_bf16(s[2 * 33], s[3 * 33]); o.z = cvt_pk_bf16(s[4 * 33], s[5 * 33]); o.w = cvt_pk_bf16(s[6 * 33], s[7 * 33]);
        *(GAS v4u*)(WT + (size_t)(row_off + p0 + n) * K + k0 + 8 * c) = o; }
    LDS_WAIT(); asm volatile("" ::: "memory");
}
__device__ __forceinline__ void xp_load(float (&wv)[32], const float* W, int N, int nblk, int item, int lane) {
    const int kb = item / nblk, nb = item % nblk, k0 = 64 * kb, n0 = 32 * nb;
#pragma unroll
    for (int i = 0; i < 32; ++i) wv[i] = W[(size_t)(k0 + 2 * i + (lane >> 5)) * N + n0 + (lane & 31)];
}
__device__ __forceinline__ void xp_finish(const float (&wv)[32], int K, int nblk, bf16* WT, LAS float* scr, int item, int lane) {
    const int kb = item / nblk, nb = item % nblk, k0 = 64 * kb, n0 = 32 * nb;
#pragma unroll
    for (int i = 0; i < 32; ++i) scr[(2 * i + (lane >> 5)) * 33 + (lane & 31)] = wv[i];
    LDS_WAIT(); asm volatile("" ::: "memory");
    const int c = lane & 7;
#pragma unroll
    for (int j = 0; j < 4; ++j) { const int n = (lane >> 3) + 8 * j; const LAS float* s = scr + (8 * c) * 33 + n;
        v4u o; o.x = cvt_pk_bf16(s[0 * 33], s[1 * 33]); o.y = cvt_pk_bf16(s[2 * 33], s[3 * 33]); o.z = cvt_pk_bf16(s[4 * 33], s[5 * 33]); o.w = cvt_pk_bf16(s[6 * 33], s[7 * 33]);
        *(GAS v4u*)(WT + (size_t)(n0 + n) * K + k0 + 8 * c) = o; }
    LDS_WAIT(); asm volatile("" ::: "memory");
}
__device__ __forceinline__ void rms_row_to_bf16(int lane, const float* xrow, const float* g, bf16* orow) {
    const GAS f32x4* xr = (const GAS f32x4*)xrow + lane; const GAS f32x4* gr = (const GAS f32x4*)g + lane;
    f32x4 v[4]; float s = 0.f;
#pragma unroll
    for (int j = 0; j < 4; ++j) { v[j] = xr[64 * j]; s += (v[j].x * v[j].x + v[j].y * v[j].y) + (v[j].z * v[j].z + v[j].w * v[j].w); }
    const float r = 1.f / sqrtf(wave_sum64(s) * (1.f / 1024.f) + 1e-5f);
    GAS unsigned long long* o8 = (GAS unsigned long long*)orow + lane;
#pragma unroll
    for (int j = 0; j < 4; ++j) { const f32x4 gg = gr[64 * j]; o8[64 * j] = (unsigned long long)cvt_pk_bf16(v[j].x * r * gg.x, v[j].y * r * gg.y) | ((unsigned long long)cvt_pk_bf16(v[j].z * r * gg.z, v[j].w * r * gg.w) << 32); }
}
struct Args { const float* in[23]; float* out; unsigned char* ws; int ph_lo, ph_hi, li, pad; };
__device__ __forceinline__ void p0_prologue(Frame& F, const Args& A) {
    LAS float* scr = (LAS float*)(F.lds + RING_OFF + F.wave * 16384);
    const int gw = F.vcu * NWAVES + F.wave, NGW = F.G * NWAVES;
    constexpr int I_IN = 16 * (DIN / 32), I_MKV = 16 * 32, I_BR = 8 * 32, I_OUT = 16 * 32;
    constexpr int NITEMS = I_IN + I_MKV + 3 * I_BR + I_OUT;
    for (int it = gw; it < NITEMS; it += NGW) {
        int r = it;
        if (r < I_IN) { p0_transpose_item<true>(A.in[3], 1024, DIN, (bf16*)(F.ws + WS_WIN), 0, scr, r, F.lane); continue; } r -= I_IN;
        if (r < I_MKV) { p0_transpose_item<true>(A.in[9], 1024, 1024, (bf16*)(F.ws + WS_WMEMKV), 0, scr, r, F.lane); continue; } r -= I_MKV;
        if (r < 3 * I_BR) { const int w = r / I_BR; p0_transpose_item<false>(w == 0 ? A.in[12] : (w == 1 ? A.in[13] : A.in[14]), 512, 1024, (bf16*)(F.ws + WS_WBR) + (size_t)w * 1024 * 512, 0, scr, r % I_BR, F.lane); continue; } r -= 3 * I_BR;
        p0_transpose_item<false>(A.in[15], 1024, 1024, (bf16*)(F.ws + WS_WOUT), 0, scr, r, F.lane);
    }
    if (gw == 0) { ((float*)(F.ws + WS_GTAB))[F.lane] = A.in[6][F.lane]; ((float*)(F.ws + WS_GTAB))[64 + F.lane] = A.in[7][F.lane]; }
    for (int m = gw; m < NTOK; m += NGW) rms_row_to_bf16(F.lane, A.in[0] + (size_t)m * DM, A.in[2], (bf16*)(F.ws + WS_HB) + (size_t)m * DM);
    for (int m = gw; m < NB * MEMLEN; m += NGW) rms_row_to_bf16(F.lane, A.in[1] + (size_t)m * DM, A.in[8], (bf16*)(F.ws + WS_HM) + (size_t)m * DM);
}

struct P1Order {
    pg8::StaticOrder so; int G, c;
    __device__ void init(int G_, int c_) { so.init(NTOK, DIN, G_, 0); G = G_; c = c_; }
    __device__ bool next(int i, pg8::Unit& u) const {
        long L = (long)i * G + c;
        if (L < 1664) { pg8::StaticOrder t = so; t.G = 1; t.c = 0; return t.next((int)L, u); }
        L -= 1664; if (L >= 16) return false;
        u.pm = 64 + (int)(L >> 2); u.pn = 26 + (int)(L & 3); return true;
    }
    __device__ __forceinline__ void a_ready(const pg8::Unit&) const {}
    __device__ __forceinline__ void done(const pg8::Unit&) const {}
};
__device__ __forceinline__ float sigmoid_f(float x) { return __builtin_amdgcn_rcpf(1.f + __expf(-x)); }
struct EpiP1 {
    static constexpr bool PERM = true, AFTER_DRAIN = false;
    unsigned char* ws; const float* b_gate; const float* gtab; float* KMEAN; float* MEMKSS; int atom_on;
    __device__ __forceinline__ void operator()(const pg8::f32x4 (&acc)[2][2][4][2], const pg8::Unit& u, int wr, int wc, int fr, int fq) const {
        using pg8::f32x4; using pg8::u32x4;
        const int pn = u.pn; int type, ldc, cb; size_t off; int row0 = u.pm * 256;
        if (pn == 0) { type = 0; off = WS_RQ; ldc = 256; cb = 0; }
        else if (pn == 1) { type = 1; off = WS_RK; ldc = 256; cb = 0; }
        else if (pn < 4) { type = 0; off = WS_RV; ldc = 512; cb = (pn - 2) * 256; }
        else if (pn < 6) { type = 2; off = WS_RG; ldc = 512; cb = (pn - 4) * 256; }
        else if (pn < 8) { type = 3; off = WS_MQ; ldc = 512; cb = (pn - 6) * 256; }
        else if (pn < 10) { type = 4; off = WS_MK; ldc = 512; cb = (pn - 8) * 256; }
        else if (pn < 12) { type = 0; off = WS_MV; ldc = 512; cb = (pn - 10) * 256; }
        else if (pn < 14) { type = 0; off = WS_CQ; ldc = 512; cb = (pn - 12) * 256; }
        else if (pn < 26) { type = 5; off = WS_GT; ldc = 3072; cb = (pn - 14) * 256; }
        else if (pn < 28) { type = 6; off = WS_MEMK; ldc = 512; cb = (pn - 26) * 256; row0 = (u.pm - 64) * 256; }
        else { type = 0; off = WS_MEMV; ldc = 512; cb = (pn - 28) * 256; row0 = (u.pm - 64) * 256; }
        bf16_t* base = (bf16_t*)(ws + off) + cb + 64 * wc + 8 * fq;
        const int rbase = row0 + 64 * wr + fr;
#define P1_STORE(rowp, bj, v0, v1) do { u32x4 w_; w_.x = cvt_pk_bf16((v0)[0], (v0)[1]); w_.y = cvt_pk_bf16((v0)[2], (v0)[3]); w_.z = cvt_pk_bf16((v1)[0], (v1)[1]); w_.w = cvt_pk_bf16((v1)[2], (v1)[3]); *(u32x4*)((rowp) + 32 * (bj)) = w_; } while (0)
        if (type <= 1) {
            const float sc = type == 1 ? 0.125f : 1.f;
#pragma unroll
            for (int ai = 0; ai < 2; ++ai)
#pragma unroll
                for (int m = 0; m < 4; ++m) { bf16_t* rowp = base + (size_t)(rbase + 128 * ai + 16 * m) * ldc;
#pragma unroll
                    for (int bj = 0; bj < 2; ++bj) { const f32x4 v0 = acc[ai][bj][m][0] * sc, v1 = acc[ai][bj][m][1] * sc; P1_STORE(rowp, bj, v0, v1); } }
        } else if (type == 2) {
#pragma unroll
            for (int ai = 0; ai < 2; ++ai)
#pragma unroll
                for (int m = 0; m < 4; ++m) { bf16_t* rowp = base + (size_t)(rbase + 128 * ai + 16 * m) * ldc;
#pragma unroll
                    for (int bj = 0; bj < 2; ++bj) { f32x4 v0 = acc[ai][bj][m][0], v1 = acc[ai][bj][m][1];
#pragma unroll
                        for (int j = 0; j < 4; ++j) { v0[j] = v0[j] * sigmoid_f(v0[j]); v1[j] = v1[j] * sigmoid_f(v1[j]); }
                        P1_STORE(rowp, bj, v0, v1); } }
        } else if (type == 5) {
            f32x4 bv[2][2];
#pragma unroll
            for (int bj = 0; bj < 2; ++bj)
#pragma unroll
                for (int n = 0; n < 2; ++n) bv[bj][n] = *(const f32x4*)(b_gate + cb + 64 * wc + 32 * bj + 8 * fq + 4 * n);
#pragma unroll
            for (int ai = 0; ai < 2; ++ai)
#pragma unroll
                for (int m = 0; m < 4; ++m) { bf16_t* rowp = base + (size_t)(rbase + 128 * ai + 16 * m) * ldc;
#pragma unroll
                    for (int bj = 0; bj < 2; ++bj) { f32x4 v0 = acc[ai][bj][m][0] + bv[bj][0], v1 = acc[ai][bj][m][1] + bv[bj][1];
#pragma unroll
                        for (int j = 0; j < 4; ++j) { v0[j] = sigmoid_f(v0[j]); v1[j] = sigmoid_f(v1[j]); }
                        P1_STORE(rowp, bj, v0, v1); } }
        } else if (type == 6) {
#pragma unroll
            for (int ai = 0; ai < 2; ++ai)
#pragma unroll
                for (int m = 0; m < 4; ++m) { const int row = rbase + 128 * ai + 16 * m; bf16_t* rowp = base + (size_t)row * ldc; float ss = 0.f;
#pragma unroll
                    for (int bj = 0; bj < 2; ++bj) { const f32x4 v0 = acc[ai][bj][m][0], v1 = acc[ai][bj][m][1];
                        ss += (v0[0] * v0[0] + v0[1] * v0[1]) + (v0[2] * v0[2] + v0[3] * v0[3]) + (v1[0] * v1[0] + v1[1] * v1[1]) + (v1[2] * v1[2] + v1[3] * v1[3]);
                        P1_STORE(rowp, bj, v0, v1); }
                    ss += __shfl_xor(ss, 16); ss += __shfl_xor(ss, 32);
                    if (fq == 0 && atom_on) atomicAdd(MEMKSS + (size_t)row * 4 + (cb >> 7) + (wc >> 1), ss);
                    }
        } else {
            const float* g = gtab + (type == 3 ? 0 : 64);
            f32x4 gv[2][2]; float rr[2][4];
#pragma unroll
            for (int bj = 0; bj < 2; ++bj)
#pragma unroll
                for (int n = 0; n < 2; ++n) gv[bj][n] = *(const f32x4*)(g + 32 * bj + 8 * fq + 4 * n);
#pragma unroll
            for (int ai = 0; ai < 2; ++ai)
#pragma unroll
                for (int m = 0; m < 4; ++m) { bf16_t* rowp = base + (size_t)(rbase + 128 * ai + 16 * m) * ldc; float ss = 0.f;
#pragma unroll
                    for (int bj = 0; bj < 2; ++bj) { const f32x4 v0 = acc[ai][bj][m][0], v1 = acc[ai][bj][m][1];
                        ss += (v0[0] * v0[0] + v0[1] * v0[1]) + (v0[2] * v0[2] + v0[3] * v0[3]) + (v1[0] * v1[0] + v1[1] * v1[1]) + (v1[2] * v1[2] + v1[3] * v1[3]); }
                    ss += __shfl_xor(ss, 16); ss += __shfl_xor(ss, 32);
                    const float r = (1.f / sqrtf(ss * (1.f / 64.f) + 1e-5f)) * (type == 3 ? 0.18033688011112042f : 1.f); rr[ai][m] = r;
#pragma unroll
                    for (int bj = 0; bj < 2; ++bj) { const f32x4 v0 = acc[ai][bj][m][0] * r * gv[bj][0], v1 = acc[ai][bj][m][1] * r * gv[bj][1];
                        P1_STORE(rowp, bj, v0, v1); }
                    asm volatile("" ::: "memory"); }
            if (type == 4 && atom_on) {
                float* km = KMEAN + ((size_t)u.pm * 8 + (cb >> 6) + wc) * 64 + 8 * fq;
#pragma unroll
                for (int bj = 0; bj < 2; ++bj)
#pragma unroll
                    for (int n = 0; n < 2; ++n)
#pragma unroll
                        for (int j = 0; j < 4; ++j) { float s = 0.f;
#pragma unroll
                            for (int ai = 0; ai < 2; ++ai)
#pragma unroll
                                for (int m = 0; m < 4; ++m) s += acc[ai][bj][m][n][j] * rr[ai][m];
                            s += __shfl_xor(s, 1); s += __shfl_xor(s, 2); s += __shfl_xor(s, 4); s += __shfl_xor(s, 8);
                            if (fr == 0) atomicAdd(km + 32 * bj + 4 * n + j, s * gv[bj][n][j] * (1.f / 256.f)); }
            }
        }
#undef P1_STORE
    }
};

constexpr int TB_OFF = LDSCTL_OFF + 1024;
__device__ __forceinline__ unsigned cvt_pk(float lo, float hi) { return cvt_pk_bf16(lo, hi); }

struct P3Order {
    pg8::StaticOrder so; int G, c; const unsigned char* ws;
    __device__ void init(int G_, int c_, const unsigned char* ws_) { so.init(NTOK, 1024, 1, 0); G = G_; c = c_; ws = ws_; }
    __device__ bool next(int i, pg9::Unit& u) const {
        const int tl = (i / 3) * G + c; if (tl >= 256) return false; pg8::Unit t; so.next(tl, t); u.pm = t.pm; u.pn = t.pn; u.aux = i % 3; u.cnt = 256; return true; }
    __device__ __forceinline__ const char* a_base(const pg9::Unit& u) const { return (const char*)(ws + WS_ORET) + (size_t)u.aux * (WS_OMOBA - WS_ORET) + (size_t)u.pm * 256 * 512 * 2; }
    __device__ __forceinline__ const char* b_base(const pg9::Unit& u) const { return (const char*)(ws + WS_WBR) + (size_t)u.aux * 1024 * 512 * 2 + (size_t)u.pn * 256 * 512 * 2; }
};
struct EpiP3 {
    static constexpr bool PERM = true, CHAIN = true;
    const bf16_t* GT; bf16_t* Y;
    __device__ __forceinline__ bool chain_more(const pg9::Unit& u) const { return u.aux < 2; }
    __device__ __forceinline__ void rescale(pg8::f32x4 (&acc)[2][2][4][2], const pg9::Unit& u, int wr, int wc, int fr, int fq) const {
        const int s = u.aux;
#pragma unroll
        for (int ai = 0; ai < 2; ++ai)
#pragma unroll
            for (int m = 0; m < 4; ++m) { const bf16_t* gp = GT + (size_t)(u.pm * 256 + 128 * ai + 64 * wr + 16 * m + fr) * 3072 + s * 1024 + u.pn * 256 + 32 * wc + 8 * fq;
#pragma unroll
                for (int bj = 0; bj < 2; ++bj) { const pg8::u32x4 ga = *(const pg8::u32x4*)(gp + 128 * bj), gb = *(const pg8::u32x4*)(gp + 1024 + 128 * bj);
#pragma unroll
                    for (int n = 0; n < 2; ++n)
#pragma unroll
                        for (int j = 0; j < 4; ++j) { const int e = 4 * n + j; const unsigned wa = ga[e >> 1], wb = gb[e >> 1];
                            const float fa = __uint_as_float((e & 1) ? (wa & 0xffff0000u) : (wa << 16)), fb = __uint_as_float((e & 1) ? (wb & 0xffff0000u) : (wb << 16));
                            acc[ai][bj][m][n][j] *= fa * __builtin_amdgcn_rcpf(fmaxf(fb, 1e-20f)); } }
                asm volatile("" ::: "memory"); }
    }
    __device__ __forceinline__ void operator()(const pg8::f32x4 (&acc)[2][2][4][2], const pg9::Unit& u, int wr, int wc, int fr, int fq) const {
#pragma unroll
        for (int ai = 0; ai < 2; ++ai)
#pragma unroll
            for (int m = 0; m < 4; ++m) { const size_t row = (size_t)(u.pm * 256 + 128 * ai + 64 * wr + 16 * m + fr); const bf16_t* gp = GT + row * 3072 + 2048 + u.pn * 256 + 32 * wc + 8 * fq; bf16_t* yp = Y + row * 1024 + u.pn * 256 + 32 * wc + 8 * fq;
#pragma unroll
                for (int bj = 0; bj < 2; ++bj) { const pg8::u32x4 ga = *(const pg8::u32x4*)(gp + 128 * bj); float v[8];
#pragma unroll
                    for (int n = 0; n < 2; ++n)
#pragma unroll
                        for (int j = 0; j < 4; ++j) { const int e = 4 * n + j; const unsigned wa = ga[e >> 1]; v[e] = acc[ai][bj][m][n][j] * __uint_as_float((e & 1) ? (wa & 0xffff0000u) : (wa << 16)); }
                    pg8::u32x4 w; w.x = cvt_pk(v[0], v[1]); w.y = cvt_pk(v[2], v[3]); w.z = cvt_pk(v[4], v[5]); w.w = cvt_pk(v[6], v[7]); *(pg8::u32x4*)(yp + 128 * bj) = w; }
                asm volatile("" ::: "memory"); }
    }
};
struct P4Order {
    pg8::StaticOrder so; int G, c; const unsigned char* ws;
    __device__ void init(int G_, int c_, const unsigned char* ws_) { so.init(NTOK, 1024, 1, 0); G = G_; c = c_; ws = ws_; }
    __device__ bool next(int i, pg9::Unit& u) const { const int tl = i * G + c; if (tl >= 256) return false; pg8::Unit t; so.next(tl, t); u.pm = t.pm; u.pn = t.pn; u.aux = 0; u.cnt = 256; return true; }
    __device__ __forceinline__ const char* a_base(const pg9::Unit& u) const { return (const char*)(ws + WS_Y) + (size_t)u.pm * 256 * 1024 * 2; }
    __device__ __forceinline__ const char* b_base(const pg9::Unit& u) const { return (const char*)(ws + WS_WOUT) + (size_t)u.pn * 256 * 1024 * 2; }
};
struct EpiP4 {
    static constexpr bool PERM = false, CHAIN = false;
    const float* x; float* out;
    __device__ __forceinline__ void operator()(const pg8::f32x4 (&acc)[2][2][4][2], const pg9::Unit& u, int wr, int wc, int fr, int fq) const {
#pragma unroll
        for (int ai = 0; ai < 2; ++ai)
#pragma unroll
            for (int m = 0; m < 4; ++m) { const size_t off = (size_t)(u.pm * 256 + 128 * ai + 64 * wr + 16 * m + fr) * 1024 + u.pn * 256 + 32 * wc + 4 * fq;
#pragma unroll
                for (int bj = 0; bj < 2; ++bj)
#pragma unroll
                    for (int n = 0; n < 2; ++n) { const pg8::f32x4 xv = *(const pg8::f32x4*)(x + off + 128 * bj + 16 * n); *(pg8::f32x4*)(out + off + 128 * bj + 16 * n) = xv + acc[ai][bj][m][n]; }
                if (m & 1) asm volatile("" ::: "memory"); }
    }
};
__device__ __forceinline__ float wave_max64(float v) {
#pragma unroll
    for (int o = 1; o < 64; o <<= 1) v = fmaxf(v, __shfl_xor(v, o));
    return v;
}
__device__ __forceinline__ void p5_router(Frame& F, const float* X1, const float* g_ffn, const float* w_router, const float* b_router, int* COUNTS, int* LISTS) {
    bf16_t* XT = (bf16_t*)(F.ws + WS_XT); int* TOPE = (int*)(F.ws + WS_TOPE); float* TOPW = (float*)(F.ws + WS_TOPW);
    const int lane = F.lane, e = lane & 31, kq = lane >> 5, tid = F.tid;
    LAS float* wsh = (LAS float*)(F.lds);
    LAS float* xs = (LAS float*)(F.lds + 65536) + F.wave * 2048;
    for (int v = F.vcu; v < NTOK / 64; v += F.G) {
        const int tw = v * 64 + F.wave * 8;
        float acc[2][4]; float rr[2][4];
#pragma unroll
        for (int g = 0; g < 2; ++g)
#pragma unroll
            for (int q = 0; q < 4; ++q) { acc[g][q] = 0.f; rr[g][q] = 0.f; }
#pragma unroll
        for (int half = 0; half < 2; ++half) {
            __syncthreads();
#pragma unroll
            for (int i = 0; i < 8; ++i) { const int ci = tid + 512 * i; *(LAS f32x4*)(wsh + 4 * ci) = *(const f32x4*)(w_router + (size_t)half * 512 * 32 + 4 * ci); }
            __syncthreads();
#pragma unroll
            for (int g = 0; g < 2; ++g) {
                if (half == 0) {
                    f32x4 x4[4][4]; float s4[4];
#pragma unroll
                    for (int q = 0; q < 4; ++q) { const float* xr = X1 + (size_t)(tw + 4 * g + q) * 1024; s4[q] = 0.f;
#pragma unroll
                        for (int j = 0; j < 4; ++j) x4[q][j] = *(const f32x4*)(xr + 4 * lane + 256 * j); }
#pragma unroll
                    for (int q = 0; q < 4; ++q) {
#pragma unroll
                        for (int j = 0; j < 4; ++j) s4[q] += (x4[q][j].x * x4[q][j].x + x4[q][j].y * x4[q][j].y) + (x4[q][j].z * x4[q][j].z + x4[q][j].w * x4[q][j].w); }
#pragma unroll
                    for (int o_ = 1; o_ < 64; o_ <<= 1) {
#pragma unroll
                        for (int q = 0; q < 4; ++q) s4[q] += __shfl_xor(s4[q], o_); }
#pragma unroll
                    for (int q = 0; q < 4; ++q) { const int t = tw + 4 * g + q; const float r = 1.f / sqrtf(s4[q] * (1.f / 1024.f) + 1e-5f); rr[g][q] = r;
#pragma unroll
                        for (int j = 0; j < 4; ++j) { const f32x4 gg = *(const f32x4*)(g_ffn + 4 * lane + 256 * j); const f32x4 xn = x4[q][j] * r * gg;
                            uint2 w; w.x = cvt_pk(xn.x, xn.y); w.y = cvt_pk(xn.z, xn.w); *(uint2*)(XT + (size_t)t * 1024 + 4 * lane + 256 * j) = w;
                            if (j < 2) *(LAS f32x4*)(xs + q * 512 + 4 * lane + 256 * j) = xn; } }
                } else {
                    f32x4 x2[4][2];
#pragma unroll
                    for (int q = 0; q < 4; ++q)
#pragma unroll
                        for (int j = 0; j < 2; ++j) x2[q][j] = *(const f32x4*)(X1 + (size_t)(tw + 4 * g + q) * 1024 + 512 + 4 * lane + 256 * j);
#pragma unroll
                    for (int q = 0; q < 4; ++q)
#pragma unroll
                        for (int j = 0; j < 2; ++j) { const f32x4 gg = *(const f32x4*)(g_ffn + 512 + 4 * lane + 256 * j); *(LAS f32x4*)(xs + q * 512 + 4 * lane + 256 * j) = x2[q][j] * rr[g][q] * gg; }
                }
                asm volatile("s_waitcnt lgkmcnt(0)" ::: "memory");
#pragma unroll 2
                for (int k = 256 * kq; k < 256 * kq + 256; k += 4) { const float w0 = wsh[(k + 0) * 32 + e], w1 = wsh[(k + 1) * 32 + e], w2 = wsh[(k + 2) * 32 + e], w3 = wsh[(k + 3) * 32 + e];
#pragma unroll
                    for (int q = 0; q < 4; ++q) { const f32x4 x = *(const LAS f32x4*)(xs + q * 512 + k); acc[g][q] += x.x * w0 + x.y * w1 + x.z * w2 + x.w * w3; } }
                asm volatile("s_waitcnt lgkmcnt(0)" ::: "memory");
            }
        }
        volatile LAS int* lcnt = (volatile LAS int*)(F.lds + TB_OFF);
        __syncthreads();
        if (tid < 32) lcnt[tid] = 0;
        __syncthreads();
        const float bias = b_router[e];
        int my_e[2][4], my_r[2][4];
#pragma unroll
        for (int g = 0; g < 2; ++g)
#pragma unroll
            for (int q = 0; q < 4; ++q) { const int t = tw + 4 * g + q; float lg = acc[g][q] + __shfl_xor(acc[g][q], 32) + bias; if (lane >= 32) lg = -INFINITY;
                float tv[4]; int te[4];
#pragma unroll
                for (int k = 0; k < 4; ++k) { const float m = wave_max64(lg); const unsigned long long bal = __ballot(lg == m); const int ee = __ffsll((long long)bal) - 1; tv[k] = m; te[k] = ee; if (lane == ee) lg = -INFINITY; }
                float ex[4], se = 0.f;
#pragma unroll
                for (int k = 0; k < 4; ++k) { ex[k] = __expf(tv[k] - tv[0]); se += ex[k]; }
                int e_l = te[0]; float w_l = ex[0];
#pragma unroll
                for (int k = 1; k < 4; ++k) if (lane == k) { e_l = te[k]; w_l = ex[k]; }
                my_e[g][q] = e_l; my_r[g][q] = 0;
                if (lane < 4) { TOPE[t * 4 + lane] = e_l; TOPW[t * 4 + lane] = w_l / se; my_r[g][q] = __hip_atomic_fetch_add((LAS int*)(F.lds + TB_OFF) + e_l, 1, __ATOMIC_RELAXED, __HIP_MEMORY_SCOPE_WORKGROUP); } }
        __syncthreads();
        if (tid < 32) { const int c = lcnt[tid]; lcnt[32 + tid] = c ? atomicAdd(&COUNTS[tid], c) : 0; }
        __syncthreads();
#pragma unroll
        for (int g = 0; g < 2; ++g)
#pragma unroll
            for (int q = 0; q < 4; ++q) if (lane < 4) { const int t = tw + 4 * g + q; LISTS[(size_t)my_e[g][q] * 16384 + lcnt[32 + my_e[g][q]] + my_r[g][q]] = t * 4 + lane; }
    }
}
__device__ __forceinline__ void moe_tables(Frame& F) {
    volatile LAS int* TB = (volatile LAS int*)(F.lds + TB_OFF);
    if (F.tid == 0) { const int* COUNTS = (const int*)F.ctl + CW_COUNTS; int acc = 0; for (int e = 0; e < 32; ++e) { const int c = __hip_atomic_load(COUNTS + e, __ATOMIC_RELAXED, __HIP_MEMORY_SCOPE_AGENT); TB[e] = acc; TB[33 + e] = c; acc += (c + 255) >> 8; } TB[32] = acc; }
    __syncthreads();
}
template <int NPN_LOG2, size_t WOFF, int NROWS_B, int ASHIFT, size_t AOFF> struct MoeOrder {
    int perx, xcd, l; const unsigned char* ws; const LAS int* TB; const int* LISTS;
    __device__ void init(int G_, int vcu_, const unsigned char* ws_, const LAS int* TB_) { perx = G_ / 8; xcd = vcu_ / perx; l = vcu_ % perx; ws = ws_; TB = TB_; LISTS = (const int*)(ws_ + WS_LISTS); }
    __device__ bool next(int i, pg9::Unit& u) const {
        const int uidx = i * perx + l; const int mt = TB[4 * xcd] + (uidx >> NPN_LOG2); if (mt >= TB[4 * xcd + 4]) return false;
        int e = 4 * xcd;
#pragma unroll
        for (int k = 1; k < 4; ++k) if (TB[4 * xcd + k] <= mt) e = 4 * xcd + k;
        u.aux = e; u.pm = mt - TB[e]; u.pn = uidx & ((1 << NPN_LOG2) - 1); u.cnt = TB[33 + e] - u.pm * 256; return true;
    }
    __device__ __forceinline__ const char* a_base(const pg9::Unit&) const { return (const char*)(ws + AOFF); }
    __device__ __forceinline__ const char* b_base(const pg9::Unit& u) const { return (const char*)(ws + WOFF) + ((size_t)u.aux * NROWS_B + (size_t)u.pn * 256) * 1024 * 2; }
    __device__ __forceinline__ unsigned a_row_off(const pg9::Unit& u, int r) const { const int rr = r < u.cnt ? r : u.cnt - 1; const int id = LISTS[(size_t)u.aux * 16384 + u.pm * 256 + rr]; return (unsigned)(id >> ASHIFT) * 2048u; }
};
struct EpiMoe1 {
    static constexpr bool PERM = true, CHAIN = false;
    const int* LISTS; const float* b1; bf16_t* ACT;
    __device__ __forceinline__ void operator()(const pg8::f32x4 (&acc)[2][2][4][2], const pg9::Unit& u, int wr, int wc, int fr, int fq) const {
        const int e = u.aux; const int c0 = u.pn * 256 + 32 * wc + 8 * fq;
        pg8::f32x4 bv[2][2];
#pragma unroll
        for (int bj = 0; bj < 2; ++bj)
#pragma unroll
            for (int n = 0; n < 2; ++n) bv[bj][n] = *(const pg8::f32x4*)(b1 + (size_t)e * 2048 + c0 + 128 * bj + 4 * n);
#pragma unroll
        for (int ai = 0; ai < 2; ++ai)
#pragma unroll
            for (int m = 0; m < 4; ++m) { const int r = 128 * ai + 64 * wr + 16 * m + fr; const bool ok = r < u.cnt; const int id = ok ? LISTS[(size_t)e * 16384 + u.pm * 256 + r] : 0;
#pragma unroll
                for (int bj = 0; bj < 2; ++bj) { float a[4];
#pragma unroll
                    for (int n = 0; n < 2; ++n)
#pragma unroll
                        for (int p = 0; p < 2; ++p) { const float gl = fminf(acc[ai][bj][m][n][2 * p] + bv[bj][n][2 * p], 7.0f); const float li = fminf(fmaxf(acc[ai][bj][m][n][2 * p + 1] + bv[bj][n][2 * p + 1], -7.0f), 7.0f);
                            a[2 * n + p] = gl * sigmoid_f(1.702f * gl) * (li + 1.f); }
                    if (ok) { uint2 w; w.x = cvt_pk(a[0], a[1]); w.y = cvt_pk(a[2], a[3]); *(uint2*)(ACT + (size_t)id * 1024 + ((c0 + 128 * bj) >> 1)) = w; } }
                asm volatile("" ::: "memory"); }
    }
};
struct EpiMoe2 {
    static constexpr bool PERM = true, CHAIN = false;
    const int* LISTS; const float* b2; bf16_t* YS;
    __device__ __forceinline__ void operator()(const pg8::f32x4 (&acc)[2][2][4][2], const pg9::Unit& u, int wr, int wc, int fr, int fq) const {
        const int e = u.aux; const int c0 = u.pn * 256 + 32 * wc + 8 * fq;
        pg8::f32x4 bv[2][2];
#pragma unroll
        for (int bj = 0; bj < 2; ++bj)
#pragma unroll
            for (int n = 0; n < 2; ++n) bv[bj][n] = *(const pg8::f32x4*)(b2 + (size_t)e * 1024 + c0 + 128 * bj + 4 * n);
#pragma unroll
        for (int ai = 0; ai < 2; ++ai)
#pragma unroll
            for (int m = 0; m < 4; ++m) { const int r = 128 * ai + 64 * wr + 16 * m + fr; const bool ok = r < u.cnt; const int id = ok ? LISTS[(size_t)e * 16384 + u.pm * 256 + r] : 0;
#pragma unroll
                for (int bj = 0; bj < 2; ++bj) { const pg8::f32x4 v0 = acc[ai][bj][m][0] + bv[bj][0], v1 = acc[ai][bj][m][1] + bv[bj][1];
                    if (ok) { pg8::u32x4 w; w.x = cvt_pk(v0[0], v0[1]); w.y = cvt_pk(v0[2], v0[3]); w.z = cvt_pk(v1[0], v1[1]); w.w = cvt_pk(v1[2], v1[3]); *(pg8::u32x4*)(YS + (size_t)id * 1024 + c0 + 128 * bj) = w; } }
                asm volatile("" ::: "memory"); }
    }
};
__device__ __forceinline__ void p8_combine(Frame& F, const float* src, float* out) {
    const bf16_t* YS = (const bf16_t*)(F.ws + WS_YS); const float* TOPW = (const float*)(F.ws + WS_TOPW);
    const int gw = F.vcu * NWAVES + F.wave, NGW = F.G * NWAVES, lane = F.lane;
    for (int t = gw; t < NTOK; t += NGW) {
        const f32x4 w4 = *(const f32x4*)(TOPW + (size_t)t * 4);
#pragma unroll
        for (int j = 0; j < 2; ++j) {
            const int c = 8 * lane + 512 * j; f32x4 a0 = *(const f32x4*)(src + (size_t)t * 1024 + c), a1 = *(const f32x4*)(src + (size_t)t * 1024 + c + 4);
#pragma unroll
            for (int k = 0; k < 4; ++k) { const v4u y = *(const v4u*)(YS + ((size_t)t * 4 + k) * 1024 + c); const float wk = w4[k];
                a0.x += wk * __uint_as_float(y.x << 16); a0.y += wk * __uint_as_float(y.x & 0xffff0000u); a0.z += wk * __uint_as_float(y.y << 16); a0.w += wk * __uint_as_float(y.y & 0xffff0000u);
                a1.x += wk * __uint_as_float(y.z << 16); a1.y += wk * __uint_as_float(y.z & 0xffff0000u); a1.z += wk * __uint_as_float(y.w << 16); a1.w += wk * __uint_as_float(y.w & 0xffff0000u); }
            *(f32x4*)(out + (size_t)t * 1024 + c) = a0; *(f32x4*)(out + (size_t)t * 1024 + c + 4) = a1; }
    }
}
namespace att {
typedef float f32x16 __attribute__((ext_vector_type(16)));
typedef short s16x4 __attribute__((ext_vector_type(4)));
typedef short v4i16_t __attribute__((ext_vector_type(4)));
using pg8::bf16x8;
constexpr float LOG2E = 1.4426950408889634f;
__device__ __forceinline__ constexpr int crow(int r, int hi) { return (r & 3) + 8 * (r >> 2) + 4 * hi; }
template <int D> __device__ __forceinline__ int kswz(int row) { return D == 64 ? ((row >> 1) & 7) : (row & 15); }
template <int D> __device__ __forceinline__ int vswz(int row) { return D == 64 ? (((row >> 1) & 1) << 2) : ((row & 3) << 2); }
__device__ __forceinline__ s16x4 vtr(const LAS unsigned char* p) { return __builtin_bit_cast(s16x4, __builtin_amdgcn_ds_read_tr16_b64_v4i16((LAS v4i16_t*)p)); }
__device__ __forceinline__ bf16x8 pack8(const f32x16& x, int s) {
    typedef unsigned u32x4_t __attribute__((ext_vector_type(4))); u32x4_t p;
    p[0] = cvt_pk_bf16(x[8 * s + 0], x[8 * s + 1]); p[1] = cvt_pk_bf16(x[8 * s + 2], x[8 * s + 3]); p[2] = cvt_pk_bf16(x[8 * s + 4], x[8 * s + 5]); p[3] = cvt_pk_bf16(x[8 * s + 6], x[8 * s + 7]);
    return __builtin_bit_cast(bf16x8, p);
}
__device__ __forceinline__ float bfl(unsigned w) { return __uint_as_float(w << 16); }
__device__ __forceinline__ float bfh(unsigned w) { return __uint_as_float(w & 0xffff0000u); }

template <bool MOBA, int TK> __device__ __forceinline__ int tile_kbase(int tt, int qb) { constexpr int TPB = 256 / TK; if (!MOBA) return TK * tt; if (tt < TPB) return qb * 256 + TK * tt; const int u = tt - TPB; return (u / TPB) * 256 + TK * (u % TPB); }
template <int D, bool MOBA, int NSUB>
__device__ __forceinline__ void attn_unit(Frame& F, const int b, const int h, const int qb,
                                          const bf16_t* Qg, const bf16_t* Kg, const bf16_t* Vg, bf16_t* Og, const int ld,
                                          const float* KMEAN, const float* KSS, const float* gq, const float* gk) {
    constexpr int NKH = 2  , TK = 64 * NSUB  , KB = TK * D * 2, NKS = D / 16, NDH = D / 32, CPR = D / 8  , NST = (TK * CPR) / 512  ;
    int tid = F.tid, lane = F.lane; asm volatile("" : "+v"(tid), "+v"(lane));
    const int wave = F.wave, r32 = lane & 31, hi = lane >> 5;
    LAS unsigned char* lds = F.lds;
    const size_t qrow = (size_t)b * SEQ + qb * 256 + wave * 32 + r32;
    bf16x8 qr[NKS];
#pragma unroll
    for (int ks = 0; ks < NKS; ++ks) qr[ks] = *(const bf16x8*)(Qg + qrow * ld + h * D + 16 * ks + 8 * hi);
    unsigned selmask = 0u;
    if constexpr (MOBA) {
        if (qb > 0) {
            LAS float* kml = (LAS float*)(lds + 4 * KB);
            if (tid < qb * 16) *(LAS f32x4*)(kml + 4 * tid) = *(const f32x4*)(KMEAN + (((size_t)b * 16 + (tid >> 4)) * 8 + h) * 64 + 4 * (tid & 15));
            __syncthreads();
            float qf[NKS * 8];
#pragma unroll
            for (int ks = 0; ks < NKS; ++ks) { const pg8::u32x4 w = __builtin_bit_cast(pg8::u32x4, qr[ks]);
#pragma unroll
                for (int j = 0; j < 4; ++j) { qf[ks * 8 + 2 * j] = bfl(w[j]); qf[ks * 8 + 2 * j + 1] = bfh(w[j]); } }
            float v0 = -INFINITY, v1 = -INFINITY, v2 = -INFINITY; int i0 = -1, i1 = -1, i2 = -1;
#pragma unroll 1
            for (int j = 0; j < qb; ++j) { const LAS float* km = kml + 64 * j + 8 * hi; float s = 0.f;
#pragma unroll
                for (int ks = 0; ks < NKS; ++ks) { const f32x4 k0 = *(const LAS f32x4*)(km + 16 * ks), k1 = *(const LAS f32x4*)(km + 16 * ks + 4);
                    s += qf[ks * 8 + 0] * k0[0] + qf[ks * 8 + 1] * k0[1] + qf[ks * 8 + 2] * k0[2] + qf[ks * 8 + 3] * k0[3] + qf[ks * 8 + 4] * k1[0] + qf[ks * 8 + 5] * k1[1] + qf[ks * 8 + 6] * k1[2] + qf[ks * 8 + 7] * k1[3]; }
                s += __shfl_xor(s, 32);
                const bool c0 = s > v0, c1 = s > v1, c2 = s > v2;
                v2 = c1 ? v1 : (c2 ? s : v2); i2 = c1 ? i1 : (c2 ? j : i2);
                v1 = c0 ? v0 : (c1 ? s : v1); i1 = c0 ? i0 : (c1 ? j : i1);
                v0 = c0 ? s : v0; i0 = c0 ? j : i0; }
            selmask = (i0 >= 0 ? (1u << i0) : 0u) | (i1 >= 0 ? (1u << i1) : 0u) | (i2 >= 0 ? (1u << i2) : 0u);
        }
    } else {
        float qf[NKS * 8]; float ss = 0.f;
#pragma unroll
        for (int ks = 0; ks < NKS; ++ks) { const pg8::u32x4 w = __builtin_bit_cast(pg8::u32x4, qr[ks]);
#pragma unroll
            for (int j = 0; j < 4; ++j) { qf[ks * 8 + 2 * j] = bfl(w[j]); qf[ks * 8 + 2 * j + 1] = bfh(w[j]); ss += qf[ks * 8 + 2 * j] * qf[ks * 8 + 2 * j] + qf[ks * 8 + 2 * j + 1] * qf[ks * 8 + 2 * j + 1]; } }
        ss += __shfl_xor(ss, 32);
        const float rq = (1.f / sqrtf(ss * (1.f / D) + 1e-5f)) * (0.08838834764831845f * LOG2E);
#pragma unroll
        for (int ks = 0; ks < NKS; ++ks) { const float* g1 = gq + 16 * ks + 8 * hi; const float* g2 = gk + 16 * ks + 8 * hi; pg8::u32x4 w;
#pragma unroll
            for (int j = 0; j < 4; ++j) w[j] = cvt_pk_bf16(qf[ks * 8 + 2 * j] * rq * g1[2 * j] * g2[2 * j], qf[ks * 8 + 2 * j + 1] * rq * g1[2 * j + 1] * g2[2 * j + 1]);
            qr[ks] = __builtin_bit_cast(bf16x8, w); }
    }
    constexpr int TPB = 256 / TK;
    const int NT = MOBA ? TPB * (qb + 1) : TPB;
    const float sl2 = MOBA ? exp2f(-(float)(h + 1)) * LOG2E : 0.f;
    v4u kreg[NST], vreg[NST];
#define ATT_LOAD(tt) do { const int kb_ = tile_kbase<MOBA, TK>(tt, qb); _Pragma("unroll") for (int i_ = 0; i_ < NST; ++i_) { const int ci_ = tid + 512 * i_, row_ = ci_ / CPR, ch_ = ci_ % CPR; \
        const size_t g_ = (size_t)(kb_ + row_) * ld + h * D + 8 * ch_; kreg[i_] = *(const v4u*)(Kg + g_); vreg[i_] = *(const v4u*)(Vg + g_); \
        if (!MOBA) { const float rk_ = 1.f / sqrtf(KSS[(size_t)(kb_ + row_) * 4 + h] * (1.f / D) + 1e-5f); v4u k_ = kreg[i_]; \
            k_.x = cvt_pk_bf16(bfl(k_.x) * rk_, bfh(k_.x) * rk_); k_.y = cvt_pk_bf16(bfl(k_.y) * rk_, bfh(k_.y) * rk_); k_.z = cvt_pk_bf16(bfl(k_.z) * rk_, bfh(k_.z) * rk_); k_.w = cvt_pk_bf16(bfl(k_.w) * rk_, bfh(k_.w) * rk_); kreg[i_] = k_; } } } while (0)
#define ATT_WRITE(buf) do { _Pragma("unroll") for (int i_ = 0; i_ < NST; ++i_) { const int ci_ = tid + 512 * i_, row_ = ci_ / CPR, ch_ = ci_ % CPR; \
        *(LAS v4u*)(lds + (buf) * KB + row_ * (2 * D) + ((ch_ ^ kswz<D>(row_)) << 4)) = kreg[i_]; *(LAS v4u*)(lds + (2 + (buf)) * KB + row_ * (2 * D) + ((ch_ ^ vswz<D>(row_)) << 4)) = vreg[i_]; } } while (0)
    ATT_LOAD(0); ATT_WRITE(0);
    __syncthreads();
    float m = -1e30f, l = 0.f;
    f32x16 o[NDH];
#pragma unroll
    for (int dh = 0; dh < NDH; ++dh)
#pragma unroll
        for (int r = 0; r < 16; ++r) o[dh][r] = 0.f;
    const int qrel = wave * 32 + r32;
    f32x16 cinit[NKH];
#pragma unroll
    for (int kh = 0; kh < NKH; ++kh)
#pragma unroll
        for (int r = 0; r < 16; ++r) cinit[kh][r] = MOBA ? sl2 * (float)(32 * kh + (r & 3) + 8 * (r >> 2)) : 0.f;
    for (int tt = 0; tt < NT; ++tt) {
        int lane_t = lane; asm volatile("" : "+v"(lane_t));
        const int r32 = lane_t & 31, hi = lane_t >> 5, i16 = lane_t & 15, blk = (lane_t >> 4) & 1, tq = i16 >> 2, tp = i16 & 3;
        const int buf = tt & 1;
        if (tt + 1 < NT) ATT_LOAD(tt + 1);
#pragma unroll 1
        for (int sub = 0; sub < NSUB; ++sub) {
        bool act = true; bool lane_sel = true; int pblk = -1;
        if constexpr (MOBA) { if (tt >= TPB) { pblk = (tt - TPB) / TPB; lane_sel = (selmask >> pblk) & 1u; act = __builtin_amdgcn_ballot_w64(lane_sel) != 0ull; }
            else act = (TK * tt + 64 * sub <= wave * 32 + 31); }
        if (act) {
            f32x16 p[NKH];
            const LAS unsigned char* Kb = lds + buf * KB + sub * 64 * (2 * D);
#pragma unroll
            for (int ks = 0; ks < NKS; ++ks) {
#pragma unroll
                for (int kh = 0; kh < NKH; ++kh) { const int row = 32 * kh + r32;
                    const bf16x8 a = *(const LAS bf16x8*)(Kb + row * (2 * D) + (((2 * ks + hi) ^ kswz<D>(row)) << 4));
                    p[kh] = __builtin_amdgcn_mfma_f32_32x32x16_bf16(a, qr[ks], ks == 0 ? cinit[kh] : p[kh], 0, 0, 0); }
            }
            float offl = 0.f;
            if constexpr (MOBA) {
                const int kb = tile_kbase<MOBA, TK>(tt, qb) + 64 * sub; offl = sl2 * (float)(kb - qb * 256 + 4 * hi);
                if (tt < TPB) {
                    const int k0 = TK * tt + 64 * sub + 4 * hi;
#pragma unroll
                    for (int kh = 0; kh < NKH; ++kh)
#pragma unroll
                        for (int r = 0; r < 16; ++r) { const int kv = k0 + 32 * kh + (r & 3) + 8 * (r >> 2); if (kv > qrel) p[kh][r] = -INFINITY; }
                } else if (!lane_sel) {
#pragma unroll
                    for (int kh = 0; kh < NKH; ++kh)
#pragma unroll
                        for (int r = 0; r < 16; ++r) p[kh][r] = -INFINITY;
                }
            }
            float mx = p[0][0];
#pragma unroll
            for (int kh = 0; kh < NKH; ++kh)
#pragma unroll
                for (int r = 0; r < 16; ++r) mx = fmaxf(mx, p[kh][r]);
            mx += offl;
            mx = fmaxf(mx, __shfl_xor(mx, 32));
            const float mnew = fmaxf(m, mx);
            if (__builtin_amdgcn_ballot_w64(mnew > m) != 0ull) { const float alpha = __builtin_amdgcn_exp2f(m - mnew); l *= alpha;
#pragma unroll
                for (int dh = 0; dh < NDH; ++dh)
#pragma unroll
                    for (int r = 0; r < 16; ++r) o[dh][r] *= alpha;
                m = mnew; }
            float ps = 0.f; const float mt = m - offl;
#pragma unroll
            for (int kh = 0; kh < NKH; ++kh)
#pragma unroll
                for (int r = 0; r < 16; ++r) { p[kh][r] = __builtin_amdgcn_exp2f(p[kh][r] - mt); ps += p[kh][r]; }
            l += ps;
            const LAS unsigned char* Vb = lds + (2 + buf) * KB + sub * 64 * (2 * D);
#pragma unroll
            for (int kh = 0; kh < NKH; ++kh)
#pragma unroll
                for (int s = 0; s < 2; ++s) {
                    const bf16x8 pb = pack8(p[kh], s);
#pragma unroll
                    for (int dh = 0; dh < NDH; ++dh) {
                        const int rowA = 32 * kh + 16 * s + 4 * hi + tq, rowB = rowA + 8, chv = 4 * dh + 2 * blk + (tp >> 1);
                        const s16x4 lo = vtr(Vb + rowA * (2 * D) + ((chv ^ vswz<D>(rowA)) << 4) + 8 * (tp & 1));
                        const s16x4 hh = vtr(Vb + rowB * (2 * D) + ((chv ^ vswz<D>(rowB)) << 4) + 8 * (tp & 1));
                        const bf16x8 va = (bf16x8){lo[0], lo[1], lo[2], lo[3], hh[0], hh[1], hh[2], hh[3]};
                        o[dh] = __builtin_amdgcn_mfma_f32_32x32x16_bf16(va, pb, o[dh], 0, 0, 0);
                    }
                }
        }
        }
        if (tt + 1 < NT) ATT_WRITE(buf ^ 1);
        __syncthreads();
    }
    l += __shfl_xor(l, 32);
    const float inv = 1.f / l;
    bf16_t* orow = Og + qrow * ld + h * D;
#pragma unroll
    for (int dh = 0; dh < NDH; ++dh)
#pragma unroll
        for (int g = 0; g < 4; ++g) { uint2 w; w.x = cvt_pk_bf16(o[dh][4 * g] * inv, o[dh][4 * g + 1] * inv); w.y = cvt_pk_bf16(o[dh][4 * g + 2] * inv, o[dh][4 * g + 3] * inv);
            *(uint2*)(orow + 32 * dh + 8 * g + 4 * hi) = w; }
#undef ATT_LOAD
#undef ATT_WRITE
}
}
__device__ __forceinline__ void p2_moba(Frame& F) {
    const bf16_t* MQ = (const bf16_t*)(F.ws + WS_MQ); const bf16_t* MK = (const bf16_t*)(F.ws + WS_MK); const bf16_t* MV = (const bf16_t*)(F.ws + WS_MV); bf16_t* OM = (bf16_t*)(F.ws + WS_OMOBA);
    for (int pr = F.vcu; pr < 256; pr += F.G) { const int bh = pr >> 3, p = pr & 7, b = bh >> 3, h = bh & 7;
#pragma unroll 1
        for (int k = 0; k < 2; ++k) { const int qb = k ? 15 - p : p;
            att::attn_unit<64, true, 2>(F, b, h, qb, MQ, MK + (size_t)b * SEQ * 512, MV + (size_t)b * SEQ * 512, OM, 512, (const float*)(F.ctl + CW_KMEAN), nullptr, nullptr, nullptr); } }
}
__device__ __forceinline__ void p2_mem(Frame& F, const float* g_mem_q, const float* g_mem_k) {
    const bf16_t* CQ = (const bf16_t*)(F.ws + WS_CQ); const bf16_t* MEMK = (const bf16_t*)(F.ws + WS_MEMK); const bf16_t* MEMV = (const bf16_t*)(F.ws + WS_MEMV); bf16_t* OM = (bf16_t*)(F.ws + WS_OMEM);
#pragma unroll 1
    for (int u = F.vcu; u < 256; u += F.G) { const int bh = u >> 4, qb = u & 15, b = bh >> 2, h = bh & 3;
        att::attn_unit<128, false, 1>(F, b, h, qb, CQ, MEMK + (size_t)b * MEMLEN * 512, MEMV + (size_t)b * MEMLEN * 512, OM, 512, nullptr, (const float*)(F.ctl + CW_MEMKSS) + (size_t)b * MEMLEN * 4, g_mem_q, g_mem_k); }
}
namespace ret {
using att::f32x16; using att::s16x4; using att::vtr; using att::pack8; using att::kswz; using att::vswz; using att::crow; using pg8::bf16x8;
constexpr int L_KT = 0, L_KD = 16384, L_VT = 32768, L_SB = 65536, L_SS = 98304, L_G = 99328;
__device__ __forceinline__ void retention_item(Frame& F, const int b, const int h, const float* g_ret_out) {
    const bf16_t* RQ = (const bf16_t*)(F.ws + WS_RQ); const bf16_t* RK = (const bf16_t*)(F.ws + WS_RK); const bf16_t* RV = (const bf16_t*)(F.ws + WS_RV); const bf16_t* RG = (const bf16_t*)(F.ws + WS_RG); bf16_t* ORET = (bf16_t*)(F.ws + WS_ORET);
    int tid = F.tid, lane = F.lane; asm volatile("" : "+v"(tid), "+v"(lane));
    const int wave = F.wave;
    LAS unsigned char* lds = F.lds;
    const float lg2_o = log2f(1.f - exp2f(-5.f - (float)h)), g128 = exp2f(128.f * lg2_o);
    const size_t tok0 = (size_t)b * SEQ;
    v4u kreg[2], vreg[4];
#define RET_LOAD(n) do { _Pragma("unroll") for (int i_ = 0; i_ < 2; ++i_) { const int ci_ = tid + 512 * i_; kreg[i_] = *(const v4u*)(RK + (tok0 + (n) * 128 + (ci_ >> 3)) * 256 + h * 64 + 8 * (ci_ & 7)); } \
        _Pragma("unroll") for (int i_ = 0; i_ < 4; ++i_) { const int ci_ = tid + 512 * i_; vreg[i_] = *(const v4u*)(RV + (tok0 + (n) * 128 + (ci_ >> 4)) * 512 + h * 128 + 8 * (ci_ & 15)); } } while (0)
#define RET_WRITE() do { _Pragma("unroll") for (int i_ = 0; i_ < 2; ++i_) { const int ci_ = tid + 512 * i_, row_ = ci_ >> 3, ch_ = ci_ & 7; const v4u k_ = kreg[i_]; \
            *(LAS v4u*)(lds + L_KT + row_ * 128 + ((ch_ ^ kswz<64>(row_)) << 4)) = k_; const float dk_ = __builtin_amdgcn_exp2f(lg2 * (float)(127 - row_)); v4u d_; \
            d_.x = cvt_pk_bf16(att::bfl(k_.x) * dk_, att::bfh(k_.x) * dk_); d_.y = cvt_pk_bf16(att::bfl(k_.y) * dk_, att::bfh(k_.y) * dk_); d_.z = cvt_pk_bf16(att::bfl(k_.z) * dk_, att::bfh(k_.z) * dk_); d_.w = cvt_pk_bf16(att::bfl(k_.w) * dk_, att::bfh(k_.w) * dk_); \
            *(LAS v4u*)(lds + L_KD + row_ * 128 + ((ch_ ^ vswz<64>(row_)) << 4)) = d_; } \
        _Pragma("unroll") for (int i_ = 0; i_ < 4; ++i_) { const int ci_ = tid + 512 * i_, row_ = ci_ >> 4, ch_ = ci_ & 15; *(LAS v4u*)(lds + L_VT + row_ * 256 + ((ch_ ^ vswz<128>(row_)) << 4)) = vreg[i_]; } } while (0)
    { const float lg2 = lg2_o; RET_LOAD(0); RET_WRITE(); }
    { const v4u z = {0u, 0u, 0u, 0u}; *(LAS v4u*)(lds + L_SB + tid * 32) = z; *(LAS v4u*)(lds + L_SB + tid * 32 + 16) = z; }
    f32x16 st;
#pragma unroll
    for (int r = 0; r < 16; ++r) st[r] = 0.f;
    const int ib = wave & 3, e2 = wave >> 2;
    LAS float* ssb = (LAS float*)(lds + L_SS);
    if (tid < 128) ((LAS float*)(lds + L_G))[tid] = g_ret_out[tid];
    bf16x8 qn[4];
    { const size_t tr0 = tok0 + 32 * ib + (lane & 31);
#pragma unroll
      for (int ks = 0; ks < 4; ++ks) qn[ks] = *(const bf16x8*)(RQ + tr0 * 256 + h * 64 + 16 * ks + 8 * (lane >> 5)); }
    __syncthreads();
    for (int n = 0; n < 32; ++n) {
        int lane_n = lane; float lg2 = lg2_o; asm volatile("" : "+v"(lane_n), "+v"(lg2));
        const int r32 = lane_n & 31, hi = lane_n >> 5, i16 = lane_n & 15, blk = (lane_n >> 4) & 1, tq = i16 >> 2, tp = i16 & 3;
        if (n + 1 < 32) RET_LOAD(n + 1);
        const LAS unsigned char* Sb = lds + L_SB + (n & 1) * 16384; LAS unsigned char* Sn = lds + L_SB + ((n + 1) & 1) * 16384;
        const size_t tokrow = tok0 + n * 128 + 32 * ib + r32;
        f32x16 o[2];
        uint2 rgv[8];
#pragma unroll
        for (int q2 = 0; q2 < 2; ++q2)
#pragma unroll
            for (int g = 0; g < 4; ++g) rgv[q2 * 4 + g] = *(const uint2*)(RG + tokrow * 512 + h * 128 + 64 * e2 + 32 * q2 + 8 * g + 4 * hi);
        {
            bf16x8 qr[4];
#pragma unroll
            for (int ks = 0; ks < 4; ++ks) qr[ks] = qn[ks];
            if (n + 1 < 32) {
#pragma unroll
                for (int ks = 0; ks < 4; ++ks) qn[ks] = *(const bf16x8*)(RQ + (tokrow + 128) * 256 + h * 64 + 16 * ks + 8 * hi); }
#pragma unroll
            for (int q2 = 0; q2 < 2; ++q2) {
#pragma unroll
                for (int r = 0; r < 16; ++r) o[q2][r] = 0.f;
                const int e = 64 * e2 + 32 * q2 + r32;
#pragma unroll
                for (int ks = 0; ks < 4; ++ks) { const bf16x8 a = *(const LAS bf16x8*)(Sb + e * 128 + (((2 * ks + hi) ^ kswz<64>(e)) << 4)); o[q2] = __builtin_amdgcn_mfma_f32_32x32x16_bf16(a, qr[ks], o[q2], 0, 0, 0); } }
            const float gq = __builtin_amdgcn_exp2f(lg2 * (float)(32 * ib + r32 + 1));
#pragma unroll
            for (int q2 = 0; q2 < 2; ++q2)
#pragma unroll
                for (int r = 0; r < 16; ++r) o[q2][r] *= gq;
            __builtin_amdgcn_sched_barrier(0);
#pragma unroll 1
            for (int jb = 0; jb <= ib; ++jb) {
                f32x16 p;
#pragma unroll
                for (int r = 0; r < 16; ++r) p[r] = 0.f;
                const int krow_ = 32 * jb + r32;
#pragma unroll
                for (int ks = 0; ks < 4; ++ks) { const bf16x8 a = *(const LAS bf16x8*)(lds + L_KT + krow_ * 128 + (((2 * ks + hi) ^ kswz<64>(krow_)) << 4)); p = __builtin_amdgcn_mfma_f32_32x32x16_bf16(a, qr[ks], p, 0, 0, 0); }
                const float cl = __builtin_amdgcn_exp2f(lg2 * (float)(32 * (ib - jb) + r32 - 4 * hi));
                const bool diag = (jb == ib);
#pragma unroll
                for (int r = 0; r < 16; ++r) { float v = p[r] * (cl * __builtin_amdgcn_exp2f(-lg2 * (float)((r & 3) + 8 * (r >> 2)))); if (diag && ((r & 3) + 8 * (r >> 2) + 4 * hi) > r32) v = 0.f; p[r] = v; }
#pragma unroll
                for (int s = 0; s < 2; ++s) { const bf16x8 pb = pack8(p, s);
                    const int rowA = 32 * jb + 16 * s + 4 * hi + tq, rowB = rowA + 8;
#pragma unroll
                    for (int q2 = 0; q2 < 2; ++q2) { const int chv = 4 * (2 * e2 + q2) + 2 * blk + (tp >> 1);
                        const s16x4 lo = vtr(lds + L_VT + rowA * 256 + ((chv ^ vswz<128>(rowA)) << 4) + 8 * (tp & 1));
                        const s16x4 hh = vtr(lds + L_VT + rowB * 256 + ((chv ^ vswz<128>(rowB)) << 4) + 8 * (tp & 1));
                        const bf16x8 va = (bf16x8){lo[0], lo[1], lo[2], lo[3], hh[0], hh[1], hh[2], hh[3]};
                        o[q2] = __builtin_amdgcn_mfma_f32_32x32x16_bf16(va, pb, o[q2], 0, 0, 0); }
                    __builtin_amdgcn_sched_barrier(0); }
            }
        }
        __builtin_amdgcn_sched_barrier(0);
        { float ss = 0.f;
#pragma unroll
            for (int q2 = 0; q2 < 2; ++q2)
#pragma unroll
                for (int r = 0; r < 16; ++r) ss += o[q2][r] * o[q2][r];
            ss += __shfl_xor(ss, 32);
            if (hi == 0) ssb[e2 * 128 + 32 * ib + r32] = ss; }
        __builtin_amdgcn_sched_barrier(0);
        { const int eh = wave & 3, dh = wave >> 2;
#pragma unroll
            for (int r = 0; r < 16; ++r) st[r] *= g128;
#pragma unroll 1
            for (int kst = 0; kst < 8; ++kst) { const int rowA = 16 * kst + 4 * hi + tq, rowB = rowA + 8, chv = 4 * eh + 2 * blk + (tp >> 1), chk = 4 * dh + 2 * blk + (tp >> 1);
                const s16x4 lo = vtr(lds + L_VT + rowA * 256 + ((chv ^ vswz<128>(rowA)) << 4) + 8 * (tp & 1));
                const s16x4 hh = vtr(lds + L_VT + rowB * 256 + ((chv ^ vswz<128>(rowB)) << 4) + 8 * (tp & 1));
                const s16x4 kl = vtr(lds + L_KD + rowA * 128 + ((chk ^ vswz<64>(rowA)) << 4) + 8 * (tp & 1));
                const s16x4 kh = vtr(lds + L_KD + rowB * 128 + ((chk ^ vswz<64>(rowB)) << 4) + 8 * (tp & 1));
                const bf16x8 va = (bf16x8){lo[0], lo[1], lo[2], lo[3], hh[0], hh[1], hh[2], hh[3]};
                const bf16x8 kb = (bf16x8){kl[0], kl[1], kl[2], kl[3], kh[0], kh[1], kh[2], kh[3]};
                st = __builtin_amdgcn_mfma_f32_32x32x16_bf16(va, kb, st, 0, 0, 0); }
#pragma unroll
            for (int r = 0; r < 16; ++r) { const int e = 32 * eh + (r & 3) + 8 * (r >> 2) + 4 * hi, dd = 32 * dh + r32;
                *(LAS bf16_t*)(Sn + e * 128 + ((((dd >> 3) ^ kswz<64>(e))) << 4) + (dd & 7) * 2) = f2bf(st[r]); } }
        __builtin_amdgcn_sched_barrier(0);
        __syncthreads();
        { const float rn = 1.f / sqrtf((ssb[32 * ib + r32] + ssb[128 + 32 * ib + r32]) * (1.f / 128.f) + 1e-5f);
#pragma unroll
            for (int q2 = 0; q2 < 2; ++q2)
#pragma unroll
                for (int g = 0; g < 4; ++g) { const int e = 64 * e2 + 32 * q2 + 8 * g + 4 * hi; const f32x4 gg = *(const LAS f32x4*)(lds + L_G + 4 * e); const uint2 rg = rgv[q2 * 4 + g];
                    uint2 w; w.x = cvt_pk_bf16(o[q2][4 * g] * rn * gg[0] * att::bfl(rg.x), o[q2][4 * g + 1] * rn * gg[1] * att::bfh(rg.x)); w.y = cvt_pk_bf16(o[q2][4 * g + 2] * rn * gg[2] * att::bfl(rg.y), o[q2][4 * g + 3] * rn * gg[3] * att::bfh(rg.y));
                    *(uint2*)(ORET + tokrow * 512 + h * 128 + e) = w; } }
        if (n + 1 < 32) RET_WRITE();
        __syncthreads();
    }
#undef RET_LOAD
#undef RET_WRITE
}
}
constexpr int P1_SPARE = 0, P1_CONV = 0;
__device__ __forceinline__ void conv_item(Frame& F, const int c, const float* w1, const float* w2) {
            LAS float* scr = (LAS float*)(F.lds + RING_OFF + F.wave * 16384);
            const bool isw1 = c < 512; const int cc = isw1 ? c : c - 512, e = cc >> 4, kb = cc & 15, nblk = isw1 ? 64 : 32, N = isw1 ? 2048 : 1024;
            const float* Wsrc = isw1 ? w1 + (size_t)e * 1024 * 2048 : w2 + (size_t)e * 1024 * 1024;
            bf16* WT = isw1 ? (bf16*)(F.ws + WS_W1) + (size_t)e * 2048 * 1024 : (bf16*)(F.ws + WS_W2) + (size_t)e * 1024 * 1024;
            float wa[32], wb[32];
            xp_load(wa, Wsrc, N, nblk, kb * nblk + F.wave, F.lane);
#pragma unroll 1
            for (int nb = F.wave; nb < nblk; nb += 16) {
                xp_load(wb, Wsrc, N, nblk, kb * nblk + nb + 8, F.lane);
                xp_finish(wa, 1024, nblk, WT, scr, kb * nblk + nb, F.lane);
                if (nb + 16 < nblk) xp_load(wa, Wsrc, N, nblk, kb * nblk + nb + 16, F.lane);
                xp_finish(wb, 1024, nblk, WT, scr, kb * nblk + nb + 8, F.lane);
            }
}
constexpr int CW_QUEUE = 128;
__device__ __forceinline__ void p2_mixers(Frame& F, const float* g_ret_out, const float* g_mem_q, const float* g_mem_k, const float* w1, const float* w2, const int qword, const int qlo, const int qhi, const int tmask) {
    volatile LAS int* slot = (volatile LAS int*)(F.lds + TB_OFF + 512);
    const bf16_t* MQ = (const bf16_t*)(F.ws + WS_MQ); const bf16_t* MK = (const bf16_t*)(F.ws + WS_MK); const bf16_t* MV = (const bf16_t*)(F.ws + WS_MV); bf16_t* OMO = (bf16_t*)(F.ws + WS_OMOBA);
    const bf16_t* CQ = (const bf16_t*)(F.ws + WS_CQ); const bf16_t* MEMK = (const bf16_t*)(F.ws + WS_MEMK); const bf16_t* MEMV = (const bf16_t*)(F.ws + WS_MEMV); bf16_t* OME = (bf16_t*)(F.ws + WS_OMEM);
    for (;;) {
        __syncthreads();
        if (F.tid == 0) slot[0] = (int)__hip_atomic_fetch_add((unsigned*)F.ctl + qword, 1u, __ATOMIC_RELAXED, __HIP_MEMORY_SCOPE_AGENT);
        __syncthreads();
        const int it = slot[0] + qlo;
        if (it >= qhi) break;
        if (it < 16) { if (tmask & 1) ret::retention_item(F, it >> 2, it & 3, g_ret_out); continue; }
        const int j = it - 16, grp = j / 7, pos = j % 7;
        if (pos & 1) { const int a = 3 * grp + (pos >> 1);
            if (a < 512) { if (!(tmask & 2)) continue; const int qb = 15 - (a >> 5), bh = a & 31, b = bh >> 3, h = bh & 7;
                att::attn_unit<64, true, 2>(F, b, h, qb, MQ, MK + (size_t)b * SEQ * 512, MV + (size_t)b * SEQ * 512, OMO, 512, (const float*)(F.ctl + CW_KMEAN), nullptr, nullptr, nullptr); }
            else { if (!(tmask & 4)) continue; const int u = a - 512, bh = u >> 4, qb = u & 15, b = bh >> 2, h = bh & 3;
                att::attn_unit<128, false, 1>(F, b, h, qb, CQ, MEMK + (size_t)b * MEMLEN * 512, MEMV + (size_t)b * MEMLEN * 512, OME, 512, nullptr, (const float*)(F.ctl + CW_MEMKSS) + (size_t)b * MEMLEN * 4, g_mem_q, g_mem_k); }
        } else { if (!(tmask & 8)) continue; const int c = 4 * grp + (pos >> 1); if (c >= P1_CONV) conv_item(F, c, w1, w2);
        }
    }
}
#define WAVE_LDS_FENCE() do { asm volatile("s_waitcnt lgkmcnt(0)" ::: "memory"); } while (0)
__device__ __forceinline__ void p2_moba_slow(Frame& F) {
    const bf16_t* MQ = (const bf16_t*)(F.ws + WS_MQ); const bf16_t* MK = (const bf16_t*)(F.ws + WS_MK); const bf16_t* MV = (const bf16_t*)(F.ws + WS_MV); const float* KMEAN = (const float*)(F.ctl + CW_KMEAN); bf16_t* OMOBA = (bf16_t*)(F.ws + WS_OMOBA);
    LAS float* sc = (LAS float*)(F.lds) + F.wave * 1152; LAS float* qsh = sc + 1024;
    const int gw = F.vcu * NWAVES + F.wave, NGW = F.G * NWAVES, lane = F.lane;
    for (int w = gw; w < NB * 8 * SEQ; w += NGW) {
        const int t = w & 4095, h = (w >> 12) & 7, b = w >> 15; const int qb = t >> 8; const size_t row = (size_t)b * 4096 + t;
        qsh[lane] = bf2f(MQ[row * 512 + h * 64 + lane]);
        WAVE_LDS_FENCE();
        float q[64];
#pragma unroll
        for (int d = 0; d < 64; ++d) q[d] = qsh[d];
        float gsc = -INFINITY; if (lane < qb) { const float* km = KMEAN + (((size_t)b * 16 + lane) * 8 + h) * 64; float s = 0.f;
#pragma unroll
            for (int d = 0; d < 64; ++d) s += q[d] * km[d];
            gsc = s; }
        int sel[4]; sel[0] = qb;
#pragma unroll
        for (int r = 0; r < 3; ++r) { const float m = wave_max64(gsc); int j = -1; if (m != -INFINITY) { const unsigned long long bal = __ballot(gsc == m); j = __ffsll((long long)bal) - 1; } sel[r + 1] = j; if (lane == j) gsc = -INFINITY; }
        const float slope = exp2f(-(float)(h + 1)); float mx = -INFINITY;
#pragma unroll
        for (int s = 0; s < 4; ++s) { const int blk = sel[s];
            for (int c = 0; c < 4; ++c) { const int kp = blk * 256 + c * 64 + lane; float v = -INFINITY;
                if (blk >= 0 && kp <= t) { const bf16_t* kr = MK + ((size_t)b * 4096 + kp) * 512 + h * 64; float d_ = 0.f;
#pragma unroll
                    for (int d = 0; d < 64; ++d) d_ += q[d] * bf2f(kr[d]);
                    v = d_ * 0.125f - slope * (float)(t - kp); }
                sc[s * 256 + c * 64 + lane] = v; mx = fmaxf(mx, v); } }
        mx = wave_max64(mx); float sum = 0.f;
        for (int i = lane; i < 1024; i += 64) { const float p = __expf(sc[i] - mx); sc[i] = p; sum += p; }
        sum = wave_sum64(sum);
        WAVE_LDS_FENCE();
        float o = 0.f;
#pragma unroll
        for (int s = 0; s < 4; ++s) { const int blk = sel[s]; if (blk >= 0) for (int k = 0; k < 256; ++k) { const float p = sc[s * 256 + k]; if (p != 0.f) o += p * bf2f(MV[((size_t)b * 4096 + blk * 256 + k) * 512 + h * 64 + lane]); } }
        OMOBA[row * 512 + h * 64 + lane] = f2bf(o / sum);
        WAVE_LDS_FENCE();
    }
}
__device__ __forceinline__ void p2_mem_slow(Frame& F, const float* g_mem_q, const float* g_mem_k) {
    const bf16_t* CQ = (const bf16_t*)(F.ws + WS_CQ); const bf16_t* MEMK = (const bf16_t*)(F.ws + WS_MEMK); const bf16_t* MEMV = (const bf16_t*)(F.ws + WS_MEMV); const float* MEMKSS = (const float*)(F.ctl + CW_MEMKSS); bf16_t* OMEM = (bf16_t*)(F.ws + WS_OMEM);
    LAS float* sc = (LAS float*)(F.lds) + F.wave * 1152; LAS float* qsh = sc + 1024;
    const int gw = F.vcu * NWAVES + F.wave, NGW = F.G * NWAVES, lane = F.lane;
    for (int w = gw; w < NB * 4 * SEQ; w += NGW) {
        const int t = w & 4095, h = (w >> 12) & 3, b = w >> 14; const size_t row = (size_t)b * 4096 + t;
        const float q0 = bf2f(CQ[row * 512 + h * 128 + lane]), q1 = bf2f(CQ[row * 512 + h * 128 + 64 + lane]);
        const float rq = 1.f / sqrtf(wave_sum64(q0 * q0 + q1 * q1) * (1.f / 128.f) + 1e-5f);
        qsh[lane] = q0 * rq * g_mem_q[lane] * g_mem_k[lane]; qsh[lane + 64] = q1 * rq * g_mem_q[lane + 64] * g_mem_k[lane + 64];
        WAVE_LDS_FENCE();
        float mx = -INFINITY;
        for (int c = 0; c < 4; ++c) { const int m = c * 64 + lane; const bf16_t* kr = MEMK + ((size_t)b * 256 + m) * 512 + h * 128; float d_ = 0.f; for (int d = 0; d < 128; ++d) d_ += qsh[d] * bf2f(kr[d]);
            const float rk = 1.f / sqrtf(MEMKSS[((size_t)b * 256 + m) * 4 + h] * (1.f / 128.f) + 1e-5f); const float v = d_ * rk * 0.08838834764831845f; sc[m] = v; mx = fmaxf(mx, v); }
        mx = wave_max64(mx); float sum = 0.f;
        for (int i = lane; i < 256; i += 64) { const float p = __expf(sc[i] - mx); sc[i] = p; sum += p; }
        sum = wave_sum64(sum); WAVE_LDS_FENCE();
        float o0 = 0.f, o1 = 0.f;
        for (int k = 0; k < 256; ++k) { const float p = sc[k]; const bf16_t* vr = MEMV + ((size_t)b * 256 + k) * 512 + h * 128; o0 += p * bf2f(vr[lane]); o1 += p * bf2f(vr[lane + 64]); }
        OMEM[row * 512 + h * 128 + lane] = f2bf(o0 / sum); OMEM[row * 512 + h * 128 + 64 + lane] = f2bf(o1 / sum);
        WAVE_LDS_FENCE();
    }
}
__device__ __forceinline__ void p2_ret_slow(Frame& F, const float* g_ret_out) {
    const bf16_t* RQ = (const bf16_t*)(F.ws + WS_RQ); const bf16_t* RK = (const bf16_t*)(F.ws + WS_RK); const bf16_t* RV = (const bf16_t*)(F.ws + WS_RV); const bf16_t* RG = (const bf16_t*)(F.ws + WS_RG); bf16_t* ORET = (bf16_t*)(F.ws + WS_ORET);
    LAS float* qs = (LAS float*)(F.lds) + 16384; LAS float* ks = qs + 64; LAS float* part = ks + 64; LAS float* red = part + 256;
    const int tid = F.tid, e = tid & 127, hf = (tid >> 7) & 1;
    for (int it = F.vcu; it < 16; it += F.G) {
        const int b = it >> 2, h = it & 3; const float gamma = 1.f - exp2f(-5.f - (float)h);
        float s[32];
#pragma unroll
        for (int i = 0; i < 32; ++i) s[i] = 0.f;
        for (int t = 0; t < 4096; ++t) { const size_t row = (size_t)b * 4096 + t;
            if (tid < 64) qs[tid] = bf2f(RQ[row * 256 + h * 64 + tid]); else if (tid < 128) ks[tid - 64] = bf2f(RK[row * 256 + h * 64 + tid - 64]);
            const float v = bf2f(RV[row * 512 + h * 128 + e]);
            __syncthreads();
            float o = 0.f;
            if (tid < 256) {
#pragma unroll
                for (int i = 0; i < 32; ++i) { s[i] = gamma * s[i] + ks[hf * 32 + i] * v; o += qs[hf * 32 + i] * s[i]; }
                part[tid] = o; }
            __syncthreads();
            float ov = 0.f;
            if (tid < 128) { ov = part[tid] + part[tid + 128]; const float ss = wave_sum64(ov * ov); if ((tid & 63) == 0) red[tid >> 6] = ss; }
            __syncthreads();
            if (tid < 128) { const float r = 1.f / sqrtf((red[0] + red[1]) * (1.f / 128.f) + 1e-5f); ORET[row * 512 + h * 128 + tid] = f2bf(ov * r * g_ret_out[tid] * bf2f(RG[row * 512 + h * 128 + tid])); }
        }
    }
}
constexpr int N_PHASES = 9;
#ifndef PROBE_MASK
#define PROBE_MASK 0
#endif
constexpr int P2_NITEMS = 16 + 7 * 256;
#ifndef P2_LO
#define P2_LO 0
#define P2_HI P2_NITEMS
#endif
#ifndef P2_TMASK
#define P2_TMASK 15
#endif
#define NREP(k) ((((PROBE_MASK) >> (k)) & 1) ? 2 : 1)
__global__ void __launch_bounds__(NWAVES * 64, 2) mega(Args args) {
    extern __shared__ __attribute__((aligned(16))) unsigned char lds[];
    Frame F;
    F.lds = (LAS unsigned char*)lds; F.MISC = (volatile LAS unsigned*)(F.lds + MISC_OFF);
    F.tid = threadIdx.x; F.lane = F.tid & 63; F.wave = __builtin_amdgcn_readfirstlane(F.tid >> 6);
    F.G = gridDim.x; { const int bx = blockIdx.x; F.vcu = (F.G % 8 == 0) ? (bx % 8) * (F.G / 8) + bx / 8 : bx; }
    F.ws = args.ws; F.out = args.out; F.ctl = (gu32*)(args.ws + WS_CTL);
    for (int u = F.tid; u < (LDS_BYTES - LDSCTL_OFF) / 4; u += NWAVES * 64) ((LAS unsigned*)(F.lds + LDSCTL_OFF))[u] = 0u;
    __syncthreads();
    XcdBarrier bar = xcd_barrier_post((unsigned*)(F.ctl + CW_BAR) + args.li * XCD_BAR_WORDS, F.MISC + 8);
    const int lo = args.ph_lo, hi = args.ph_hi;
#define IN(k) (lo <= (k) && (k) < hi)
#define BOTH(k) (IN(k) && IN((k) + 1))
    if (IN(0)) { for (int rep = 0; rep < NREP(0); ++rep) p0_prologue(F, args); if (BOTH(0)) xcd_barrier(bar); }
    if (IN(1)) {
        pg8::Gemm g{(const pg8::bf16_t*)(F.ws + WS_HB), (const pg8::bf16_t*)(F.ws + WS_WIN), NTOK + 1024, DIN + 1024, 1024};
        const int G1 = F.G - P1_SPARE; const bool p1_gemm = (int)blockIdx.x < G1;
        P1Order S; S.init(G1, p1_gemm ? (int)blockIdx.x : 0);
        EpiP1 E{F.ws, args.in[4], (const float*)(F.ws + WS_GTAB), (float*)(F.ctl + CW_KMEAN), (float*)(F.ctl + CW_MEMKSS), 1};
        if (p1_gemm) pg8::gemm_phase<EpiP1, P1Order, true, true>(F.lds + RING_OFF, g, S, E);
        else { for (int c = (int)blockIdx.x - G1; c < P1_CONV; c += (P1_SPARE ? P1_SPARE : 1)) { conv_item(F, c, args.in[19], args.in[21]); __syncthreads(); } }
        if (NREP(1) > 1) { xcd_barrier(bar); E.atom_on = 0; pg8::gemm_phase<EpiP1, P1Order, true, true>(F.lds + RING_OFF, g, S, E); }
        if (BOTH(1)) xcd_barrier(bar);
    }
    if (IN(2)) {
        p2_mixers(F, args.in[5], args.in[10], args.in[11], args.in[19], args.in[21], CW_QUEUE, 0, P2_NITEMS, 15);
        if (NREP(2) > 1) { xcd_barrier(bar); p2_mixers(F, args.in[5], args.in[10], args.in[11], args.in[19], args.in[21], CW_QUEUE + 1024, P2_LO, P2_HI, P2_TMASK); }
        if (BOTH(2)) xcd_barrier(bar);
    }
    if (IN(3)) {
        P3Order S; S.init(F.G, (int)blockIdx.x, F.ws); EpiP3 E{(const bf16_t*)(F.ws + WS_GT), (bf16_t*)(F.ws + WS_Y)};
        pg9::gemm_phase<EpiP3, P3Order, false>(F.lds + RING_OFF, 512, 512, 512, S, E);
        if (NREP(3) > 1) pg9::gemm_phase<EpiP3, P3Order, false>(F.lds + RING_OFF, 512, 512, 512, S, E);
        if (BOTH(3)) xcd_barrier(bar);
    }
    if (IN(4)) {
        P4Order S; S.init(F.G, (int)blockIdx.x, F.ws); EpiP4 E{args.in[0], F.out};
        pg9::gemm_phase<EpiP4, P4Order, false>(F.lds + RING_OFF, 1024, 1024, 1024, S, E);
        if (NREP(4) > 1) pg9::gemm_phase<EpiP4, P4Order, false>(F.lds + RING_OFF, 1024, 1024, 1024, S, E);
        if (BOTH(4)) xcd_barrier(bar);
    }
    if (IN(5)) { p5_router(F, F.out, args.in[16], args.in[17], args.in[18], (int*)F.ctl + CW_COUNTS, (int*)(F.ws + WS_LISTS));
        if (NREP(5) > 1) p5_router(F, F.out, args.in[16], args.in[17], args.in[18], (int*)F.ctl + CW_COUNTS + 256, (int*)(F.ws + WS_RETST));
        if (BOTH(5)) xcd_barrier(bar); }
    if (IN(6)) {
        moe_tables(F);
        MoeOrder<3, WS_W1, 2048, 2, WS_XT> S; S.init(F.G, F.vcu, F.ws, (const LAS int*)(F.lds + TB_OFF));
        EpiMoe1 E{(const int*)(F.ws + WS_LISTS), args.in[20], (bf16_t*)(F.ws + WS_ACT)};
        pg9::gemm_phase<EpiMoe1, MoeOrder<3, WS_W1, 2048, 2, WS_XT>, true>(F.lds + RING_OFF, 1024, 1024, 1024, S, E);
        if (NREP(6) > 1) { xcd_barrier(bar); } if (NREP(6) > 1) pg9::gemm_phase<EpiMoe1, MoeOrder<3, WS_W1, 2048, 2, WS_XT>, true>(F.lds + RING_OFF, 1024, 1024, 1024, S, E);
        if (BOTH(6)) xcd_barrier(bar);
    }
    if (IN(7)) {
        moe_tables(F);
        MoeOrder<2, WS_W2, 1024, 0, WS_ACT> S; S.init(F.G, F.vcu, F.ws, (const LAS int*)(F.lds + TB_OFF));
        EpiMoe2 E{(const int*)(F.ws + WS_LISTS), args.in[22], (bf16_t*)(F.ws + WS_YS)};
        pg9::gemm_phase<EpiMoe2, MoeOrder<2, WS_W2, 1024, 0, WS_ACT>, true>(F.lds + RING_OFF, 1024, 1024, 1024, S, E);
        if (NREP(7) > 1) { xcd_barrier(bar); } if (NREP(7) > 1) pg9::gemm_phase<EpiMoe2, MoeOrder<2, WS_W2, 1024, 0, WS_ACT>, true>(F.lds + RING_OFF, 1024, 1024, 1024, S, E);
        if (BOTH(7)) xcd_barrier(bar);
    }
    if (IN(8)) { p8_combine(F, F.out, F.out); if (NREP(8) > 1) p8_combine(F, F.out, (float*)(F.ws + WS_HB)); }
    if (NREP(9) > 1) { for (int i = 0; i < 16; ++i) xcd_barrier(bar); }
#undef IN
#undef BOTH
}
#ifndef MK_ONE_LAUNCH
#define MK_ONE_LAUNCH 1
#endif
extern "C" void kernel_launch(void* const* d_in, const int* in_sizes, int n_in, void* d_out, int out_size, void* d_ws, size_t ws_size, hipStream_t stream) {
    if (ws_size < WS_END) { fprintf(stderr, "kernel_launch: ws too small %zu < %zu\n", ws_size, (size_t)WS_END); return; }
    unsigned char* ws = (unsigned char*)d_ws; float* out = (float*)d_out;
    static int grid = 0;
    if (grid == 0) {
        int dev = 0, cus = 0; if (hipGetDevice(&dev) != hipSuccess || hipDeviceGetAttribute(&cus, hipDeviceAttributeMultiprocessorCount, dev) != hipSuccess) { fprintf(stderr, "kernel_launch: device query failed\n"); grid = -1; return; }
        if (hipFuncSetAttribute((const void*)mega, hipFuncAttributeMaxDynamicSharedMemorySize, LDS_BYTES) != hipSuccess) { fprintf(stderr, "kernel_launch: hipFuncSetAttribute failed\n"); grid = -1; return; }
        (void)hipGetLastError(); grid = cus;
    }
    if (grid < 0) return;
    (void)hipMemsetAsync(ws + WS_CTL, 0, 1 * MiB, stream);
    Args a; memset(&a, 0, sizeof a); for (int i = 0; i < 23; ++i) a.in[i] = (const float*)d_in[i]; a.out = out; a.ws = ws; a.li = 0;
#if MK_ONE_LAUNCH
    a.ph_lo = 0; a.ph_hi = N_PHASES;
    hipLaunchKernelGGL(mega, dim3(grid), dim3(NWAVES * 64), LDS_BYTES, stream, a);
#else
    for (int p = 0; p < N_PHASES; ++p) { a.ph_lo = p; a.ph_hi = p + 1; hipLaunchKernelGGL(mega, dim3(grid), dim3(NWAVES * 64), LDS_BYTES, stream, a); }
#endif
}
```

```cpp
#define PROBE_MASK 0
#include <hip/hip_runtime.h>
#include <cstdio>
#include <cstdint>
#include <cstring>
typedef unsigned short bf16_t;
__host__ __device__ inline float bf2f(bf16_t v) { unsigned u = ((unsigned)v) << 16; float f; __builtin_memcpy(&f, &u, 4); return f; }
__host__ __device__ inline bf16_t f2bf(float f) { unsigned u; __builtin_memcpy(&u, &f, 4); u += 0x7fffu + ((u >> 16) & 1u); return (bf16_t)(u >> 16); }
constexpr int NTOK = 16384, SEQ = 4096, NB = 4, DM = 1024, DIN = 6656, MEMLEN = 256, NEXP = 32;
constexpr size_t MiB = (size_t)1 << 20;
constexpr size_t WS_CTL = 0;
constexpr size_t WS_WIN = 1 * MiB;
constexpr size_t WS_WMEMKV = 14 * MiB;
constexpr size_t WS_WBR = 16 * MiB;
constexpr size_t WS_WOUT = 19 * MiB;
constexpr size_t WS_W1 = 21 * MiB;
constexpr size_t WS_W2 = 149 * MiB;
constexpr size_t WS_HB = 213 * MiB;
constexpr size_t WS_HM = 245 * MiB;
constexpr size_t WS_RQ = 247 * MiB, WS_RK = 255 * MiB, WS_RV = 263 * MiB, WS_RG = 279 * MiB, WS_MQ = 295 * MiB, WS_MK = 311 * MiB, WS_MV = 327 * MiB, WS_CQ = 343 * MiB, WS_GT = 359 * MiB;
constexpr size_t WS_MEMK = 455 * MiB, WS_MEMV = 456 * MiB, WS_KMEAN = 457 * MiB, WS_MEMKSS = 457 * MiB + 512 * 1024;
constexpr size_t WS_GTAB = 457 * MiB + 768 * 1024;
constexpr size_t WS_ORET = 458 * MiB, WS_OMOBA = 474 * MiB, WS_OMEM = 490 * MiB;
constexpr size_t WS_Y = 506 * MiB, WS_XT = 538 * MiB;
constexpr size_t WS_TOPE = 570 * MiB, WS_TOPW = 570 * MiB + 256 * 1024, WS_LISTS = 571 * MiB;
constexpr size_t WS_ACT = 574 * MiB;
constexpr size_t WS_YS = 703 * MiB;
constexpr size_t WS_RETST = 959 * MiB;
constexpr size_t WS_END = 832 * MiB;
constexpr size_t WS_PROJ = 574 * MiB;
constexpr size_t WS_PM = 990 * MiB;
constexpr size_t WS_ORAW = 574 * MiB;
constexpr size_t WS_T0 = 703 * MiB, WS_T1 = 767 * MiB, WS_T2 = 831 * MiB;
constexpr int CW_COUNTS = 64;
namespace pg8 {
#define PG8_LAS __attribute__((address_space(3)))
typedef unsigned short bf16_t;
typedef short bf16x8 __attribute__((ext_vector_type(8)));
typedef float f32x4 __attribute__((ext_vector_type(4)));
typedef unsigned u32x4 __attribute__((ext_vector_type(4)));
constexpr int BM = 256, BK = 64, HALF = 128, HTB = HALF * BK * 2  , STAGE_BYTES = 8 * HTB, NXCD = 8, WGM = 8;

__host__ __device__ __forceinline__ int lds_byte(int r, int c) { const int st = (r >> 4) * 2 + (c >> 5), rr = r & 15, cc = c & 31, ob = rr * 64 + cc * 2; return st * 1024 + (ob ^ (((ob >> 9) & 1) << 5)); }
__host__ __device__ __forceinline__ void stage_rc(int b, int& R, int& C) { const int st = b / 1024, sb = b % 1024, swz = sb ^ (((sb >> 9) & 1) << 5); R = (st >> 1) * 16 + swz / 64; C = (st & 1) * 32 + (swz % 64) / 2; }
__host__ __device__ __forceinline__ int perm32(int rho) { const int n = rho >> 4, i = rho & 15; return 8 * (i >> 2) + 4 * n + (i & 3); }

struct Unit { int pm, pn; };
struct Gemm { const bf16_t* A; const bf16_t* Bt; int M, N, K; };
struct StaticOrder {
    int nM, nN, nwg, G, c;
    __host__ __device__ void init(int M, int N, int G_, int c_) { nM = M / BM; nN = N / BM; nwg = nM * nN; G = G_; c = c_; }
    __host__ __device__ bool next(int i, Unit& u) const {
        const long L = (long)i * G + c; if (L >= nwg) return false;
        int wgid = (int)L; { const int q = nwg / NXCD, r = nwg % NXCD, xcd = wgid % NXCD, off = wgid / NXCD; wgid = (xcd < r ? xcd * (q + 1) : r * (q + 1) + (xcd - r) * q) + off; }
        const int nig = WGM * nN, gid = wgid / nig, fm = gid * WGM, gsz = (nM - fm) < WGM ? (nM - fm) : WGM;
        u.pm = fm + ((wgid % nig) % gsz); u.pn = (wgid % nig) / gsz; return true;
    }
    __device__ __forceinline__ void a_ready(const Unit&) const {}
    __device__ __forceinline__ void done(const Unit&) const {}
};
__device__ __forceinline__ unsigned cvt_pk_bf16(float lo, float hi) { unsigned r; asm volatile("v_cvt_pk_bf16_f32 %0, %1, %2" : "=v"(r) : "v"(lo), "v"(hi)); return r; }
typedef float f32x2 __attribute__((ext_vector_type(2)));
template <class Epi, class Sched, bool ALIGN_EPI = false, bool SP2 = false>
__device__ __forceinline__ void gemm_phase(PG8_LAS unsigned char* lds, const Gemm g, const Sched& S, const Epi& E) {
    const int tid = threadIdx.x, wid = __builtin_amdgcn_readfirstlane(tid >> 6), lane = tid & 63, wr = wid >> 2, wc = wid & 3, fr = lane & 15, fq = lane >> 4;
    const int K = g.K, nt = K / BK;
    unsigned voffA[2], voffB[2];
#pragma unroll
    for (int i = 0; i < 2; ++i) { int R, C; stage_rc(tid * 16 + i * 8192, R, C); const int Rb = Epi::PERM ? ((R & ~31) + perm32(R & 31)) : R;
        voffA[i] = (unsigned)(R * K + C) * 2u; voffB[i] = (unsigned)(Rb * K + C) * 2u; }
    const size_t kstep = (size_t)(BK * 2);
    const size_t hstep = (size_t)HALF * K * 2;
    const size_t tstep = 2 * hstep;
    const unsigned ldsw = (unsigned)wid * 1024u;
    const int aoff = lds_byte(wr * 64 + fr, fq * 8), boff = lds_byte(wc * 32 + fr, fq * 8);
#define PG8_SA(b, h) (((b) * 2 + (h)) * HTB)
#define PG8_SB(b, h) ((4 + (b) * 2 + (h)) * HTB)
#define PG8_STAGE(bufoff, gbase, voff) do { _Pragma("unroll") for (int _i = 0; _i < 2; ++_i) \
        __builtin_amdgcn_global_load_lds((const unsigned*)((const char*)(gbase) + (voff)[_i]), (PG8_LAS unsigned*)(lds + (bufoff) + ldsw + _i * 8192), 16, 0, 0); } while (0)
#define PG8_LDA(dst, b, h) do { _Pragma("unroll") for (int m = 0; m < 4; ++m) _Pragma("unroll") for (int k = 0; k < 2; ++k) dst[m][k] = *(const PG8_LAS bf16x8*)(lds + PG8_SA(b, h) + aoff + m * 2048 + k * 1024); } while (0)
#define PG8_LDB(dst, b, h) do { _Pragma("unroll") for (int n = 0; n < 2; ++n) _Pragma("unroll") for (int k = 0; k < 2; ++k) dst[n][k] = *(const PG8_LAS bf16x8*)(lds + PG8_SB(b, h) + boff + n * 2048 + k * 1024); } while (0)
#define PG8_MMA(ai, bj, At, Bt) do { __builtin_amdgcn_s_setprio(1); _Pragma("unroll") for (int m = 0; m < 4; ++m) _Pragma("unroll") for (int n = 0; n < 2; ++n) _Pragma("unroll") for (int k = 0; k < 2; ++k) \
        acc[ai][bj][m][n] = __builtin_amdgcn_mfma_f32_16x16x32_bf16(Bt[n][k], At[m][k], acc[ai][bj][m][n], 0, 0, 0); __builtin_amdgcn_s_setprio(0); } while (0)
#define PG8_WAIT_V(n) asm volatile("s_waitcnt vmcnt(" #n ")" ::: "memory")
#define PG8_WAIT_L(n) asm volatile("s_waitcnt lgkmcnt(" #n ")" ::: "memory")
#define PG8_BAR __builtin_amdgcn_s_barrier()
#define PG8_SCHED __builtin_amdgcn_sched_barrier(0)
    Unit cur, nxt; int ui = 0;
    if (!S.next(0, cur)) return;
    f32x4 acc[2][2][4][2];
#pragma unroll
    for (int a = 0; a < 2; ++a)
#pragma unroll
        for (int b = 0; b < 2; ++b)
#pragma unroll
            for (int m = 0; m < 4; ++m)
#pragma unroll
                for (int n = 0; n < 2; ++n) acc[a][b][m][n] = (f32x4){0.f, 0.f, 0.f, 0.f};
    bf16x8 At[4][2], B0[2][2], B1[2][2];
    const char* cA = (const char*)g.A + (size_t)cur.pm * tstep; const char* cB = (const char*)g.Bt + (size_t)cur.pn * tstep;
    S.a_ready(cur);
    if constexpr (SP2) {
        PG8_STAGE(PG8_SB(0, 0), cB, voffB); PG8_STAGE(PG8_SB(0, 1), cB + hstep, voffB); PG8_STAGE(PG8_SA(0, 0), cA, voffA); PG8_STAGE(PG8_SA(0, 1), cA + hstep, voffA);
        if (wr == 1) PG8_BAR;
        PG8_WAIT_V(2); PG8_BAR;
        PG8_STAGE(PG8_SB(1, 0), cB + kstep, voffB); PG8_STAGE(PG8_SA(1, 0), cA + kstep, voffA); PG8_STAGE(PG8_SB(1, 1), cB + hstep + kstep, voffB);
        PG8_WAIT_V(6); PG8_BAR;
    } else {
        PG8_STAGE(PG8_SB(0, 0), cB, voffB); PG8_STAGE(PG8_SA(0, 0), cA, voffA); PG8_STAGE(PG8_SB(0, 1), cB + hstep, voffB); PG8_STAGE(PG8_SA(0, 1), cA + hstep, voffA);
        if (wr == 1) PG8_BAR;
        PG8_WAIT_V(4); PG8_BAR;
        PG8_STAGE(PG8_SB(1, 0), cB + kstep, voffB); PG8_STAGE(PG8_SA(1, 0), cA + kstep, voffA); PG8_STAGE(PG8_SB(1, 1), cB + hstep + kstep, voffB);
        PG8_WAIT_V(6); PG8_BAR;
    }
    for (;;) {
        const bool has_next = S.next(ui + 1, nxt);
        const char* nA = has_next ? (const char*)g.A + (size_t)nxt.pm * tstep : cA; const char* nB = has_next ? (const char*)g.Bt + (size_t)nxt.pn * tstep : cB;
        for (int t = 0; t < nt; t += 2) {
            const bool last = (t == nt - 2);
            const char* a1 = cA + (size_t)(t + 1) * kstep;
            const char* a2 = last ? nA : cA + (size_t)(t + 2) * kstep; const char* b2 = last ? nB : cB + (size_t)(t + 2) * kstep;
            const char* a3 = a2 + kstep; const char* b3 = b2 + kstep;
            if (last && has_next) S.a_ready(nxt);
            if constexpr (SP2) {
            PG8_LDB(B0, 0, 0); PG8_LDB(B1, 0, 1); PG8_SCHED; PG8_LDA(At, 0, 0); PG8_STAGE(PG8_SA(1, 1), a1 + hstep, voffA);
            PG8_WAIT_V(8); PG8_WAIT_L(0); PG8_BAR; PG8_MMA(0, 0, At, B0); PG8_MMA(0, 1, At, B1); PG8_BAR; PG8_SCHED;
            PG8_LDA(At, 0, 1); PG8_STAGE(PG8_SB(0, 0), b2, voffB); PG8_STAGE(PG8_SB(0, 1), b2 + hstep, voffB); PG8_STAGE(PG8_SA(0, 0), a2, voffA);
            PG8_WAIT_V(8); PG8_WAIT_L(0); PG8_BAR; PG8_MMA(1, 0, At, B0); PG8_MMA(1, 1, At, B1); PG8_BAR; PG8_SCHED;
            PG8_LDB(B0, 1, 0); PG8_LDB(B1, 1, 1); PG8_SCHED; PG8_LDA(At, 1, 0); PG8_STAGE(PG8_SA(0, 1), a2 + hstep, voffA);
            PG8_WAIT_V(8); PG8_WAIT_L(0); PG8_BAR; PG8_MMA(0, 0, At, B0); PG8_MMA(0, 1, At, B1); PG8_BAR; PG8_SCHED;
            PG8_LDA(At, 1, 1); PG8_STAGE(PG8_SB(1, 0), b3, voffB); PG8_STAGE(PG8_SB(1, 1), b3 + hstep, voffB); PG8_STAGE(PG8_SA(1, 0), a3, voffA);
            PG8_WAIT_V(8); PG8_WAIT_L(0); PG8_BAR; PG8_MMA(1, 0, At, B0); PG8_MMA(1, 1, At, B1); PG8_BAR; PG8_SCHED;
            } else {
            PG8_LDB(B0, 0, 0); PG8_SCHED; PG8_LDA(At, 0, 0); PG8_STAGE(PG8_SA(1, 1), a1 + hstep, voffA);
            PG8_WAIT_L(8); PG8_BAR; PG8_WAIT_L(0); PG8_MMA(0, 0, At, B0); PG8_BAR; PG8_SCHED;
            PG8_LDB(B1, 0, 1); PG8_STAGE(PG8_SB(0, 0), b2, voffB);
            PG8_BAR; PG8_WAIT_L(0); PG8_MMA(0, 1, At, B1); PG8_BAR;
            PG8_LDA(At, 0, 1); PG8_STAGE(PG8_SA(0, 0), a2, voffA);
            PG8_BAR; PG8_WAIT_L(0); PG8_MMA(1, 0, At, B0); PG8_BAR; PG8_SCHED;
            PG8_STAGE(PG8_SB(0, 1), b2 + hstep, voffB);
            PG8_WAIT_V(6); PG8_BAR; PG8_MMA(1, 1, At, B1); PG8_BAR;
            PG8_LDB(B0, 1, 0); PG8_SCHED; PG8_LDA(At, 1, 0); PG8_STAGE(PG8_SA(0, 1), a2 + hstep, voffA);
            PG8_WAIT_L(8); PG8_BAR; PG8_WAIT_L(0); PG8_MMA(0, 0, At, B0); PG8_BAR; PG8_SCHED;
            PG8_LDB(B1, 1, 1); PG8_STAGE(PG8_SB(1, 0), b3, voffB);
            PG8_BAR; PG8_WAIT_L(0); PG8_MMA(0, 1, At, B1); PG8_BAR;
            PG8_LDA(At, 1, 1); PG8_STAGE(PG8_SA(1, 0), a3, voffA);
            PG8_BAR; PG8_WAIT_L(0); PG8_MMA(1, 0, At, B0); PG8_BAR; PG8_SCHED;
            PG8_STAGE(PG8_SB(1, 1), b3 + hstep, voffB);
            PG8_WAIT_V(6); PG8_BAR; PG8_MMA(1, 1, At, B1); PG8_BAR;
            }
        }
        if constexpr (ALIGN_EPI) { if (wr == 0) PG8_BAR; }
        if constexpr (!Epi::AFTER_DRAIN) { E(acc, cur, wr, wc, fr, fq); S.done(cur); }
        if (!has_next) break;
#pragma unroll
        for (int a = 0; a < 2; ++a)
#pragma unroll
            for (int b = 0; b < 2; ++b)
#pragma unroll
                for (int m = 0; m < 4; ++m)
#pragma unroll
                    for (int n = 0; n < 2; ++n) acc[a][b][m][n] = (f32x4){0.f, 0.f, 0.f, 0.f};
        cur = nxt; cA = nA; cB = nB; ++ui;
        if constexpr (ALIGN_EPI) { if (wr == 1) PG8_BAR; }
    }
    PG8_WAIT_V(0);
    if constexpr (!ALIGN_EPI) { if (wr == 0) PG8_BAR; }
    PG8_BAR;
    if constexpr (Epi::AFTER_DRAIN) { E.fused(acc, cur, wr, wc, fr, fq, lds, wid, lane); S.done(cur); }
#undef PG8_SA
#undef PG8_SB
#undef PG8_STAGE
#undef PG8_LDA
#undef PG8_LDB
#undef PG8_MMA
#undef PG8_WAIT_V
#undef PG8_WAIT_L
#undef PG8_BAR
#undef PG8_SCHED
}
}
namespace pg9 {
using pg8::bf16x8; using pg8::f32x4; using pg8::u32x4; using pg8::lds_byte; using pg8::stage_rc; using pg8::perm32;
constexpr int BK = 64, HALF = 128, HTB = HALF * BK * 2;
struct Unit { int pm, pn, aux, cnt; };
template <class Epi, class Sched, bool GATHER>
__device__ __forceinline__ void gemm_phase(PG8_LAS unsigned char* lds, const int K, const int lda, const int ldb, const Sched& S, const Epi& E) {
    const int tid = threadIdx.x, wid = __builtin_amdgcn_readfirstlane(tid >> 6), lane = tid & 63, wr = wid >> 2, wc = wid & 3, fr = lane & 15, fq = lane >> 4;
    const int nt = K / BK;
    unsigned offA[2][2], offAn[2][2], offB[2][2]; int RA[2], CA[2];
#pragma unroll
    for (int i = 0; i < 2; ++i) { int R, C; stage_rc(tid * 16 + i * 8192, R, C); const int Rb = Epi::PERM ? ((R & ~31) + perm32(R & 31)) : R; RA[i] = R; CA[i] = C * 2;
#pragma unroll
        for (int h = 0; h < 2; ++h) { offB[h][i] = (unsigned)((Rb + 128 * h) * ldb + C) * 2u; offA[h][i] = (unsigned)((R + 128 * h) * lda + C) * 2u; offAn[h][i] = offA[h][i]; } }
    const size_t kstep = (size_t)(BK * 2);
    const unsigned ldsw = (unsigned)wid * 1024u;
    const int aoff = lds_byte(wr * 64 + fr, fq * 8), boff = lds_byte(wc * 32 + fr, fq * 8);
#define PG9_SA(b, h) (((b) * 2 + (h)) * HTB)
#define PG9_SB(b, h) ((4 + (b) * 2 + (h)) * HTB)
#define PG9_STAGE(bufoff, gbase, voff) do { _Pragma("unroll") for (int _i = 0; _i < 2; ++_i) \
        __builtin_amdgcn_global_load_lds((const unsigned*)((const char*)(gbase) + (voff)[_i]), (PG8_LAS unsigned*)(lds + (bufoff) + ldsw + _i * 8192), 16, 0, 0); } while (0)
#define PG9_LDA(dst, b, h) do { _Pragma("unroll") for (int m = 0; m < 4; ++m) _Pragma("unroll") for (int k = 0; k < 2; ++k) dst[m][k] = *(const PG8_LAS bf16x8*)(lds + PG9_SA(b, h) + aoff + m * 2048 + k * 1024); } while (0)
#define PG9_LDB(dst, b, h) do { _Pragma("unroll") for (int n = 0; n < 2; ++n) _Pragma("unroll") for (int k = 0; k < 2; ++k) dst[n][k] = *(const PG8_LAS bf16x8*)(lds + PG9_SB(b, h) + boff + n * 2048 + k * 1024); } while (0)
#define PG9_MMA(ai, bj, At, Bt) do { __builtin_amdgcn_s_setprio(1); _Pragma("unroll") for (int m = 0; m < 4; ++m) _Pragma("unroll") for (int n = 0; n < 2; ++n) _Pragma("unroll") for (int k = 0; k < 2; ++k) \
        acc[ai][bj][m][n] = __builtin_amdgcn_mfma_f32_16x16x32_bf16(Bt[n][k], At[m][k], acc[ai][bj][m][n], 0, 0, 0); __builtin_amdgcn_s_setprio(0); } while (0)
#define PG9_WAIT_V(n) asm volatile("s_waitcnt vmcnt(" #n ")" ::: "memory")
#define PG9_WAIT_L(n) asm volatile("s_waitcnt lgkmcnt(" #n ")" ::: "memory")
#define PG9_BAR __builtin_amdgcn_s_barrier()
#define PG9_SCHED __builtin_amdgcn_sched_barrier(0)
    Unit cur, nxt; int ui = 0;
    if (!S.next(0, cur)) return;
    f32x4 acc[2][2][4][2];
#pragma unroll
    for (int a = 0; a < 2; ++a)
#pragma unroll
        for (int b = 0; b < 2; ++b)
#pragma unroll
            for (int m = 0; m < 4; ++m)
#pragma unroll
                for (int n = 0; n < 2; ++n) acc[a][b][m][n] = (f32x4){0.f, 0.f, 0.f, 0.f};
    bf16x8 At[4][2], B0[2][2], B1[2][2];
    const char* cA = S.a_base(cur); const char* cB = S.b_base(cur);
    if constexpr (GATHER) {
#pragma unroll
        for (int h = 0; h < 2; ++h)
#pragma unroll
            for (int i = 0; i < 2; ++i) offA[h][i] = S.a_row_off(cur, RA[i] + 128 * h) + (unsigned)CA[i];
    }
    PG9_STAGE(PG9_SB(0, 0), cB, offB[0]); PG9_STAGE(PG9_SB(0, 1), cB, offB[1]); PG9_STAGE(PG9_SA(0, 0), cA, offA[0]); PG9_STAGE(PG9_SA(0, 1), cA, offA[1]);
    if (wr == 1) PG9_BAR;
    PG9_WAIT_V(2); PG9_BAR;
    PG9_STAGE(PG9_SB(1, 0), cB + kstep, offB[0]); PG9_STAGE(PG9_SA(1, 0), cA + kstep, offA[0]); PG9_STAGE(PG9_SB(1, 1), cB + kstep, offB[1]);
    PG9_WAIT_V(6); PG9_BAR;
    for (;;) {
        const bool has_next = S.next(ui + 1, nxt);
        const char* nA = has_next ? S.a_base(nxt) : cA; const char* nB = has_next ? S.b_base(nxt) : cB;
        if constexpr (GATHER) {
#pragma unroll
            for (int h = 0; h < 2; ++h)
#pragma unroll
                for (int i = 0; i < 2; ++i) offAn[h][i] = has_next ? (S.a_row_off(nxt, RA[i] + 128 * h) + (unsigned)CA[i]) : offA[h][i];
        }
        for (int t = 0; t < nt; t += 2) {
            const bool last = (t == nt - 2);
            const char* a1 = cA + (size_t)(t + 1) * kstep;
            const char* a2 = last ? nA : cA + (size_t)(t + 2) * kstep; const char* b2 = last ? nB : cB + (size_t)(t + 2) * kstep;
            const char* a3 = a2 + kstep; const char* b3 = b2 + kstep;
            unsigned oA2[2][2];
#pragma unroll
            for (int h = 0; h < 2; ++h)
#pragma unroll
                for (int i = 0; i < 2; ++i) oA2[h][i] = (GATHER && last) ? offAn[h][i] : offA[h][i];
            PG9_LDB(B0, 0, 0); PG9_LDB(B1, 0, 1); PG9_SCHED; PG9_LDA(At, 0, 0); PG9_STAGE(PG9_SA(1, 1), a1, offA[1]);
            PG9_WAIT_V(8); PG9_WAIT_L(0); PG9_BAR; PG9_MMA(0, 0, At, B0); PG9_MMA(0, 1, At, B1); PG9_BAR; PG9_SCHED;
            PG9_LDA(At, 0, 1); PG9_STAGE(PG9_SB(0, 0), b2, offB[0]); PG9_STAGE(PG9_SB(0, 1), b2, offB[1]); PG9_STAGE(PG9_SA(0, 0), a2, oA2[0]);
            PG9_WAIT_V(8); PG9_WAIT_L(0); PG9_BAR; PG9_MMA(1, 0, At, B0); PG9_MMA(1, 1, At, B1); PG9_BAR; PG9_SCHED;
            PG9_LDB(B0, 1, 0); PG9_LDB(B1, 1, 1); PG9_SCHED; PG9_LDA(At, 1, 0); PG9_STAGE(PG9_SA(0, 1), a2, oA2[1]);
            PG9_WAIT_V(8); PG9_WAIT_L(0); PG9_BAR; PG9_MMA(0, 0, At, B0); PG9_MMA(0, 1, At, B1); PG9_BAR; PG9_SCHED;
            PG9_LDA(At, 1, 1); PG9_STAGE(PG9_SB(1, 0), b3, offB[0]); PG9_STAGE(PG9_SB(1, 1), b3, offB[1]); PG9_STAGE(PG9_SA(1, 0), a3, oA2[0]);
            PG9_WAIT_V(8); PG9_WAIT_L(0); PG9_BAR; PG9_MMA(1, 0, At, B0); PG9_MMA(1, 1, At, B1); PG9_BAR; PG9_SCHED;
        }
        if (wr == 0) PG9_BAR;
        bool keep = false;
        if constexpr (Epi::CHAIN) keep = E.chain_more(cur);
        if (keep) { if constexpr (Epi::CHAIN) E.rescale(acc, cur, wr, wc, fr, fq); }
        else E(acc, cur, wr, wc, fr, fq);
        if (!has_next) break;
        if (!keep) {
#pragma unroll
            for (int a = 0; a < 2; ++a)
#pragma unroll
                for (int b = 0; b < 2; ++b)
#pragma unroll
                    for (int m = 0; m < 4; ++m)
#pragma unroll
                        for (int n = 0; n < 2; ++n) acc[a][b][m][n] = (f32x4){0.f, 0.f, 0.f, 0.f};
        }
        cur = nxt; cA = nA; cB = nB; ++ui;
        if constexpr (GATHER) {
#pragma unroll
            for (int h = 0; h < 2; ++h)
#pragma unroll
                for (int i = 0; i < 2; ++i) offA[h][i] = offAn[h][i];
        }
        if (wr == 1) PG9_BAR;
    }
    PG9_WAIT_V(0);
    PG9_BAR;
#undef PG9_SA
#undef PG9_SB
#undef PG9_STAGE
#undef PG9_LDA
#undef PG9_LDB
#undef PG9_MMA
#undef PG9_WAIT_V
#undef PG9_WAIT_L
#undef PG9_BAR
#undef PG9_SCHED
}
}
#define GAS __attribute__((address_space(1)))
#define LAS __attribute__((address_space(3)))
typedef unsigned short bf16;
typedef unsigned v4u __attribute__((ext_vector_type(4)));
typedef float f32x4 __attribute__((ext_vector_type(4)));
typedef short bf16x8 __attribute__((ext_vector_type(8)));
typedef GAS unsigned gu32;
typedef GAS unsigned long long gu64;
#define RLX_AGENT __ATOMIC_RELAXED, __HIP_MEMORY_SCOPE_AGENT
#define LDS_WAIT() asm volatile("s_waitcnt lgkmcnt(0)" ::: "memory")
#define VM_WAIT() asm volatile("s_waitcnt vmcnt(0)" ::: "memory")
__device__ __forceinline__ unsigned long long rt() { return __builtin_amdgcn_s_memrealtime(); }
__device__ __forceinline__ unsigned f2bfu(float f) { unsigned u = __builtin_bit_cast(unsigned, f); return (u + 0x7fffu + ((u >> 16) & 1u)) >> 16; }
__device__ __forceinline__ unsigned pk2(float lo, float hi) { return f2bfu(lo) | (f2bfu(hi) << 16); }
#define XB_TMO      128
#define XB_XCNT(j)  (256  + 64 * (j))
#define XB_XSUB(j)  (1280 + 64 * (j))
#define XB_XGEN(j)  (2304 + 64 * (j))
#define XB_TOP      3328
#define XB_TOPGEN   3392
#define XCD_BAR_WORDS 3456
#define XB_SPIN_CAP (1u << 18)

__device__ __forceinline__ unsigned xb_ld(unsigned* p)              { return __hip_atomic_load(p, __ATOMIC_RELAXED, __HIP_MEMORY_SCOPE_AGENT); }
__device__ __forceinline__ unsigned xb_add(unsigned* p, unsigned v) { return __hip_atomic_fetch_add(p, v, __ATOMIC_RELAXED, __HIP_MEMORY_SCOPE_AGENT); }
__device__ __forceinline__ unsigned xb_xcc_id() { return (unsigned)__builtin_amdgcn_s_getreg((3 << 11) | 20) & 0xFu; }
#define XB_SPIN(cond, bar) do { unsigned _sp = 0; while (cond) { __builtin_amdgcn_s_sleep(1); \
    if ((++_sp & 255u) == 0u) { if (xb_ld(&(bar)[XB_TMO])) break; if (_sp > XB_SPIN_CAP) { atomicAdd(&(bar)[XB_TMO], 1u); break; } } } } while (0)

struct XcdBarrier {
    unsigned* bar; unsigned x;
    volatile LAS unsigned* st;
};

__device__ __forceinline__ XcdBarrier xcd_barrier_post(unsigned* bar, volatile LAS unsigned* st) {
    XcdBarrier b; b.bar = bar; b.x = xb_xcc_id(); b.st = st;
    if (threadIdx.x == 0) (void)xb_add(&bar[XB_XCNT(b.x)], 1u);
    return b;
}
__device__ __forceinline__ void xcd_barrier_complete(unsigned* bar, unsigned x, unsigned& nloc, unsigned& nx) {
    const unsigned G = gridDim.x * gridDim.y * gridDim.z;
    unsigned sum, cnt, mine, sp = 0u;
    for (;;) {
        sum = 0u; cnt = 0u; mine = 0u;
#pragma unroll
        for (unsigned j = 0; j < 16; ++j) { const unsigned c = xb_ld(&bar[XB_XCNT(j)]); sum += c; cnt += (c > 0u) ? 1u : 0u; mine = (j == x) ? c : mine; }
        if (sum == G) break;
        __builtin_amdgcn_s_sleep(1);
        if ((++sp & 255u) == 0u) { if (xb_ld(&bar[XB_TMO])) break; if (sp > XB_SPIN_CAP) { atomicAdd(&bar[XB_TMO], 1u); break; } }
    }
    nloc = mine > 0u ? mine : 1u; nx = cnt > 0u ? cnt : 1u;
}

__device__ __forceinline__ void xcd_barrier(const XcdBarrier& b) {
    asm volatile("s_waitcnt vmcnt(0)" ::: "memory");
    __syncthreads();
    if (threadIdx.x == 0) {
        unsigned* bar = b.bar;
        __builtin_amdgcn_s_waitcnt(0);
        unsigned nloc = b.st[0], nx = b.st[1];
        if (nloc == 0u) { xcd_barrier_complete(bar, b.x, nloc, nx); b.st[0] = nloc; b.st[1] = nx; }
        const unsigned old = xb_add(&bar[XB_XSUB(b.x)], 1u);
        const unsigned gen = old / nloc;
        if (old + 1u == (gen + 1u) * nloc) {
            __builtin_amdgcn_fence(__ATOMIC_RELEASE, "agent");
            asm volatile("s_waitcnt vmcnt(0)" ::: "memory");
            const unsigned og = xb_add(&bar[XB_TOP], 1u);
            const unsigned tg = og / nx;
            if (og + 1u == (tg + 1u) * nx) xb_add(&bar[XB_TOPGEN], 1u);
            else XB_SPIN(xb_ld(&bar[XB_TOPGEN]) == tg, bar);
            __builtin_amdgcn_fence(__ATOMIC_ACQUIRE, "agent");
            xb_add(&bar[XB_XGEN(b.x)], 1u);
            asm volatile("s_waitcnt vmcnt(0)" ::: "memory");
        } else {
            XB_SPIN(xb_ld(&bar[XB_XGEN(b.x)]) == gen, bar);
            __builtin_amdgcn_fence(__ATOMIC_ACQUIRE, "agent");
            asm volatile("s_waitcnt vmcnt(0)" ::: "memory");
        }
    }
    __syncthreads();
}
constexpr int NWAVES = 8;
constexpr int RING_OFF = 0, RING_BYTES = 131072;
constexpr int LDSCTL_OFF = RING_BYTES, MISC_OFF = LDSCTL_OFF + 320;
constexpr int LDS_BYTES = 147456;
constexpr int CW_BAR = 4096;
constexpr int CW_KMEAN = 32768;
constexpr int CW_MEMKSS = 65536;
static_assert((CW_MEMKSS + 4096) * 4 <= (int)MiB && CW_BAR + 4 * 3456 <= CW_KMEAN, "ctl map");

struct Frame {
    LAS unsigned char* lds; volatile LAS unsigned* MISC; gu32* ctl;
    int tid, lane, wave, vcu, G;
    unsigned char* ws; float* out;
};
typedef float f32x2_t __attribute__((ext_vector_type(2))); typedef __bf16 bf16x2_t __attribute__((ext_vector_type(2)));
__device__ __forceinline__ unsigned cvt_pk_bf16(float lo, float hi) { f32x2_t v = {lo, hi}; bf16x2_t b = __builtin_convertvector(v, bf16x2_t); return __builtin_bit_cast(unsigned, b); }
__device__ __forceinline__ float wave_sum64(float v) {
#pragma unroll
    for (int o = 1; o < 64; o <<= 1) v += __shfl_xor(v, o);
    return v;
}
template <bool HEADPERM> __device__ __forceinline__ void p0_transpose_item(const float* W, int K, int N, bf16* WT, int row_off, LAS float* scr, int item, int lane) {
    const int nblk = N / 32, kb = item / nblk, nb = item % nblk, k0 = 64 * kb, n0 = 32 * nb;
    int p0 = n0; if (HEADPERM) { const int lg = (n0 >> 5) & 7; p0 = (n0 & ~255) + 32 * (4 * (lg & 1) + (lg >> 1)); }
    float wv[32];
#pragma unroll
    for (int i = 0; i < 32; ++i) wv[i] = W[(size_t)(k0 + 2 * i + (lane >> 5)) * N + n0 + (lane & 31)];
#pragma unroll
    for (int i = 0; i < 32; ++i) scr[(2 * i + (lane >> 5)) * 33 + (lane & 31)] = wv[i];
    LDS_WAIT(); asm volatile("" ::: "memory");
    const int c = lane & 7;
#pragma unroll
    for (int j = 0; j < 4; ++j) { const int n = (lane >> 3) + 8 * j; const LAS float* s = scr + (8 * c) * 33 + n;
        v4u o; o.x = cvt_pk_bf16(s[0 * 33], s[1 * 33]); o.y = cvt_pk_bf16(s[2 * 33], s[3 * 33]); o.z = cvt_pk_bf16(s[4 * 33], s[5 * 33]); o.w = cvt_pk_bf16(s[6 * 33], s[7 * 33]);
        *(GAS v4u*)(WT + (size_t)(row_off + p0 + n) * K + k0 + 8 * c) = o; }
    LDS_WAIT(); asm volatile("" ::: "memory");
}
__device__ __forceinline__ void xp_load(float (&wv)[32], const float* W, int N, int nblk, int item, int lane) {
    const int kb = item / nblk, nb = item % nblk, k0 = 64 * kb, n0 = 32 * nb;
#pragma unroll
    for (int i = 0; i < 32; ++i) wv[i] = W[(size_t)(k0 + 2 * i + (lane >> 5)) * N + n0 + (lane & 31)];
}
__device__ __forceinline__ void xp_finish(const float (&wv)[32], int K, int nblk, bf16* WT, LAS float* scr, int item, int lane) {
    const int kb = item / nblk, nb = item % nblk, k0 = 64 * kb, n0 = 32 * nb;
#pragma unroll
    for (int i = 0; i < 32; ++i) scr[(2 * i + (lane >> 5)) * 33 + (lane & 31)] = wv[i];
    LDS_WAIT(); asm volatile("" ::: "memory");
    const int c = lane & 7;
#pragma unroll
    for (int j = 0; j < 4; ++j) { const int n = (lane >> 3) + 8 * j; const LAS float* s = scr + (8 * c) * 33 + n;
        v4u o; o.x = cvt_pk_bf16(s[0 * 33], s[1 * 33]); o.y = cvt_pk_bf16(s[2 * 33], s[3 * 33]); o.z = cvt_pk_bf16(s[4 * 33], s[5 * 33]); o.w = cvt_pk_bf16(s[6 * 33], s[7 * 33]);
        *(GAS v4u*)(WT + (size_t)(n0 + n) * K + k0 + 8 * c) = o; }
    LDS_WAIT(); asm volatile("" ::: "memory");
}
__device__ __forceinline__ void rms_row_to_bf16(int lane, const float* xrow, const float* g, bf16* orow) {
    const GAS f32x4* xr = (const GAS f32x4*)xrow + lane; const GAS f32x4* gr = (const GAS f32x4*)g + lane;
    f32x4 v[4]; float s = 0.f;
#pragma unroll
    for (int j = 0; j < 4; ++j) { v[j] = xr[64 * j]; s += (v[j].x * v[j].x + v[j].y * v[j].y) + (v[j].z * v[j].z + v[j].w * v[j].w); }
    const float r = 1.f / sqrtf(wave_sum64(s) * (1.f / 1024.f) + 1e-5f);
    GAS unsigned long long* o8 = (GAS unsigned long long*)orow + lane;
#pragma unroll
    for (int j = 0; j < 4; ++j) { const f32x4 gg = gr[64 * j]; o8[64 * j] = (unsigned long long)cvt_pk_bf16(v[j].x * r * gg.x, v[j].y * r * gg.y) | ((unsigned long long)cvt_pk_bf16(v[j].z * r * gg.z, v[j].w * r * gg.w) << 32); }
}
struct Args { const float* in[23]; float* out; unsigned char* ws; int ph_lo, ph_hi, li, pad; };
__device__ __forceinline__ void p0_prologue(Frame& F, const Args& A) {
    LAS float* scr = (LAS float*)(F.lds + RING_OFF + F.wave * 16384);
    const int gw = F.vcu * NWAVES + F.wave, NGW = F.G * NWAVES;
    constexpr int I_IN = 16 * (DIN / 32), I_MKV = 16 * 32, I_BR = 8 * 32, I_OUT = 16 * 32;
    constexpr int NITEMS = I_IN + I_MKV + 3 * I_BR + I_OUT;
    for (int it = gw; it < NITEMS; it += NGW) {
        int r = it;
        if (r < I_IN) { p0_transpose_item<true>(A.in[3], 1024, DIN, (bf16*)(F.ws + WS_WIN), 0, scr, r, F.lane); continue; } r -= I_IN;
        if (r < I_MKV) { p0_transpose_item<true>(A.in[9], 1024, 1024, (bf16*)(F.ws + WS_WMEMKV), 0, scr, r, F.lane); continue; } r -= I_MKV;
        if (r < 3 * I_BR) { const int w = r / I_BR; p0_transpose_item<false>(w == 0 ? A.in[12] : (w == 1 ? A.in[13] : A.in[14]), 512, 1024, (bf16*)(F.ws + WS_WBR) + (size_t)w * 1024 * 512, 0, scr, r % I_BR, F.lane); continue; } r -= 3 * I_BR;
        p0_transpose_item<false>(A.in[15], 1024, 1024, (bf16*)(F.ws + WS_WOUT), 0, scr, r, F.lane);
    }
    if (gw == 0) { ((float*)(F.ws + WS_GTAB))[F.lane] = A.in[6][F.lane]; ((float*)(F.ws + WS_GTAB))[64 + F.lane] = A.in[7][F.lane]; }
    for (int m = gw; m < NTOK; m += NGW) rms_row_to_bf16(F.lane, A.in[0] + (size_t)m * DM, A.in[2], (bf16*)(F.ws + WS_HB) + (size_t)m * DM);
    for (int m = gw; m < NB * MEMLEN; m += NGW) rms_row_to_bf16(F.lane, A.in[1] + (size_t)m * DM, A.in[8], (bf16*)(F.ws + WS_HM) + (size_t)m * DM);
}

struct P1Order {
    pg8::StaticOrder so; int G, c;
    __device__ void init(int G_, int c_) { so.init(NTOK, DIN, G_, 0); G = G_; c = c_; }
    __device__ bool next(int i, pg8::Unit& u) const {
        long L = (long)i * G + c;
        if (L < 1664) { pg8::StaticOrder t = so; t.G = 1; t.c = 0; return t.next((int)L, u); }
        L -= 1664; if (L >= 16) return false;
        u.pm = 64 + (int)(L >> 2); u.pn = 26 + (int)(L & 3); return true;
    }
    __device__ __forceinline__ void a_ready(const pg8::Unit&) const {}
    __device__ __forceinline__ void done(const pg8::Unit&) const {}
};
__device__ __forceinline__ float sigmoid_f(float x) { return __builtin_amdgcn_rcpf(1.f + __expf(-x)); }
struct EpiP1 {
    static constexpr bool PERM = true, AFTER_DRAIN = false;
    unsigned char* ws; const float* b_gate; const float* gtab; float* KMEAN; float* MEMKSS; int atom_on;
    __device__ __forceinline__ void operator()(const pg8::f32x4 (&acc)[2][2][4][2], const pg8::Unit& u, int wr, int wc, int fr, int fq) const {
        using pg8::f32x4; using pg8::u32x4;
        const int pn = u.pn; int type, ldc, cb; size_t off; int row0 = u.pm * 256;
        if (pn == 0) { type = 0; off = WS_RQ; ldc = 256; cb = 0; }
        else if (pn == 1) { type = 1; off = WS_RK; ldc = 256; cb = 0; }
        else if (pn < 4) { type = 0; off = WS_RV; ldc = 512; cb = (pn - 2) * 256; }
        else if (pn < 6) { type = 2; off = WS_RG; ldc = 512; cb = (pn - 4) * 256; }
        else if (pn < 8) { type = 3; off = WS_MQ; ldc = 512; cb = (pn - 6) * 256; }
        else if (pn < 10) { type = 4; off = WS_MK; ldc = 512; cb = (pn - 8) * 256; }
        else if (pn < 12) { type = 0; off = WS_MV; ldc = 512; cb = (pn - 10) * 256; }
        else if (pn < 14) { type = 0; off = WS_CQ; ldc = 512; cb = (pn - 12) * 256; }
        else if (pn < 26) { type = 5; off = WS_GT; ldc = 3072; cb = (pn - 14) * 256; }
        else if (pn < 28) { type = 6; off = WS_MEMK; ldc = 512; cb = (pn - 26) * 256; row0 = (u.pm - 64) * 256; }
        else { type = 0; off = WS_MEMV; ldc = 512; cb = (pn - 28) * 256; row0 = (u.pm - 64) * 256; }
        bf16_t* base = (bf16_t*)(ws + off) + cb + 64 * wc + 8 * fq;
        const int rbase = row0 + 64 * wr + fr;
#define P1_STORE(rowp, bj, v0, v1) do { u32x4 w_; w_.x = cvt_pk_bf16((v0)[0], (v0)[1]); w_.y = cvt_pk_bf16((v0)[2], (v0)[3]); w_.z = cvt_pk_bf16((v1)[0], (v1)[1]); w_.w = cvt_pk_bf16((v1)[2], (v1)[3]); *(u32x4*)((rowp) + 32 * (bj)) = w_; } while (0)
        if (type <= 1) {
            const float sc = type == 1 ? 0.125f : 1.f;
#pragma unroll
            for (int ai = 0; ai < 2; ++ai)
#pragma unroll
                for (int m = 0; m < 4; ++m) { bf16_t* rowp = base + (size_t)(rbase + 128 * ai + 16 * m) * ldc;
#pragma unroll
                    for (int bj = 0; bj < 2; ++bj) { const f32x4 v0 = acc[ai][bj][m][0] * sc, v1 = acc[ai][bj][m][1] * sc; P1_STORE(rowp, bj, v0, v1); } }
        } else if (type == 2) {
#pragma unroll
            for (int ai = 0; ai < 2; ++ai)
#pragma unroll
                for (int m = 0; m < 4; ++m) { bf16_t* rowp = base + (size_t)(rbase + 128 * ai + 16 * m) * ldc;
#pragma unroll
                    for (int bj = 0; bj < 2; ++bj) { f32x4 v0 = acc[ai][bj][m][0], v1 = acc[ai][bj][m][1];
#pragma unroll
                        for (int j = 0; j < 4; ++j) { v0[j] = v0[j] * sigmoid_f(v0[j]); v1[j] = v1[j] * sigmoid_f(v1[j]); }
                        P1_STORE(rowp, bj, v0, v1); } }
        } else if (type == 5) {
            f32x4 bv[2][2];
#pragma unroll
            for (int bj = 0; bj < 2; ++bj)
#pragma unroll
                for (int n = 0; n < 2; ++n) bv[bj][n] = *(const f32x4*)(b_gate + cb + 64 * wc + 32 * bj + 8 * fq + 4 * n);
#pragma unroll
            for (int ai = 0; ai < 2; ++ai)
#pragma unroll
                for (int m = 0; m < 4; ++m) { bf16_t* rowp = base + (size_t)(rbase + 128 * ai + 16 * m) * ldc;
#pragma unroll
                    for (int bj = 0; bj < 2; ++bj) { f32x4 v0 = acc[ai][bj][m][0] + bv[bj][0], v1 = acc[ai][bj][m][1] + bv[bj][1];
#pragma unroll
                        for (int j = 0; j < 4; ++j) { v0[j] = sigmoid_f(v0[j]); v1[j] = sigmoid_f(v1[j]); }
                        P1_STORE(rowp, bj, v0, v1); } }
        } else if (type == 6) {
#pragma unroll
            for (int ai = 0; ai < 2; ++ai)
#pragma unroll
                for (int m = 0; m < 4; ++m) { const int row = rbase + 128 * ai + 16 * m; bf16_t* rowp = base + (size_t)row * ldc; float ss = 0.f;
#pragma unroll
                    for (int bj = 0; bj < 2; ++bj) { const f32x4 v0 = acc[ai][bj][m][0], v1 = acc[ai][bj][m][1];
                        ss += (v0[0] * v0[0] + v0[1] * v0[1]) + (v0[2] * v0[2] + v0[3] * v0[3]) + (v1[0] * v1[0] + v1[1] * v1[1]) + (v1[2] * v1[2] + v1[3] * v1[3]);
                        P1_STORE(rowp, bj, v0, v1); }
                    ss += __shfl_xor(ss, 16); ss += __shfl_xor(ss, 32);
                    if (fq == 0 && atom_on) atomicAdd(MEMKSS + (size_t)row * 4 + (cb >> 7) + (wc >> 1), ss);
                    }
        } else {
            const float* g = gtab + (type == 3 ? 0 : 64);
            f32x4 gv[2][2]; float rr[2][4];
#pragma unroll
            for (int bj = 0; bj < 2; ++bj)
#pragma unroll
                for (int n = 0; n < 2; ++n) gv[bj][n] = *(const f32x4*)(g + 32 * bj + 8 * fq + 4 * n);
#pragma unroll
            for (int ai = 0; ai < 2; ++ai)
#pragma unroll
                for (int m = 0; m < 4; ++m) { bf16_t* rowp = base + (size_t)(rbase + 128 * ai + 16 * m) * ldc; float ss = 0.f;
#pragma unroll
                    for (int bj = 0; bj < 2; ++bj) { const f32x4 v0 = acc[ai][bj][m][0], v1 = acc[ai][bj][m][1];
                        ss += (v0[0] * v0[0] + v0[1] * v0[1]) + (v0[2] * v0[2] + v0[3] * v0[3]) + (v1[0] * v1[0] + v1[1] * v1[1]) + (v1[2] * v1[2] + v1[3] * v1[3]); }
                    ss += __shfl_xor(ss, 16); ss += __shfl_xor(ss, 32);
                    const float r = (1.f / sqrtf(ss * (1.f / 64.f) + 1e-5f)) * (type == 3 ? 0.18033688011112042f : 1.f); rr[ai][m] = r;
#pragma unroll
                    for (int bj = 0; bj < 2; ++bj) { const f32x4 v0 = acc[ai][bj][m][0] * r * gv[bj][0], v1 = acc[ai][bj][m][1] * r * gv[bj][1];
                        P1_STORE(rowp, bj, v0, v1); }
                    asm volatile("" ::: "memory"); }
            if (type == 4 && atom_on) {
                float* km = KMEAN + ((size_t)u.pm * 8 + (cb >> 6) + wc) * 64 + 8 * fq;
#pragma unroll
                for (int bj = 0; bj < 2; ++bj)
#pragma unroll
                    for (int n = 0; n < 2; ++n)
#pragma unroll
                        for (int j = 0; j < 4; ++j) { float s = 0.f;
#pragma unroll
                            for (int ai = 0; ai < 2; ++ai)
#pragma unroll
                                for (int m = 0; m < 4; ++m) s += acc[ai][bj][m][n][j] * rr[ai][m];
                            s += __shfl_xor(s, 1); s += __shfl_xor(s, 2); s += __shfl_xor(s, 4); s += __shfl_xor(s, 8);
                            if (fr == 0) atomicAdd(km + 32 * bj + 4 * n + j, s * gv[bj][n][j] * (1.f / 256.f)); }
            }
        }
#undef P1_STORE
    }
};

constexpr int TB_OFF = LDSCTL_OFF + 1024;
__device__ __forceinline__ unsigned cvt_pk(float lo, float hi) { return cvt_pk_bf16(lo, hi); }

struct P3Order {
    pg8::StaticOrder so; int G, c; const unsigned char* ws;
    __device__ void init(int G_, int c_, const unsigned char* ws_) { so.init(NTOK, 1024, 1, 0); G = G_; c = c_; ws = ws_; }
    __device__ bool next(int i, pg9::Unit& u) const {
        const int tl = (i / 3) * G + c; if (tl >= 256) return false; pg8::Unit t; so.next(tl, t); u.pm = t.pm; u.pn = t.pn; u.aux = i % 3; u.cnt = 256; return true; }
    __device__ __forceinline__ const char* a_base(const pg9::Unit& u) const { return (const char*)(ws + WS_ORET) + (size_t)u.aux * (WS_OMOBA - WS_ORET) + (size_t)u.pm * 256 * 512 * 2; }
    __device__ __forceinline__ const char* b_base(const pg9::Unit& u) const { return (const char*)(ws + WS_WBR) + (size_t)u.aux * 1024 * 512 * 2 + (size_t)u.pn * 256 * 512 * 2; }
};
struct EpiP3 {
    static constexpr bool PERM = true, CHAIN = true;
    const bf16_t* GT; bf16_t* Y;
    __device__ __forceinline__ bool chain_more(const pg9::Unit& u) const { return u.aux < 2; }
    __device__ __forceinline__ void rescale(pg8::f32x4 (&acc)[2][2][4][2], const pg9::Unit& u, int wr, int wc, int fr, int fq) const {
        const int s = u.aux;
#pragma unroll
        for (int ai = 0; ai < 2; ++ai)
#pragma unroll
            for (int m = 0; m < 4; ++m) { const bf16_t* gp = GT + (size_t)(u.pm * 256 + 128 * ai + 64 * wr + 16 * m + fr) * 3072 + s * 1024 + u.pn * 256 + 32 * wc + 8 * fq;
#pragma unroll
                for (int bj = 0; bj < 2; ++bj) { const pg8::u32x4 ga = *(const pg8::u32x4*)(gp + 128 * bj), gb = *(const pg8::u32x4*)(gp + 1024 + 128 * bj);
#pragma unroll
                    for (int n = 0; n < 2; ++n)
#pragma unroll
                        for (int j = 0; j < 4; ++j) { const int e = 4 * n + j; const unsigned wa = ga[e >> 1], wb = gb[e >> 1];
                            const float fa = __uint_as_float((e & 1) ? (wa & 0xffff0000u) : (wa << 16)), fb = __uint_as_float((e & 1) ? (wb & 0xffff0000u) : (wb << 16));
                            acc[ai][bj][m][n][j] *= fa * __builtin_amdgcn_rcpf(fmaxf(fb, 1e-20f)); } }
                asm volatile("" ::: "memory"); }
    }
    __device__ __forceinline__ void operator()(const pg8::f32x4 (&acc)[2][2][4][2], const pg9::Unit& u, int wr, int wc, int fr, int fq) const {
#pragma unroll
        for (int ai = 0; ai < 2; ++ai)
#pragma unroll
            for (int m = 0; m < 4; ++m) { const size_t row = (size_t)(u.pm * 256 + 128 * ai + 64 * wr + 16 * m + fr); const bf16_t* gp = GT + row * 3072 + 2048 + u.pn * 256 + 32 * wc + 8 * fq; bf16_t* yp = Y + row * 1024 + u.pn * 256 + 32 * wc + 8 * fq;
#pragma unroll
                for (int bj = 0; bj < 2; ++bj) { const pg8::u32x4 ga = *(const pg8::u32x4*)(gp + 128 * bj); float v[8];
#pragma unroll
                    for (int n = 0; n < 2; ++n)
#pragma unroll
                        for (int j = 0; j < 4; ++j) { const int e = 4 * n + j; const unsigned wa = ga[e >> 1]; v[e] = acc[ai][bj][m][n][j] * __uint_as_float((e & 1) ? (wa & 0xffff0000u) : (wa << 16)); }
                    pg8::u32x4 w; w.x = cvt_pk(v[0], v[1]); w.y = cvt_pk(v[2], v[3]); w.z = cvt_pk(v[4], v[5]); w.w = cvt_pk(v[6], v[7]); *(pg8::u32x4*)(yp + 128 * bj) = w; }
                asm volatile("" ::: "memory"); }
    }
};
struct P4Order {
    pg8::StaticOrder so; int G, c; const unsigned char* ws;
    __device__ void init(int G_, int c_, const unsigned char* ws_) { so.init(NTOK, 1024, 1, 0); G = G_; c = c_; ws = ws_; }
    __device__ bool next(int i, pg9::Unit& u) const { const int tl = i * G + c; if (tl >= 256) return false; pg8::Unit t; so.next(tl, t); u.pm = t.pm; u.pn = t.pn; u.aux = 0; u.cnt = 256; return true; }
    __device__ __forceinline__ const char* a_base(const pg9::Unit& u) const { return (const char*)(ws + WS_Y) + (size_t)u.pm * 256 * 1024 * 2; }
    __device__ __forceinline__ const char* b_base(const pg9::Unit& u) const { return (const char*)(ws + WS_WOUT) + (size_t)u.pn * 256 * 1024 * 2; }
};
struct EpiP4 {
    static constexpr bool PERM = false, CHAIN = false;
    const float* x; float* out;
    __device__ __forceinline__ void operator()(const pg8::f32x4 (&acc)[2][2][4][2], const pg9::Unit& u, int wr, int wc, int fr, int fq) const {
#pragma unroll
        for (int ai = 0; ai < 2; ++ai)
#pragma unroll
            for (int m = 0; m < 4; ++m) { const size_t off = (size_t)(u.pm * 256 + 128 * ai + 64 * wr + 16 * m + fr) * 1024 + u.pn * 256 + 32 * wc + 4 * fq;
#pragma unroll
                for (int bj = 0; bj < 2; ++bj)
#pragma unroll
                    for (int n = 0; n < 2; ++n) { const pg8::f32x4 xv = *(const pg8::f32x4*)(x + off + 128 * bj + 16 * n); *(pg8::f32x4*)(out + off + 128 * bj + 16 * n) = xv + acc[ai][bj][m][n]; }
                if (m & 1) asm volatile("" ::: "memory"); }
    }
};
__device__ __forceinline__ float wave_max64(float v) {
#pragma unroll
    for (int o = 1; o < 64; o <<= 1) v = fmaxf(v, __shfl_xor(v, o));
    return v;
}
__device__ __forceinline__ void p5_router(Frame& F, const float* X1, const float* g_ffn, const float* w_router, const float* b_router, int* COUNTS, int* LISTS) {
    bf16_t* XT = (bf16_t*)(F.ws + WS_XT); int* TOPE = (int*)(F.ws + WS_TOPE); float* TOPW = (float*)(F.ws + WS_TOPW);
    const int lane = F.lane, e = lane & 31, kq = lane >> 5, tid = F.tid;
    LAS float* wsh = (LAS float*)(F.lds);
    LAS float* xs = (LAS float*)(F.lds + 65536) + F.wave * 2048;
    for (int v = F.vcu; v < NTOK / 64; v += F.G) {
        const int tw = v * 64 + F.wave * 8;
        float acc[2][4]; float rr[2][4];
#pragma unroll
        for (int g = 0; g < 2; ++g)
#pragma unroll
            for (int q = 0; q < 4; ++q) { acc[g][q] = 0.f; rr[g][q] = 0.f; }
#pragma unroll
        for (int half = 0; half < 2; ++half) {
            __syncthreads();
#pragma unroll
            for (int i = 0; i < 8; ++i) { const int ci = tid + 512 * i; *(LAS f32x4*)(wsh + 4 * ci) = *(const f32x4*)(w_router + (size_t)half * 512 * 32 + 4 * ci); }
            __syncthreads();
#pragma unroll
            for (int g = 0; g < 2; ++g) {
                if (half == 0) {
                    f32x4 x4[4][4]; float s4[4];
#pragma unroll
                    for (int q = 0; q < 4; ++q) { const float* xr = X1 + (size_t)(tw + 4 * g + q) * 1024; s4[q] = 0.f;
#pragma unroll
                        for (int j = 0; j < 4; ++j) x4[q][j] = *(const f32x4*)(xr + 4 * lane + 256 * j); }
#pragma unroll
                    for (int q = 0; q < 4; ++q) {
#pragma unroll
                        for (int j = 0; j < 4; ++j) s4[q] += (x4[q][j].x * x4[q][j].x + x4[q][j].y * x4[q][j].y) + (x4[q][j].z * x4[q][j].z + x4[q][j].w * x4[q][j].w); }
#pragma unroll
                    for (int o_ = 1; o_ < 64; o_ <<= 1) {
#pragma unroll
                        for (int q = 0; q < 4; ++q) s4[q] += __shfl_xor(s4[q], o_); }
#pragma unroll
                    for (int q = 0; q < 4; ++q) { const int t = tw + 4 * g + q; const float r = 1.f / sqrtf(s4[q] * (1.f / 1024.f) + 1e-5f); rr[g][q] = r;
#pragma unroll
                        for (int j = 0; j < 4; ++j) { const f32x4 gg = *(const f32x4*)(g_ffn + 4 * lane + 256 * j); const f32x4 xn = x4[q][j] * r * gg;
                            uint2 w; w.x = cvt_pk(xn.x, xn.y); w.y = cvt_pk(xn.z, xn.w); *(uint2*)(XT + (size_t)t * 1024 + 4 * lane + 256 * j) = w;
                            if (j < 2) *(LAS f32x4*)(xs + q * 512 + 4 * lane + 256 * j) = xn; } }
                } else {
                    f32x4 x2[4][2];
#pragma unroll
                    for (int q = 0; q < 4; ++q)
#pragma unroll
                        for (int j = 0; j < 2; ++j) x2[q][j] = *(const f32x4*)(X1 + (size_t)(tw + 4 * g + q) * 1024 + 512 + 4 * lane + 256 * j);
#pragma unroll
                    for (int q = 0; q < 4; ++q)
#pragma unroll
                        for (int j = 0; j < 2; ++j) { const f32x4 gg = *(const f32x4*)(g_ffn + 512 + 4 * lane + 256 * j); *(LAS f32x4*)(xs + q * 512 + 4 * lane + 256 * j) = x2[q][j] * rr[g][q] * gg; }
                }
                asm volatile("s_waitcnt lgkmcnt(0)" ::: "memory");
#pragma unroll 2
                for (int k = 256 * kq; k < 256 * kq + 256; k += 4) { const float w0 = wsh[(k + 0) * 32 + e], w1 = wsh[(k + 1) * 32 + e], w2 = wsh[(k + 2) * 32 + e], w3 = wsh[(k + 3) * 32 + e];
#pragma unroll
                    for (int q = 0; q < 4; ++q) { const f32x4 x = *(const LAS f32x4*)(xs + q * 512 + k); acc[g][q] += x.x * w0 + x.y * w1 + x.z * w2 + x.w * w3; } }
                asm volatile("s_waitcnt lgkmcnt(0)" ::: "memory");
            }
        }
        volatile LAS int* lcnt = (volatile LAS int*)(F.lds + TB_OFF);
        __syncthreads();
        if (tid < 32) lcnt[tid] = 0;
        __syncthreads();
        const float bias = b_router[e];
        int my_e[2][4], my_r[2][4];
#pragma unroll
        for (int g = 0; g < 2; ++g)
#pragma unroll
            for (int q = 0; q < 4; ++q) { const int t = tw + 4 * g + q; float lg = acc[g][q] + __shfl_xor(acc[g][q], 32) + bias; if (lane >= 32) lg = -INFINITY;
                float tv[4]; int te[4];
#pragma unroll
                for (int k = 0; k < 4; ++k) { const float m = wave_max64(lg); const unsigned long long bal = __ballot(lg == m); const int ee = __ffsll((long long)bal) - 1; tv[k] = m; te[k] = ee; if (lane == ee) lg = -INFINITY; }
                float ex[4], se = 0.f;
#pragma unroll
                for (int k = 0; k < 4; ++k) { ex[k] = __expf(tv[k] - tv[0]); se += ex[k]; }
                int e_l = te[0]; float w_l = ex[0];
#pragma unroll
                for (int k = 1; k < 4; ++k) if (lane == k) { e_l = te[k]; w_l = ex[k]; }
                my_e[g][q] = e_l; my_r[g][q] = 0;
                if (lane < 4) { TOPE[t * 4 + lane] = e_l; TOPW[t * 4 + lane] = w_l / se; my_r[g][q] = __hip_atomic_fetch_add((LAS int*)(F.lds + TB_OFF) + e_l, 1, __ATOMIC_RELAXED, __HIP_MEMORY_SCOPE_WORKGROUP); } }
        __syncthreads();
        if (tid < 32) { const int c = lcnt[tid]; lcnt[32 + tid] = c ? atomicAdd(&COUNTS[tid], c) : 0; }
        __syncthreads();
#pragma unroll
        for (int g = 0; g < 2; ++g)
#pragma unroll
            for (int q = 0; q < 4; ++q) if (lane < 4) { const int t = tw + 4 * g + q; LISTS[(size_t)my_e[g][q] * 16384 + lcnt[32 + my_e[g][q]] + my_r[g][q]] = t * 4 + lane; }
    }
}
__device__ __forceinline__ void moe_tables(Frame& F) {
    volatile LAS int* TB = (volatile LAS int*)(F.lds + TB_OFF);
    if (F.tid == 0) { const int* COUNTS = (const int*)F.ctl + CW_COUNTS; int acc = 0; for (int e = 0; e < 32; ++e) { const int c = __hip_atomic_load(COUNTS + e, __ATOMIC_RELAXED, __HIP_MEMORY_SCOPE_AGENT); TB[e] = acc; TB[33 + e] = c; acc += (c + 255) >> 8; } TB[32] = acc; }
    __syncthreads();
}
template <int NPN_LOG2, size_t WOFF, int NROWS_B, int ASHIFT, size_t AOFF> struct MoeOrder {
    int perx, xcd, l; const unsigned char* ws; const LAS int* TB; const int* LISTS;
    __device__ void init(int G_, int vcu_, const unsigned char* ws_, const LAS int* TB_) { perx = G_ / 8; xcd = vcu_ / perx; l = vcu_ % perx; ws = ws_; TB = TB_; LISTS = (const int*)(ws_ + WS_LISTS); }
    __device__ bool next(int i, pg9::Unit& u) const {
        const int uidx = i * perx + l; const int mt = TB[4 * xcd] + (uidx >> NPN_LOG2); if (mt >= TB[4 * xcd + 4]) return false;
        int e = 4 * xcd;
#pragma unroll
        for (int k = 1; k < 4; ++k) if (TB[4 * xcd + k] <= mt) e = 4 * xcd + k;
        u.aux = e; u.pm = mt - TB[e]; u.pn = uidx & ((1 << NPN_LOG2) - 1); u.cnt = TB[33 + e] - u.pm * 256; return true;
    }
    __device__ __forceinline__ const char* a_base(const pg9::Unit&) const { return (const char*)(ws + AOFF); }
    __device__ __forceinline__ const char* b_base(const pg9::Unit& u) const { return (const char*)(ws + WOFF) + ((size_t)u.aux * NROWS_B + (size_t)u.pn * 256) * 1024 * 2; }
    __device__ __forceinline__ unsigned a_row_off(const pg9::Unit& u, int r) const { const int rr = r < u.cnt ? r : u.cnt - 1; const int id = LISTS[(size_t)u.aux * 16384 + u.pm * 256 + rr]; return (unsigned)(id >> ASHIFT) * 2048u; }
};
struct EpiMoe1 {
    static constexpr bool PERM = true, CHAIN = false;
    const int* LISTS; const float* b1; bf16_t* ACT;
    __device__ __forceinline__ void operator()(const pg8::f32x4 (&acc)[2][2][4][2], const pg9::Unit& u, int wr, int wc, int fr, int fq) const {
        const int e = u.aux; const int c0 = u.pn * 256 + 32 * wc + 8 * fq;
        pg8::f32x4 bv[2][2];
#pragma unroll
        for (int bj = 0; bj < 2; ++bj)
#pragma unroll
            for (int n = 0; n < 2; ++n) bv[bj][n] = *(const pg8::f32x4*)(b1 + (size_t)e * 2048 + c0 + 128 * bj + 4 * n);
#pragma unroll
        for (int ai = 0; ai < 2; ++ai)
#pragma unroll
            for (int m = 0; m < 4; ++m) { const int r = 128 * ai + 64 * wr + 16 * m + fr; const bool ok = r < u.cnt; const int id = ok ? LISTS[(size_t)e * 16384 + u.pm * 256 + r] : 0;
#pragma unroll
                for (int bj = 0; bj < 2; ++bj) { float a[4];
#pragma unroll
                    for (int n = 0; n < 2; ++n)
#pragma unroll
                        for (int p = 0; p < 2; ++p) { const float gl = fminf(acc[ai][bj][m][n][2 * p] + bv[bj][n][2 * p], 7.0f); const float li = fminf(fmaxf(acc[ai][bj][m][n][2 * p + 1] + bv[bj][n][2 * p + 1], -7.0f), 7.0f);
                            a[2 * n + p] = gl * sigmoid_f(1.702f * gl) * (li + 1.f); }
                    if (ok) { uint2 w; w.x = cvt_pk(a[0], a[1]); w.y = cvt_pk(a[2], a[3]); *(uint2*)(ACT + (size_t)id * 1024 + ((c0 + 128 * bj) >> 1)) = w; } }
                asm volatile("" ::: "memory"); }
    }
};
struct EpiMoe2 {
    static constexpr bool PERM = true, CHAIN = false;
    const int* LISTS; const float* b2; bf16_t* YS;
    __device__ __forceinline__ void operator()(const pg8::f32x4 (&acc)[2][2][4][2], const pg9::Unit& u, int wr, int wc, int fr, int fq) const {
        const int e = u.aux; const int c0 = u.pn * 256 + 32 * wc + 8 * fq;
        pg8::f32x4 bv[2][2];
#pragma unroll
        for (int bj = 0; bj < 2; ++bj)
#pragma unroll
            for (int n = 0; n < 2; ++n) bv[bj][n] = *(const pg8::f32x4*)(b2 + (size_t)e * 1024 + c0 + 128 * bj + 4 * n);
#pragma unroll
        for (int ai = 0; ai < 2; ++ai)
#pragma unroll
            for (int m = 0; m < 4; ++m) { const int r = 128 * ai + 64 * wr + 16 * m + fr; const bool ok = r < u.cnt; const int id = ok ? LISTS[(size_t)e * 16384 + u.pm * 256 + r] : 0;
#pragma unroll
                for (int bj = 0; bj < 2; ++bj) { const pg8::f32x4 v0 = acc[ai][bj][m][0] + bv[bj][0], v1 = acc[ai][bj][m][1] + bv[bj][1];
                    if (ok) { pg8::u32x4 w; w.x = cvt_pk(v0[0], v0[1]); w.y = cvt_pk(v0[2], v0[3]); w.z = cvt_pk(v1[0], v1[1]); w.w = cvt_pk(v1[2], v1[3]); *(pg8::u32x4*)(YS + (size_t)id * 1024 + c0 + 128 * bj) = w; } }
                asm volatile("" ::: "memory"); }
    }
};
__device__ __forceinline__ void p8_combine(Frame& F, const float* src, float* out) {
    const bf16_t* YS = (const bf16_t*)(F.ws + WS_YS); const float* TOPW = (const float*)(F.ws + WS_TOPW);
    const int gw = F.vcu * NWAVES + F.wave, NGW = F.G * NWAVES, lane = F.lane;
    for (int t = gw; t < NTOK; t += NGW) {
        const f32x4 w4 = *(const f32x4*)(TOPW + (size_t)t * 4);
#pragma unroll
        for (int j = 0; j < 2; ++j) {
            const int c = 8 * lane + 512 * j; f32x4 a0 = *(const f32x4*)(src + (size_t)t * 1024 + c), a1 = *(const f32x4*)(src + (size_t)t * 1024 + c + 4);
#pragma unroll
            for (int k = 0; k < 4; ++k) { const v4u y = *(const v4u*)(YS + ((size_t)t * 4 + k) * 1024 + c); const float wk = w4[k];
                a0.x += wk * __uint_as_float(y.x << 16); a0.y += wk * __uint_as_float(y.x & 0xffff0000u); a0.z += wk * __uint_as_float(y.y << 16); a0.w += wk * __uint_as_float(y.y & 0xffff0000u);
                a1.x += wk * __uint_as_float(y.z << 16); a1.y += wk * __uint_as_float(y.z & 0xffff0000u); a1.z += wk * __uint_as_float(y.w << 16); a1.w += wk * __uint_as_float(y.w & 0xffff0000u); }
            *(f32x4*)(out + (size_t)t * 1024 + c) = a0; *(f32x4*)(out + (size_t)t * 1024 + c + 4) = a1; }
    }
}
namespace att {
typedef float f32x16 __attribute__((ext_vector_type(16)));
typedef short s16x4 __attribute__((ext_vector_type(4)));
typedef short v4i16_t __attribute__((ext_vector_type(4)));
using pg8::bf16x8;
constexpr float LOG2E = 1.4426950408889634f;
__device__ __forceinline__ constexpr int crow(int r, int hi) { return (r & 3) + 8 * (r >> 2) + 4 * hi; }
template <int D> __device__ __forceinline__ int kswz(int row) { return D == 64 ? ((row >> 1) & 7) : (row & 15); }
template <int D> __device__ __forceinline__ int vswz(int row) { return D == 64 ? (((row >> 1) & 1) << 2) : ((row & 3) << 2); }
__device__ __forceinline__ s16x4 vtr(const LAS unsigned char* p) { return __builtin_bit_cast(s16x4, __builtin_amdgcn_ds_read_tr16_b64_v4i16((LAS v4i16_t*)p)); }
__device__ __forceinline__ bf16x8 pack8(const f32x16& x, int s) {
    typedef unsigned u32x4_t __attribute__((ext_vector_type(4))); u32x4_t p;
    p[0] = cvt_pk_bf16(x[8 * s + 0], x[8 * s + 1]); p[1] = cvt_pk_bf16(x[8 * s + 2], x[8 * s + 3]); p[2] = cvt_pk_bf16(x[8 * s + 4], x[8 * s + 5]); p[3] = cvt_pk_bf16(x[8 * s + 6], x[8 * s + 7]);
    return __builtin_bit_cast(bf16x8, p);
}
__device__ __forceinline__ float bfl(unsigned w) { return __uint_as_float(w << 16); }
__device__ __forceinline__ float bfh(unsigned w) { return __uint_as_float(w & 0xffff0000u); }

template <bool MOBA, int TK> __device__ __forceinline__ int tile_kbase(int tt, int qb) { constexpr int TPB = 256 / TK; if (!MOBA) return TK * tt; if (tt < TPB) return qb * 256 + TK * tt; const int u = tt - TPB; return (u / TPB) * 256 + TK * (u % TPB); }
template <int D, bool MOBA, int NSUB>
__device__ __forceinline__ void attn_unit(Frame& F, const int b, const int h, const int qb,
                                          const bf16_t* Qg, const bf16_t* Kg, const bf16_t* Vg, bf16_t* Og, const int ld,
                                          const float* KMEAN, const float* KSS, const float* gq, const float* gk) {
    constexpr int NKH = 2  , TK = 64 * NSUB  , KB = TK * D * 2, NKS = D / 16, NDH = D / 32, CPR = D / 8  , NST = (TK * CPR) / 512  ;
    int tid = F.tid, lane = F.lane; asm volatile("" : "+v"(tid), "+v"(lane));
    const int wave = F.wave, r32 = lane & 31, hi = lane >> 5;
    LAS unsigned char* lds = F.lds;
    const size_t qrow = (size_t)b * SEQ + qb * 256 + wave * 32 + r32;
    bf16x8 qr[NKS];
#pragma unroll
    for (int ks = 0; ks < NKS; ++ks) qr[ks] = *(const bf16x8*)(Qg + qrow * ld + h * D + 16 * ks + 8 * hi);
    unsigned selmask = 0u;
    if constexpr (MOBA) {
        if (qb > 0) {
            LAS float* kml = (LAS float*)(lds + 4 * KB);
            if (tid < qb * 16) *(LAS f32x4*)(kml + 4 * tid) = *(const f32x4*)(KMEAN + (((size_t)b * 16 + (tid >> 4)) * 8 + h) * 64 + 4 * (tid & 15));
            __syncthreads();
            float qf[NKS * 8];
#pragma unroll
            for (int ks = 0; ks < NKS; ++ks) { const pg8::u32x4 w = __builtin_bit_cast(pg8::u32x4, qr[ks]);
#pragma unroll
                for (int j = 0; j < 4; ++j) { qf[ks * 8 + 2 * j] = bfl(w[j]); qf[ks * 8 + 2 * j + 1] = bfh(w[j]); } }
            float v0 = -INFINITY, v1 = -INFINITY, v2 = -INFINITY; int i0 = -1, i1 = -1, i2 = -1;
#pragma unroll 1
            for (int j = 0; j < qb; ++j) { const LAS float* km = kml + 64 * j + 8 * hi; float s = 0.f;
#pragma unroll
                for (int ks = 0; ks < NKS; ++ks) { const f32x4 k0 = *(const LAS f32x4*)(km + 16 * ks), k1 = *(const LAS f32x4*)(km + 16 * ks + 4);
                    s += qf[ks * 8 + 0] * k0[0] + qf[ks * 8 + 1] * k0[1] + qf[ks * 8 + 2] * k0[2] + qf[ks * 8 + 3] * k0[3] + qf[ks * 8 + 4] * k1[0] + qf[ks * 8 + 5] * k1[1] + qf[ks * 8 + 6] * k1[2] + qf[ks * 8 + 7] * k1[3]; }
                s += __shfl_xor(s, 32);
                const bool c0 = s > v0, c1 = s > v1, c2 = s > v2;
                v2 = c1 ? v1 : (c2 ? s : v2); i2 = c1 ? i1 : (c2 ? j : i2);
                v1 = c0 ? v0 : (c1 ? s : v1); i1 = c0 ? i0 : (c1 ? j : i1);
                v0 = c0 ? s : v0; i0 = c0 ? j : i0; }
            selmask = (i0 >= 0 ? (1u << i0) : 0u) | (i1 >= 0 ? (1u << i1) : 0u) | (i2 >= 0 ? (1u << i2) : 0u);
        }
    } else {
        float qf[NKS * 8]; float ss = 0.f;
#pragma unroll
        for (int ks = 0; ks < NKS; ++ks) { const pg8::u32x4 w = __builtin_bit_cast(pg8::u32x4, qr[ks]);
#pragma unroll
            for (int j = 0; j < 4; ++j) { qf[ks * 8 + 2 * j] = bfl(w[j]); qf[ks * 8 + 2 * j + 1] = bfh(w[j]); ss += qf[ks * 8 + 2 * j] * qf[ks * 8 + 2 * j] + qf[ks * 8 + 2 * j + 1] * qf[ks * 8 + 2 * j + 1]; } }
        ss += __shfl_xor(ss, 32);
        const float rq = (1.f / sqrtf(ss * (1.f / D) + 1e-5f)) * (0.08838834764831845f * LOG2E);
#pragma unroll
        for (int ks = 0; ks < NKS; ++ks) { const float* g1 = gq + 16 * ks + 8 * hi; const float* g2 = gk + 16 * ks + 8 * hi; pg8::u32x4 w;
#pragma unroll
            for (int j = 0; j < 4; ++j) w[j] = cvt_pk_bf16(qf[ks * 8 + 2 * j] * rq * g1[2 * j] * g2[2 * j], qf[ks * 8 + 2 * j + 1] * rq * g1[2 * j + 1] * g2[2 * j + 1]);
            qr[ks] = __builtin_bit_cast(bf16x8, w); }
    }
    constexpr int TPB = 256 / TK;
    const int NT = MOBA ? TPB * (qb + 1) : TPB;
    const float sl2 = MOBA ? exp2f(-(float)(h + 1)) * LOG2E : 0.f;
    v4u kreg[NST], vreg[NST];
#define ATT_LOAD(tt) do { const int kb_ = tile_kbase<MOBA, TK>(tt, qb); _Pragma("unroll") for (int i_ = 0; i_ < NST; ++i_) { const int ci_ = tid + 512 * i_, row_ = ci_ / CPR, ch_ = ci_ % CPR; \
        const size_t g_ = (size_t)(kb_ + row_) * ld + h * D + 8 * ch_; kreg[i_] = *(const v4u*)(Kg + g_); vreg[i_] = *(const v4u*)(Vg + g_); \
        if (!MOBA) { const float rk_ = 1.f / sqrtf(KSS[(size_t)(kb_ + row_) * 4 + h] * (1.f / D) + 1e-5f); v4u k_ = kreg[i_]; \
            k_.x = cvt_pk_bf16(bfl(k_.x) * rk_, bfh(k_.x) * rk_); k_.y = cvt_pk_bf16(bfl(k_.y) * rk_, bfh(k_.y) * rk_); k_.z = cvt_pk_bf16(bfl(k_.z) * rk_, bfh(k_.z) * rk_); k_.w = cvt_pk_bf16(bfl(k_.w) * rk_, bfh(k_.w) * rk_); kreg[i_] = k_; } } } while (0)
#define ATT_WRITE(buf) do { _Pragma("unroll") for (int i_ = 0; i_ < NST; ++i_) { const int ci_ = tid + 512 * i_, row_ = ci_ / CPR, ch_ = ci_ % CPR; \
        *(LAS v4u*)(lds + (buf) * KB + row_ * (2 * D) + ((ch_ ^ kswz<D>(row_)) << 4)) = kreg[i_]; *(LAS v4u*)(lds + (2 + (buf)) * KB + row_ * (2 * D) + ((ch_ ^ vswz<D>(row_)) << 4)) = vreg[i_]; } } while (0)
    ATT_LOAD(0); ATT_WRITE(0);
    __syncthreads();
    float m = -1e30f, l = 0.f;
    f32x16 o[NDH];
#pragma unroll
    for (int dh = 0; dh < NDH; ++dh)
#pragma unroll
        for (int r = 0; r < 16; ++r) o[dh][r] = 0.f;
    const int qrel = wave * 32 + r32;
    f32x16 cinit[NKH];
#pragma unroll
    for (int kh = 0; kh < NKH; ++kh)
#pragma unroll
        for (int r = 0; r < 16; ++r) cinit[kh][r] = MOBA ? sl2 * (float)(32 * kh + (r & 3) + 8 * (r >> 2)) : 0.f;
    for (int tt = 0; tt < NT; ++tt) {
        int lane_t = lane; asm volatile("" : "+v"(lane_t));
        const int r32 = lane_t & 31, hi = lane_t >> 5, i16 = lane_t & 15, blk = (lane_t >> 4) & 1, tq = i16 >> 2, tp = i16 & 3;
        const int buf = tt & 1;
        if (tt + 1 < NT) ATT_LOAD(tt + 1);
#pragma unroll 1
        for (int sub = 0; sub < NSUB; ++sub) {
        bool act = true; bool lane_sel = true; int pblk = -1;
        if constexpr (MOBA) { if (tt >= TPB) { pblk = (tt - TPB) / TPB; lane_sel = (selmask >> pblk) & 1u; act = __builtin_amdgcn_ballot_w64(lane_sel) != 0ull; }
            else act = (TK * tt + 64 * sub <= wave * 32 + 31); }
        if (act) {
            f32x16 p[NKH];
            const LAS unsigned char* Kb = lds + buf * KB + sub * 64 * (2 * D);
#pragma unroll
            for (int ks = 0; ks < NKS; ++ks) {
#pragma unroll
                for (int kh = 0; kh < NKH; ++kh) { const int row = 32 * kh + r32;
                    const bf16x8 a = *(const LAS bf16x8*)(Kb + row * (2 * D) + (((2 * ks + hi) ^ kswz<D>(row)) << 4));
                    p[kh] = __builtin_amdgcn_mfma_f32_32x32x16_bf16(a, qr[ks], ks == 0 ? cinit[kh] : p[kh], 0, 0, 0); }
            }
            float offl = 0.f;
            if constexpr (MOBA) {
                const int kb = tile_kbase<MOBA, TK>(tt, qb) + 64 * sub; offl = sl2 * (float)(kb - qb * 256 + 4 * hi);
                if (tt < TPB) {
                    const int k0 = TK * tt + 64 * sub + 4 * hi;
#pragma unroll
                    for (int kh = 0; kh < NKH; ++kh)
#pragma unroll
                        for (int r = 0; r < 16; ++r) { const int kv = k0 + 32 * kh + (r & 3) + 8 * (r >> 2); if (kv > qrel) p[kh][r] = -INFINITY; }
                } else if (!lane_sel) {
#pragma unroll
                    for (int kh = 0; kh < NKH; ++kh)
#pragma unroll
                        for (int r = 0; r < 16; ++r) p[kh][r] = -INFINITY;
                }
            }
            float mx = p[0][0];
#pragma unroll
            for (int kh = 0; kh < NKH; ++kh)
#pragma unroll
                for (int r = 0; r < 16; ++r) mx = fmaxf(mx, p[kh][r]);
            mx += offl;
            mx = fmaxf(mx, __shfl_xor(mx, 32));
            const float mnew = fmaxf(m, mx);
            if (__builtin_amdgcn_ballot_w64(mnew > m) != 0ull) { const float alpha = __builtin_amdgcn_exp2f(m - mnew); l *= alpha;
#pragma unroll
                for (int dh = 0; dh < NDH; ++dh)
#pragma unroll
                    for (int r = 0; r < 16; ++r) o[dh][r] *= alpha;
                m = mnew; }
            float ps = 0.f; const float mt = m - offl;
#pragma unroll
            for (int kh = 0; kh < NKH; ++kh)
#pragma unroll
                for (int r = 0; r < 16; ++r) { p[kh][r] = __builtin_amdgcn_exp2f(p[kh][r] - mt); ps += p[kh][r]; }
            l += ps;
            const LAS unsigned char* Vb = lds + (2 + buf) * KB + sub * 64 * (2 * D);
#pragma unroll
            for (int kh = 0; kh < NKH; ++kh)
#pragma unroll
                for (int s = 0; s < 2; ++s) {
                    const bf16x8 pb = pack8(p[kh], s);
#pragma unroll
                    for (int dh = 0; dh < NDH; ++dh) {
                        const int rowA = 32 * kh + 16 * s + 4 * hi + tq, rowB = rowA + 8, chv = 4 * dh + 2 * blk + (tp >> 1);
                        const s16x4 lo = vtr(Vb + rowA * (2 * D) + ((chv ^ vswz<D>(rowA)) << 4) + 8 * (tp & 1));
                        const s16x4 hh = vtr(Vb + rowB * (2 * D) + ((chv ^ vswz<D>(rowB)) << 4) + 8 * (tp & 1));
                        const bf16x8 va = (bf16x8){lo[0], lo[1], lo[2], lo[3], hh[0], hh[1], hh[2], hh[3]};
                        o[dh] = __builtin_amdgcn_mfma_f32_32x32x16_bf16(va, pb, o[dh], 0, 0, 0);
                    }
                }
        }
        }
        if (tt + 1 < NT) ATT_WRITE(buf ^ 1);
        __syncthreads();
    }
    l += __shfl_xor(l, 32);
    const float inv = 1.f / l;
    bf16_t* orow = Og + qrow * ld + h * D;
#pragma unroll
    for (int dh = 0; dh < NDH; ++dh)
#pragma unroll
        for (int g = 0; g < 4; ++g) { uint2 w; w.x = cvt_pk_bf16(o[dh][4 * g] * inv, o[dh][4 * g + 1] * inv); w.y = cvt_pk_bf16(o[dh][4 * g + 2] * inv, o[dh][4 * g + 3] * inv);
            *(uint2*)(orow + 32 * dh + 8 * g + 4 * hi) = w; }
#undef ATT_LOAD
#undef ATT_WRITE
}

__device__ __forceinline__ void moba_pair(Frame& F, const int qb, const int b0, const int h0, const int b1, const int h1,
                                          const bf16_t* MQ, const bf16_t* MK, const bf16_t* MV, bf16_t* OM, const float* KMEAN) {
    constexpr int D = 64, KB = 64 * D * 2, NKS = 4, NDH = 2, ld = 512;
    int tid = F.tid, lane = F.lane; asm volatile("" : "+v"(tid), "+v"(lane));
    const int wave = F.wave, uh = wave >> 2, w4 = wave & 3, utid = tid & 255;
    const int b = uh ? b1 : b0, h = uh ? h1 : h0;
    LAS unsigned char* lds = F.lds + uh * 65536;
    LAS float* kml = (LAS float*)(F.lds + LDSCTL_OFF + 2048 + uh * 4096);
    const bf16_t* Kg = MK + (size_t)b * SEQ * ld; const bf16_t* Vg = MV + (size_t)b * SEQ * ld;
    const float sl2 = exp2f(-(float)(h + 1)) * LOG2E;
    bf16x8 qr[2][NKS]; unsigned selmask[2] = {0u, 0u};
    {
        const int r32 = lane & 31, hi = lane >> 5;
#pragma unroll
        for (int g = 0; g < 2; ++g) { const size_t qrow = (size_t)b * SEQ + qb * 256 + w4 * 64 + 32 * g + r32;
#pragma unroll
            for (int ks = 0; ks < NKS; ++ks) qr[g][ks] = *(const bf16x8*)(MQ + qrow * ld + h * D + 16 * ks + 8 * hi); }
        if (qb > 0) {
            if (utid < qb * 16) *(LAS f32x4*)(kml + 4 * utid) = *(const f32x4*)(KMEAN + (((size_t)b * 16 + (utid >> 4)) * 8 + h) * 64 + 4 * (utid & 15));
            __syncthreads();
#pragma unroll
            for (int g = 0; g < 2; ++g) {
                float qf[NKS * 8];
#pragma unroll
                for (int ks = 0; ks < NKS; ++ks) { const pg8::u32x4 w = __builtin_bit_cast(pg8::u32x4, qr[g][ks]);
#pragma unroll
                    for (int j = 0; j < 4; ++j) { qf[ks * 8 + 2 * j] = bfl(w[j]); qf[ks * 8 + 2 * j + 1] = bfh(w[j]); } }
                float v0 = -INFINITY, v1 = -INFINITY, v2 = -INFINITY; int i0 = -1, i1 = -1, i2 = -1;
#pragma unroll 1
                for (int j = 0; j < qb; ++j) { const LAS float* km = kml + 64 * j + 8 * hi; float s = 0.f;
#pragma unroll
                    for (int ks = 0; ks < NKS; ++ks) { const f32x4 k0 = *(const LAS f32x4*)(km + 16 * ks), k1 = *(const LAS f32x4*)(km + 16 * ks + 4);
                        s += qf[ks * 8 + 0] * k0[0] + qf[ks * 8 + 1] * k0[1] + qf[ks * 8 + 2] * k0[2] + qf[ks * 8 + 3] * k0[3] + qf[ks * 8 + 4] * k1[0] + qf[ks * 8 + 5] * k1[1] + qf[ks * 8 + 6] * k1[2] + qf[ks * 8 + 7] * k1[3]; }
                    s += __shfl_xor(s, 32);
                    const bool c0 = s > v0, c1 = s > v1, c2 = s > v2;
                    v2 = c1 ? v1 : (c2 ? s : v2); i2 = c1 ? i1 : (c2 ? j : i2);
                    v1 = c0 ? v0 : (c1 ? s : v1); i1 = c0 ? i0 : (c1 ? j : i1);
                    v0 = c0 ? s : v0; i0 = c0 ? j : i0; }
                selmask[g] = (i0 >= 0 ? (1u << i0) : 0u) | (i1 >= 0 ? (1u << i1) : 0u) | (i2 >= 0 ? (1u << i2) : 0u);
            }
        }
    }
    const int NT = 4 * (qb + 1);
#define MP_STAGE(tt, buf) do { const int kb_ = tile_kbase<true, 64>(tt, qb); _Pragma("unroll") for (int i_ = 0; i_ < 2; ++i_) { const int ci_ = utid + 256 * i_, row_ = ci_ >> 3, cp_ = ci_ & 7; \
        const size_t gk_ = (size_t)(kb_ + row_) * ld + h * D + 8 * (cp_ ^ kswz<64>(row_)), gv_ = (size_t)(kb_ + row_) * ld + h * D + 8 * (cp_ ^ vswz<64>(row_)); \
        __builtin_amdgcn_global_load_lds((const unsigned*)(Kg + gk_), (LAS unsigned*)(lds + (2 * (buf)) * KB + (w4 * 64 + 256 * i_) * 16), 16, 0, 0); \
        __builtin_amdgcn_global_load_lds((const unsigned*)(Vg + gv_), (LAS unsigned*)(lds + (2 * (buf) + 1) * KB + (w4 * 64 + 256 * i_) * 16), 16, 0, 0); } } while (0)
    MP_STAGE(0, 0); if (NT > 1) MP_STAGE(1, 1); if (NT > 2) MP_STAGE(2, 2);
    float m[2] = {-1e30f, -1e30f}, l[2] = {0.f, 0.f};
    f32x16 o[2][NDH];
#pragma unroll
    for (int g = 0; g < 2; ++g)
#pragma unroll
        for (int dh = 0; dh < NDH; ++dh)
#pragma unroll
            for (int r = 0; r < 16; ++r) o[g][dh][r] = 0.f;
    for (int tt = 0; tt < NT; ++tt) {
        int lane_t = lane; asm volatile("" : "+v"(lane_t));
        const int r32 = lane_t & 31, hi = lane_t >> 5, i16 = lane_t & 15, blk = (lane_t >> 4) & 1, tq = i16 >> 2, tp = i16 & 3;
        const int buf = tt & 3;
        { const int ahead = NT - 1 - tt;
          if (ahead >= 2) asm volatile("s_waitcnt vmcnt(8)" ::: "memory"); else if (ahead == 1) asm volatile("s_waitcnt vmcnt(4)" ::: "memory"); else asm volatile("s_waitcnt vmcnt(0)" ::: "memory"); }
        asm volatile("s_waitcnt lgkmcnt(0)" ::: "memory"); __builtin_amdgcn_s_barrier(); asm volatile("" ::: "memory");
        if (tt + 3 < NT) MP_STAGE(tt + 3, (tt + 3) & 3);
        bool act[2]; bool lane_sel[2];
#pragma unroll
        for (int g = 0; g < 2; ++g) { lane_sel[g] = true;
            if (tt >= 4) { lane_sel[g] = (selmask[g] >> ((tt - 4) >> 2)) & 1u; act[g] = __builtin_amdgcn_ballot_w64(lane_sel[g]) != 0ull; }
            else act[g] = (64 * tt <= w4 * 64 + 32 * g + 31); }
        if (act[0] || act[1]) {
            const LAS unsigned char* Kb = lds + (2 * buf) * KB; const LAS unsigned char* Vb = lds + (2 * buf + 1) * KB;
            const int kb = tile_kbase<true, 64>(tt, qb); const float offl = sl2 * (float)(kb - qb * 256 + 4 * hi);
            bf16x8 pb[2][4];
#pragma unroll
            for (int g = 0; g < 2; ++g) {
                if (act[g]) {
                    f32x16 p[2];
#pragma unroll
                    for (int kh = 0; kh < 2; ++kh)
#pragma unroll
                        for (int r = 0; r < 16; ++r) p[kh][r] = sl2 * (float)(32 * kh + (r & 3) + 8 * (r >> 2));
#pragma unroll
                    for (int ks = 0; ks < NKS; ++ks)
#pragma unroll
                        for (int kh = 0; kh < 2; ++kh) { const int row = 32 * kh + r32;
                            const bf16x8 a = *(const LAS bf16x8*)(Kb + row * 128 + (((2 * ks + hi) ^ kswz<64>(row)) << 4));
                            p[kh] = __builtin_amdgcn_mfma_f32_32x32x16_bf16(a, qr[g][ks], p[kh], 0, 0, 0); }
                    if (tt < 4) { const int qrel = w4 * 64 + 32 * g + r32, k0 = 64 * tt + 4 * hi;
#pragma unroll
                        for (int kh = 0; kh < 2; ++kh)
#pragma unroll
                            for (int r = 0; r < 16; ++r) { const int kv = k0 + 32 * kh + (r & 3) + 8 * (r >> 2); if (kv > qrel) p[kh][r] = -INFINITY; }
                    } else if (!lane_sel[g]) {
#pragma unroll
                        for (int kh = 0; kh < 2; ++kh)
#pragma unroll
                            for (int r = 0; r < 16; ++r) p[kh][r] = -INFINITY;
                    }
                    float mx = p[0][0];
#pragma unroll
                    for (int kh = 0; kh < 2; ++kh)
#pragma unroll
                        for (int r = 0; r < 16; ++r) mx = fmaxf(mx, p[kh][r]);
                    mx += offl; mx = fmaxf(mx, __shfl_xor(mx, 32));
                    const float mnew = fmaxf(m[g], mx);
                    if (__builtin_amdgcn_ballot_w64(mnew > m[g]) != 0ull) { const float alpha = __builtin_amdgcn_exp2f(m[g] - mnew); l[g] *= alpha;
#pragma unroll
                        for (int dh = 0; dh < NDH; ++dh)
#pragma unroll
                            for (int r = 0; r < 16; ++r) o[g][dh][r] *= alpha;
                        m[g] = mnew; }
                    float ps = 0.f; const float mt = m[g] - offl;
#pragma unroll
                    for (int kh = 0; kh < 2; ++kh)
#pragma unroll
                        for (int r = 0; r < 16; ++r) { p[kh][r] = __builtin_amdgcn_exp2f(p[kh][r] - mt); ps += p[kh][r]; }
                    l[g] += ps;
#pragma unroll
                    for (int kh = 0; kh < 2; ++kh)
#pragma unroll
                        for (int s = 0; s < 2; ++s) pb[g][2 * kh + s] = pack8(p[kh], s);
                } else {
#pragma unroll
                    for (int q = 0; q < 4; ++q) pb[g][q] = (bf16x8){0, 0, 0, 0, 0, 0, 0, 0};
                }
            }
#pragma unroll
            for (int kh = 0; kh < 2; ++kh)
#pragma unroll
                for (int s = 0; s < 2; ++s)
#pragma unroll
                    for (int dh = 0; dh < NDH; ++dh) {
                        const int rowA = 32 * kh + 16 * s + 4 * hi + tq, rowB = rowA + 8, chv = 4 * dh + 2 * blk + (tp >> 1);
                        const s16x4 lo = vtr(Vb + rowA * 128 + ((chv ^ vswz<64>(rowA)) << 4) + 8 * (tp & 1));
                        const s16x4 hh = vtr(Vb + rowB * 128 + ((chv ^ vswz<64>(rowB)) << 4) + 8 * (tp & 1));
                        const bf16x8 va = (bf16x8){lo[0], lo[1], lo[2], lo[3], hh[0], hh[1], hh[2], hh[3]};
#pragma unroll
                        for (int g = 0; g < 2; ++g) o[g][dh] = __builtin_amdgcn_mfma_f32_32x32x16_bf16(va, pb[g][2 * kh + s], o[g][dh], 0, 0, 0);
                    }
        }
    }
    asm volatile("s_waitcnt lgkmcnt(0)" ::: "memory"); __builtin_amdgcn_s_barrier(); asm volatile("" ::: "memory");
    { const int r32 = lane & 31, hi = lane >> 5;
#pragma unroll
      for (int g = 0; g < 2; ++g) { float lt = l[g]; lt += __shfl_xor(lt, 32); const float inv = 1.f / lt;
          bf16_t* orow = OM + ((size_t)b * SEQ + qb * 256 + w4 * 64 + 32 * g + r32) * ld + h * D;
#pragma unroll
          for (int dh = 0; dh < NDH; ++dh)
#pragma unroll
              for (int q = 0; q < 4; ++q) { uint2 w; w.x = cvt_pk_bf16(o[g][dh][4 * q] * inv, o[g][dh][4 * q + 1] * inv); w.y = cvt_pk_bf16(o[g][dh][4 * q + 2] * inv, o[g][dh][4 * q + 3] * inv);
                  *(uint2*)(orow + 32 * dh + 8 * q + 4 * hi) = w; } } }
#undef MP_STAGE
}
}
__device__ __forceinline__ void p2_moba(Frame& F) {
    const bf16_t* MQ = (const bf16_t*)(F.ws + WS_MQ); const bf16_t* MK = (const bf16_t*)(F.ws + WS_MK); const bf16_t* MV = (const bf16_t*)(F.ws + WS_MV); bf16_t* OM = (bf16_t*)(F.ws + WS_OMOBA);
    for (int pr = F.vcu; pr < 256; pr += F.G) { const int bh = pr >> 3, p = pr & 7, b = bh >> 3, h = bh & 7;
#pragma unroll 1
        for (int k = 0; k < 2; ++k) { const int qb = k ? 15 - p : p;
            att::attn_unit<64, true, 2>(F, b, h, qb, MQ, MK + (size_t)b * SEQ * 512, MV + (size_t)b * SEQ * 512, OM, 512, (const float*)(F.ctl + CW_KMEAN), nullptr, nullptr, nullptr); } }
}
__device__ __forceinline__ void p2_mem(Frame& F, const float* g_mem_q, const float* g_mem_k) {
    const bf16_t* CQ = (const bf16_t*)(F.ws + WS_CQ); const bf16_t* MEMK = (const bf16_t*)(F.ws + WS_MEMK); const bf16_t* MEMV = (const bf16_t*)(F.ws + WS_MEMV); bf16_t* OM = (bf16_t*)(F.ws + WS_OMEM);
#pragma unroll 1
    for (int u = F.vcu; u < 256; u += F.G) { const int bh = u >> 4, qb = u & 15, b = bh >> 2, h = bh & 3;
        att::attn_unit<128, false, 1>(F, b, h, qb, CQ, MEMK + (size_t)b * MEMLEN * 512, MEMV + (size_t)b * MEMLEN * 512, OM, 512, nullptr, (const float*)(F.ctl + CW_MEMKSS) + (size_t)b * MEMLEN * 4, g_mem_q, g_mem_k); }
}
namespace ret {
using att::f32x16; using att::s16x4; using att::vtr; using att::pack8; using att::kswz; using att::vswz; using att::crow; using pg8::bf16x8;
constexpr int L_KT = 0, L_KD = 16384, L_VT = 32768, L_SB = 65536, L_SS = 98304, L_G = 99328;
__device__ __forceinline__ void retention_item(Frame& F, const int b, const int h, const float* g_ret_out, const int c0, const int c1) {
    const bf16_t* RQ = (const bf16_t*)(F.ws + WS_RQ); const bf16_t* RK = (const bf16_t*)(F.ws + WS_RK); const bf16_t* RV = (const bf16_t*)(F.ws + WS_RV); const bf16_t* RG = (const bf16_t*)(F.ws + WS_RG); bf16_t* ORET = (bf16_t*)(F.ws + WS_ORET);
    int tid = F.tid, lane = F.lane; asm volatile("" : "+v"(tid), "+v"(lane));
    const int wave = F.wave;
    LAS unsigned char* lds = F.lds;
    const float lg2_o = log2f(1.f - exp2f(-5.f - (float)h)), g128 = exp2f(128.f * lg2_o);
    const size_t tok0 = (size_t)b * SEQ;
    v4u kreg[2], vreg[4];
#define RET_LOAD(n) do { _Pragma("unroll") for (int i_ = 0; i_ < 2; ++i_) { const int ci_ = tid + 512 * i_; kreg[i_] = *(const v4u*)(RK + (tok0 + (n) * 128 + (ci_ >> 3)) * 256 + h * 64 + 8 * (ci_ & 7)); } \
        _Pragma("unroll") for (int i_ = 0; i_ < 4; ++i_) { const int ci_ = tid + 512 * i_; vreg[i_] = *(const v4u*)(RV + (tok0 + (n) * 128 + (ci_ >> 4)) * 512 + h * 128 + 8 * (ci_ & 15)); } } while (0)
#define RET_WRITE() do { _Pragma("unroll") for (int i_ = 0; i_ < 2; ++i_) { const int ci_ = tid + 512 * i_, row_ = ci_ >> 3, ch_ = ci_ & 7; const v4u k_ = kreg[i_]; \
            *(LAS v4u*)(lds + L_KT + row_ * 128 + ((ch_ ^ kswz<64>(row_)) << 4)) = k_; const float dk_ = __builtin_amdgcn_exp2f(lg2 * (float)(127 - row_)); v4u d_; \
            d_.x = cvt_pk_bf16(att::bfl(k_.x) * dk_, att::bfh(k_.x) * dk_); d_.y = cvt_pk_bf16(att::bfl(k_.y) * dk_, att::bfh(k_.y) * dk_); d_.z = cvt_pk_bf16(att::bfl(k_.z) * dk_, att::bfh(k_.z) * dk_); d_.w = cvt_pk_bf16(att::bfl(k_.w) * dk_, att::bfh(k_.w) * dk_); \
            *(LAS v4u*)(lds + L_KD + row_ * 128 + ((ch_ ^ vswz<64>(row_)) << 4)) = d_; } \
        _Pragma("unroll") for (int i_ = 0; i_ < 4; ++i_) { const int ci_ = tid + 512 * i_, row_ = ci_ >> 4, ch_ = ci_ & 15; *(LAS v4u*)(lds + L_VT + row_ * 256 + ((ch_ ^ vswz<128>(row_)) << 4)) = vreg[i_]; } } while (0)
    { const float lg2 = lg2_o; RET_LOAD(0); RET_WRITE(); }
    { const v4u z = {0u, 0u, 0u, 0u}; *(LAS v4u*)(lds + L_SB + tid * 32) = z; *(LAS v4u*)(lds + L_SB + tid * 32 + 16) = z; }
    f32x16 st;
#pragma unroll
    for (int r = 0; r < 16; ++r) st[r] = 0.f;
    const int ib = wave & 3, e2 = wave >> 2;
    LAS float* ssb = (LAS float*)(lds + L_SS);
    if (tid < 128) ((LAS float*)(lds + L_G))[tid] = g_ret_out[tid];
    bf16x8 qn[4];
    { const size_t tr0 = tok0 + (size_t)c0 * 128 + 32 * ib + (lane & 31);
#pragma unroll
      for (int ks = 0; ks < 4; ++ks) qn[ks] = *(const bf16x8*)(RQ + tr0 * 256 + h * 64 + 16 * ks + 8 * (lane >> 5)); }
    __syncthreads();
    for (int n = 0; n < c1; ++n) {
        const bool outp = n >= c0;
        int lane_n = lane; float lg2 = lg2_o; asm volatile("" : "+v"(lane_n), "+v"(lg2));
        const int r32 = lane_n & 31, hi = lane_n >> 5, i16 = lane_n & 15, blk = (lane_n >> 4) & 1, tq = i16 >> 2, tp = i16 & 3;
        if (n + 1 < c1) RET_LOAD(n + 1);
        const LAS unsigned char* Sb = lds + L_SB + (n & 1) * 16384; LAS unsigned char* Sn = lds + L_SB + ((n + 1) & 1) * 16384;
        const size_t tokrow = tok0 + n * 128 + 32 * ib + r32;
        f32x16 o[2]; uint2 rgv[8];
#pragma unroll
        for (int q2 = 0; q2 < 2; ++q2)
#pragma unroll
            for (int r = 0; r < 16; ++r) o[q2][r] = 0.f;
#pragma unroll
        for (int q = 0; q < 8; ++q) rgv[q] = make_uint2(0u, 0u);
        if (outp) {
#pragma unroll
        for (int q2 = 0; q2 < 2; ++q2)
#pragma unroll
            for (int g = 0; g < 4; ++g) rgv[q2 * 4 + g] = *(const uint2*)(RG + tokrow * 512 + h * 128 + 64 * e2 + 32 * q2 + 8 * g + 4 * hi);
        {
            bf16x8 qr[4];
#pragma unroll
            for (int ks = 0; ks < 4; ++ks) qr[ks] = qn[ks];
            if (n + 1 < c1) {
#pragma unroll
                for (int ks = 0; ks < 4; ++ks) qn[ks] = *(const bf16x8*)(RQ + (tokrow + 128) * 256 + h * 64 + 16 * ks + 8 * hi); }
#pragma unroll
            for (int q2 = 0; q2 < 2; ++q2) {
#pragma unroll
                for (int r = 0; r < 16; ++r) o[q2][r] = 0.f;
                const int e = 64 * e2 + 32 * q2 + r32;
#pragma unroll
                for (int ks = 0; ks < 4; ++ks) { const bf16x8 a = *(const LAS bf16x8*)(Sb + e * 128 + (((2 * ks + hi) ^ kswz<64>(e)) << 4)); o[q2] = __builtin_amdgcn_mfma_f32_32x32x16_bf16(a, qr[ks], o[q2], 0, 0, 0); } }
            const float gq = __builtin_amdgcn_exp2f(lg2 * (float)(32 * ib + r32 + 1));
#pragma unroll
            for (int q2 = 0; q2 < 2; ++q2)
#pragma unroll
                for (int r = 0; r < 16; ++r) o[q2][r] *= gq;
            __builtin_amdgcn_sched_barrier(0);
#pragma unroll 1
            for (int jb = 0; jb <= ib; ++jb) {
                f32x16 p;
#pragma unroll
                for (int r = 0; r < 16; ++r) p[r] = 0.f;
                const int krow_ = 32 * jb + r32;
#pragma unroll
                for (int ks = 0; ks < 4; ++ks) { const bf16x8 a = *(const LAS bf16x8*)(lds + L_KT + krow_ * 128 + (((2 * ks + hi) ^ kswz<64>(krow_)) << 4)); p = __builtin_amdgcn_mfma_f32_32x32x16_bf16(a, qr[ks], p, 0, 0, 0); }
                const float cl = __builtin_amdgcn_exp2f(lg2 * (float)(32 * (ib - jb) + r32 - 4 * hi));
                const bool diag = (jb == ib);
#pragma unroll
                for (int r = 0; r < 16; ++r) { float v = p[r] * (cl * __builtin_amdgcn_exp2f(-lg2 * (float)((r & 3) + 8 * (r >> 2)))); if (diag && ((r & 3) + 8 * (r >> 2) + 4 * hi) > r32) v = 0.f; p[r] = v; }
#pragma unroll
                for (int s = 0; s < 2; ++s) { const bf16x8 pb = pack8(p, s);
                    const int rowA = 32 * jb + 16 * s + 4 * hi + tq, rowB = rowA + 8;
#pragma unroll
                    for (int q2 = 0; q2 < 2; ++q2) { const int chv = 4 * (2 * e2 + q2) + 2 * blk + (tp >> 1);
                        const s16x4 lo = vtr(lds + L_VT + rowA * 256 + ((chv ^ vswz<128>(rowA)) << 4) + 8 * (tp & 1));
                        const s16x4 hh = vtr(lds + L_VT + rowB * 256 + ((chv ^ vswz<128>(rowB)) << 4) + 8 * (tp & 1));
                        const bf16x8 va = (bf16x8){lo[0], lo[1], lo[2], lo[3], hh[0], hh[1], hh[2], hh[3]};
                        o[q2] = __builtin_amdgcn_mfma_f32_32x32x16_bf16(va, pb, o[q2], 0, 0, 0); }
                    __builtin_amdgcn_sched_barrier(0); }
            }
        }
        __builtin_amdgcn_sched_barrier(0);
        { float ss = 0.f;
#pragma unroll
            for (int q2 = 0; q2 < 2; ++q2)
#pragma unroll
                for (int r = 0; r < 16; ++r) ss += o[q2][r] * o[q2][r];
            ss += __shfl_xor(ss, 32);
            if (hi == 0) ssb[e2 * 128 + 32 * ib + r32] = ss; }
        }
        __builtin_amdgcn_sched_barrier(0);
        { const int eh = wave & 3, dh = wave >> 2;
#pragma unroll
            for (int r = 0; r < 16; ++r) st[r] *= g128;
#pragma unroll 1
            for (int kst = 0; kst < 8; ++kst) { const int rowA = 16 * kst + 4 * hi + tq, rowB = rowA + 8, chv = 4 * eh + 2 * blk + (tp >> 1), chk = 4 * dh + 2 * blk + (tp >> 1);
                const s16x4 lo = vtr(lds + L_VT + rowA * 256 + ((chv ^ vswz<128>(rowA)) << 4) + 8 * (tp & 1));
                const s16x4 hh = vtr(lds + L_VT + rowB * 256 + ((chv ^ vswz<128>(rowB)) << 4) + 8 * (tp & 1));
                const s16x4 kl = vtr(lds + L_KD + rowA * 128 + ((chk ^ vswz<64>(rowA)) << 4) + 8 * (tp & 1));
                const s16x4 kh = vtr(lds + L_KD + rowB * 128 + ((chk ^ vswz<64>(rowB)) << 4) + 8 * (tp & 1));
                const bf16x8 va = (bf16x8){lo[0], lo[1], lo[2], lo[3], hh[0], hh[1], hh[2], hh[3]};
                const bf16x8 kb = (bf16x8){kl[0], kl[1], kl[2], kl[3], kh[0], kh[1], kh[2], kh[3]};
                st = __builtin_amdgcn_mfma_f32_32x32x16_bf16(va, kb, st, 0, 0, 0); }
#pragma unroll
            for (int r = 0; r < 16; ++r) { const int e = 32 * eh + (r & 3) + 8 * (r >> 2) + 4 * hi, dd = 32 * dh + r32;
                *(LAS bf16_t*)(Sn + e * 128 + ((((dd >> 3) ^ kswz<64>(e))) << 4) + (dd & 7) * 2) = f2bf(st[r]); } }
        __builtin_amdgcn_sched_barrier(0);
        __syncthreads();
        if (outp) { const float rn = 1.f / sqrtf((ssb[32 * ib + r32] + ssb[128 + 32 * ib + r32]) * (1.f / 128.f) + 1e-5f);
#pragma unroll
            for (int q2 = 0; q2 < 2; ++q2)
#pragma unroll
                for (int g = 0; g < 4; ++g) { const int e = 64 * e2 + 32 * q2 + 8 * g + 4 * hi; const f32x4 gg = *(const LAS f32x4*)(lds + L_G + 4 * e); const uint2 rg = rgv[q2 * 4 + g];
                    uint2 w; w.x = cvt_pk_bf16(o[q2][4 * g] * rn * gg[0] * att::bfl(rg.x), o[q2][4 * g + 1] * rn * gg[1] * att::bfh(rg.x)); w.y = cvt_pk_bf16(o[q2][4 * g + 2] * rn * gg[2] * att::bfl(rg.y), o[q2][4 * g + 3] * rn * gg[3] * att::bfh(rg.y));
                    *(uint2*)(ORET + tokrow * 512 + h * 128 + e) = w; } }
        if (n + 1 < c1) RET_WRITE();
        __syncthreads();
    }
#undef RET_LOAD
#undef RET_WRITE
}
}
constexpr int P1_SPARE = 0, P1_CONV = 0;
__device__ __forceinline__ void conv_item(Frame& F, const int c, const float* w1, const float* w2) {
            LAS float* scr = (LAS float*)(F.lds + RING_OFF + F.wave * 16384);
            const bool isw1 = c < 512; const int cc = isw1 ? c : c - 512, e = cc >> 4, kb = cc & 15, nblk = isw1 ? 64 : 32, N = isw1 ? 2048 : 1024;
            const float* Wsrc = isw1 ? w1 + (size_t)e * 1024 * 2048 : w2 + (size_t)e * 1024 * 1024;
            bf16* WT = isw1 ? (bf16*)(F.ws + WS_W1) + (size_t)e * 2048 * 1024 : (bf16*)(F.ws + WS_W2) + (size_t)e * 1024 * 1024;
            float wa[32], wb[32];
            xp_load(wa, Wsrc, N, nblk, kb * nblk + F.wave, F.lane);
#pragma unroll 1
            for (int nb = F.wave; nb < nblk; nb += 16) {
                xp_load(wb, Wsrc, N, nblk, kb * nblk + nb + 8, F.lane);
                xp_finish(wa, 1024, nblk, WT, scr, kb * nblk + nb, F.lane);
                if (nb + 16 < nblk) xp_load(wa, Wsrc, N, nblk, kb * nblk + nb + 16, F.lane);
                xp_finish(wb, 1024, nblk, WT, scr, kb * nblk + nb + 8, F.lane);
            }
}
constexpr int CW_QUEUE = 128;
__device__ __forceinline__ void p2_mixers(Frame& F, const float* g_ret_out, const float* g_mem_q, const float* g_mem_k, const float* w1, const float* w2, const int qword, const int qlo, const int qhi, const int tmask) {
    volatile LAS int* slot = (volatile LAS int*)(F.lds + TB_OFF + 512);
    const bf16_t* MQ = (const bf16_t*)(F.ws + WS_MQ); const bf16_t* MK = (const bf16_t*)(F.ws + WS_MK); const bf16_t* MV = (const bf16_t*)(F.ws + WS_MV); bf16_t* OMO = (bf16_t*)(F.ws + WS_OMOBA);
    const bf16_t* CQ = (const bf16_t*)(F.ws + WS_CQ); const bf16_t* MEMK = (const bf16_t*)(F.ws + WS_MEMK); const bf16_t* MEMV = (const bf16_t*)(F.ws + WS_MEMV); bf16_t* OME = (bf16_t*)(F.ws + WS_OMEM);
    for (;;) {
        __syncthreads();
        if (F.tid == 0) slot[0] = (int)__hip_atomic_fetch_add((unsigned*)F.ctl + qword, 1u, __ATOMIC_RELAXED, __HIP_MEMORY_SCOPE_AGENT);
        __syncthreads();
        const int it = slot[0] + qlo;
        if (it >= qhi) break;
        if (it < 64) { if (tmask & 1) { const int seg = 3 - (it >> 4), bh = it & 15; ret::retention_item(F, bh >> 2, bh & 3, g_ret_out, 8 * seg, 8 * seg + 8); } continue; }
        const int j = it - 64;
        if (j < 256) { if (!(tmask & 2)) continue;
            const int qb = 15 - (j >> 4), bh0 = j & 15, bh1 = bh0 + 16;
            att::moba_pair(F, qb, bh0 >> 3, bh0 & 7, bh1 >> 3, bh1 & 7, MQ, MK, MV, OMO, (const float*)(F.ctl + CW_KMEAN)); }
        else { const int j2 = j - 256, grp = j2 / 5, pos = j2 % 5;
            if (pos == 4) { if (!(tmask & 4)) continue; const int u = grp, bh = u >> 4, qb = u & 15, b = bh >> 2, h = bh & 3;
                att::attn_unit<128, false, 1>(F, b, h, qb, CQ, MEMK + (size_t)b * MEMLEN * 512, MEMV + (size_t)b * MEMLEN * 512, OME, 512, nullptr, (const float*)(F.ctl + CW_MEMKSS) + (size_t)b * MEMLEN * 4, g_mem_q, g_mem_k); }
            else { if (!(tmask & 8)) continue; const int c = 4 * grp + pos; if (c >= P1_CONV) conv_item(F, c, w1, w2); }
        }
    }
}
#define WAVE_LDS_FENCE() do { asm volatile("s_waitcnt lgkmcnt(0)" ::: "memory"); } while (0)
__device__ __forceinline__ void p2_moba_slow(Frame& F) {
    const bf16_t* MQ = (const bf16_t*)(F.ws + WS_MQ); const bf16_t* MK = (const bf16_t*)(F.ws + WS_MK); const bf16_t* MV = (const bf16_t*)(F.ws + WS_MV); const float* KMEAN = (const float*)(F.ctl + CW_KMEAN); bf16_t* OMOBA = (bf16_t*)(F.ws + WS_OMOBA);
    LAS float* sc = (LAS float*)(F.lds) + F.wave * 1152; LAS float* qsh = sc + 1024;
    const int gw = F.vcu * NWAVES + F.wave, NGW = F.G * NWAVES, lane = F.lane;
    for (int w = gw; w < NB * 8 * SEQ; w += NGW) {
        const int t = w & 4095, h = (w >> 12) & 7, b = w >> 15; const int qb = t >> 8; const size_t row = (size_t)b * 4096 + t;
        qsh[lane] = bf2f(MQ[row * 512 + h * 64 + lane]);
        WAVE_LDS_FENCE();
        float q[64];
#pragma unroll
        for (int d = 0; d < 64; ++d) q[d] = qsh[d];
        float gsc = -INFINITY; if (lane < qb) { const float* km = KMEAN + (((size_t)b * 16 + lane) * 8 + h) * 64; float s = 0.f;
#pragma unroll
            for (int d = 0; d < 64; ++d) s += q[d] * km[d];
            gsc = s; }
        int sel[4]; sel[0] = qb;
#pragma unroll
        for (int r = 0; r < 3; ++r) { const float m = wave_max64(gsc); int j = -1; if (m != -INFINITY) { const unsigned long long bal = __ballot(gsc == m); j = __ffsll((long long)bal) - 1; } sel[r + 1] = j; if (lane == j) gsc = -INFINITY; }
        const float slope = exp2f(-(float)(h + 1)); float mx = -INFINITY;
#pragma unroll
        for (int s = 0; s < 4; ++s) { const int blk = sel[s];
            for (int c = 0; c < 4; ++c) { const int kp = blk * 256 + c * 64 + lane; float v = -INFINITY;
                if (blk >= 0 && kp <= t) { const bf16_t* kr = MK + ((size_t)b * 4096 + kp) * 512 + h * 64; float d_ = 0.f;
#pragma unroll
                    for (int d = 0; d < 64; ++d) d_ += q[d] * bf2f(kr[d]);
                    v = d_ * 0.125f - slope * (float)(t - kp); }
                sc[s * 256 + c * 64 + lane] = v; mx = fmaxf(mx, v); } }
        mx = wave_max64(mx); float sum = 0.f;
        for (int i = lane; i < 1024; i += 64) { const float p = __expf(sc[i] - mx); sc[i] = p; sum += p; }
        sum = wave_sum64(sum);
        WAVE_LDS_FENCE();
        float o = 0.f;
#pragma unroll
        for (int s = 0; s < 4; ++s) { const int blk = sel[s]; if (blk >= 0) for (int k = 0; k < 256; ++k) { const float p = sc[s * 256 + k]; if (p != 0.f) o += p * bf2f(MV[((size_t)b * 4096 + blk * 256 + k) * 512 + h * 64 + lane]); } }
        OMOBA[row * 512 + h * 64 + lane] = f2bf(o / sum);
        WAVE_LDS_FENCE();
    }
}
__device__ __forceinline__ void p2_mem_slow(Frame& F, const float* g_mem_q, const float* g_mem_k) {
    const bf16_t* CQ = (const bf16_t*)(F.ws + WS_CQ); const bf16_t* MEMK = (const bf16_t*)(F.ws + WS_MEMK); const bf16_t* MEMV = (const bf16_t*)(F.ws + WS_MEMV); const float* MEMKSS = (const float*)(F.ctl + CW_MEMKSS); bf16_t* OMEM = (bf16_t*)(F.ws + WS_OMEM);
    LAS float* sc = (LAS float*)(F.lds) + F.wave * 1152; LAS float* qsh = sc + 1024;
    const int gw = F.vcu * NWAVES + F.wave, NGW = F.G * NWAVES, lane = F.lane;
    for (int w = gw; w < NB * 4 * SEQ; w += NGW) {
        const int t = w & 4095, h = (w >> 12) & 3, b = w >> 14; const size_t row = (size_t)b * 4096 + t;
        const float q0 = bf2f(CQ[row * 512 + h * 128 + lane]), q1 = bf2f(CQ[row * 512 + h * 128 + 64 + lane]);
        const float rq = 1.f / sqrtf(wave_sum64(q0 * q0 + q1 * q1) * (1.f / 128.f) + 1e-5f);
        qsh[lane] = q0 * rq * g_mem_q[lane] * g_mem_k[lane]; qsh[lane + 64] = q1 * rq * g_mem_q[lane + 64] * g_mem_k[lane + 64];
        WAVE_LDS_FENCE();
        float mx = -INFINITY;
        for (int c = 0; c < 4; ++c) { const int m = c * 64 + lane; const bf16_t* kr = MEMK + ((size_t)b * 256 + m) * 512 + h * 128; float d_ = 0.f; for (int d = 0; d < 128; ++d) d_ += qsh[d] * bf2f(kr[d]);
            const float rk = 1.f / sqrtf(MEMKSS[((size_t)b * 256 + m) * 4 + h] * (1.f / 128.f) + 1e-5f); const float v = d_ * rk * 0.08838834764831845f; sc[m] = v; mx = fmaxf(mx, v); }
        mx = wave_max64(mx); float sum = 0.f;
        for (int i = lane; i < 256; i += 64) { const float p = __expf(sc[i] - mx); sc[i] = p; sum += p; }
        sum = wave_sum64(sum); WAVE_LDS_FENCE();
        float o0 = 0.f, o1 = 0.f;
        for (int k = 0; k < 256; ++k) { const float p = sc[k]; const bf16_t* vr = MEMV + ((size_t)b * 256 + k) * 512 + h * 128; o0 += p * bf2f(vr[lane]); o1 += p * bf2f(vr[lane + 64]); }
        OMEM[row * 512 + h * 128 + lane] = f2bf(o0 / sum); OMEM[row * 512 + h * 128 + 64 + lane] = f2bf(o1 / sum);
        WAVE_LDS_FENCE();
    }
}
__device__ __forceinline__ void p2_ret_slow(Frame& F, const float* g_ret_out) {
    const bf16_t* RQ = (const bf16_t*)(F.ws + WS_RQ); const bf16_t* RK = (const bf16_t*)(F.ws + WS_RK); const bf16_t* RV = (const bf16_t*)(F.ws + WS_RV); const bf16_t* RG = (const bf16_t*)(F.ws + WS_RG); bf16_t* ORET = (bf16_t*)(F.ws + WS_ORET);
    LAS float* qs = (LAS float*)(F.lds) + 16384; LAS float* ks = qs + 64; LAS float* part = ks + 64; LAS float* red = part + 256;
    const int tid = F.tid, e = tid & 127, hf = (tid >> 7) & 1;
    for (int it = F.vcu; it < 16; it += F.G) {
        const int b = it >> 2, h = it & 3; const float gamma = 1.f - exp2f(-5.f - (float)h);
        float s[32];
#pragma unroll
        for (int i = 0; i < 32; ++i) s[i] = 0.f;
        for (int t = 0; t < 4096; ++t) { const size_t row = (size_t)b * 4096 + t;
            if (tid < 64) qs[tid] = bf2f(RQ[row * 256 + h * 64 + tid]); else if (tid < 128) ks[tid - 64] = bf2f(RK[row * 256 + h * 64 + tid - 64]);
            const float v = bf2f(RV[row * 512 + h * 128 + e]);
            __syncthreads();
            float o = 0.f;
            if (tid < 256) {
#pragma unroll
                for (int i = 0; i < 32; ++i) { s[i] = gamma * s[i] + ks[hf * 32 + i] * v; o += qs[hf * 32 + i] * s[i]; }
                part[tid] = o; }
            __syncthreads();
            float ov = 0.f;
            if (tid < 128) { ov = part[tid] + part[tid + 128]; const float ss = wave_sum64(ov * ov); if ((tid & 63) == 0) red[tid >> 6] = ss; }
            __syncthreads();
            if (tid < 128) { const float r = 1.f / sqrtf((red[0] + red[1]) * (1.f / 128.f) + 1e-5f); ORET[row * 512 + h * 128 + tid] = f2bf(ov * r * g_ret_out[tid] * bf2f(RG[row * 512 + h * 128 + tid])); }
        }
    }
}
constexpr int N_PHASES = 9;
#ifndef PROBE_MASK
#define PROBE_MASK 0
#endif
constexpr int P2_NITEMS = 64 + 256 + 5 * 256;
#ifndef P2_LO
#define P2_LO 0
#define P2_HI P2_NITEMS
#endif
#ifndef P2_TMASK
#define P2_TMASK 15
#endif
#define NREP(k) ((((PROBE_MASK) >> (k)) & 1) ? 2 : 1)
__global__ void __launch_bounds__(NWAVES * 64, 2) mega(Args args) {
    extern __shared__ __attribute__((aligned(16))) unsigned char lds[];
    Frame F;
    F.lds = (LAS unsigned char*)lds; F.MISC = (volatile LAS unsigned*)(F.lds + MISC_OFF);
    F.tid = threadIdx.x; F.lane = F.tid & 63; F.wave = __builtin_amdgcn_readfirstlane(F.tid >> 6);
    F.G = gridDim.x; { const int bx = blockIdx.x; F.vcu = (F.G % 8 == 0) ? (bx % 8) * (F.G / 8) + bx / 8 : bx; }
    F.ws = args.ws; F.out = args.out; F.ctl = (gu32*)(args.ws + WS_CTL);
    for (int u = F.tid; u < (LDS_BYTES - LDSCTL_OFF) / 4; u += NWAVES * 64) ((LAS unsigned*)(F.lds + LDSCTL_OFF))[u] = 0u;
    __syncthreads();
    XcdBarrier bar = xcd_barrier_post((unsigned*)(F.ctl + CW_BAR) + args.li * XCD_BAR_WORDS, F.MISC + 8);
    const int lo = args.ph_lo, hi = args.ph_hi;
#define IN(k) (lo <= (k) && (k) < hi)
#define BOTH(k) (IN(k) && IN((k) + 1))
    if (IN(0)) { for (int rep = 0; rep < NREP(0); ++rep) p0_prologue(F, args); if (BOTH(0)) xcd_barrier(bar); }
    if (IN(1)) {
        pg8::Gemm g{(const pg8::bf16_t*)(F.ws + WS_HB), (const pg8::bf16_t*)(F.ws + WS_WIN), NTOK + 1024, DIN + 1024, 1024};
        const int G1 = F.G - P1_SPARE; const bool p1_gemm = (int)blockIdx.x < G1;
        P1Order S; S.init(G1, p1_gemm ? (int)blockIdx.x : 0);
        EpiP1 E{F.ws, args.in[4], (const float*)(F.ws + WS_GTAB), (float*)(F.ctl + CW_KMEAN), (float*)(F.ctl + CW_MEMKSS), 1};
        if (p1_gemm) pg8::gemm_phase<EpiP1, P1Order, true, true>(F.lds + RING_OFF, g, S, E);
        else { for (int c = (int)blockIdx.x - G1; c < P1_CONV; c += (P1_SPARE ? P1_SPARE : 1)) { conv_item(F, c, args.in[19], args.in[21]); __syncthreads(); } }
        if (NREP(1) > 1) { xcd_barrier(bar); E.atom_on = 0; pg8::gemm_phase<EpiP1, P1Order, true, true>(F.lds + RING_OFF, g, S, E); }
        if (BOTH(1)) xcd_barrier(bar);
    }
    if (IN(2)) {
        p2_mixers(F, args.in[5], args.in[10], args.in[11], args.in[19], args.in[21], CW_QUEUE, 0, P2_NITEMS, 15);
        if (NREP(2) > 1) { xcd_barrier(bar); p2_mixers(F, args.in[5], args.in[10], args.in[11], args.in[19], args.in[21], CW_QUEUE + 1024, P2_LO, P2_HI, P2_TMASK); }
        if (BOTH(2)) xcd_barrier(bar);
    }
    if (IN(3)) {
        P3Order S; S.init(F.G, (int)blockIdx.x, F.ws); EpiP3 E{(const bf16_t*)(F.ws + WS_GT), (bf16_t*)(F.ws + WS_Y)};
        pg9::gemm_phase<EpiP3, P3Order, false>(F.lds + RING_OFF, 512, 512, 512, S, E);
        if (NREP(3) > 1) pg9::gemm_phase<EpiP3, P3Order, false>(F.lds + RING_OFF, 512, 512, 512, S, E);
        if (BOTH(3)) xcd_barrier(bar);
    }
    if (IN(4)) {
        P4Order S; S.init(F.G, (int)blockIdx.x, F.ws); EpiP4 E{args.in[0], F.out};
        pg9::gemm_phase<EpiP4, P4Order, false>(F.lds + RING_OFF, 1024, 1024, 1024, S, E);
        if (NREP(4) > 1) pg9::gemm_phase<EpiP4, P4Order, false>(F.lds + RING_OFF, 1024, 1024, 1024, S, E);
        if (BOTH(4)) xcd_barrier(bar);
    }
    if (IN(5)) { p5_router(F, F.out, args.in[16], args.in[17], args.in[18], (int*)F.ctl + CW_COUNTS, (int*)(F.ws + WS_LISTS));
        if (NREP(5) > 1) p5_router(F, F.out, args.in[16], args.in[17], args.in[18], (int*)F.ctl + CW_COUNTS + 256, (int*)(F.ws + WS_RETST));
        if (BOTH(5)) xcd_barrier(bar); }
    if (IN(6)) {
        moe_tables(F);
        MoeOrder<3, WS_W1, 2048, 2, WS_XT> S; S.init(F.G, F.vcu, F.ws, (const LAS int*)(F.lds + TB_OFF));
        EpiMoe1 E{(const int*)(F.ws + WS_LISTS), args.in[20], (bf16_t*)(F.ws + WS_ACT)};
        pg9::gemm_phase<EpiMoe1, MoeOrder<3, WS_W1, 2048, 2, WS_XT>, true>(F.lds + RING_OFF, 1024, 1024, 1024, S, E);
        if (NREP(6) > 1) { xcd_barrier(bar); } if (NREP(6) > 1) pg9::gemm_phase<EpiMoe1, MoeOrder<3, WS_W1, 2048, 2, WS_XT>, true>(F.lds + RING_OFF, 1024, 1024, 1024, S, E);
        if (BOTH(6)) xcd_barrier(bar);
    }
    if (IN(7)) {
        moe_tables(F);
        MoeOrder<2, WS_W2, 1024, 0, WS_ACT> S; S.init(F.G, F.vcu, F.ws, (const LAS int*)(F.lds + TB_OFF));
        EpiMoe2 E{(const int*)(F.ws + WS_LISTS), args.in[22], (bf16_t*)(F.ws + WS_YS)};
        pg9::gemm_phase<EpiMoe2, MoeOrder<2, WS_W2, 1024, 0, WS_ACT>, true>(F.lds + RING_OFF, 1024, 1024, 1024, S, E);
        if (NREP(7) > 1) { xcd_barrier(bar); } if (NREP(7) > 1) pg9::gemm_phase<EpiMoe2, MoeOrder<2, WS_W2, 1024, 0, WS_ACT>, true>(F.lds + RING_OFF, 1024, 1024, 1024, S, E);
        if (BOTH(7)) xcd_barrier(bar);
    }
    if (IN(8)) { p8_combine(F, F.out, F.out); if (NREP(8) > 1) p8_combine(F, F.out, (float*)(F.ws + WS_HB)); }
    if (NREP(9) > 1) { for (int i = 0; i < 16; ++i) xcd_barrier(bar); }
#undef IN
#undef BOTH
}
#ifndef MK_ONE_LAUNCH
#define MK_ONE_LAUNCH 1
#endif
extern "C" void kernel_launch(void* const* d_in, const int* in_sizes, int n_in, void* d_out, int out_size, void* d_ws, size_t ws_size, hipStream_t stream) {
    if (ws_size < WS_END) { fprintf(stderr, "kernel_launch: ws too small %zu < %zu\n", ws_size, (size_t)WS_END); return; }
    unsigned char* ws = (unsigned char*)d_ws; float* out = (float*)d_out;
    static int grid = 0;
    if (grid == 0) {
        int dev = 0, cus = 0; if (hipGetDevice(&dev) != hipSuccess || hipDeviceGetAttribute(&cus, hipDeviceAttributeMultiprocessorCount, dev) != hipSuccess) { fprintf(stderr, "kernel_launch: device query failed\n"); grid = -1; return; }
        if (hipFuncSetAttribute((const void*)mega, hipFuncAttributeMaxDynamicSharedMemorySize, LDS_BYTES) != hipSuccess) { fprintf(stderr, "kernel_launch: hipFuncSetAttribute failed\n"); grid = -1; return; }
        (void)hipGetLastError(); grid = cus;
    }
    if (grid < 0) return;
    (void)hipMemsetAsync(ws + WS_CTL, 0, 1 * MiB, stream);
    Args a; memset(&a, 0, sizeof a); for (int i = 0; i < 23; ++i) a.in[i] = (const float*)d_in[i]; a.out = out; a.ws = ws; a.li = 0;
#if MK_ONE_LAUNCH
    a.ph_lo = 0; a.ph_hi = N_PHASES;
    hipLaunchKernelGGL(mega, dim3(grid), dim3(NWAVES * 64), LDS_BYTES, stream, a);
#else
    for (int p = 0; p < N_PHASES; ++p) { a.ph_lo = p; a.ph_hi = p + 1; hipLaunchKernelGGL(mega, dim3(grid), dim3(NWAVES * 64), LDS_BYTES, stream, a); }
#endif
}
```

```cpp
#define PROBE_MASK 0
#include <hip/hip_runtime.h>
#include <cstdio>
#include <cstdint>
#include <cstring>
typedef unsigned short bf16_t;
__host__ __device__ inline float bf2f(bf16_t v) { unsigned u = ((unsigned)v) << 16; float f; __builtin_memcpy(&f, &u, 4); return f; }
__host__ __device__ inline bf16_t f2bf(float f) { unsigned u; __builtin_memcpy(&u, &f, 4); u += 0x7fffu + ((u >> 16) & 1u); return (bf16_t)(u >> 16); }
constexpr int NTOK = 16384, SEQ = 4096, NB = 4, DM = 1024, DIN = 6656, MEMLEN = 256, NEXP = 32;
constexpr size_t MiB = (size_t)1 << 20;
constexpr size_t WS_CTL = 0;
constexpr size_t WS_WIN = 1 * MiB;
constexpr size_t WS_WMEMKV = 14 * MiB;
constexpr size_t WS_WBR = 16 * MiB;
constexpr size_t WS_WOUT = 19 * MiB;
constexpr size_t WS_W1 = 21 * MiB;
constexpr size_t WS_W2 = 149 * MiB;
constexpr size_t WS_HB = 213 * MiB;
constexpr size_t WS_HM = 245 * MiB;
constexpr size_t WS_RQ = 247 * MiB, WS_RK = 255 * MiB, WS_RV = 263 * MiB, WS_RG = 279 * MiB, WS_MQ = 295 * MiB, WS_MK = 311 * MiB, WS_MV = 327 * MiB, WS_CQ = 343 * MiB, WS_GT = 359 * MiB;
constexpr size_t WS_MEMK = 455 * MiB, WS_MEMV = 456 * MiB, WS_KMEAN = 457 * MiB, WS_MEMKSS = 457 * MiB + 512 * 1024;
constexpr size_t WS_WRS = 457 * MiB + 768 * 1024 + 4096;
constexpr size_t WS_GTAB = 457 * MiB + 768 * 1024;
constexpr size_t WS_ORET = 458 * MiB, WS_OMOBA = 474 * MiB, WS_OMEM = 490 * MiB;
constexpr size_t WS_Y = 506 * MiB, WS_XT = 538 * MiB;
constexpr size_t WS_TOPE = 570 * MiB, WS_TOPW = 570 * MiB + 256 * 1024, WS_LISTS = 571 * MiB;
constexpr size_t WS_ACT = 574 * MiB;
constexpr size_t WS_YS = 722 * MiB;
constexpr size_t WS_SLOT = 870 * MiB;
constexpr size_t WS_RETST = 959 * MiB;
constexpr size_t WS_END = 871 * MiB;
constexpr size_t WS_PROJ = 574 * MiB;
constexpr size_t WS_PM = 990 * MiB;
constexpr size_t WS_ORAW = 574 * MiB;
constexpr size_t WS_T0 = 703 * MiB, WS_T1 = 767 * MiB, WS_T2 = 831 * MiB;
constexpr int CW_COUNTS = 64;
namespace pg8 {
#define PG8_LAS __attribute__((address_space(3)))
typedef unsigned short bf16_t;
typedef short bf16x8 __attribute__((ext_vector_type(8)));
typedef float f32x4 __attribute__((ext_vector_type(4)));
typedef unsigned u32x4 __attribute__((ext_vector_type(4)));
constexpr int BM = 256, BK = 64, HALF = 128, HTB = HALF * BK * 2  , STAGE_BYTES = 8 * HTB, NXCD = 8, WGM = 4;

__host__ __device__ __forceinline__ int lds_byte(int r, int c) { const int st = (r >> 4) * 2 + (c >> 5), rr = r & 15, cc = c & 31, ob = rr * 64 + cc * 2; return st * 1024 + (ob ^ (((ob >> 9) & 1) << 5)); }
__host__ __device__ __forceinline__ void stage_rc(int b, int& R, int& C) { const int st = b / 1024, sb = b % 1024, swz = sb ^ (((sb >> 9) & 1) << 5); R = (st >> 1) * 16 + swz / 64; C = (st & 1) * 32 + (swz % 64) / 2; }
__host__ __device__ __forceinline__ int perm32(int rho) { const int n = rho >> 4, i = rho & 15; return 8 * (i >> 2) + 4 * n + (i & 3); }

struct Unit { int pm, pn; };
struct Gemm { const bf16_t* A; const bf16_t* Bt; int M, N, K; };
struct StaticOrder {
    int nM, nN, nwg, G, c;
    __host__ __device__ void init(int M, int N, int G_, int c_) { nM = M / BM; nN = N / BM; nwg = nM * nN; G = G_; c = c_; }
    __host__ __device__ bool next(int i, Unit& u) const {
        const long L = (long)i * G + c; if (L >= nwg) return false;
        int wgid = (int)L; { const int q = nwg / NXCD, r = nwg % NXCD, xcd = wgid % NXCD, off = wgid / NXCD; wgid = (xcd < r ? xcd * (q + 1) : r * (q + 1) + (xcd - r) * q) + off; }
        const int nig = WGM * nN, gid = wgid / nig, fm = gid * WGM, gsz = (nM - fm) < WGM ? (nM - fm) : WGM;
        u.pm = fm + ((wgid % nig) % gsz); u.pn = (wgid % nig) / gsz; return true;
    }
    __device__ __forceinline__ void a_ready(const Unit&) const {}
    __device__ __forceinline__ void done(const Unit&) const {}
};
__device__ __forceinline__ unsigned cvt_pk_bf16(float lo, float hi) { unsigned r; asm volatile("v_cvt_pk_bf16_f32 %0, %1, %2" : "=v"(r) : "v"(lo), "v"(hi)); return r; }
typedef float f32x2 __attribute__((ext_vector_type(2)));
template <class Epi, class Sched, bool ALIGN_EPI = false, bool SP2 = false>
__device__ __forceinline__ void gemm_phase(PG8_LAS unsigned char* lds, const Gemm g, const Sched& S, const Epi& E) {
    const int tid = threadIdx.x, wid = __builtin_amdgcn_readfirstlane(tid >> 6), lane = tid & 63, wr = wid >> 2, wc = wid & 3, fr = lane & 15, fq = lane >> 4;
    const int K = g.K, nt = K / BK;
    unsigned voffA[2], voffB[2];
#pragma unroll
    for (int i = 0; i < 2; ++i) { int R, C; stage_rc(tid * 16 + i * 8192, R, C); const int Rb = Epi::PERM ? ((R & ~31) + perm32(R & 31)) : R;
        voffA[i] = (unsigned)(R * K + C) * 2u; voffB[i] = (unsigned)(Rb * K + C) * 2u; }
    const size_t kstep = (size_t)(BK * 2);
    const size_t hstep = (size_t)HALF * K * 2;
    const size_t tstep = 2 * hstep;
    const unsigned ldsw = (unsigned)wid * 1024u;
    const int aoff = lds_byte(wr * 64 + fr, fq * 8), boff = lds_byte(wc * 32 + fr, fq * 8);
#define PG8_SA(b, h) (((b) * 2 + (h)) * HTB)
#define PG8_SB(b, h) ((4 + (b) * 2 + (h)) * HTB)
#define PG8_STAGE(bufoff, gbase, voff) do { _Pragma("unroll") for (int _i = 0; _i < 2; ++_i) \
        __builtin_amdgcn_global_load_lds((const unsigned*)((const char*)(gbase) + (voff)[_i]), (PG8_LAS unsigned*)(lds + (bufoff) + ldsw + _i * 8192), 16, 0, 0); } while (0)
#define PG8_LDA(dst, b, h) do { _Pragma("unroll") for (int m = 0; m < 4; ++m) _Pragma("unroll") for (int k = 0; k < 2; ++k) dst[m][k] = *(const PG8_LAS bf16x8*)(lds + PG8_SA(b, h) + aoff + m * 2048 + k * 1024); } while (0)
#define PG8_LDB(dst, b, h) do { _Pragma("unroll") for (int n = 0; n < 2; ++n) _Pragma("unroll") for (int k = 0; k < 2; ++k) dst[n][k] = *(const PG8_LAS bf16x8*)(lds + PG8_SB(b, h) + boff + n * 2048 + k * 1024); } while (0)
#define PG8_MMA(ai, bj, At, Bt) do { __builtin_amdgcn_s_setprio(1); _Pragma("unroll") for (int m = 0; m < 4; ++m) _Pragma("unroll") for (int n = 0; n < 2; ++n) _Pragma("unroll") for (int k = 0; k < 2; ++k) \
        acc[ai][bj][m][n] = __builtin_amdgcn_mfma_f32_16x16x32_bf16(Bt[n][k], At[m][k], acc[ai][bj][m][n], 0, 0, 0); __builtin_amdgcn_s_setprio(0); } while (0)
#define PG8_WAIT_V(n) asm volatile("s_waitcnt vmcnt(" #n ")" ::: "memory")
#define PG8_WAIT_L(n) asm volatile("s_waitcnt lgkmcnt(" #n ")" ::: "memory")
#define PG8_BAR __builtin_amdgcn_s_barrier()
#define PG8_SCHED __builtin_amdgcn_sched_barrier(0)
    Unit cur, nxt; int ui = 0;
    if (!S.next(0, cur)) return;
    f32x4 acc[2][2][4][2];
#pragma unroll
    for (int a = 0; a < 2; ++a)
#pragma unroll
        for (int b = 0; b < 2; ++b)
#pragma unroll
            for (int m = 0; m < 4; ++m)
#pragma unroll
                for (int n = 0; n < 2; ++n) acc[a][b][m][n] = (f32x4){0.f, 0.f, 0.f, 0.f};
    bf16x8 At[4][2], B0[2][2], B1[2][2];
    const char* cA = (const char*)g.A + (size_t)cur.pm * tstep; const char* cB = (const char*)g.Bt + (size_t)cur.pn * tstep;
    S.a_ready(cur);
    if constexpr (SP2) {
        PG8_STAGE(PG8_SB(0, 0), cB, voffB); PG8_STAGE(PG8_SB(0, 1), cB + hstep, voffB); PG8_STAGE(PG8_SA(0, 0), cA, voffA); PG8_STAGE(PG8_SA(0, 1), cA + hstep, voffA);
        if (wr == 1) PG8_BAR;
        PG8_WAIT_V(2); PG8_BAR;
        PG8_STAGE(PG8_SB(1, 0), cB + kstep, voffB); PG8_STAGE(PG8_SA(1, 0), cA + kstep, voffA); PG8_STAGE(PG8_SB(1, 1), cB + hstep + kstep, voffB);
        PG8_WAIT_V(6); PG8_BAR;
    } else {
        PG8_STAGE(PG8_SB(0, 0), cB, voffB); PG8_STAGE(PG8_SA(0, 0), cA, voffA); PG8_STAGE(PG8_SB(0, 1), cB + hstep, voffB); PG8_STAGE(PG8_SA(0, 1), cA + hstep, voffA);
        if (wr == 1) PG8_BAR;
        PG8_WAIT_V(4); PG8_BAR;
        PG8_STAGE(PG8_SB(1, 0), cB + kstep, voffB); PG8_STAGE(PG8_SA(1, 0), cA + kstep, voffA); PG8_STAGE(PG8_SB(1, 1), cB + hstep + kstep, voffB);
        PG8_WAIT_V(6); PG8_BAR;
    }
    for (;;) {
        const bool has_next = S.next(ui + 1, nxt);
        const char* nA = has_next ? (const char*)g.A + (size_t)nxt.pm * tstep : cA; const char* nB = has_next ? (const char*)g.Bt + (size_t)nxt.pn * tstep : cB;
        for (int t = 0; t < nt; t += 2) {
            const bool last = (t == nt - 2);
            const char* a1 = cA + (size_t)(t + 1) * kstep;
            const char* a2 = last ? nA : cA + (size_t)(t + 2) * kstep; const char* b2 = last ? nB : cB + (size_t)(t + 2) * kstep;
            const char* a3 = a2 + kstep; const char* b3 = b2 + kstep;
            if (last && has_next) S.a_ready(nxt);
            if constexpr (SP2) {
            PG8_LDB(B0, 0, 0); PG8_LDB(B1, 0, 1); PG8_SCHED; PG8_LDA(At, 0, 0); PG8_STAGE(PG8_SA(1, 1), a1 + hstep, voffA);
            PG8_WAIT_V(8); PG8_WAIT_L(0); PG8_BAR; PG8_MMA(0, 0, At, B0); PG8_MMA(0, 1, At, B1); PG8_BAR; PG8_SCHED;
            PG8_LDA(At, 0, 1); PG8_STAGE(PG8_SB(0, 0), b2, voffB); PG8_STAGE(PG8_SB(0, 1), b2 + hstep, voffB); PG8_STAGE(PG8_SA(0, 0), a2, voffA);
            PG8_WAIT_V(8); PG8_WAIT_L(0); PG8_BAR; PG8_MMA(1, 0, At, B0); PG8_MMA(1, 1, At, B1); PG8_BAR; PG8_SCHED;
            PG8_LDB(B0, 1, 0); PG8_LDB(B1, 1, 1); PG8_SCHED; PG8_LDA(At, 1, 0); PG8_STAGE(PG8_SA(0, 1), a2 + hstep, voffA);
            PG8_WAIT_V(8); PG8_WAIT_L(0); PG8_BAR; PG8_MMA(0, 0, At, B0); PG8_MMA(0, 1, At, B1); PG8_BAR; PG8_SCHED;
            PG8_LDA(At, 1, 1); PG8_STAGE(PG8_SB(1, 0), b3, voffB); PG8_STAGE(PG8_SB(1, 1), b3 + hstep, voffB); PG8_STAGE(PG8_SA(1, 0), a3, voffA);
            PG8_WAIT_V(8); PG8_WAIT_L(0); PG8_BAR; PG8_MMA(1, 0, At, B0); PG8_MMA(1, 1, At, B1); PG8_BAR; PG8_SCHED;
            } else {
            PG8_LDB(B0, 0, 0); PG8_SCHED; PG8_LDA(At, 0, 0); PG8_STAGE(PG8_SA(1, 1), a1 + hstep, voffA);
            PG8_WAIT_L(8); PG8_BAR; PG8_WAIT_L(0); PG8_MMA(0, 0, At, B0); PG8_BAR; PG8_SCHED;
            PG8_LDB(B1, 0, 1); PG8_STAGE(PG8_SB(0, 0), b2, voffB);
            PG8_BAR; PG8_WAIT_L(0); PG8_MMA(0, 1, At, B1); PG8_BAR;
            PG8_LDA(At, 0, 1); PG8_STAGE(PG8_SA(0, 0), a2, voffA);
            PG8_BAR; PG8_WAIT_L(0); PG8_MMA(1, 0, At, B0); PG8_BAR; PG8_SCHED;
            PG8_STAGE(PG8_SB(0, 1), b2 + hstep, voffB);
            PG8_WAIT_V(6); PG8_BAR; PG8_MMA(1, 1, At, B1); PG8_BAR;
            PG8_LDB(B0, 1, 0); PG8_SCHED; PG8_LDA(At, 1, 0); PG8_STAGE(PG8_SA(0, 1), a2 + hstep, voffA);
            PG8_WAIT_L(8); PG8_BAR; PG8_WAIT_L(0); PG8_MMA(0, 0, At, B0); PG8_BAR; PG8_SCHED;
            PG8_LDB(B1, 1, 1); PG8_STAGE(PG8_SB(1, 0), b3, voffB);
            PG8_BAR; PG8_WAIT_L(0); PG8_MMA(0, 1, At, B1); PG8_BAR;
            PG8_LDA(At, 1, 1); PG8_STAGE(PG8_SA(1, 0), a3, voffA);
            PG8_BAR; PG8_WAIT_L(0); PG8_MMA(1, 0, At, B0); PG8_BAR; PG8_SCHED;
            PG8_STAGE(PG8_SB(1, 1), b3 + hstep, voffB);
            PG8_WAIT_V(6); PG8_BAR; PG8_MMA(1, 1, At, B1); PG8_BAR;
            }
        }
        if constexpr (ALIGN_EPI) { if (wr == 0) PG8_BAR; }
        if constexpr (!Epi::AFTER_DRAIN) { E(acc, cur, wr, wc, fr, fq); S.done(cur); }
        if (!has_next) break;
#pragma unroll
        for (int a = 0; a < 2; ++a)
#pragma unroll
            for (int b = 0; b < 2; ++b)
#pragma unroll
                for (int m = 0; m < 4; ++m)
#pragma unroll
                    for (int n = 0; n < 2; ++n) acc[a][b][m][n] = (f32x4){0.f, 0.f, 0.f, 0.f};
        cur = nxt; cA = nA; cB = nB; ++ui;
        if constexpr (ALIGN_EPI) { if (wr == 1) PG8_BAR; }
    }
    PG8_WAIT_V(0);
    if constexpr (!ALIGN_EPI) { if (wr == 0) PG8_BAR; }
    PG8_BAR;
    if constexpr (Epi::AFTER_DRAIN) { E.fused(acc, cur, wr, wc, fr, fq, lds, wid, lane); S.done(cur); }
#undef PG8_SA
#undef PG8_SB
#undef PG8_STAGE
#undef PG8_LDA
#undef PG8_LDB
#undef PG8_MMA
#undef PG8_WAIT_V
#undef PG8_WAIT_L
#undef PG8_BAR
#undef PG8_SCHED
}
}
namespace pg9 {
using pg8::bf16x8; using pg8::f32x4; using pg8::u32x4; using pg8::lds_byte; using pg8::stage_rc; using pg8::perm32;
constexpr int BK = 64, HALF = 128, HTB = HALF * BK * 2;
struct Unit { int pm, pn, aux, cnt, row0, ty; };
template <class Epi, class Sched, bool GATHER>
__device__ __forceinline__ void gemm_phase(PG8_LAS unsigned char* lds, const int K, const int lda, const int ldb, const Sched& S, const Epi& E) {
    const int tid = threadIdx.x, wid = __builtin_amdgcn_readfirstlane(tid >> 6), lane = tid & 63, wr = wid >> 2, wc = wid & 3, fr = lane & 15, fq = lane >> 4;
    const int nt = K / BK;
    unsigned offA[2][2], offAn[2][2], offB[2][2]; int RA[2], CA[2];
#pragma unroll
    for (int i = 0; i < 2; ++i) { int R, C; stage_rc(tid * 16 + i * 8192, R, C); const int Rb = Epi::PERM ? ((R & ~31) + perm32(R & 31)) : R; RA[i] = R; CA[i] = C * 2;
#pragma unroll
        for (int h = 0; h < 2; ++h) { offB[h][i] = (unsigned)((Rb + 128 * h) * ldb + C) * 2u; offA[h][i] = (unsigned)((R + 128 * h) * lda + C) * 2u; offAn[h][i] = offA[h][i]; } }
    const size_t kstep = (size_t)(BK * 2);
    const unsigned ldsw = (unsigned)wid * 1024u;
    const int aoff = lds_byte(wr * 64 + fr, fq * 8), boff = lds_byte(wc * 32 + fr, fq * 8);
#define PG9_SA(b, h) (((b) * 2 + (h)) * HTB)
#define PG9_SB(b, h) ((4 + (b) * 2 + (h)) * HTB)
#define PG9_STAGE(bufoff, gbase, voff) do { _Pragma("unroll") for (int _i = 0; _i < 2; ++_i) \
        __builtin_amdgcn_global_load_lds((const unsigned*)((const char*)(gbase) + (voff)[_i]), (PG8_LAS unsigned*)(lds + (bufoff) + ldsw + _i * 8192), 16, 0, 0); } while (0)
#define PG9_LDA(dst, b, h) do { _Pragma("unroll") for (int m = 0; m < 4; ++m) _Pragma("unroll") for (int k = 0; k < 2; ++k) dst[m][k] = *(const PG8_LAS bf16x8*)(lds + PG9_SA(b, h) + aoff + m * 2048 + k * 1024); } while (0)
#define PG9_LDB(dst, b, h) do { _Pragma("unroll") for (int n = 0; n < 2; ++n) _Pragma("unroll") for (int k = 0; k < 2; ++k) dst[n][k] = *(const PG8_LAS bf16x8*)(lds + PG9_SB(b, h) + boff + n * 2048 + k * 1024); } while (0)
#define PG9_MMA(ai, bj, At, Bt) do { __builtin_amdgcn_s_setprio(1); _Pragma("unroll") for (int m = 0; m < 4; ++m) _Pragma("unroll") for (int n = 0; n < 2; ++n) _Pragma("unroll") for (int k = 0; k < 2; ++k) \
        acc[ai][bj][m][n] = __builtin_amdgcn_mfma_f32_16x16x32_bf16(Bt[n][k], At[m][k], acc[ai][bj][m][n], 0, 0, 0); __builtin_amdgcn_s_setprio(0); } while (0)
#define PG9_WAIT_V(n) asm volatile("s_waitcnt vmcnt(" #n ")" ::: "memory")
#define PG9_WAIT_L(n) asm volatile("s_waitcnt lgkmcnt(" #n ")" ::: "memory")
#define PG9_BAR __builtin_amdgcn_s_barrier()
#define PG9_SCHED __builtin_amdgcn_sched_barrier(0)
    Unit cur, nxt; int ui = 0;
    if (!S.next(0, cur)) return;
    f32x4 acc[2][2][4][2];
#pragma unroll
    for (int a = 0; a < 2; ++a)
#pragma unroll
        for (int b = 0; b < 2; ++b)
#pragma unroll
            for (int m = 0; m < 4; ++m)
#pragma unroll
                for (int n = 0; n < 2; ++n) acc[a][b][m][n] = (f32x4){0.f, 0.f, 0.f, 0.f};
    bf16x8 At[4][2], B0[2][2], B1[2][2];
    S.a_ready(cur, wid, lane);
    const char* cA = S.a_base(cur); const char* cB = S.b_base(cur);
    if constexpr (GATHER) {
#pragma unroll
        for (int h = 0; h < 2; ++h)
#pragma unroll
            for (int i = 0; i < 2; ++i) offA[h][i] = S.a_row_off(cur, RA[i] + 128 * h) + (unsigned)CA[i];
    }
    PG9_STAGE(PG9_SB(0, 0), cB, offB[0]); PG9_STAGE(PG9_SB(0, 1), cB, offB[1]); PG9_STAGE(PG9_SA(0, 0), cA, offA[0]); PG9_STAGE(PG9_SA(0, 1), cA, offA[1]);
    if (wr == 1) PG9_BAR;
    PG9_WAIT_V(2); PG9_BAR;
    PG9_STAGE(PG9_SB(1, 0), cB + kstep, offB[0]); PG9_STAGE(PG9_SA(1, 0), cA + kstep, offA[0]); PG9_STAGE(PG9_SB(1, 1), cB + kstep, offB[1]);
    PG9_WAIT_V(6); PG9_BAR;
    for (;;) {
        const bool has_next = S.next(ui + 1, nxt);
        if (has_next) S.a_ready(nxt, wid, lane);
        const char* nA = has_next ? S.a_base(nxt) : cA; const char* nB = has_next ? S.b_base(nxt) : cB;
        if constexpr (GATHER) {
#pragma unroll
            for (int h = 0; h < 2; ++h)
#pragma unroll
                for (int i = 0; i < 2; ++i) offAn[h][i] = has_next ? (S.a_row_off(nxt, RA[i] + 128 * h) + (unsigned)CA[i]) : offA[h][i];
        }
        const int ntu = S.nt_of(cur, nt);
        for (int t = 0; t < ntu; t += 2) {
            const bool last = (t == ntu - 2);
            const char* a1 = cA + (size_t)(t + 1) * kstep;
            const char* a2 = last ? nA : cA + (size_t)(t + 2) * kstep; const char* b2 = last ? nB : cB + (size_t)(t + 2) * kstep;
            const char* a3 = a2 + kstep; const char* b3 = b2 + kstep;
            unsigned oA2[2][2];
#pragma unroll
            for (int h = 0; h < 2; ++h)
#pragma unroll
                for (int i = 0; i < 2; ++i) oA2[h][i] = (GATHER && last) ? offAn[h][i] : offA[h][i];
            PG9_LDB(B0, 0, 0); PG9_LDB(B1, 0, 1); PG9_SCHED; PG9_LDA(At, 0, 0); PG9_STAGE(PG9_SA(1, 1), a1, offA[1]);
            PG9_WAIT_V(8); PG9_WAIT_L(0); PG9_BAR; PG9_MMA(0, 0, At, B0); PG9_MMA(0, 1, At, B1); PG9_BAR; PG9_SCHED;
            PG9_LDA(At, 0, 1); PG9_STAGE(PG9_SB(0, 0), b2, offB[0]); PG9_STAGE(PG9_SB(0, 1), b2, offB[1]); PG9_STAGE(PG9_SA(0, 0), a2, oA2[0]);
            PG9_WAIT_V(8); PG9_WAIT_L(0); PG9_BAR; PG9_MMA(1, 0, At, B0); PG9_MMA(1, 1, At, B1); PG9_BAR; PG9_SCHED;
            PG9_LDB(B0, 1, 0); PG9_LDB(B1, 1, 1); PG9_SCHED; PG9_LDA(At, 1, 0); PG9_STAGE(PG9_SA(0, 1), a2, oA2[1]);
            PG9_WAIT_V(8); PG9_WAIT_L(0); PG9_BAR; PG9_MMA(0, 0, At, B0); PG9_MMA(0, 1, At, B1); PG9_BAR; PG9_SCHED;
            PG9_LDA(At, 1, 1); PG9_STAGE(PG9_SB(1, 0), b3, offB[0]); PG9_STAGE(PG9_SB(1, 1), b3, offB[1]); PG9_STAGE(PG9_SA(1, 0), a3, oA2[0]);
            PG9_WAIT_V(8); PG9_WAIT_L(0); PG9_BAR; PG9_MMA(1, 0, At, B0); PG9_MMA(1, 1, At, B1); PG9_BAR; PG9_SCHED;
        }
        if (wr == 0) PG9_BAR;
        bool keep = false;
        if constexpr (Epi::CHAIN) keep = E.chain_more(cur);
        if (keep) { if constexpr (Epi::CHAIN) E.rescale(acc, cur, wr, wc, fr, fq); }
        else { E(acc, cur, wr, wc, fr, fq); S.done(cur, lane); }
        if (!has_next) break;
        if (!keep) {
#pragma unroll
            for (int a = 0; a < 2; ++a)
#pragma unroll
                for (int b = 0; b < 2; ++b)
#pragma unroll
                    for (int m = 0; m < 4; ++m)
#pragma unroll
                        for (int n = 0; n < 2; ++n) acc[a][b][m][n] = (f32x4){0.f, 0.f, 0.f, 0.f};
        }
        cur = nxt; cA = nA; cB = nB; ++ui;
        if constexpr (GATHER) {
#pragma unroll
            for (int h = 0; h < 2; ++h)
#pragma unroll
                for (int i = 0; i < 2; ++i) offA[h][i] = offAn[h][i];
        }
        if (wr == 1) PG9_BAR;
    }
    PG9_WAIT_V(0);
    PG9_BAR;
#undef PG9_SA
#undef PG9_SB
#undef PG9_STAGE
#undef PG9_LDA
#undef PG9_LDB
#undef PG9_MMA
#undef PG9_WAIT_V
#undef PG9_WAIT_L
#undef PG9_BAR
#undef PG9_SCHED
}
}
#define GAS __attribute__((address_space(1)))
#define LAS __attribute__((address_space(3)))
typedef unsigned short bf16;
typedef unsigned v4u __attribute__((ext_vector_type(4)));
typedef float f32x4 __attribute__((ext_vector_type(4)));
typedef short bf16x8 __attribute__((ext_vector_type(8)));
typedef GAS unsigned gu32;
typedef GAS unsigned long long gu64;
#define RLX_AGENT __ATOMIC_RELAXED, __HIP_MEMORY_SCOPE_AGENT
#define LDS_WAIT() asm volatile("s_waitcnt lgkmcnt(0)" ::: "memory")
#define VM_WAIT() asm volatile("s_waitcnt vmcnt(0)" ::: "memory")
__device__ __forceinline__ unsigned long long rt() { return __builtin_amdgcn_s_memrealtime(); }
__device__ __forceinline__ unsigned f2bfu(float f) { unsigned u = __builtin_bit_cast(unsigned, f); return (u + 0x7fffu + ((u >> 16) & 1u)) >> 16; }
__device__ __forceinline__ unsigned pk2(float lo, float hi) { return f2bfu(lo) | (f2bfu(hi) << 16); }
#define XB_TMO      128
#define XB_XCNT(j)  (256  + 64 * (j))
#define XB_XSUB(j)  (1280 + 64 * (j))
#define XB_XGEN(j)  (2304 + 64 * (j))
#define XB_TOP      3328
#define XB_TOPGEN   3392
#define XCD_BAR_WORDS 3456
#define XB_SPIN_CAP (1u << 18)

__device__ __forceinline__ unsigned xb_ld(unsigned* p)              { return __hip_atomic_load(p, __ATOMIC_RELAXED, __HIP_MEMORY_SCOPE_AGENT); }
__device__ __forceinline__ unsigned xb_add(unsigned* p, unsigned v) { return __hip_atomic_fetch_add(p, v, __ATOMIC_RELAXED, __HIP_MEMORY_SCOPE_AGENT); }
__device__ __forceinline__ unsigned xb_xcc_id() { return (unsigned)__builtin_amdgcn_s_getreg((3 << 11) | 20) & 0xFu; }
#define XB_SPIN(cond, bar) do { unsigned _sp = 0; while (cond) { __builtin_amdgcn_s_sleep(1); \
    if ((++_sp & 255u) == 0u) { if (xb_ld(&(bar)[XB_TMO])) break; if (_sp > XB_SPIN_CAP) { atomicAdd(&(bar)[XB_TMO], 1u); break; } } } } while (0)

struct XcdBarrier {
    unsigned* bar; unsigned x;
    volatile LAS unsigned* st;
};

__device__ __forceinline__ XcdBarrier xcd_barrier_post(unsigned* bar, volatile LAS unsigned* st) {
    XcdBarrier b; b.bar = bar; b.x = xb_xcc_id(); b.st = st;
    if (threadIdx.x == 0) (void)xb_add(&bar[XB_XCNT(b.x)], 1u);
    return b;
}
__device__ __forceinline__ void xcd_barrier_complete(unsigned* bar, unsigned x, unsigned& nloc, unsigned& nx) {
    const unsigned G = gridDim.x * gridDim.y * gridDim.z;
    unsigned sum, cnt, mine, sp = 0u;
    for (;;) {
        sum = 0u; cnt = 0u; mine = 0u;
#pragma unroll
        for (unsigned j = 0; j < 16; ++j) { const unsigned c = xb_ld(&bar[XB_XCNT(j)]); sum += c; cnt += (c > 0u) ? 1u : 0u; mine = (j == x) ? c : mine; }
        if (sum == G) break;
        __builtin_amdgcn_s_sleep(1);
        if ((++sp & 255u) == 0u) { if (xb_ld(&bar[XB_TMO])) break; if (sp > XB_SPIN_CAP) { atomicAdd(&bar[XB_TMO], 1u); break; } }
    }
    nloc = mine > 0u ? mine : 1u; nx = cnt > 0u ? cnt : 1u;
}

__device__ __forceinline__ void xcd_barrier(const XcdBarrier& b) {
    asm volatile("s_waitcnt vmcnt(0)" ::: "memory");
    __syncthreads();
    if (threadIdx.x == 0) {
        unsigned* bar = b.bar;
        __builtin_amdgcn_s_waitcnt(0);
        unsigned nloc = b.st[0], nx = b.st[1];
        if (nloc == 0u) { xcd_barrier_complete(bar, b.x, nloc, nx); b.st[0] = nloc; b.st[1] = nx; }
        const unsigned old = xb_add(&bar[XB_XSUB(b.x)], 1u);
        const unsigned gen = old / nloc;
        if (old + 1u == (gen + 1u) * nloc) {
            __builtin_amdgcn_fence(__ATOMIC_RELEASE, "agent");
            asm volatile("s_waitcnt vmcnt(0)" ::: "memory");
            const unsigned og = xb_add(&bar[XB_TOP], 1u);
            const unsigned tg = og / nx;
            if (og + 1u == (tg + 1u) * nx) xb_add(&bar[XB_TOPGEN], 1u);
            else XB_SPIN(xb_ld(&bar[XB_TOPGEN]) == tg, bar);
            __builtin_amdgcn_fence(__ATOMIC_ACQUIRE, "agent");
            xb_add(&bar[XB_XGEN(b.x)], 1u);
            asm volatile("s_waitcnt vmcnt(0)" ::: "memory");
        } else {
            XB_SPIN(xb_ld(&bar[XB_XGEN(b.x)]) == gen, bar);
            __builtin_amdgcn_fence(__ATOMIC_ACQUIRE, "agent");
            asm volatile("s_waitcnt vmcnt(0)" ::: "memory");
        }
    }
    __syncthreads();
}
constexpr int NWAVES = 8;
constexpr int RING_OFF = 0, RING_BYTES = 131072;
constexpr int LDSCTL_OFF = RING_BYTES, MISC_OFF = LDSCTL_OFF + 320;
constexpr int LDS_BYTES = 147456;
constexpr int CW_BAR = 4096;
constexpr int CW_KMEAN = 32768;
constexpr int CW_MEMKSS = 65536;
static_assert((CW_MEMKSS + 4096) * 4 <= (int)MiB && CW_BAR + 4 * 3456 <= CW_KMEAN, "ctl map");

struct Frame {
    LAS unsigned char* lds; volatile LAS unsigned* MISC; gu32* ctl;
    int tid, lane, wave, vcu, G;
    unsigned char* ws; float* out;
};
typedef float f32x2_t __attribute__((ext_vector_type(2))); typedef __bf16 bf16x2_t __attribute__((ext_vector_type(2)));
__device__ __forceinline__ unsigned cvt_pk_bf16(float lo, float hi) { f32x2_t v = {lo, hi}; bf16x2_t b = __builtin_convertvector(v, bf16x2_t); return __builtin_bit_cast(unsigned, b); }
__device__ __forceinline__ float wave_sum64(float v) {
#pragma unroll
    for (int o = 1; o < 64; o <<= 1) v += __shfl_xor(v, o);
    return v;
}
template <bool HEADPERM> __device__ __forceinline__ void p0_transpose_item(const float* W, int K, int N, bf16* WT, int row_off, LAS float* scr, int item, int lane) {
    const int nblk = N / 32, kb = item / nblk, nb = item % nblk, k0 = 64 * kb, n0 = 32 * nb;
    int p0 = n0; if (HEADPERM) { const int lg = (n0 >> 5) & 7; p0 = (n0 & ~255) + 32 * (4 * (lg & 1) + (lg >> 1)); }
    float wv[32];
#pragma unroll
    for (int i = 0; i < 32; ++i) wv[i] = __builtin_nontemporal_load(&W[(size_t)(k0 + 2 * i + (lane >> 5)) * N + n0 + (lane & 31)]);
#pragma unroll
    for (int i = 0; i < 32; ++i) scr[(2 * i + (lane >> 5)) * 33 + (lane & 31)] = wv[i];
    LDS_WAIT(); asm volatile("" ::: "memory");
    const int c = lane & 7;
#pragma unroll
    for (int j = 0; j < 4; ++j) { const int n = (lane >> 3) + 8 * j; const LAS float* s = scr + (8 * c) * 33 + n;
        v4u o; o.x = cvt_pk_bf16(s[0 * 33], s[1 * 33]); o.y = cvt_pk_bf16(s[2 * 33], s[3 * 33]); o.z = cvt_pk_bf16(s[4 * 33], s[5 * 33]); o.w = cvt_pk_bf16(s[6 * 33], s[7 * 33]);
        *(GAS v4u*)(WT + (size_t)(row_off + p0 + n) * K + k0 + 8 * c) = o; }
    LDS_WAIT(); asm volatile("" ::: "memory");
}
__device__ __forceinline__ void xp_load(float (&wv)[32], const float* W, int N, int nblk, int item, int lane) {
    const int kb = item / nblk, nb = item % nblk, k0 = 64 * kb, n0 = 32 * nb;
#pragma unroll
    for (int i = 0; i < 32; ++i) wv[i] = __builtin_nontemporal_load(&W[(size_t)(k0 + 2 * i + (lane >> 5)) * N + n0 + (lane & 31)]);
}
__device__ __forceinline__ void xp_finish(const float (&wv)[32], int K, int nblk, bf16* WT, LAS float* scr, int item, int lane) {
    const int kb = item / nblk, nb = item % nblk, k0 = 64 * kb, n0 = 32 * nb;
#pragma unroll
    for (int i = 0; i < 32; ++i) scr[(2 * i + (lane >> 5)) * 33 + (lane & 31)] = wv[i];
    LDS_WAIT(); asm volatile("" ::: "memory");
    const int c = lane & 7;
#pragma unroll
    for (int j = 0; j < 4; ++j) { const int n = (lane >> 3) + 8 * j; const LAS float* s = scr + (8 * c) * 33 + n;
        v4u o; o.x = cvt_pk_bf16(s[0 * 33], s[1 * 33]); o.y = cvt_pk_bf16(s[2 * 33], s[3 * 33]); o.z = cvt_pk_bf16(s[4 * 33], s[5 * 33]); o.w = cvt_pk_bf16(s[6 * 33], s[7 * 33]);
        *(GAS v4u*)(WT + (size_t)(n0 + n) * K + k0 + 8 * c) = o; }
    LDS_WAIT(); asm volatile("" ::: "memory");
}
__device__ __forceinline__ void cv_load(f32x4 (&v)[8], const int slot, const float* w1, const float* w2, const int lane) {
    const int q = slot / 17, r = slot - 17 * q; if (r >= 12) return;
    const int bi = 12 * q + r; const bool isw1 = bi < 32768; const int b2 = isw1 ? bi : bi - 32768;
    const int e = isw1 ? (b2 >> 10) : (b2 >> 9), kb = isw1 ? ((b2 >> 6) & 15) : ((b2 >> 5) & 15), nb = isw1 ? (b2 & 63) : (b2 & 31), N = isw1 ? 2048 : 1024;
    const float* src = (isw1 ? w1 : w2) + ((size_t)e * 1024 + 64 * kb + (lane >> 3)) * N + 32 * nb + 4 * (lane & 7);
#pragma unroll
    for (int i = 0; i < 8; ++i) v[i] = __builtin_nontemporal_load((const f32x4*)(src + (size_t)(8 * i) * N));
}
__device__ __forceinline__ void cv_finish(const f32x4 (&v)[8], const int slot, unsigned char* ws, LAS float* scr, const int lane) {
    const int q = slot / 17, r = slot - 17 * q; if (r >= 12) return;
    const int bi = 12 * q + r; const bool isw1 = bi < 32768; const int b2 = isw1 ? bi : bi - 32768;
    const int e = isw1 ? (b2 >> 10) : (b2 >> 9), kb = isw1 ? ((b2 >> 6) & 15) : ((b2 >> 5) & 15), nb = isw1 ? (b2 & 63) : (b2 & 31);
    bf16* WT = (bf16*)(ws + (isw1 ? WS_W1 : WS_W2)) + ((size_t)e * (isw1 ? 2048 : 1024) + 32 * nb) * 1024 + 64 * kb;
#pragma unroll
    for (int i = 0; i < 8; ++i) { LAS float* d = scr + (8 * i + (lane >> 3)) * 33 + 4 * (lane & 7); d[0] = v[i].x; d[1] = v[i].y; d[2] = v[i].z; d[3] = v[i].w; }
    LDS_WAIT(); asm volatile("" ::: "memory");
    const int c = lane & 7;
#pragma unroll
    for (int j = 0; j < 4; ++j) { const int n = (lane >> 3) + 8 * j; const LAS float* s = scr + (8 * c) * 33 + n;
        v4u o; o.x = cvt_pk_bf16(s[0 * 33], s[1 * 33]); o.y = cvt_pk_bf16(s[2 * 33], s[3 * 33]); o.z = cvt_pk_bf16(s[4 * 33], s[5 * 33]); o.w = cvt_pk_bf16(s[6 * 33], s[7 * 33]);
        *(GAS v4u*)(WT + (size_t)n * 1024 + 8 * c) = o; }
    LDS_WAIT(); asm volatile("" ::: "memory");
}
__device__ __forceinline__ void rms_row_to_bf16(int lane, const float* xrow, const float* g, bf16* orow) {
    const GAS f32x4* xr = (const GAS f32x4*)xrow + lane; const GAS f32x4* gr = (const GAS f32x4*)g + lane;
    f32x4 v[4]; float s = 0.f;
#pragma unroll
    for (int j = 0; j < 4; ++j) { v[j] = xr[64 * j]; s += (v[j].x * v[j].x + v[j].y * v[j].y) + (v[j].z * v[j].z + v[j].w * v[j].w); }
    const float r = 1.f / sqrtf(wave_sum64(s) * (1.f / 1024.f) + 1e-5f);
    GAS unsigned long long* o8 = (GAS unsigned long long*)orow + lane;
#pragma unroll
    for (int j = 0; j < 4; ++j) { const f32x4 gg = gr[64 * j]; o8[64 * j] = (unsigned long long)cvt_pk_bf16(v[j].x * r * gg.x, v[j].y * r * gg.y) | ((unsigned long long)cvt_pk_bf16(v[j].z * r * gg.z, v[j].w * r * gg.w) << 32); }
}
struct Args { const float* in[23]; float* out; unsigned char* ws; int ph_lo, ph_hi, li, pad; };
__device__ __forceinline__ void p0_prologue(Frame& F, const Args& A) {
    LAS float* scr = (LAS float*)(F.lds + RING_OFF + F.wave * 16384);
    const int gw = F.vcu * NWAVES + F.wave, NGW = F.G * NWAVES;
    constexpr int I_IN = 16 * (DIN / 32), I_MKV = 16 * 32, I_BR = 8 * 32, I_OUT = 16 * 32;
    constexpr int NITEMS = I_IN + I_MKV + 3 * I_BR + I_OUT;
    for (int it = gw; it < NITEMS; it += NGW) {
        int r = it;
        if (r < I_IN) { p0_transpose_item<true>(A.in[3], 1024, DIN, (bf16*)(F.ws + WS_WIN), 0, scr, r, F.lane); continue; } r -= I_IN;
        if (r < I_MKV) { p0_transpose_item<true>(A.in[9], 1024, 1024, (bf16*)(F.ws + WS_WMEMKV), 0, scr, r, F.lane); continue; } r -= I_MKV;
        if (r < 3 * I_BR) { const int w = r / I_BR; p0_transpose_item<false>(w == 0 ? A.in[12] : (w == 1 ? A.in[13] : A.in[14]), 512, 1024, (bf16*)(F.ws + WS_WBR) + (size_t)w * 1024 * 512, 0, scr, r % I_BR, F.lane); continue; } r -= 3 * I_BR;
        p0_transpose_item<false>(A.in[15], 1024, 1024, (bf16*)(F.ws + WS_WOUT), 0, scr, r, F.lane);
    }
    { bf16_t* WR = (bf16_t*)(F.ws + WS_WRS); const float* wr = A.in[17];
      for (int i = F.vcu * 512 + F.tid; i < 32768; i += F.G * 512) { const int e = i >> 10, k = i & 1023; const float v = wr[k * 32 + e]; const bf16_t h = f2bf(v); WR[i] = h; WR[32768 + i] = f2bf(v - bf2f(h)); } }
    if (gw == 0) { ((float*)(F.ws + WS_GTAB))[F.lane] = A.in[6][F.lane]; ((float*)(F.ws + WS_GTAB))[64 + F.lane] = A.in[7][F.lane]; }
    for (int m = gw; m < NTOK; m += NGW) rms_row_to_bf16(F.lane, A.in[0] + (size_t)m * DM, A.in[2], (bf16*)(F.ws + WS_HB) + (size_t)m * DM);
    for (int m = gw; m < NB * MEMLEN; m += NGW) rms_row_to_bf16(F.lane, A.in[1] + (size_t)m * DM, A.in[8], (bf16*)(F.ws + WS_HM) + (size_t)m * DM);
}

struct P1Order {
    pg8::StaticOrder so; int G, c;
    __device__ void init(int G_, int c_) { so.init(NTOK, DIN, G_, 0); G = G_; c = c_; }
    __device__ bool next(int i, pg8::Unit& u) const {
        long L = (long)i * G + c;
        if (L < 1664) { pg8::StaticOrder t = so; t.G = 1; t.c = 0; return t.next((int)L, u); }
        L -= 1664; if (L >= 16) return false;
        u.pm = 64 + (int)(L >> 2); u.pn = 26 + (int)(L & 3); return true;
    }
    __device__ __forceinline__ void a_ready(const pg8::Unit&) const {}
    __device__ __forceinline__ void done(const pg8::Unit&) const {}
};
__device__ __forceinline__ float sigmoid_f(float x) { return __builtin_amdgcn_rcpf(1.f + __expf(-x)); }
struct EpiP1 {
    static constexpr bool PERM = true, AFTER_DRAIN = false;
    unsigned char* ws; const float* b_gate; const float* gtab; float* KMEAN; float* MEMKSS; int atom_on;
    __device__ __forceinline__ void operator()(const pg8::f32x4 (&acc)[2][2][4][2], const pg8::Unit& u, int wr, int wc, int fr, int fq) const {
        using pg8::f32x4; using pg8::u32x4;
        const int pn = u.pn; int type, ldc, cb; size_t off; int row0 = u.pm * 256;
        if (pn == 0) { type = 0; off = WS_RQ; ldc = 256; cb = 0; }
        else if (pn == 1) { type = 1; off = WS_RK; ldc = 256; cb = 0; }
        else if (pn < 4) { type = 0; off = WS_RV; ldc = 512; cb = (pn - 2) * 256; }
        else if (pn < 6) { type = 2; off = WS_RG; ldc = 512; cb = (pn - 4) * 256; }
        else if (pn < 8) { type = 3; off = WS_MQ; ldc = 512; cb = (pn - 6) * 256; }
        else if (pn < 10) { type = 4; off = WS_MK; ldc = 512; cb = (pn - 8) * 256; }
        else if (pn < 12) { type = 0; off = WS_MV; ldc = 512; cb = (pn - 10) * 256; }
        else if (pn < 14) { type = 0; off = WS_CQ; ldc = 512; cb = (pn - 12) * 256; }
        else if (pn < 26) { type = 5; off = WS_GT; ldc = 3072; cb = (pn - 14) * 256; }
        else if (pn < 28) { type = 6; off = WS_MEMK; ldc = 512; cb = (pn - 26) * 256; row0 = (u.pm - 64) * 256; }
        else { type = 0; off = WS_MEMV; ldc = 512; cb = (pn - 28) * 256; row0 = (u.pm - 64) * 256; }
        bf16_t* base = (bf16_t*)(ws + off) + cb + 64 * wc + 8 * fq;
        const int rbase = row0 + 64 * wr + fr;
#define P1_STORE(rowp, bj, v0, v1) do { u32x4 w_; w_.x = cvt_pk_bf16((v0)[0], (v0)[1]); w_.y = cvt_pk_bf16((v0)[2], (v0)[3]); w_.z = cvt_pk_bf16((v1)[0], (v1)[1]); w_.w = cvt_pk_bf16((v1)[2], (v1)[3]); *(u32x4*)((rowp) + 32 * (bj)) = w_; } while (0)
        if (type <= 1) {
            const float sc = type == 1 ? 0.125f : 1.f;
#pragma unroll
            for (int ai = 0; ai < 2; ++ai)
#pragma unroll
                for (int m = 0; m < 4; ++m) { bf16_t* rowp = base + (size_t)(rbase + 128 * ai + 16 * m) * ldc;
#pragma unroll
                    for (int bj = 0; bj < 2; ++bj) { const f32x4 v0 = acc[ai][bj][m][0] * sc, v1 = acc[ai][bj][m][1] * sc; P1_STORE(rowp, bj, v0, v1); } }
        } else if (type == 2) {
#pragma unroll
            for (int ai = 0; ai < 2; ++ai)
#pragma unroll
                for (int m = 0; m < 4; ++m) { bf16_t* rowp = base + (size_t)(rbase + 128 * ai + 16 * m) * ldc;
#pragma unroll
                    for (int bj = 0; bj < 2; ++bj) { f32x4 v0 = acc[ai][bj][m][0], v1 = acc[ai][bj][m][1];
#pragma unroll
                        for (int j = 0; j < 4; ++j) { v0[j] = v0[j] * sigmoid_f(v0[j]); v1[j] = v1[j] * sigmoid_f(v1[j]); }
                        P1_STORE(rowp, bj, v0, v1); } }
        } else if (type == 5) {
            f32x4 bv[2][2];
#pragma unroll
            for (int bj = 0; bj < 2; ++bj)
#pragma unroll
                for (int n = 0; n < 2; ++n) bv[bj][n] = *(const f32x4*)(b_gate + cb + 64 * wc + 32 * bj + 8 * fq + 4 * n);
#pragma unroll
            for (int ai = 0; ai < 2; ++ai)
#pragma unroll
                for (int m = 0; m < 4; ++m) { bf16_t* rowp = base + (size_t)(rbase + 128 * ai + 16 * m) * ldc;
#pragma unroll
                    for (int bj = 0; bj < 2; ++bj) { f32x4 v0 = acc[ai][bj][m][0] + bv[bj][0], v1 = acc[ai][bj][m][1] + bv[bj][1];
#pragma unroll
                        for (int j = 0; j < 4; ++j) { v0[j] = sigmoid_f(v0[j]); v1[j] = sigmoid_f(v1[j]); }
                        P1_STORE(rowp, bj, v0, v1); } }
        } else if (type == 6) {
#pragma unroll
            for (int ai = 0; ai < 2; ++ai)
#pragma unroll
                for (int m = 0; m < 4; ++m) { const int row = rbase + 128 * ai + 16 * m; bf16_t* rowp = base + (size_t)row * ldc; float ss = 0.f;
#pragma unroll
                    for (int bj = 0; bj < 2; ++bj) { const f32x4 v0 = acc[ai][bj][m][0], v1 = acc[ai][bj][m][1];
                        ss += (v0[0] * v0[0] + v0[1] * v0[1]) + (v0[2] * v0[2] + v0[3] * v0[3]) + (v1[0] * v1[0] + v1[1] * v1[1]) + (v1[2] * v1[2] + v1[3] * v1[3]);
                        P1_STORE(rowp, bj, v0, v1); }
                    ss += __shfl_xor(ss, 16); ss += __shfl_xor(ss, 32);
                    if (fq == 0 && atom_on) atomicAdd(MEMKSS + (size_t)row * 4 + (cb >> 7) + (wc >> 1), ss);
                    }
        } else {
            const float* g = gtab + (type == 3 ? 0 : 64);
            f32x4 gv[2][2]; float rr[2][4];
#pragma unroll
            for (int bj = 0; bj < 2; ++bj)
#pragma unroll
                for (int n = 0; n < 2; ++n) gv[bj][n] = *(const f32x4*)(g + 32 * bj + 8 * fq + 4 * n);
#pragma unroll
            for (int ai = 0; ai < 2; ++ai)
#pragma unroll
                for (int m = 0; m < 4; ++m) { bf16_t* rowp = base + (size_t)(rbase + 128 * ai + 16 * m) * ldc; float ss = 0.f;
#pragma unroll
                    for (int bj = 0; bj < 2; ++bj) { const f32x4 v0 = acc[ai][bj][m][0], v1 = acc[ai][bj][m][1];
                        ss += (v0[0] * v0[0] + v0[1] * v0[1]) + (v0[2] * v0[2] + v0[3] * v0[3]) + (v1[0] * v1[0] + v1[1] * v1[1]) + (v1[2] * v1[2] + v1[3] * v1[3]); }
                    ss += __shfl_xor(ss, 16); ss += __shfl_xor(ss, 32);
                    const float r = (1.f / sqrtf(ss * (1.f / 64.f) + 1e-5f)) * (type == 3 ? 0.18033688011112042f : 1.f); rr[ai][m] = r;
#pragma unroll
                    for (int bj = 0; bj < 2; ++bj) { const f32x4 v0 = acc[ai][bj][m][0] * r * gv[bj][0], v1 = acc[ai][bj][m][1] * r * gv[bj][1];
                        P1_STORE(rowp, bj, v0, v1); }
                    asm volatile("" ::: "memory"); }
            if (type == 4 && atom_on) {
                float* km = KMEAN + ((size_t)u.pm * 8 + (cb >> 6) + wc) * 64 + 8 * fq;
#pragma unroll
                for (int bj = 0; bj < 2; ++bj)
#pragma unroll
                    for (int n = 0; n < 2; ++n)
#pragma unroll
                        for (int j = 0; j < 4; ++j) { float s = 0.f;
#pragma unroll
                            for (int ai = 0; ai < 2; ++ai)
#pragma unroll
                                for (int m = 0; m < 4; ++m) s += acc[ai][bj][m][n][j] * rr[ai][m];
                            s += __shfl_xor(s, 1); s += __shfl_xor(s, 2); s += __shfl_xor(s, 4); s += __shfl_xor(s, 8);
                            if (fr == 0) atomicAdd(km + 32 * bj + 4 * n + j, s * gv[bj][n][j] * (1.f / 256.f)); }
            }
        }
#undef P1_STORE
    }
};

constexpr int TB_OFF = LDSCTL_OFF + 1024;
__device__ __forceinline__ unsigned cvt_pk(float lo, float hi) { return cvt_pk_bf16(lo, hi); }

struct P3Order {
    pg8::StaticOrder so; int G, c; const unsigned char* ws;
    __device__ void init(int G_, int c_, const unsigned char* ws_) { so.init(NTOK, 1024, 1, 0); G = G_; c = c_; ws = ws_; }
    __device__ bool next(int i, pg9::Unit& u) const {
        const int tl = (i / 3) * G + c; if (tl >= 256) return false; pg8::Unit t; so.next(tl, t); u.pm = t.pm; u.pn = t.pn; u.aux = i % 3; u.cnt = 256; u.row0 = 0; u.ty = 0; return true; }
    __device__ __forceinline__ void a_ready(const pg9::Unit&, int, int) const {}
    __device__ __forceinline__ void done(const pg9::Unit&, int) const {}
    __device__ __forceinline__ int nt_of(const pg9::Unit&, int nt) const { return nt; }
    __device__ __forceinline__ const char* a_base(const pg9::Unit& u) const { return (const char*)(ws + WS_ORET) + (size_t)u.aux * (WS_OMOBA - WS_ORET) + (size_t)u.pm * 256 * 512 * 2; }
    __device__ __forceinline__ const char* b_base(const pg9::Unit& u) const { return (const char*)(ws + WS_WBR) + (size_t)u.aux * 1024 * 512 * 2 + (size_t)u.pn * 256 * 512 * 2; }
};
struct EpiP3 {
    static constexpr bool PERM = true, CHAIN = true;
    const bf16_t* GT; bf16_t* Y;
    __device__ __forceinline__ bool chain_more(const pg9::Unit& u) const { return u.aux < 2; }
    __device__ __forceinline__ void rescale(pg8::f32x4 (&acc)[2][2][4][2], const pg9::Unit& u, int wr, int wc, int fr, int fq) const {
        const int s = u.aux;
#pragma unroll
        for (int ai = 0; ai < 2; ++ai)
#pragma unroll
            for (int m = 0; m < 4; ++m) { const bf16_t* gp = GT + (size_t)(u.pm * 256 + 128 * ai + 64 * wr + 16 * m + fr) * 3072 + s * 1024 + u.pn * 256 + 32 * wc + 8 * fq;
#pragma unroll
                for (int bj = 0; bj < 2; ++bj) { const pg8::u32x4 ga = *(const pg8::u32x4*)(gp + 128 * bj), gb = *(const pg8::u32x4*)(gp + 1024 + 128 * bj);
#pragma unroll
                    for (int n = 0; n < 2; ++n)
#pragma unroll
                        for (int j = 0; j < 4; ++j) { const int e = 4 * n + j; const unsigned wa = ga[e >> 1], wb = gb[e >> 1];
                            const float fa = __uint_as_float((e & 1) ? (wa & 0xffff0000u) : (wa << 16)), fb = __uint_as_float((e & 1) ? (wb & 0xffff0000u) : (wb << 16));
                            acc[ai][bj][m][n][j] *= fa * __builtin_amdgcn_rcpf(fmaxf(fb, 1e-20f)); } }
                asm volatile("" ::: "memory"); }
    }
    __device__ __forceinline__ void operator()(const pg8::f32x4 (&acc)[2][2][4][2], const pg9::Unit& u, int wr, int wc, int fr, int fq) const {
#pragma unroll
        for (int ai = 0; ai < 2; ++ai)
#pragma unroll
            for (int m = 0; m < 4; ++m) { const size_t row = (size_t)(u.pm * 256 + 128 * ai + 64 * wr + 16 * m + fr); const bf16_t* gp = GT + row * 3072 + 2048 + u.pn * 256 + 32 * wc + 8 * fq; bf16_t* yp = Y + row * 1024 + u.pn * 256 + 32 * wc + 8 * fq;
#pragma unroll
                for (int bj = 0; bj < 2; ++bj) { const pg8::u32x4 ga = *(const pg8::u32x4*)(gp + 128 * bj); float v[8];
#pragma unroll
                    for (int n = 0; n < 2; ++n)
#pragma unroll
                        for (int j = 0; j < 4; ++j) { const int e = 4 * n + j; const unsigned wa = ga[e >> 1]; v[e] = acc[ai][bj][m][n][j] * __uint_as_float((e & 1) ? (wa & 0xffff0000u) : (wa << 16)); }
                    pg8::u32x4 w; w.x = cvt_pk(v[0], v[1]); w.y = cvt_pk(v[2], v[3]); w.z = cvt_pk(v[4], v[5]); w.w = cvt_pk(v[6], v[7]); *(pg8::u32x4*)(yp + 128 * bj) = w; }
                asm volatile("" ::: "memory"); }
    }
};
struct P4Order {
    pg8::StaticOrder so; int G, c; const unsigned char* ws;
    __device__ void init(int G_, int c_, const unsigned char* ws_) { so.init(NTOK, 1024, 1, 0); G = G_; c = c_; ws = ws_; }
    __device__ bool next(int i, pg9::Unit& u) const { const int tl = i * G + c; if (tl >= 256) return false; pg8::Unit t; so.next(tl, t); u.pm = t.pm; u.pn = t.pn; u.aux = 0; u.cnt = 256; u.row0 = 0; u.ty = 0; return true; }
    __device__ __forceinline__ void a_ready(const pg9::Unit&, int, int) const {}
    __device__ __forceinline__ void done(const pg9::Unit&, int) const {}
    __device__ __forceinline__ int nt_of(const pg9::Unit&, int nt) const { return nt; }
    __device__ __forceinline__ const char* a_base(const pg9::Unit& u) const { return (const char*)(ws + WS_Y) + (size_t)u.pm * 256 * 1024 * 2; }
    __device__ __forceinline__ const char* b_base(const pg9::Unit& u) const { return (const char*)(ws + WS_WOUT) + (size_t)u.pn * 256 * 1024 * 2; }
};
struct EpiP4 {
    static constexpr bool PERM = false, CHAIN = false;
    const float* x; float* out;
    __device__ __forceinline__ void operator()(const pg8::f32x4 (&acc)[2][2][4][2], const pg9::Unit& u, int wr, int wc, int fr, int fq) const {
#pragma unroll
        for (int ai = 0; ai < 2; ++ai)
#pragma unroll
            for (int m = 0; m < 4; ++m) { const size_t off = (size_t)(u.pm * 256 + 128 * ai + 64 * wr + 16 * m + fr) * 1024 + u.pn * 256 + 32 * wc + 4 * fq;
#pragma unroll
                for (int bj = 0; bj < 2; ++bj)
#pragma unroll
                    for (int n = 0; n < 2; ++n) { const pg8::f32x4 xv = *(const pg8::f32x4*)(x + off + 128 * bj + 16 * n); *(pg8::f32x4*)(out + off + 128 * bj + 16 * n) = xv + acc[ai][bj][m][n]; }
                if (m & 1) asm volatile("" ::: "memory"); }
    }
};
__device__ __forceinline__ float wave_max64(float v) {
#pragma unroll
    for (int o = 1; o < 64; o <<= 1) v = fmaxf(v, __shfl_xor(v, o));
    return v;
}
__device__ __forceinline__ void p5_router(Frame& F, const float* X1, const float* g_ffn, const float* w_router, const float* b_router, int* COUNTS, int* LISTS) {
    bf16_t* XT = (bf16_t*)(F.ws + WS_XT); int* TOPE = (int*)(F.ws + WS_TOPE); float* TOPW = (float*)(F.ws + WS_TOPW);
    const int lane = F.lane, e = lane & 31, tid = F.tid;
    LAS float* wsh = (LAS float*)(F.lds);
    LAS float* xs = (LAS float*)(F.lds + 36864) + F.wave * 2176;
    for (int v = F.vcu; v < NTOK / 64; v += F.G) {
        const int tw = v * 64 + F.wave * 8;
        f32x4 xr[2][4][4];
#pragma unroll
        for (int g = 0; g < 2; ++g)
#pragma unroll
            for (int q = 0; q < 4; ++q) { const float* xp = X1 + (size_t)(tw + 4 * g + q) * 1024;
#pragma unroll
                for (int j = 0; j < 4; ++j) xr[g][q][j] = *(const f32x4*)(xp + 4 * lane + 256 * j); }
        f32x4 gg[4];
#pragma unroll
        for (int j = 0; j < 4; ++j) gg[j] = *(const f32x4*)(g_ffn + 4 * lane + 256 * j);
#pragma unroll
        for (int g = 0; g < 2; ++g) { float s4[4];
#pragma unroll
            for (int q = 0; q < 4; ++q) { s4[q] = 0.f;
#pragma unroll
                for (int j = 0; j < 4; ++j) { const f32x4 x = xr[g][q][j]; s4[q] += (x.x * x.x + x.y * x.y) + (x.z * x.z + x.w * x.w); } }
#pragma unroll
            for (int o_ = 1; o_ < 64; o_ <<= 1) {
#pragma unroll
                for (int q = 0; q < 4; ++q) s4[q] += __shfl_xor(s4[q], o_); }
#pragma unroll
            for (int q = 0; q < 4; ++q) { const int t = tw + 4 * g + q; const float r = 1.f / sqrtf(s4[q] * (1.f / 1024.f) + 1e-5f);
#pragma unroll
                for (int j = 0; j < 4; ++j) { const f32x4 xn = xr[g][q][j] * r * gg[j]; xr[g][q][j] = xn;
                    uint2 w; w.x = cvt_pk(xn.x, xn.y); w.y = cvt_pk(xn.z, xn.w); *(uint2*)(XT + (size_t)t * 1024 + 4 * lane + 256 * j) = w; } } }
        pg8::f32x4 dacc[2] = {{0.f, 0.f, 0.f, 0.f}, {0.f, 0.f, 0.f, 0.f}};
        LAS bf16_t* wq = (LAS bf16_t*)wsh; LAS bf16_t* xq = (LAS bf16_t*)xs;
        const bf16_t* WR = (const bf16_t*)(F.ws + WS_WRS);
        const int fm = lane & 15, fk = lane >> 4;
#pragma unroll
        for (int qtr = 0; qtr < 4; ++qtr) {
            __syncthreads();
#pragma unroll
            for (int i = 0; i < 4; ++i) { const int ci = tid + 512 * i, hl = ci >> 10, ee = (ci >> 5) & 31, c = ci & 31;
                *(LAS v4u*)(wq + (hl * 32 + ee) * 264 + 8 * c) = *(const v4u*)(WR + (size_t)hl * 32768 + ee * 1024 + 256 * qtr + 8 * c); }
#pragma unroll
            for (int g = 0; g < 2; ++g)
#pragma unroll
                for (int q = 0; q < 4; ++q) { const f32x4 x = xr[g][q][qtr];
                    const unsigned h0 = cvt_pk(x.x, x.y), h1 = cvt_pk(x.z, x.w);
                    const unsigned l0 = cvt_pk(x.x - __uint_as_float(h0 << 16), x.y - __uint_as_float(h0 & 0xffff0000u)), l1 = cvt_pk(x.z - __uint_as_float(h1 << 16), x.w - __uint_as_float(h1 & 0xffff0000u));
                    typedef unsigned u32x2v __attribute__((ext_vector_type(2)));
                    const u32x2v hv = {h0, h1}, lv = {l0, l1};
                    *(LAS u32x2v*)(xq + (4 * g + q) * 264 + 4 * lane) = hv; *(LAS u32x2v*)(xq + (8 + 4 * g + q) * 264 + 4 * lane) = lv; }
            __syncthreads();
#pragma unroll
            for (int ks = 0; ks < 8; ++ks) {
                const pg8::bf16x8 bh = *(const LAS pg8::bf16x8*)(xq + (fm & 7) * 264 + 32 * ks + 8 * fk), bl = *(const LAS pg8::bf16x8*)(xq + (8 + (fm & 7)) * 264 + 32 * ks + 8 * fk);
#pragma unroll
                for (int et = 0; et < 2; ++et) {
                    const pg8::bf16x8 ah = *(const LAS pg8::bf16x8*)(wq + (16 * et + fm) * 264 + 32 * ks + 8 * fk), al = *(const LAS pg8::bf16x8*)(wq + (32 + 16 * et + fm) * 264 + 32 * ks + 8 * fk);
                    dacc[et] = __builtin_amdgcn_mfma_f32_16x16x32_bf16(ah, bh, dacc[et], 0, 0, 0);
                    dacc[et] = __builtin_amdgcn_mfma_f32_16x16x32_bf16(ah, bl, dacc[et], 0, 0, 0);
                    dacc[et] = __builtin_amdgcn_mfma_f32_16x16x32_bf16(al, bh, dacc[et], 0, 0, 0); } }
            asm volatile("s_waitcnt lgkmcnt(0)" ::: "memory");
        }
        float acc[2][4];
        { LAS float* lg = (LAS float*)xq;
          if (fm < 8) {
#pragma unroll
              for (int et = 0; et < 2; ++et)
#pragma unroll
                  for (int r = 0; r < 4; ++r) lg[fm * 33 + 16 * et + 4 * fk + r] = dacc[et][r]; }
          asm volatile("s_waitcnt lgkmcnt(0)" ::: "memory");
#pragma unroll
          for (int t8 = 0; t8 < 8; ++t8) acc[t8 >> 2][t8 & 3] = lg[t8 * 33 + e];
          asm volatile("s_waitcnt lgkmcnt(0)" ::: "memory"); }
        volatile LAS int* lcnt = (volatile LAS int*)(F.lds + TB_OFF);
        __syncthreads();
        if (tid < 32) lcnt[tid] = 0;
        __syncthreads();
        const float bias = b_router[e];
        int my_e[2][4], my_r[2][4];
#pragma unroll
        for (int g = 0; g < 2; ++g)
#pragma unroll
            for (int q = 0; q < 4; ++q) { const int t = tw + 4 * g + q; float lg = acc[g][q] + bias; if (lane >= 32) lg = -INFINITY;
                float tv[4]; int te[4];
#pragma unroll
                for (int k = 0; k < 4; ++k) { const float m = wave_max64(lg); const unsigned long long bal = __ballot(lg == m); const int ee = __ffsll((long long)bal) - 1; tv[k] = m; te[k] = ee; if (lane == ee) lg = -INFINITY; }
                float ex[4], se = 0.f;
#pragma unroll
                for (int k = 0; k < 4; ++k) { ex[k] = __expf(tv[k] - tv[0]); se += ex[k]; }
                int e_l = te[0]; float w_l = ex[0];
#pragma unroll
                for (int k = 1; k < 4; ++k) if (lane == k) { e_l = te[k]; w_l = ex[k]; }
                my_e[g][q] = e_l; my_r[g][q] = 0;
                if (lane < 4) { TOPE[t * 4 + lane] = e_l; TOPW[t * 4 + lane] = w_l / se; my_r[g][q] = __hip_atomic_fetch_add((LAS int*)(F.lds + TB_OFF) + e_l, 1, __ATOMIC_RELAXED, __HIP_MEMORY_SCOPE_WORKGROUP); } }
        __syncthreads();
        if (tid < 32) { int t2 = tid; asm volatile("" : "+v"(t2)); const int c = lcnt[t2]; lcnt[32 + t2] = c ? atomicAdd(&COUNTS[t2], c) : 0; }
        __syncthreads();
#pragma unroll
        for (int g = 0; g < 2; ++g)
#pragma unroll
            for (int q = 0; q < 4; ++q) if (lane < 4) { const int t = tw + 4 * g + q; LISTS[(size_t)my_e[g][q] * 16384 + lcnt[32 + my_e[g][q]] + my_r[g][q]] = t * 4 + lane; }
    }
}
__device__ __forceinline__ void moe_tables(Frame& F) {
    volatile LAS int* TB = (volatile LAS int*)(F.lds + TB_OFF);
    if (F.tid < 64) {
        const int* COUNTS = (const int*)F.ctl + CW_COUNTS; const int ln = F.tid;
        const int c = ln < 32 ? __hip_atomic_load(COUNTS + ln, __ATOMIC_RELAXED, __HIP_MEMORY_SCOPE_AGENT) : 0;
        int inc = (c + 255) >> 8;
#pragma unroll
        for (int o = 1; o < 32; o <<= 1) { const int v = __shfl_up(inc, o); if (ln >= o) inc += v; }
        if (ln < 32) { TB[ln] = inc - ((c + 255) >> 8); TB[33 + ln] = c; }
        if (ln == 31) TB[32] = inc;
    }
    __syncthreads();
}
template <int NPN_LOG2, size_t WOFF, int NROWS_B, int ASHIFT, size_t AOFF> struct MoeOrder {
    int perx, xcd, l; const unsigned char* ws; const LAS int* TB; const int* LISTS;
    __device__ void init(int G_, int vcu_, const unsigned char* ws_, const LAS int* TB_) { perx = G_ / 8; xcd = vcu_ / perx; l = vcu_ % perx; ws = ws_; TB = TB_; LISTS = (const int*)(ws_ + WS_LISTS); }
    __device__ bool next(int i, pg9::Unit& u) const {
        const int uidx = i * perx + l; const int mt = TB[4 * xcd] + (uidx >> NPN_LOG2); if (mt >= TB[4 * xcd + 4]) return false;
        int e = 4 * xcd;
#pragma unroll
        for (int k = 1; k < 4; ++k) if (TB[4 * xcd + k] <= mt) e = 4 * xcd + k;
        u.aux = e; u.pm = mt - TB[e]; u.pn = uidx & ((1 << NPN_LOG2) - 1); u.cnt = TB[33 + e] - u.pm * 256; u.row0 = mt * 256; u.ty = 0; return true;
    }
    __device__ __forceinline__ void a_ready(const pg9::Unit&, int, int) const {}
    __device__ __forceinline__ void done(const pg9::Unit&, int) const {}
    __device__ __forceinline__ int nt_of(const pg9::Unit&, int nt) const { return nt; }
    __device__ __forceinline__ const char* a_base(const pg9::Unit& u) const { return (const char*)(ws + AOFF) + (ASHIFT == 0 ? (size_t)u.row0 * 2048 : (size_t)0); }
    __device__ __forceinline__ const char* b_base(const pg9::Unit& u) const { return (const char*)(ws + WOFF) + ((size_t)u.aux * NROWS_B + (size_t)u.pn * 256) * 1024 * 2; }
    __device__ __forceinline__ unsigned a_row_off(const pg9::Unit& u, int r) const { const int rr = r < u.cnt ? r : u.cnt - 1; const int id = LISTS[(size_t)u.aux * 16384 + u.pm * 256 + rr]; return (unsigned)(id >> ASHIFT) * 2048u; }
};
constexpr bool MOE2_SPLIT = false;
constexpr size_t WS_PB = WS_GT;
__device__ __forceinline__ void moe2_split(int ntiles, int perx, int& base, int& L, int& spl) {
    const int U = 4 * ntiles, R = U / perx; base = R * perx; L = U - base;
    spl = (!MOE2_SPLIT || L == 0 || (perx & 3)) ? 1 : (4 * L <= perx ? 4 : (2 * L <= perx ? 2 : 1));
}
__device__ __forceinline__ int pb_row(int x, int s, int jt) { return ((x * 3 + (s - 1)) * 4 + jt) * 256; }
struct Moe2SplitOrder {
    int perx, xcd, l, T0, R, base, L, spl; const unsigned char* ws; const LAS int* TB;
    __device__ void init(int G_, int vcu_, const unsigned char* ws_, const LAS int* TB_) { perx = G_ / 8; xcd = vcu_ / perx; l = vcu_ % perx; ws = ws_; TB = TB_; T0 = TB[4 * xcd]; moe2_split(TB[4 * xcd + 4] - T0, perx, base, L, spl); R = base / perx;
        T0 = __builtin_amdgcn_readfirstlane(T0); R = __builtin_amdgcn_readfirstlane(R); base = __builtin_amdgcn_readfirstlane(base); L = __builtin_amdgcn_readfirstlane(L); spl = __builtin_amdgcn_readfirstlane(spl); }
    __device__ bool next(int i, pg9::Unit& u) const {
        int uidx, s = 0, sp = 1;
        if (i < R) uidx = i * perx + l;
        else if (i == R && l < L * spl) { s = (l >= L) + (l >= 2 * L) + (l >= 3 * L); uidx = base + l - s * L; sp = spl; }
        else return false;
        const int mt = T0 + (uidx >> 2);
        int e = 4 * xcd;
#pragma unroll
        for (int k = 1; k < 4; ++k) if (TB[4 * xcd + k] <= mt) e = 4 * xcd + k;
        u.aux = e; u.pm = mt - TB[e]; u.pn = uidx & 3; u.cnt = TB[33 + e] - u.pm * 256; u.row0 = mt * 256; u.ty = s | (sp << 4) | (((uidx >> 2) - (base >> 2)) << 8);
        u.aux = __builtin_amdgcn_readfirstlane(u.aux); u.pm = __builtin_amdgcn_readfirstlane(u.pm); u.pn = __builtin_amdgcn_readfirstlane(u.pn); u.cnt = __builtin_amdgcn_readfirstlane(u.cnt);
        u.row0 = __builtin_amdgcn_readfirstlane(u.row0); u.ty = __builtin_amdgcn_readfirstlane(u.ty); return true;
    }
    __device__ __forceinline__ void a_ready(const pg9::Unit&, int, int) const {}
    __device__ __forceinline__ void done(const pg9::Unit&, int) const {}
    __device__ __forceinline__ int nt_of(const pg9::Unit& u, int nt) const { return nt >> (((u.ty >> 4) & 15) >> 1); }
    __device__ __forceinline__ size_t koff(const pg9::Unit& u) const { return (size_t)((u.ty & 15) * (2048 >> (((u.ty >> 4) & 15) >> 1))); }
    __device__ __forceinline__ const char* a_base(const pg9::Unit& u) const { return (const char*)(ws + WS_ACT) + (size_t)u.row0 * 2048 + koff(u); }
    __device__ __forceinline__ const char* b_base(const pg9::Unit& u) const { return (const char*)(ws + WS_W2) + ((size_t)u.aux * 1024 + (size_t)u.pn * 256) * 1024 * 2 + koff(u); }
};
struct EpiMoe1 {
    static constexpr bool PERM = true, CHAIN = false;
    const int* LISTS; const float* b1; bf16_t* ACT; int* SLOT;
    __device__ __forceinline__ void operator()(const pg8::f32x4 (&acc)[2][2][4][2], const pg9::Unit& u, int wr, int wc, int fr, int fq) const {
        const int e = u.aux; const int c0 = u.pn * 256 + 32 * wc + 8 * fq;
        pg8::f32x4 bv[2][2];
#pragma unroll
        for (int bj = 0; bj < 2; ++bj)
#pragma unroll
            for (int n = 0; n < 2; ++n) bv[bj][n] = *(const pg8::f32x4*)(b1 + (size_t)e * 2048 + c0 + 128 * bj + 4 * n);
        const bool slotw = (u.pn == 0) && (wc == 0) && (fq == 0);
#pragma unroll
        for (int ai = 0; ai < 2; ++ai)
#pragma unroll
            for (int m = 0; m < 4; ++m) { const int r = 128 * ai + 64 * wr + 16 * m + fr; const bool ok = r < u.cnt;
                if (slotw && ok) SLOT[LISTS[(size_t)e * 16384 + u.pm * 256 + r]] = u.row0 + r;
#pragma unroll
                for (int bj = 0; bj < 2; ++bj) { float a[4];
#pragma unroll
                    for (int n = 0; n < 2; ++n)
#pragma unroll
                        for (int p = 0; p < 2; ++p) { const float gl = fminf(acc[ai][bj][m][n][2 * p] + bv[bj][n][2 * p], 7.0f); const float li = fminf(fmaxf(acc[ai][bj][m][n][2 * p + 1] + bv[bj][n][2 * p + 1], -7.0f), 7.0f);
                            a[2 * n + p] = gl * sigmoid_f(1.702f * gl) * (li + 1.f); }
                    if (ok) { uint2 w; w.x = cvt_pk(a[0], a[1]); w.y = cvt_pk(a[2], a[3]); *(uint2*)(ACT + (size_t)(u.row0 + r) * 1024 + ((c0 + 128 * bj) >> 1)) = w; } }
                asm volatile("" ::: "memory"); }
    }
};
struct EpiMoe2 {
    static constexpr bool PERM = true, CHAIN = false;
    const float* b2; unsigned char* ws;
    __device__ __forceinline__ void operator()(const pg8::f32x4 (&acc)[2][2][4][2], const pg9::Unit& u, int wr, int wc, int fr, int fq) const {
        asm volatile("" : "+v"(fr));
        const int e = u.aux; const int c0 = u.pn * 256 + 32 * wc + 8 * fq; const int sl = u.ty & 15;
        pg8::f32x4 bv[2][2];
#pragma unroll
        for (int bj = 0; bj < 2; ++bj)
#pragma unroll
            for (int n = 0; n < 2; ++n) bv[bj][n] = sl ? (pg8::f32x4){0.f, 0.f, 0.f, 0.f} : *(const pg8::f32x4*)(b2 + (size_t)e * 1024 + c0 + 128 * bj + 4 * n);
        bf16_t* D = (bf16_t*)(ws + (sl ? WS_PB : WS_YS)) + (size_t)(sl ? pb_row(e >> 2, sl, u.ty >> 8) : u.row0) * 1024;
#pragma unroll
        for (int ai = 0; ai < 2; ++ai)
#pragma unroll
            for (int m = 0; m < 4; ++m) { const int r = 128 * ai + 64 * wr + 16 * m + fr; const bool ok = r < u.cnt;
#pragma unroll
                for (int bj = 0; bj < 2; ++bj) { const pg8::f32x4 v0 = acc[ai][bj][m][0] + bv[bj][0], v1 = acc[ai][bj][m][1] + bv[bj][1];
                    if (ok) { pg8::u32x4 w; w.x = cvt_pk(v0[0], v0[1]); w.y = cvt_pk(v0[2], v0[3]); w.z = cvt_pk(v1[0], v1[1]); w.w = cvt_pk(v1[2], v1[3]); *(pg8::u32x4*)(D + (size_t)r * 1024 + c0 + 128 * bj) = w; } }
                asm volatile("" ::: "memory"); }
    }
};

__device__ __forceinline__ void p8_combine(Frame& F, const float* src, float* out) {
    const bf16_t* YS = (const bf16_t*)(F.ws + WS_YS); const bf16_t* PB = (const bf16_t*)(F.ws + WS_PB); const float* TOPW = (const float*)(F.ws + WS_TOPW); const int* SLOT = (const int*)(F.ws + WS_SLOT);
    const int gw = F.vcu * NWAVES + F.wave, NGW = F.G * NWAVES, lane = F.lane;
    volatile LAS int* TB = (volatile LAS int*)(F.lds + TB_OFF);
    if (MOE2_SPLIT) moe_tables(F);
    if (MOE2_SPLIT && F.tid < 8) { int base, L, spl; moe2_split(TB[4 * F.tid + 4] - TB[4 * F.tid], F.G / 8, base, L, spl); TB[72 + 2 * F.tid] = base; TB[73 + 2 * F.tid] = spl; }
    __syncthreads();
    for (int t = gw; t < NTOK; t += NGW) {
        const f32x4 w4 = *(const f32x4*)(TOPW + (size_t)t * 4); const int4 s4 = *(const int4*)(SLOT + (size_t)t * 4); const int sl[4] = {s4.x, s4.y, s4.z, s4.w};
        int spk[4], ltk[4], xk[4], bk[4];
#pragma unroll
        for (int k = 0; k < 4; ++k) { if (!MOE2_SPLIT) { xk[k] = ltk[k] = bk[k] = 0; spk[k] = 1; continue; } const int mt = sl[k] >> 8; int x = 0;
#pragma unroll
            for (int q = 1; q < 8; ++q) if (TB[4 * q] <= mt) x = q;
            xk[k] = x; ltk[k] = mt - TB[4 * x]; bk[k] = TB[72 + 2 * x]; spk[k] = TB[73 + 2 * x]; }
        const bool anysplit = (spk[0] | spk[1] | spk[2] | spk[3]) > 1;
#pragma unroll
        for (int j = 0; j < 2; ++j) {
            const int c = 8 * lane + 512 * j; f32x4 a0 = *(const f32x4*)(src + (size_t)t * 1024 + c), a1 = *(const f32x4*)(src + (size_t)t * 1024 + c + 4);
#pragma unroll
            for (int k = 0; k < 4; ++k) { const v4u y = __builtin_nontemporal_load((const v4u*)(YS + (size_t)sl[k] * 1024 + c)); const float wk = w4[k];
                a0.x += wk * __uint_as_float(y.x << 16); a0.y += wk * __uint_as_float(y.x & 0xffff0000u); a0.z += wk * __uint_as_float(y.y << 16); a0.w += wk * __uint_as_float(y.y & 0xffff0000u);
                a1.x += wk * __uint_as_float(y.z << 16); a1.y += wk * __uint_as_float(y.z & 0xffff0000u); a1.z += wk * __uint_as_float(y.w << 16); a1.w += wk * __uint_as_float(y.w & 0xffff0000u); }
            if (anysplit) {
                const int pn = (lane >> 5) + 2 * j;
#pragma unroll
                for (int k = 0; k < 4; ++k) if (spk[k] > 1 && 4 * ltk[k] + pn >= bk[k]) { const float wk = w4[k]; const int jt = ltk[k] - (bk[k] >> 2);
                    for (int s = 1; s < spk[k]; ++s) { const v4u y = *(const v4u*)(PB + (size_t)(pb_row(xk[k], s, jt) + (sl[k] & 255)) * 1024 + c);
                        a0.x += wk * __uint_as_float(y.x << 16); a0.y += wk * __uint_as_float(y.x & 0xffff0000u); a0.z += wk * __uint_as_float(y.y << 16); a0.w += wk * __uint_as_float(y.y & 0xffff0000u);
                        a1.x += wk * __uint_as_float(y.z << 16); a1.y += wk * __uint_as_float(y.z & 0xffff0000u); a1.z += wk * __uint_as_float(y.w << 16); a1.w += wk * __uint_as_float(y.w & 0xffff0000u); } }
            }
            __builtin_nontemporal_store(a0, (f32x4*)(out + (size_t)t * 1024 + c)); __builtin_nontemporal_store(a1, (f32x4*)(out + (size_t)t * 1024 + c + 4)); }
    }
}
namespace att {
typedef float f32x16 __attribute__((ext_vector_type(16)));
typedef float f32x8 __attribute__((ext_vector_type(8)));
using pg8::f32x2;
typedef short s16x4 __attribute__((ext_vector_type(4)));
typedef short v4i16_t __attribute__((ext_vector_type(4)));
using pg8::bf16x8;
constexpr float LOG2E = 1.4426950408889634f;
__device__ __forceinline__ constexpr int crow(int r, int hi) { return (r & 3) + 8 * (r >> 2) + 4 * hi; }
template <int D> __device__ __forceinline__ int kswz(int row) { return D == 64 ? ((row >> 1) & 7) : (row & 15); }
template <int D> __device__ __forceinline__ int vswz(int row) { return D == 64 ? (((row >> 1) & 1) << 2) : ((row & 3) << 2); }
__device__ __forceinline__ s16x4 vtr(const LAS unsigned char* p) { return __builtin_bit_cast(s16x4, __builtin_amdgcn_ds_read_tr16_b64_v4i16((LAS v4i16_t*)p)); }
__device__ __forceinline__ bf16x8 pack8(const f32x16& x, int s) {
    typedef unsigned u32x4_t __attribute__((ext_vector_type(4))); u32x4_t p;
    p[0] = cvt_pk_bf16(x[8 * s + 0], x[8 * s + 1]); p[1] = cvt_pk_bf16(x[8 * s + 2], x[8 * s + 3]); p[2] = cvt_pk_bf16(x[8 * s + 4], x[8 * s + 5]); p[3] = cvt_pk_bf16(x[8 * s + 6], x[8 * s + 7]);
    return __builtin_bit_cast(bf16x8, p);
}
__device__ __forceinline__ float bfl(unsigned w) { return __uint_as_float(w << 16); }
__device__ __forceinline__ float bfh(unsigned w) { return __uint_as_float(w & 0xffff0000u); }

template <bool MOBA, int TK> __device__ __forceinline__ int tile_kbase(int tt, int qb) { constexpr int TPB = 256 / TK; if (!MOBA) return TK * tt; if (tt < TPB) return qb * 256 + TK * tt; const int u = tt - TPB; return (u / TPB) * 256 + TK * (u % TPB); }
template <int D, bool MOBA, int NSUB>
__device__ __forceinline__ void attn_unit(Frame& F, const int b, const int h, const int qb,
                                          const bf16_t* Qg, const bf16_t* Kg, const bf16_t* Vg, bf16_t* Og, const int ld,
                                          const float* KMEAN, const float* KSS, const float* gq, const float* gk) {
    constexpr int NKH = 2  , TK = 64 * NSUB  , KB = TK * D * 2, NKS = D / 16, NDH = D / 32, CPR = D / 8  , NST = (TK * CPR) / 512  ;
    int tid = F.tid, lane = F.lane; asm volatile("" : "+v"(tid), "+v"(lane));
    const int wave = F.wave, r32 = lane & 31, hi = lane >> 5;
    LAS unsigned char* lds = F.lds;
    const size_t qrow = (size_t)b * SEQ + qb * 256 + wave * 32 + r32;
    bf16x8 qr[NKS];
#pragma unroll
    for (int ks = 0; ks < NKS; ++ks) qr[ks] = *(const bf16x8*)(Qg + qrow * ld + h * D + 16 * ks + 8 * hi);
    unsigned selmask = 0u;
    if constexpr (MOBA) {
        if (qb > 0) {
            LAS float* kml = (LAS float*)(lds + 4 * KB);
            if (tid < qb * 16) *(LAS f32x4*)(kml + 4 * tid) = *(const f32x4*)(KMEAN + (((size_t)b * 16 + (tid >> 4)) * 8 + h) * 64 + 4 * (tid & 15));
            __syncthreads();
            float qf[NKS * 8];
#pragma unroll
            for (int ks = 0; ks < NKS; ++ks) { const pg8::u32x4 w = __builtin_bit_cast(pg8::u32x4, qr[ks]);
#pragma unroll
                for (int j = 0; j < 4; ++j) { qf[ks * 8 + 2 * j] = bfl(w[j]); qf[ks * 8 + 2 * j + 1] = bfh(w[j]); } }
            float v0 = -INFINITY, v1 = -INFINITY, v2 = -INFINITY; int i0 = -1, i1 = -1, i2 = -1;
#pragma unroll 1
            for (int j = 0; j < qb; ++j) { const LAS float* km = kml + 64 * j + 8 * hi; float s = 0.f;
#pragma unroll
                for (int ks = 0; ks < NKS; ++ks) { const f32x4 k0 = *(const LAS f32x4*)(km + 16 * ks), k1 = *(const LAS f32x4*)(km + 16 * ks + 4);
                    s += qf[ks * 8 + 0] * k0[0] + qf[ks * 8 + 1] * k0[1] + qf[ks * 8 + 2] * k0[2] + qf[ks * 8 + 3] * k0[3] + qf[ks * 8 + 4] * k1[0] + qf[ks * 8 + 5] * k1[1] + qf[ks * 8 + 6] * k1[2] + qf[ks * 8 + 7] * k1[3]; }
                s += __shfl_xor(s, 32);
                const bool c0 = s > v0, c1 = s > v1, c2 = s > v2;
                v2 = c1 ? v1 : (c2 ? s : v2); i2 = c1 ? i1 : (c2 ? j : i2);
                v1 = c0 ? v0 : (c1 ? s : v1); i1 = c0 ? i0 : (c1 ? j : i1);
                v0 = c0 ? s : v0; i0 = c0 ? j : i0; }
            selmask = (i0 >= 0 ? (1u << i0) : 0u) | (i1 >= 0 ? (1u << i1) : 0u) | (i2 >= 0 ? (1u << i2) : 0u);
        }
    } else {
        float qf[NKS * 8]; float ss = 0.f;
#pragma unroll
        for (int ks = 0; ks < NKS; ++ks) { const pg8::u32x4 w = __builtin_bit_cast(pg8::u32x4, qr[ks]);
#pragma unroll
            for (int j = 0; j < 4; ++j) { qf[ks * 8 + 2 * j] = bfl(w[j]); qf[ks * 8 + 2 * j + 1] = bfh(w[j]); ss += qf[ks * 8 + 2 * j] * qf[ks * 8 + 2 * j] + qf[ks * 8 + 2 * j + 1] * qf[ks * 8 + 2 * j + 1]; } }
        ss += __shfl_xor(ss, 32);
        const float rq = (1.f / sqrtf(ss * (1.f / D) + 1e-5f)) * (0.08838834764831845f * LOG2E);
#pragma unroll
        for (int ks = 0; ks < NKS; ++ks) { const float* g1 = gq + 16 * ks + 8 * hi; const float* g2 = gk + 16 * ks + 8 * hi; pg8::u32x4 w;
#pragma unroll
            for (int j = 0; j < 4; ++j) w[j] = cvt_pk_bf16(qf[ks * 8 + 2 * j] * rq * g1[2 * j] * g2[2 * j], qf[ks * 8 + 2 * j + 1] * rq * g1[2 * j + 1] * g2[2 * j + 1]);
            qr[ks] = __builtin_bit_cast(bf16x8, w); }
    }
    constexpr int TPB = 256 / TK;
    const int NT = MOBA ? TPB * (qb + 1) : TPB;
    const float sl2 = MOBA ? exp2f(-(float)(h + 1)) * LOG2E : 0.f;
    v4u kreg[NST], vreg[NST];
#define ATT_LOAD(tt) do { const int kb_ = tile_kbase<MOBA, TK>(tt, qb); _Pragma("unroll") for (int i_ = 0; i_ < NST; ++i_) { const int ci_ = tid + 512 * i_, row_ = ci_ / CPR, ch_ = ci_ % CPR; \
        const size_t g_ = (size_t)(kb_ + row_) * ld + h * D + 8 * ch_; kreg[i_] = *(const v4u*)(Kg + g_); vreg[i_] = *(const v4u*)(Vg + g_); \
        if (!MOBA) { const float rk_ = 1.f / sqrtf(KSS[(size_t)(kb_ + row_) * 4 + h] * (1.f / D) + 1e-5f); v4u k_ = kreg[i_]; \
            k_.x = cvt_pk_bf16(bfl(k_.x) * rk_, bfh(k_.x) * rk_); k_.y = cvt_pk_bf16(bfl(k_.y) * rk_, bfh(k_.y) * rk_); k_.z = cvt_pk_bf16(bfl(k_.z) * rk_, bfh(k_.z) * rk_); k_.w = cvt_pk_bf16(bfl(k_.w) * rk_, bfh(k_.w) * rk_); kreg[i_] = k_; } } } while (0)
#define ATT_WRITE(buf) do { _Pragma("unroll") for (int i_ = 0; i_ < NST; ++i_) { const int ci_ = tid + 512 * i_, row_ = ci_ / CPR, ch_ = ci_ % CPR; \
        *(LAS v4u*)(lds + (buf) * KB + row_ * (2 * D) + ((ch_ ^ kswz<D>(row_)) << 4)) = kreg[i_]; *(LAS v4u*)(lds + (2 + (buf)) * KB + row_ * (2 * D) + ((ch_ ^ vswz<D>(row_)) << 4)) = vreg[i_]; } } while (0)
    ATT_LOAD(0); ATT_WRITE(0);
    __syncthreads();
    float m = -1e30f, l = 0.f;
    f32x16 o[NDH];
#pragma unroll
    for (int dh = 0; dh < NDH; ++dh)
#pragma unroll
        for (int r = 0; r < 16; ++r) o[dh][r] = 0.f;
    const int qrel = wave * 32 + r32;
    f32x16 cinit[NKH];
#pragma unroll
    for (int kh = 0; kh < NKH; ++kh)
#pragma unroll
        for (int r = 0; r < 16; ++r) cinit[kh][r] = MOBA ? sl2 * (float)(32 * kh + (r & 3) + 8 * (r >> 2)) : 0.f;
    for (int tt = 0; tt < NT; ++tt) {
        int lane_t = lane; asm volatile("" : "+v"(lane_t));
        const int r32 = lane_t & 31, hi = lane_t >> 5, i16 = lane_t & 15, blk = (lane_t >> 4) & 1, tq = i16 >> 2, tp = i16 & 3;
        const int buf = tt & 1;
        if (tt + 1 < NT) ATT_LOAD(tt + 1);
#pragma unroll 1
        for (int sub = 0; sub < NSUB; ++sub) {
        bool act = true; bool lane_sel = true; int pblk = -1;
        if constexpr (MOBA) { if (tt >= TPB) { pblk = (tt - TPB) / TPB; lane_sel = (selmask >> pblk) & 1u; act = __builtin_amdgcn_ballot_w64(lane_sel) != 0ull; }
            else act = (TK * tt + 64 * sub <= wave * 32 + 31); }
        if (act) {
            f32x16 p[NKH];
            const LAS unsigned char* Kb = lds + buf * KB + sub * 64 * (2 * D);
#pragma unroll
            for (int ks = 0; ks < NKS; ++ks) {
#pragma unroll
                for (int kh = 0; kh < NKH; ++kh) { const int row = 32 * kh + r32;
                    const bf16x8 a = *(const LAS bf16x8*)(Kb + row * (2 * D) + (((2 * ks + hi) ^ kswz<D>(row)) << 4));
                    p[kh] = __builtin_amdgcn_mfma_f32_32x32x16_bf16(a, qr[ks], ks == 0 ? cinit[kh] : p[kh], 0, 0, 0); }
            }
            float offl = 0.f;
            if constexpr (MOBA) {
                const int kb = tile_kbase<MOBA, TK>(tt, qb) + 64 * sub; offl = sl2 * (float)(kb - qb * 256 + 4 * hi);
                if (tt < TPB) {
                    const int k0 = TK * tt + 64 * sub + 4 * hi;
#pragma unroll
                    for (int kh = 0; kh < NKH; ++kh)
#pragma unroll
                        for (int r = 0; r < 16; ++r) { const int kv = k0 + 32 * kh + (r & 3) + 8 * (r >> 2); if (kv > qrel) p[kh][r] = -INFINITY; }
                } else if (!lane_sel) {
#pragma unroll
                    for (int kh = 0; kh < NKH; ++kh)
#pragma unroll
                        for (int r = 0; r < 16; ++r) p[kh][r] = -INFINITY;
                }
            }
            float mx = p[0][0];
#pragma unroll
            for (int kh = 0; kh < NKH; ++kh)
#pragma unroll
                for (int r = 0; r < 16; ++r) mx = fmaxf(mx, p[kh][r]);
            mx += offl;
            mx = fmaxf(mx, __shfl_xor(mx, 32));
            const float mnew = fmaxf(m, mx);
            if (__builtin_amdgcn_ballot_w64(mnew > m) != 0ull) { const float alpha = __builtin_amdgcn_exp2f(m - mnew); l *= alpha;
#pragma unroll
                for (int dh = 0; dh < NDH; ++dh)
#pragma unroll
                    for (int r = 0; r < 16; ++r) o[dh][r] *= alpha;
                m = mnew; }
            float ps = 0.f; const float mt = m - offl;
#pragma unroll
            for (int kh = 0; kh < NKH; ++kh)
#pragma unroll
                for (int r = 0; r < 16; ++r) { p[kh][r] = __builtin_amdgcn_exp2f(p[kh][r] - mt); ps += p[kh][r]; }
            l += ps;
            const LAS unsigned char* Vb = lds + (2 + buf) * KB + sub * 64 * (2 * D);
#pragma unroll
            for (int kh = 0; kh < NKH; ++kh)
#pragma unroll
                for (int s = 0; s < 2; ++s) {
                    const bf16x8 pb = pack8(p[kh], s);
#pragma unroll
                    for (int dh = 0; dh < NDH; ++dh) {
                        const int rowA = 32 * kh + 16 * s + 4 * hi + tq, rowB = rowA + 8, chv = 4 * dh + 2 * blk + (tp >> 1);
                        const s16x4 lo = vtr(Vb + rowA * (2 * D) + ((chv ^ vswz<D>(rowA)) << 4) + 8 * (tp & 1));
                        const s16x4 hh = vtr(Vb + rowB * (2 * D) + ((chv ^ vswz<D>(rowB)) << 4) + 8 * (tp & 1));
                        const bf16x8 va = (bf16x8){lo[0], lo[1], lo[2], lo[3], hh[0], hh[1], hh[2], hh[3]};
                        o[dh] = __builtin_amdgcn_mfma_f32_32x32x16_bf16(va, pb, o[dh], 0, 0, 0);
                    }
                }
        }
        }
        if (tt + 1 < NT) ATT_WRITE(buf ^ 1);
        __syncthreads();
    }
    l += __shfl_xor(l, 32);
    const float inv = 1.f / l;
    bf16_t* orow = Og + qrow * ld + h * D;
#pragma unroll
    for (int dh = 0; dh < NDH; ++dh)
#pragma unroll
        for (int g = 0; g < 4; ++g) { uint2 w; w.x = cvt_pk_bf16(o[dh][4 * g] * inv, o[dh][4 * g + 1] * inv); w.y = cvt_pk_bf16(o[dh][4 * g + 2] * inv, o[dh][4 * g + 3] * inv);
            *(uint2*)(orow + 32 * dh + 8 * g + 4 * hi) = w; }
#undef ATT_LOAD
#undef ATT_WRITE
}

__device__ __forceinline__ void mem_attn_group(Frame& F, const int b, const int h, const int qb0, const int NQ,
                                               const bf16_t* Qg, const bf16_t* Kg, const bf16_t* Vg, bf16_t* Og, const float* KSS, const float* gq, const float* gk) {
    constexpr int D = 128, ld = 512, NKH = 2, KB = 64 * D * 2, NKS = D / 16, NDH = D / 32, CPR = D / 8;
    int tid = F.tid, lane = F.lane; asm volatile("" : "+v"(tid), "+v"(lane));
    const int wave = F.wave;
    LAS unsigned char* lds = F.lds;
    bf16x8 qn[NKS];
    { const size_t qrow0 = (size_t)b * SEQ + qb0 * 256 + wave * 32 + (lane & 31);
#pragma unroll
      for (int ks = 0; ks < NKS; ++ks) qn[ks] = *(const bf16x8*)(Qg + qrow0 * ld + h * D + 16 * ks + 8 * (lane >> 5)); }
    {
        v4u kreg[8], vreg[8]; float rks[8];
#pragma unroll
        for (int i = 0; i < 8; ++i) { const int ci = tid + 512 * i, row = ci / CPR, ch = ci % CPR; const size_t g_ = (size_t)row * ld + h * D + 8 * ch; kreg[i] = *(const v4u*)(Kg + g_); vreg[i] = *(const v4u*)(Vg + g_); rks[i] = KSS[(size_t)row * 4 + h]; }
        float gg[8];
        { const int ch = tid % CPR; const f32x4 a0 = *(const f32x4*)(gq + 8 * ch), a1 = *(const f32x4*)(gq + 8 * ch + 4), b0 = *(const f32x4*)(gk + 8 * ch), b1 = *(const f32x4*)(gk + 8 * ch + 4);
          gg[0] = a0.x * b0.x; gg[1] = a0.y * b0.y; gg[2] = a0.z * b0.z; gg[3] = a0.w * b0.w; gg[4] = a1.x * b1.x; gg[5] = a1.y * b1.y; gg[6] = a1.z * b1.z; gg[7] = a1.w * b1.w; }
#pragma unroll
        for (int i = 0; i < 8; ++i) { const int ci = tid + 512 * i, row = ci / CPR, ch = ci % CPR, t = row >> 6, rr = row & 63;
            const float rk = 1.f / sqrtf(rks[i] * (1.f / D) + 1e-5f); v4u k_ = kreg[i];
            k_.x = cvt_pk_bf16(bfl(k_.x) * rk * gg[0], bfh(k_.x) * rk * gg[1]); k_.y = cvt_pk_bf16(bfl(k_.y) * rk * gg[2], bfh(k_.y) * rk * gg[3]); k_.z = cvt_pk_bf16(bfl(k_.z) * rk * gg[4], bfh(k_.z) * rk * gg[5]); k_.w = cvt_pk_bf16(bfl(k_.w) * rk * gg[6], bfh(k_.w) * rk * gg[7]);
            *(LAS v4u*)(lds + t * KB + rr * (2 * D) + ((ch ^ kswz<D>(rr)) << 4)) = k_; *(LAS v4u*)(lds + (4 + t) * KB + rr * (2 * D) + ((ch ^ vswz<D>(rr)) << 4)) = vreg[i]; }
    }
    __syncthreads();
#pragma unroll 1
    for (int qi = 0; qi < NQ; ++qi) {
        int lane_q = lane; asm volatile("" : "+v"(lane_q));
        const int r32 = lane_q & 31, hi = lane_q >> 5, i16 = lane_q & 15, blk = (lane_q >> 4) & 1, tq = i16 >> 2, tp = i16 & 3;
        const size_t qrow = (size_t)b * SEQ + (qb0 + qi) * 256 + wave * 32 + r32;
        bf16x8 qr[NKS];
#pragma unroll
        for (int ks = 0; ks < NKS; ++ks) qr[ks] = qn[ks];
        if (qi + 1 < NQ) {
#pragma unroll
            for (int ks = 0; ks < NKS; ++ks) qn[ks] = *(const bf16x8*)(Qg + (qrow + 256) * ld + h * D + 16 * ks + 8 * hi); }
        {
            float qf[NKS * 8]; float ss = 0.f;
#pragma unroll
            for (int ks = 0; ks < NKS; ++ks) { const pg8::u32x4 w = __builtin_bit_cast(pg8::u32x4, qr[ks]);
#pragma unroll
                for (int j = 0; j < 4; ++j) { qf[ks * 8 + 2 * j] = bfl(w[j]); qf[ks * 8 + 2 * j + 1] = bfh(w[j]); ss += qf[ks * 8 + 2 * j] * qf[ks * 8 + 2 * j] + qf[ks * 8 + 2 * j + 1] * qf[ks * 8 + 2 * j + 1]; } }
            ss += __shfl_xor(ss, 32);
            const float rq = (1.f / sqrtf(ss * (1.f / D) + 1e-5f)) * (0.08838834764831845f * LOG2E);
#pragma unroll
            for (int ks = 0; ks < NKS; ++ks) { pg8::u32x4 w;
#pragma unroll
                for (int j = 0; j < 4; ++j) w[j] = cvt_pk_bf16(qf[ks * 8 + 2 * j] * rq, qf[ks * 8 + 2 * j + 1] * rq);
                qr[ks] = __builtin_bit_cast(bf16x8, w); }
        }
        float m = -1e30f, l = 0.f;
        f32x16 o[NDH];
#pragma unroll
        for (int dh = 0; dh < NDH; ++dh)
#pragma unroll
            for (int r = 0; r < 16; ++r) o[dh][r] = 0.f;
#pragma unroll
        for (int tt = 0; tt < 4; ++tt) {
            const LAS unsigned char* Kb = lds + tt * KB; const LAS unsigned char* Vb = lds + (4 + tt) * KB;
            f32x16 p[NKH];
#pragma unroll
            for (int kh = 0; kh < NKH; ++kh)
#pragma unroll
                for (int r = 0; r < 16; ++r) p[kh][r] = 0.f;
#pragma unroll
            for (int ks = 0; ks < NKS; ++ks)
#pragma unroll
                for (int kh = 0; kh < NKH; ++kh) { const int row = 32 * kh + r32;
                    const bf16x8 a = *(const LAS bf16x8*)(Kb + row * (2 * D) + (((2 * ks + hi) ^ kswz<D>(row)) << 4));
                    p[kh] = __builtin_amdgcn_mfma_f32_32x32x16_bf16(a, qr[ks], p[kh], 0, 0, 0); }
            float mx = p[0][0];
#pragma unroll
            for (int kh = 0; kh < NKH; ++kh)
#pragma unroll
                for (int r = 0; r < 16; ++r) mx = fmaxf(mx, p[kh][r]);
            mx = fmaxf(mx, __shfl_xor(mx, 32));
            const float mnew = fmaxf(m, mx);
            if (__builtin_amdgcn_ballot_w64(mnew > m) != 0ull) { const float alpha = __builtin_amdgcn_exp2f(m - mnew); l *= alpha;
#pragma unroll
                for (int dh = 0; dh < NDH; ++dh)
#pragma unroll
                    for (int r = 0; r < 16; ++r) o[dh][r] *= alpha;
                m = mnew; }
            float ps = 0.f;
#pragma unroll
            for (int kh = 0; kh < NKH; ++kh)
#pragma unroll
                for (int r = 0; r < 16; ++r) { p[kh][r] = __builtin_amdgcn_exp2f(p[kh][r] - m); ps += p[kh][r]; }
            l += ps;
#pragma unroll
            for (int kh = 0; kh < NKH; ++kh)
#pragma unroll
                for (int s = 0; s < 2; ++s) {
                    const bf16x8 pb = pack8(p[kh], s);
#pragma unroll
                    for (int dh = 0; dh < NDH; ++dh) {
                        const int rowA = 32 * kh + 16 * s + 4 * hi + tq, rowB = rowA + 8, chv = 4 * dh + 2 * blk + (tp >> 1);
                        const s16x4 lo = vtr(Vb + rowA * (2 * D) + ((chv ^ vswz<D>(rowA)) << 4) + 8 * (tp & 1));
                        const s16x4 hh = vtr(Vb + rowB * (2 * D) + ((chv ^ vswz<D>(rowB)) << 4) + 8 * (tp & 1));
                        const bf16x8 va = (bf16x8){lo[0], lo[1], lo[2], lo[3], hh[0], hh[1], hh[2], hh[3]};
                        o[dh] = __builtin_amdgcn_mfma_f32_32x32x16_bf16(va, pb, o[dh], 0, 0, 0);
                    }
                }
        }
        l += __shfl_xor(l, 32);
        const float inv = 1.f / l;
        bf16_t* orow = Og + qrow * ld + h * D;
#pragma unroll
        for (int dh = 0; dh < NDH; ++dh)
#pragma unroll
            for (int g = 0; g < 4; ++g) { uint2 w; w.x = cvt_pk_bf16(o[dh][4 * g] * inv, o[dh][4 * g + 1] * inv); w.y = cvt_pk_bf16(o[dh][4 * g + 2] * inv, o[dh][4 * g + 3] * inv);
                *(uint2*)(orow + 32 * dh + 8 * g + 4 * hi) = w; }
    }
}

template <bool FIXM, int VAR>
__device__ __forceinline__ void moba_pair(Frame& F, const int qb, const int b0, const int h0, const int b1, const int h1,
                                          const bf16_t* MQ, const bf16_t* MK, const bf16_t* MV, bf16_t* OM, const float* KMEAN,
                                          const int convmode, const int cstep0, const float* w1, const float* w2, const float mref) {
    constexpr int D = 64, KB = 64 * D * 2, NKS = 4, NDH = 2, ld = 512;
    int tid = F.tid, lane = F.lane; asm volatile("" : "+v"(tid), "+v"(lane));
    const int wave = F.wave, uh = wave >> 2, w4 = wave & 3, utid = tid & 255;
    if (convmode && uh) {
        LAS float* scr = (LAS float*)(F.lds + 65536 + w4 * 16384);
        const int NTc = 4 * (qb + 1), slot0 = __builtin_amdgcn_readfirstlane(4 * cstep0 + w4);
        if (qb > 0) __syncthreads();
        f32x4 v0[8], v1[8], v2[8], v3[8];
#define CV_ISSUE(v, t) do { if ((t) < NTc) cv_load(v, slot0 + 4 * (t), w1, w2, lane); } while (0)
#define CV_RETIRE(v, t) cv_finish(v, slot0 + 4 * (t), F.ws, scr, lane)
#define CV_BAR do { asm volatile("" ::: "memory"); __builtin_amdgcn_s_barrier(); asm volatile("" ::: "memory"); } while (0)
        CV_ISSUE(v0, 0); CV_ISSUE(v1, 1); CV_ISSUE(v2, 2);
#pragma unroll 1
        for (int tt = 0; tt < NTc; tt += 4) {
            CV_BAR; CV_ISSUE(v3, tt + 3); CV_RETIRE(v0, tt);
            CV_BAR; CV_ISSUE(v0, tt + 4); CV_RETIRE(v1, tt + 1);
            CV_BAR; CV_ISSUE(v1, tt + 5); CV_RETIRE(v2, tt + 2);
            CV_BAR; CV_ISSUE(v2, tt + 6); CV_RETIRE(v3, tt + 3);
        }
        CV_BAR;
#undef CV_ISSUE
#undef CV_RETIRE
#undef CV_BAR
        return;
    }
    const int b = uh ? b1 : b0, h = uh ? h1 : h0;
    LAS unsigned char* lds = F.lds + uh * 65536;
    LAS float* kml = (LAS float*)(F.lds + LDSCTL_OFF + 2048 + uh * 4096);
    const bf16_t* Kg = MK + (size_t)b * SEQ * ld; const bf16_t* Vg = MV + (size_t)b * SEQ * ld;
    const float sl2 = exp2f(-(float)(h + 1)) * LOG2E;
    bf16x8 qr[2][NKS]; unsigned selmask[2] = {0u, 0u};
    {
        const int r32 = lane & 31, hi = lane >> 5;
#pragma unroll
        for (int g = 0; g < 2; ++g) { const size_t qrow = (size_t)b * SEQ + qb * 256 + w4 * 64 + 32 * g + r32;
#pragma unroll
            for (int ks = 0; ks < NKS; ++ks) qr[g][ks] = *(const bf16x8*)(MQ + qrow * ld + h * D + 16 * ks + 8 * hi); }
        if (qb > 0) {
            if (utid < qb * 16) *(LAS f32x4*)(kml + 4 * utid) = *(const f32x4*)(KMEAN + (((size_t)b * 16 + (utid >> 4)) * 8 + h) * 64 + 4 * (utid & 15));
            __syncthreads();
#pragma unroll
            for (int g = 0; g < 2; ++g) {
                float qf[NKS * 8];
#pragma unroll
                for (int ks = 0; ks < NKS; ++ks) { const pg8::u32x4 w = __builtin_bit_cast(pg8::u32x4, qr[g][ks]);
#pragma unroll
                    for (int j = 0; j < 4; ++j) { qf[ks * 8 + 2 * j] = bfl(w[j]); qf[ks * 8 + 2 * j + 1] = bfh(w[j]); } }
                float v0 = -INFINITY, v1 = -INFINITY, v2 = -INFINITY; int i0 = -1, i1 = -1, i2 = -1;
#pragma unroll 1
                for (int j = 0; j < qb; ++j) { const LAS float* km = kml + 64 * j + 8 * hi; float s = 0.f;
#pragma unroll
                    for (int ks = 0; ks < NKS; ++ks) { const f32x4 k0 = *(const LAS f32x4*)(km + 16 * ks), k1 = *(const LAS f32x4*)(km + 16 * ks + 4);
                        s += qf[ks * 8 + 0] * k0[0] + qf[ks * 8 + 1] * k0[1] + qf[ks * 8 + 2] * k0[2] + qf[ks * 8 + 3] * k0[3] + qf[ks * 8 + 4] * k1[0] + qf[ks * 8 + 5] * k1[1] + qf[ks * 8 + 6] * k1[2] + qf[ks * 8 + 7] * k1[3]; }
                    s += __shfl_xor(s, 32);
                    const bool c0 = s > v0, c1 = s > v1, c2 = s > v2;
                    v2 = c1 ? v1 : (c2 ? s : v2); i2 = c1 ? i1 : (c2 ? j : i2);
                    v1 = c0 ? v0 : (c1 ? s : v1); i1 = c0 ? i0 : (c1 ? j : i1);
                    v0 = c0 ? s : v0; i0 = c0 ? j : i0; }
                selmask[g] = (i0 >= 0 ? (1u << i0) : 0u) | (i1 >= 0 ? (1u << i1) : 0u) | (i2 >= 0 ? (1u << i2) : 0u);
            }
        }
    }
    const int NT = 4 * (qb + 1);
#define MP_STAGE(tt, buf) do { const int kb_ = tile_kbase<true, 64>(tt, qb); _Pragma("unroll") for (int i_ = 0; i_ < 2; ++i_) { const int ci_ = utid + 256 * i_, row_ = ci_ >> 3, cp_ = ci_ & 7; \
        const size_t gk_ = (size_t)(kb_ + row_) * ld + h * D + 8 * (cp_ ^ kswz<64>(row_)), gv_ = (size_t)(kb_ + row_) * ld + h * D + 8 * (cp_ ^ vswz<64>(row_)); \
        __builtin_amdgcn_global_load_lds((const unsigned*)(Kg + gk_), (LAS unsigned*)(lds + (2 * (buf)) * KB + (w4 * 64 + 256 * i_) * 16), 16, 0, 0); \
        __builtin_amdgcn_global_load_lds((const unsigned*)(Vg + gv_), (LAS unsigned*)(lds + (2 * (buf) + 1) * KB + (w4 * 64 + 256 * i_) * 16), 16, 0, 0); } } while (0)
    MP_STAGE(0, 0); if (NT > 1) MP_STAGE(1, 1); if (NT > 2) MP_STAGE(2, 2);
    float m[2] = {-1e30f, -1e30f}, l[2] = {0.f, 0.f};
    float cq[2], a4[4];
#pragma unroll
    for (int g = 0; g < 2; ++g) cq[g] = -(mref + sl2 * (float)(w4 * 64 + 32 * g + (lane & 31)));
#pragma unroll
    for (int i = 0; i < 4; ++i) a4[i] = sl2 * (float)i;
    const float slh = __uint_as_float(cvt_pk_bf16(sl2, sl2) & 0xffff0000u), sll = sl2 - slh;
    bf16x8 akk[2];
#pragma unroll
    for (int kh = 0; kh < 2; ++kh) { const float rw = (float)(32 * kh + (lane & 31)); pg8::u32x4 aw; const bool up = (lane >> 5) != 0;
        aw[0] = up ? 0u : cvt_pk_bf16(rw, 1.f); aw[1] = up ? 0u : cvt_pk_bf16(1.f, rw); aw[2] = 0u; aw[3] = 0u; akk[kh] = __builtin_bit_cast(bf16x8, aw); }
    f32x16 o[2][NDH];
#pragma unroll
    for (int g = 0; g < 2; ++g)
#pragma unroll
        for (int dh = 0; dh < NDH; ++dh)
#pragma unroll
            for (int r = 0; r < 16; ++r) o[g][dh][r] = 0.f;
    for (int tt = 0; tt < NT; ++tt) {
        int lane_t = lane; asm volatile("" : "+v"(lane_t));
        const int r32 = lane_t & 31, hi = lane_t >> 5, i16 = lane_t & 15, blk = (lane_t >> 4) & 1, tq = i16 >> 2, tp = i16 & 3;
        const int buf = tt & 3;
        { const int ahead = NT - 1 - tt;
          if (ahead >= 2) asm volatile("s_waitcnt vmcnt(8)" ::: "memory"); else if (ahead == 1) asm volatile("s_waitcnt vmcnt(4)" ::: "memory"); else asm volatile("s_waitcnt vmcnt(0)" ::: "memory"); }
        asm volatile("s_waitcnt lgkmcnt(0)" ::: "memory"); if (VAR != 4) __builtin_amdgcn_s_barrier(); asm volatile("" ::: "memory");
        if (tt + 3 < NT) MP_STAGE(tt + 3, (tt + 3) & 3);
        bool act[2]; bool lane_sel[2];
#pragma unroll
        for (int g = 0; g < 2; ++g) { lane_sel[g] = true;
            if (tt >= 4) { lane_sel[g] = (selmask[g] >> ((tt - 4) >> 2)) & 1u; act[g] = __builtin_amdgcn_ballot_w64(lane_sel[g]) != 0ull; }
            else act[g] = (64 * tt <= w4 * 64 + 32 * g + 31); }
        if (act[0] || act[1]) {
            const LAS unsigned char* Kb = lds + (2 * buf) * KB; const LAS unsigned char* Vb = lds + (2 * buf + 1) * KB;
            const int kb = tile_kbase<true, 64>(tt, qb); const float offl = sl2 * (float)(kb - qb * 256 + 4 * hi);
            bf16x8 pb[2][4];
            if (FIXM && VAR == 0) {
                f32x16 pp[2][2];
                const float cbt = sl2 * (float)(kb - qb * 256);
#pragma unroll
                for (int g = 0; g < 2; ++g) {
                    const float cbv = lane_sel[g] ? cbt + cq[g] : -INFINITY;
                    const unsigned u0 = cvt_pk_bf16(slh, cbv); const float cbh = __uint_as_float(u0 & 0xffff0000u);
                    const unsigned u1 = cvt_pk_bf16(lane_sel[g] ? cbv - cbh : 0.f, sll);
                    pg8::u32x4 bw; bw[0] = hi ? 0u : u0; bw[1] = hi ? 0u : u1; bw[2] = 0u; bw[3] = 0u;
                    const bf16x8 bfrag = __builtin_bit_cast(bf16x8, bw);
#pragma unroll
                    for (int kh = 0; kh < 2; ++kh) { const f32x16 z = {0.f, 0.f, 0.f, 0.f, 0.f, 0.f, 0.f, 0.f, 0.f, 0.f, 0.f, 0.f, 0.f, 0.f, 0.f, 0.f};
                        pp[g][kh] = __builtin_amdgcn_mfma_f32_32x32x16_bf16(akk[kh], bfrag, z, 0, 0, 0); } }
#pragma unroll
                for (int ks = 0; ks < NKS; ++ks)
#pragma unroll
                    for (int kh = 0; kh < 2; ++kh) { const int row = 32 * kh + r32;
                        const bf16x8 a = *(const LAS bf16x8*)(Kb + row * 128 + (((2 * ks + hi) ^ kswz<64>(row)) << 4));
                        pp[0][kh] = __builtin_amdgcn_mfma_f32_32x32x16_bf16(a, qr[0][ks], pp[0][kh], 0, 0, 0);
                        pp[1][kh] = __builtin_amdgcn_mfma_f32_32x32x16_bf16(a, qr[1][ks], pp[1][kh], 0, 0, 0); }
                if (tt == w4) {
#pragma unroll
                    for (int g = 0; g < 2; ++g) { const int qrel = 32 * g + r32, k0 = 4 * hi;
#pragma unroll
                        for (int kh = 0; kh < 2; ++kh)
#pragma unroll
                            for (int r = 0; r < 16; ++r) { const int kv = k0 + 32 * kh + (r & 3) + 8 * (r >> 2); if (kv > qrel) pp[g][kh][r] = -INFINITY; } } }
#pragma unroll
                for (int kh = 0; kh < 2; ++kh)
#pragma unroll
                    for (int s = 0; s < 2; ++s) {
                        bf16x8 pq[2];
#pragma unroll
                        for (int g = 0; g < 2; ++g) { float e8[8];
#pragma unroll
                            for (int j = 0; j < 8; ++j) e8[j] = __builtin_amdgcn_exp2f(pp[g][kh][8 * s + j]);
                            l[g] += ((e8[0] + e8[1]) + (e8[2] + e8[3])) + ((e8[4] + e8[5]) + (e8[6] + e8[7]));
                            pg8::u32x4 w; w[0] = cvt_pk_bf16(e8[0], e8[1]); w[1] = cvt_pk_bf16(e8[2], e8[3]); w[2] = cvt_pk_bf16(e8[4], e8[5]); w[3] = cvt_pk_bf16(e8[6], e8[7]);
                            pq[g] = __builtin_bit_cast(bf16x8, w); }
#pragma unroll
                        for (int dh = 0; dh < NDH; ++dh) {
                            const int rowA = 32 * kh + 16 * s + 4 * hi + tq, rowB = rowA + 8, chv = 4 * dh + 2 * blk + (tp >> 1);
                            const s16x4 lo = vtr(Vb + rowA * 128 + ((chv ^ vswz<64>(rowA)) << 4) + 8 * (tp & 1));
                            const s16x4 hh = vtr(Vb + rowB * 128 + ((chv ^ vswz<64>(rowB)) << 4) + 8 * (tp & 1));
                            const bf16x8 va = (bf16x8){lo[0], lo[1], lo[2], lo[3], hh[0], hh[1], hh[2], hh[3]};
#pragma unroll
                            for (int g = 0; g < 2; ++g) o[g][dh] = __builtin_amdgcn_mfma_f32_32x32x16_bf16(va, pq[g], o[g][dh], 0, 0, 0);
                        }
                    }
            } else
#pragma unroll
            for (int g = 0; g < 2; ++g) {
                if (act[g]) {
                    f32x16 p[2];
                    if (FIXM) { const float cb = offl + cq[g]; float bq[2][4];
#pragma unroll
                        for (int kh = 0; kh < 2; ++kh)
#pragma unroll
                            for (int j = 0; j < 4; ++j) bq[kh][j] = fmaf(sl2, (float)(32 * kh + 8 * j), cb);
#pragma unroll
                        for (int kh = 0; kh < 2; ++kh)
#pragma unroll
                            for (int r = 0; r < 16; ++r) p[kh][r] = a4[r & 3] + bq[kh][r >> 2];
                    } else {
#pragma unroll
                        for (int kh = 0; kh < 2; ++kh)
#pragma unroll
                            for (int r = 0; r < 16; ++r) p[kh][r] = sl2 * (float)(32 * kh + (r & 3) + 8 * (r >> 2));
                    }
                    if (VAR != 3) {
#pragma unroll
                    for (int ks = 0; ks < NKS; ++ks)
#pragma unroll
                        for (int kh = 0; kh < 2; ++kh) { const int row = 32 * kh + r32;
                            const bf16x8 a = *(const LAS bf16x8*)(Kb + row * 128 + (((2 * ks + hi) ^ kswz<64>(row)) << 4));
                            p[kh] = __builtin_amdgcn_mfma_f32_32x32x16_bf16(a, qr[g][ks], p[kh], 0, 0, 0); }
                    }
                    if (tt < 4) { const int qrel = w4 * 64 + 32 * g + r32, k0 = 64 * tt + 4 * hi;
#pragma unroll
                        for (int kh = 0; kh < 2; ++kh)
#pragma unroll
                            for (int r = 0; r < 16; ++r) { const int kv = k0 + 32 * kh + (r & 3) + 8 * (r >> 2); if (kv > qrel) p[kh][r] = -INFINITY; }
                    } else if (!lane_sel[g]) {
#pragma unroll
                        for (int kh = 0; kh < 2; ++kh)
#pragma unroll
                            for (int r = 0; r < 16; ++r) p[kh][r] = -INFINITY;
                    }
                    if (!FIXM) {
                    float mx = p[0][0];
#pragma unroll
                    for (int kh = 0; kh < 2; ++kh)
#pragma unroll
                        for (int r = 0; r < 16; ++r) mx = fmaxf(mx, p[kh][r]);
                    mx += offl; mx = fmaxf(mx, __shfl_xor(mx, 32));
                    const float mnew = fmaxf(m[g], mx);
                    if (__builtin_amdgcn_ballot_w64(mnew > m[g]) != 0ull) { const float alpha = __builtin_amdgcn_exp2f(m[g] - mnew); l[g] *= alpha;
#pragma unroll
                        for (int dh = 0; dh < NDH; ++dh)
#pragma unroll
                            for (int r = 0; r < 16; ++r) o[g][dh][r] *= alpha;
                        m[g] = mnew; }
                    const float mt = m[g] - offl;
                    p[0] = p[0] - mt; p[1] = p[1] - mt;
                    }
                    if (VAR != 2) {
#pragma unroll
                    for (int kh = 0; kh < 2; ++kh)
#pragma unroll
                        for (int r = 0; r < 16; ++r) p[kh][r] = __builtin_amdgcn_exp2f(p[kh][r]);
                    }
                    if (VAR == 2) l[g] += p[0][0]; else
                    { const f32x16 s16 = p[0] + p[1]; const f32x8 s8 = s16.lo + s16.hi; const f32x4 s4 = s8.lo + s8.hi; const f32x2 s2 = s4.lo + s4.hi; l[g] += s2.x + s2.y; }
#pragma unroll
                    for (int kh = 0; kh < 2; ++kh)
#pragma unroll
                        for (int s = 0; s < 2; ++s) pb[g][2 * kh + s] = pack8(p[kh], s);
                } else {
#pragma unroll
                    for (int q = 0; q < 4; ++q) pb[g][q] = (bf16x8){0, 0, 0, 0, 0, 0, 0, 0};
                }
            }
            if (FIXM && VAR == 0) { } else
            if (VAR == 1) { unsigned x = 0;
#pragma unroll
                for (int g = 0; g < 2; ++g)
#pragma unroll
                    for (int q = 0; q < 4; ++q) { const pg8::u32x4 w = __builtin_bit_cast(pg8::u32x4, pb[g][q]); x ^= w[0] ^ w[1] ^ w[2] ^ w[3]; }
                o[0][0][0] += __uint_as_float(x & 0x3fffffffu); } else
#pragma unroll
            for (int kh = 0; kh < 2; ++kh)
#pragma unroll
                for (int s = 0; s < 2; ++s)
#pragma unroll
                    for (int dh = 0; dh < NDH; ++dh) {
                        const int rowA = 32 * kh + 16 * s + 4 * hi + tq, rowB = rowA + 8, chv = 4 * dh + 2 * blk + (tp >> 1);
                        const s16x4 lo = vtr(Vb + rowA * 128 + ((chv ^ vswz<64>(rowA)) << 4) + 8 * (tp & 1));
                        const s16x4 hh = vtr(Vb + rowB * 128 + ((chv ^ vswz<64>(rowB)) << 4) + 8 * (tp & 1));
                        const bf16x8 va = (bf16x8){lo[0], lo[1], lo[2], lo[3], hh[0], hh[1], hh[2], hh[3]};
#pragma unroll
                        for (int g = 0; g < 2; ++g) o[g][dh] = __builtin_amdgcn_mfma_f32_32x32x16_bf16(va, pb[g][2 * kh + s], o[g][dh], 0, 0, 0);
                    }
        }
    }
    asm volatile("s_waitcnt lgkmcnt(0)" ::: "memory"); __builtin_amdgcn_s_barrier(); asm volatile("" ::: "memory");
    { const int r32 = lane & 31, hi = lane >> 5;
#pragma unroll
      for (int g = 0; g < 2; ++g) { float lt = l[g]; lt += __shfl_xor(lt, 32); const float inv = 1.f / lt;
          bf16_t* orow = OM + ((size_t)b * SEQ + qb * 256 + w4 * 64 + 32 * g + r32) * ld + h * D;
#pragma unroll
          for (int dh = 0; dh < NDH; ++dh)
#pragma unroll
              for (int q = 0; q < 4; ++q) { uint2 w; w.x = cvt_pk_bf16(o[g][dh][4 * q] * inv, o[g][dh][4 * q + 1] * inv); w.y = cvt_pk_bf16(o[g][dh][4 * q + 2] * inv, o[g][dh][4 * q + 3] * inv);
                  *(uint2*)(orow + 32 * dh + 8 * q + 4 * hi) = w; } } }
#undef MP_STAGE
}
}
namespace ret {
using att::f32x16; using att::s16x4; using att::vtr; using att::pack8; using att::kswz; using att::vswz; using att::crow; using pg8::bf16x8;
constexpr int L_KT = 0, L_KD = 16384, L_VT = 32768, L_SB = 65536, L_SS = 98304, L_G = 99328;
__device__ __forceinline__ void retention_item(Frame& F, const int b, const int h, const float* g_ret_out, const int c0, const int c1) {
    const bf16_t* RQ = (const bf16_t*)(F.ws + WS_RQ); const bf16_t* RK = (const bf16_t*)(F.ws + WS_RK); const bf16_t* RV = (const bf16_t*)(F.ws + WS_RV); const bf16_t* RG = (const bf16_t*)(F.ws + WS_RG); bf16_t* ORET = (bf16_t*)(F.ws + WS_ORET);
    int tid = F.tid, lane = F.lane; asm volatile("" : "+v"(tid), "+v"(lane));
    const int wave = F.wave;
    LAS unsigned char* lds = F.lds;
    const float lg2_o = log2f(1.f - exp2f(-5.f - (float)h)), g128 = exp2f(128.f * lg2_o);
    const size_t tok0 = (size_t)b * SEQ;
    v4u kreg[2], vreg[4];
#define RET_LOAD(n) do { _Pragma("unroll") for (int i_ = 0; i_ < 2; ++i_) { const int ci_ = tid + 512 * i_; kreg[i_] = *(const v4u*)(RK + (tok0 + (n) * 128 + (ci_ >> 3)) * 256 + h * 64 + 8 * (ci_ & 7)); } \
        _Pragma("unroll") for (int i_ = 0; i_ < 4; ++i_) { const int ci_ = tid + 512 * i_; vreg[i_] = *(const v4u*)(RV + (tok0 + (n) * 128 + (ci_ >> 4)) * 512 + h * 128 + 8 * (ci_ & 15)); } } while (0)
#define RET_WRITE() do { _Pragma("unroll") for (int i_ = 0; i_ < 2; ++i_) { const int ci_ = tid + 512 * i_, row_ = ci_ >> 3, ch_ = ci_ & 7; const v4u k_ = kreg[i_]; \
            *(LAS v4u*)(lds + L_KT + row_ * 128 + ((ch_ ^ kswz<64>(row_)) << 4)) = k_; const float dk_ = __builtin_amdgcn_exp2f(lg2 * (float)(127 - row_)); v4u d_; \
            d_.x = cvt_pk_bf16(att::bfl(k_.x) * dk_, att::bfh(k_.x) * dk_); d_.y = cvt_pk_bf16(att::bfl(k_.y) * dk_, att::bfh(k_.y) * dk_); d_.z = cvt_pk_bf16(att::bfl(k_.z) * dk_, att::bfh(k_.z) * dk_); d_.w = cvt_pk_bf16(att::bfl(k_.w) * dk_, att::bfh(k_.w) * dk_); \
            *(LAS v4u*)(lds + L_KD + row_ * 128 + ((ch_ ^ vswz<64>(row_)) << 4)) = d_; } \
        _Pragma("unroll") for (int i_ = 0; i_ < 4; ++i_) { const int ci_ = tid + 512 * i_, row_ = ci_ >> 4, ch_ = ci_ & 15; *(LAS v4u*)(lds + L_VT + row_ * 256 + ((ch_ ^ vswz<128>(row_)) << 4)) = vreg[i_]; } } while (0)
    { const float lg2 = lg2_o; RET_LOAD(0); RET_WRITE(); }
    { const v4u z = {0u, 0u, 0u, 0u}; *(LAS v4u*)(lds + L_SB + tid * 32) = z; *(LAS v4u*)(lds + L_SB + tid * 32 + 16) = z; }
    f32x16 st;
#pragma unroll
    for (int r = 0; r < 16; ++r) st[r] = 0.f;
    const int ib = wave & 3, e2 = wave >> 2;
    LAS float* ssb = (LAS float*)(lds + L_SS);
    if (tid < 128) ((LAS float*)(lds + L_G))[tid] = g_ret_out[tid];
    bf16x8 qn[4];
    { const size_t tr0 = tok0 + (size_t)c0 * 128 + 32 * ib + (lane & 31);
#pragma unroll
      for (int ks = 0; ks < 4; ++ks) qn[ks] = *(const bf16x8*)(RQ + tr0 * 256 + h * 64 + 16 * ks + 8 * (lane >> 5)); }
    __syncthreads();
    for (int n = 0; n < c1; ++n) {
        const bool outp = n >= c0;
        int lane_n = lane; float lg2 = lg2_o; asm volatile("" : "+v"(lane_n), "+v"(lg2));
        const int r32 = lane_n & 31, hi = lane_n >> 5, i16 = lane_n & 15, blk = (lane_n >> 4) & 1, tq = i16 >> 2, tp = i16 & 3;
        if (n + 1 < c1) RET_LOAD(n + 1);
        const LAS unsigned char* Sb = lds + L_SB + (n & 1) * 16384; LAS unsigned char* Sn = lds + L_SB + ((n + 1) & 1) * 16384;
        const size_t tokrow = tok0 + n * 128 + 32 * ib + r32;
        f32x16 o[2]; uint2 rgv[8];
#pragma unroll
        for (int q2 = 0; q2 < 2; ++q2)
#pragma unroll
            for (int r = 0; r < 16; ++r) o[q2][r] = 0.f;
#pragma unroll
        for (int q = 0; q < 8; ++q) rgv[q] = make_uint2(0u, 0u);
        if (outp) {
#pragma unroll
        for (int q2 = 0; q2 < 2; ++q2)
#pragma unroll
            for (int g = 0; g < 4; ++g) rgv[q2 * 4 + g] = *(const uint2*)(RG + tokrow * 512 + h * 128 + 64 * e2 + 32 * q2 + 8 * g + 4 * hi);
        {
            bf16x8 qr[4];
#pragma unroll
            for (int ks = 0; ks < 4; ++ks) qr[ks] = qn[ks];
            if (n + 1 < c1) {
#pragma unroll
                for (int ks = 0; ks < 4; ++ks) qn[ks] = *(const bf16x8*)(RQ + (tokrow + 128) * 256 + h * 64 + 16 * ks + 8 * hi); }
#pragma unroll
            for (int q2 = 0; q2 < 2; ++q2) {
#pragma unroll
                for (int r = 0; r < 16; ++r) o[q2][r] = 0.f;
                const int e = 64 * e2 + 32 * q2 + r32;
#pragma unroll
                for (int ks = 0; ks < 4; ++ks) { const bf16x8 a = *(const LAS bf16x8*)(Sb + e * 128 + (((2 * ks + hi) ^ kswz<64>(e)) << 4)); o[q2] = __builtin_amdgcn_mfma_f32_32x32x16_bf16(a, qr[ks], o[q2], 0, 0, 0); } }
            const float gq = __builtin_amdgcn_exp2f(lg2 * (float)(32 * ib + r32 + 1));
#pragma unroll
            for (int q2 = 0; q2 < 2; ++q2)
#pragma unroll
                for (int r = 0; r < 16; ++r) o[q2][r] *= gq;
            __builtin_amdgcn_sched_barrier(0);
#pragma unroll 1
            for (int jb = 0; jb <= ib; ++jb) {
                f32x16 p;
#pragma unroll
                for (int r = 0; r < 16; ++r) p[r] = 0.f;
                const int krow_ = 32 * jb + r32;
#pragma unroll
                for (int ks = 0; ks < 4; ++ks) { const bf16x8 a = *(const LAS bf16x8*)(lds + L_KT + krow_ * 128 + (((2 * ks + hi) ^ kswz<64>(krow_)) << 4)); p = __builtin_amdgcn_mfma_f32_32x32x16_bf16(a, qr[ks], p, 0, 0, 0); }
                const float cl = __builtin_amdgcn_exp2f(lg2 * (float)(32 * (ib - jb) + r32 - 4 * hi));
                const bool diag = (jb == ib);
#pragma unroll
                for (int r = 0; r < 16; ++r) { float v = p[r] * (cl * __builtin_amdgcn_exp2f(-lg2 * (float)((r & 3) + 8 * (r >> 2)))); if (diag && ((r & 3) + 8 * (r >> 2) + 4 * hi) > r32) v = 0.f; p[r] = v; }
#pragma unroll
                for (int s = 0; s < 2; ++s) { const bf16x8 pb = pack8(p, s);
                    const int rowA = 32 * jb + 16 * s + 4 * hi + tq, rowB = rowA + 8;
#pragma unroll
                    for (int q2 = 0; q2 < 2; ++q2) { const int chv = 4 * (2 * e2 + q2) + 2 * blk + (tp >> 1);
                        const s16x4 lo = vtr(lds + L_VT + rowA * 256 + ((chv ^ vswz<128>(rowA)) << 4) + 8 * (tp & 1));
                        const s16x4 hh = vtr(lds + L_VT + rowB * 256 + ((chv ^ vswz<128>(rowB)) << 4) + 8 * (tp & 1));
                        const bf16x8 va = (bf16x8){lo[0], lo[1], lo[2], lo[3], hh[0], hh[1], hh[2], hh[3]};
                        o[q2] = __builtin_amdgcn_mfma_f32_32x32x16_bf16(va, pb, o[q2], 0, 0, 0); }
                    __builtin_amdgcn_sched_barrier(0); }
            }
        }
        __builtin_amdgcn_sched_barrier(0);
        { float ss = 0.f;
#pragma unroll
            for (int q2 = 0; q2 < 2; ++q2)
#pragma unroll
                for (int r = 0; r < 16; ++r) ss += o[q2][r] * o[q2][r];
            ss += __shfl_xor(ss, 32);
            if (hi == 0) ssb[e2 * 128 + 32 * ib + r32] = ss; }
        }
        __builtin_amdgcn_sched_barrier(0);
        { const int eh = wave & 3, dh = wave >> 2;
#pragma unroll
            for (int r = 0; r < 16; ++r) st[r] *= g128;
#pragma unroll 1
            for (int kst = 0; kst < 8; ++kst) { const int rowA = 16 * kst + 4 * hi + tq, rowB = rowA + 8, chv = 4 * eh + 2 * blk + (tp >> 1), chk = 4 * dh + 2 * blk + (tp >> 1);
                const s16x4 lo = vtr(lds + L_VT + rowA * 256 + ((chv ^ vswz<128>(rowA)) << 4) + 8 * (tp & 1));
                const s16x4 hh = vtr(lds + L_VT + rowB * 256 + ((chv ^ vswz<128>(rowB)) << 4) + 8 * (tp & 1));
                const s16x4 kl = vtr(lds + L_KD + rowA * 128 + ((chk ^ vswz<64>(rowA)) << 4) + 8 * (tp & 1));
                const s16x4 kh = vtr(lds + L_KD + rowB * 128 + ((chk ^ vswz<64>(rowB)) << 4) + 8 * (tp & 1));
                const bf16x8 va = (bf16x8){lo[0], lo[1], lo[2], lo[3], hh[0], hh[1], hh[2], hh[3]};
                const bf16x8 kb = (bf16x8){kl[0], kl[1], kl[2], kl[3], kh[0], kh[1], kh[2], kh[3]};
                st = __builtin_amdgcn_mfma_f32_32x32x16_bf16(va, kb, st, 0, 0, 0); }
#pragma unroll
            for (int r = 0; r < 16; ++r) { const int e = 32 * eh + (r & 3) + 8 * (r >> 2) + 4 * hi, dd = 32 * dh + r32;
                *(LAS bf16_t*)(Sn + e * 128 + ((((dd >> 3) ^ kswz<64>(e))) << 4) + (dd & 7) * 2) = f2bf(st[r]); } }
        __builtin_amdgcn_sched_barrier(0);
        __syncthreads();
        if (outp) { const float rn = 1.f / sqrtf((ssb[32 * ib + r32] + ssb[128 + 32 * ib + r32]) * (1.f / 128.f) + 1e-5f);
#pragma unroll
            for (int q2 = 0; q2 < 2; ++q2)
#pragma unroll
                for (int g = 0; g < 4; ++g) { const int e = 64 * e2 + 32 * q2 + 8 * g + 4 * hi; const f32x4 gg = *(const LAS f32x4*)(lds + L_G + 4 * e); const uint2 rg = rgv[q2 * 4 + g];
                    uint2 w; w.x = cvt_pk_bf16(o[q2][4 * g] * rn * gg[0] * att::bfl(rg.x), o[q2][4 * g + 1] * rn * gg[1] * att::bfh(rg.x)); w.y = cvt_pk_bf16(o[q2][4 * g + 2] * rn * gg[2] * att::bfl(rg.y), o[q2][4 * g + 3] * rn * gg[3] * att::bfh(rg.y));
                    *(uint2*)(ORET + tokrow * 512 + h * 128 + e) = w; } }
        if (n + 1 < c1) RET_WRITE();
        __syncthreads();
    }
#undef RET_LOAD
#undef RET_WRITE
}
}
constexpr int P1_SPARE = 0, P1_CONV = 0;
__device__ __forceinline__ int p1_fill_count(int G) { const int rem = 1680 % G; return rem ? ((G - rem) & ~1) : 0; }
__device__ __forceinline__ void conv_item(Frame& F, const int c, const float* w1, const float* w2) {
            LAS float* scr = (LAS float*)(F.lds + RING_OFF + F.wave * 16384);
            const bool isw1 = c < 512; const int cc = isw1 ? c : c - 512, e = cc >> 4, kb = cc & 15, nblk = isw1 ? 64 : 32, N = isw1 ? 2048 : 1024;
            const float* Wsrc = isw1 ? w1 + (size_t)e * 1024 * 2048 : w2 + (size_t)e * 1024 * 1024;
            bf16* WT = isw1 ? (bf16*)(F.ws + WS_W1) + (size_t)e * 2048 * 1024 : (bf16*)(F.ws + WS_W2) + (size_t)e * 1024 * 1024;
            float wa[32], wb[32];
            xp_load(wa, Wsrc, N, nblk, kb * nblk + F.wave, F.lane);
#pragma unroll 1
            for (int nb = F.wave; nb < nblk; nb += 16) {
                xp_load(wb, Wsrc, N, nblk, kb * nblk + nb + 8, F.lane);
                xp_finish(wa, 1024, nblk, WT, scr, kb * nblk + nb, F.lane);
                if (nb + 16 < nblk) xp_load(wa, Wsrc, N, nblk, kb * nblk + nb + 16, F.lane);
                xp_finish(wb, 1024, nblk, WT, scr, kb * nblk + nb + 8, F.lane);
            }
}
__device__ __forceinline__ void conv_pair(Frame& F, const int c, const float* w1, const float* w2) {
            if (c + 1 < p1_fill_count(F.G)) return;
            LAS float* scr = (LAS float*)(F.lds + RING_OFF + F.wave * 16384);
            const bool isw1 = c < 512; const int cc = isw1 ? c : c - 512, e = cc >> 4, kb = cc & 15, nblk = isw1 ? 64 : 32, N = isw1 ? 2048 : 1024, sh = isw1 ? 3 : 2, T = 2 << sh;
            const float* Wsrc = isw1 ? w1 + (size_t)e * 1024 * 2048 : w2 + (size_t)e * 1024 * 1024;
            bf16* WT = isw1 ? (bf16*)(F.ws + WS_W1) + (size_t)e * 2048 * 1024 : (bf16*)(F.ws + WS_W2) + (size_t)e * 1024 * 1024;
            float wa[32], wb[32];
#define CP_IDX(k) ((kb + ((k) >> sh)) * nblk + F.wave + 8 * ((k) & ((1 << sh) - 1)))
            xp_load(wa, Wsrc, N, nblk, CP_IDX(0), F.lane);
#pragma unroll 1
            for (int k = 0; k < T; k += 2) {
                xp_load(wb, Wsrc, N, nblk, CP_IDX(k + 1), F.lane);
                xp_finish(wa, 1024, nblk, WT, scr, CP_IDX(k), F.lane);
                if (k + 2 < T) xp_load(wa, Wsrc, N, nblk, CP_IDX(k + 2), F.lane);
                xp_finish(wb, 1024, nblk, WT, scr, CP_IDX(k + 1), F.lane);
            }
#undef CP_IDX
}
constexpr int CW_QUEUE = 128;
constexpr int RET_SEGS = 4, RET_ITEMS = 16 * RET_SEGS;
__device__ __forceinline__ float moba_mref(Frame& F) {
    const float* gt = (const float*)(F.ws + WS_GTAB); float v = fabsf(gt[F.lane] * gt[64 + F.lane]);
#pragma unroll
    for (int o = 1; o < 64; o <<= 1) v = fmaxf(v, __shfl_xor(v, o));
    return 1.04f * 0.18033688f * 64.f * v + 0.25f;
}
template <int VAR>
__device__ __forceinline__ void p2_mixers(Frame& F, const float* g_ret_out, const float* g_mem_q, const float* g_mem_k, const float* w1, const float* w2, const int qword, const int qlo, const int qhi, const int tmask, const float mref) {
    volatile LAS int* slot = (volatile LAS int*)(F.lds + TB_OFF + 512);
    const bf16_t* MQ = (const bf16_t*)(F.ws + WS_MQ); const bf16_t* MK = (const bf16_t*)(F.ws + WS_MK); const bf16_t* MV = (const bf16_t*)(F.ws + WS_MV); bf16_t* OMO = (bf16_t*)(F.ws + (VAR ? WS_ACT : WS_OMOBA));
    const bf16_t* CQ = (const bf16_t*)(F.ws + WS_CQ); const bf16_t* MEMK = (const bf16_t*)(F.ws + WS_MEMK); const bf16_t* MEMV = (const bf16_t*)(F.ws + WS_MEMV); bf16_t* OME = (bf16_t*)(F.ws + WS_OMEM);
    const bool fixm = mref < 40.f;
    bool first = true;
    for (;;) {
        int it;
        if (first) { first = false; it = F.vcu + qlo; __syncthreads(); }
        else {
            __syncthreads();
            if (F.tid == 0) slot[0] = (int)__hip_atomic_fetch_add((unsigned*)F.ctl + qword, 1u, __ATOMIC_RELAXED, __HIP_MEMORY_SCOPE_AGENT);
            __syncthreads();
            it = slot[0] + F.G + qlo;
        }
        if (it >= qhi) break;
        if (it < RET_ITEMS) { if (tmask & 1) { const int seg = RET_SEGS - 1 - (it >> 4), bh = it & 15; ret::retention_item(F, bh >> 2, bh & 3, g_ret_out, (32 / RET_SEGS) * seg, (32 / RET_SEGS) * (seg + 1)); } continue; }
        const int j = it - RET_ITEMS, sg = j / 14, rj = j - 14 * sg, ismem = (rj == 0 || rj == 7), idx = rj - 1 - (rj > 7 ? 1 : 0), tri = ismem ? 0 : idx % 3, grp = ismem ? 2 * sg + (rj == 7 ? 1 : 0) : 4 * sg + idx / 3, pos = ismem ? 3 : tri;
        if (pos == 1) { if (!(tmask & 2)) continue;
            const int qb = 15 - (grp >> 4), bh0 = grp & 15, bh1 = bh0 + 16;
            if (fixm) att::moba_pair<true, VAR>(F, qb, bh0 >> 3, bh0 & 7, bh1 >> 3, bh1 & 7, MQ, MK, MV, OMO, (const float*)(F.ctl + CW_KMEAN), 0, 0, w1, w2, mref);
            else att::moba_pair<false, 0>(F, qb, bh0 >> 3, bh0 & 7, bh1 >> 3, bh1 & 7, MQ, MK, MV, OMO, (const float*)(F.ctl + CW_KMEAN), 0, 0, w1, w2, 0.f); }
        else if (pos == 3) { if (!(tmask & 4)) continue;
            const int u = grp, bh = u >> 3, qb0 = 2 * (u & 7), b = bh >> 2, h = bh & 3;
            att::mem_attn_group(F, b, h, qb0, 2, CQ, MEMK + (size_t)b * MEMLEN * 512, MEMV + (size_t)b * MEMLEN * 512, OME, (const float*)(F.ctl + CW_MEMKSS) + (size_t)b * MEMLEN * 4, g_mem_q, g_mem_k); }
        else { if (!(tmask & 8)) continue; const int c = 4 * grp + pos; conv_pair(F, c, w1, w2); }
    }
}
constexpr int N_PHASES = 9;
#ifndef PROBE_MASK
#define PROBE_MASK 0
#endif
constexpr int P2_NITEMS = RET_ITEMS + 14 * 64;
#ifndef P2_LO
#define P2_LO 0
#define P2_HI P2_NITEMS
#endif
#ifndef P2_VAR
#define P2_VAR 0
#endif
#ifndef P2_TMASK
#define P2_TMASK 15
#endif
#define NREP(k) ((((PROBE_MASK) >> (k)) & 1) ? 2 : 1)
__global__ void __launch_bounds__(NWAVES * 64, 2) mega(Args args) {
    extern __shared__ __attribute__((aligned(16))) unsigned char lds[];
    Frame F;
    F.lds = (LAS unsigned char*)lds; F.MISC = (volatile LAS unsigned*)(F.lds + MISC_OFF);
    F.tid = threadIdx.x; F.lane = F.tid & 63; F.wave = __builtin_amdgcn_readfirstlane(F.tid >> 6);
    F.G = gridDim.x; { const int bx = blockIdx.x; F.vcu = (F.G % 8 == 0) ? (bx % 8) * (F.G / 8) + bx / 8 : bx; }
    F.ws = args.ws; F.out = args.out; F.ctl = (gu32*)(args.ws + WS_CTL);
    for (int u = F.tid; u < (LDS_BYTES - LDSCTL_OFF) / 4; u += NWAVES * 64) ((LAS unsigned*)(F.lds + LDSCTL_OFF))[u] = 0u;
    __syncthreads();
    XcdBarrier bar = xcd_barrier_post((unsigned*)(F.ctl + CW_BAR) + args.li * XCD_BAR_WORDS, F.MISC + 8);
    const int lo = args.ph_lo, hi = args.ph_hi;
#define IN(k) (lo <= (k) && (k) < hi)
#define BOTH(k) (IN(k) && IN((k) + 1))
    if (IN(0)) { for (int rep = 0; rep < NREP(0); ++rep) p0_prologue(F, args); if (BOTH(0)) xcd_barrier(bar); }
    if (IN(1)) {
        pg8::Gemm g{(const pg8::bf16_t*)(F.ws + WS_HB), (const pg8::bf16_t*)(F.ws + WS_WIN), NTOK + 1024, DIN + 1024, 1024};
        const int G1 = F.G - P1_SPARE; const bool p1_gemm = (int)blockIdx.x < G1;
        P1Order S; S.init(G1, p1_gemm ? (int)blockIdx.x : 0);
        EpiP1 E{F.ws, args.in[4], (const float*)(F.ws + WS_GTAB), (float*)(F.ctl + CW_KMEAN), (float*)(F.ctl + CW_MEMKSS), 1};
        if (p1_gemm) pg8::gemm_phase<EpiP1, P1Order, true, true>(F.lds + RING_OFF, g, S, E);
        if (P1_SPARE == 0) { const int ci = (int)blockIdx.x - 1680 % F.G; if (1680 % F.G != 0 && ci >= 0 && ci < p1_fill_count(F.G)) conv_item(F, ci, args.in[19], args.in[21]); }
        else { for (int c = (int)blockIdx.x - G1; c < P1_CONV; c += (P1_SPARE ? P1_SPARE : 1)) { conv_item(F, c, args.in[19], args.in[21]); __syncthreads(); } }
        if (NREP(1) > 1) { xcd_barrier(bar); E.atom_on = 0; pg8::gemm_phase<EpiP1, P1Order, true, true>(F.lds + RING_OFF, g, S, E); }
        if (BOTH(1)) xcd_barrier(bar);
    }
    if (IN(2)) {
        const float mref = moba_mref(F);
        p2_mixers<0>(F, args.in[5], args.in[10], args.in[11], args.in[19], args.in[21], CW_QUEUE, 0, P2_NITEMS, 15, mref);
        if (NREP(2) > 1) { xcd_barrier(bar); p2_mixers<P2_VAR>(F, args.in[5], args.in[10], args.in[11], args.in[19], args.in[21], CW_QUEUE + 1024, P2_LO, P2_HI, P2_TMASK, mref); }
        if (BOTH(2)) xcd_barrier(bar);
    }
    if (IN(3)) {
        P3Order S; S.init(F.G, (int)blockIdx.x, F.ws); EpiP3 E{(const bf16_t*)(F.ws + WS_GT), (bf16_t*)(F.ws + WS_Y)};
        pg9::gemm_phase<EpiP3, P3Order, false>(F.lds + RING_OFF, 512, 512, 512, S, E);
        if (NREP(3) > 1) pg9::gemm_phase<EpiP3, P3Order, false>(F.lds + RING_OFF, 512, 512, 512, S, E);
        if (BOTH(3)) xcd_barrier(bar);
    }
    if (IN(4)) {
        P4Order S; S.init(F.G, (int)blockIdx.x, F.ws); EpiP4 E{args.in[0], F.out};
        pg9::gemm_phase<EpiP4, P4Order, false>(F.lds + RING_OFF, 1024, 1024, 1024, S, E);
        if (NREP(4) > 1) pg9::gemm_phase<EpiP4, P4Order, false>(F.lds + RING_OFF, 1024, 1024, 1024, S, E);
        if (BOTH(4)) xcd_barrier(bar);
    }
    if (IN(5)) { p5_router(F, F.out, args.in[16], args.in[17], args.in[18], (int*)F.ctl + CW_COUNTS, (int*)(F.ws + WS_LISTS));
        if (NREP(5) > 1) p5_router(F, F.out, args.in[16], args.in[17], args.in[18], (int*)F.ctl + CW_COUNTS + 256, (int*)(F.ws + WS_RETST));
        if (BOTH(5)) xcd_barrier(bar); }
    if (IN(6)) {
        moe_tables(F);
        MoeOrder<3, WS_W1, 2048, 2, WS_XT> S; S.init(F.G, F.vcu, F.ws, (const LAS int*)(F.lds + TB_OFF));
        EpiMoe1 E{(const int*)(F.ws + WS_LISTS), args.in[20], (bf16_t*)(F.ws + WS_ACT), (int*)(F.ws + WS_SLOT)};
        pg9::gemm_phase<EpiMoe1, MoeOrder<3, WS_W1, 2048, 2, WS_XT>, true>(F.lds + RING_OFF, 1024, 1024, 1024, S, E);
        if (NREP(6) > 1) { xcd_barrier(bar); } if (NREP(6) > 1) pg9::gemm_phase<EpiMoe1, MoeOrder<3, WS_W1, 2048, 2, WS_XT>, true>(F.lds + RING_OFF, 1024, 1024, 1024, S, E);
        if (BOTH(6)) xcd_barrier(bar);
    }
    if (IN(7)) {
        moe_tables(F);
        Moe2SplitOrder S; S.init(F.G, F.vcu, F.ws, (const LAS int*)(F.lds + TB_OFF));
        EpiMoe2 E{args.in[22], F.ws};
        pg9::gemm_phase<EpiMoe2, Moe2SplitOrder, false>(F.lds + RING_OFF, 1024, 1024, 1024, S, E);
        {
            const int perx = F.G / 8, lx = F.vcu % perx;
            if (lx >= perx / 2) { float sink = 0.f;
#pragma unroll 1
                for (int part = 0; part < 2; ++part) { const int v = F.vcu - part * (perx / 2);
                    for (size_t r = (size_t)v * (NTOK / F.G); r < (size_t)(v + 1) * (NTOK / F.G); r += 8) {
                        const f32x4* pp = (const f32x4*)(F.out + r * 1024) + F.tid; f32x4 a = pp[0], b = pp[512], c = pp[1024], d = pp[1536]; sink += (a.x + b.x) + (c.x + d.x); } }
                asm volatile("" :: "v"(sink)); } }
        if (NREP(7) > 1) { xcd_barrier(bar); } if (NREP(7) > 1) pg9::gemm_phase<EpiMoe2, Moe2SplitOrder, false>(F.lds + RING_OFF, 1024, 1024, 1024, S, E);
        if (BOTH(7)) xcd_barrier(bar);
    }
    if (IN(8)) { p8_combine(F, F.out, F.out); if (NREP(8) > 1) p8_combine(F, F.out, (float*)(F.ws + WS_HB)); }
    if (NREP(9) > 1) { for (int i = 0; i < 16; ++i) xcd_barrier(bar); }
#undef IN
#undef BOTH
}
#ifndef MK_ONE_LAUNCH
#define MK_ONE_LAUNCH 1
#endif
extern "C" void kernel_launch(void* const* d_in, const int* in_sizes, int n_in, void* d_out, int out_size, void* d_ws, size_t ws_size, hipStream_t stream) {
    if (ws_size < WS_END) { fprintf(stderr, "kernel_launch: ws too small %zu < %zu\n", ws_size, (size_t)WS_END); return; }
    unsigned char* ws = (unsigned char*)d_ws; float* out = (float*)d_out;
    static int grid = 0;
    if (grid == 0) {
        int dev = 0, cus = 0; if (hipGetDevice(&dev) != hipSuccess || hipDeviceGetAttribute(&cus, hipDeviceAttributeMultiprocessorCount, dev) != hipSuccess) { fprintf(stderr, "kernel_launch: device query failed\n"); grid = -1; return; }
        if (hipFuncSetAttribute((const void*)mega, hipFuncAttributeMaxDynamicSharedMemorySize, LDS_BYTES) != hipSuccess) { fprintf(stderr, "kernel_launch: hipFuncSetAttribute failed\n"); grid = -1; return; }
        (void)hipGetLastError(); grid = cus;
    }
    if (grid < 0) return;
    (void)hipMemsetAsync(ws + WS_CTL, 0, 1 * MiB, stream);
    Args a; memset(&a, 0, sizeof a); for (int i = 0; i < 23; ++i) a.in[i] = (const float*)d_in[i]; a.out = out; a.ws = ws; a.li = 0;
#if MK_ONE_LAUNCH
    a.ph_lo = 0; a.ph_hi = N_PHASES;
    hipLaunchKernelGGL(mega, dim3(grid), dim3(NWAVES * 64), LDS_BYTES, stream, a);
#else
    for (int p = 0; p < N_PHASES; ++p) { a.ph_lo = p; a.ph_hi = p + 1; hipLaunchKernelGGL(mega, dim3(grid), dim3(NWAVES * 64), LDS_BYTES, stream, a); }
#endif
}
```

```cpp
#define PROBE_MASK 0
#include <hip/hip_runtime.h>
#include <cstdio>
#include <cstdint>
#include <cstring>
typedef unsigned short bf16_t;
__host__ __device__ inline float bf2f(bf16_t v) { unsigned u = ((unsigned)v) << 16; float f; __builtin_memcpy(&f, &u, 4); return f; }
__host__ __device__ inline bf16_t f2bf(float f) { unsigned u; __builtin_memcpy(&u, &f, 4); u += 0x7fffu + ((u >> 16) & 1u); return (bf16_t)(u >> 16); }
constexpr int NTOK = 16384, SEQ = 4096, NB = 4, DM = 1024, DIN = 6656, MEMLEN = 256, NEXP = 32;
constexpr size_t MiB = (size_t)1 << 20;
constexpr size_t WS_CTL = 0;
constexpr size_t WS_WIN = 1 * MiB;
constexpr size_t WS_WMEMKV = 14 * MiB;
constexpr size_t WS_WBR = 16 * MiB;
constexpr size_t WS_WOUT = 19 * MiB;
constexpr size_t WS_W1 = 21 * MiB;
constexpr size_t WS_W2 = 149 * MiB;
constexpr size_t WS_HB = 213 * MiB;
constexpr size_t WS_HM = 245 * MiB;
constexpr size_t WS_RQ = 247 * MiB, WS_RK = 255 * MiB, WS_RV = 263 * MiB, WS_RG = 279 * MiB, WS_MQ = 295 * MiB, WS_MK = 311 * MiB, WS_MV = 327 * MiB, WS_CQ = 343 * MiB, WS_GT = 359 * MiB;
constexpr size_t WS_MEMK = 455 * MiB, WS_MEMV = 456 * MiB, WS_KMEAN = 457 * MiB, WS_MEMKSS = 457 * MiB + 512 * 1024;
constexpr size_t WS_WRS = 457 * MiB + 768 * 1024 + 4096;
constexpr size_t WS_GTAB = 457 * MiB + 768 * 1024;
constexpr size_t WS_ORET = 458 * MiB, WS_OMOBA = 474 * MiB, WS_OMEM = 490 * MiB;
constexpr size_t WS_Y = 506 * MiB, WS_XT = 538 * MiB;
constexpr size_t WS_TOPE = 570 * MiB, WS_TOPW = 570 * MiB + 256 * 1024, WS_LISTS = 571 * MiB;
constexpr size_t WS_ACT = 574 * MiB;
constexpr size_t WS_YS = 722 * MiB;
constexpr size_t WS_SLOT = 870 * MiB;
constexpr size_t WS_RETST = 959 * MiB;
constexpr size_t WS_END = 871 * MiB;
constexpr size_t WS_PROJ = 574 * MiB;
constexpr size_t WS_PM = 990 * MiB;
constexpr size_t WS_ORAW = 574 * MiB;
constexpr size_t WS_T0 = 703 * MiB, WS_T1 = 767 * MiB, WS_T2 = 831 * MiB;
constexpr int CW_COUNTS = 64;
namespace pg8 {
#define PG8_LAS __attribute__((address_space(3)))
typedef unsigned short bf16_t;
typedef short bf16x8 __attribute__((ext_vector_type(8)));
typedef float f32x4 __attribute__((ext_vector_type(4)));
typedef unsigned u32x4 __attribute__((ext_vector_type(4)));
constexpr int BM = 256, BK = 64, HALF = 128, HTB = HALF * BK * 2  , STAGE_BYTES = 8 * HTB, NXCD = 8, WGM = 4;

__host__ __device__ __forceinline__ int lds_byte(int r, int c) { const int st = (r >> 4) * 2 + (c >> 5), rr = r & 15, cc = c & 31, ob = rr * 64 + cc * 2; return st * 1024 + (ob ^ (((ob >> 9) & 1) << 5)); }
__host__ __device__ __forceinline__ void stage_rc(int b, int& R, int& C) { const int st = b / 1024, sb = b % 1024, swz = sb ^ (((sb >> 9) & 1) << 5); R = (st >> 1) * 16 + swz / 64; C = (st & 1) * 32 + (swz % 64) / 2; }
__host__ __device__ __forceinline__ int perm32(int rho) { const int n = rho >> 4, i = rho & 15; return 8 * (i >> 2) + 4 * n + (i & 3); }

struct Unit { int pm, pn; };
struct Gemm { const bf16_t* A; const bf16_t* Bt; int M, N, K; };
struct StaticOrder {
    int nM, nN, nwg, G, c;
    __host__ __device__ void init(int M, int N, int G_, int c_) { nM = M / BM; nN = N / BM; nwg = nM * nN; G = G_; c = c_; }
    __host__ __device__ bool next(int i, Unit& u) const {
        const long L = (long)i * G + c; if (L >= nwg) return false;
        int wgid = (int)L; { const int q = nwg / NXCD, r = nwg % NXCD, xcd = wgid % NXCD, off = wgid / NXCD; wgid = (xcd < r ? xcd * (q + 1) : r * (q + 1) + (xcd - r) * q) + off; }
        const int nig = WGM * nN, gid = wgid / nig, fm = gid * WGM, gsz = (nM - fm) < WGM ? (nM - fm) : WGM;
        u.pm = fm + ((wgid % nig) % gsz); u.pn = (wgid % nig) / gsz; return true;
    }
    __device__ __forceinline__ void a_ready(const Unit&) const {}
    __device__ __forceinline__ void done(const Unit&) const {}
};
__device__ __forceinline__ unsigned cvt_pk_bf16(float lo, float hi) { unsigned r; asm volatile("v_cvt_pk_bf16_f32 %0, %1, %2" : "=v"(r) : "v"(lo), "v"(hi)); return r; }
typedef float f32x2 __attribute__((ext_vector_type(2)));
template <class Epi, class Sched, bool ALIGN_EPI = false, bool SP2 = false>
__device__ __forceinline__ void gemm_phase(PG8_LAS unsigned char* lds, const Gemm g, const Sched& S, const Epi& E) {
    const int tid = threadIdx.x, wid = __builtin_amdgcn_readfirstlane(tid >> 6), lane = tid & 63, wr = wid >> 2, wc = wid & 3, fr = lane & 15, fq = lane >> 4;
    const int K = g.K, nt = K / BK;
    unsigned voffA[2], voffB[2];
#pragma unroll
    for (int i = 0; i < 2; ++i) { int R, C; stage_rc(tid * 16 + i * 8192, R, C); const int Rb = Epi::PERM ? ((R & ~31) + perm32(R & 31)) : R;
        voffA[i] = (unsigned)(R * K + C) * 2u; voffB[i] = (unsigned)(Rb * K + C) * 2u; }
    const size_t kstep = (size_t)(BK * 2);
    const size_t hstep = (size_t)HALF * K * 2;
    const size_t tstep = 2 * hstep;
    const unsigned ldsw = (unsigned)wid * 1024u;
    const int aoff = lds_byte(wr * 64 + fr, fq * 8), boff = lds_byte(wc * 32 + fr, fq * 8);
#define PG8_SA(b, h) (((b) * 2 + (h)) * HTB)
#define PG8_SB(b, h) ((4 + (b) * 2 + (h)) * HTB)
#define PG8_STAGE(bufoff, gbase, voff) do { _Pragma("unroll") for (int _i = 0; _i < 2; ++_i) \
        __builtin_amdgcn_global_load_lds((const unsigned*)((const char*)(gbase) + (voff)[_i]), (PG8_LAS unsigned*)(lds + (bufoff) + ldsw + _i * 8192), 16, 0, 0); } while (0)
#define PG8_LDA(dst, b, h) do { _Pragma("unroll") for (int m = 0; m < 4; ++m) _Pragma("unroll") for (int k = 0; k < 2; ++k) dst[m][k] = *(const PG8_LAS bf16x8*)(lds + PG8_SA(b, h) + aoff + m * 2048 + k * 1024); } while (0)
#define PG8_LDB(dst, b, h) do { _Pragma("unroll") for (int n = 0; n < 2; ++n) _Pragma("unroll") for (int k = 0; k < 2; ++k) dst[n][k] = *(const PG8_LAS bf16x8*)(lds + PG8_SB(b, h) + boff + n * 2048 + k * 1024); } while (0)
#define PG8_MMA(ai, bj, At, Bt) do { __builtin_amdgcn_s_setprio(1); _Pragma("unroll") for (int m = 0; m < 4; ++m) _Pragma("unroll") for (int n = 0; n < 2; ++n) _Pragma("unroll") for (int k = 0; k < 2; ++k) \
        acc[ai][bj][m][n] = __builtin_amdgcn_mfma_f32_16x16x32_bf16(Bt[n][k], At[m][k], acc[ai][bj][m][n], 0, 0, 0); __builtin_amdgcn_s_setprio(0); } while (0)
#define PG8_WAIT_V(n) asm volatile("s_waitcnt vmcnt(" #n ")" ::: "memory")
#define PG8_WAIT_L(n) asm volatile("s_waitcnt lgkmcnt(" #n ")" ::: "memory")
#define PG8_BAR __builtin_amdgcn_s_barrier()
#define PG8_SCHED __builtin_amdgcn_sched_barrier(0)
    Unit cur, nxt; int ui = 0;
    if (!S.next(0, cur)) return;
    f32x4 acc[2][2][4][2];
#pragma unroll
    for (int a = 0; a < 2; ++a)
#pragma unroll
        for (int b = 0; b < 2; ++b)
#pragma unroll
            for (int m = 0; m < 4; ++m)
#pragma unroll
                for (int n = 0; n < 2; ++n) acc[a][b][m][n] = (f32x4){0.f, 0.f, 0.f, 0.f};
    bf16x8 At[4][2], B0[2][2], B1[2][2];
    const char* cA = (const char*)g.A + (size_t)cur.pm * tstep; const char* cB = (const char*)g.Bt + (size_t)cur.pn * tstep;
    S.a_ready(cur);
    if constexpr (SP2) {
        PG8_STAGE(PG8_SB(0, 0), cB, voffB); PG8_STAGE(PG8_SB(0, 1), cB + hstep, voffB); PG8_STAGE(PG8_SA(0, 0), cA, voffA); PG8_STAGE(PG8_SA(0, 1), cA + hstep, voffA);
        if (wr == 1) PG8_BAR;
        PG8_WAIT_V(2); PG8_BAR;
        PG8_STAGE(PG8_SB(1, 0), cB + kstep, voffB); PG8_STAGE(PG8_SA(1, 0), cA + kstep, voffA); PG8_STAGE(PG8_SB(1, 1), cB + hstep + kstep, voffB);
        PG8_WAIT_V(6); PG8_BAR;
    } else {
        PG8_STAGE(PG8_SB(0, 0), cB, voffB); PG8_STAGE(PG8_SA(0, 0), cA, voffA); PG8_STAGE(PG8_SB(0, 1), cB + hstep, voffB); PG8_STAGE(PG8_SA(0, 1), cA + hstep, voffA);
        if (wr == 1) PG8_BAR;
        PG8_WAIT_V(4); PG8_BAR;
        PG8_STAGE(PG8_SB(1, 0), cB + kstep, voffB); PG8_STAGE(PG8_SA(1, 0), cA + kstep, voffA); PG8_STAGE(PG8_SB(1, 1), cB + hstep + kstep, voffB);
        PG8_WAIT_V(6); PG8_BAR;
    }
    for (;;) {
        const bool has_next = S.next(ui + 1, nxt);
        const char* nA = has_next ? (const char*)g.A + (size_t)nxt.pm * tstep : cA; const char* nB = has_next ? (const char*)g.Bt + (size_t)nxt.pn * tstep : cB;
        for (int t = 0; t < nt; t += 2) {
            const bool last = (t == nt - 2);
            const char* a1 = cA + (size_t)(t + 1) * kstep;
            const char* a2 = last ? nA : cA + (size_t)(t + 2) * kstep; const char* b2 = last ? nB : cB + (size_t)(t + 2) * kstep;
            const char* a3 = a2 + kstep; const char* b3 = b2 + kstep;
            if (last && has_next) S.a_ready(nxt);
            if constexpr (SP2) {
            PG8_LDB(B0, 0, 0); PG8_LDB(B1, 0, 1); PG8_SCHED; PG8_LDA(At, 0, 0); PG8_STAGE(PG8_SA(1, 1), a1 + hstep, voffA);
            PG8_WAIT_V(8); PG8_WAIT_L(0); PG8_BAR; PG8_MMA(0, 0, At, B0); PG8_MMA(0, 1, At, B1); PG8_BAR; PG8_SCHED;
            PG8_LDA(At, 0, 1); PG8_STAGE(PG8_SB(0, 0), b2, voffB); PG8_STAGE(PG8_SB(0, 1), b2 + hstep, voffB); PG8_STAGE(PG8_SA(0, 0), a2, voffA);
            PG8_WAIT_V(8); PG8_WAIT_L(0); PG8_BAR; PG8_MMA(1, 0, At, B0); PG8_MMA(1, 1, At, B1); PG8_BAR; PG8_SCHED;
            PG8_LDB(B0, 1, 0); PG8_LDB(B1, 1, 1); PG8_SCHED; PG8_LDA(At, 1, 0); PG8_STAGE(PG8_SA(0, 1), a2 + hstep, voffA);
            PG8_WAIT_V(8); PG8_WAIT_L(0); PG8_BAR; PG8_MMA(0, 0, At, B0); PG8_MMA(0, 1, At, B1); PG8_BAR; PG8_SCHED;
            PG8_LDA(At, 1, 1); PG8_STAGE(PG8_SB(1, 0), b3, voffB); PG8_STAGE(PG8_SB(1, 1), b3 + hstep, voffB); PG8_STAGE(PG8_SA(1, 0), a3, voffA);
            PG8_WAIT_V(8); PG8_WAIT_L(0); PG8_BAR; PG8_MMA(1, 0, At, B0); PG8_MMA(1, 1, At, B1); PG8_BAR; PG8_SCHED;
            } else {
            PG8_LDB(B0, 0, 0); PG8_SCHED; PG8_LDA(At, 0, 0); PG8_STAGE(PG8_SA(1, 1), a1 + hstep, voffA);
            PG8_WAIT_L(8); PG8_BAR; PG8_WAIT_L(0); PG8_MMA(0, 0, At, B0); PG8_BAR; PG8_SCHED;
            PG8_LDB(B1, 0, 1); PG8_STAGE(PG8_SB(0, 0), b2, voffB);
            PG8_BAR; PG8_WAIT_L(0); PG8_MMA(0, 1, At, B1); PG8_BAR;
            PG8_LDA(At, 0, 1); PG8_STAGE(PG8_SA(0, 0), a2, voffA);
            PG8_BAR; PG8_WAIT_L(0); PG8_MMA(1, 0, At, B0); PG8_BAR; PG8_SCHED;
            PG8_STAGE(PG8_SB(0, 1), b2 + hstep, voffB);
            PG8_WAIT_V(6); PG8_BAR; PG8_MMA(1, 1, At, B1); PG8_BAR;
            PG8_LDB(B0, 1, 0); PG8_SCHED; PG8_LDA(At, 1, 0); PG8_STAGE(PG8_SA(0, 1), a2 + hstep, voffA);
            PG8_WAIT_L(8); PG8_BAR; PG8_WAIT_L(0); PG8_MMA(0, 0, At, B0); PG8_BAR; PG8_SCHED;
            PG8_LDB(B1, 1, 1); PG8_STAGE(PG8_SB(1, 0), b3, voffB);
            PG8_BAR; PG8_WAIT_L(0); PG8_MMA(0, 1, At, B1); PG8_BAR;
            PG8_LDA(At, 1, 1); PG8_STAGE(PG8_SA(1, 0), a3, voffA);
            PG8_BAR; PG8_WAIT_L(0); PG8_MMA(1, 0, At, B0); PG8_BAR; PG8_SCHED;
            PG8_STAGE(PG8_SB(1, 1), b3 + hstep, voffB);
            PG8_WAIT_V(6); PG8_BAR; PG8_MMA(1, 1, At, B1); PG8_BAR;
            }
        }
        if constexpr (ALIGN_EPI) { if (wr == 0) PG8_BAR; }
        if constexpr (!Epi::AFTER_DRAIN) { E(acc, cur, wr, wc, fr, fq); S.done(cur); }
        if (!has_next) break;
#pragma unroll
        for (int a = 0; a < 2; ++a)
#pragma unroll
            for (int b = 0; b < 2; ++b)
#pragma unroll
                for (int m = 0; m < 4; ++m)
#pragma unroll
                    for (int n = 0; n < 2; ++n) acc[a][b][m][n] = (f32x4){0.f, 0.f, 0.f, 0.f};
        cur = nxt; cA = nA; cB = nB; ++ui;
        if constexpr (ALIGN_EPI) { if (wr == 1) PG8_BAR; }
    }
    PG8_WAIT_V(0);
    if constexpr (!ALIGN_EPI) { if (wr == 0) PG8_BAR; }
    PG8_BAR;
    if constexpr (Epi::AFTER_DRAIN) { E.fused(acc, cur, wr, wc, fr, fq, lds, wid, lane); S.done(cur); }
#undef PG8_SA
#undef PG8_SB
#undef PG8_STAGE
#undef PG8_LDA
#undef PG8_LDB
#undef PG8_MMA
#undef PG8_WAIT_V
#undef PG8_WAIT_L
#undef PG8_BAR
#undef PG8_SCHED
}
}
namespace pg9 {
using pg8::bf16x8; using pg8::f32x4; using pg8::u32x4; using pg8::lds_byte; using pg8::stage_rc; using pg8::perm32;
constexpr int BK = 64, HALF = 128, HTB = HALF * BK * 2;
struct Unit { int pm, pn, aux, cnt, row0, ty; };
template <class Epi, class Sched, bool GATHER>
__device__ __forceinline__ void gemm_phase(PG8_LAS unsigned char* lds, const int K, const int lda, const int ldb, const Sched& S, const Epi& E) {
    const int tid = threadIdx.x, wid = __builtin_amdgcn_readfirstlane(tid >> 6), lane = tid & 63, wr = wid >> 2, wc = wid & 3, fr = lane & 15, fq = lane >> 4;
    const int nt = K / BK;
    unsigned offA[2][2], offAn[2][2], offB[2][2]; int RA[2], CA[2];
#pragma unroll
    for (int i = 0; i < 2; ++i) { int R, C; stage_rc(tid * 16 + i * 8192, R, C); const int Rb = Epi::PERM ? ((R & ~31) + perm32(R & 31)) : R; RA[i] = R; CA[i] = C * 2;
#pragma unroll
        for (int h = 0; h < 2; ++h) { offB[h][i] = (unsigned)((Rb + 128 * h) * ldb + C) * 2u; offA[h][i] = (unsigned)((R + 128 * h) * lda + C) * 2u; offAn[h][i] = offA[h][i]; } }
    const size_t kstep = (size_t)(BK * 2);
    const unsigned ldsw = (unsigned)wid * 1024u;
    const int aoff = lds_byte(wr * 64 + fr, fq * 8), boff = lds_byte(wc * 32 + fr, fq * 8);
#define PG9_SA(b, h) (((b) * 2 + (h)) * HTB)
#define PG9_SB(b, h) ((4 + (b) * 2 + (h)) * HTB)
#define PG9_STAGE(bufoff, gbase, voff) do { _Pragma("unroll") for (int _i = 0; _i < 2; ++_i) \
        __builtin_amdgcn_global_load_lds((const unsigned*)((const char*)(gbase) + (voff)[_i]), (PG8_LAS unsigned*)(lds + (bufoff) + ldsw + _i * 8192), 16, 0, 0); } while (0)
#define PG9_LDA(dst, b, h) do { _Pragma("unroll") for (int m = 0; m < 4; ++m) _Pragma("unroll") for (int k = 0; k < 2; ++k) dst[m][k] = *(const PG8_LAS bf16x8*)(lds + PG9_SA(b, h) + aoff + m * 2048 + k * 1024); } while (0)
#define PG9_LDB(dst, b, h) do { _Pragma("unroll") for (int n = 0; n < 2; ++n) _Pragma("unroll") for (int k = 0; k < 2; ++k) dst[n][k] = *(const PG8_LAS bf16x8*)(lds + PG9_SB(b, h) + boff + n * 2048 + k * 1024); } while (0)
#define PG9_MMA(ai, bj, At, Bt) do { __builtin_amdgcn_s_setprio(1); _Pragma("unroll") for (int m = 0; m < 4; ++m) _Pragma("unroll") for (int n = 0; n < 2; ++n) _Pragma("unroll") for (int k = 0; k < 2; ++k) \
        acc[ai][bj][m][n] = __builtin_amdgcn_mfma_f32_16x16x32_bf16(Bt[n][k], At[m][k], acc[ai][bj][m][n], 0, 0, 0); __builtin_amdgcn_s_setprio(0); } while (0)
#define PG9_WAIT_V(n) asm volatile("s_waitcnt vmcnt(" #n ")" ::: "memory")
#define PG9_WAIT_L(n) asm volatile("s_waitcnt lgkmcnt(" #n ")" ::: "memory")
#define PG9_BAR __builtin_amdgcn_s_barrier()
#define PG9_SCHED __builtin_amdgcn_sched_barrier(0)
    Unit cur, nxt; int ui = 0;
    if (!S.next(0, cur)) return;
    f32x4 acc[2][2][4][2];
#pragma unroll
    for (int a = 0; a < 2; ++a)
#pragma unroll
        for (int b = 0; b < 2; ++b)
#pragma unroll
            for (int m = 0; m < 4; ++m)
#pragma unroll
                for (int n = 0; n < 2; ++n) acc[a][b][m][n] = (f32x4){0.f, 0.f, 0.f, 0.f};
    bf16x8 At[4][2], B0[2][2], B1[2][2];
    S.a_ready(cur, wid, lane);
    const char* cA = S.a_base(cur); const char* cB = S.b_base(cur);
    if constexpr (GATHER) {
#pragma unroll
        for (int h = 0; h < 2; ++h)
#pragma unroll
            for (int i = 0; i < 2; ++i) offA[h][i] = S.a_row_off(cur, RA[i] + 128 * h) + (unsigned)CA[i];
    }
    PG9_STAGE(PG9_SB(0, 0), cB, offB[0]); PG9_STAGE(PG9_SB(0, 1), cB, offB[1]); PG9_STAGE(PG9_SA(0, 0), cA, offA[0]); PG9_STAGE(PG9_SA(0, 1), cA, offA[1]);
    if (wr == 1) PG9_BAR;
    PG9_WAIT_V(2); PG9_BAR;
    PG9_STAGE(PG9_SB(1, 0), cB + kstep, offB[0]); PG9_STAGE(PG9_SA(1, 0), cA + kstep, offA[0]); PG9_STAGE(PG9_SB(1, 1), cB + kstep, offB[1]);
    PG9_WAIT_V(6); PG9_BAR;
    for (;;) {
        const bool has_next = S.next(ui + 1, nxt);
        if (has_next) S.a_ready(nxt, wid, lane);
        const char* nA = has_next ? S.a_base(nxt) : cA; const char* nB = has_next ? S.b_base(nxt) : cB;
        if constexpr (GATHER) {
#pragma unroll
            for (int h = 0; h < 2; ++h)
#pragma unroll
                for (int i = 0; i < 2; ++i) offAn[h][i] = has_next ? (S.a_row_off(nxt, RA[i] + 128 * h) + (unsigned)CA[i]) : offA[h][i];
        }
        const int ntu = S.nt_of(cur, nt);
        for (int t = 0; t < ntu; t += 2) {
            const bool last = (t == ntu - 2);
            const char* a1 = cA + (size_t)(t + 1) * kstep;
            const char* a2 = last ? nA : cA + (size_t)(t + 2) * kstep; const char* b2 = last ? nB : cB + (size_t)(t + 2) * kstep;
            const char* a3 = a2 + kstep; const char* b3 = b2 + kstep;
            unsigned oA2[2][2];
#pragma unroll
            for (int h = 0; h < 2; ++h)
#pragma unroll
                for (int i = 0; i < 2; ++i) oA2[h][i] = (GATHER && last) ? offAn[h][i] : offA[h][i];
            PG9_LDB(B0, 0, 0); PG9_LDB(B1, 0, 1); PG9_SCHED; PG9_LDA(At, 0, 0); PG9_STAGE(PG9_SA(1, 1), a1, offA[1]);
            PG9_WAIT_V(8); PG9_WAIT_L(0); PG9_BAR; PG9_MMA(0, 0, At, B0); PG9_MMA(0, 1, At, B1); PG9_BAR; PG9_SCHED;
            PG9_LDA(At, 0, 1); PG9_STAGE(PG9_SB(0, 0), b2, offB[0]); PG9_STAGE(PG9_SB(0, 1), b2, offB[1]); PG9_STAGE(PG9_SA(0, 0), a2, oA2[0]);
            PG9_WAIT_V(8); PG9_WAIT_L(0); PG9_BAR; PG9_MMA(1, 0, At, B0); PG9_MMA(1, 1, At, B1); PG9_BAR; PG9_SCHED;
            PG9_LDB(B0, 1, 0); PG9_LDB(B1, 1, 1); PG9_SCHED; PG9_LDA(At, 1, 0); PG9_STAGE(PG9_SA(0, 1), a2, oA2[1]);
            PG9_WAIT_V(8); PG9_WAIT_L(0); PG9_BAR; PG9_MMA(0, 0, At, B0); PG9_MMA(0, 1, At, B1); PG9_BAR; PG9_SCHED;
            PG9_LDA(At, 1, 1); PG9_STAGE(PG9_SB(1, 0), b3, offB[0]); PG9_STAGE(PG9_SB(1, 1), b3, offB[1]); PG9_STAGE(PG9_SA(1, 0), a3, oA2[0]);
            PG9_WAIT_V(8); PG9_WAIT_L(0); PG9_BAR; PG9_MMA(1, 0, At, B0); PG9_MMA(1, 1, At, B1); PG9_BAR; PG9_SCHED;
        }
        if (wr == 0) PG9_BAR;
        bool keep = false;
        if constexpr (Epi::CHAIN) keep = E.chain_more(cur);
        if (keep) { if constexpr (Epi::CHAIN) E.rescale(acc, cur, wr, wc, fr, fq); }
        else { E(acc, cur, wr, wc, fr, fq); S.done(cur, lane); }
        if (!has_next) break;
        if (!keep) {
#pragma unroll
            for (int a = 0; a < 2; ++a)
#pragma unroll
                for (int b = 0; b < 2; ++b)
#pragma unroll
                    for (int m = 0; m < 4; ++m)
#pragma unroll
                        for (int n = 0; n < 2; ++n) acc[a][b][m][n] = (f32x4){0.f, 0.f, 0.f, 0.f};
        }
        cur = nxt; cA = nA; cB = nB; ++ui;
        if constexpr (GATHER) {
#pragma unroll
            for (int h = 0; h < 2; ++h)
#pragma unroll
                for (int i = 0; i < 2; ++i) offA[h][i] = offAn[h][i];
        }
        if (wr == 1) PG9_BAR;
    }
    PG9_WAIT_V(0);
    PG9_BAR;
#undef PG9_SA
#undef PG9_SB
#undef PG9_STAGE
#undef PG9_LDA
#undef PG9_LDB
#undef PG9_MMA
#undef PG9_WAIT_V
#undef PG9_WAIT_L
#undef PG9_BAR
#undef PG9_SCHED
}
}
#define GAS __attribute__((address_space(1)))
#define LAS __attribute__((address_space(3)))
typedef unsigned short bf16;
typedef unsigned v4u __attribute__((ext_vector_type(4)));
typedef float f32x4 __attribute__((ext_vector_type(4)));
typedef short bf16x8 __attribute__((ext_vector_type(8)));
typedef GAS unsigned gu32;
typedef GAS unsigned long long gu64;
#define RLX_AGENT __ATOMIC_RELAXED, __HIP_MEMORY_SCOPE_AGENT
#define LDS_WAIT() asm volatile("s_waitcnt lgkmcnt(0)" ::: "memory")
#define VM_WAIT() asm volatile("s_waitcnt vmcnt(0)" ::: "memory")
__device__ __forceinline__ unsigned long long rt() { return __builtin_amdgcn_s_memrealtime(); }
__device__ __forceinline__ unsigned f2bfu(float f) { unsigned u = __builtin_bit_cast(unsigned, f); return (u + 0x7fffu + ((u >> 16) & 1u)) >> 16; }
__device__ __forceinline__ unsigned pk2(float lo, float hi) { return f2bfu(lo) | (f2bfu(hi) << 16); }
#define XB_TMO      128
#define XB_XCNT(j)  (256  + 64 * (j))
#define XB_XSUB(j)  (1280 + 64 * (j))
#define XB_XGEN(j)  (2304 + 64 * (j))
#define XB_TOP      3328
#define XB_TOPGEN   3392
#define XCD_BAR_WORDS 3456
#define XB_SPIN_CAP (1u << 18)

__device__ __forceinline__ unsigned xb_ld(unsigned* p)              { return __hip_atomic_load(p, __ATOMIC_RELAXED, __HIP_MEMORY_SCOPE_AGENT); }
__device__ __forceinline__ unsigned xb_add(unsigned* p, unsigned v) { return __hip_atomic_fetch_add(p, v, __ATOMIC_RELAXED, __HIP_MEMORY_SCOPE_AGENT); }
__device__ __forceinline__ unsigned xb_xcc_id() { return (unsigned)__builtin_amdgcn_s_getreg((3 << 11) | 20) & 0xFu; }
#define XB_SPIN(cond, bar) do { unsigned _sp = 0; while (cond) { __builtin_amdgcn_s_sleep(1); \
    if ((++_sp & 255u) == 0u) { if (xb_ld(&(bar)[XB_TMO])) break; if (_sp > XB_SPIN_CAP) { atomicAdd(&(bar)[XB_TMO], 1u); break; } } } } while (0)

struct XcdBarrier {
    unsigned* bar; unsigned x;
    volatile LAS unsigned* st;
};

__device__ __forceinline__ XcdBarrier xcd_barrier_post(unsigned* bar, volatile LAS unsigned* st) {
    XcdBarrier b; b.bar = bar; b.x = xb_xcc_id(); b.st = st;
    if (threadIdx.x == 0) (void)xb_add(&bar[XB_XCNT(b.x)], 1u);
    return b;
}
__device__ __forceinline__ void xcd_barrier_complete(unsigned* bar, unsigned x, unsigned& nloc, unsigned& nx) {
    const unsigned G = gridDim.x * gridDim.y * gridDim.z;
    unsigned sum, cnt, mine, sp = 0u;
    for (;;) {
        sum = 0u; cnt = 0u; mine = 0u;
#pragma unroll
        for (unsigned j = 0; j < 16; ++j) { const unsigned c = xb_ld(&bar[XB_XCNT(j)]); sum += c; cnt += (c > 0u) ? 1u : 0u; mine = (j == x) ? c : mine; }
        if (sum == G) break;
        __builtin_amdgcn_s_sleep(1);
        if ((++sp & 255u) == 0u) { if (xb_ld(&bar[XB_TMO])) break; if (sp > XB_SPIN_CAP) { atomicAdd(&bar[XB_TMO], 1u); break; } }
    }
    nloc = mine > 0u ? mine : 1u; nx = cnt > 0u ? cnt : 1u;
}

__device__ __forceinline__ void xcd_barrier(const XcdBarrier& b) {
    asm volatile("s_waitcnt vmcnt(0)" ::: "memory");
    __syncthreads();
    if (threadIdx.x == 0) {
        unsigned* bar = b.bar;
        __builtin_amdgcn_s_waitcnt(0);
        unsigned nloc = b.st[0], nx = b.st[1];
        if (nloc == 0u) { xcd_barrier_complete(bar, b.x, nloc, nx); b.st[0] = nloc; b.st[1] = nx; }
        const unsigned old = xb_add(&bar[XB_XSUB(b.x)], 1u);
        const unsigned gen = old / nloc;
        if (old + 1u == (gen + 1u) * nloc) {
            __builtin_amdgcn_fence(__ATOMIC_RELEASE, "agent");
            asm volatile("s_waitcnt vmcnt(0)" ::: "memory");
            const unsigned og = xb_add(&bar[XB_TOP], 1u);
            const unsigned tg = og / nx;
            if (og + 1u == (tg + 1u) * nx) xb_add(&bar[XB_TOPGEN], 1u);
            else XB_SPIN(xb_ld(&bar[XB_TOPGEN]) == tg, bar);
            __builtin_amdgcn_fence(__ATOMIC_ACQUIRE, "agent");
            xb_add(&bar[XB_XGEN(b.x)], 1u);
            asm volatile("s_waitcnt vmcnt(0)" ::: "memory");
        } else {
            XB_SPIN(xb_ld(&bar[XB_XGEN(b.x)]) == gen, bar);
            __builtin_amdgcn_fence(__ATOMIC_ACQUIRE, "agent");
            asm volatile("s_waitcnt vmcnt(0)" ::: "memory");
        }
    }
    __syncthreads();
}
constexpr int NWAVES = 8;
constexpr int RING_OFF = 0, RING_BYTES = 131072;
constexpr int LDSCTL_OFF = RING_BYTES, MISC_OFF = LDSCTL_OFF + 320;
constexpr int LDS_BYTES = 147456;
constexpr int CW_BAR = 4096;
constexpr int CW_KMEAN = 32768;
constexpr int CW_MEMKSS = 65536;
static_assert((CW_MEMKSS + 4096) * 4 <= (int)MiB && CW_BAR + 4 * 3456 <= CW_KMEAN, "ctl map");

struct Frame {
    LAS unsigned char* lds; volatile LAS unsigned* MISC; gu32* ctl;
    int tid, lane, wave, vcu, G;
    unsigned char* ws; float* out;
};
typedef float f32x2_t __attribute__((ext_vector_type(2))); typedef __bf16 bf16x2_t __attribute__((ext_vector_type(2)));
__device__ __forceinline__ unsigned cvt_pk_bf16(float lo, float hi) { f32x2_t v = {lo, hi}; bf16x2_t b = __builtin_convertvector(v, bf16x2_t); return __builtin_bit_cast(unsigned, b); }
__device__ __forceinline__ float wave_sum64(float v) {
#pragma unroll
    for (int o = 1; o < 64; o <<= 1) v += __shfl_xor(v, o);
    return v;
}
template <bool HEADPERM> __device__ __forceinline__ void p0_transpose_item(const float* W, int K, int N, bf16* WT, int row_off, LAS float* scr, int item, int lane) {
    const int nblk = N / 32, kb = item / nblk, nb = item % nblk, k0 = 64 * kb, n0 = 32 * nb;
    int p0 = n0; if (HEADPERM) { const int lg = (n0 >> 5) & 7; p0 = (n0 & ~255) + 32 * (4 * (lg & 1) + (lg >> 1)); }
    float wv[32];
#pragma unroll
    for (int i = 0; i < 32; ++i) wv[i] = __builtin_nontemporal_load(&W[(size_t)(k0 + 2 * i + (lane >> 5)) * N + n0 + (lane & 31)]);
#pragma unroll
    for (int i = 0; i < 32; ++i) scr[(2 * i + (lane >> 5)) * 33 + (lane & 31)] = wv[i];
    LDS_WAIT(); asm volatile("" ::: "memory");
    const int c = lane & 7;
#pragma unroll
    for (int j = 0; j < 4; ++j) { const int n = (lane >> 3) + 8 * j; const LAS float* s = scr + (8 * c) * 33 + n;
        v4u o; o.x = cvt_pk_bf16(s[0 * 33], s[1 * 33]); o.y = cvt_pk_bf16(s[2 * 33], s[3 * 33]); o.z = cvt_pk_bf16(s[4 * 33], s[5 * 33]); o.w = cvt_pk_bf16(s[6 * 33], s[7 * 33]);
        *(GAS v4u*)(WT + (size_t)(row_off + p0 + n) * K + k0 + 8 * c) = o; }
    LDS_WAIT(); asm volatile("" ::: "memory");
}
__device__ __forceinline__ void xp_load(float (&wv)[32], const float* W, int N, int nblk, int item, int lane) {
    const int kb = item / nblk, nb = item % nblk, k0 = 64 * kb, n0 = 32 * nb;
#pragma unroll
    for (int i = 0; i < 32; ++i) wv[i] = __builtin_nontemporal_load(&W[(size_t)(k0 + 2 * i + (lane >> 5)) * N + n0 + (lane & 31)]);
}
__device__ __forceinline__ void xp_finish(const float (&wv)[32], int K, int nblk, bf16* WT, LAS float* scr, int item, int lane) {
    const int kb = item / nblk, nb = item % nblk, k0 = 64 * kb, n0 = 32 * nb;
#pragma unroll
    for (int i = 0; i < 32; ++i) scr[(2 * i + (lane >> 5)) * 33 + (lane & 31)] = wv[i];
    LDS_WAIT(); asm volatile("" ::: "memory");
    const int c = lane & 7;
#pragma unroll
    for (int j = 0; j < 4; ++j) { const int n = (lane >> 3) + 8 * j; const LAS float* s = scr + (8 * c) * 33 + n;
        v4u o; o.x = cvt_pk_bf16(s[0 * 33], s[1 * 33]); o.y = cvt_pk_bf16(s[2 * 33], s[3 * 33]); o.z = cvt_pk_bf16(s[4 * 33], s[5 * 33]); o.w = cvt_pk_bf16(s[6 * 33], s[7 * 33]);
        *(GAS v4u*)(WT + (size_t)(n0 + n) * K + k0 + 8 * c) = o; }
    LDS_WAIT(); asm volatile("" ::: "memory");
}
__device__ __forceinline__ void cv_load(f32x4 (&v)[8], const int slot, const float* w1, const float* w2, const int lane) {
    const int q = slot / 17, r = slot - 17 * q; if (r >= 12) return;
    const int bi = 12 * q + r; const bool isw1 = bi < 32768; const int b2 = isw1 ? bi : bi - 32768;
    const int e = isw1 ? (b2 >> 10) : (b2 >> 9), kb = isw1 ? ((b2 >> 6) & 15) : ((b2 >> 5) & 15), nb = isw1 ? (b2 & 63) : (b2 & 31), N = isw1 ? 2048 : 1024;
    const float* src = (isw1 ? w1 : w2) + ((size_t)e * 1024 + 64 * kb + (lane >> 3)) * N + 32 * nb + 4 * (lane & 7);
#pragma unroll
    for (int i = 0; i < 8; ++i) v[i] = __builtin_nontemporal_load((const f32x4*)(src + (size_t)(8 * i) * N));
}
__device__ __forceinline__ void cv_finish(const f32x4 (&v)[8], const int slot, unsigned char* ws, LAS float* scr, const int lane) {
    const int q = slot / 17, r = slot - 17 * q; if (r >= 12) return;
    const int bi = 12 * q + r; const bool isw1 = bi < 32768; const int b2 = isw1 ? bi : bi - 32768;
    const int e = isw1 ? (b2 >> 10) : (b2 >> 9), kb = isw1 ? ((b2 >> 6) & 15) : ((b2 >> 5) & 15), nb = isw1 ? (b2 & 63) : (b2 & 31);
    bf16* WT = (bf16*)(ws + (isw1 ? WS_W1 : WS_W2)) + ((size_t)e * (isw1 ? 2048 : 1024) + 32 * nb) * 1024 + 64 * kb;
#pragma unroll
    for (int i = 0; i < 8; ++i) { LAS float* d = scr + (8 * i + (lane >> 3)) * 33 + 4 * (lane & 7); d[0] = v[i].x; d[1] = v[i].y; d[2] = v[i].z; d[3] = v[i].w; }
    LDS_WAIT(); asm volatile("" ::: "memory");
    const int c = lane & 7;
#pragma unroll
    for (int j = 0; j < 4; ++j) { const int n = (lane >> 3) + 8 * j; const LAS float* s = scr + (8 * c) * 33 + n;
        v4u o; o.x = cvt_pk_bf16(s[0 * 33], s[1 * 33]); o.y = cvt_pk_bf16(s[2 * 33], s[3 * 33]); o.z = cvt_pk_bf16(s[4 * 33], s[5 * 33]); o.w = cvt_pk_bf16(s[6 * 33], s[7 * 33]);
        *(GAS v4u*)(WT + (size_t)n * 1024 + 8 * c) = o; }
    LDS_WAIT(); asm volatile("" ::: "memory");
}
__device__ __forceinline__ void rms_row_to_bf16(int lane, const float* xrow, const float* g, bf16* orow) {
    const GAS f32x4* xr = (const GAS f32x4*)xrow + lane; const GAS f32x4* gr = (const GAS f32x4*)g + lane;
    f32x4 v[4]; float s = 0.f;
#pragma unroll
    for (int j = 0; j < 4; ++j) { v[j] = xr[64 * j]; s += (v[j].x * v[j].x + v[j].y * v[j].y) + (v[j].z * v[j].z + v[j].w * v[j].w); }
    const float r = 1.f / sqrtf(wave_sum64(s) * (1.f / 1024.f) + 1e-5f);
    GAS unsigned long long* o8 = (GAS unsigned long long*)orow + lane;
#pragma unroll
    for (int j = 0; j < 4; ++j) { const f32x4 gg = gr[64 * j]; o8[64 * j] = (unsigned long long)cvt_pk_bf16(v[j].x * r * gg.x, v[j].y * r * gg.y) | ((unsigned long long)cvt_pk_bf16(v[j].z * r * gg.z, v[j].w * r * gg.w) << 32); }
}
struct Args { const float* in[23]; float* out; unsigned char* ws; int ph_lo, ph_hi, li, pad; };
__device__ __forceinline__ void p0_prologue(Frame& F, const Args& A) {
    LAS float* scr = (LAS float*)(F.lds + RING_OFF + F.wave * 16384);
    const int gw = F.vcu * NWAVES + F.wave, NGW = F.G * NWAVES;
    constexpr int I_IN = 16 * (DIN / 32), I_MKV = 16 * 32, I_BR = 8 * 32, I_OUT = 16 * 32;
    constexpr int NITEMS = I_IN + I_MKV + 3 * I_BR + I_OUT;
    for (int it = gw; it < NITEMS; it += NGW) {
        int r = it;
        if (r < I_IN) { p0_transpose_item<true>(A.in[3], 1024, DIN, (bf16*)(F.ws + WS_WIN), 0, scr, r, F.lane); continue; } r -= I_IN;
        if (r < I_MKV) { p0_transpose_item<true>(A.in[9], 1024, 1024, (bf16*)(F.ws + WS_WMEMKV), 0, scr, r, F.lane); continue; } r -= I_MKV;
        if (r < 3 * I_BR) { const int w = r / I_BR; p0_transpose_item<false>(w == 0 ? A.in[12] : (w == 1 ? A.in[13] : A.in[14]), 512, 1024, (bf16*)(F.ws + WS_WBR) + (size_t)w * 1024 * 512, 0, scr, r % I_BR, F.lane); continue; } r -= 3 * I_BR;
        p0_transpose_item<false>(A.in[15], 1024, 1024, (bf16*)(F.ws + WS_WOUT), 0, scr, r, F.lane);
    }
    { bf16_t* WR = (bf16_t*)(F.ws + WS_WRS); const float* wr = A.in[17];
      for (int i = F.vcu * 512 + F.tid; i < 32768; i += F.G * 512) { const int e = i >> 10, k = i & 1023; const float v = wr[k * 32 + e]; const bf16_t h = f2bf(v); WR[i] = h; WR[32768 + i] = f2bf(v - bf2f(h)); } }
    if (gw == 0) { ((float*)(F.ws + WS_GTAB))[F.lane] = A.in[6][F.lane]; ((float*)(F.ws + WS_GTAB))[64 + F.lane] = A.in[7][F.lane]; }
    for (int m = gw; m < NTOK; m += NGW) rms_row_to_bf16(F.lane, A.in[0] + (size_t)m * DM, A.in[2], (bf16*)(F.ws + WS_HB) + (size_t)m * DM);
    for (int m = gw; m < NB * MEMLEN; m += NGW) rms_row_to_bf16(F.lane, A.in[1] + (size_t)m * DM, A.in[8], (bf16*)(F.ws + WS_HM) + (size_t)m * DM);
}

struct P1Order {
    pg8::StaticOrder so; int G, c;
    __device__ void init(int G_, int c_) { so.init(NTOK, DIN, G_, 0); G = G_; c = c_; }
    __device__ bool next(int i, pg8::Unit& u) const {
        long L = (long)i * G + c;
        if (L < 1664) { pg8::StaticOrder t = so; t.G = 1; t.c = 0; return t.next((int)L, u); }
        L -= 1664; if (L >= 16) return false;
        u.pm = 64 + (int)(L >> 2); u.pn = 26 + (int)(L & 3); return true;
    }
    __device__ __forceinline__ void a_ready(const pg8::Unit&) const {}
    __device__ __forceinline__ void done(const pg8::Unit&) const {}
};
__device__ __forceinline__ float sigmoid_f(float x) { return __builtin_amdgcn_rcpf(1.f + __expf(-x)); }
struct EpiP1 {
    static constexpr bool PERM = true, AFTER_DRAIN = false;
    unsigned char* ws; const float* b_gate; const float* gtab; float* KMEAN; float* MEMKSS; int atom_on;
    __device__ __forceinline__ void operator()(const pg8::f32x4 (&acc)[2][2][4][2], const pg8::Unit& u, int wr, int wc, int fr, int fq) const {
        using pg8::f32x4; using pg8::u32x4;
        const int pn = u.pn; int type, ldc, cb; size_t off; int row0 = u.pm * 256;
        if (pn == 0) { type = 0; off = WS_RQ; ldc = 256; cb = 0; }
        else if (pn == 1) { type = 1; off = WS_RK; ldc = 256; cb = 0; }
        else if (pn < 4) { type = 0; off = WS_RV; ldc = 512; cb = (pn - 2) * 256; }
        else if (pn < 6) { type = 2; off = WS_RG; ldc = 512; cb = (pn - 4) * 256; }
        else if (pn < 8) { type = 3; off = WS_MQ; ldc = 512; cb = (pn - 6) * 256; }
        else if (pn < 10) { type = 4; off = WS_MK; ldc = 512; cb = (pn - 8) * 256; }
        else if (pn < 12) { type = 0; off = WS_MV; ldc = 512; cb = (pn - 10) * 256; }
        else if (pn < 14) { type = 0; off = WS_CQ; ldc = 512; cb = (pn - 12) * 256; }
        else if (pn < 26) { type = 5; off = WS_GT; ldc = 3072; cb = (pn - 14) * 256; }
        else if (pn < 28) { type = 6; off = WS_MEMK; ldc = 512; cb = (pn - 26) * 256; row0 = (u.pm - 64) * 256; }
        else { type = 0; off = WS_MEMV; ldc = 512; cb = (pn - 28) * 256; row0 = (u.pm - 64) * 256; }
        bf16_t* base = (bf16_t*)(ws + off) + cb + 64 * wc + 8 * fq;
        const int rbase = row0 + 64 * wr + fr;
#define P1_STORE(rowp, bj, v0, v1) do { u32x4 w_; w_.x = cvt_pk_bf16((v0)[0], (v0)[1]); w_.y = cvt_pk_bf16((v0)[2], (v0)[3]); w_.z = cvt_pk_bf16((v1)[0], (v1)[1]); w_.w = cvt_pk_bf16((v1)[2], (v1)[3]); *(u32x4*)((rowp) + 32 * (bj)) = w_; } while (0)
        if (type <= 1) {
            const float sc = type == 1 ? 0.125f : 1.f;
#pragma unroll
            for (int ai = 0; ai < 2; ++ai)
#pragma unroll
                for (int m = 0; m < 4; ++m) { bf16_t* rowp = base + (size_t)(rbase + 128 * ai + 16 * m) * ldc;
#pragma unroll
                    for (int bj = 0; bj < 2; ++bj) { const f32x4 v0 = acc[ai][bj][m][0] * sc, v1 = acc[ai][bj][m][1] * sc; P1_STORE(rowp, bj, v0, v1); } }
        } else if (type == 2) {
#pragma unroll
            for (int ai = 0; ai < 2; ++ai)
#pragma unroll
                for (int m = 0; m < 4; ++m) { bf16_t* rowp = base + (size_t)(rbase + 128 * ai + 16 * m) * ldc;
#pragma unroll
                    for (int bj = 0; bj < 2; ++bj) { f32x4 v0 = acc[ai][bj][m][0], v1 = acc[ai][bj][m][1];
#pragma unroll
                        for (int j = 0; j < 4; ++j) { v0[j] = v0[j] * sigmoid_f(v0[j]); v1[j] = v1[j] * sigmoid_f(v1[j]); }
                        P1_STORE(rowp, bj, v0, v1); } }
        } else if (type == 5) {
            f32x4 bv[2][2];
#pragma unroll
            for (int bj = 0; bj < 2; ++bj)
#pragma unroll
                for (int n = 0; n < 2; ++n) bv[bj][n] = *(const f32x4*)(b_gate + cb + 64 * wc + 32 * bj + 8 * fq + 4 * n);
#pragma unroll
            for (int ai = 0; ai < 2; ++ai)
#pragma unroll
                for (int m = 0; m < 4; ++m) { bf16_t* rowp = base + (size_t)(rbase + 128 * ai + 16 * m) * ldc;
#pragma unroll
                    for (int bj = 0; bj < 2; ++bj) { f32x4 v0 = acc[ai][bj][m][0] + bv[bj][0], v1 = acc[ai][bj][m][1] + bv[bj][1];
#pragma unroll
                        for (int j = 0; j < 4; ++j) { v0[j] = sigmoid_f(v0[j]); v1[j] = sigmoid_f(v1[j]); }
                        P1_STORE(rowp, bj, v0, v1); } }
        } else if (type == 6) {
#pragma unroll
            for (int ai = 0; ai < 2; ++ai)
#pragma unroll
                for (int m = 0; m < 4; ++m) { const int row = rbase + 128 * ai + 16 * m; bf16_t* rowp = base + (size_t)row * ldc; float ss = 0.f;
#pragma unroll
                    for (int bj = 0; bj < 2; ++bj) { const f32x4 v0 = acc[ai][bj][m][0], v1 = acc[ai][bj][m][1];
                        ss += (v0[0] * v0[0] + v0[1] * v0[1]) + (v0[2] * v0[2] + v0[3] * v0[3]) + (v1[0] * v1[0] + v1[1] * v1[1]) + (v1[2] * v1[2] + v1[3] * v1[3]);
                        P1_STORE(rowp, bj, v0, v1); }
                    ss += __shfl_xor(ss, 16); ss += __shfl_xor(ss, 32);
                    if (fq == 0 && atom_on) atomicAdd(MEMKSS + (size_t)row * 4 + (cb >> 7) + (wc >> 1), ss);
                    }
        } else {
            const float* g = gtab + (type == 3 ? 0 : 64);
            f32x4 gv[2][2]; float rr[2][4];
#pragma unroll
            for (int bj = 0; bj < 2; ++bj)
#pragma unroll
                for (int n = 0; n < 2; ++n) gv[bj][n] = *(const f32x4*)(g + 32 * bj + 8 * fq + 4 * n);
#pragma unroll
            for (int ai = 0; ai < 2; ++ai)
#pragma unroll
                for (int m = 0; m < 4; ++m) { bf16_t* rowp = base + (size_t)(rbase + 128 * ai + 16 * m) * ldc; float ss = 0.f;
#pragma unroll
                    for (int bj = 0; bj < 2; ++bj) { const f32x4 v0 = acc[ai][bj][m][0], v1 = acc[ai][bj][m][1];
                        ss += (v0[0] * v0[0] + v0[1] * v0[1]) + (v0[2] * v0[2] + v0[3] * v0[3]) + (v1[0] * v1[0] + v1[1] * v1[1]) + (v1[2] * v1[2] + v1[3] * v1[3]); }
                    ss += __shfl_xor(ss, 16); ss += __shfl_xor(ss, 32);
                    const float r = (1.f / sqrtf(ss * (1.f / 64.f) + 1e-5f)) * (type == 3 ? 0.18033688011112042f : 1.f); rr[ai][m] = r;
#pragma unroll
                    for (int bj = 0; bj < 2; ++bj) { const f32x4 v0 = acc[ai][bj][m][0] * r * gv[bj][0], v1 = acc[ai][bj][m][1] * r * gv[bj][1];
                        P1_STORE(rowp, bj, v0, v1); }
                    asm volatile("" ::: "memory"); }
            if (type == 4 && atom_on) {
                float* km = KMEAN + ((size_t)u.pm * 8 + (cb >> 6) + wc) * 64 + 8 * fq;
#pragma unroll
                for (int bj = 0; bj < 2; ++bj)
#pragma unroll
                    for (int n = 0; n < 2; ++n)
#pragma unroll
                        for (int j = 0; j < 4; ++j) { float s = 0.f;
#pragma unroll
                            for (int ai = 0; ai < 2; ++ai)
#pragma unroll
                                for (int m = 0; m < 4; ++m) s += acc[ai][bj][m][n][j] * rr[ai][m];
                            s += __shfl_xor(s, 1); s += __shfl_xor(s, 2); s += __shfl_xor(s, 4); s += __shfl_xor(s, 8);
                            if (fr == 0) atomicAdd(km + 32 * bj + 4 * n + j, s * gv[bj][n][j] * (1.f / 256.f)); }
            }
        }
#undef P1_STORE
    }
};

constexpr int TB_OFF = LDSCTL_OFF + 1024;
__device__ __forceinline__ unsigned cvt_pk(float lo, float hi) { return cvt_pk_bf16(lo, hi); }

struct P3Order {
    pg8::StaticOrder so; int G, c; const unsigned char* ws;
    __device__ void init(int G_, int c_, const unsigned char* ws_) { so.init(NTOK, 1024, 1, 0); G = G_; c = c_; ws = ws_; }
    __device__ bool next(int i, pg9::Unit& u) const {
        const int tl = (i / 3) * G + c; if (tl >= 256) return false; pg8::Unit t; so.next(tl, t); u.pm = t.pm; u.pn = t.pn; u.aux = i % 3; u.cnt = 256; u.row0 = 0; u.ty = 0; return true; }
    __device__ __forceinline__ void a_ready(const pg9::Unit&, int, int) const {}
    __device__ __forceinline__ void done(const pg9::Unit&, int) const {}
    __device__ __forceinline__ int nt_of(const pg9::Unit&, int nt) const { return nt; }
    __device__ __forceinline__ const char* a_base(const pg9::Unit& u) const { return (const char*)(ws + WS_ORET) + (size_t)u.aux * (WS_OMOBA - WS_ORET) + (size_t)u.pm * 256 * 512 * 2; }
    __device__ __forceinline__ const char* b_base(const pg9::Unit& u) const { return (const char*)(ws + WS_WBR) + (size_t)u.aux * 1024 * 512 * 2 + (size_t)u.pn * 256 * 512 * 2; }
};
struct EpiP3 {
    static constexpr bool PERM = true, CHAIN = true;
    const bf16_t* GT; bf16_t* Y;
    __device__ __forceinline__ bool chain_more(const pg9::Unit& u) const { return u.aux < 2; }
    __device__ __forceinline__ void rescale(pg8::f32x4 (&acc)[2][2][4][2], const pg9::Unit& u, int wr, int wc, int fr, int fq) const {
        const int s = u.aux;
#pragma unroll
        for (int ai = 0; ai < 2; ++ai)
#pragma unroll
            for (int m = 0; m < 4; ++m) { const bf16_t* gp = GT + (size_t)(u.pm * 256 + 128 * ai + 64 * wr + 16 * m + fr) * 3072 + s * 1024 + u.pn * 256 + 32 * wc + 8 * fq;
#pragma unroll
                for (int bj = 0; bj < 2; ++bj) { const pg8::u32x4 ga = *(const pg8::u32x4*)(gp + 128 * bj), gb = *(const pg8::u32x4*)(gp + 1024 + 128 * bj);
#pragma unroll
                    for (int n = 0; n < 2; ++n)
#pragma unroll
                        for (int j = 0; j < 4; ++j) { const int e = 4 * n + j; const unsigned wa = ga[e >> 1], wb = gb[e >> 1];
                            const float fa = __uint_as_float((e & 1) ? (wa & 0xffff0000u) : (wa << 16)), fb = __uint_as_float((e & 1) ? (wb & 0xffff0000u) : (wb << 16));
                            acc[ai][bj][m][n][j] *= fa * __builtin_amdgcn_rcpf(fmaxf(fb, 1e-20f)); } }
                asm volatile("" ::: "memory"); }
    }
    __device__ __forceinline__ void operator()(const pg8::f32x4 (&acc)[2][2][4][2], const pg9::Unit& u, int wr, int wc, int fr, int fq) const {
#pragma unroll
        for (int ai = 0; ai < 2; ++ai)
#pragma unroll
            for (int m = 0; m < 4; ++m) { const size_t row = (size_t)(u.pm * 256 + 128 * ai + 64 * wr + 16 * m + fr); const bf16_t* gp = GT + row * 3072 + 2048 + u.pn * 256 + 32 * wc + 8 * fq; bf16_t* yp = Y + row * 1024 + u.pn * 256 + 32 * wc + 8 * fq;
#pragma unroll
                for (int bj = 0; bj < 2; ++bj) { const pg8::u32x4 ga = *(const pg8::u32x4*)(gp + 128 * bj); float v[8];
#pragma unroll
                    for (int n = 0; n < 2; ++n)
#pragma unroll
                        for (int j = 0; j < 4; ++j) { const int e = 4 * n + j; const unsigned wa = ga[e >> 1]; v[e] = acc[ai][bj][m][n][j] * __uint_as_float((e & 1) ? (wa & 0xffff0000u) : (wa << 16)); }
                    pg8::u32x4 w; w.x = cvt_pk(v[0], v[1]); w.y = cvt_pk(v[2], v[3]); w.z = cvt_pk(v[4], v[5]); w.w = cvt_pk(v[6], v[7]); *(pg8::u32x4*)(yp + 128 * bj) = w; }
                asm volatile("" ::: "memory"); }
    }
};
struct P4Order {
    pg8::StaticOrder so; int G, c; const unsigned char* ws;
    __device__ void init(int G_, int c_, const unsigned char* ws_) { so.init(NTOK, 1024, 1, 0); G = G_; c = c_; ws = ws_; }
    __device__ bool next(int i, pg9::Unit& u) const { const int tl = i * G + c; if (tl >= 256) return false; pg8::Unit t; so.next(tl, t); u.pm = t.pm; u.pn = t.pn; u.aux = 0; u.cnt = 256; u.row0 = 0; u.ty = 0; return true; }
    __device__ __forceinline__ void a_ready(const pg9::Unit&, int, int) const {}
    __device__ __forceinline__ void done(const pg9::Unit&, int) const {}
    __device__ __forceinline__ int nt_of(const pg9::Unit&, int nt) const { return nt; }
    __device__ __forceinline__ const char* a_base(const pg9::Unit& u) const { return (const char*)(ws + WS_Y) + (size_t)u.pm * 256 * 1024 * 2; }
    __device__ __forceinline__ const char* b_base(const pg9::Unit& u) const { return (const char*)(ws + WS_WOUT) + (size_t)u.pn * 256 * 1024 * 2; }
};
struct EpiP4 {
    static constexpr bool PERM = false, CHAIN = false;
    const float* x; float* out;
    __device__ __forceinline__ void operator()(const pg8::f32x4 (&acc)[2][2][4][2], const pg9::Unit& u, int wr, int wc, int fr, int fq) const {
#pragma unroll
        for (int ai = 0; ai < 2; ++ai)
#pragma unroll
            for (int m = 0; m < 4; ++m) { const size_t off = (size_t)(u.pm * 256 + 128 * ai + 64 * wr + 16 * m + fr) * 1024 + u.pn * 256 + 32 * wc + 4 * fq;
#pragma unroll
                for (int bj = 0; bj < 2; ++bj)
#pragma unroll
                    for (int n = 0; n < 2; ++n) { const pg8::f32x4 xv = *(const pg8::f32x4*)(x + off + 128 * bj + 16 * n); *(pg8::f32x4*)(out + off + 128 * bj + 16 * n) = xv + acc[ai][bj][m][n]; }
                if (m & 1) asm volatile("" ::: "memory"); }
    }
};
__device__ __forceinline__ float wave_max64(float v) {
#pragma unroll
    for (int o = 1; o < 64; o <<= 1) v = fmaxf(v, __shfl_xor(v, o));
    return v;
}
__device__ __forceinline__ void p5_router(Frame& F, const float* X1, const float* g_ffn, const float* w_router, const float* b_router, int* COUNTS, int* LISTS) {
    bf16_t* XT = (bf16_t*)(F.ws + WS_XT); int* TOPE = (int*)(F.ws + WS_TOPE); float* TOPW = (float*)(F.ws + WS_TOPW);
    const int lane = F.lane, e = lane & 31, tid = F.tid;
    LAS float* wsh = (LAS float*)(F.lds);
    LAS float* xs = (LAS float*)(F.lds + 36864) + F.wave * 2176;
    for (int v = F.vcu; v < NTOK / 64; v += F.G) {
        const int tw = v * 64 + F.wave * 8;
        f32x4 xr[2][4][4];
#pragma unroll
        for (int g = 0; g < 2; ++g)
#pragma unroll
            for (int q = 0; q < 4; ++q) { const float* xp = X1 + (size_t)(tw + 4 * g + q) * 1024;
#pragma unroll
                for (int j = 0; j < 4; ++j) xr[g][q][j] = *(const f32x4*)(xp + 4 * lane + 256 * j); }
        f32x4 gg[4];
#pragma unroll
        for (int j = 0; j < 4; ++j) gg[j] = *(const f32x4*)(g_ffn + 4 * lane + 256 * j);
#pragma unroll
        for (int g = 0; g < 2; ++g) { float s4[4];
#pragma unroll
            for (int q = 0; q < 4; ++q) { s4[q] = 0.f;
#pragma unroll
                for (int j = 0; j < 4; ++j) { const f32x4 x = xr[g][q][j]; s4[q] += (x.x * x.x + x.y * x.y) + (x.z * x.z + x.w * x.w); } }
#pragma unroll
            for (int o_ = 1; o_ < 64; o_ <<= 1) {
#pragma unroll
                for (int q = 0; q < 4; ++q) s4[q] += __shfl_xor(s4[q], o_); }
#pragma unroll
            for (int q = 0; q < 4; ++q) { const int t = tw + 4 * g + q; const float r = 1.f / sqrtf(s4[q] * (1.f / 1024.f) + 1e-5f);
#pragma unroll
                for (int j = 0; j < 4; ++j) { const f32x4 xn = xr[g][q][j] * r * gg[j]; xr[g][q][j] = xn;
                    uint2 w; w.x = cvt_pk(xn.x, xn.y); w.y = cvt_pk(xn.z, xn.w); *(uint2*)(XT + (size_t)t * 1024 + 4 * lane + 256 * j) = w; } } }
        pg8::f32x4 dacc[2] = {{0.f, 0.f, 0.f, 0.f}, {0.f, 0.f, 0.f, 0.f}};
        LAS bf16_t* wq = (LAS bf16_t*)wsh; LAS bf16_t* xq = (LAS bf16_t*)xs;
        const bf16_t* WR = (const bf16_t*)(F.ws + WS_WRS);
        const int fm = lane & 15, fk = lane >> 4;
#pragma unroll
        for (int qtr = 0; qtr < 4; ++qtr) {
            __syncthreads();
#pragma unroll
            for (int i = 0; i < 4; ++i) { const int ci = tid + 512 * i, hl = ci >> 10, ee = (ci >> 5) & 31, c = ci & 31;
                *(LAS v4u*)(wq + (hl * 32 + ee) * 264 + 8 * c) = *(const v4u*)(WR + (size_t)hl * 32768 + ee * 1024 + 256 * qtr + 8 * c); }
#pragma unroll
            for (int g = 0; g < 2; ++g)
#pragma unroll
                for (int q = 0; q < 4; ++q) { const f32x4 x = xr[g][q][qtr];
                    const unsigned h0 = cvt_pk(x.x, x.y), h1 = cvt_pk(x.z, x.w);
                    const unsigned l0 = cvt_pk(x.x - __uint_as_float(h0 << 16), x.y - __uint_as_float(h0 & 0xffff0000u)), l1 = cvt_pk(x.z - __uint_as_float(h1 << 16), x.w - __uint_as_float(h1 & 0xffff0000u));
                    typedef unsigned u32x2v __attribute__((ext_vector_type(2)));
                    const u32x2v hv = {h0, h1}, lv = {l0, l1};
                    *(LAS u32x2v*)(xq + (4 * g + q) * 264 + 4 * lane) = hv; *(LAS u32x2v*)(xq + (8 + 4 * g + q) * 264 + 4 * lane) = lv; }
            __syncthreads();
#pragma unroll
            for (int ks = 0; ks < 8; ++ks) {
                const pg8::bf16x8 bh = *(const LAS pg8::bf16x8*)(xq + (fm & 7) * 264 + 32 * ks + 8 * fk), bl = *(const LAS pg8::bf16x8*)(xq + (8 + (fm & 7)) * 264 + 32 * ks + 8 * fk);
#pragma unroll
                for (int et = 0; et < 2; ++et) {
                    const pg8::bf16x8 ah = *(const LAS pg8::bf16x8*)(wq + (16 * et + fm) * 264 + 32 * ks + 8 * fk), al = *(const LAS pg8::bf16x8*)(wq + (32 + 16 * et + fm) * 264 + 32 * ks + 8 * fk);
                    dacc[et] = __builtin_amdgcn_mfma_f32_16x16x32_bf16(ah, bh, dacc[et], 0, 0, 0);
                    dacc[et] = __builtin_amdgcn_mfma_f32_16x16x32_bf16(ah, bl, dacc[et], 0, 0, 0);
                    dacc[et] = __builtin_amdgcn_mfma_f32_16x16x32_bf16(al, bh, dacc[et], 0, 0, 0); } }
            asm volatile("s_waitcnt lgkmcnt(0)" ::: "memory");
        }
        float acc[2][4];
        { LAS float* lg = (LAS float*)xq;
          if (fm < 8) {
#pragma unroll
              for (int et = 0; et < 2; ++et)
#pragma unroll
                  for (int r = 0; r < 4; ++r) lg[fm * 33 + 16 * et + 4 * fk + r] = dacc[et][r]; }
          asm volatile("s_waitcnt lgkmcnt(0)" ::: "memory");
#pragma unroll
          for (int t8 = 0; t8 < 8; ++t8) acc[t8 >> 2][t8 & 3] = lg[t8 * 33 + e];
          asm volatile("s_waitcnt lgkmcnt(0)" ::: "memory"); }
        volatile LAS int* lcnt = (volatile LAS int*)(F.lds + TB_OFF);
        __syncthreads();
        if (tid < 32) lcnt[tid] = 0;
        __syncthreads();
        const float bias = b_router[e];
        int my_e[2][4], my_r[2][4];
#pragma unroll
        for (int g = 0; g < 2; ++g)
#pragma unroll
            for (int q = 0; q < 4; ++q) { const int t = tw + 4 * g + q; float lg = acc[g][q] + bias; if (lane >= 32) lg = -INFINITY;
                float tv[4]; int te[4];
#pragma unroll
                for (int k = 0; k < 4; ++k) { const float m = wave_max64(lg); const unsigned long long bal = __ballot(lg == m); const int ee = __ffsll((long long)bal) - 1; tv[k] = m; te[k] = ee; if (lane == ee) lg = -INFINITY; }
                float ex[4], se = 0.f;
#pragma unroll
                for (int k = 0; k < 4; ++k) { ex[k] = __expf(tv[k] - tv[0]); se += ex[k]; }
                int e_l = te[0]; float w_l = ex[0];
#pragma unroll
                for (int k = 1; k < 4; ++k) if (lane == k) { e_l = te[k]; w_l = ex[k]; }
                my_e[g][q] = e_l; my_r[g][q] = 0;
                if (lane < 4) { TOPE[t * 4 + lane] = e_l; TOPW[t * 4 + lane] = w_l / se; my_r[g][q] = __hip_atomic_fetch_add((LAS int*)(F.lds + TB_OFF) + e_l, 1, __ATOMIC_RELAXED, __HIP_MEMORY_SCOPE_WORKGROUP); } }
        __syncthreads();
        if (tid < 32) { int t2 = tid; asm volatile("" : "+v"(t2)); const int c = lcnt[t2]; lcnt[32 + t2] = c ? atomicAdd(&COUNTS[t2], c) : 0; }
        __syncthreads();
#pragma unroll
        for (int g = 0; g < 2; ++g)
#pragma unroll
            for (int q = 0; q < 4; ++q) if (lane < 4) { const int t = tw + 4 * g + q; LISTS[(size_t)my_e[g][q] * 16384 + lcnt[32 + my_e[g][q]] + my_r[g][q]] = t * 4 + lane; }
    }
}
__device__ __forceinline__ void moe_tables(Frame& F) {
    volatile LAS int* TB = (volatile LAS int*)(F.lds + TB_OFF);
    if (F.tid < 64) {
        const int* COUNTS = (const int*)F.ctl + CW_COUNTS; const int ln = F.tid;
        const int c = ln < 32 ? __hip_atomic_load(COUNTS + ln, __ATOMIC_RELAXED, __HIP_MEMORY_SCOPE_AGENT) : 0;
        int inc = (c + 255) >> 8;
#pragma unroll
        for (int o = 1; o < 32; o <<= 1) { const int v = __shfl_up(inc, o); if (ln >= o) inc += v; }
        if (ln < 32) { TB[ln] = inc - ((c + 255) >> 8); TB[33 + ln] = c; }
        if (ln == 31) TB[32] = inc;
    }
    __syncthreads();
}
template <int NPN_LOG2, size_t WOFF, int NROWS_B, int ASHIFT, size_t AOFF> struct MoeOrder {
    int perx, xcd, l; const unsigned char* ws; const LAS int* TB; const int* LISTS;
    __device__ void init(int G_, int vcu_, const unsigned char* ws_, const LAS int* TB_) { perx = G_ / 8; xcd = vcu_ / perx; l = vcu_ % perx; ws = ws_; TB = TB_; LISTS = (const int*)(ws_ + WS_LISTS); }
    __device__ bool next(int i, pg9::Unit& u) const {
        const int uidx = i * perx + l; const int mt = TB[4 * xcd] + (uidx >> NPN_LOG2); if (mt >= TB[4 * xcd + 4]) return false;
        int e = 4 * xcd;
#pragma unroll
        for (int k = 1; k < 4; ++k) if (TB[4 * xcd + k] <= mt) e = 4 * xcd + k;
        u.aux = e; u.pm = mt - TB[e]; u.pn = uidx & ((1 << NPN_LOG2) - 1); u.cnt = TB[33 + e] - u.pm * 256; u.row0 = mt * 256; u.ty = 0; return true;
    }
    __device__ __forceinline__ void a_ready(const pg9::Unit&, int, int) const {}
    __device__ __forceinline__ void done(const pg9::Unit&, int) const {}
    __device__ __forceinline__ int nt_of(const pg9::Unit&, int nt) const { return nt; }
    __device__ __forceinline__ const char* a_base(const pg9::Unit& u) const { return (const char*)(ws + AOFF) + (ASHIFT == 0 ? (size_t)u.row0 * 2048 : (size_t)0); }
    __device__ __forceinline__ const char* b_base(const pg9::Unit& u) const { return (const char*)(ws + WOFF) + ((size_t)u.aux * NROWS_B + (size_t)u.pn * 256) * 1024 * 2; }
    __device__ __forceinline__ unsigned a_row_off(const pg9::Unit& u, int r) const { const int rr = r < u.cnt ? r : u.cnt - 1; const int id = LISTS[(size_t)u.aux * 16384 + u.pm * 256 + rr]; return (unsigned)(id >> ASHIFT) * 2048u; }
};
constexpr bool MOE2_SPLIT = false;
constexpr size_t WS_PB = WS_GT;
__device__ __forceinline__ void moe2_split(int ntiles, int perx, int& base, int& L, int& spl) {
    const int U = 4 * ntiles, R = U / perx; base = R * perx; L = U - base;
    spl = (!MOE2_SPLIT || L == 0 || (perx & 3)) ? 1 : (4 * L <= perx ? 4 : (2 * L <= perx ? 2 : 1));
}
__device__ __forceinline__ int pb_row(int x, int s, int jt) { return ((x * 3 + (s - 1)) * 4 + jt) * 256; }
struct Moe2SplitOrder {
    int perx, xcd, l, T0, R, base, L, spl; const unsigned char* ws; const LAS int* TB;
    __device__ void init(int G_, int vcu_, const unsigned char* ws_, const LAS int* TB_) { perx = G_ / 8; xcd = vcu_ / perx; l = vcu_ % perx; ws = ws_; TB = TB_; T0 = TB[4 * xcd]; moe2_split(TB[4 * xcd + 4] - T0, perx, base, L, spl); R = base / perx;
        T0 = __builtin_amdgcn_readfirstlane(T0); R = __builtin_amdgcn_readfirstlane(R); base = __builtin_amdgcn_readfirstlane(base); L = __builtin_amdgcn_readfirstlane(L); spl = __builtin_amdgcn_readfirstlane(spl); }
    __device__ bool next(int i, pg9::Unit& u) const {
        int uidx, s = 0, sp = 1;
        if (i < R) uidx = i * perx + l;
        else if (i == R && l < L * spl) { s = (l >= L) + (l >= 2 * L) + (l >= 3 * L); uidx = base + l - s * L; sp = spl; }
        else return false;
        const int mt = T0 + (uidx >> 2);
        int e = 4 * xcd;
#pragma unroll
        for (int k = 1; k < 4; ++k) if (TB[4 * xcd + k] <= mt) e = 4 * xcd + k;
        u.aux = e; u.pm = mt - TB[e]; u.pn = uidx & 3; u.cnt = TB[33 + e] - u.pm * 256; u.row0 = mt * 256; u.ty = s | (sp << 4) | (((uidx >> 2) - (base >> 2)) << 8);
        u.aux = __builtin_amdgcn_readfirstlane(u.aux); u.pm = __builtin_amdgcn_readfirstlane(u.pm); u.pn = __builtin_amdgcn_readfirstlane(u.pn); u.cnt = __builtin_amdgcn_readfirstlane(u.cnt);
        u.row0 = __builtin_amdgcn_readfirstlane(u.row0); u.ty = __builtin_amdgcn_readfirstlane(u.ty); return true;
    }
    __device__ __forceinline__ void a_ready(const pg9::Unit&, int, int) const {}
    __device__ __forceinline__ void done(const pg9::Unit&, int) const {}
    __device__ __forceinline__ int nt_of(const pg9::Unit& u, int nt) const { return nt >> (((u.ty >> 4) & 15) >> 1); }
    __device__ __forceinline__ size_t koff(const pg9::Unit& u) const { return (size_t)((u.ty & 15) * (2048 >> (((u.ty >> 4) & 15) >> 1))); }
    __device__ __forceinline__ const char* a_base(const pg9::Unit& u) const { return (const char*)(ws + WS_ACT) + (size_t)u.row0 * 2048 + koff(u); }
    __device__ __forceinline__ const char* b_base(const pg9::Unit& u) const { return (const char*)(ws + WS_W2) + ((size_t)u.aux * 1024 + (size_t)u.pn * 256) * 1024 * 2 + koff(u); }
};
struct EpiMoe1 {
    static constexpr bool PERM = true, CHAIN = false;
    const int* LISTS; const float* b1; bf16_t* ACT; int* SLOT;
    __device__ __forceinline__ void operator()(const pg8::f32x4 (&acc)[2][2][4][2], const pg9::Unit& u, int wr, int wc, int fr, int fq) const {
        const int e = u.aux; const int c0 = u.pn * 256 + 32 * wc + 8 * fq;
        pg8::f32x4 bv[2][2];
#pragma unroll
        for (int bj = 0; bj < 2; ++bj)
#pragma unroll
            for (int n = 0; n < 2; ++n) bv[bj][n] = *(const pg8::f32x4*)(b1 + (size_t)e * 2048 + c0 + 128 * bj + 4 * n);
        const bool slotw = (u.pn == 0) && (wc == 0) && (fq == 0);
#pragma unroll
        for (int ai = 0; ai < 2; ++ai)
#pragma unroll
            for (int m = 0; m < 4; ++m) { const int r = 128 * ai + 64 * wr + 16 * m + fr; const bool ok = r < u.cnt;
                if (slotw && ok) SLOT[LISTS[(size_t)e * 16384 + u.pm * 256 + r]] = u.row0 + r;
#pragma unroll
                for (int bj = 0; bj < 2; ++bj) { float a[4];
#pragma unroll
                    for (int n = 0; n < 2; ++n)
#pragma unroll
                        for (int p = 0; p < 2; ++p) { const float gl = fminf(acc[ai][bj][m][n][2 * p] + bv[bj][n][2 * p], 7.0f); const float li = fminf(fmaxf(acc[ai][bj][m][n][2 * p + 1] + bv[bj][n][2 * p + 1], -7.0f), 7.0f);
                            a[2 * n + p] = gl * sigmoid_f(1.702f * gl) * (li + 1.f); }
                    if (ok) { uint2 w; w.x = cvt_pk(a[0], a[1]); w.y = cvt_pk(a[2], a[3]); *(uint2*)(ACT + (size_t)(u.row0 + r) * 1024 + ((c0 + 128 * bj) >> 1)) = w; } }
                asm volatile("" ::: "memory"); }
    }
};
struct EpiMoe2 {
    static constexpr bool PERM = true, CHAIN = false;
    const float* b2; unsigned char* ws;
    __device__ __forceinline__ void operator()(const pg8::f32x4 (&acc)[2][2][4][2], const pg9::Unit& u, int wr, int wc, int fr, int fq) const {
        asm volatile("" : "+v"(fr));
        const int e = u.aux; const int c0 = u.pn * 256 + 32 * wc + 8 * fq; const int sl = u.ty & 15;
        pg8::f32x4 bv[2][2];
#pragma unroll
        for (int bj = 0; bj < 2; ++bj)
#pragma unroll
            for (int n = 0; n < 2; ++n) bv[bj][n] = sl ? (pg8::f32x4){0.f, 0.f, 0.f, 0.f} : *(const pg8::f32x4*)(b2 + (size_t)e * 1024 + c0 + 128 * bj + 4 * n);
        bf16_t* D = (bf16_t*)(ws + (sl ? WS_PB : WS_YS)) + (size_t)(sl ? pb_row(e >> 2, sl, u.ty >> 8) : u.row0) * 1024;
#pragma unroll
        for (int ai = 0; ai < 2; ++ai)
#pragma unroll
            for (int m = 0; m < 4; ++m) { const int r = 128 * ai + 64 * wr + 16 * m + fr; const bool ok = r < u.cnt;
#pragma unroll
                for (int bj = 0; bj < 2; ++bj) { const pg8::f32x4 v0 = acc[ai][bj][m][0] + bv[bj][0], v1 = acc[ai][bj][m][1] + bv[bj][1];
                    if (ok) { pg8::u32x4 w; w.x = cvt_pk(v0[0], v0[1]); w.y = cvt_pk(v0[2], v0[3]); w.z = cvt_pk(v1[0], v1[1]); w.w = cvt_pk(v1[2], v1[3]); *(pg8::u32x4*)(D + (size_t)r * 1024 + c0 + 128 * bj) = w; } }
                asm volatile("" ::: "memory"); }
    }
};

__device__ __forceinline__ void p8_combine(Frame& F, const float* src, float* out) {
    const bf16_t* YS = (const bf16_t*)(F.ws + WS_YS); const bf16_t* PB = (const bf16_t*)(F.ws + WS_PB); const float* TOPW = (const float*)(F.ws + WS_TOPW); const int* SLOT = (const int*)(F.ws + WS_SLOT);
    const int gw = F.vcu * NWAVES + F.wave, NGW = F.G * NWAVES, lane = F.lane;
    volatile LAS int* TB = (volatile LAS int*)(F.lds + TB_OFF);
    if (MOE2_SPLIT) moe_tables(F);
    if (MOE2_SPLIT && F.tid < 8) { int base, L, spl; moe2_split(TB[4 * F.tid + 4] - TB[4 * F.tid], F.G / 8, base, L, spl); TB[72 + 2 * F.tid] = base; TB[73 + 2 * F.tid] = spl; }
    __syncthreads();
    for (int t = gw; t < NTOK; t += NGW) {
        const f32x4 w4 = *(const f32x4*)(TOPW + (size_t)t * 4); const int4 s4 = *(const int4*)(SLOT + (size_t)t * 4); const int sl[4] = {s4.x, s4.y, s4.z, s4.w};
        int spk[4], ltk[4], xk[4], bk[4];
#pragma unroll
        for (int k = 0; k < 4; ++k) { if (!MOE2_SPLIT) { xk[k] = ltk[k] = bk[k] = 0; spk[k] = 1; continue; } const int mt = sl[k] >> 8; int x = 0;
#pragma unroll
            for (int q = 1; q < 8; ++q) if (TB[4 * q] <= mt) x = q;
            xk[k] = x; ltk[k] = mt - TB[4 * x]; bk[k] = TB[72 + 2 * x]; spk[k] = TB[73 + 2 * x]; }
        const bool anysplit = (spk[0] | spk[1] | spk[2] | spk[3]) > 1;
#pragma unroll
        for (int j = 0; j < 2; ++j) {
            const int c = 8 * lane + 512 * j; f32x4 a0 = *(const f32x4*)(src + (size_t)t * 1024 + c), a1 = *(const f32x4*)(src + (size_t)t * 1024 + c + 4);
#pragma unroll
            for (int k = 0; k < 4; ++k) { const v4u y = __builtin_nontemporal_load((const v4u*)(YS + (size_t)sl[k] * 1024 + c)); const float wk = w4[k];
                a0.x += wk * __uint_as_float(y.x << 16); a0.y += wk * __uint_as_float(y.x & 0xffff0000u); a0.z += wk * __uint_as_float(y.y << 16); a0.w += wk * __uint_as_float(y.y & 0xffff0000u);
                a1.x += wk * __uint_as_float(y.z << 16); a1.y += wk * __uint_as_float(y.z & 0xffff0000u); a1.z += wk * __uint_as_float(y.w << 16); a1.w += wk * __uint_as_float(y.w & 0xffff0000u); }
            if (anysplit) {
                const int pn = (lane >> 5) + 2 * j;
#pragma unroll
                for (int k = 0; k < 4; ++k) if (spk[k] > 1 && 4 * ltk[k] + pn >= bk[k]) { const float wk = w4[k]; const int jt = ltk[k] - (bk[k] >> 2);
                    for (int s = 1; s < spk[k]; ++s) { const v4u y = *(const v4u*)(PB + (size_t)(pb_row(xk[k], s, jt) + (sl[k] & 255)) * 1024 + c);
                        a0.x += wk * __uint_as_float(y.x << 16); a0.y += wk * __uint_as_float(y.x & 0xffff0000u); a0.z += wk * __uint_as_float(y.y << 16); a0.w += wk * __uint_as_float(y.y & 0xffff0000u);
                        a1.x += wk * __uint_as_float(y.z << 16); a1.y += wk * __uint_as_float(y.z & 0xffff0000u); a1.z += wk * __uint_as_float(y.w << 16); a1.w += wk * __uint_as_float(y.w & 0xffff0000u); } }
            }
            __builtin_nontemporal_store(a0, (f32x4*)(out + (size_t)t * 1024 + c)); __builtin_nontemporal_store(a1, (f32x4*)(out + (size_t)t * 1024 + c + 4)); }
    }
}
namespace att {
typedef float f32x16 __attribute__((ext_vector_type(16)));
typedef float f32x8 __attribute__((ext_vector_type(8)));
using pg8::f32x2;
typedef short s16x4 __attribute__((ext_vector_type(4)));
typedef short v4i16_t __attribute__((ext_vector_type(4)));
using pg8::bf16x8;
constexpr float LOG2E = 1.4426950408889634f;
__device__ __forceinline__ constexpr int crow(int r, int hi) { return (r & 3) + 8 * (r >> 2) + 4 * hi; }
template <int D> __device__ __forceinline__ int kswz(int row) { return D == 64 ? ((row >> 1) & 7) : (row & 15); }
template <int D> __device__ __forceinline__ int vswz(int row) { return D == 64 ? (((row >> 1) & 1) << 2) : ((row & 3) << 2); }
__device__ __forceinline__ s16x4 vtr(const LAS unsigned char* p) { return __builtin_bit_cast(s16x4, __builtin_amdgcn_ds_read_tr16_b64_v4i16((LAS v4i16_t*)p)); }
__device__ __forceinline__ bf16x8 pack8(const f32x16& x, int s) {
    typedef unsigned u32x4_t __attribute__((ext_vector_type(4))); u32x4_t p;
    p[0] = cvt_pk_bf16(x[8 * s + 0], x[8 * s + 1]); p[1] = cvt_pk_bf16(x[8 * s + 2], x[8 * s + 3]); p[2] = cvt_pk_bf16(x[8 * s + 4], x[8 * s + 5]); p[3] = cvt_pk_bf16(x[8 * s + 6], x[8 * s + 7]);
    return __builtin_bit_cast(bf16x8, p);
}
__device__ __forceinline__ float bfl(unsigned w) { return __uint_as_float(w << 16); }
__device__ __forceinline__ float bfh(unsigned w) { return __uint_as_float(w & 0xffff0000u); }

template <bool MOBA, int TK> __device__ __forceinline__ int tile_kbase(int tt, int qb) { constexpr int TPB = 256 / TK; if (!MOBA) return TK * tt; if (tt < TPB) return qb * 256 + TK * tt; const int u = tt - TPB; return (u / TPB) * 256 + TK * (u % TPB); }
template <int D, bool MOBA, int NSUB>
__device__ __forceinline__ void attn_unit(Frame& F, const int b, const int h, const int qb,
                                          const bf16_t* Qg, const bf16_t* Kg, const bf16_t* Vg, bf16_t* Og, const int ld,
                                          const float* KMEAN, const float* KSS, const float* gq, const float* gk) {
    constexpr int NKH = 2  , TK = 64 * NSUB  , KB = TK * D * 2, NKS = D / 16, NDH = D / 32, CPR = D / 8  , NST = (TK * CPR) / 512  ;
    int tid = F.tid, lane = F.lane; asm volatile("" : "+v"(tid), "+v"(lane));
    const int wave = F.wave, r32 = lane & 31, hi = lane >> 5;
    LAS unsigned char* lds = F.lds;
    const size_t qrow = (size_t)b * SEQ + qb * 256 + wave * 32 + r32;
    bf16x8 qr[NKS];
#pragma unroll
    for (int ks = 0; ks < NKS; ++ks) qr[ks] = *(const bf16x8*)(Qg + qrow * ld + h * D + 16 * ks + 8 * hi);
    unsigned selmask = 0u;
    if constexpr (MOBA) {
        if (qb > 0) {
            LAS float* kml = (LAS float*)(lds + 4 * KB);
            if (tid < qb * 16) *(LAS f32x4*)(kml + 4 * tid) = *(const f32x4*)(KMEAN + (((size_t)b * 16 + (tid >> 4)) * 8 + h) * 64 + 4 * (tid & 15));
            __syncthreads();
            float qf[NKS * 8];
#pragma unroll
            for (int ks = 0; ks < NKS; ++ks) { const pg8::u32x4 w = __builtin_bit_cast(pg8::u32x4, qr[ks]);
#pragma unroll
                for (int j = 0; j < 4; ++j) { qf[ks * 8 + 2 * j] = bfl(w[j]); qf[ks * 8 + 2 * j + 1] = bfh(w[j]); } }
            float v0 = -INFINITY, v1 = -INFINITY, v2 = -INFINITY; int i0 = -1, i1 = -1, i2 = -1;
#pragma unroll 1
            for (int j = 0; j < qb; ++j) { const LAS float* km = kml + 64 * j + 8 * hi; float s = 0.f;
#pragma unroll
                for (int ks = 0; ks < NKS; ++ks) { const f32x4 k0 = *(const LAS f32x4*)(km + 16 * ks), k1 = *(const LAS f32x4*)(km + 16 * ks + 4);
                    s += qf[ks * 8 + 0] * k0[0] + qf[ks * 8 + 1] * k0[1] + qf[ks * 8 + 2] * k0[2] + qf[ks * 8 + 3] * k0[3] + qf[ks * 8 + 4] * k1[0] + qf[ks * 8 + 5] * k1[1] + qf[ks * 8 + 6] * k1[2] + qf[ks * 8 + 7] * k1[3]; }
                s += __shfl_xor(s, 32);
                const bool c0 = s > v0, c1 = s > v1, c2 = s > v2;
                v2 = c1 ? v1 : (c2 ? s : v2); i2 = c1 ? i1 : (c2 ? j : i2);
                v1 = c0 ? v0 : (c1 ? s : v1); i1 = c0 ? i0 : (c1 ? j : i1);
                v0 = c0 ? s : v0; i0 = c0 ? j : i0; }
            selmask = (i0 >= 0 ? (1u << i0) : 0u) | (i1 >= 0 ? (1u << i1) : 0u) | (i2 >= 0 ? (1u << i2) : 0u);
        }
    } else {
        float qf[NKS * 8]; float ss = 0.f;
#pragma unroll
        for (int ks = 0; ks < NKS; ++ks) { const pg8::u32x4 w = __builtin_bit_cast(pg8::u32x4, qr[ks]);
#pragma unroll
            for (int j = 0; j < 4; ++j) { qf[ks * 8 + 2 * j] = bfl(w[j]); qf[ks * 8 + 2 * j + 1] = bfh(w[j]); ss += qf[ks * 8 + 2 * j] * qf[ks * 8 + 2 * j] + qf[ks * 8 + 2 * j + 1] * qf[ks * 8 + 2 * j + 1]; } }
        ss += __shfl_xor(ss, 32);
        const float rq = (1.f / sqrtf(ss * (1.f / D) + 1e-5f)) * (0.08838834764831845f * LOG2E);
#pragma unroll
        for (int ks = 0; ks < NKS; ++ks) { const float* g1 = gq + 16 * ks + 8 * hi; const float* g2 = gk + 16 * ks + 8 * hi; pg8::u32x4 w;
#pragma unroll
            for (int j = 0; j < 4; ++j) w[j] = cvt_pk_bf16(qf[ks * 8 + 2 * j] * rq * g1[2 * j] * g2[2 * j], qf[ks * 8 + 2 * j + 1] * rq * g1[2 * j + 1] * g2[2 * j + 1]);
            qr[ks] = __builtin_bit_cast(bf16x8, w); }
    }
    constexpr int TPB = 256 / TK;
    const int NT = MOBA ? TPB * (qb + 1) : TPB;
    const float sl2 = MOBA ? exp2f(-(float)(h + 1)) * LOG2E : 0.f;
    v4u kreg[NST], vreg[NST];
#define ATT_LOAD(tt) do { const int kb_ = tile_kbase<MOBA, TK>(tt, qb); _Pragma("unroll") for (int i_ = 0; i_ < NST; ++i_) { const int ci_ = tid + 512 * i_, row_ = ci_ / CPR, ch_ = ci_ % CPR; \
        const size_t g_ = (size_t)(kb_ + row_) * ld + h * D + 8 * ch_; kreg[i_] = *(const v4u*)(Kg + g_); vreg[i_] = *(const v4u*)(Vg + g_); \
        if (!MOBA) { const float rk_ = 1.f / sqrtf(KSS[(size_t)(kb_ + row_) * 4 + h] * (1.f / D) + 1e-5f); v4u k_ = kreg[i_]; \
            k_.x = cvt_pk_bf16(bfl(k_.x) * rk_, bfh(k_.x) * rk_); k_.y = cvt_pk_bf16(bfl(k_.y) * rk_, bfh(k_.y) * rk_); k_.z = cvt_pk_bf16(bfl(k_.z) * rk_, bfh(k_.z) * rk_); k_.w = cvt_pk_bf16(bfl(k_.w) * rk_, bfh(k_.w) * rk_); kreg[i_] = k_; } } } while (0)
#define ATT_WRITE(buf) do { _Pragma("unroll") for (int i_ = 0; i_ < NST; ++i_) { const int ci_ = tid + 512 * i_, row_ = ci_ / CPR, ch_ = ci_ % CPR; \
        *(LAS v4u*)(lds + (buf) * KB + row_ * (2 * D) + ((ch_ ^ kswz<D>(row_)) << 4)) = kreg[i_]; *(LAS v4u*)(lds + (2 + (buf)) * KB + row_ * (2 * D) + ((ch_ ^ vswz<D>(row_)) << 4)) = vreg[i_]; } } while (0)
    ATT_LOAD(0); ATT_WRITE(0);
    __syncthreads();
    float m = -1e30f, l = 0.f;
    f32x16 o[NDH];
#pragma unroll
    for (int dh = 0; dh < NDH; ++dh)
#pragma unroll
        for (int r = 0; r < 16; ++r) o[dh][r] = 0.f;
    const int qrel = wave * 32 + r32;
    f32x16 cinit[NKH];
#pragma unroll
    for (int kh = 0; kh < NKH; ++kh)
#pragma unroll
        for (int r = 0; r < 16; ++r) cinit[kh][r] = MOBA ? sl2 * (float)(32 * kh + (r & 3) + 8 * (r >> 2)) : 0.f;
    for (int tt = 0; tt < NT; ++tt) {
        int lane_t = lane; asm volatile("" : "+v"(lane_t));
        const int r32 = lane_t & 31, hi = lane_t >> 5, i16 = lane_t & 15, blk = (lane_t >> 4) & 1, tq = i16 >> 2, tp = i16 & 3;
        const int buf = tt & 1;
        if (tt + 1 < NT) ATT_LOAD(tt + 1);
#pragma unroll 1
        for (int sub = 0; sub < NSUB; ++sub) {
        bool act = true; bool lane_sel = true; int pblk = -1;
        if constexpr (MOBA) { if (tt >= TPB) { pblk = (tt - TPB) / TPB; lane_sel = (selmask >> pblk) & 1u; act = __builtin_amdgcn_ballot_w64(lane_sel) != 0ull; }
            else act = (TK * tt + 64 * sub <= wave * 32 + 31); }
        if (act) {
            f32x16 p[NKH];
            const LAS unsigned char* Kb = lds + buf * KB + sub * 64 * (2 * D);
#pragma unroll
            for (int ks = 0; ks < NKS; ++ks) {
#pragma unroll
                for (int kh = 0; kh < NKH; ++kh) { const int row = 32 * kh + r32;
                    const bf16x8 a = *(const LAS bf16x8*)(Kb + row * (2 * D) + (((2 * ks + hi) ^ kswz<D>(row)) << 4));
                    p[kh] = __builtin_amdgcn_mfma_f32_32x32x16_bf16(a, qr[ks], ks == 0 ? cinit[kh] : p[kh], 0, 0, 0); }
            }
            float offl = 0.f;
            if constexpr (MOBA) {
                const int kb = tile_kbase<MOBA, TK>(tt, qb) + 64 * sub; offl = sl2 * (float)(kb - qb * 256 + 4 * hi);
                if (tt < TPB) {
                    const int k0 = TK * tt + 64 * sub + 4 * hi;
#pragma unroll
                    for (int kh = 0; kh < NKH; ++kh)
#pragma unroll
                        for (int r = 0; r < 16; ++r) { const int kv = k0 + 32 * kh + (r & 3) + 8 * (r >> 2); if (kv > qrel) p[kh][r] = -INFINITY; }
                } else if (!lane_sel) {
#pragma unroll
                    for (int kh = 0; kh < NKH; ++kh)
#pragma unroll
                        for (int r = 0; r < 16; ++r) p[kh][r] = -INFINITY;
                }
            }
            float mx = p[0][0];
#pragma unroll
            for (int kh = 0; kh < NKH; ++kh)
#pragma unroll
                for (int r = 0; r < 16; ++r) mx = fmaxf(mx, p[kh][r]);
            mx += offl;
            mx = fmaxf(mx, __shfl_xor(mx, 32));
            const float mnew = fmaxf(m, mx);
            if (__builtin_amdgcn_ballot_w64(mnew > m) != 0ull) { const float alpha = __builtin_amdgcn_exp2f(m - mnew); l *= alpha;
#pragma unroll
                for (int dh = 0; dh < NDH; ++dh)
#pragma unroll
                    for (int r = 0; r < 16; ++r) o[dh][r] *= alpha;
                m = mnew; }
            float ps = 0.f; const float mt = m - offl;
#pragma unroll
            for (int kh = 0; kh < NKH; ++kh)
#pragma unroll
                for (int r = 0; r < 16; ++r) { p[kh][r] = __builtin_amdgcn_exp2f(p[kh][r] - mt); ps += p[kh][r]; }
            l += ps;
            const LAS unsigned char* Vb = lds + (2 + buf) * KB + sub * 64 * (2 * D);
#pragma unroll
            for (int kh = 0; kh < NKH; ++kh)
#pragma unroll
                for (int s = 0; s < 2; ++s) {
                    const bf16x8 pb = pack8(p[kh], s);
#pragma unroll
                    for (int dh = 0; dh < NDH; ++dh) {
                        const int rowA = 32 * kh + 16 * s + 4 * hi + tq, rowB = rowA + 8, chv = 4 * dh + 2 * blk + (tp >> 1);
                        const s16x4 lo = vtr(Vb + rowA * (2 * D) + ((chv ^ vswz<D>(rowA)) << 4) + 8 * (tp & 1));
                        const s16x4 hh = vtr(Vb + rowB * (2 * D) + ((chv ^ vswz<D>(rowB)) << 4) + 8 * (tp & 1));
                        const bf16x8 va = (bf16x8){lo[0], lo[1], lo[2], lo[3], hh[0], hh[1], hh[2], hh[3]};
                        o[dh] = __builtin_amdgcn_mfma_f32_32x32x16_bf16(va, pb, o[dh], 0, 0, 0);
                    }
                }
        }
        }
        if (tt + 1 < NT) ATT_WRITE(buf ^ 1);
        __syncthreads();
    }
    l += __shfl_xor(l, 32);
    const float inv = 1.f / l;
    bf16_t* orow = Og + qrow * ld + h * D;
#pragma unroll
    for (int dh = 0; dh < NDH; ++dh)
#pragma unroll
        for (int g = 0; g < 4; ++g) { uint2 w; w.x = cvt_pk_bf16(o[dh][4 * g] * inv, o[dh][4 * g + 1] * inv); w.y = cvt_pk_bf16(o[dh][4 * g + 2] * inv, o[dh][4 * g + 3] * inv);
            *(uint2*)(orow + 32 * dh + 8 * g + 4 * hi) = w; }
#undef ATT_LOAD
#undef ATT_WRITE
}

__device__ __forceinline__ void mem_attn_group(Frame& F, const int b, const int h, const int qb0, const int NQ,
                                               const bf16_t* Qg, const bf16_t* Kg, const bf16_t* Vg, bf16_t* Og, const float* KSS, const float* gq, const float* gk) {
    constexpr int D = 128, ld = 512, NKH = 2, KB = 64 * D * 2, NKS = D / 16, NDH = D / 32, CPR = D / 8;
    int tid = F.tid, lane = F.lane; asm volatile("" : "+v"(tid), "+v"(lane));
    const int wave = F.wave;
    LAS unsigned char* lds = F.lds;
    bf16x8 qn[NKS];
    { const size_t qrow0 = (size_t)b * SEQ + qb0 * 256 + wave * 32 + (lane & 31);
#pragma unroll
      for (int ks = 0; ks < NKS; ++ks) qn[ks] = *(const bf16x8*)(Qg + qrow0 * ld + h * D + 16 * ks + 8 * (lane >> 5)); }
    {
        v4u kreg[8], vreg[8]; float rks[8];
#pragma unroll
        for (int i = 0; i < 8; ++i) { const int ci = tid + 512 * i, row = ci / CPR, ch = ci % CPR; const size_t g_ = (size_t)row * ld + h * D + 8 * ch; kreg[i] = *(const v4u*)(Kg + g_); vreg[i] = *(const v4u*)(Vg + g_); rks[i] = KSS[(size_t)row * 4 + h]; }
        float gg[8];
        { const int ch = tid % CPR; const f32x4 a0 = *(const f32x4*)(gq + 8 * ch), a1 = *(const f32x4*)(gq + 8 * ch + 4), b0 = *(const f32x4*)(gk + 8 * ch), b1 = *(const f32x4*)(gk + 8 * ch + 4);
          gg[0] = a0.x * b0.x; gg[1] = a0.y * b0.y; gg[2] = a0.z * b0.z; gg[3] = a0.w * b0.w; gg[4] = a1.x * b1.x; gg[5] = a1.y * b1.y; gg[6] = a1.z * b1.z; gg[7] = a1.w * b1.w; }
#pragma unroll
        for (int i = 0; i < 8; ++i) { const int ci = tid + 512 * i, row = ci / CPR, ch = ci % CPR, t = row >> 6, rr = row & 63;
            const float rk = 1.f / sqrtf(rks[i] * (1.f / D) + 1e-5f); v4u k_ = kreg[i];
            k_.x = cvt_pk_bf16(bfl(k_.x) * rk * gg[0], bfh(k_.x) * rk * gg[1]); k_.y = cvt_pk_bf16(bfl(k_.y) * rk * gg[2], bfh(k_.y) * rk * gg[3]); k_.z = cvt_pk_bf16(bfl(k_.z) * rk * gg[4], bfh(k_.z) * rk * gg[5]); k_.w = cvt_pk_bf16(bfl(k_.w) * rk * gg[6], bfh(k_.w) * rk * gg[7]);
            *(LAS v4u*)(lds + t * KB + rr * (2 * D) + ((ch ^ kswz<D>(rr)) << 4)) = k_; *(LAS v4u*)(lds + (4 + t) * KB + rr * (2 * D) + ((ch ^ vswz<D>(rr)) << 4)) = vreg[i]; }
    }
    __syncthreads();
#pragma unroll 1
    for (int qi = 0; qi < NQ; ++qi) {
        int lane_q = lane; asm volatile("" : "+v"(lane_q));
        const int r32 = lane_q & 31, hi = lane_q >> 5, i16 = lane_q & 15, blk = (lane_q >> 4) & 1, tq = i16 >> 2, tp = i16 & 3;
        const size_t qrow = (size_t)b * SEQ + (qb0 + qi) * 256 + wave * 32 + r32;
        bf16x8 qr[NKS];
#pragma unroll
        for (int ks = 0; ks < NKS; ++ks) qr[ks] = qn[ks];
        if (qi + 1 < NQ) {
#pragma unroll
            for (int ks = 0; ks < NKS; ++ks) qn[ks] = *(const bf16x8*)(Qg + (qrow + 256) * ld + h * D + 16 * ks + 8 * hi); }
        {
            float qf[NKS * 8]; float ss = 0.f;
#pragma unroll
            for (int ks = 0; ks < NKS; ++ks) { const pg8::u32x4 w = __builtin_bit_cast(pg8::u32x4, qr[ks]);
#pragma unroll
                for (int j = 0; j < 4; ++j) { qf[ks * 8 + 2 * j] = bfl(w[j]); qf[ks * 8 + 2 * j + 1] = bfh(w[j]); ss += qf[ks * 8 + 2 * j] * qf[ks * 8 + 2 * j] + qf[ks * 8 + 2 * j + 1] * qf[ks * 8 + 2 * j + 1]; } }
            ss += __shfl_xor(ss, 32);
            const float rq = (1.f / sqrtf(ss * (1.f / D) + 1e-5f)) * (0.08838834764831845f * LOG2E);
#pragma unroll
            for (int ks = 0; ks < NKS; ++ks) { pg8::u32x4 w;
#pragma unroll
                for (int j = 0; j < 4; ++j) w[j] = cvt_pk_bf16(qf[ks * 8 + 2 * j] * rq, qf[ks * 8 + 2 * j + 1] * rq);
                qr[ks] = __builtin_bit_cast(bf16x8, w); }
        }
        float m = -1e30f, l = 0.f;
        f32x16 o[NDH];
#pragma unroll
        for (int dh = 0; dh < NDH; ++dh)
#pragma unroll
            for (int r = 0; r < 16; ++r) o[dh][r] = 0.f;
#pragma unroll
        for (int tt = 0; tt < 4; ++tt) {
            const LAS unsigned char* Kb = lds + tt * KB; const LAS unsigned char* Vb = lds + (4 + tt) * KB;
            f32x16 p[NKH];
#pragma unroll
            for (int kh = 0; kh < NKH; ++kh)
#pragma unroll
                for (int r = 0; r < 16; ++r) p[kh][r] = 0.f;
#pragma unroll
            for (int ks = 0; ks < NKS; ++ks)
#pragma unroll
                for (int kh = 0; kh < NKH; ++kh) { const int row = 32 * kh + r32;
                    const bf16x8 a = *(const LAS bf16x8*)(Kb + row * (2 * D) + (((2 * ks + hi) ^ kswz<D>(row)) << 4));
                    p[kh] = __builtin_amdgcn_mfma_f32_32x32x16_bf16(a, qr[ks], p[kh], 0, 0, 0); }
            float mx = p[0][0];
#pragma unroll
            for (int kh = 0; kh < NKH; ++kh)
#pragma unroll
                for (int r = 0; r < 16; ++r) mx = fmaxf(mx, p[kh][r]);
            mx = fmaxf(mx, __shfl_xor(mx, 32));
            const float mnew = fmaxf(m, mx);
            if (__builtin_amdgcn_ballot_w64(mnew > m) != 0ull) { const float alpha = __builtin_amdgcn_exp2f(m - mnew); l *= alpha;
#pragma unroll
                for (int dh = 0; dh < NDH; ++dh)
#pragma unroll
                    for (int r = 0; r < 16; ++r) o[dh][r] *= alpha;
                m = mnew; }
            float ps = 0.f;
#pragma unroll
            for (int kh = 0; kh < NKH; ++kh)
#pragma unroll
                for (int r = 0; r < 16; ++r) { p[kh][r] = __builtin_amdgcn_exp2f(p[kh][r] - m); ps += p[kh][r]; }
            l += ps;
#pragma unroll
            for (int kh = 0; kh < NKH; ++kh)
#pragma unroll
                for (int s = 0; s < 2; ++s) {
                    const bf16x8 pb = pack8(p[kh], s);
#pragma unroll
                    for (int dh = 0; dh < NDH; ++dh) {
                        const int rowA = 32 * kh + 16 * s + 4 * hi + tq, rowB = rowA + 8, chv = 4 * dh + 2 * blk + (tp >> 1);
                        const s16x4 lo = vtr(Vb + rowA * (2 * D) + ((chv ^ vswz<D>(rowA)) << 4) + 8 * (tp & 1));
                        const s16x4 hh = vtr(Vb + rowB * (2 * D) + ((chv ^ vswz<D>(rowB)) << 4) + 8 * (tp & 1));
                        const bf16x8 va = (bf16x8){lo[0], lo[1], lo[2], lo[3], hh[0], hh[1], hh[2], hh[3]};
                        o[dh] = __builtin_amdgcn_mfma_f32_32x32x16_bf16(va, pb, o[dh], 0, 0, 0);
                    }
                }
        }
        l += __shfl_xor(l, 32);
        const float inv = 1.f / l;
        bf16_t* orow = Og + qrow * ld + h * D;
#pragma unroll
        for (int dh = 0; dh < NDH; ++dh)
#pragma unroll
            for (int g = 0; g < 4; ++g) { uint2 w; w.x = cvt_pk_bf16(o[dh][4 * g] * inv, o[dh][4 * g + 1] * inv); w.y = cvt_pk_bf16(o[dh][4 * g + 2] * inv, o[dh][4 * g + 3] * inv);
                *(uint2*)(orow + 32 * dh + 8 * g + 4 * hi) = w; }
    }
}

template <bool FIXM, int VAR>
__device__ __forceinline__ void moba_pair(Frame& F, const int qb, const int b0, const int h0, const int b1, const int h1,
                                          const bf16_t* MQ, const bf16_t* MK, const bf16_t* MV, bf16_t* OM, const float* KMEAN,
                                          const int convmode, const int cstep0, const float* w1, const float* w2, const float mref) {
    constexpr int D = 64, KB = 64 * D * 2, NKS = 4, NDH = 2, ld = 512;
    int tid = F.tid, lane = F.lane; asm volatile("" : "+v"(tid), "+v"(lane));
    const int wave = F.wave, uh = wave >> 2, w4 = wave & 3, utid = tid & 255;
    if (convmode && uh) {
        LAS float* scr = (LAS float*)(F.lds + 65536 + w4 * 16384);
        const int NTc = 4 * (qb + 1), slot0 = __builtin_amdgcn_readfirstlane(4 * cstep0 + w4);
        if (qb > 0) __syncthreads();
        f32x4 v0[8], v1[8], v2[8], v3[8];
#define CV_ISSUE(v, t) do { if ((t) < NTc) cv_load(v, slot0 + 4 * (t), w1, w2, lane); } while (0)
#define CV_RETIRE(v, t) cv_finish(v, slot0 + 4 * (t), F.ws, scr, lane)
#define CV_BAR do { asm volatile("" ::: "memory"); __builtin_amdgcn_s_barrier(); asm volatile("" ::: "memory"); } while (0)
        CV_ISSUE(v0, 0); CV_ISSUE(v1, 1); CV_ISSUE(v2, 2);
#pragma unroll 1
        for (int tt = 0; tt < NTc; tt += 4) {
            CV_BAR; CV_ISSUE(v3, tt + 3); CV_RETIRE(v0, tt);
            CV_BAR; CV_ISSUE(v0, tt + 4); CV_RETIRE(v1, tt + 1);
            CV_BAR; CV_ISSUE(v1, tt + 5); CV_RETIRE(v2, tt + 2);
            CV_BAR; CV_ISSUE(v2, tt + 6); CV_RETIRE(v3, tt + 3);
        }
        CV_BAR;
#undef CV_ISSUE
#undef CV_RETIRE
#undef CV_BAR
        return;
    }
    const int b = uh ? b1 : b0, h = uh ? h1 : h0;
    LAS unsigned char* lds = F.lds + uh * 65536;
    LAS float* kml = (LAS float*)(F.lds + LDSCTL_OFF + 2048 + uh * 4096);
    const bf16_t* Kg = MK + (size_t)b * SEQ * ld; const bf16_t* Vg = MV + (size_t)b * SEQ * ld;
    const float sl2 = exp2f(-(float)(h + 1)) * LOG2E;
    bf16x8 qr[2][NKS]; unsigned selmask[2] = {0u, 0u};
    {
        const int r32 = lane & 31, hi = lane >> 5;
#pragma unroll
        for (int g = 0; g < 2; ++g) { const size_t qrow = (size_t)b * SEQ + qb * 256 + w4 * 64 + 32 * g + r32;
#pragma unroll
            for (int ks = 0; ks < NKS; ++ks) qr[g][ks] = *(const bf16x8*)(MQ + qrow * ld + h * D + 16 * ks + 8 * hi); }
        if (qb > 0) {
            if (utid < qb * 16) *(LAS f32x4*)(kml + 4 * utid) = *(const f32x4*)(KMEAN + (((size_t)b * 16 + (utid >> 4)) * 8 + h) * 64 + 4 * (utid & 15));
            __syncthreads();
#pragma unroll
            for (int g = 0; g < 2; ++g) {
                float qf[NKS * 8];
#pragma unroll
                for (int ks = 0; ks < NKS; ++ks) { const pg8::u32x4 w = __builtin_bit_cast(pg8::u32x4, qr[g][ks]);
#pragma unroll
                    for (int j = 0; j < 4; ++j) { qf[ks * 8 + 2 * j] = bfl(w[j]); qf[ks * 8 + 2 * j + 1] = bfh(w[j]); } }
                float v0 = -INFINITY, v1 = -INFINITY, v2 = -INFINITY; int i0 = -1, i1 = -1, i2 = -1;
#pragma unroll 1
                for (int j = 0; j < qb; ++j) { const LAS float* km = kml + 64 * j + 8 * hi; float s = 0.f;
#pragma unroll
                    for (int ks = 0; ks < NKS; ++ks) { const f32x4 k0 = *(const LAS f32x4*)(km + 16 * ks), k1 = *(const LAS f32x4*)(km + 16 * ks + 4);
                        s += qf[ks * 8 + 0] * k0[0] + qf[ks * 8 + 1] * k0[1] + qf[ks * 8 + 2] * k0[2] + qf[ks * 8 + 3] * k0[3] + qf[ks * 8 + 4] * k1[0] + qf[ks * 8 + 5] * k1[1] + qf[ks * 8 + 6] * k1[2] + qf[ks * 8 + 7] * k1[3]; }
                    s += __shfl_xor(s, 32);
                    const bool c0 = s > v0, c1 = s > v1, c2 = s > v2;
                    v2 = c1 ? v1 : (c2 ? s : v2); i2 = c1 ? i1 : (c2 ? j : i2);
                    v1 = c0 ? v0 : (c1 ? s : v1); i1 = c0 ? i0 : (c1 ? j : i1);
                    v0 = c0 ? s : v0; i0 = c0 ? j : i0; }
                selmask[g] = (i0 >= 0 ? (1u << i0) : 0u) | (i1 >= 0 ? (1u << i1) : 0u) | (i2 >= 0 ? (1u << i2) : 0u);
            }
        }
    }
    const int NT = 4 * (qb + 1);
#define MP_STAGE(tt, buf) do { const int kb_ = tile_kbase<true, 64>(tt, qb); _Pragma("unroll") for (int i_ = 0; i_ < 2; ++i_) { const int ci_ = utid + 256 * i_, row_ = ci_ >> 3, cp_ = ci_ & 7; \
        const size_t gk_ = (size_t)(kb_ + row_) * ld + h * D + 8 * (cp_ ^ kswz<64>(row_)), gv_ = (size_t)(kb_ + row_) * ld + h * D + 8 * (cp_ ^ vswz<64>(row_)); \
        __builtin_amdgcn_global_load_lds((const unsigned*)(Kg + gk_), (LAS unsigned*)(lds + (2 * (buf)) * KB + (w4 * 64 + 256 * i_) * 16), 16, 0, 0); \
        __builtin_amdgcn_global_load_lds((const unsigned*)(Vg + gv_), (LAS unsigned*)(lds + (2 * (buf) + 1) * KB + (w4 * 64 + 256 * i_) * 16), 16, 0, 0); } } while (0)
    MP_STAGE(0, 0); if (NT > 1) MP_STAGE(1, 1); if (NT > 2) MP_STAGE(2, 2);
    float m[2] = {-1e30f, -1e30f}, l[2] = {0.f, 0.f};
    float cq[2], a4[4];
#pragma unroll
    for (int g = 0; g < 2; ++g) cq[g] = -(mref + sl2 * (float)(w4 * 64 + 32 * g + (lane & 31)));
#pragma unroll
    for (int i = 0; i < 4; ++i) a4[i] = sl2 * (float)i;
    const float slh = __uint_as_float(cvt_pk_bf16(sl2, sl2) & 0xffff0000u), sll = sl2 - slh;
    bf16x8 akk[2];
#pragma unroll
    for (int kh = 0; kh < 2; ++kh) { const float rw = (float)(32 * kh + (lane & 31)); pg8::u32x4 aw; const bool up = (lane >> 5) != 0;
        aw[0] = up ? 0u : cvt_pk_bf16(rw, 1.f); aw[1] = up ? 0u : cvt_pk_bf16(1.f, rw); aw[2] = 0u; aw[3] = 0u; akk[kh] = __builtin_bit_cast(bf16x8, aw); }
    f32x16 o[2][NDH];
#pragma unroll
    for (int g = 0; g < 2; ++g)
#pragma unroll
        for (int dh = 0; dh < NDH; ++dh)
#pragma unroll
            for (int r = 0; r < 16; ++r) o[g][dh][r] = 0.f;
    for (int tt = 0; tt < NT; ++tt) {
        int lane_t = lane; asm volatile("" : "+v"(lane_t));
        const int r32 = lane_t & 31, hi = lane_t >> 5, i16 = lane_t & 15, blk = (lane_t >> 4) & 1, tq = i16 >> 2, tp = i16 & 3;
        const int buf = tt & 3;
        { const int ahead = NT - 1 - tt;
          if (ahead >= 2) asm volatile("s_waitcnt vmcnt(8)" ::: "memory"); else if (ahead == 1) asm volatile("s_waitcnt vmcnt(4)" ::: "memory"); else asm volatile("s_waitcnt vmcnt(0)" ::: "memory"); }
        asm volatile("s_waitcnt lgkmcnt(0)" ::: "memory"); if (VAR != 4) __builtin_amdgcn_s_barrier(); asm volatile("" ::: "memory");
        if (tt + 3 < NT) MP_STAGE(tt + 3, (tt + 3) & 3);
        bool act[2]; bool lane_sel[2];
#pragma unroll
        for (int g = 0; g < 2; ++g) { lane_sel[g] = true;
            if (tt >= 4) { lane_sel[g] = (selmask[g] >> ((tt - 4) >> 2)) & 1u; act[g] = __builtin_amdgcn_ballot_w64(lane_sel[g]) != 0ull; }
            else act[g] = (64 * tt <= w4 * 64 + 32 * g + 31); }
        if (act[0] || act[1]) {
            const LAS unsigned char* Kb = lds + (2 * buf) * KB; const LAS unsigned char* Vb = lds + (2 * buf + 1) * KB;
            const int kb = tile_kbase<true, 64>(tt, qb); const float offl = sl2 * (float)(kb - qb * 256 + 4 * hi);
            bf16x8 pb[2][4];
            if (FIXM && VAR == 0) {
                f32x16 pp[2][2];
                const float cbt = sl2 * (float)(kb - qb * 256);
#pragma unroll
                for (int g = 0; g < 2; ++g) {
                    const float cbv = lane_sel[g] ? cbt + cq[g] : -INFINITY;
                    const unsigned u0 = cvt_pk_bf16(slh, cbv); const float cbh = __uint_as_float(u0 & 0xffff0000u);
                    const unsigned u1 = cvt_pk_bf16(lane_sel[g] ? cbv - cbh : 0.f, sll);
                    pg8::u32x4 bw; bw[0] = hi ? 0u : u0; bw[1] = hi ? 0u : u1; bw[2] = 0u; bw[3] = 0u;
                    const bf16x8 bfrag = __builtin_bit_cast(bf16x8, bw);
#pragma unroll
                    for (int kh = 0; kh < 2; ++kh) { const f32x16 z = {0.f, 0.f, 0.f, 0.f, 0.f, 0.f, 0.f, 0.f, 0.f, 0.f, 0.f, 0.f, 0.f, 0.f, 0.f, 0.f};
                        pp[g][kh] = __builtin_amdgcn_mfma_f32_32x32x16_bf16(akk[kh], bfrag, z, 0, 0, 0); } }
#pragma unroll
                for (int ks = 0; ks < NKS; ++ks)
#pragma unroll
                    for (int kh = 0; kh < 2; ++kh) { const int row = 32 * kh + r32;
                        const bf16x8 a = *(const LAS bf16x8*)(Kb + row * 128 + (((2 * ks + hi) ^ kswz<64>(row)) << 4));
                        pp[0][kh] = __builtin_amdgcn_mfma_f32_32x32x16_bf16(a, qr[0][ks], pp[0][kh], 0, 0, 0);
                        pp[1][kh] = __builtin_amdgcn_mfma_f32_32x32x16_bf16(a, qr[1][ks], pp[1][kh], 0, 0, 0); }
                if (tt == w4) {
#pragma unroll
                    for (int g = 0; g < 2; ++g) { const int qrel = 32 * g + r32, k0 = 4 * hi;
#pragma unroll
                        for (int kh = 0; kh < 2; ++kh)
#pragma unroll
                            for (int r = 0; r < 16; ++r) { const int kv = k0 + 32 * kh + (r & 3) + 8 * (r >> 2); if (kv > qrel) pp[g][kh][r] = -INFINITY; } } }
#pragma unroll
                for (int kh = 0; kh < 2; ++kh)
#pragma unroll
                    for (int s = 0; s < 2; ++s) {
                        bf16x8 pq[2];
#pragma unroll
                        for (int g = 0; g < 2; ++g) { float e8[8];
#pragma unroll
                            for (int j = 0; j < 8; ++j) e8[j] = __builtin_amdgcn_exp2f(pp[g][kh][8 * s + j]);
                            l[g] += ((e8[0] + e8[1]) + (e8[2] + e8[3])) + ((e8[4] + e8[5]) + (e8[6] + e8[7]));
                            pg8::u32x4 w; w[0] = cvt_pk_bf16(e8[0], e8[1]); w[1] = cvt_pk_bf16(e8[2], e8[3]); w[2] = cvt_pk_bf16(e8[4], e8[5]); w[3] = cvt_pk_bf16(e8[6], e8[7]);
                            pq[g] = __builtin_bit_cast(bf16x8, w); }
#pragma unroll
                        for (int dh = 0; dh < NDH; ++dh) {
                            const int rowA = 32 * kh + 16 * s + 4 * hi + tq, rowB = rowA + 8, chv = 4 * dh + 2 * blk + (tp >> 1);
                            const s16x4 lo = vtr(Vb + rowA * 128 + ((chv ^ vswz<64>(rowA)) << 4) + 8 * (tp & 1));
                            const s16x4 hh = vtr(Vb + rowB * 128 + ((chv ^ vswz<64>(rowB)) << 4) + 8 * (tp & 1));
                            const bf16x8 va = (bf16x8){lo[0], lo[1], lo[2], lo[3], hh[0], hh[1], hh[2], hh[3]};
#pragma unroll
                            for (int g = 0; g < 2; ++g) o[g][dh] = __builtin_amdgcn_mfma_f32_32x32x16_bf16(va, pq[g], o[g][dh], 0, 0, 0);
                        }
                    }
            } else
#pragma unroll
            for (int g = 0; g < 2; ++g) {
                if (act[g]) {
                    f32x16 p[2];
                    if (FIXM) { const float cb = offl + cq[g]; float bq[2][4];
#pragma unroll
                        for (int kh = 0; kh < 2; ++kh)
#pragma unroll
                            for (int j = 0; j < 4; ++j) bq[kh][j] = fmaf(sl2, (float)(32 * kh + 8 * j), cb);
#pragma unroll
                        for (int kh = 0; kh < 2; ++kh)
#pragma unroll
                            for (int r = 0; r < 16; ++r) p[kh][r] = a4[r & 3] + bq[kh][r >> 2];
                    } else {
#pragma unroll
                        for (int kh = 0; kh < 2; ++kh)
#pragma unroll
                            for (int r = 0; r < 16; ++r) p[kh][r] = sl2 * (float)(32 * kh + (r & 3) + 8 * (r >> 2));
                    }
                    if (VAR != 3) {
#pragma unroll
                    for (int ks = 0; ks < NKS; ++ks)
#pragma unroll
                        for (int kh = 0; kh < 2; ++kh) { const int row = 32 * kh + r32;
                            const bf16x8 a = *(const LAS bf16x8*)(Kb + row * 128 + (((2 * ks + hi) ^ kswz<64>(row)) << 4));
                            p[kh] = __builtin_amdgcn_mfma_f32_32x32x16_bf16(a, qr[g][ks], p[kh], 0, 0, 0); }
                    }
                    if (tt < 4) { const int qrel = w4 * 64 + 32 * g + r32, k0 = 64 * tt + 4 * hi;
#pragma unroll
                        for (int kh = 0; kh < 2; ++kh)
#pragma unroll
                            for (int r = 0; r < 16; ++r) { const int kv = k0 + 32 * kh + (r & 3) + 8 * (r >> 2); if (kv > qrel) p[kh][r] = -INFINITY; }
                    } else if (!lane_sel[g]) {
#pragma unroll
                        for (int kh = 0; kh < 2; ++kh)
#pragma unroll
                            for (int r = 0; r < 16; ++r) p[kh][r] = -INFINITY;
                    }
                    if (!FIXM) {
                    float mx = p[0][0];
#pragma unroll
                    for (int kh = 0; kh < 2; ++kh)
#pragma unroll
                        for (int r = 0; r < 16; ++r) mx = fmaxf(mx, p[kh][r]);
                    mx += offl; mx = fmaxf(mx, __shfl_xor(mx, 32));
                    const float mnew = fmaxf(m[g], mx);
                    if (__builtin_amdgcn_ballot_w64(mnew > m[g]) != 0ull) { const float alpha = __builtin_amdgcn_exp2f(m[g] - mnew); l[g] *= alpha;
#pragma unroll
                        for (int dh = 0; dh < NDH; ++dh)
#pragma unroll
                            for (int r = 0; r < 16; ++r) o[g][dh][r] *= alpha;
                        m[g] = mnew; }
                    const float mt = m[g] - offl;
                    p[0] = p[0] - mt; p[1] = p[1] - mt;
                    }
                    if (VAR != 2) {
#pragma unroll
                    for (int kh = 0; kh < 2; ++kh)
#pragma unroll
                        for (int r = 0; r < 16; ++r) p[kh][r] = __builtin_amdgcn_exp2f(p[kh][r]);
                    }
                    if (VAR == 2) l[g] += p[0][0]; else
                    { const f32x16 s16 = p[0] + p[1]; const f32x8 s8 = s16.lo + s16.hi; const f32x4 s4 = s8.lo + s8.hi; const f32x2 s2 = s4.lo + s4.hi; l[g] += s2.x + s2.y; }
#pragma unroll
                    for (int kh = 0; kh < 2; ++kh)
#pragma unroll
                        for (int s = 0; s < 2; ++s) pb[g][2 * kh + s] = pack8(p[kh], s);
                } else {
#pragma unroll
                    for (int q = 0; q < 4; ++q) pb[g][q] = (bf16x8){0, 0, 0, 0, 0, 0, 0, 0};
                }
            }
            if (FIXM && VAR == 0) { } else
            if (VAR == 1) { unsigned x = 0;
#pragma unroll
                for (int g = 0; g < 2; ++g)
#pragma unroll
                    for (int q = 0; q < 4; ++q) { const pg8::u32x4 w = __builtin_bit_cast(pg8::u32x4, pb[g][q]); x ^= w[0] ^ w[1] ^ w[2] ^ w[3]; }
                o[0][0][0] += __uint_as_float(x & 0x3fffffffu); } else
#pragma unroll
            for (int kh = 0; kh < 2; ++kh)
#pragma unroll
                for (int s = 0; s < 2; ++s)
#pragma unroll
                    for (int dh = 0; dh < NDH; ++dh) {
                        const int rowA = 32 * kh + 16 * s + 4 * hi + tq, rowB = rowA + 8, chv = 4 * dh + 2 * blk + (tp >> 1);
                        const s16x4 lo = vtr(Vb + rowA * 128 + ((chv ^ vswz<64>(rowA)) << 4) + 8 * (tp & 1));
                        const s16x4 hh = vtr(Vb + rowB * 128 + ((chv ^ vswz<64>(rowB)) << 4) + 8 * (tp & 1));
                        const bf16x8 va = (bf16x8){lo[0], lo[1], lo[2], lo[3], hh[0], hh[1], hh[2], hh[3]};
#pragma unroll
                        for (int g = 0; g < 2; ++g) o[g][dh] = __builtin_amdgcn_mfma_f32_32x32x16_bf16(va, pb[g][2 * kh + s], o[g][dh], 0, 0, 0);
                    }
        }
    }
    asm volatile("s_waitcnt lgkmcnt(0)" ::: "memory"); __builtin_amdgcn_s_barrier(); asm volatile("" ::: "memory");
    { const int r32 = lane & 31, hi = lane >> 5;
#pragma unroll
      for (int g = 0; g < 2; ++g) { float lt = l[g]; lt += __shfl_xor(lt, 32); const float inv = 1.f / lt;
          bf16_t* orow = OM + ((size_t)b * SEQ + qb * 256 + w4 * 64 + 32 * g + r32) * ld + h * D;
#pragma unroll
          for (int dh = 0; dh < NDH; ++dh)
#pragma unroll
              for (int q = 0; q < 4; ++q) { uint2 w; w.x = cvt_pk_bf16(o[g][dh][4 * q] * inv, o[g][dh][4 * q + 1] * inv); w.y = cvt_pk_bf16(o[g][dh][4 * q + 2] * inv, o[g][dh][4 * q + 3] * inv);
                  *(uint2*)(orow + 32 * dh + 8 * q + 4 * hi) = w; } } }
#undef MP_STAGE
}
}
namespace ret {
using att::f32x16; using att::s16x4; using att::vtr; using att::pack8; using att::kswz; using att::vswz; using att::crow; using pg8::bf16x8;
constexpr int L_KT = 0, L_KD = 16384, L_VT = 32768, L_SB = 65536, L_SS = 98304, L_G = 99328;
__device__ __forceinline__ void retention_item(Frame& F, const int b, const int h, const float* g_ret_out, const int c0, const int c1) {
    const bf16_t* RQ = (const bf16_t*)(F.ws + WS_RQ); const bf16_t* RK = (const bf16_t*)(F.ws + WS_RK); const bf16_t* RV = (const bf16_t*)(F.ws + WS_RV); const bf16_t* RG = (const bf16_t*)(F.ws + WS_RG); bf16_t* ORET = (bf16_t*)(F.ws + WS_ORET);
    int tid = F.tid, lane = F.lane; asm volatile("" : "+v"(tid), "+v"(lane));
    const int wave = F.wave;
    LAS unsigned char* lds = F.lds;
    const float lg2_o = log2f(1.f - exp2f(-5.f - (float)h)), g128 = exp2f(128.f * lg2_o);
    const size_t tok0 = (size_t)b * SEQ;
    v4u kreg[2], vreg[4];
#define RET_LOAD(n) do { _Pragma("unroll") for (int i_ = 0; i_ < 2; ++i_) { const int ci_ = tid + 512 * i_; kreg[i_] = *(const v4u*)(RK + (tok0 + (n) * 128 + (ci_ >> 3)) * 256 + h * 64 + 8 * (ci_ & 7)); } \
        _Pragma("unroll") for (int i_ = 0; i_ < 4; ++i_) { const int ci_ = tid + 512 * i_; vreg[i_] = *(const v4u*)(RV + (tok0 + (n) * 128 + (ci_ >> 4)) * 512 + h * 128 + 8 * (ci_ & 15)); } } while (0)
#define RET_WRITE() do { _Pragma("unroll") for (int i_ = 0; i_ < 2; ++i_) { const int ci_ = tid + 512 * i_, row_ = ci_ >> 3, ch_ = ci_ & 7; const v4u k_ = kreg[i_]; \
            *(LAS v4u*)(lds + L_KT + row_ * 128 + ((ch_ ^ kswz<64>(row_)) << 4)) = k_; const float dk_ = __builtin_amdgcn_exp2f(lg2 * (float)(127 - row_)); v4u d_; \
            d_.x = cvt_pk_bf16(att::bfl(k_.x) * dk_, att::bfh(k_.x) * dk_); d_.y = cvt_pk_bf16(att::bfl(k_.y) * dk_, att::bfh(k_.y) * dk_); d_.z = cvt_pk_bf16(att::bfl(k_.z) * dk_, att::bfh(k_.z) * dk_); d_.w = cvt_pk_bf16(att::bfl(k_.w) * dk_, att::bfh(k_.w) * dk_); \
            *(LAS v4u*)(lds + L_KD + row_ * 128 + ((ch_ ^ vswz<64>(row_)) << 4)) = d_; } \
        _Pragma("unroll") for (int i_ = 0; i_ < 4; ++i_) { const int ci_ = tid + 512 * i_, row_ = ci_ >> 4, ch_ = ci_ & 15; *(LAS v4u*)(lds + L_VT + row_ * 256 + ((ch_ ^ vswz<128>(row_)) << 4)) = vreg[i_]; } } while (0)
    { const float lg2 = lg2_o; RET_LOAD(0); RET_WRITE(); }
    { const v4u z = {0u, 0u, 0u, 0u}; *(LAS v4u*)(lds + L_SB + tid * 32) = z; *(LAS v4u*)(lds + L_SB + tid * 32 + 16) = z; }
    f32x16 st;
#pragma unroll
    for (int r = 0; r < 16; ++r) st[r] = 0.f;
    const int ib = wave & 3, e2 = wave >> 2;
    LAS float* ssb = (LAS float*)(lds + L_SS);
    if (tid < 128) ((LAS float*)(lds + L_G))[tid] = g_ret_out[tid];
    bf16x8 qn[4];
    { const size_t tr0 = tok0 + (size_t)c0 * 128 + 32 * ib + (lane & 31);
#pragma unroll
      for (int ks = 0; ks < 4; ++ks) qn[ks] = *(const bf16x8*)(RQ + tr0 * 256 + h * 64 + 16 * ks + 8 * (lane >> 5)); }
    __syncthreads();
    for (int n = 0; n < c1; ++n) {
        const bool outp = n >= c0;
        int lane_n = lane; float lg2 = lg2_o; asm volatile("" : "+v"(lane_n), "+v"(lg2));
        const int r32 = lane_n & 31, hi = lane_n >> 5, i16 = lane_n & 15, blk = (lane_n >> 4) & 1, tq = i16 >> 2, tp = i16 & 3;
        if (n + 1 < c1) RET_LOAD(n + 1);
        const LAS unsigned char* Sb = lds + L_SB + (n & 1) * 16384; LAS unsigned char* Sn = lds + L_SB + ((n + 1) & 1) * 16384;
        const size_t tokrow = tok0 + n * 128 + 32 * ib + r32;
        f32x16 o[2]; uint2 rgv[8];
#pragma unroll
        for (int q2 = 0; q2 < 2; ++q2)
#pragma unroll
            for (int r = 0; r < 16; ++r) o[q2][r] = 0.f;
#pragma unroll
        for (int q = 0; q < 8; ++q) rgv[q] = make_uint2(0u, 0u);
        if (outp) {
#pragma unroll
        for (int q2 = 0; q2 < 2; ++q2)
#pragma unroll
            for (int g = 0; g < 4; ++g) rgv[q2 * 4 + g] = *(const uint2*)(RG + tokrow * 512 + h * 128 + 64 * e2 + 32 * q2 + 8 * g + 4 * hi);
        {
            bf16x8 qr[4];
#pragma unroll
            for (int ks = 0; ks < 4; ++ks) qr[ks] = qn[ks];
            if (n + 1 < c1) {
#pragma unroll
                for (int ks = 0; ks < 4; ++ks) qn[ks] = *(const bf16x8*)(RQ + (tokrow + 128) * 256 + h * 64 + 16 * ks + 8 * hi); }
#pragma unroll
            for (int q2 = 0; q2 < 2; ++q2) {
#pragma unroll
                for (int r = 0; r < 16; ++r) o[q2][r] = 0.f;
                const int e = 64 * e2 + 32 * q2 + r32;
#pragma unroll
                for (int ks = 0; ks < 4; ++ks) { const bf16x8 a = *(const LAS bf16x8*)(Sb + e * 128 + (((2 * ks + hi) ^ kswz<64>(e)) << 4)); o[q2] = __builtin_amdgcn_mfma_f32_32x32x16_bf16(a, qr[ks], o[q2], 0, 0, 0); } }
            const float gq = __builtin_amdgcn_exp2f(lg2 * (float)(32 * ib + r32 + 1));
#pragma unroll
            for (int q2 = 0; q2 < 2; ++q2)
#pragma unroll
                for (int r = 0; r < 16; ++r) o[q2][r] *= gq;
            __builtin_amdgcn_sched_barrier(0);
#pragma unroll 1
            for (int jb = 0; jb <= ib; ++jb) {
                f32x16 p;
#pragma unroll
                for (int r = 0; r < 16; ++r) p[r] = 0.f;
                const int krow_ = 32 * jb + r32;
#pragma unroll
                for (int ks = 0; ks < 4; ++ks) { const bf16x8 a = *(const LAS bf16x8*)(lds + L_KT + krow_ * 128 + (((2 * ks + hi) ^ kswz<64>(krow_)) << 4)); p = __builtin_amdgcn_mfma_f32_32x32x16_bf16(a, qr[ks], p, 0, 0, 0); }
                const float cl = __builtin_amdgcn_exp2f(lg2 * (float)(32 * (ib - jb) + r32 - 4 * hi));
                const bool diag = (jb == ib);
#pragma unroll
                for (int r = 0; r < 16; ++r) { float v = p[r] * (cl * __builtin_amdgcn_exp2f(-lg2 * (float)((r & 3) + 8 * (r >> 2)))); if (diag && ((r & 3) + 8 * (r >> 2) + 4 * hi) > r32) v = 0.f; p[r] = v; }
#pragma unroll
                for (int s = 0; s < 2; ++s) { const bf16x8 pb = pack8(p, s);
                    const int rowA = 32 * jb + 16 * s + 4 * hi + tq, rowB = rowA + 8;
#pragma unroll
                    for (int q2 = 0; q2 < 2; ++q2) { const int chv = 4 * (2 * e2 + q2) + 2 * blk + (tp >> 1);
                        const s16x4 lo = vtr(lds + L_VT + rowA * 256 + ((chv ^ vswz<128>(rowA)) << 4) + 8 * (tp & 1));
                        const s16x4 hh = vtr(lds + L_VT + rowB * 256 + ((chv ^ vswz<128>(rowB)) << 4) + 8 * (tp & 1));
                        const bf16x8 va = (bf16x8){lo[0], lo[1], lo[2], lo[3], hh[0], hh[1], hh[2], hh[3]};
                        o[q2] = __builtin_amdgcn_mfma_f32_32x32x16_bf16(va, pb, o[q2], 0, 0, 0); }
                    __builtin_amdgcn_sched_barrier(0); }
            }
        }
        __builtin_amdgcn_sched_barrier(0);
        { float ss = 0.f;
#pragma unroll
            for (int q2 = 0; q2 < 2; ++q2)
#pragma unroll
                for (int r = 0; r < 16; ++r) ss += o[q2][r] * o[q2][r];
            ss += __shfl_xor(ss, 32);
            if (hi == 0) ssb[e2 * 128 + 32 * ib + r32] = ss; }
        }
        __builtin_amdgcn_sched_barrier(0);
        { const int eh = wave & 3, dh = wave >> 2;
#pragma unroll
            for (int r = 0; r < 16; ++r) st[r] *= g128;
#pragma unroll 1
            for (int kst = 0; kst < 8; ++kst) { const int rowA = 16 * kst + 4 * hi + tq, rowB = rowA + 8, chv = 4 * eh + 2 * blk + (tp >> 1), chk = 4 * dh + 2 * blk + (tp >> 1);
                const s16x4 lo = vtr(lds + L_VT + rowA * 256 + ((chv ^ vswz<128>(rowA)) << 4) + 8 * (tp & 1));
                const s16x4 hh = vtr(lds + L_VT + rowB * 256 + ((chv ^ vswz<128>(rowB)) << 4) + 8 * (tp & 1));
                const s16x4 kl = vtr(lds + L_KD + rowA * 128 + ((chk ^ vswz<64>(rowA)) << 4) + 8 * (tp & 1));
                const s16x4 kh = vtr(lds + L_KD + rowB * 128 + ((chk ^ vswz<64>(rowB)) << 4) + 8 * (tp & 1));
                const bf16x8 va = (bf16x8){lo[0], lo[1], lo[2], lo[3], hh[0], hh[1], hh[2], hh[3]};
                const bf16x8 kb = (bf16x8){kl[0], kl[1], kl[2], kl[3], kh[0], kh[1], kh[2], kh[3]};
                st = __builtin_amdgcn_mfma_f32_32x32x16_bf16(va, kb, st, 0, 0, 0); }
            if (n + 1 >= c0) {
#pragma unroll
            for (int r = 0; r < 16; ++r) { const int e = 32 * eh + (r & 3) + 8 * (r >> 2) + 4 * hi, dd = 32 * dh + r32;
                *(LAS bf16_t*)(Sn + e * 128 + ((((dd >> 3) ^ kswz<64>(e))) << 4) + (dd & 7) * 2) = f2bf(st[r]); } } }
        __builtin_amdgcn_sched_barrier(0);
        __syncthreads();
        if (outp) { const float rn = 1.f / sqrtf((ssb[32 * ib + r32] + ssb[128 + 32 * ib + r32]) * (1.f / 128.f) + 1e-5f);
#pragma unroll
            for (int q2 = 0; q2 < 2; ++q2)
#pragma unroll
                for (int g = 0; g < 4; ++g) { const int e = 64 * e2 + 32 * q2 + 8 * g + 4 * hi; const f32x4 gg = *(const LAS f32x4*)(lds + L_G + 4 * e); const uint2 rg = rgv[q2 * 4 + g];
                    uint2 w; w.x = cvt_pk_bf16(o[q2][4 * g] * rn * gg[0] * att::bfl(rg.x), o[q2][4 * g + 1] * rn * gg[1] * att::bfh(rg.x)); w.y = cvt_pk_bf16(o[q2][4 * g + 2] * rn * gg[2] * att::bfl(rg.y), o[q2][4 * g + 3] * rn * gg[3] * att::bfh(rg.y));
                    *(uint2*)(ORET + tokrow * 512 + h * 128 + e) = w; } }
        if (n + 1 < c1) RET_WRITE();
        __syncthreads();
    }
#undef RET_LOAD
#undef RET_WRITE
}
}
constexpr int P1_SPARE = 0, P1_CONV = 0;
__device__ __forceinline__ int p1_fill_count(int G) { const int rem = 1680 % G; return rem ? ((G - rem) & ~1) : 0; }
__device__ __forceinline__ void conv_item(Frame& F, const int c, const float* w1, const float* w2) {
            LAS float* scr = (LAS float*)(F.lds + RING_OFF + F.wave * 16384);
            const bool isw1 = c < 512; const int cc = isw1 ? c : c - 512, e = cc >> 4, kb = cc & 15, nblk = isw1 ? 64 : 32, N = isw1 ? 2048 : 1024;
            const float* Wsrc = isw1 ? w1 + (size_t)e * 1024 * 2048 : w2 + (size_t)e * 1024 * 1024;
            bf16* WT = isw1 ? (bf16*)(F.ws + WS_W1) + (size_t)e * 2048 * 1024 : (bf16*)(F.ws + WS_W2) + (size_t)e * 1024 * 1024;
            float wa[32], wb[32];
            xp_load(wa, Wsrc, N, nblk, kb * nblk + F.wave, F.lane);
#pragma unroll 1
            for (int nb = F.wave; nb < nblk; nb += 16) {
                xp_load(wb, Wsrc, N, nblk, kb * nblk + nb + 8, F.lane);
                xp_finish(wa, 1024, nblk, WT, scr, kb * nblk + nb, F.lane);
                if (nb + 16 < nblk) xp_load(wa, Wsrc, N, nblk, kb * nblk + nb + 16, F.lane);
                xp_finish(wb, 1024, nblk, WT, scr, kb * nblk + nb + 8, F.lane);
            }
}
__device__ __forceinline__ void conv_pair(Frame& F, const int c, const float* w1, const float* w2) {
            if (c + 1 < p1_fill_count(F.G)) return;
            LAS float* scr = (LAS float*)(F.lds + RING_OFF + F.wave * 16384);
            const bool isw1 = c < 512; const int cc = isw1 ? c : c - 512, e = cc >> 4, kb = cc & 15, nblk = isw1 ? 64 : 32, N = isw1 ? 2048 : 1024, sh = isw1 ? 3 : 2, T = 2 << sh;
            const float* Wsrc = isw1 ? w1 + (size_t)e * 1024 * 2048 : w2 + (size_t)e * 1024 * 1024;
            bf16* WT = isw1 ? (bf16*)(F.ws + WS_W1) + (size_t)e * 2048 * 1024 : (bf16*)(F.ws + WS_W2) + (size_t)e * 1024 * 1024;
            float wa[32], wb[32];
#define CP_IDX(k) ((kb + ((k) >> sh)) * nblk + F.wave + 8 * ((k) & ((1 << sh) - 1)))
            xp_load(wa, Wsrc, N, nblk, CP_IDX(0), F.lane);
#pragma unroll 1
            for (int k = 0; k < T; k += 2) {
                xp_load(wb, Wsrc, N, nblk, CP_IDX(k + 1), F.lane);
                xp_finish(wa, 1024, nblk, WT, scr, CP_IDX(k), F.lane);
                if (k + 2 < T) xp_load(wa, Wsrc, N, nblk, CP_IDX(k + 2), F.lane);
                xp_finish(wb, 1024, nblk, WT, scr, CP_IDX(k + 1), F.lane);
            }
#undef CP_IDX
}
constexpr int CW_QUEUE = 128;
constexpr int RET_SEGS = 4, RET_ITEMS = 16 * RET_SEGS;
__device__ __forceinline__ float moba_mref(Frame& F) {
    const float* gt = (const float*)(F.ws + WS_GTAB); float v = fabsf(gt[F.lane] * gt[64 + F.lane]);
#pragma unroll
    for (int o = 1; o < 64; o <<= 1) v = fmaxf(v, __shfl_xor(v, o));
    return 1.04f * 0.18033688f * 64.f * v + 0.25f;
}
template <int VAR>
__device__ __forceinline__ void p2_mixers(Frame& F, const float* g_ret_out, const float* g_mem_q, const float* g_mem_k, const float* w1, const float* w2, const int qword, const int qlo, const int qhi, const int tmask, const float mref) {
    volatile LAS int* slot = (volatile LAS int*)(F.lds + TB_OFF + 512);
    const bf16_t* MQ = (const bf16_t*)(F.ws + WS_MQ); const bf16_t* MK = (const bf16_t*)(F.ws + WS_MK); const bf16_t* MV = (const bf16_t*)(F.ws + WS_MV); bf16_t* OMO = (bf16_t*)(F.ws + (VAR ? WS_ACT : WS_OMOBA));
    const bf16_t* CQ = (const bf16_t*)(F.ws + WS_CQ); const bf16_t* MEMK = (const bf16_t*)(F.ws + WS_MEMK); const bf16_t* MEMV = (const bf16_t*)(F.ws + WS_MEMV); bf16_t* OME = (bf16_t*)(F.ws + WS_OMEM);
    const bool fixm = mref < 40.f;
    bool first = true;
    for (;;) {
        int it;
        if (first) { first = false; it = F.vcu + qlo; __syncthreads(); }
        else {
            __syncthreads();
            if (F.tid == 0) slot[0] = (int)__hip_atomic_fetch_add((unsigned*)F.ctl + qword, 1u, __ATOMIC_RELAXED, __HIP_MEMORY_SCOPE_AGENT);
            __syncthreads();
            it = slot[0] + F.G + qlo;
        }
        if (it >= qhi) break;
        if (it < RET_ITEMS) { if (tmask & 1) { const int seg = RET_SEGS - 1 - (it >> 4), bh = it & 15; ret::retention_item(F, bh >> 2, bh & 3, g_ret_out, (32 / RET_SEGS) * seg, (32 / RET_SEGS) * (seg + 1)); } continue; }
        const int j = it - RET_ITEMS, sg = j / 14, rj = j - 14 * sg, ismem = (rj == 0 || rj == 7), idx = rj - 1 - (rj > 7 ? 1 : 0), tri = ismem ? 0 : idx % 3, grp = ismem ? 2 * sg + (rj == 7 ? 1 : 0) : 4 * sg + idx / 3, pos = ismem ? 3 : tri;
        if (pos == 1) { if (!(tmask & 2)) continue;
            const int qb = 15 - (grp >> 4), bh0 = grp & 15, bh1 = bh0 + 16;
            if (fixm) att::moba_pair<true, VAR>(F, qb, bh0 >> 3, bh0 & 7, bh1 >> 3, bh1 & 7, MQ, MK, MV, OMO, (const float*)(F.ctl + CW_KMEAN), 0, 0, w1, w2, mref);
            else att::moba_pair<false, 0>(F, qb, bh0 >> 3, bh0 & 7, bh1 >> 3, bh1 & 7, MQ, MK, MV, OMO, (const float*)(F.ctl + CW_KMEAN), 0, 0, w1, w2, 0.f); }
        else if (pos == 3) { if (!(tmask & 4)) continue;
            const int u = grp, bh = u >> 3, qb0 = 2 * (u & 7), b = bh >> 2, h = bh & 3;
            att::mem_attn_group(F, b, h, qb0, 2, CQ, MEMK + (size_t)b * MEMLEN * 512, MEMV + (size_t)b * MEMLEN * 512, OME, (const float*)(F.ctl + CW_MEMKSS) + (size_t)b * MEMLEN * 4, g_mem_q, g_mem_k); }
        else { if (!(tmask & 8)) continue; const int c = 4 * grp + pos; conv_pair(F, c, w1, w2); }
    }
}
constexpr int N_PHASES = 9;
#ifndef PROBE_MASK
#define PROBE_MASK 0
#endif
constexpr int P2_NITEMS = RET_ITEMS + 14 * 64;
#ifndef P2_LO
#define P2_LO 0
#define P2_HI P2_NITEMS
#endif
#ifndef P2_VAR
#define P2_VAR 0
#endif
#ifndef P2_TMASK
#define P2_TMASK 15
#endif
#define NREP(k) ((((PROBE_MASK) >> (k)) & 1) ? 2 : 1)
__global__ void __launch_bounds__(NWAVES * 64, 2) mega(Args args) {
    extern __shared__ __attribute__((aligned(16))) unsigned char lds[];
    Frame F;
    F.lds = (LAS unsigned char*)lds; F.MISC = (volatile LAS unsigned*)(F.lds + MISC_OFF);
    F.tid = threadIdx.x; F.lane = F.tid & 63; F.wave = __builtin_amdgcn_readfirstlane(F.tid >> 6);
    F.G = gridDim.x; { const int bx = blockIdx.x; F.vcu = (F.G % 8 == 0) ? (bx % 8) * (F.G / 8) + bx / 8 : bx; }
    F.ws = args.ws; F.out = args.out; F.ctl = (gu32*)(args.ws + WS_CTL);
    for (int u = F.tid; u < (LDS_BYTES - LDSCTL_OFF) / 4; u += NWAVES * 64) ((LAS unsigned*)(F.lds + LDSCTL_OFF))[u] = 0u;
    __syncthreads();
    XcdBarrier bar = xcd_barrier_post((unsigned*)(F.ctl + CW_BAR) + args.li * XCD_BAR_WORDS, F.MISC + 8);
    const int lo = args.ph_lo, hi = args.ph_hi;
#define IN(k) (lo <= (k) && (k) < hi)
#define BOTH(k) (IN(k) && IN((k) + 1))
    if (IN(0)) { for (int rep = 0; rep < NREP(0); ++rep) p0_prologue(F, args); if (BOTH(0)) xcd_barrier(bar); }
    if (IN(1)) {
        pg8::Gemm g{(const pg8::bf16_t*)(F.ws + WS_HB), (const pg8::bf16_t*)(F.ws + WS_WIN), NTOK + 1024, DIN + 1024, 1024};
        const int G1 = F.G - P1_SPARE; const bool p1_gemm = (int)blockIdx.x < G1;
        P1Order S; S.init(G1, p1_gemm ? (int)blockIdx.x : 0);
        EpiP1 E{F.ws, args.in[4], (const float*)(F.ws + WS_GTAB), (float*)(F.ctl + CW_KMEAN), (float*)(F.ctl + CW_MEMKSS), 1};
        if (p1_gemm) pg8::gemm_phase<EpiP1, P1Order, true, true>(F.lds + RING_OFF, g, S, E);
        if (P1_SPARE == 0) { const int ci = (int)blockIdx.x - 1680 % F.G; if (1680 % F.G != 0 && ci >= 0 && ci < p1_fill_count(F.G)) conv_item(F, ci, args.in[19], args.in[21]); }
        else { for (int c = (int)blockIdx.x - G1; c < P1_CONV; c += (P1_SPARE ? P1_SPARE : 1)) { conv_item(F, c, args.in[19], args.in[21]); __syncthreads(); } }
        if (NREP(1) > 1) { xcd_barrier(bar); E.atom_on = 0; pg8::gemm_phase<EpiP1, P1Order, true, true>(F.lds + RING_OFF, g, S, E); }
        if (BOTH(1)) xcd_barrier(bar);
    }
    if (IN(2)) {
        const float mref = moba_mref(F);
        p2_mixers<0>(F, args.in[5], args.in[10], args.in[11], args.in[19], args.in[21], CW_QUEUE, 0, P2_NITEMS, 15, mref);
        if (NREP(2) > 1) { xcd_barrier(bar); p2_mixers<P2_VAR>(F, args.in[5], args.in[10], args.in[11], args.in[19], args.in[21], CW_QUEUE + 1024, P2_LO, P2_HI, P2_TMASK, mref); }
        if (BOTH(2)) xcd_barrier(bar);
    }
    if (IN(3)) {
        P3Order S; S.init(F.G, (int)blockIdx.x, F.ws); EpiP3 E{(const bf16_t*)(F.ws + WS_GT), (bf16_t*)(F.ws + WS_Y)};
        pg9::gemm_phase<EpiP3, P3Order, false>(F.lds + RING_OFF, 512, 512, 512, S, E);
        if (NREP(3) > 1) pg9::gemm_phase<EpiP3, P3Order, false>(F.lds + RING_OFF, 512, 512, 512, S, E);
        if (BOTH(3)) xcd_barrier(bar);
    }
    if (IN(4)) {
        P4Order S; S.init(F.G, (int)blockIdx.x, F.ws); EpiP4 E{args.in[0], F.out};
        pg9::gemm_phase<EpiP4, P4Order, false>(F.lds + RING_OFF, 1024, 1024, 1024, S, E);
        if (NREP(4) > 1) pg9::gemm_phase<EpiP4, P4Order, false>(F.lds + RING_OFF, 1024, 1024, 1024, S, E);
        if (BOTH(4)) xcd_barrier(bar);
    }
    if (IN(5)) { p5_router(F, F.out, args.in[16], args.in[17], args.in[18], (int*)F.ctl + CW_COUNTS, (int*)(F.ws + WS_LISTS));
        if (NREP(5) > 1) p5_router(F, F.out, args.in[16], args.in[17], args.in[18], (int*)F.ctl + CW_COUNTS + 256, (int*)(F.ws + WS_RETST));
        if (BOTH(5)) xcd_barrier(bar); }
    if (IN(6)) {
        moe_tables(F);
        MoeOrder<3, WS_W1, 2048, 2, WS_XT> S; S.init(F.G, F.vcu, F.ws, (const LAS int*)(F.lds + TB_OFF));
        EpiMoe1 E{(const int*)(F.ws + WS_LISTS), args.in[20], (bf16_t*)(F.ws + WS_ACT), (int*)(F.ws + WS_SLOT)};
        pg9::gemm_phase<EpiMoe1, MoeOrder<3, WS_W1, 2048, 2, WS_XT>, true>(F.lds + RING_OFF, 1024, 1024, 1024, S, E);
        if (NREP(6) > 1) { xcd_barrier(bar); } if (NREP(6) > 1) pg9::gemm_phase<EpiMoe1, MoeOrder<3, WS_W1, 2048, 2, WS_XT>, true>(F.lds + RING_OFF, 1024, 1024, 1024, S, E);
        if (BOTH(6)) xcd_barrier(bar);
    }
    if (IN(7)) {
        moe_tables(F);
        Moe2SplitOrder S; S.init(F.G, F.vcu, F.ws, (const LAS int*)(F.lds + TB_OFF));
        EpiMoe2 E{args.in[22], F.ws};
        pg9::gemm_phase<EpiMoe2, Moe2SplitOrder, false>(F.lds + RING_OFF, 1024, 1024, 1024, S, E);
        if (NREP(7) > 1) { xcd_barrier(bar); } if (NREP(7) > 1) pg9::gemm_phase<EpiMoe2, Moe2SplitOrder, false>(F.lds + RING_OFF, 1024, 1024, 1024, S, E);
        if (BOTH(7)) xcd_barrier(bar);
    }
    if (IN(8)) { p8_combine(F, F.out, F.out); if (NREP(8) > 1) p8_combine(F, F.out, (float*)(F.ws + WS_HB)); }
    if (NREP(9) > 1) { for (int i = 0; i < 16; ++i) xcd_barrier(bar); }
#undef IN
#undef BOTH
}
#ifndef MK_ONE_LAUNCH
#define MK_ONE_LAUNCH 1
#endif
extern "C" void kernel_launch(void* const* d_in, const int* in_sizes, int n_in, void* d_out, int out_size, void* d_ws, size_t ws_size, hipStream_t stream) {
    if (ws_size < WS_END) { fprintf(stderr, "kernel_launch: ws too small %zu < %zu\n", ws_size, (size_t)WS_END); return; }
    unsigned char* ws = (unsigned char*)d_ws; float* out = (float*)d_out;
    static int grid = 0;
    if (grid == 0) {
        int dev = 0, cus = 0; if (hipGetDevice(&dev) != hipSuccess || hipDeviceGetAttribute(&cus, hipDeviceAttributeMultiprocessorCount, dev) != hipSuccess) { fprintf(stderr, "kernel_launch: device query failed\n"); grid = -1; return; }
        if (hipFuncSetAttribute((const void*)mega, hipFuncAttributeMaxDynamicSharedMemorySize, LDS_BYTES) != hipSuccess) { fprintf(stderr, "kernel_launch: hipFuncSetAttribute failed\n"); grid = -1; return; }
        (void)hipGetLastError(); grid = cus;
    }
    if (grid < 0) return;
    (void)hipMemsetAsync(ws + WS_CTL, 0, 1 * MiB, stream);
    Args a; memset(&a, 0, sizeof a); for (int i = 0; i < 23; ++i) a.in[i] = (const float*)d_in[i]; a.out = out; a.ws = ws; a.li = 0;
#if MK_ONE_LAUNCH
    a.ph_lo = 0; a.ph_hi = N_PHASES;
    hipLaunchKernelGGL(mega, dim3(grid), dim3(NWAVES * 64), LDS_BYTES, stream, a);
#else
    for (int p = 0; p < N_PHASES; ++p) { a.ph_lo = p; a.ph_hi = p + 1; hipLaunchKernelGGL(mega, dim3(grid), dim3(NWAVES * 64), LDS_BYTES, stream, a); }
#endif
}
```

```cpp
#define PROBE_MASK 0
#include <hip/hip_runtime.h>
#include <cstdio>
#include <cstdint>
#include <cstring>
typedef unsigned short bf16_t;
__host__ __device__ inline float bf2f(bf16_t v) { unsigned u = ((unsigned)v) << 16; float f; __builtin_memcpy(&f, &u, 4); return f; }
__host__ __device__ inline bf16_t f2bf(float f) { unsigned u; __builtin_memcpy(&u, &f, 4); u += 0x7fffu + ((u >> 16) & 1u); return (bf16_t)(u >> 16); }
constexpr int NTOK = 16384, SEQ = 4096, NB = 4, DM = 1024, DIN = 6656, MEMLEN = 256, NEXP = 32;
constexpr size_t MiB = (size_t)1 << 20;
constexpr size_t WS_CTL = 0;
constexpr size_t WS_WIN = 1 * MiB;
constexpr size_t WS_WMEMKV = 14 * MiB;
constexpr size_t WS_WBR = 16 * MiB;
constexpr size_t WS_WOUT = 19 * MiB;
constexpr size_t WS_W1 = 21 * MiB;
constexpr size_t WS_W2 = 149 * MiB;
constexpr size_t WS_HB = 213 * MiB;
constexpr size_t WS_HM = 245 * MiB;
constexpr size_t WS_RQ = 247 * MiB, WS_RK = 255 * MiB, WS_RV = 263 * MiB, WS_RG = 279 * MiB, WS_MQ = 295 * MiB, WS_MK = 311 * MiB, WS_MV = 327 * MiB, WS_CQ = 343 * MiB, WS_GT = 359 * MiB;
constexpr size_t WS_MEMK = 455 * MiB, WS_MEMV = 456 * MiB, WS_KMEAN = 457 * MiB, WS_MEMKSS = 457 * MiB + 512 * 1024;
constexpr size_t WS_WRS = 457 * MiB + 768 * 1024 + 4096;
constexpr size_t WS_GTAB = 457 * MiB + 768 * 1024;
constexpr size_t WS_ORET = 458 * MiB, WS_OMOBA = 474 * MiB, WS_OMEM = 490 * MiB;
constexpr size_t WS_Y = 506 * MiB, WS_XT = 538 * MiB;
constexpr size_t WS_TOPE = 570 * MiB, WS_TOPW = 570 * MiB + 256 * 1024, WS_LISTS = 571 * MiB;
constexpr size_t WS_ACT = 574 * MiB;
constexpr size_t WS_YS = 722 * MiB;
constexpr size_t WS_SLOT = 870 * MiB;
constexpr size_t WS_RETST = 959 * MiB;
constexpr size_t WS_END = 871 * MiB;
constexpr size_t WS_PROJ = 574 * MiB;
constexpr size_t WS_PM = 990 * MiB;
constexpr size_t WS_ORAW = 574 * MiB;
constexpr size_t WS_T0 = 703 * MiB, WS_T1 = 767 * MiB, WS_T2 = 831 * MiB;
constexpr int CW_COUNTS = 64;
namespace pg8 {
#define PG8_LAS __attribute__((address_space(3)))
typedef unsigned short bf16_t;
typedef short bf16x8 __attribute__((ext_vector_type(8)));
typedef float f32x4 __attribute__((ext_vector_type(4)));
typedef unsigned u32x4 __attribute__((ext_vector_type(4)));
constexpr int BM = 256, BK = 64, HALF = 128, HTB = HALF * BK * 2  , STAGE_BYTES = 8 * HTB, NXCD = 8, WGM = 4;

__host__ __device__ __forceinline__ int lds_byte(int r, int c) { const int st = (r >> 4) * 2 + (c >> 5), rr = r & 15, cc = c & 31, ob = rr * 64 + cc * 2; return st * 1024 + (ob ^ (((ob >> 9) & 1) << 5)); }
__host__ __device__ __forceinline__ void stage_rc(int b, int& R, int& C) { const int st = b / 1024, sb = b % 1024, swz = sb ^ (((sb >> 9) & 1) << 5); R = (st >> 1) * 16 + swz / 64; C = (st & 1) * 32 + (swz % 64) / 2; }
__host__ __device__ __forceinline__ int perm32(int rho) { const int n = rho >> 4, i = rho & 15; return 8 * (i >> 2) + 4 * n + (i & 3); }

struct Unit { int pm, pn; };
struct Gemm { const bf16_t* A; const bf16_t* Bt; int M, N, K; };
struct StaticOrder {
    int nM, nN, nwg, G, c;
    __host__ __device__ void init(int M, int N, int G_, int c_) { nM = M / BM; nN = N / BM; nwg = nM * nN; G = G_; c = c_; }
    __host__ __device__ bool next(int i, Unit& u) const {
        const long L = (long)i * G + c; if (L >= nwg) return false;
        int wgid = (int)L; { const int q = nwg / NXCD, r = nwg % NXCD, xcd = wgid % NXCD, off = wgid / NXCD; wgid = (xcd < r ? xcd * (q + 1) : r * (q + 1) + (xcd - r) * q) + off; }
        const int nig = WGM * nN, gid = wgid / nig, fm = gid * WGM, gsz = (nM - fm) < WGM ? (nM - fm) : WGM;
        u.pm = fm + ((wgid % nig) % gsz); u.pn = (wgid % nig) / gsz; return true;
    }
    __device__ __forceinline__ void a_ready(const Unit&) const {}
    __device__ __forceinline__ void done(const Unit&) const {}
};
__device__ __forceinline__ unsigned cvt_pk_bf16(float lo, float hi) { unsigned r; asm volatile("v_cvt_pk_bf16_f32 %0, %1, %2" : "=v"(r) : "v"(lo), "v"(hi)); return r; }
typedef float f32x2 __attribute__((ext_vector_type(2)));
template <class Epi, class Sched, bool ALIGN_EPI = false, bool SP2 = false>
__device__ __forceinline__ void gemm_phase(PG8_LAS unsigned char* lds, const Gemm g, const Sched& S, const Epi& E) {
    const int tid = threadIdx.x, wid = __builtin_amdgcn_readfirstlane(tid >> 6), lane = tid & 63, wr = wid >> 2, wc = wid & 3, fr = lane & 15, fq = lane >> 4;
    const int K = g.K, nt = K / BK;
    unsigned voffA[2], voffB[2];
#pragma unroll
    for (int i = 0; i < 2; ++i) { int R, C; stage_rc(tid * 16 + i * 8192, R, C); const int Rb = Epi::PERM ? ((R & ~31) + perm32(R & 31)) : R;
        voffA[i] = (unsigned)(R * K + C) * 2u; voffB[i] = (unsigned)(Rb * K + C) * 2u; }
    const size_t kstep = (size_t)(BK * 2);
    const size_t hstep = (size_t)HALF * K * 2;
    const size_t tstep = 2 * hstep;
    const unsigned ldsw = (unsigned)wid * 1024u;
    const int aoff = lds_byte(wr * 64 + fr, fq * 8), boff = lds_byte(wc * 32 + fr, fq * 8);
#define PG8_SA(b, h) (((b) * 2 + (h)) * HTB)
#define PG8_SB(b, h) ((4 + (b) * 2 + (h)) * HTB)
#define PG8_STAGE(bufoff, gbase, voff) do { _Pragma("unroll") for (int _i = 0; _i < 2; ++_i) \
        __builtin_amdgcn_global_load_lds((const unsigned*)((const char*)(gbase) + (voff)[_i]), (PG8_LAS unsigned*)(lds + (bufoff) + ldsw + _i * 8192), 16, 0, 0); } while (0)
#define PG8_LDA(dst, b, h) do { _Pragma("unroll") for (int m = 0; m < 4; ++m) _Pragma("unroll") for (int k = 0; k < 2; ++k) dst[m][k] = *(const PG8_LAS bf16x8*)(lds + PG8_SA(b, h) + aoff + m * 2048 + k * 1024); } while (0)
#define PG8_LDB(dst, b, h) do { _Pragma("unroll") for (int n = 0; n < 2; ++n) _Pragma("unroll") for (int k = 0; k < 2; ++k) dst[n][k] = *(const PG8_LAS bf16x8*)(lds + PG8_SB(b, h) + boff + n * 2048 + k * 1024); } while (0)
#define PG8_MMA(ai, bj, At, Bt) do { __builtin_amdgcn_s_setprio(1); _Pragma("unroll") for (int m = 0; m < 4; ++m) _Pragma("unroll") for (int n = 0; n < 2; ++n) _Pragma("unroll") for (int k = 0; k < 2; ++k) \
        acc[ai][bj][m][n] = __builtin_amdgcn_mfma_f32_16x16x32_bf16(Bt[n][k], At[m][k], acc[ai][bj][m][n], 0, 0, 0); __builtin_amdgcn_s_setprio(0); } while (0)
#define PG8_WAIT_V(n) asm volatile("s_waitcnt vmcnt(" #n ")" ::: "memory")
#define PG8_WAIT_L(n) asm volatile("s_waitcnt lgkmcnt(" #n ")" ::: "memory")
#define PG8_BAR __builtin_amdgcn_s_barrier()
#define PG8_SCHED __builtin_amdgcn_sched_barrier(0)
    Unit cur, nxt; int ui = 0;
    if (!S.next(0, cur)) return;
    f32x4 acc[2][2][4][2];
#pragma unroll
    for (int a = 0; a < 2; ++a)
#pragma unroll
        for (int b = 0; b < 2; ++b)
#pragma unroll
            for (int m = 0; m < 4; ++m)
#pragma unroll
                for (int n = 0; n < 2; ++n) acc[a][b][m][n] = (f32x4){0.f, 0.f, 0.f, 0.f};
    bf16x8 At[4][2], B0[2][2], B1[2][2];
    const char* cA = (const char*)g.A + (size_t)cur.pm * tstep; const char* cB = (const char*)g.Bt + (size_t)cur.pn * tstep;
    S.a_ready(cur);
    if constexpr (SP2) {
        PG8_STAGE(PG8_SB(0, 0), cB, voffB); PG8_STAGE(PG8_SB(0, 1), cB + hstep, voffB); PG8_STAGE(PG8_SA(0, 0), cA, voffA); PG8_STAGE(PG8_SA(0, 1), cA + hstep, voffA);
        if (wr == 1) PG8_BAR;
        PG8_WAIT_V(2); PG8_BAR;
        PG8_STAGE(PG8_SB(1, 0), cB + kstep, voffB); PG8_STAGE(PG8_SA(1, 0), cA + kstep, voffA); PG8_STAGE(PG8_SB(1, 1), cB + hstep + kstep, voffB);
        PG8_WAIT_V(6); PG8_BAR;
    } else {
        PG8_STAGE(PG8_SB(0, 0), cB, voffB); PG8_STAGE(PG8_SA(0, 0), cA, voffA); PG8_STAGE(PG8_SB(0, 1), cB + hstep, voffB); PG8_STAGE(PG8_SA(0, 1), cA + hstep, voffA);
        if (wr == 1) PG8_BAR;
        PG8_WAIT_V(4); PG8_BAR;
        PG8_STAGE(PG8_SB(1, 0), cB + kstep, voffB); PG8_STAGE(PG8_SA(1, 0), cA + kstep, voffA); PG8_STAGE(PG8_SB(1, 1), cB + hstep + kstep, voffB);
        PG8_WAIT_V(6); PG8_BAR;
    }
    for (;;) {
        const bool has_next = S.next(ui + 1, nxt);
        const char* nA = has_next ? (const char*)g.A + (size_t)nxt.pm * tstep : cA; const char* nB = has_next ? (const char*)g.Bt + (size_t)nxt.pn * tstep : cB;
        for (int t = 0; t < nt; t += 2) {
            const bool last = (t == nt - 2);
            const char* a1 = cA + (size_t)(t + 1) * kstep;
            const char* a2 = last ? nA : cA + (size_t)(t + 2) * kstep; const char* b2 = last ? nB : cB + (size_t)(t + 2) * kstep;
            const char* a3 = a2 + kstep; const char* b3 = b2 + kstep;
            if (last && has_next) S.a_ready(nxt);
            if constexpr (SP2) {
            PG8_LDB(B0, 0, 0); PG8_LDB(B1, 0, 1); PG8_SCHED; PG8_LDA(At, 0, 0); PG8_STAGE(PG8_SA(1, 1), a1 + hstep, voffA);
            PG8_WAIT_V(8); PG8_WAIT_L(0); PG8_BAR; PG8_MMA(0, 0, At, B0); PG8_MMA(0, 1, At, B1); PG8_BAR; PG8_SCHED;
            PG8_LDA(At, 0, 1); PG8_STAGE(PG8_SB(0, 0), b2, voffB); PG8_STAGE(PG8_SB(0, 1), b2 + hstep, voffB); PG8_STAGE(PG8_SA(0, 0), a2, voffA);
            PG8_WAIT_V(8); PG8_WAIT_L(0); PG8_BAR; PG8_MMA(1, 0, At, B0); PG8_MMA(1, 1, At, B1); PG8_BAR; PG8_SCHED;
            PG8_LDB(B0, 1, 0); PG8_LDB(B1, 1, 1); PG8_SCHED; PG8_LDA(At, 1, 0); PG8_STAGE(PG8_SA(0, 1), a2 + hstep, voffA);
            PG8_WAIT_V(8); PG8_WAIT_L(0); PG8_BAR; PG8_MMA(0, 0, At, B0); PG8_MMA(0, 1, At, B1); PG8_BAR; PG8_SCHED;
            PG8_LDA(At, 1, 1); PG8_STAGE(PG8_SB(1, 0), b3, voffB); PG8_STAGE(PG8_SB(1, 1), b3 + hstep, voffB); PG8_STAGE(PG8_SA(1, 0), a3, voffA);
            PG8_WAIT_V(8); PG8_WAIT_L(0); PG8_BAR; PG8_MMA(1, 0, At, B0); PG8_MMA(1, 1, At, B1); PG8_BAR; PG8_SCHED;
            } else {
            PG8_LDB(B0, 0, 0); PG8_SCHED; PG8_LDA(At, 0, 0); PG8_STAGE(PG8_SA(1, 1), a1 + hstep, voffA);
            PG8_WAIT_L(8); PG8_BAR; PG8_WAIT_L(0); PG8_MMA(0, 0, At, B0); PG8_BAR; PG8_SCHED;
            PG8_LDB(B1, 0, 1); PG8_STAGE(PG8_SB(0, 0), b2, voffB);
            PG8_BAR; PG8_WAIT_L(0); PG8_MMA(0, 1, At, B1); PG8_BAR;
            PG8_LDA(At, 0, 1); PG8_STAGE(PG8_SA(0, 0), a2, voffA);
            PG8_BAR; PG8_WAIT_L(0); PG8_MMA(1, 0, At, B0); PG8_BAR; PG8_SCHED;
            PG8_STAGE(PG8_SB(0, 1), b2 + hstep, voffB);
            PG8_WAIT_V(6); PG8_BAR; PG8_MMA(1, 1, At, B1); PG8_BAR;
            PG8_LDB(B0, 1, 0); PG8_SCHED; PG8_LDA(At, 1, 0); PG8_STAGE(PG8_SA(0, 1), a2 + hstep, voffA);
            PG8_WAIT_L(8); PG8_BAR; PG8_WAIT_L(0); PG8_MMA(0, 0, At, B0); PG8_BAR; PG8_SCHED;
            PG8_LDB(B1, 1, 1); PG8_STAGE(PG8_SB(1, 0), b3, voffB);
            PG8_BAR; PG8_WAIT_L(0); PG8_MMA(0, 1, At, B1); PG8_BAR;
            PG8_LDA(At, 1, 1); PG8_STAGE(PG8_SA(1, 0), a3, voffA);
            PG8_BAR; PG8_WAIT_L(0); PG8_MMA(1, 0, At, B0); PG8_BAR; PG8_SCHED;
            PG8_STAGE(PG8_SB(1, 1), b3 + hstep, voffB);
            PG8_WAIT_V(6); PG8_BAR; PG8_MMA(1, 1, At, B1); PG8_BAR;
            }
        }
        if constexpr (ALIGN_EPI) { if (wr == 0) PG8_BAR; }
        if constexpr (!Epi::AFTER_DRAIN) { E(acc, cur, wr, wc, fr, fq); S.done(cur); }
        if (!has_next) break;
#pragma unroll
        for (int a = 0; a < 2; ++a)
#pragma unroll
            for (int b = 0; b < 2; ++b)
#pragma unroll
                for (int m = 0; m < 4; ++m)
#pragma unroll
                    for (int n = 0; n < 2; ++n) acc[a][b][m][n] = (f32x4){0.f, 0.f, 0.f, 0.f};
        cur = nxt; cA = nA; cB = nB; ++ui;
        if constexpr (ALIGN_EPI) { if (wr == 1) PG8_BAR; }
    }
    PG8_WAIT_V(0);
    if constexpr (!ALIGN_EPI) { if (wr == 0) PG8_BAR; }
    PG8_BAR;
    if constexpr (Epi::AFTER_DRAIN) { E.fused(acc, cur, wr, wc, fr, fq, lds, wid, lane); S.done(cur); }
#undef PG8_SA
#undef PG8_SB
#undef PG8_STAGE
#undef PG8_LDA
#undef PG8_LDB
#undef PG8_MMA
#undef PG8_WAIT_V
#undef PG8_WAIT_L
#undef PG8_BAR
#undef PG8_SCHED
}
}
namespace pg9 {
using pg8::bf16x8; using pg8::f32x4; using pg8::u32x4; using pg8::lds_byte; using pg8::stage_rc; using pg8::perm32;
constexpr int BK = 64, HALF = 128, HTB = HALF * BK * 2;
struct Unit { int pm, pn, aux, cnt, row0, ty; };
template <class Epi, class Sched, bool GATHER>
__device__ __forceinline__ void gemm_phase(PG8_LAS unsigned char* lds, const int K, const int lda, const int ldb, const Sched& S, const Epi& E) {
    const int tid = threadIdx.x, wid = __builtin_amdgcn_readfirstlane(tid >> 6), lane = tid & 63, wr = wid >> 2, wc = wid & 3, fr = lane & 15, fq = lane >> 4;
    const int nt = K / BK;
    unsigned offA[2][2], offAn[2][2], offB[2][2]; int RA[2], CA[2];
#pragma unroll
    for (int i = 0; i < 2; ++i) { int R, C; stage_rc(tid * 16 + i * 8192, R, C); const int Rb = Epi::PERM ? ((R & ~31) + perm32(R & 31)) : R; RA[i] = R; CA[i] = C * 2;
#pragma unroll
        for (int h = 0; h < 2; ++h) { offB[h][i] = (unsigned)((Rb + 128 * h) * ldb + C) * 2u; offA[h][i] = (unsigned)((R + 128 * h) * lda + C) * 2u; offAn[h][i] = offA[h][i]; } }
    const size_t kstep = (size_t)(BK * 2);
    const unsigned ldsw = (unsigned)wid * 1024u;
    const int aoff = lds_byte(wr * 64 + fr, fq * 8), boff = lds_byte(wc * 32 + fr, fq * 8);
#define PG9_SA(b, h) (((b) * 2 + (h)) * HTB)
#define PG9_SB(b, h) ((4 + (b) * 2 + (h)) * HTB)
#define PG9_STAGE(bufoff, gbase, voff) do { _Pragma("unroll") for (int _i = 0; _i < 2; ++_i) \
        __builtin_amdgcn_global_load_lds((const unsigned*)((const char*)(gbase) + (voff)[_i]), (PG8_LAS unsigned*)(lds + (bufoff) + ldsw + _i * 8192), 16, 0, 0); } while (0)
#define PG9_LDA(dst, b, h) do { _Pragma("unroll") for (int m = 0; m < 4; ++m) _Pragma("unroll") for (int k = 0; k < 2; ++k) dst[m][k] = *(const PG8_LAS bf16x8*)(lds + PG9_SA(b, h) + aoff + m * 2048 + k * 1024); } while (0)
#define PG9_LDB(dst, b, h) do { _Pragma("unroll") for (int n = 0; n < 2; ++n) _Pragma("unroll") for (int k = 0; k < 2; ++k) dst[n][k] = *(const PG8_LAS bf16x8*)(lds + PG9_SB(b, h) + boff + n * 2048 + k * 1024); } while (0)
#define PG9_MMA(ai, bj, At, Bt) do { __builtin_amdgcn_s_setprio(1); _Pragma("unroll") for (int m = 0; m < 4; ++m) _Pragma("unroll") for (int n = 0; n < 2; ++n) _Pragma("unroll") for (int k = 0; k < 2; ++k) \
        acc[ai][bj][m][n] = __builtin_amdgcn_mfma_f32_16x16x32_bf16(Bt[n][k], At[m][k], acc[ai][bj][m][n], 0, 0, 0); __builtin_amdgcn_s_setprio(0); } while (0)
#define PG9_WAIT_V(n) asm volatile("s_waitcnt vmcnt(" #n ")" ::: "memory")
#define PG9_WAIT_L(n) asm volatile("s_waitcnt lgkmcnt(" #n ")" ::: "memory")
#define PG9_BAR __builtin_amdgcn_s_barrier()
#define PG9_SCHED __builtin_amdgcn_sched_barrier(0)
    Unit cur, nxt; int ui = 0;
    if (!S.next(0, cur)) return;
    f32x4 acc[2][2][4][2];
#pragma unroll
    for (int a = 0; a < 2; ++a)
#pragma unroll
        for (int b = 0; b < 2; ++b)
#pragma unroll
            for (int m = 0; m < 4; ++m)
#pragma unroll
                for (int n = 0; n < 2; ++n) acc[a][b][m][n] = (f32x4){0.f, 0.f, 0.f, 0.f};
    bf16x8 At[4][2], B0[2][2], B1[2][2];
    S.a_ready(cur, wid, lane);
    const char* cA = S.a_base(cur); const char* cB = S.b_base(cur);
    if constexpr (GATHER) {
#pragma unroll
        for (int h = 0; h < 2; ++h)
#pragma unroll
            for (int i = 0; i < 2; ++i) offA[h][i] = S.a_row_off(cur, RA[i] + 128 * h) + (unsigned)CA[i];
    }
    PG9_STAGE(PG9_SB(0, 0), cB, offB[0]); PG9_STAGE(PG9_SB(0, 1), cB, offB[1]); PG9_STAGE(PG9_SA(0, 0), cA, offA[0]); PG9_STAGE(PG9_SA(0, 1), cA, offA[1]);
    if (wr == 1) PG9_BAR;
    PG9_WAIT_V(2); PG9_BAR;
    PG9_STAGE(PG9_SB(1, 0), cB + kstep, offB[0]); PG9_STAGE(PG9_SA(1, 0), cA + kstep, offA[0]); PG9_STAGE(PG9_SB(1, 1), cB + kstep, offB[1]);
    PG9_WAIT_V(6); PG9_BAR;
    for (;;) {
        const bool has_next = S.next(ui + 1, nxt);
        if (has_next) S.a_ready(nxt, wid, lane);
        const char* nA = has_next ? S.a_base(nxt) : cA; const char* nB = has_next ? S.b_base(nxt) : cB;
        if constexpr (GATHER) {
#pragma unroll
            for (int h = 0; h < 2; ++h)
#pragma unroll
                for (int i = 0; i < 2; ++i) offAn[h][i] = has_next ? (S.a_row_off(nxt, RA[i] + 128 * h) + (unsigned)CA[i]) : offA[h][i];
        }
        const int ntu = S.nt_of(cur, nt);
        for (int t = 0; t < ntu; t += 2) {
            const bool last = (t == ntu - 2);
            const char* a1 = cA + (size_t)(t + 1) * kstep;
            const char* a2 = last ? nA : cA + (size_t)(t + 2) * kstep; const char* b2 = last ? nB : cB + (size_t)(t + 2) * kstep;
            const char* a3 = a2 + kstep; const char* b3 = b2 + kstep;
            unsigned oA2[2][2];
#pragma unroll
            for (int h = 0; h < 2; ++h)
#pragma unroll
                for (int i = 0; i < 2; ++i) oA2[h][i] = (GATHER && last) ? offAn[h][i] : offA[h][i];
            PG9_LDB(B0, 0, 0); PG9_LDB(B1, 0, 1); PG9_SCHED; PG9_LDA(At, 0, 0); PG9_STAGE(PG9_SA(1, 1), a1, offA[1]);
            PG9_WAIT_V(8); PG9_WAIT_L(0); PG9_BAR; PG9_MMA(0, 0, At, B0); PG9_MMA(0, 1, At, B1); PG9_BAR; PG9_SCHED;
            PG9_LDA(At, 0, 1); PG9_STAGE(PG9_SB(0, 0), b2, offB[0]); PG9_STAGE(PG9_SB(0, 1), b2, offB[1]); PG9_STAGE(PG9_SA(0, 0), a2, oA2[0]);
            PG9_WAIT_V(8); PG9_WAIT_L(0); PG9_BAR; PG9_MMA(1, 0, At, B0); PG9_MMA(1, 1, At, B1); PG9_BAR; PG9_SCHED;
            PG9_LDB(B0, 1, 0); PG9_LDB(B1, 1, 1); PG9_SCHED; PG9_LDA(At, 1, 0); PG9_STAGE(PG9_SA(0, 1), a2, oA2[1]);
            PG9_WAIT_V(8); PG9_WAIT_L(0); PG9_BAR; PG9_MMA(0, 0, At, B0); PG9_MMA(0, 1, At, B1); PG9_BAR; PG9_SCHED;
            PG9_LDA(At, 1, 1); PG9_STAGE(PG9_SB(1, 0), b3, offB[0]); PG9_STAGE(PG9_SB(1, 1), b3, offB[1]); PG9_STAGE(PG9_SA(1, 0), a3, oA2[0]);
            PG9_WAIT_V(8); PG9_WAIT_L(0); PG9_BAR; PG9_MMA(1, 0, At, B0); PG9_MMA(1, 1, At, B1); PG9_BAR; PG9_SCHED;
        }
        if (wr == 0) PG9_BAR;
        bool keep = false;
        if constexpr (Epi::CHAIN) keep = E.chain_more(cur);
        if (keep) { if constexpr (Epi::CHAIN) E.rescale(acc, cur, wr, wc, fr, fq); }
        else { E(acc, cur, wr, wc, fr, fq); S.done(cur, lane); }
        if (!has_next) break;
        if (!keep) {
#pragma unroll
            for (int a = 0; a < 2; ++a)
#pragma unroll
                for (int b = 0; b < 2; ++b)
#pragma unroll
                    for (int m = 0; m < 4; ++m)
#pragma unroll
                        for (int n = 0; n < 2; ++n) acc[a][b][m][n] = (f32x4){0.f, 0.f, 0.f, 0.f};
        }
        cur = nxt; cA = nA; cB = nB; ++ui;
        if constexpr (GATHER) {
#pragma unroll
            for (int h = 0; h < 2; ++h)
#pragma unroll
                for (int i = 0; i < 2; ++i) offA[h][i] = offAn[h][i];
        }
        if (wr == 1) PG9_BAR;
    }
    PG9_WAIT_V(0);
    PG9_BAR;
#undef PG9_SA
#undef PG9_SB
#undef PG9_STAGE
#undef PG9_LDA
#undef PG9_LDB
#undef PG9_MMA
#undef PG9_WAIT_V
#undef PG9_WAIT_L
#undef PG9_BAR
#undef PG9_SCHED
}
}
#define GAS __attribute__((address_space(1)))
#define LAS __attribute__((address_space(3)))
typedef unsigned short bf16;
typedef unsigned v4u __attribute__((ext_vector_type(4)));
typedef float f32x4 __attribute__((ext_vector_type(4)));
typedef short bf16x8 __attribute__((ext_vector_type(8)));
typedef GAS unsigned gu32;
typedef GAS unsigned long long gu64;
#define RLX_AGENT __ATOMIC_RELAXED, __HIP_MEMORY_SCOPE_AGENT
#define LDS_WAIT() asm volatile("s_waitcnt lgkmcnt(0)" ::: "memory")
#define VM_WAIT() asm volatile("s_waitcnt vmcnt(0)" ::: "memory")
__device__ __forceinline__ unsigned long long rt() { return __builtin_amdgcn_s_memrealtime(); }
__device__ __forceinline__ unsigned f2bfu(float f) { unsigned u = __builtin_bit_cast(unsigned, f); return (u + 0x7fffu + ((u >> 16) & 1u)) >> 16; }
__device__ __forceinline__ unsigned pk2(float lo, float hi) { return f2bfu(lo) | (f2bfu(hi) << 16); }
#define XB_TMO      128
#define XB_XCNT(j)  (256  + 64 * (j))
#define XB_XSUB(j)  (1280 + 64 * (j))
#define XB_XGEN(j)  (2304 + 64 * (j))
#define XB_TOP      3328
#define XB_TOPGEN   3392
#define XCD_BAR_WORDS 3456
#define XB_SPIN_CAP (1u << 18)

__device__ __forceinline__ unsigned xb_ld(unsigned* p)              { return __hip_atomic_load(p, __ATOMIC_RELAXED, __HIP_MEMORY_SCOPE_AGENT); }
__device__ __forceinline__ unsigned xb_add(unsigned* p, unsigned v) { return __hip_atomic_fetch_add(p, v, __ATOMIC_RELAXED, __HIP_MEMORY_SCOPE_AGENT); }
__device__ __forceinline__ unsigned xb_xcc_id() { return (unsigned)__builtin_amdgcn_s_getreg((3 << 11) | 20) & 0xFu; }
#define XB_SPIN(cond, bar) do { unsigned _sp = 0; while (cond) { __builtin_amdgcn_s_sleep(1); \
    if ((++_sp & 255u) == 0u) { if (xb_ld(&(bar)[XB_TMO])) break; if (_sp > XB_SPIN_CAP) { atomicAdd(&(bar)[XB_TMO], 1u); break; } } } } while (0)

struct XcdBarrier {
    unsigned* bar; unsigned x;
    volatile LAS unsigned* st;
};

__device__ __forceinline__ XcdBarrier xcd_barrier_post(unsigned* bar, volatile LAS unsigned* st) {
    XcdBarrier b; b.bar = bar; b.x = xb_xcc_id(); b.st = st;
    if (threadIdx.x == 0) (void)xb_add(&bar[XB_XCNT(b.x)], 1u);
    return b;
}
__device__ __forceinline__ void xcd_barrier_complete(unsigned* bar, unsigned x, unsigned& nloc, unsigned& nx) {
    const unsigned G = gridDim.x * gridDim.y * gridDim.z;
    unsigned sum, cnt, mine, sp = 0u;
    for (;;) {
        sum = 0u; cnt = 0u; mine = 0u;
#pragma unroll
        for (unsigned j = 0; j < 16; ++j) { const unsigned c = xb_ld(&bar[XB_XCNT(j)]); sum += c; cnt += (c > 0u) ? 1u : 0u; mine = (j == x) ? c : mine; }
        if (sum == G) break;
        __builtin_amdgcn_s_sleep(1);
        if ((++sp & 255u) == 0u) { if (xb_ld(&bar[XB_TMO])) break; if (sp > XB_SPIN_CAP) { atomicAdd(&bar[XB_TMO], 1u); break; } }
    }
    nloc = mine > 0u ? mine : 1u; nx = cnt > 0u ? cnt : 1u;
}

__device__ __forceinline__ void xcd_barrier(const XcdBarrier& b) {
    asm volatile("s_waitcnt vmcnt(0)" ::: "memory");
    __syncthreads();
    if (threadIdx.x == 0) {
        unsigned* bar = b.bar;
        __builtin_amdgcn_s_waitcnt(0);
        unsigned nloc = b.st[0], nx = b.st[1];
        if (nloc == 0u) { xcd_barrier_complete(bar, b.x, nloc, nx); b.st[0] = nloc; b.st[1] = nx; }
        const unsigned old = xb_add(&bar[XB_XSUB(b.x)], 1u);
        const unsigned gen = old / nloc;
        if (old + 1u == (gen + 1u) * nloc) {
            __builtin_amdgcn_fence(__ATOMIC_RELEASE, "agent");
            asm volatile("s_waitcnt vmcnt(0)" ::: "memory");
            const unsigned og = xb_add(&bar[XB_TOP], 1u);
            const unsigned tg = og / nx;
            if (og + 1u == (tg + 1u) * nx) xb_add(&bar[XB_TOPGEN], 1u);
            else XB_SPIN(xb_ld(&bar[XB_TOPGEN]) == tg, bar);
            __builtin_amdgcn_fence(__ATOMIC_ACQUIRE, "agent");
            xb_add(&bar[XB_XGEN(b.x)], 1u);
            asm volatile("s_waitcnt vmcnt(0)" ::: "memory");
        } else {
            XB_SPIN(xb_ld(&bar[XB_XGEN(b.x)]) == gen, bar);
            __builtin_amdgcn_fence(__ATOMIC_ACQUIRE, "agent");
            asm volatile("s_waitcnt vmcnt(0)" ::: "memory");
        }
    }
    __syncthreads();
}
constexpr int NWAVES = 8;
constexpr int RING_OFF = 0, RING_BYTES = 131072;
constexpr int LDSCTL_OFF = RING_BYTES, MISC_OFF = LDSCTL_OFF + 320;
constexpr int LDS_BYTES = 147456;
constexpr int CW_BAR = 4096;
constexpr int CW_KMEAN = 32768;
constexpr int CW_MEMKSS = 65536;
static_assert((CW_MEMKSS + 4096) * 4 <= (int)MiB && CW_BAR + 4 * 3456 <= CW_KMEAN, "ctl map");

struct Frame {
    LAS unsigned char* lds; volatile LAS unsigned* MISC; gu32* ctl;
    int tid, lane, wave, vcu, G;
    unsigned char* ws; float* out;
};
typedef float f32x2_t __attribute__((ext_vector_type(2))); typedef __bf16 bf16x2_t __attribute__((ext_vector_type(2)));
__device__ __forceinline__ unsigned cvt_pk_bf16(float lo, float hi) { f32x2_t v = {lo, hi}; bf16x2_t b = __builtin_convertvector(v, bf16x2_t); return __builtin_bit_cast(unsigned, b); }
__device__ __forceinline__ float wave_sum64(float v) {
#pragma unroll
    for (int o = 1; o < 64; o <<= 1) v += __shfl_xor(v, o);
    return v;
}
template <bool HEADPERM> __device__ __forceinline__ void p0_transpose_item(const float* W, int K, int N, bf16* WT, int row_off, LAS float* scr, int item, int lane) {
    const int nblk = N / 32, kb = item / nblk, nb = item % nblk, k0 = 64 * kb, n0 = 32 * nb;
    int p0 = n0; if (HEADPERM) { const int lg = (n0 >> 5) & 7; p0 = (n0 & ~255) + 32 * (4 * (lg & 1) + (lg >> 1)); }
    float wv[32];
#pragma unroll
    for (int i = 0; i < 32; ++i) wv[i] = __builtin_nontemporal_load(&W[(size_t)(k0 + 2 * i + (lane >> 5)) * N + n0 + (lane & 31)]);
#pragma unroll
    for (int i = 0; i < 32; ++i) scr[(2 * i + (lane >> 5)) * 33 + (lane & 31)] = wv[i];
    LDS_WAIT(); asm volatile("" ::: "memory");
    const int c = lane & 7;
#pragma unroll
    for (int j = 0; j < 4; ++j) { const int n = (lane >> 3) + 8 * j; const LAS float* s = scr + (8 * c) * 33 + n;
        v4u o; o.x = cvt_pk_bf16(s[0 * 33], s[1 * 33]); o.y = cvt_pk_bf16(s[2 * 33], s[3 * 33]); o.z = cvt_pk_bf16(s[4 * 33], s[5 * 33]); o.w = cvt_pk_bf16(s[6 * 33], s[7 * 33]);
        *(GAS v4u*)(WT + (size_t)(row_off + p0 + n) * K + k0 + 8 * c) = o; }
    LDS_WAIT(); asm volatile("" ::: "memory");
}
__device__ __forceinline__ void xp_load(float (&wv)[32], const float* W, int N, int nblk, int item, int lane) {
    const int kb = item / nblk, nb = item % nblk, k0 = 64 * kb, n0 = 32 * nb;
#pragma unroll
    for (int i = 0; i < 32; ++i) wv[i] = __builtin_nontemporal_load(&W[(size_t)(k0 + 2 * i + (lane >> 5)) * N + n0 + (lane & 31)]);
}
__device__ __forceinline__ void xp_finish(const float (&wv)[32], int K, int nblk, bf16* WT, LAS float* scr, int item, int lane) {
    const int kb = item / nblk, nb = item % nblk, k0 = 64 * kb, n0 = 32 * nb;
#pragma unroll
    for (int i = 0; i < 32; ++i) scr[(2 * i + (lane >> 5)) * 33 + (lane & 31)] = wv[i];
    LDS_WAIT(); asm volatile("" ::: "memory");
    const int c = lane & 7;
#pragma unroll
    for (int j = 0; j < 4; ++j) { const int n = (lane >> 3) + 8 * j; const LAS float* s = scr + (8 * c) * 33 + n;
        v4u o; o.x = cvt_pk_bf16(s[0 * 33], s[1 * 33]); o.y = cvt_pk_bf16(s[2 * 33], s[3 * 33]); o.z = cvt_pk_bf16(s[4 * 33], s[5 * 33]); o.w = cvt_pk_bf16(s[6 * 33], s[7 * 33]);
        __builtin_nontemporal_store(o, (v4u*)(WT + (size_t)(n0 + n) * K + k0 + 8 * c)); }
    LDS_WAIT(); asm volatile("" ::: "memory");
}
__device__ __forceinline__ void cv_load(f32x4 (&v)[8], const int slot, const float* w1, const float* w2, const int lane) {
    const int q = slot / 17, r = slot - 17 * q; if (r >= 12) return;
    const int bi = 12 * q + r; const bool isw1 = bi < 32768; const int b2 = isw1 ? bi : bi - 32768;
    const int e = isw1 ? (b2 >> 10) : (b2 >> 9), kb = isw1 ? ((b2 >> 6) & 15) : ((b2 >> 5) & 15), nb = isw1 ? (b2 & 63) : (b2 & 31), N = isw1 ? 2048 : 1024;
    const float* src = (isw1 ? w1 : w2) + ((size_t)e * 1024 + 64 * kb + (lane >> 3)) * N + 32 * nb + 4 * (lane & 7);
#pragma unroll
    for (int i = 0; i < 8; ++i) v[i] = __builtin_nontemporal_load((const f32x4*)(src + (size_t)(8 * i) * N));
}
__device__ __forceinline__ void cv_finish(const f32x4 (&v)[8], const int slot, unsigned char* ws, LAS float* scr, const int lane) {
    const int q = slot / 17, r = slot - 17 * q; if (r >= 12) return;
    const int bi = 12 * q + r; const bool isw1 = bi < 32768; const int b2 = isw1 ? bi : bi - 32768;
    const int e = isw1 ? (b2 >> 10) : (b2 >> 9), kb = isw1 ? ((b2 >> 6) & 15) : ((b2 >> 5) & 15), nb = isw1 ? (b2 & 63) : (b2 & 31);
    bf16* WT = (bf16*)(ws + (isw1 ? WS_W1 : WS_W2)) + ((size_t)e * (isw1 ? 2048 : 1024) + 32 * nb) * 1024 + 64 * kb;
#pragma unroll
    for (int i = 0; i < 8; ++i) { LAS float* d = scr + (8 * i + (lane >> 3)) * 33 + 4 * (lane & 7); d[0] = v[i].x; d[1] = v[i].y; d[2] = v[i].z; d[3] = v[i].w; }
    LDS_WAIT(); asm volatile("" ::: "memory");
    const int c = lane & 7;
#pragma unroll
    for (int j = 0; j < 4; ++j) { const int n = (lane >> 3) + 8 * j; const LAS float* s = scr + (8 * c) * 33 + n;
        v4u o; o.x = cvt_pk_bf16(s[0 * 33], s[1 * 33]); o.y = cvt_pk_bf16(s[2 * 33], s[3 * 33]); o.z = cvt_pk_bf16(s[4 * 33], s[5 * 33]); o.w = cvt_pk_bf16(s[6 * 33], s[7 * 33]);
        *(GAS v4u*)(WT + (size_t)n * 1024 + 8 * c) = o; }
    LDS_WAIT(); asm volatile("" ::: "memory");
}
__device__ __forceinline__ void rms_row_to_bf16(int lane, const float* xrow, const float* g, bf16* orow) {
    const GAS f32x4* xr = (const GAS f32x4*)xrow + lane; const GAS f32x4* gr = (const GAS f32x4*)g + lane;
    f32x4 v[4]; float s = 0.f;
#pragma unroll
    for (int j = 0; j < 4; ++j) { v[j] = xr[64 * j]; s += (v[j].x * v[j].x + v[j].y * v[j].y) + (v[j].z * v[j].z + v[j].w * v[j].w); }
    const float r = 1.f / sqrtf(wave_sum64(s) * (1.f / 1024.f) + 1e-5f);
    GAS unsigned long long* o8 = (GAS unsigned long long*)orow + lane;
#pragma unroll
    for (int j = 0; j < 4; ++j) { const f32x4 gg = gr[64 * j]; o8[64 * j] = (unsigned long long)cvt_pk_bf16(v[j].x * r * gg.x, v[j].y * r * gg.y) | ((unsigned long long)cvt_pk_bf16(v[j].z * r * gg.z, v[j].w * r * gg.w) << 32); }
}
__device__ __forceinline__ void rms4_load(f32x4 (&v)[4][4], int lane, const float* x, int m, int st, int mend) {
#pragma unroll
    for (int r = 0; r < 4; ++r) if (m + r * st < mend) { const GAS f32x4* xr = (const GAS f32x4*)(x + (size_t)(m + r * st) * DM) + lane;
#pragma unroll
        for (int j = 0; j < 4; ++j) v[r][j] = __builtin_nontemporal_load((const f32x4*)(xr + 64 * j)); }
}
__device__ __forceinline__ void rms4_finish(const f32x4 (&v)[4][4], int lane, const float* g, bf16* out, int m, int st, int mend) {
    const GAS f32x4* gr = (const GAS f32x4*)g + lane; f32x4 gg[4];
#pragma unroll
    for (int j = 0; j < 4; ++j) gg[j] = gr[64 * j];
#pragma unroll
    for (int r = 0; r < 4; ++r) if (m + r * st < mend) { float s = 0.f;
#pragma unroll
        for (int j = 0; j < 4; ++j) s += (v[r][j].x * v[r][j].x + v[r][j].y * v[r][j].y) + (v[r][j].z * v[r][j].z + v[r][j].w * v[r][j].w);
        const float rr = 1.f / sqrtf(wave_sum64(s) * (1.f / 1024.f) + 1e-5f);
        GAS unsigned long long* o8 = (GAS unsigned long long*)(out + (size_t)(m + r * st) * DM) + lane;
#pragma unroll
        for (int j = 0; j < 4; ++j) o8[64 * j] = (unsigned long long)cvt_pk_bf16(v[r][j].x * rr * gg[j].x, v[r][j].y * rr * gg[j].y) | ((unsigned long long)cvt_pk_bf16(v[r][j].z * rr * gg[j].z, v[r][j].w * rr * gg[j].w) << 32); }
}
struct Args { const float* in[23]; float* out; unsigned char* ws; int ph_lo, ph_hi, li, pad; };
__device__ __forceinline__ void p0_prologue(Frame& F, const Args& A) {
    LAS float* scr = (LAS float*)(F.lds + RING_OFF + F.wave * 16384);
    const int gw = F.vcu * NWAVES + F.wave, NGW = F.G * NWAVES;
    constexpr int I_IN = 16 * (DIN / 32), I_MKV = 16 * 32, I_BR = 8 * 32, I_OUT = 16 * 32;
    constexpr int NITEMS = I_IN + I_MKV + 3 * I_BR + I_OUT;
    f32x4 nv[4][4];
    rms4_load(nv, F.lane, A.in[0], gw, NGW, NTOK);
    for (int it = gw; it < NITEMS; it += NGW) {
        int r = it;
        if (r < I_IN) { p0_transpose_item<true>(A.in[3], 1024, DIN, (bf16*)(F.ws + WS_WIN), 0, scr, r, F.lane); continue; } r -= I_IN;
        if (r < I_MKV) { p0_transpose_item<true>(A.in[9], 1024, 1024, (bf16*)(F.ws + WS_WMEMKV), 0, scr, r, F.lane); continue; } r -= I_MKV;
        if (r < 3 * I_BR) { const int w = r / I_BR; p0_transpose_item<false>(w == 0 ? A.in[12] : (w == 1 ? A.in[13] : A.in[14]), 512, 1024, (bf16*)(F.ws + WS_WBR) + (size_t)w * 1024 * 512, 0, scr, r % I_BR, F.lane); continue; } r -= 3 * I_BR;
        p0_transpose_item<false>(A.in[15], 1024, 1024, (bf16*)(F.ws + WS_WOUT), 0, scr, r, F.lane);
    }
    { bf16_t* WR = (bf16_t*)(F.ws + WS_WRS); const float* wr = A.in[17];
      for (int i = F.vcu * 512 + F.tid; i < 32768; i += F.G * 512) { const int e = i >> 10, k = i & 1023; const float v = wr[k * 32 + e]; const bf16_t h = f2bf(v); WR[i] = h; WR[32768 + i] = f2bf(v - bf2f(h)); } }
    if (gw == 0) { ((float*)(F.ws + WS_GTAB))[F.lane] = A.in[6][F.lane]; ((float*)(F.ws + WS_GTAB))[64 + F.lane] = A.in[7][F.lane]; }
    for (int m = gw; m < NTOK; m += 4 * NGW) {
        f32x4 nw[4][4];
        rms4_load(nw, F.lane, A.in[0], m + 4 * NGW, NGW, NTOK);
        rms4_finish(nv, F.lane, A.in[2], (bf16*)(F.ws + WS_HB), m, NGW, NTOK);
#pragma unroll
        for (int r = 0; r < 4; ++r)
#pragma unroll
            for (int j = 0; j < 4; ++j) nv[r][j] = nw[r][j];
    }
    for (int m = gw; m < NB * MEMLEN; m += NGW) rms_row_to_bf16(F.lane, A.in[1] + (size_t)m * DM, A.in[8], (bf16*)(F.ws + WS_HM) + (size_t)m * DM);
}

struct P1Order {
    pg8::StaticOrder so; int G, c;
    __device__ void init(int G_, int c_) { so.init(NTOK, DIN, G_, 0); G = G_; c = c_; }
    __device__ bool next(int i, pg8::Unit& u) const {
        long L = (long)i * G + c;
        if (L < 1664) { pg8::StaticOrder t = so; t.G = 1; t.c = 0; return t.next((int)L, u); }
        L -= 1664; if (L >= 16) return false;
        u.pm = 64 + (int)(L >> 2); u.pn = 26 + (int)(L & 3); return true;
    }
    __device__ __forceinline__ void a_ready(const pg8::Unit&) const {}
    __device__ __forceinline__ void done(const pg8::Unit&) const {}
};
__device__ __forceinline__ float sigmoid_f(float x) { return __builtin_amdgcn_rcpf(1.f + __expf(-x)); }
struct EpiP1 {
    static constexpr bool PERM = true, AFTER_DRAIN = false;
    unsigned char* ws; const float* b_gate; const float* gtab; float* KMEAN; float* MEMKSS; int atom_on;
    __device__ __forceinline__ void operator()(const pg8::f32x4 (&acc)[2][2][4][2], const pg8::Unit& u, int wr, int wc, int fr, int fq) const {
        using pg8::f32x4; using pg8::u32x4;
        const int pn = u.pn; int type, ldc, cb; size_t off; int row0 = u.pm * 256;
        if (pn == 0) { type = 0; off = WS_RQ; ldc = 256; cb = 0; }
        else if (pn == 1) { type = 1; off = WS_RK; ldc = 256; cb = 0; }
        else if (pn < 4) { type = 0; off = WS_RV; ldc = 512; cb = (pn - 2) * 256; }
        else if (pn < 6) { type = 2; off = WS_RG; ldc = 512; cb = (pn - 4) * 256; }
        else if (pn < 8) { type = 3; off = WS_MQ; ldc = 512; cb = (pn - 6) * 256; }
        else if (pn < 10) { type = 4; off = WS_MK; ldc = 512; cb = (pn - 8) * 256; }
        else if (pn < 12) { type = 0; off = WS_MV; ldc = 512; cb = (pn - 10) * 256; }
        else if (pn < 14) { type = 0; off = WS_CQ; ldc = 512; cb = (pn - 12) * 256; }
        else if (pn < 26) { type = 5; off = WS_GT; ldc = 3072; cb = (pn - 14) * 256; }
        else if (pn < 28) { type = 6; off = WS_MEMK; ldc = 512; cb = (pn - 26) * 256; row0 = (u.pm - 64) * 256; }
        else { type = 0; off = WS_MEMV; ldc = 512; cb = (pn - 28) * 256; row0 = (u.pm - 64) * 256; }
        bf16_t* base = (bf16_t*)(ws + off) + cb + 64 * wc + 8 * fq;
        const int rbase = row0 + 64 * wr + fr;
#define P1_STORE(rowp, bj, v0, v1) do { u32x4 w_; w_.x = cvt_pk_bf16((v0)[0], (v0)[1]); w_.y = cvt_pk_bf16((v0)[2], (v0)[3]); w_.z = cvt_pk_bf16((v1)[0], (v1)[1]); w_.w = cvt_pk_bf16((v1)[2], (v1)[3]); *(u32x4*)((rowp) + 32 * (bj)) = w_; } while (0)
        if (type <= 1) {
            const float sc = type == 1 ? 0.125f : 1.f;
#pragma unroll
            for (int ai = 0; ai < 2; ++ai)
#pragma unroll
                for (int m = 0; m < 4; ++m) { bf16_t* rowp = base + (size_t)(rbase + 128 * ai + 16 * m) * ldc;
#pragma unroll
                    for (int bj = 0; bj < 2; ++bj) { const f32x4 v0 = acc[ai][bj][m][0] * sc, v1 = acc[ai][bj][m][1] * sc; P1_STORE(rowp, bj, v0, v1); } }
        } else if (type == 2) {
#pragma unroll
            for (int ai = 0; ai < 2; ++ai)
#pragma unroll
                for (int m = 0; m < 4; ++m) { bf16_t* rowp = base + (size_t)(rbase + 128 * ai + 16 * m) * ldc;
#pragma unroll
                    for (int bj = 0; bj < 2; ++bj) { f32x4 v0 = acc[ai][bj][m][0], v1 = acc[ai][bj][m][1];
#pragma unroll
                        for (int j = 0; j < 4; ++j) { v0[j] = v0[j] * sigmoid_f(v0[j]); v1[j] = v1[j] * sigmoid_f(v1[j]); }
                        P1_STORE(rowp, bj, v0, v1); } }
        } else if (type == 5) {
            f32x4 bv[2][2];
#pragma unroll
            for (int bj = 0; bj < 2; ++bj)
#pragma unroll
                for (int n = 0; n < 2; ++n) bv[bj][n] = *(const f32x4*)(b_gate + cb + 64 * wc + 32 * bj + 8 * fq + 4 * n);
#pragma unroll
            for (int ai = 0; ai < 2; ++ai)
#pragma unroll
                for (int m = 0; m < 4; ++m) { bf16_t* rowp = base + (size_t)(rbase + 128 * ai + 16 * m) * ldc;
#pragma unroll
                    for (int bj = 0; bj < 2; ++bj) { f32x4 v0 = acc[ai][bj][m][0] + bv[bj][0], v1 = acc[ai][bj][m][1] + bv[bj][1];
#pragma unroll
                        for (int j = 0; j < 4; ++j) { v0[j] = sigmoid_f(v0[j]); v1[j] = sigmoid_f(v1[j]); }
                        P1_STORE(rowp, bj, v0, v1); } }
        } else if (type == 6) {
#pragma unroll
            for (int ai = 0; ai < 2; ++ai)
#pragma unroll
                for (int m = 0; m < 4; ++m) { const int row = rbase + 128 * ai + 16 * m; bf16_t* rowp = base + (size_t)row * ldc; float ss = 0.f;
#pragma unroll
                    for (int bj = 0; bj < 2; ++bj) { const f32x4 v0 = acc[ai][bj][m][0], v1 = acc[ai][bj][m][1];
                        ss += (v0[0] * v0[0] + v0[1] * v0[1]) + (v0[2] * v0[2] + v0[3] * v0[3]) + (v1[0] * v1[0] + v1[1] * v1[1]) + (v1[2] * v1[2] + v1[3] * v1[3]);
                        P1_STORE(rowp, bj, v0, v1); }
                    ss += __shfl_xor(ss, 16); ss += __shfl_xor(ss, 32);
                    if (fq == 0 && atom_on) atomicAdd(MEMKSS + (size_t)row * 4 + (cb >> 7) + (wc >> 1), ss);
                    }
        } else {
            const float* g = gtab + (type == 3 ? 0 : 64);
            f32x4 gv[2][2]; float rr[2][4];
#pragma unroll
            for (int bj = 0; bj < 2; ++bj)
#pragma unroll
                for (int n = 0; n < 2; ++n) gv[bj][n] = *(const f32x4*)(g + 32 * bj + 8 * fq + 4 * n);
#pragma unroll
            for (int ai = 0; ai < 2; ++ai)
#pragma unroll
                for (int m = 0; m < 4; ++m) { bf16_t* rowp = base + (size_t)(rbase + 128 * ai + 16 * m) * ldc; float ss = 0.f;
#pragma unroll
                    for (int bj = 0; bj < 2; ++bj) { const f32x4 v0 = acc[ai][bj][m][0], v1 = acc[ai][bj][m][1];
                        ss += (v0[0] * v0[0] + v0[1] * v0[1]) + (v0[2] * v0[2] + v0[3] * v0[3]) + (v1[0] * v1[0] + v1[1] * v1[1]) + (v1[2] * v1[2] + v1[3] * v1[3]); }
                    ss += __shfl_xor(ss, 16); ss += __shfl_xor(ss, 32);
                    const float r = (1.f / sqrtf(ss * (1.f / 64.f) + 1e-5f)) * (type == 3 ? 0.18033688011112042f : 1.f); rr[ai][m] = r;
#pragma unroll
                    for (int bj = 0; bj < 2; ++bj) { const f32x4 v0 = acc[ai][bj][m][0] * r * gv[bj][0], v1 = acc[ai][bj][m][1] * r * gv[bj][1];
                        P1_STORE(rowp, bj, v0, v1); }
                    asm volatile("" ::: "memory"); }
            if (type == 4 && atom_on) {
                float* km = KMEAN + ((size_t)u.pm * 8 + (cb >> 6) + wc) * 64 + 8 * fq;
#pragma unroll
                for (int bj = 0; bj < 2; ++bj)
#pragma unroll
                    for (int n = 0; n < 2; ++n)
#pragma unroll
                        for (int j = 0; j < 4; ++j) { float s = 0.f;
#pragma unroll
                            for (int ai = 0; ai < 2; ++ai)
#pragma unroll
                                for (int m = 0; m < 4; ++m) s += acc[ai][bj][m][n][j] * rr[ai][m];
                            s += __shfl_xor(s, 1); s += __shfl_xor(s, 2); s += __shfl_xor(s, 4); s += __shfl_xor(s, 8);
                            if (fr == 0) atomicAdd(km + 32 * bj + 4 * n + j, s * gv[bj][n][j] * (1.f / 256.f)); }
            }
        }
#undef P1_STORE
    }
};

constexpr int TB_OFF = LDSCTL_OFF + 1024;
__device__ __forceinline__ unsigned cvt_pk(float lo, float hi) { return cvt_pk_bf16(lo, hi); }

struct P3Order {
    pg8::StaticOrder so; int G, c; const unsigned char* ws;
    __device__ void init(int G_, int c_, const unsigned char* ws_) { so.init(NTOK, 1024, 1, 0); G = G_; c = c_; ws = ws_; }
    __device__ bool next(int i, pg9::Unit& u) const {
        const int tl = (i / 3) * G + c; if (tl >= 256) return false; pg8::Unit t; so.next(tl, t); u.pm = t.pm; u.pn = t.pn; u.aux = i % 3; u.cnt = 256; u.row0 = 0; u.ty = 0; return true; }
    __device__ __forceinline__ void a_ready(const pg9::Unit&, int, int) const {}
    __device__ __forceinline__ void done(const pg9::Unit&, int) const {}
    __device__ __forceinline__ int nt_of(const pg9::Unit&, int nt) const { return nt; }
    __device__ __forceinline__ const char* a_base(const pg9::Unit& u) const { return (const char*)(ws + WS_ORET) + (size_t)u.aux * (WS_OMOBA - WS_ORET) + (size_t)u.pm * 256 * 512 * 2; }
    __device__ __forceinline__ const char* b_base(const pg9::Unit& u) const { return (const char*)(ws + WS_WBR) + (size_t)u.aux * 1024 * 512 * 2 + (size_t)u.pn * 256 * 512 * 2; }
};
struct EpiP3 {
    static constexpr bool PERM = true, CHAIN = true;
    const bf16_t* GT; bf16_t* Y;
    __device__ __forceinline__ bool chain_more(const pg9::Unit& u) const { return u.aux < 2; }
    __device__ __forceinline__ void rescale(pg8::f32x4 (&acc)[2][2][4][2], const pg9::Unit& u, int wr, int wc, int fr, int fq) const {
        const int s = u.aux;
#pragma unroll
        for (int ai = 0; ai < 2; ++ai)
#pragma unroll
            for (int m = 0; m < 4; ++m) { const bf16_t* gp = GT + (size_t)(u.pm * 256 + 128 * ai + 64 * wr + 16 * m + fr) * 3072 + s * 1024 + u.pn * 256 + 32 * wc + 8 * fq;
#pragma unroll
                for (int bj = 0; bj < 2; ++bj) { const pg8::u32x4 ga = *(const pg8::u32x4*)(gp + 128 * bj), gb = *(const pg8::u32x4*)(gp + 1024 + 128 * bj);
#pragma unroll
                    for (int n = 0; n < 2; ++n)
#pragma unroll
                        for (int j = 0; j < 4; ++j) { const int e = 4 * n + j; const unsigned wa = ga[e >> 1], wb = gb[e >> 1];
                            const float fa = __uint_as_float((e & 1) ? (wa & 0xffff0000u) : (wa << 16)), fb = __uint_as_float((e & 1) ? (wb & 0xffff0000u) : (wb << 16));
                            acc[ai][bj][m][n][j] *= fa * __builtin_amdgcn_rcpf(fmaxf(fb, 1e-20f)); } }
                asm volatile("" ::: "memory"); }
    }
    __device__ __forceinline__ void operator()(const pg8::f32x4 (&acc)[2][2][4][2], const pg9::Unit& u, int wr, int wc, int fr, int fq) const {
#pragma unroll
        for (int ai = 0; ai < 2; ++ai)
#pragma unroll
            for (int m = 0; m < 4; ++m) { const size_t row = (size_t)(u.pm * 256 + 128 * ai + 64 * wr + 16 * m + fr); const bf16_t* gp = GT + row * 3072 + 2048 + u.pn * 256 + 32 * wc + 8 * fq; bf16_t* yp = Y + row * 1024 + u.pn * 256 + 32 * wc + 8 * fq;
#pragma unroll
                for (int bj = 0; bj < 2; ++bj) { const pg8::u32x4 ga = *(const pg8::u32x4*)(gp + 128 * bj); float v[8];
#pragma unroll
                    for (int n = 0; n < 2; ++n)
#pragma unroll
                        for (int j = 0; j < 4; ++j) { const int e = 4 * n + j; const unsigned wa = ga[e >> 1]; v[e] = acc[ai][bj][m][n][j] * __uint_as_float((e & 1) ? (wa & 0xffff0000u) : (wa << 16)); }
                    pg8::u32x4 w; w.x = cvt_pk(v[0], v[1]); w.y = cvt_pk(v[2], v[3]); w.z = cvt_pk(v[4], v[5]); w.w = cvt_pk(v[6], v[7]); *(pg8::u32x4*)(yp + 128 * bj) = w; }
                asm volatile("" ::: "memory"); }
    }
};
struct P4Order {
    pg8::StaticOrder so; int G, c; const unsigned char* ws;
    __device__ void init(int G_, int c_, const unsigned char* ws_) { so.init(NTOK, 1024, 1, 0); G = G_; c = c_; ws = ws_; }
    __device__ bool next(int i, pg9::Unit& u) const { const int tl = i * G + c; if (tl >= 256) return false; pg8::Unit t; so.next(tl, t); u.pm = t.pm; u.pn = t.pn; u.aux = 0; u.cnt = 256; u.row0 = 0; u.ty = 0; return true; }
    __device__ __forceinline__ void a_ready(const pg9::Unit&, int, int) const {}
    __device__ __forceinline__ void done(const pg9::Unit&, int) const {}
    __device__ __forceinline__ int nt_of(const pg9::Unit&, int nt) const { return nt; }
    __device__ __forceinline__ const char* a_base(const pg9::Unit& u) const { return (const char*)(ws + WS_Y) + (size_t)u.pm * 256 * 1024 * 2; }
    __device__ __forceinline__ const char* b_base(const pg9::Unit& u) const { return (const char*)(ws + WS_WOUT) + (size_t)u.pn * 256 * 1024 * 2; }
};
struct EpiP4 {
    static constexpr bool PERM = false, CHAIN = false;
    const float* x; float* out;
    __device__ __forceinline__ void operator()(const pg8::f32x4 (&acc)[2][2][4][2], const pg9::Unit& u, int wr, int wc, int fr, int fq) const {
#pragma unroll
        for (int ai = 0; ai < 2; ++ai)
#pragma unroll
            for (int m = 0; m < 4; ++m) { const size_t off = (size_t)(u.pm * 256 + 128 * ai + 64 * wr + 16 * m + fr) * 1024 + u.pn * 256 + 32 * wc + 4 * fq;
#pragma unroll
                for (int bj = 0; bj < 2; ++bj)
#pragma unroll
                    for (int n = 0; n < 2; ++n) { const pg8::f32x4 xv = *(const pg8::f32x4*)(x + off + 128 * bj + 16 * n); *(pg8::f32x4*)(out + off + 128 * bj + 16 * n) = xv + acc[ai][bj][m][n]; }
                if (m & 1) asm volatile("" ::: "memory"); }
    }
};
__device__ __forceinline__ float wave_max64(float v) {
#pragma unroll
    for (int o = 1; o < 64; o <<= 1) v = fmaxf(v, __shfl_xor(v, o));
    return v;
}
__device__ __forceinline__ void p5_router(Frame& F, const float* X1, const float* g_ffn, const float* w_router, const float* b_router, int* COUNTS, int* LISTS) {
    bf16_t* XT = (bf16_t*)(F.ws + WS_XT); int* TOPE = (int*)(F.ws + WS_TOPE); float* TOPW = (float*)(F.ws + WS_TOPW);
    const int lane = F.lane, e = lane & 31, tid = F.tid;
    LAS float* wsh = (LAS float*)(F.lds);
    LAS float* xs = (LAS float*)(F.lds + 36864) + F.wave * 2176;
    for (int v = F.vcu; v < NTOK / 64; v += F.G) {
        const int tw = v * 64 + F.wave * 8;
        f32x4 xr[2][4][4];
#pragma unroll
        for (int g = 0; g < 2; ++g)
#pragma unroll
            for (int q = 0; q < 4; ++q) { const float* xp = X1 + (size_t)(tw + 4 * g + q) * 1024;
#pragma unroll
                for (int j = 0; j < 4; ++j) xr[g][q][j] = *(const f32x4*)(xp + 4 * lane + 256 * j); }
        f32x4 gg[4];
#pragma unroll
        for (int j = 0; j < 4; ++j) gg[j] = *(const f32x4*)(g_ffn + 4 * lane + 256 * j);
#pragma unroll
        for (int g = 0; g < 2; ++g) { float s4[4];
#pragma unroll
            for (int q = 0; q < 4; ++q) { s4[q] = 0.f;
#pragma unroll
                for (int j = 0; j < 4; ++j) { const f32x4 x = xr[g][q][j]; s4[q] += (x.x * x.x + x.y * x.y) + (x.z * x.z + x.w * x.w); } }
#pragma unroll
            for (int o_ = 1; o_ < 64; o_ <<= 1) {
#pragma unroll
                for (int q = 0; q < 4; ++q) s4[q] += __shfl_xor(s4[q], o_); }
#pragma unroll
            for (int q = 0; q < 4; ++q) { const int t = tw + 4 * g + q; const float r = 1.f / sqrtf(s4[q] * (1.f / 1024.f) + 1e-5f);
#pragma unroll
                for (int j = 0; j < 4; ++j) { const f32x4 xn = xr[g][q][j] * r * gg[j]; xr[g][q][j] = xn;
                    uint2 w; w.x = cvt_pk(xn.x, xn.y); w.y = cvt_pk(xn.z, xn.w); *(uint2*)(XT + (size_t)t * 1024 + 4 * lane + 256 * j) = w; } } }
        pg8::f32x4 dacc[2] = {{0.f, 0.f, 0.f, 0.f}, {0.f, 0.f, 0.f, 0.f}};
        LAS bf16_t* wq = (LAS bf16_t*)wsh; LAS bf16_t* xq = (LAS bf16_t*)xs;
        const bf16_t* WR = (const bf16_t*)(F.ws + WS_WRS);
        const int fm = lane & 15, fk = lane >> 4;
#pragma unroll
        for (int qtr = 0; qtr < 4; ++qtr) {
            __syncthreads();
#pragma unroll
            for (int i = 0; i < 4; ++i) { const int ci = tid + 512 * i, hl = ci >> 10, ee = (ci >> 5) & 31, c = ci & 31;
                *(LAS v4u*)(wq + (hl * 32 + ee) * 264 + 8 * c) = *(const v4u*)(WR + (size_t)hl * 32768 + ee * 1024 + 256 * qtr + 8 * c); }
#pragma unroll
            for (int g = 0; g < 2; ++g)
#pragma unroll
                for (int q = 0; q < 4; ++q) { const f32x4 x = xr[g][q][qtr];
                    const unsigned h0 = cvt_pk(x.x, x.y), h1 = cvt_pk(x.z, x.w);
                    const unsigned l0 = cvt_pk(x.x - __uint_as_float(h0 << 16), x.y - __uint_as_float(h0 & 0xffff0000u)), l1 = cvt_pk(x.z - __uint_as_float(h1 << 16), x.w - __uint_as_float(h1 & 0xffff0000u));
                    typedef unsigned u32x2v __attribute__((ext_vector_type(2)));
                    const u32x2v hv = {h0, h1}, lv = {l0, l1};
                    *(LAS u32x2v*)(xq + (4 * g + q) * 264 + 4 * lane) = hv; *(LAS u32x2v*)(xq + (8 + 4 * g + q) * 264 + 4 * lane) = lv; }
            __syncthreads();
#pragma unroll
            for (int ks = 0; ks < 8; ++ks) {
                const pg8::bf16x8 bh = *(const LAS pg8::bf16x8*)(xq + (fm & 7) * 264 + 32 * ks + 8 * fk), bl = *(const LAS pg8::bf16x8*)(xq + (8 + (fm & 7)) * 264 + 32 * ks + 8 * fk);
#pragma unroll
                for (int et = 0; et < 2; ++et) {
                    const pg8::bf16x8 ah = *(const LAS pg8::bf16x8*)(wq + (16 * et + fm) * 264 + 32 * ks + 8 * fk), al = *(const LAS pg8::bf16x8*)(wq + (32 + 16 * et + fm) * 264 + 32 * ks + 8 * fk);
                    dacc[et] = __builtin_amdgcn_mfma_f32_16x16x32_bf16(ah, bh, dacc[et], 0, 0, 0);
                    dacc[et] = __builtin_amdgcn_mfma_f32_16x16x32_bf16(ah, bl, dacc[et], 0, 0, 0);
                    dacc[et] = __builtin_amdgcn_mfma_f32_16x16x32_bf16(al, bh, dacc[et], 0, 0, 0); } }
            asm volatile("s_waitcnt lgkmcnt(0)" ::: "memory");
        }
        float acc[2][4];
        { LAS float* lg = (LAS float*)xq;
          if (fm < 8) {
#pragma unroll
              for (int et = 0; et < 2; ++et)
#pragma unroll
                  for (int r = 0; r < 4; ++r) lg[fm * 33 + 16 * et + 4 * fk + r] = dacc[et][r]; }
          asm volatile("s_waitcnt lgkmcnt(0)" ::: "memory");
#pragma unroll
          for (int t8 = 0; t8 < 8; ++t8) acc[t8 >> 2][t8 & 3] = lg[t8 * 33 + e];
          asm volatile("s_waitcnt lgkmcnt(0)" ::: "memory"); }
        volatile LAS int* lcnt = (volatile LAS int*)(F.lds + TB_OFF);
        __syncthreads();
        if (tid < 32) lcnt[tid] = 0;
        __syncthreads();
        const float bias = b_router[e];
        int my_e[2][4], my_r[2][4];
#pragma unroll
        for (int g = 0; g < 2; ++g)
#pragma unroll
            for (int q = 0; q < 4; ++q) { const int t = tw + 4 * g + q; float lg = acc[g][q] + bias; if (lane >= 32) lg = -INFINITY;
                float tv[4]; int te[4];
#pragma unroll
                for (int k = 0; k < 4; ++k) { const float m = wave_max64(lg); const unsigned long long bal = __ballot(lg == m); const int ee = __ffsll((long long)bal) - 1; tv[k] = m; te[k] = ee; if (lane == ee) lg = -INFINITY; }
                float ex[4], se = 0.f;
#pragma unroll
                for (int k = 0; k < 4; ++k) { ex[k] = __expf(tv[k] - tv[0]); se += ex[k]; }
                int e_l = te[0]; float w_l = ex[0];
#pragma unroll
                for (int k = 1; k < 4; ++k) if (lane == k) { e_l = te[k]; w_l = ex[k]; }
                my_e[g][q] = e_l; my_r[g][q] = 0;
                if (lane < 4) { TOPE[t * 4 + lane] = e_l; TOPW[t * 4 + lane] = w_l / se; my_r[g][q] = __hip_atomic_fetch_add((LAS int*)(F.lds + TB_OFF) + e_l, 1, __ATOMIC_RELAXED, __HIP_MEMORY_SCOPE_WORKGROUP); } }
        __syncthreads();
        if (tid < 32) { int t2 = tid; asm volatile("" : "+v"(t2)); const int c = lcnt[t2]; lcnt[32 + t2] = c ? atomicAdd(&COUNTS[t2], c) : 0; }
        __syncthreads();
#pragma unroll
        for (int g = 0; g < 2; ++g)
#pragma unroll
            for (int q = 0; q < 4; ++q) if (lane < 4) { const int t = tw + 4 * g + q; LISTS[(size_t)my_e[g][q] * 16384 + lcnt[32 + my_e[g][q]] + my_r[g][q]] = t * 4 + lane; }
    }
}
__device__ __forceinline__ void moe_tables(Frame& F) {
    volatile LAS int* TB = (volatile LAS int*)(F.lds + TB_OFF);
    if (F.tid < 64) {
        const int* COUNTS = (const int*)F.ctl + CW_COUNTS; const int ln = F.tid;
        const int c = ln < 32 ? __hip_atomic_load(COUNTS + ln, __ATOMIC_RELAXED, __HIP_MEMORY_SCOPE_AGENT) : 0;
        int inc = (c + 255) >> 8;
#pragma unroll
        for (int o = 1; o < 32; o <<= 1) { const int v = __shfl_up(inc, o); if (ln >= o) inc += v; }
        if (ln < 32) { TB[ln] = inc - ((c + 255) >> 8); TB[33 + ln] = c; }
        if (ln == 31) TB[32] = inc;
    }
    __syncthreads();
}
template <int NPN_LOG2, size_t WOFF, int NROWS_B, int ASHIFT, size_t AOFF> struct MoeOrder {
    int perx, xcd, l; const unsigned char* ws; const LAS int* TB; const int* LISTS;
    __device__ void init(int G_, int vcu_, const unsigned char* ws_, const LAS int* TB_) { perx = G_ / 8; xcd = vcu_ / perx; l = vcu_ % perx; ws = ws_; TB = TB_; LISTS = (const int*)(ws_ + WS_LISTS); }
    __device__ bool next(int i, pg9::Unit& u) const {
        const int uidx = i * perx + l; const int mt = TB[4 * xcd] + (uidx >> NPN_LOG2); if (mt >= TB[4 * xcd + 4]) return false;
        int e = 4 * xcd;
#pragma unroll
        for (int k = 1; k < 4; ++k) if (TB[4 * xcd + k] <= mt) e = 4 * xcd + k;
        u.aux = e; u.pm = mt - TB[e]; u.pn = uidx & ((1 << NPN_LOG2) - 1); u.cnt = TB[33 + e] - u.pm * 256; u.row0 = mt * 256; u.ty = 0; return true;
    }
    __device__ __forceinline__ void a_ready(const pg9::Unit&, int, int) const {}
    __device__ __forceinline__ void done(const pg9::Unit&, int) const {}
    __device__ __forceinline__ int nt_of(const pg9::Unit&, int nt) const { return nt; }
    __device__ __forceinline__ const char* a_base(const pg9::Unit& u) const { return (const char*)(ws + AOFF) + (ASHIFT == 0 ? (size_t)u.row0 * 2048 : (size_t)0); }
    __device__ __forceinline__ const char* b_base(const pg9::Unit& u) const { return (const char*)(ws + WOFF) + ((size_t)u.aux * NROWS_B + (size_t)u.pn * 256) * 1024 * 2; }
    __device__ __forceinline__ unsigned a_row_off(const pg9::Unit& u, int r) const { const int rr = r < u.cnt ? r : u.cnt - 1; const int id = LISTS[(size_t)u.aux * 16384 + u.pm * 256 + rr]; return (unsigned)(id >> ASHIFT) * 2048u; }
};
constexpr bool MOE2_SPLIT = false;
constexpr size_t WS_PB = WS_GT;
__device__ __forceinline__ void moe2_split(int ntiles, int perx, int& base, int& L, int& spl) {
    const int U = 4 * ntiles, R = U / perx; base = R * perx; L = U - base;
    spl = (!MOE2_SPLIT || L == 0 || (perx & 3)) ? 1 : (4 * L <= perx ? 4 : (2 * L <= perx ? 2 : 1));
}
__device__ __forceinline__ int pb_row(int x, int s, int jt) { return ((x * 3 + (s - 1)) * 4 + jt) * 256; }
struct Moe2SplitOrder {
    int perx, xcd, l, T0, R, base, L, spl; const unsigned char* ws; const LAS int* TB;
    __device__ void init(int G_, int vcu_, const unsigned char* ws_, const LAS int* TB_) { perx = G_ / 8; xcd = vcu_ / perx; l = vcu_ % perx; ws = ws_; TB = TB_; T0 = TB[4 * xcd]; moe2_split(TB[4 * xcd + 4] - T0, perx, base, L, spl); R = base / perx;
        T0 = __builtin_amdgcn_readfirstlane(T0); R = __builtin_amdgcn_readfirstlane(R); base = __builtin_amdgcn_readfirstlane(base); L = __builtin_amdgcn_readfirstlane(L); spl = __builtin_amdgcn_readfirstlane(spl); }
    __device__ bool next(int i, pg9::Unit& u) const {
        int uidx, s = 0, sp = 1;
        if (i < R) uidx = i * perx + l;
        else if (i == R && l < L * spl) { s = (l >= L) + (l >= 2 * L) + (l >= 3 * L); uidx = base + l - s * L; sp = spl; }
        else return false;
        const int mt = T0 + (uidx >> 2);
        int e = 4 * xcd;
#pragma unroll
        for (int k = 1; k < 4; ++k) if (TB[4 * xcd + k] <= mt) e = 4 * xcd + k;
        u.aux = e; u.pm = mt - TB[e]; u.pn = uidx & 3; u.cnt = TB[33 + e] - u.pm * 256; u.row0 = mt * 256; u.ty = s | (sp << 4) | (((uidx >> 2) - (base >> 2)) << 8);
        u.aux = __builtin_amdgcn_readfirstlane(u.aux); u.pm = __builtin_amdgcn_readfirstlane(u.pm); u.pn = __builtin_amdgcn_readfirstlane(u.pn); u.cnt = __builtin_amdgcn_readfirstlane(u.cnt);
        u.row0 = __builtin_amdgcn_readfirstlane(u.row0); u.ty = __builtin_amdgcn_readfirstlane(u.ty); return true;
    }
    __device__ __forceinline__ void a_ready(const pg9::Unit&, int, int) const {}
    __device__ __forceinline__ void done(const pg9::Unit&, int) const {}
    __device__ __forceinline__ int nt_of(const pg9::Unit& u, int nt) const { return nt >> (((u.ty >> 4) & 15) >> 1); }
    __device__ __forceinline__ size_t koff(const pg9::Unit& u) const { return (size_t)((u.ty & 15) * (2048 >> (((u.ty >> 4) & 15) >> 1))); }
    __device__ __forceinline__ const char* a_base(const pg9::Unit& u) const { return (const char*)(ws + WS_ACT) + (size_t)u.row0 * 2048 + koff(u); }
    __device__ __forceinline__ const char* b_base(const pg9::Unit& u) const { return (const char*)(ws + WS_W2) + ((size_t)u.aux * 1024 + (size_t)u.pn * 256) * 1024 * 2 + koff(u); }
};
struct EpiMoe1 {
    static constexpr bool PERM = true, CHAIN = false;
    const int* LISTS; const float* b1; bf16_t* ACT; int* SLOT;
    __device__ __forceinline__ void operator()(const pg8::f32x4 (&acc)[2][2][4][2], const pg9::Unit& u, int wr, int wc, int fr, int fq) const {
        const int e = u.aux; const int c0 = u.pn * 256 + 32 * wc + 8 * fq;
        pg8::f32x4 bv[2][2];
#pragma unroll
        for (int bj = 0; bj < 2; ++bj)
#pragma unroll
            for (int n = 0; n < 2; ++n) bv[bj][n] = *(const pg8::f32x4*)(b1 + (size_t)e * 2048 + c0 + 128 * bj + 4 * n);
        const bool slotw = (u.pn == 0) && (wc == 0) && (fq == 0);
#pragma unroll
        for (int ai = 0; ai < 2; ++ai)
#pragma unroll
            for (int m = 0; m < 4; ++m) { const int r = 128 * ai + 64 * wr + 16 * m + fr; const bool ok = r < u.cnt;
                if (slotw && ok) SLOT[LISTS[(size_t)e * 16384 + u.pm * 256 + r]] = u.row0 + r;
#pragma unroll
                for (int bj = 0; bj < 2; ++bj) { float a[4];
#pragma unroll
                    for (int n = 0; n < 2; ++n)
#pragma unroll
                        for (int p = 0; p < 2; ++p) { const float gl = fminf(acc[ai][bj][m][n][2 * p] + bv[bj][n][2 * p], 7.0f); const float li = fminf(fmaxf(acc[ai][bj][m][n][2 * p + 1] + bv[bj][n][2 * p + 1], -7.0f), 7.0f);
                            a[2 * n + p] = gl * sigmoid_f(1.702f * gl) * (li + 1.f); }
                    if (ok) { uint2 w; w.x = cvt_pk(a[0], a[1]); w.y = cvt_pk(a[2], a[3]); *(uint2*)(ACT + (size_t)(u.row0 + r) * 1024 + ((c0 + 128 * bj) >> 1)) = w; } }
                asm volatile("" ::: "memory"); }
    }
};
struct EpiMoe2 {
    static constexpr bool PERM = true, CHAIN = false;
    const float* b2; unsigned char* ws;
    __device__ __forceinline__ void operator()(const pg8::f32x4 (&acc)[2][2][4][2], const pg9::Unit& u, int wr, int wc, int fr, int fq) const {
        asm volatile("" : "+v"(fr));
        const int e = u.aux; const int c0 = u.pn * 256 + 32 * wc + 8 * fq; const int sl = u.ty & 15;
        pg8::f32x4 bv[2][2];
#pragma unroll
        for (int bj = 0; bj < 2; ++bj)
#pragma unroll
            for (int n = 0; n < 2; ++n) bv[bj][n] = sl ? (pg8::f32x4){0.f, 0.f, 0.f, 0.f} : *(const pg8::f32x4*)(b2 + (size_t)e * 1024 + c0 + 128 * bj + 4 * n);
        bf16_t* D = (bf16_t*)(ws + (sl ? WS_PB : WS_YS)) + (size_t)(sl ? pb_row(e >> 2, sl, u.ty >> 8) : u.row0) * 1024;
#pragma unroll
        for (int ai = 0; ai < 2; ++ai)
#pragma unroll
            for (int m = 0; m < 4; ++m) { const int r = 128 * ai + 64 * wr + 16 * m + fr; const bool ok = r < u.cnt;
#pragma unroll
                for (int bj = 0; bj < 2; ++bj) { const pg8::f32x4 v0 = acc[ai][bj][m][0] + bv[bj][0], v1 = acc[ai][bj][m][1] + bv[bj][1];
                    if (ok) { pg8::u32x4 w; w.x = cvt_pk(v0[0], v0[1]); w.y = cvt_pk(v0[2], v0[3]); w.z = cvt_pk(v1[0], v1[1]); w.w = cvt_pk(v1[2], v1[3]); *(pg8::u32x4*)(D + (size_t)r * 1024 + c0 + 128 * bj) = w; } }
                asm volatile("" ::: "memory"); }
    }
};

__device__ __forceinline__ void p8_combine(Frame& F, const float* src, float* out) {
    const bf16_t* YS = (const bf16_t*)(F.ws + WS_YS); const bf16_t* PB = (const bf16_t*)(F.ws + WS_PB); const float* TOPW = (const float*)(F.ws + WS_TOPW); const int* SLOT = (const int*)(F.ws + WS_SLOT);
    const int gw = F.vcu * NWAVES + F.wave, NGW = F.G * NWAVES, lane = F.lane;
    volatile LAS int* TB = (volatile LAS int*)(F.lds + TB_OFF);
    if (MOE2_SPLIT) moe_tables(F);
    if (MOE2_SPLIT && F.tid < 8) { int base, L, spl; moe2_split(TB[4 * F.tid + 4] - TB[4 * F.tid], F.G / 8, base, L, spl); TB[72 + 2 * F.tid] = base; TB[73 + 2 * F.tid] = spl; }
    __syncthreads();
    for (int t = gw; t < NTOK; t += NGW) {
        const f32x4 w4 = *(const f32x4*)(TOPW + (size_t)t * 4); const int4 s4 = *(const int4*)(SLOT + (size_t)t * 4); const int sl[4] = {s4.x, s4.y, s4.z, s4.w};
        int spk[4], ltk[4], xk[4], bk[4];
#pragma unroll
        for (int k = 0; k < 4; ++k) { if (!MOE2_SPLIT) { xk[k] = ltk[k] = bk[k] = 0; spk[k] = 1; continue; } const int mt = sl[k] >> 8; int x = 0;
#pragma unroll
            for (int q = 1; q < 8; ++q) if (TB[4 * q] <= mt) x = q;
            xk[k] = x; ltk[k] = mt - TB[4 * x]; bk[k] = TB[72 + 2 * x]; spk[k] = TB[73 + 2 * x]; }
        const bool anysplit = (spk[0] | spk[1] | spk[2] | spk[3]) > 1;
#pragma unroll
        for (int j = 0; j < 2; ++j) {
            const int c = 8 * lane + 512 * j; f32x4 a0 = *(const f32x4*)(src + (size_t)t * 1024 + c), a1 = *(const f32x4*)(src + (size_t)t * 1024 + c + 4);
#pragma unroll
            for (int k = 0; k < 4; ++k) { const v4u y = __builtin_nontemporal_load((const v4u*)(YS + (size_t)sl[k] * 1024 + c)); const float wk = w4[k];
                a0.x += wk * __uint_as_float(y.x << 16); a0.y += wk * __uint_as_float(y.x & 0xffff0000u); a0.z += wk * __uint_as_float(y.y << 16); a0.w += wk * __uint_as_float(y.y & 0xffff0000u);
                a1.x += wk * __uint_as_float(y.z << 16); a1.y += wk * __uint_as_float(y.z & 0xffff0000u); a1.z += wk * __uint_as_float(y.w << 16); a1.w += wk * __uint_as_float(y.w & 0xffff0000u); }
            if (anysplit) {
                const int pn = (lane >> 5) + 2 * j;
#pragma unroll
                for (int k = 0; k < 4; ++k) if (spk[k] > 1 && 4 * ltk[k] + pn >= bk[k]) { const float wk = w4[k]; const int jt = ltk[k] - (bk[k] >> 2);
                    for (int s = 1; s < spk[k]; ++s) { const v4u y = *(const v4u*)(PB + (size_t)(pb_row(xk[k], s, jt) + (sl[k] & 255)) * 1024 + c);
                        a0.x += wk * __uint_as_float(y.x << 16); a0.y += wk * __uint_as_float(y.x & 0xffff0000u); a0.z += wk * __uint_as_float(y.y << 16); a0.w += wk * __uint_as_float(y.y & 0xffff0000u);
                        a1.x += wk * __uint_as_float(y.z << 16); a1.y += wk * __uint_as_float(y.z & 0xffff0000u); a1.z += wk * __uint_as_float(y.w << 16); a1.w += wk * __uint_as_float(y.w & 0xffff0000u); } }
            }
            __builtin_nontemporal_store(a0, (f32x4*)(out + (size_t)t * 1024 + c)); __builtin_nontemporal_store(a1, (f32x4*)(out + (size_t)t * 1024 + c + 4)); }
    }
}
namespace att {
typedef float f32x16 __attribute__((ext_vector_type(16)));
typedef float f32x8 __attribute__((ext_vector_type(8)));
using pg8::f32x2;
typedef short s16x4 __attribute__((ext_vector_type(4)));
typedef short v4i16_t __attribute__((ext_vector_type(4)));
using pg8::bf16x8;
constexpr float LOG2E = 1.4426950408889634f;
__device__ __forceinline__ constexpr int crow(int r, int hi) { return (r & 3) + 8 * (r >> 2) + 4 * hi; }
template <int D> __device__ __forceinline__ int kswz(int row) { return D == 64 ? ((row >> 1) & 7) : (row & 15); }
template <int D> __device__ __forceinline__ int vswz(int row) { return D == 64 ? (((row >> 1) & 1) << 2) : ((row & 3) << 2); }
__device__ __forceinline__ s16x4 vtr(const LAS unsigned char* p) { return __builtin_bit_cast(s16x4, __builtin_amdgcn_ds_read_tr16_b64_v4i16((LAS v4i16_t*)p)); }
__device__ __forceinline__ bf16x8 pack8(const f32x16& x, int s) {
    typedef unsigned u32x4_t __attribute__((ext_vector_type(4))); u32x4_t p;
    p[0] = cvt_pk_bf16(x[8 * s + 0], x[8 * s + 1]); p[1] = cvt_pk_bf16(x[8 * s + 2], x[8 * s + 3]); p[2] = cvt_pk_bf16(x[8 * s + 4], x[8 * s + 5]); p[3] = cvt_pk_bf16(x[8 * s + 6], x[8 * s + 7]);
    return __builtin_bit_cast(bf16x8, p);
}
__device__ __forceinline__ float bfl(unsigned w) { return __uint_as_float(w << 16); }
__device__ __forceinline__ float bfh(unsigned w) { return __uint_as_float(w & 0xffff0000u); }

template <bool MOBA, int TK> __device__ __forceinline__ int tile_kbase(int tt, int qb) { constexpr int TPB = 256 / TK; if (!MOBA) return TK * tt; if (tt < TPB) return qb * 256 + TK * tt; const int u = tt - TPB; return (u / TPB) * 256 + TK * (u % TPB); }
template <int D, bool MOBA, int NSUB>
__device__ __forceinline__ void attn_unit(Frame& F, const int b, const int h, const int qb,
                                          const bf16_t* Qg, const bf16_t* Kg, const bf16_t* Vg, bf16_t* Og, const int ld,
                                          const float* KMEAN, const float* KSS, const float* gq, const float* gk) {
    constexpr int NKH = 2  , TK = 64 * NSUB  , KB = TK * D * 2, NKS = D / 16, NDH = D / 32, CPR = D / 8  , NST = (TK * CPR) / 512  ;
    int tid = F.tid, lane = F.lane; asm volatile("" : "+v"(tid), "+v"(lane));
    const int wave = F.wave, r32 = lane & 31, hi = lane >> 5;
    LAS unsigned char* lds = F.lds;
    const size_t qrow = (size_t)b * SEQ + qb * 256 + wave * 32 + r32;
    bf16x8 qr[NKS];
#pragma unroll
    for (int ks = 0; ks < NKS; ++ks) qr[ks] = *(const bf16x8*)(Qg + qrow * ld + h * D + 16 * ks + 8 * hi);
    unsigned selmask = 0u;
    if constexpr (MOBA) {
        if (qb > 0) {
            LAS float* kml = (LAS float*)(lds + 4 * KB);
            if (tid < qb * 16) *(LAS f32x4*)(kml + 4 * tid) = *(const f32x4*)(KMEAN + (((size_t)b * 16 + (tid >> 4)) * 8 + h) * 64 + 4 * (tid & 15));
            __syncthreads();
            float qf[NKS * 8];
#pragma unroll
            for (int ks = 0; ks < NKS; ++ks) { const pg8::u32x4 w = __builtin_bit_cast(pg8::u32x4, qr[ks]);
#pragma unroll
                for (int j = 0; j < 4; ++j) { qf[ks * 8 + 2 * j] = bfl(w[j]); qf[ks * 8 + 2 * j + 1] = bfh(w[j]); } }
            float v0 = -INFINITY, v1 = -INFINITY, v2 = -INFINITY; int i0 = -1, i1 = -1, i2 = -1;
#pragma unroll 1
            for (int j = 0; j < qb; ++j) { const LAS float* km = kml + 64 * j + 8 * hi; float s = 0.f;
#pragma unroll
                for (int ks = 0; ks < NKS; ++ks) { const f32x4 k0 = *(const LAS f32x4*)(km + 16 * ks), k1 = *(const LAS f32x4*)(km + 16 * ks + 4);
                    s += qf[ks * 8 + 0] * k0[0] + qf[ks * 8 + 1] * k0[1] + qf[ks * 8 + 2] * k0[2] + qf[ks * 8 + 3] * k0[3] + qf[ks * 8 + 4] * k1[0] + qf[ks * 8 + 5] * k1[1] + qf[ks * 8 + 6] * k1[2] + qf[ks * 8 + 7] * k1[3]; }
                s += __shfl_xor(s, 32);
                const bool c0 = s > v0, c1 = s > v1, c2 = s > v2;
                v2 = c1 ? v1 : (c2 ? s : v2); i2 = c1 ? i1 : (c2 ? j : i2);
                v1 = c0 ? v0 : (c1 ? s : v1); i1 = c0 ? i0 : (c1 ? j : i1);
                v0 = c0 ? s : v0; i0 = c0 ? j : i0; }
            selmask = (i0 >= 0 ? (1u << i0) : 0u) | (i1 >= 0 ? (1u << i1) : 0u) | (i2 >= 0 ? (1u << i2) : 0u);
        }
    } else {
        float qf[NKS * 8]; float ss = 0.f;
#pragma unroll
        for (int ks = 0; ks < NKS; ++ks) { const pg8::u32x4 w = __builtin_bit_cast(pg8::u32x4, qr[ks]);
#pragma unroll
            for (int j = 0; j < 4; ++j) { qf[ks * 8 + 2 * j] = bfl(w[j]); qf[ks * 8 + 2 * j + 1] = bfh(w[j]); ss += qf[ks * 8 + 2 * j] * qf[ks * 8 + 2 * j] + qf[ks * 8 + 2 * j + 1] * qf[ks * 8 + 2 * j + 1]; } }
        ss += __shfl_xor(ss, 32);
        const float rq = (1.f / sqrtf(ss * (1.f / D) + 1e-5f)) * (0.08838834764831845f * LOG2E);
#pragma unroll
        for (int ks = 0; ks < NKS; ++ks) { const float* g1 = gq + 16 * ks + 8 * hi; const float* g2 = gk + 16 * ks + 8 * hi; pg8::u32x4 w;
#pragma unroll
            for (int j = 0; j < 4; ++j) w[j] = cvt_pk_bf16(qf[ks * 8 + 2 * j] * rq * g1[2 * j] * g2[2 * j], qf[ks * 8 + 2 * j + 1] * rq * g1[2 * j + 1] * g2[2 * j + 1]);
            qr[ks] = __builtin_bit_cast(bf16x8, w); }
    }
    constexpr int TPB = 256 / TK;
    const int NT = MOBA ? TPB * (qb + 1) : TPB;
    const float sl2 = MOBA ? exp2f(-(float)(h + 1)) * LOG2E : 0.f;
    v4u kreg[NST], vreg[NST];
#define ATT_LOAD(tt) do { const int kb_ = tile_kbase<MOBA, TK>(tt, qb); _Pragma("unroll") for (int i_ = 0; i_ < NST; ++i_) { const int ci_ = tid + 512 * i_, row_ = ci_ / CPR, ch_ = ci_ % CPR; \
        const size_t g_ = (size_t)(kb_ + row_) * ld + h * D + 8 * ch_; kreg[i_] = *(const v4u*)(Kg + g_); vreg[i_] = *(const v4u*)(Vg + g_); \
        if (!MOBA) { const float rk_ = 1.f / sqrtf(KSS[(size_t)(kb_ + row_) * 4 + h] * (1.f / D) + 1e-5f); v4u k_ = kreg[i_]; \
            k_.x = cvt_pk_bf16(bfl(k_.x) * rk_, bfh(k_.x) * rk_); k_.y = cvt_pk_bf16(bfl(k_.y) * rk_, bfh(k_.y) * rk_); k_.z = cvt_pk_bf16(bfl(k_.z) * rk_, bfh(k_.z) * rk_); k_.w = cvt_pk_bf16(bfl(k_.w) * rk_, bfh(k_.w) * rk_); kreg[i_] = k_; } } } while (0)
#define ATT_WRITE(buf) do { _Pragma("unroll") for (int i_ = 0; i_ < NST; ++i_) { const int ci_ = tid + 512 * i_, row_ = ci_ / CPR, ch_ = ci_ % CPR; \
        *(LAS v4u*)(lds + (buf) * KB + row_ * (2 * D) + ((ch_ ^ kswz<D>(row_)) << 4)) = kreg[i_]; *(LAS v4u*)(lds + (2 + (buf)) * KB + row_ * (2 * D) + ((ch_ ^ vswz<D>(row_)) << 4)) = vreg[i_]; } } while (0)
    ATT_LOAD(0); ATT_WRITE(0);
    __syncthreads();
    float m = -1e30f, l = 0.f;
    f32x16 o[NDH];
#pragma unroll
    for (int dh = 0; dh < NDH; ++dh)
#pragma unroll
        for (int r = 0; r < 16; ++r) o[dh][r] = 0.f;
    const int qrel = wave * 32 + r32;
    f32x16 cinit[NKH];
#pragma unroll
    for (int kh = 0; kh < NKH; ++kh)
#pragma unroll
        for (int r = 0; r < 16; ++r) cinit[kh][r] = MOBA ? sl2 * (float)(32 * kh + (r & 3) + 8 * (r >> 2)) : 0.f;
    for (int tt = 0; tt < NT; ++tt) {
        int lane_t = lane; asm volatile("" : "+v"(lane_t));
        const int r32 = lane_t & 31, hi = lane_t >> 5, i16 = lane_t & 15, blk = (lane_t >> 4) & 1, tq = i16 >> 2, tp = i16 & 3;
        const int buf = tt & 1;
        if (tt + 1 < NT) ATT_LOAD(tt + 1);
#pragma unroll 1
        for (int sub = 0; sub < NSUB; ++sub) {
        bool act = true; bool lane_sel = true; int pblk = -1;
        if constexpr (MOBA) { if (tt >= TPB) { pblk = (tt - TPB) / TPB; lane_sel = (selmask >> pblk) & 1u; act = __builtin_amdgcn_ballot_w64(lane_sel) != 0ull; }
            else act = (TK * tt + 64 * sub <= wave * 32 + 31); }
        if (act) {
            f32x16 p[NKH];
            const LAS unsigned char* Kb = lds + buf * KB + sub * 64 * (2 * D);
#pragma unroll
            for (int ks = 0; ks < NKS; ++ks) {
#pragma unroll
                for (int kh = 0; kh < NKH; ++kh) { const int row = 32 * kh + r32;
                    const bf16x8 a = *(const LAS bf16x8*)(Kb + row * (2 * D) + (((2 * ks + hi) ^ kswz<D>(row)) << 4));
                    p[kh] = __builtin_amdgcn_mfma_f32_32x32x16_bf16(a, qr[ks], ks == 0 ? cinit[kh] : p[kh], 0, 0, 0); }
            }
            float offl = 0.f;
            if constexpr (MOBA) {
                const int kb = tile_kbase<MOBA, TK>(tt, qb) + 64 * sub; offl = sl2 * (float)(kb - qb * 256 + 4 * hi);
                if (tt < TPB) {
                    const int k0 = TK * tt + 64 * sub + 4 * hi;
#pragma unroll
                    for (int kh = 0; kh < NKH; ++kh)
#pragma unroll
                        for (int r = 0; r < 16; ++r) { const int kv = k0 + 32 * kh + (r & 3) + 8 * (r >> 2); if (kv > qrel) p[kh][r] = -INFINITY; }
                } else if (!lane_sel) {
#pragma unroll
                    for (int kh = 0; kh < NKH; ++kh)
#pragma unroll
                        for (int r = 0; r < 16; ++r) p[kh][r] = -INFINITY;
                }
            }
            float mx = p[0][0];
#pragma unroll
            for (int kh = 0; kh < NKH; ++kh)
#pragma unroll
                for (int r = 0; r < 16; ++r) mx = fmaxf(mx, p[kh][r]);
            mx += offl;
            mx = fmaxf(mx, __shfl_xor(mx, 32));
            const float mnew = fmaxf(m, mx);
            if (__builtin_amdgcn_ballot_w64(mnew > m) != 0ull) { const float alpha = __builtin_amdgcn_exp2f(m - mnew); l *= alpha;
#pragma unroll
                for (int dh = 0; dh < NDH; ++dh)
#pragma unroll
                    for (int r = 0; r < 16; ++r) o[dh][r] *= alpha;
                m = mnew; }
            float ps = 0.f; const float mt = m - offl;
#pragma unroll
            for (int kh = 0; kh < NKH; ++kh)
#pragma unroll
                for (int r = 0; r < 16; ++r) { p[kh][r] = __builtin_amdgcn_exp2f(p[kh][r] - mt); ps += p[kh][r]; }
            l += ps;
            const LAS unsigned char* Vb = lds + (2 + buf) * KB + sub * 64 * (2 * D);
#pragma unroll
            for (int kh = 0; kh < NKH; ++kh)
#pragma unroll
                for (int s = 0; s < 2; ++s) {
                    const bf16x8 pb = pack8(p[kh], s);
#pragma unroll
                    for (int dh = 0; dh < NDH; ++dh) {
                        const int rowA = 32 * kh + 16 * s + 4 * hi + tq, rowB = rowA + 8, chv = 4 * dh + 2 * blk + (tp >> 1);
                        const s16x4 lo = vtr(Vb + rowA * (2 * D) + ((chv ^ vswz<D>(rowA)) << 4) + 8 * (tp & 1));
                        const s16x4 hh = vtr(Vb + rowB * (2 * D) + ((chv ^ vswz<D>(rowB)) << 4) + 8 * (tp & 1));
                        const bf16x8 va = (bf16x8){lo[0], lo[1], lo[2], lo[3], hh[0], hh[1], hh[2], hh[3]};
                        o[dh] = __builtin_amdgcn_mfma_f32_32x32x16_bf16(va, pb, o[dh], 0, 0, 0);
                    }
                }
        }
        }
        if (tt + 1 < NT) ATT_WRITE(buf ^ 1);
        __syncthreads();
    }
    l += __shfl_xor(l, 32);
    const float inv = 1.f / l;
    bf16_t* orow = Og + qrow * ld + h * D;
#pragma unroll
    for (int dh = 0; dh < NDH; ++dh)
#pragma unroll
        for (int g = 0; g < 4; ++g) { uint2 w; w.x = cvt_pk_bf16(o[dh][4 * g] * inv, o[dh][4 * g + 1] * inv); w.y = cvt_pk_bf16(o[dh][4 * g + 2] * inv, o[dh][4 * g + 3] * inv);
            *(uint2*)(orow + 32 * dh + 8 * g + 4 * hi) = w; }
#undef ATT_LOAD
#undef ATT_WRITE
}

__device__ __forceinline__ void mem_attn_group(Frame& F, const int b, const int h, const int qb0, const int NQ,
                                               const bf16_t* Qg, const bf16_t* Kg, const bf16_t* Vg, bf16_t* Og, const float* KSS, const float* gq, const float* gk) {
    constexpr int D = 128, ld = 512, NKH = 2, KB = 64 * D * 2, NKS = D / 16, NDH = D / 32, CPR = D / 8;
    int tid = F.tid, lane = F.lane; asm volatile("" : "+v"(tid), "+v"(lane));
    const int wave = F.wave;
    LAS unsigned char* lds = F.lds;
    bf16x8 qn[NKS];
    { const size_t qrow0 = (size_t)b * SEQ + qb0 * 256 + wave * 32 + (lane & 31);
#pragma unroll
      for (int ks = 0; ks < NKS; ++ks) qn[ks] = *(const bf16x8*)(Qg + qrow0 * ld + h * D + 16 * ks + 8 * (lane >> 5)); }
    {
        v4u kreg[8], vreg[8]; float rks[8];
#pragma unroll
        for (int i = 0; i < 8; ++i) { const int ci = tid + 512 * i, row = ci / CPR, ch = ci % CPR; const size_t g_ = (size_t)row * ld + h * D + 8 * ch; kreg[i] = *(const v4u*)(Kg + g_); vreg[i] = *(const v4u*)(Vg + g_); rks[i] = KSS[(size_t)row * 4 + h]; }
        float gg[8];
        { const int ch = tid % CPR; const f32x4 a0 = *(const f32x4*)(gq + 8 * ch), a1 = *(const f32x4*)(gq + 8 * ch + 4), b0 = *(const f32x4*)(gk + 8 * ch), b1 = *(const f32x4*)(gk + 8 * ch + 4);
          gg[0] = a0.x * b0.x; gg[1] = a0.y * b0.y; gg[2] = a0.z * b0.z; gg[3] = a0.w * b0.w; gg[4] = a1.x * b1.x; gg[5] = a1.y * b1.y; gg[6] = a1.z * b1.z; gg[7] = a1.w * b1.w; }
#pragma unroll
        for (int i = 0; i < 8; ++i) { const int ci = tid + 512 * i, row = ci / CPR, ch = ci % CPR, t = row >> 6, rr = row & 63;
            const float rk = 1.f / sqrtf(rks[i] * (1.f / D) + 1e-5f); v4u k_ = kreg[i];
            k_.x = cvt_pk_bf16(bfl(k_.x) * rk * gg[0], bfh(k_.x) * rk * gg[1]); k_.y = cvt_pk_bf16(bfl(k_.y) * rk * gg[2], bfh(k_.y) * rk * gg[3]); k_.z = cvt_pk_bf16(bfl(k_.z) * rk * gg[4], bfh(k_.z) * rk * gg[5]); k_.w = cvt_pk_bf16(bfl(k_.w) * rk * gg[6], bfh(k_.w) * rk * gg[7]);
            *(LAS v4u*)(lds + t * KB + rr * (2 * D) + ((ch ^ kswz<D>(rr)) << 4)) = k_; *(LAS v4u*)(lds + (4 + t) * KB + rr * (2 * D) + ((ch ^ vswz<D>(rr)) << 4)) = vreg[i]; }
    }
    __syncthreads();
#pragma unroll 1
    for (int qi = 0; qi < NQ; ++qi) {
        int lane_q = lane; asm volatile("" : "+v"(lane_q));
        const int r32 = lane_q & 31, hi = lane_q >> 5, i16 = lane_q & 15, blk = (lane_q >> 4) & 1, tq = i16 >> 2, tp = i16 & 3;
        const size_t qrow = (size_t)b * SEQ + (qb0 + qi) * 256 + wave * 32 + r32;
        bf16x8 qr[NKS];
#pragma unroll
        for (int ks = 0; ks < NKS; ++ks) qr[ks] = qn[ks];
        if (qi + 1 < NQ) {
#pragma unroll
            for (int ks = 0; ks < NKS; ++ks) qn[ks] = *(const bf16x8*)(Qg + (qrow + 256) * ld + h * D + 16 * ks + 8 * hi); }
        {
            float qf[NKS * 8]; float ss = 0.f;
#pragma unroll
            for (int ks = 0; ks < NKS; ++ks) { const pg8::u32x4 w = __builtin_bit_cast(pg8::u32x4, qr[ks]);
#pragma unroll
                for (int j = 0; j < 4; ++j) { qf[ks * 8 + 2 * j] = bfl(w[j]); qf[ks * 8 + 2 * j + 1] = bfh(w[j]); ss += qf[ks * 8 + 2 * j] * qf[ks * 8 + 2 * j] + qf[ks * 8 + 2 * j + 1] * qf[ks * 8 + 2 * j + 1]; } }
            ss += __shfl_xor(ss, 32);
            const float rq = (1.f / sqrtf(ss * (1.f / D) + 1e-5f)) * (0.08838834764831845f * LOG2E);
#pragma unroll
            for (int ks = 0; ks < NKS; ++ks) { pg8::u32x4 w;
#pragma unroll
                for (int j = 0; j < 4; ++j) w[j] = cvt_pk_bf16(qf[ks * 8 + 2 * j] * rq, qf[ks * 8 + 2 * j + 1] * rq);
                qr[ks] = __builtin_bit_cast(bf16x8, w); }
        }
        float m = -1e30f, l = 0.f;
        f32x16 o[NDH];
#pragma unroll
        for (int dh = 0; dh < NDH; ++dh)
#pragma unroll
            for (int r = 0; r < 16; ++r) o[dh][r] = 0.f;
#pragma unroll
        for (int tt = 0; tt < 4; ++tt) {
            const LAS unsigned char* Kb = lds + tt * KB; const LAS unsigned char* Vb = lds + (4 + tt) * KB;
            f32x16 p[NKH];
#pragma unroll
            for (int kh = 0; kh < NKH; ++kh)
#pragma unroll
                for (int r = 0; r < 16; ++r) p[kh][r] = 0.f;
#pragma unroll
            for (int ks = 0; ks < NKS; ++ks)
#pragma unroll
                for (int kh = 0; kh < NKH; ++kh) { const int row = 32 * kh + r32;
                    const bf16x8 a = *(const LAS bf16x8*)(Kb + row * (2 * D) + (((2 * ks + hi) ^ kswz<D>(row)) << 4));
                    p[kh] = __builtin_amdgcn_mfma_f32_32x32x16_bf16(a, qr[ks], p[kh], 0, 0, 0); }
            float mx = p[0][0];
#pragma unroll
            for (int kh = 0; kh < NKH; ++kh)
#pragma unroll
                for (int r = 0; r < 16; ++r) mx = fmaxf(mx, p[kh][r]);
            mx = fmaxf(mx, __shfl_xor(mx, 32));
            const float mnew = fmaxf(m, mx);
            if (__builtin_amdgcn_ballot_w64(mnew > m) != 0ull) { const float alpha = __builtin_amdgcn_exp2f(m - mnew); l *= alpha;
#pragma unroll
                for (int dh = 0; dh < NDH; ++dh)
#pragma unroll
                    for (int r = 0; r < 16; ++r) o[dh][r] *= alpha;
                m = mnew; }
            float ps = 0.f;
#pragma unroll
            for (int kh = 0; kh < NKH; ++kh)
#pragma unroll
                for (int r = 0; r < 16; ++r) { p[kh][r] = __builtin_amdgcn_exp2f(p[kh][r] - m); ps += p[kh][r]; }
            l += ps;
#pragma unroll
            for (int kh = 0; kh < NKH; ++kh)
#pragma unroll
                for (int s = 0; s < 2; ++s) {
                    const bf16x8 pb = pack8(p[kh], s);
#pragma unroll
                    for (int dh = 0; dh < NDH; ++dh) {
                        const int rowA = 32 * kh + 16 * s + 4 * hi + tq, rowB = rowA + 8, chv = 4 * dh + 2 * blk + (tp >> 1);
                        const s16x4 lo = vtr(Vb + rowA * (2 * D) + ((chv ^ vswz<D>(rowA)) << 4) + 8 * (tp & 1));
                        const s16x4 hh = vtr(Vb + rowB * (2 * D) + ((chv ^ vswz<D>(rowB)) << 4) + 8 * (tp & 1));
                        const bf16x8 va = (bf16x8){lo[0], lo[1], lo[2], lo[3], hh[0], hh[1], hh[2], hh[3]};
                        o[dh] = __builtin_amdgcn_mfma_f32_32x32x16_bf16(va, pb, o[dh], 0, 0, 0);
                    }
                }
        }
        l += __shfl_xor(l, 32);
        const float inv = 1.f / l;
        bf16_t* orow = Og + qrow * ld + h * D;
#pragma unroll
        for (int dh = 0; dh < NDH; ++dh)
#pragma unroll
            for (int g = 0; g < 4; ++g) { uint2 w; w.x = cvt_pk_bf16(o[dh][4 * g] * inv, o[dh][4 * g + 1] * inv); w.y = cvt_pk_bf16(o[dh][4 * g + 2] * inv, o[dh][4 * g + 3] * inv);
                *(uint2*)(orow + 32 * dh + 8 * g + 4 * hi) = w; }
    }
}

template <bool FIXM, int VAR>
__device__ __forceinline__ void moba_pair(Frame& F, const int qb, const int b0, const int h0, const int b1, const int h1,
                                          const bf16_t* MQ, const bf16_t* MK, const bf16_t* MV, bf16_t* OM, const float* KMEAN,
                                          const int convmode, const int cstep0, const float* w1, const float* w2, const float mref) {
    constexpr int D = 64, KB = 64 * D * 2, NKS = 4, NDH = 2, ld = 512;
    int tid = F.tid, lane = F.lane; asm volatile("" : "+v"(tid), "+v"(lane));
    const int wave = F.wave, uh = wave >> 2, w4 = wave & 3, utid = tid & 255;
    if (convmode && uh) {
        LAS float* scr = (LAS float*)(F.lds + 65536 + w4 * 16384);
        const int NTc = 4 * (qb + 1), slot0 = __builtin_amdgcn_readfirstlane(4 * cstep0 + w4);
        if (qb > 0) __syncthreads();
        f32x4 v0[8], v1[8], v2[8], v3[8];
#define CV_ISSUE(v, t) do { if ((t) < NTc) cv_load(v, slot0 + 4 * (t), w1, w2, lane); } while (0)
#define CV_RETIRE(v, t) cv_finish(v, slot0 + 4 * (t), F.ws, scr, lane)
#define CV_BAR do { asm volatile("" ::: "memory"); __builtin_amdgcn_s_barrier(); asm volatile("" ::: "memory"); } while (0)
        CV_ISSUE(v0, 0); CV_ISSUE(v1, 1); CV_ISSUE(v2, 2);
#pragma unroll 1
        for (int tt = 0; tt < NTc; tt += 4) {
            CV_BAR; CV_ISSUE(v3, tt + 3); CV_RETIRE(v0, tt);
            CV_BAR; CV_ISSUE(v0, tt + 4); CV_RETIRE(v1, tt + 1);
            CV_BAR; CV_ISSUE(v1, tt + 5); CV_RETIRE(v2, tt + 2);
            CV_BAR; CV_ISSUE(v2, tt + 6); CV_RETIRE(v3, tt + 3);
        }
        CV_BAR;
#undef CV_ISSUE
#undef CV_RETIRE
#undef CV_BAR
        return;
    }
    const int b = uh ? b1 : b0, h = uh ? h1 : h0;
    LAS unsigned char* lds = F.lds + uh * 65536;
    LAS float* kml = (LAS float*)(F.lds + LDSCTL_OFF + 2048 + uh * 4096);
    const bf16_t* Kg = MK + (size_t)b * SEQ * ld; const bf16_t* Vg = MV + (size_t)b * SEQ * ld;
    const float sl2 = exp2f(-(float)(h + 1)) * LOG2E;
    bf16x8 qr[2][NKS]; unsigned selmask[2] = {0u, 0u};
    {
        const int r32 = lane & 31, hi = lane >> 5;
#pragma unroll
        for (int g = 0; g < 2; ++g) { const size_t qrow = (size_t)b * SEQ + qb * 256 + w4 * 64 + 32 * g + r32;
#pragma unroll
            for (int ks = 0; ks < NKS; ++ks) qr[g][ks] = *(const bf16x8*)(MQ + qrow * ld + h * D + 16 * ks + 8 * hi); }
        if (qb > 0) {
            if (utid < qb * 16) *(LAS f32x4*)(kml + 4 * utid) = *(const f32x4*)(KMEAN + (((size_t)b * 16 + (utid >> 4)) * 8 + h) * 64 + 4 * (utid & 15));
            __syncthreads();
#pragma unroll
            for (int g = 0; g < 2; ++g) {
                float qf[NKS * 8];
#pragma unroll
                for (int ks = 0; ks < NKS; ++ks) { const pg8::u32x4 w = __builtin_bit_cast(pg8::u32x4, qr[g][ks]);
#pragma unroll
                    for (int j = 0; j < 4; ++j) { qf[ks * 8 + 2 * j] = bfl(w[j]); qf[ks * 8 + 2 * j + 1] = bfh(w[j]); } }
                float v0 = -INFINITY, v1 = -INFINITY, v2 = -INFINITY; int i0 = -1, i1 = -1, i2 = -1;
#pragma unroll 1
                for (int j = 0; j < qb; ++j) { const LAS float* km = kml + 64 * j + 8 * hi; float s = 0.f;
#pragma unroll
                    for (int ks = 0; ks < NKS; ++ks) { const f32x4 k0 = *(const LAS f32x4*)(km + 16 * ks), k1 = *(const LAS f32x4*)(km + 16 * ks + 4);
                        s += qf[ks * 8 + 0] * k0[0] + qf[ks * 8 + 1] * k0[1] + qf[ks * 8 + 2] * k0[2] + qf[ks * 8 + 3] * k0[3] + qf[ks * 8 + 4] * k1[0] + qf[ks * 8 + 5] * k1[1] + qf[ks * 8 + 6] * k1[2] + qf[ks * 8 + 7] * k1[3]; }
                    s += __shfl_xor(s, 32);
                    const bool c0 = s > v0, c1 = s > v1, c2 = s > v2;
                    v2 = c1 ? v1 : (c2 ? s : v2); i2 = c1 ? i1 : (c2 ? j : i2);
                    v1 = c0 ? v0 : (c1 ? s : v1); i1 = c0 ? i0 : (c1 ? j : i1);
                    v0 = c0 ? s : v0; i0 = c0 ? j : i0; }
                selmask[g] = (i0 >= 0 ? (1u << i0) : 0u) | (i1 >= 0 ? (1u << i1) : 0u) | (i2 >= 0 ? (1u << i2) : 0u);
            }
        }
    }
    const int NT = 4 * (qb + 1);
#define MP_STAGE(tt, buf) do { const int kb_ = tile_kbase<true, 64>(tt, qb); _Pragma("unroll") for (int i_ = 0; i_ < 2; ++i_) { const int ci_ = utid + 256 * i_, row_ = ci_ >> 3, cp_ = ci_ & 7; \
        const size_t gk_ = (size_t)(kb_ + row_) * ld + h * D + 8 * (cp_ ^ kswz<64>(row_)), gv_ = (size_t)(kb_ + row_) * ld + h * D + 8 * (cp_ ^ vswz<64>(row_)); \
        __builtin_amdgcn_global_load_lds((const unsigned*)(Kg + gk_), (LAS unsigned*)(lds + (2 * (buf)) * KB + (w4 * 64 + 256 * i_) * 16), 16, 0, 0); \
        __builtin_amdgcn_global_load_lds((const unsigned*)(Vg + gv_), (LAS unsigned*)(lds + (2 * (buf) + 1) * KB + (w4 * 64 + 256 * i_) * 16), 16, 0, 0); } } while (0)
    MP_STAGE(0, 0); if (NT > 1) MP_STAGE(1, 1); if (NT > 2) MP_STAGE(2, 2);
    float m[2] = {-1e30f, -1e30f}, l[2] = {0.f, 0.f};
    float cq[2], a4[4];
#pragma unroll
    for (int g = 0; g < 2; ++g) cq[g] = -(mref + sl2 * (float)(w4 * 64 + 32 * g + (lane & 31)));
#pragma unroll
    for (int i = 0; i < 4; ++i) a4[i] = sl2 * (float)i;
    const float slh = __uint_as_float(cvt_pk_bf16(sl2, sl2) & 0xffff0000u), sll = sl2 - slh;
    bf16x8 akk[2];
#pragma unroll
    for (int kh = 0; kh < 2; ++kh) { const float rw = (float)(32 * kh + (lane & 31)); pg8::u32x4 aw; const bool up = (lane >> 5) != 0;
        aw[0] = up ? 0u : cvt_pk_bf16(rw, 1.f); aw[1] = up ? 0u : cvt_pk_bf16(1.f, rw); aw[2] = 0u; aw[3] = 0u; akk[kh] = __builtin_bit_cast(bf16x8, aw); }
    f32x16 o[2][NDH];
#pragma unroll
    for (int g = 0; g < 2; ++g)
#pragma unroll
        for (int dh = 0; dh < NDH; ++dh)
#pragma unroll
            for (int r = 0; r < 16; ++r) o[g][dh][r] = 0.f;
    for (int tt = 0; tt < NT; ++tt) {
        int lane_t = lane; asm volatile("" : "+v"(lane_t));
        const int r32 = lane_t & 31, hi = lane_t >> 5, i16 = lane_t & 15, blk = (lane_t >> 4) & 1, tq = i16 >> 2, tp = i16 & 3;
        const int buf = tt & 3;
        { const int ahead = NT - 1 - tt;
          if (ahead >= 2) asm volatile("s_waitcnt vmcnt(8)" ::: "memory"); else if (ahead == 1) asm volatile("s_waitcnt vmcnt(4)" ::: "memory"); else asm volatile("s_waitcnt vmcnt(0)" ::: "memory"); }
        asm volatile("s_waitcnt lgkmcnt(0)" ::: "memory"); if (VAR != 4) __builtin_amdgcn_s_barrier(); asm volatile("" ::: "memory");
        if (tt + 3 < NT) MP_STAGE(tt + 3, (tt + 3) & 3);
        bool act[2]; bool lane_sel[2];
#pragma unroll
        for (int g = 0; g < 2; ++g) { lane_sel[g] = true;
            if (tt >= 4) { lane_sel[g] = (selmask[g] >> ((tt - 4) >> 2)) & 1u; act[g] = __builtin_amdgcn_ballot_w64(lane_sel[g]) != 0ull; }
            else act[g] = (64 * tt <= w4 * 64 + 32 * g + 31); }
        if (act[0] || act[1]) {
            const LAS unsigned char* Kb = lds + (2 * buf) * KB; const LAS unsigned char* Vb = lds + (2 * buf + 1) * KB;
            const int kb = tile_kbase<true, 64>(tt, qb); const float offl = sl2 * (float)(kb - qb * 256 + 4 * hi);
            bf16x8 pb[2][4];
            if (FIXM && VAR == 0) {
                f32x16 pp[2][2];
                const float cbt = sl2 * (float)(kb - qb * 256);
#pragma unroll
                for (int g = 0; g < 2; ++g) {
                    const float cbv = lane_sel[g] ? cbt + cq[g] : -INFINITY;
                    const unsigned u0 = cvt_pk_bf16(slh, cbv); const float cbh = __uint_as_float(u0 & 0xffff0000u);
                    const unsigned u1 = cvt_pk_bf16(lane_sel[g] ? cbv - cbh : 0.f, sll);
                    pg8::u32x4 bw; bw[0] = hi ? 0u : u0; bw[1] = hi ? 0u : u1; bw[2] = 0u; bw[3] = 0u;
                    const bf16x8 bfrag = __builtin_bit_cast(bf16x8, bw);
#pragma unroll
                    for (int kh = 0; kh < 2; ++kh) { const f32x16 z = {0.f, 0.f, 0.f, 0.f, 0.f, 0.f, 0.f, 0.f, 0.f, 0.f, 0.f, 0.f, 0.f, 0.f, 0.f, 0.f};
                        pp[g][kh] = __builtin_amdgcn_mfma_f32_32x32x16_bf16(akk[kh], bfrag, z, 0, 0, 0); } }
#pragma unroll
                for (int ks = 0; ks < NKS; ++ks)
#pragma unroll
                    for (int kh = 0; kh < 2; ++kh) { const int row = 32 * kh + r32;
                        const bf16x8 a = *(const LAS bf16x8*)(Kb + row * 128 + (((2 * ks + hi) ^ kswz<64>(row)) << 4));
                        pp[0][kh] = __builtin_amdgcn_mfma_f32_32x32x16_bf16(a, qr[0][ks], pp[0][kh], 0, 0, 0);
                        pp[1][kh] = __builtin_amdgcn_mfma_f32_32x32x16_bf16(a, qr[1][ks], pp[1][kh], 0, 0, 0); }
                if (tt == w4) {
#pragma unroll
                    for (int g = 0; g < 2; ++g) { const int qrel = 32 * g + r32, k0 = 4 * hi;
#pragma unroll
                        for (int kh = 0; kh < 2; ++kh)
#pragma unroll
                            for (int r = 0; r < 16; ++r) { const int kv = k0 + 32 * kh + (r & 3) + 8 * (r >> 2); if (kv > qrel) pp[g][kh][r] = -INFINITY; } } }
#pragma unroll
                for (int kh = 0; kh < 2; ++kh)
#pragma unroll
                    for (int s = 0; s < 2; ++s) {
                        bf16x8 pq[2];
#pragma unroll
                        for (int g = 0; g < 2; ++g) { float e8[8];
#pragma unroll
                            for (int j = 0; j < 8; ++j) e8[j] = __builtin_amdgcn_exp2f(pp[g][kh][8 * s + j]);
                            l[g] += ((e8[0] + e8[1]) + (e8[2] + e8[3])) + ((e8[4] + e8[5]) + (e8[6] + e8[7]));
                            pg8::u32x4 w; w[0] = cvt_pk_bf16(e8[0], e8[1]); w[1] = cvt_pk_bf16(e8[2], e8[3]); w[2] = cvt_pk_bf16(e8[4], e8[5]); w[3] = cvt_pk_bf16(e8[6], e8[7]);
                            pq[g] = __builtin_bit_cast(bf16x8, w); }
#pragma unroll
                        for (int dh = 0; dh < NDH; ++dh) {
                            const int rowA = 32 * kh + 16 * s + 4 * hi + tq, rowB = rowA + 8, chv = 4 * dh + 2 * blk + (tp >> 1);
                            const s16x4 lo = vtr(Vb + rowA * 128 + ((chv ^ vswz<64>(rowA)) << 4) + 8 * (tp & 1));
                            const s16x4 hh = vtr(Vb + rowB * 128 + ((chv ^ vswz<64>(rowB)) << 4) + 8 * (tp & 1));
                            const bf16x8 va = (bf16x8){lo[0], lo[1], lo[2], lo[3], hh[0], hh[1], hh[2], hh[3]};
#pragma unroll
                            for (int g = 0; g < 2; ++g) o[g][dh] = __builtin_amdgcn_mfma_f32_32x32x16_bf16(va, pq[g], o[g][dh], 0, 0, 0);
                        }
                    }
            } else
#pragma unroll
            for (int g = 0; g < 2; ++g) {
                if (act[g]) {
                    f32x16 p[2];
                    if (FIXM) { const float cb = offl + cq[g]; float bq[2][4];
#pragma unroll
                        for (int kh = 0; kh < 2; ++kh)
#pragma unroll
                            for (int j = 0; j < 4; ++j) bq[kh][j] = fmaf(sl2, (float)(32 * kh + 8 * j), cb);
#pragma unroll
                        for (int kh = 0; kh < 2; ++kh)
#pragma unroll
                            for (int r = 0; r < 16; ++r) p[kh][r] = a4[r & 3] + bq[kh][r >> 2];
                    } else {
#pragma unroll
                        for (int kh = 0; kh < 2; ++kh)
#pragma unroll
                            for (int r = 0; r < 16; ++r) p[kh][r] = sl2 * (float)(32 * kh + (r & 3) + 8 * (r >> 2));
                    }
                    if (VAR != 3) {
#pragma unroll
                    for (int ks = 0; ks < NKS; ++ks)
#pragma unroll
                        for (int kh = 0; kh < 2; ++kh) { const int row = 32 * kh + r32;
                            const bf16x8 a = *(const LAS bf16x8*)(Kb + row * 128 + (((2 * ks + hi) ^ kswz<64>(row)) << 4));
                            p[kh] = __builtin_amdgcn_mfma_f32_32x32x16_bf16(a, qr[g][ks], p[kh], 0, 0, 0); }
                    }
                    if (tt < 4) { const int qrel = w4 * 64 + 32 * g + r32, k0 = 64 * tt + 4 * hi;
#pragma unroll
                        for (int kh = 0; kh < 2; ++kh)
#pragma unroll
                            for (int r = 0; r < 16; ++r) { const int kv = k0 + 32 * kh + (r & 3) + 8 * (r >> 2); if (kv > qrel) p[kh][r] = -INFINITY; }
                    } else if (!lane_sel[g]) {
#pragma unroll
                        for (int kh = 0; kh < 2; ++kh)
#pragma unroll
                            for (int r = 0; r < 16; ++r) p[kh][r] = -INFINITY;
                    }
                    if (!FIXM) {
                    float mx = p[0][0];
#pragma unroll
                    for (int kh = 0; kh < 2; ++kh)
#pragma unroll
                        for (int r = 0; r < 16; ++r) mx = fmaxf(mx, p[kh][r]);
                    mx += offl; mx = fmaxf(mx, __shfl_xor(mx, 32));
                    const float mnew = fmaxf(m[g], mx);
                    if (__builtin_amdgcn_ballot_w64(mnew > m[g]) != 0ull) { const float alpha = __builtin_amdgcn_exp2f(m[g] - mnew); l[g] *= alpha;
#pragma unroll
                        for (int dh = 0; dh < NDH; ++dh)
#pragma unroll
                            for (int r = 0; r < 16; ++r) o[g][dh][r] *= alpha;
                        m[g] = mnew; }
                    const float mt = m[g] - offl;
                    p[0] = p[0] - mt; p[1] = p[1] - mt;
                    }
                    if (VAR != 2) {
#pragma unroll
                    for (int kh = 0; kh < 2; ++kh)
#pragma unroll
                        for (int r = 0; r < 16; ++r) p[kh][r] = __builtin_amdgcn_exp2f(p[kh][r]);
                    }
                    if (VAR == 2) l[g] += p[0][0]; else
                    { const f32x16 s16 = p[0] + p[1]; const f32x8 s8 = s16.lo + s16.hi; const f32x4 s4 = s8.lo + s8.hi; const f32x2 s2 = s4.lo + s4.hi; l[g] += s2.x + s2.y; }
#pragma unroll
                    for (int kh = 0; kh < 2; ++kh)
#pragma unroll
                        for (int s = 0; s < 2; ++s) pb[g][2 * kh + s] = pack8(p[kh], s);
                } else {
#pragma unroll
                    for (int q = 0; q < 4; ++q) pb[g][q] = (bf16x8){0, 0, 0, 0, 0, 0, 0, 0};
                }
            }
            if (FIXM && VAR == 0) { } else
            if (VAR == 1) { unsigned x = 0;
#pragma unroll
                for (int g = 0; g < 2; ++g)
#pragma unroll
                    for (int q = 0; q < 4; ++q) { const pg8::u32x4 w = __builtin_bit_cast(pg8::u32x4, pb[g][q]); x ^= w[0] ^ w[1] ^ w[2] ^ w[3]; }
                o[0][0][0] += __uint_as_float(x & 0x3fffffffu); } else
#pragma unroll
            for (int kh = 0; kh < 2; ++kh)
#pragma unroll
                for (int s = 0; s < 2; ++s)
#pragma unroll
                    for (int dh = 0; dh < NDH; ++dh) {
                        const int rowA = 32 * kh + 16 * s + 4 * hi + tq, rowB = rowA + 8, chv = 4 * dh + 2 * blk + (tp >> 1);
                        const s16x4 lo = vtr(Vb + rowA * 128 + ((chv ^ vswz<64>(rowA)) << 4) + 8 * (tp & 1));
                        const s16x4 hh = vtr(Vb + rowB * 128 + ((chv ^ vswz<64>(rowB)) << 4) + 8 * (tp & 1));
                        const bf16x8 va = (bf16x8){lo[0], lo[1], lo[2], lo[3], hh[0], hh[1], hh[2], hh[3]};
#pragma unroll
                        for (int g = 0; g < 2; ++g) o[g][dh] = __builtin_amdgcn_mfma_f32_32x32x16_bf16(va, pb[g][2 * kh + s], o[g][dh], 0, 0, 0);
                    }
        }
    }
    asm volatile("s_waitcnt lgkmcnt(0)" ::: "memory"); __builtin_amdgcn_s_barrier(); asm volatile("" ::: "memory");
    { const int r32 = lane & 31, hi = lane >> 5;
#pragma unroll
      for (int g = 0; g < 2; ++g) { float lt = l[g]; lt += __shfl_xor(lt, 32); const float inv = 1.f / lt;
          bf16_t* orow = OM + ((size_t)b * SEQ + qb * 256 + w4 * 64 + 32 * g + r32) * ld + h * D;
#pragma unroll
          for (int dh = 0; dh < NDH; ++dh)
#pragma unroll
              for (int q = 0; q < 4; ++q) { uint2 w; w.x = cvt_pk_bf16(o[g][dh][4 * q] * inv, o[g][dh][4 * q + 1] * inv); w.y = cvt_pk_bf16(o[g][dh][4 * q + 2] * inv, o[g][dh][4 * q + 3] * inv);
                  *(uint2*)(orow + 32 * dh + 8 * q + 4 * hi) = w; } } }
#undef MP_STAGE
}
}
namespace ret {
using att::f32x16; using att::s16x4; using att::vtr; using att::pack8; using att::kswz; using att::vswz; using att::crow; using pg8::bf16x8;
constexpr int L_KT = 0, L_KD = 16384, L_VT = 32768, L_SB = 65536, L_SS = 98304, L_G = 99328;
__device__ __forceinline__ void retention_item(Frame& F, const int b, const int h, const float* g_ret_out, const int c0, const int c1) {
    const bf16_t* RQ = (const bf16_t*)(F.ws + WS_RQ); const bf16_t* RK = (const bf16_t*)(F.ws + WS_RK); const bf16_t* RV = (const bf16_t*)(F.ws + WS_RV); const bf16_t* RG = (const bf16_t*)(F.ws + WS_RG); bf16_t* ORET = (bf16_t*)(F.ws + WS_ORET);
    int tid = F.tid, lane = F.lane; asm volatile("" : "+v"(tid), "+v"(lane));
    const int wave = F.wave;
    LAS unsigned char* lds = F.lds;
    const float lg2_o = log2f(1.f - exp2f(-5.f - (float)h)), g128 = exp2f(128.f * lg2_o);
    const size_t tok0 = (size_t)b * SEQ;
    v4u kreg[2], vreg[4], kreg2[2], vreg2[4];
#define RET_LOAD2(n) do { _Pragma("unroll") for (int i_ = 0; i_ < 2; ++i_) { const int ci_ = tid + 512 * i_; kreg2[i_] = *(const v4u*)(RK + (tok0 + (n) * 128 + (ci_ >> 3)) * 256 + h * 64 + 8 * (ci_ & 7)); } \
        _Pragma("unroll") for (int i_ = 0; i_ < 4; ++i_) { const int ci_ = tid + 512 * i_; vreg2[i_] = *(const v4u*)(RV + (tok0 + (n) * 128 + (ci_ >> 4)) * 512 + h * 128 + 8 * (ci_ & 15)); } } while (0)
#define RET_LOAD(n) do { _Pragma("unroll") for (int i_ = 0; i_ < 2; ++i_) { const int ci_ = tid + 512 * i_; kreg[i_] = *(const v4u*)(RK + (tok0 + (n) * 128 + (ci_ >> 3)) * 256 + h * 64 + 8 * (ci_ & 7)); } \
        _Pragma("unroll") for (int i_ = 0; i_ < 4; ++i_) { const int ci_ = tid + 512 * i_; vreg[i_] = *(const v4u*)(RV + (tok0 + (n) * 128 + (ci_ >> 4)) * 512 + h * 128 + 8 * (ci_ & 15)); } } while (0)
#define RET_WRITE() do { _Pragma("unroll") for (int i_ = 0; i_ < 2; ++i_) { const int ci_ = tid + 512 * i_, row_ = ci_ >> 3, ch_ = ci_ & 7; const v4u k_ = kreg[i_]; \
            *(LAS v4u*)(lds + L_KT + row_ * 128 + ((ch_ ^ kswz<64>(row_)) << 4)) = k_; const float dk_ = __builtin_amdgcn_exp2f(lg2 * (float)(127 - row_)); v4u d_; \
            d_.x = cvt_pk_bf16(att::bfl(k_.x) * dk_, att::bfh(k_.x) * dk_); d_.y = cvt_pk_bf16(att::bfl(k_.y) * dk_, att::bfh(k_.y) * dk_); d_.z = cvt_pk_bf16(att::bfl(k_.z) * dk_, att::bfh(k_.z) * dk_); d_.w = cvt_pk_bf16(att::bfl(k_.w) * dk_, att::bfh(k_.w) * dk_); \
            *(LAS v4u*)(lds + L_KD + row_ * 128 + ((ch_ ^ vswz<64>(row_)) << 4)) = d_; } \
        _Pragma("unroll") for (int i_ = 0; i_ < 4; ++i_) { const int ci_ = tid + 512 * i_, row_ = ci_ >> 4, ch_ = ci_ & 15; *(LAS v4u*)(lds + L_VT + row_ * 256 + ((ch_ ^ vswz<128>(row_)) << 4)) = vreg[i_]; } } while (0)
    { const float lg2 = lg2_o; RET_LOAD(0); RET_WRITE(); }
    if (1 < c1) RET_LOAD(1);
    { const v4u z = {0u, 0u, 0u, 0u}; *(LAS v4u*)(lds + L_SB + tid * 32) = z; *(LAS v4u*)(lds + L_SB + tid * 32 + 16) = z; }
    f32x16 st;
#pragma unroll
    for (int r = 0; r < 16; ++r) st[r] = 0.f;
    const int e2 = wave >> 2, ib = e2 ? 3 - (wave & 3) : (wave & 3);
    LAS float* ssb = (LAS float*)(lds + L_SS);
    if (tid < 128) ((LAS float*)(lds + L_G))[tid] = g_ret_out[tid];
    bf16x8 qn[4];
    { const size_t tr0 = tok0 + (size_t)c0 * 128 + 32 * ib + (lane & 31);
#pragma unroll
      for (int ks = 0; ks < 4; ++ks) qn[ks] = *(const bf16x8*)(RQ + tr0 * 256 + h * 64 + 16 * ks + 8 * (lane >> 5)); }
    __syncthreads();
    for (int n = 0; n < c1; ++n) {
        const bool outp = n >= c0;
        int lane_n = lane; float lg2 = lg2_o; asm volatile("" : "+v"(lane_n), "+v"(lg2));
        const int r32 = lane_n & 31, hi = lane_n >> 5, i16 = lane_n & 15, blk = (lane_n >> 4) & 1, tq = i16 >> 2, tp = i16 & 3;
        if (n + 2 < c1) RET_LOAD2(n + 2);
        const LAS unsigned char* Sb = lds + L_SB + (n & 1) * 16384; LAS unsigned char* Sn = lds + L_SB + ((n + 1) & 1) * 16384;
        const size_t tokrow = tok0 + n * 128 + 32 * ib + r32;
        f32x16 o[2]; uint2 rgv[8];
#pragma unroll
        for (int q2 = 0; q2 < 2; ++q2)
#pragma unroll
            for (int r = 0; r < 16; ++r) o[q2][r] = 0.f;
#pragma unroll
        for (int q = 0; q < 8; ++q) rgv[q] = make_uint2(0u, 0u);
        if (outp) {
#pragma unroll
        for (int q2 = 0; q2 < 2; ++q2)
#pragma unroll
            for (int g = 0; g < 4; ++g) rgv[q2 * 4 + g] = *(const uint2*)(RG + tokrow * 512 + h * 128 + 64 * e2 + 32 * q2 + 8 * g + 4 * hi);
        {
            bf16x8 qr[4];
#pragma unroll
            for (int ks = 0; ks < 4; ++ks) qr[ks] = qn[ks];
            if (n + 1 < c1) {
#pragma unroll
                for (int ks = 0; ks < 4; ++ks) qn[ks] = *(const bf16x8*)(RQ + (tokrow + 128) * 256 + h * 64 + 16 * ks + 8 * hi); }
#pragma unroll
            for (int q2 = 0; q2 < 2; ++q2) {
#pragma unroll
                for (int r = 0; r < 16; ++r) o[q2][r] = 0.f;
                const int e = 64 * e2 + 32 * q2 + r32;
#pragma unroll
                for (int ks = 0; ks < 4; ++ks) { const bf16x8 a = *(const LAS bf16x8*)(Sb + e * 128 + (((2 * ks + hi) ^ kswz<64>(e)) << 4)); o[q2] = __builtin_amdgcn_mfma_f32_32x32x16_bf16(a, qr[ks], o[q2], 0, 0, 0); } }
            const float gq = __builtin_amdgcn_exp2f(lg2 * (float)(32 * ib + r32 + 1));
#pragma unroll
            for (int q2 = 0; q2 < 2; ++q2)
#pragma unroll
                for (int r = 0; r < 16; ++r) o[q2][r] *= gq;
            __builtin_amdgcn_sched_barrier(0);
#pragma unroll 1
            for (int jb = 0; jb <= ib; ++jb) {
                f32x16 p;
#pragma unroll
                for (int r = 0; r < 16; ++r) p[r] = 0.f;
                const int krow_ = 32 * jb + r32;
#pragma unroll
                for (int ks = 0; ks < 4; ++ks) { const bf16x8 a = *(const LAS bf16x8*)(lds + L_KT + krow_ * 128 + (((2 * ks + hi) ^ kswz<64>(krow_)) << 4)); p = __builtin_amdgcn_mfma_f32_32x32x16_bf16(a, qr[ks], p, 0, 0, 0); }
                const float cl = __builtin_amdgcn_exp2f(lg2 * (float)(32 * (ib - jb) + r32 - 4 * hi));
                const bool diag = (jb == ib);
#pragma unroll
                for (int r = 0; r < 16; ++r) { float v = p[r] * (cl * __builtin_amdgcn_exp2f(-lg2 * (float)((r & 3) + 8 * (r >> 2)))); if (diag && ((r & 3) + 8 * (r >> 2) + 4 * hi) > r32) v = 0.f; p[r] = v; }
#pragma unroll
                for (int s = 0; s < 2; ++s) { const bf16x8 pb = pack8(p, s);
                    const int rowA = 32 * jb + 16 * s + 4 * hi + tq, rowB = rowA + 8;
#pragma unroll
                    for (int q2 = 0; q2 < 2; ++q2) { const int chv = 4 * (2 * e2 + q2) + 2 * blk + (tp >> 1);
                        const s16x4 lo = vtr(lds + L_VT + rowA * 256 + ((chv ^ vswz<128>(rowA)) << 4) + 8 * (tp & 1));
                        const s16x4 hh = vtr(lds + L_VT + rowB * 256 + ((chv ^ vswz<128>(rowB)) << 4) + 8 * (tp & 1));
                        const bf16x8 va = (bf16x8){lo[0], lo[1], lo[2], lo[3], hh[0], hh[1], hh[2], hh[3]};
                        o[q2] = __builtin_amdgcn_mfma_f32_32x32x16_bf16(va, pb, o[q2], 0, 0, 0); }
                    }
            }
        }
        __builtin_amdgcn_sched_barrier(0);
        { float ss = 0.f;
#pragma unroll
            for (int q2 = 0; q2 < 2; ++q2)
#pragma unroll
                for (int r = 0; r < 16; ++r) ss += o[q2][r] * o[q2][r];
            ss += __shfl_xor(ss, 32);
            if (hi == 0) ssb[e2 * 128 + 32 * ib + r32] = ss; }
        }
        __builtin_amdgcn_sched_barrier(0);
        { const int eh = wave & 3, dh = wave >> 2;
#pragma unroll
            for (int r = 0; r < 16; ++r) st[r] *= g128;
#pragma unroll 2
            for (int kst = 0; kst < 8; ++kst) { const int rowA = 16 * kst + 4 * hi + tq, rowB = rowA + 8, chv = 4 * eh + 2 * blk + (tp >> 1), chk = 4 * dh + 2 * blk + (tp >> 1);
                const s16x4 lo = vtr(lds + L_VT + rowA * 256 + ((chv ^ vswz<128>(rowA)) << 4) + 8 * (tp & 1));
                const s16x4 hh = vtr(lds + L_VT + rowB * 256 + ((chv ^ vswz<128>(rowB)) << 4) + 8 * (tp & 1));
                const s16x4 kl = vtr(lds + L_KD + rowA * 128 + ((chk ^ vswz<64>(rowA)) << 4) + 8 * (tp & 1));
                const s16x4 kh = vtr(lds + L_KD + rowB * 128 + ((chk ^ vswz<64>(rowB)) << 4) + 8 * (tp & 1));
                const bf16x8 va = (bf16x8){lo[0], lo[1], lo[2], lo[3], hh[0], hh[1], hh[2], hh[3]};
                const bf16x8 kb = (bf16x8){kl[0], kl[1], kl[2], kl[3], kh[0], kh[1], kh[2], kh[3]};
                st = __builtin_amdgcn_mfma_f32_32x32x16_bf16(va, kb, st, 0, 0, 0); }
            if (n + 1 >= c0) {
#pragma unroll
            for (int r = 0; r < 16; ++r) { const int e = 32 * eh + (r & 3) + 8 * (r >> 2) + 4 * hi, dd = 32 * dh + r32;
                *(LAS bf16_t*)(Sn + e * 128 + ((((dd >> 3) ^ kswz<64>(e))) << 4) + (dd & 7) * 2) = f2bf(st[r]); } } }
        __builtin_amdgcn_sched_barrier(0);
        __syncthreads();
        if (outp) { const float rn = 1.f / sqrtf((ssb[32 * ib + r32] + ssb[128 + 32 * ib + r32]) * (1.f / 128.f) + 1e-5f);
#pragma unroll
            for (int q2 = 0; q2 < 2; ++q2)
#pragma unroll
                for (int g = 0; g < 4; ++g) { const int e = 64 * e2 + 32 * q2 + 8 * g + 4 * hi; const f32x4 gg = *(const LAS f32x4*)(lds + L_G + 4 * e); const uint2 rg = rgv[q2 * 4 + g];
                    uint2 w; w.x = cvt_pk_bf16(o[q2][4 * g] * rn * gg[0] * att::bfl(rg.x), o[q2][4 * g + 1] * rn * gg[1] * att::bfh(rg.x)); w.y = cvt_pk_bf16(o[q2][4 * g + 2] * rn * gg[2] * att::bfl(rg.y), o[q2][4 * g + 3] * rn * gg[3] * att::bfh(rg.y));
                    *(uint2*)(ORET + tokrow * 512 + h * 128 + e) = w; } }
        if (n + 1 < c1) RET_WRITE();
        if (n + 2 < c1) {
#pragma unroll
            for (int i_ = 0; i_ < 2; ++i_) kreg[i_] = kreg2[i_];
#pragma unroll
            for (int i_ = 0; i_ < 4; ++i_) vreg[i_] = vreg2[i_]; }
        __syncthreads();
    }
#undef RET_LOAD
#undef RET_LOAD2
#undef RET_WRITE
}
}
constexpr int P1_SPARE = 0, P1_CONV = 0;
__device__ __forceinline__ int p1_fill_count(int G) { const int rem = 1680 % G; return rem ? ((G - rem) & ~1) : 0; }
__device__ __forceinline__ void conv_item(Frame& F, const int c, const float* w1, const float* w2) {
            LAS float* scr = (LAS float*)(F.lds + RING_OFF + F.wave * 16384);
            const bool isw1 = c < 512; const int cc = isw1 ? c : c - 512, e = cc >> 4, kb = cc & 15, nblk = isw1 ? 64 : 32, N = isw1 ? 2048 : 1024;
            const float* Wsrc = isw1 ? w1 + (size_t)e * 1024 * 2048 : w2 + (size_t)e * 1024 * 1024;
            bf16* WT = isw1 ? (bf16*)(F.ws + WS_W1) + (size_t)e * 2048 * 1024 : (bf16*)(F.ws + WS_W2) + (size_t)e * 1024 * 1024;
            float wa[32], wb[32];
            xp_load(wa, Wsrc, N, nblk, kb * nblk + F.wave, F.lane);
#pragma unroll 1
            for (int nb = F.wave; nb < nblk; nb += 16) {
                xp_load(wb, Wsrc, N, nblk, kb * nblk + nb + 8, F.lane);
                xp_finish(wa, 1024, nblk, WT, scr, kb * nblk + nb, F.lane);
                if (nb + 16 < nblk) xp_load(wa, Wsrc, N, nblk, kb * nblk + nb + 16, F.lane);
                xp_finish(wb, 1024, nblk, WT, scr, kb * nblk + nb + 8, F.lane);
            }
}
__device__ __forceinline__ void conv_pair(Frame& F, const int c, const float* w1, const float* w2) {
            if (c + 1 < p1_fill_count(F.G)) return;
            LAS float* scr = (LAS float*)(F.lds + RING_OFF + F.wave * 16384);
            const bool isw1 = c < 512; const int cc = isw1 ? c : c - 512, e = cc >> 4, kb = cc & 15, nblk = isw1 ? 64 : 32, N = isw1 ? 2048 : 1024, sh = isw1 ? 3 : 2, T = 2 << sh;
            const float* Wsrc = isw1 ? w1 + (size_t)e * 1024 * 2048 : w2 + (size_t)e * 1024 * 1024;
            bf16* WT = isw1 ? (bf16*)(F.ws + WS_W1) + (size_t)e * 2048 * 1024 : (bf16*)(F.ws + WS_W2) + (size_t)e * 1024 * 1024;
            float wa[32], wb[32];
#define CP_IDX(k) ((kb + ((k) >> sh)) * nblk + F.wave + 8 * ((k) & ((1 << sh) - 1)))
            xp_load(wa, Wsrc, N, nblk, CP_IDX(0), F.lane);
#pragma unroll 1
            for (int k = 0; k < T; k += 2) {
                xp_load(wb, Wsrc, N, nblk, CP_IDX(k + 1), F.lane);
                xp_finish(wa, 1024, nblk, WT, scr, CP_IDX(k), F.lane);
                if (k + 2 < T) xp_load(wa, Wsrc, N, nblk, CP_IDX(k + 2), F.lane);
                xp_finish(wb, 1024, nblk, WT, scr, CP_IDX(k + 1), F.lane);
            }
#undef CP_IDX
}
constexpr int CW_QUEUE = 128;
constexpr int RET_SEGS = 4, RET_ITEMS = 16 * RET_SEGS;
__device__ __forceinline__ float moba_mref(Frame& F) {
    const float* gt = (const float*)(F.ws + WS_GTAB); float v = fabsf(gt[F.lane] * gt[64 + F.lane]);
#pragma unroll
    for (int o = 1; o < 64; o <<= 1) v = fmaxf(v, __shfl_xor(v, o));
    return 1.04f * 0.18033688f * 64.f * v + 0.25f;
}
template <int VAR>
__device__ __forceinline__ void p2_mixers(Frame& F, const float* g_ret_out, const float* g_mem_q, const float* g_mem_k, const float* w1, const float* w2, const int qword, const int qlo, const int qhi, const int tmask, const float mref) {
    volatile LAS int* slot = (volatile LAS int*)(F.lds + TB_OFF + 512);
    const bf16_t* MQ = (const bf16_t*)(F.ws + WS_MQ); const bf16_t* MK = (const bf16_t*)(F.ws + WS_MK); const bf16_t* MV = (const bf16_t*)(F.ws + WS_MV); bf16_t* OMO = (bf16_t*)(F.ws + (VAR ? WS_ACT : WS_OMOBA));
    const bf16_t* CQ = (const bf16_t*)(F.ws + WS_CQ); const bf16_t* MEMK = (const bf16_t*)(F.ws + WS_MEMK); const bf16_t* MEMV = (const bf16_t*)(F.ws + WS_MEMV); bf16_t* OME = (bf16_t*)(F.ws + WS_OMEM);
    const bool fixm = mref < 40.f;
    bool first = true;
    for (;;) {
        int it;
        if (first) { first = false; it = F.vcu + qlo; __syncthreads(); }
        else {
            __syncthreads();
            if (F.tid == 0) slot[0] = (int)__hip_atomic_fetch_add((unsigned*)F.ctl + qword, 1u, __ATOMIC_RELAXED, __HIP_MEMORY_SCOPE_AGENT);
            __syncthreads();
            it = slot[0] + F.G + qlo;
        }
        if (it >= qhi) break;
        if (it < RET_ITEMS) { if (tmask & 1) { const int seg = RET_SEGS - 1 - (it >> 4), bh = it & 15; ret::retention_item(F, bh >> 2, bh & 3, g_ret_out, (32 / RET_SEGS) * seg, (32 / RET_SEGS) * (seg + 1)); } continue; }
        const int j = it - RET_ITEMS, sg = j / 14, rj = j - 14 * sg, ismem = (rj == 0 || rj == 7), idx = rj - 1 - (rj > 7 ? 1 : 0), tri = ismem ? 0 : idx % 3, grp = ismem ? 2 * sg + (rj == 7 ? 1 : 0) : 4 * sg + idx / 3, pos = ismem ? 3 : tri;
        if (pos == 1) { if (!(tmask & 2)) continue;
            const int qb = 15 - (grp >> 4), bh0 = grp & 15, bh1 = bh0 + 16;
            if (fixm) att::moba_pair<true, VAR>(F, qb, bh0 >> 3, bh0 & 7, bh1 >> 3, bh1 & 7, MQ, MK, MV, OMO, (const float*)(F.ctl + CW_KMEAN), 0, 0, w1, w2, mref);
            else att::moba_pair<false, 0>(F, qb, bh0 >> 3, bh0 & 7, bh1 >> 3, bh1 & 7, MQ, MK, MV, OMO, (const float*)(F.ctl + CW_KMEAN), 0, 0, w1, w2, 0.f); }
        else if (pos == 3) { if (!(tmask & 4)) continue;
            const int u = grp, bh = u >> 3, qb0 = 2 * (u & 7), b = bh >> 2, h = bh & 3;
            att::mem_attn_group(F, b, h, qb0, 2, CQ, MEMK + (size_t)b * MEMLEN * 512, MEMV + (size_t)b * MEMLEN * 512, OME, (const float*)(F.ctl + CW_MEMKSS) + (size_t)b * MEMLEN * 4, g_mem_q, g_mem_k); }
        else { if (!(tmask & 8)) continue; const int c = 4 * grp + pos; conv_pair(F, c, w1, w2); }
    }
}
constexpr int N_PHASES = 9;
#ifndef PROBE_MASK
#define PROBE_MASK 0
#endif
constexpr int P2_NITEMS = RET_ITEMS + 14 * 64;
#ifndef P2_LO
#define P2_LO 0
#define P2_HI P2_NITEMS
#endif
#ifndef P2_VAR
#define P2_VAR 0
#endif
#ifndef P2_TMASK
#define P2_TMASK 15
#endif
#define NREP(k) ((((PROBE_MASK) >> (k)) & 1) ? 2 : 1)
__global__ void __launch_bounds__(NWAVES * 64, 2) mega(Args args) {
    extern __shared__ __attribute__((aligned(16))) unsigned char lds[];
    Frame F;
    F.lds = (LAS unsigned char*)lds; F.MISC = (volatile LAS unsigned*)(F.lds + MISC_OFF);
    F.tid = threadIdx.x; F.lane = F.tid & 63; F.wave = __builtin_amdgcn_readfirstlane(F.tid >> 6);
    F.G = gridDim.x; { const int bx = blockIdx.x; F.vcu = (F.G % 8 == 0) ? (bx % 8) * (F.G / 8) + bx / 8 : bx; }
    F.ws = args.ws; F.out = args.out; F.ctl = (gu32*)(args.ws + WS_CTL);
    for (int u = F.tid; u < (LDS_BYTES - LDSCTL_OFF) / 4; u += NWAVES * 64) ((LAS unsigned*)(F.lds + LDSCTL_OFF))[u] = 0u;
    __syncthreads();
    XcdBarrier bar = xcd_barrier_post((unsigned*)(F.ctl + CW_BAR) + args.li * XCD_BAR_WORDS, F.MISC + 8);
    const int lo = args.ph_lo, hi = args.ph_hi;
#define IN(k) (lo <= (k) && (k) < hi)
#define BOTH(k) (IN(k) && IN((k) + 1))
    if (IN(0)) { for (int rep = 0; rep < NREP(0); ++rep) p0_prologue(F, args); if (BOTH(0)) xcd_barrier(bar); }
    if (IN(1)) {
        pg8::Gemm g{(const pg8::bf16_t*)(F.ws + WS_HB), (const pg8::bf16_t*)(F.ws + WS_WIN), NTOK + 1024, DIN + 1024, 1024};
        const int G1 = F.G - P1_SPARE; const bool p1_gemm = (int)blockIdx.x < G1;
        P1Order S; S.init(G1, p1_gemm ? (int)blockIdx.x : 0);
        EpiP1 E{F.ws, args.in[4], (const float*)(F.ws + WS_GTAB), (float*)(F.ctl + CW_KMEAN), (float*)(F.ctl + CW_MEMKSS), 1};
        if (p1_gemm) pg8::gemm_phase<EpiP1, P1Order, true, true>(F.lds + RING_OFF, g, S, E);
        if (P1_SPARE == 0) { const int ci = (int)blockIdx.x - 1680 % F.G; if (1680 % F.G != 0 && ci >= 0 && ci < p1_fill_count(F.G)) conv_item(F, ci, args.in[19], args.in[21]); }
        else { for (int c = (int)blockIdx.x - G1; c < P1_CONV; c += (P1_SPARE ? P1_SPARE : 1)) { conv_item(F, c, args.in[19], args.in[21]); __syncthreads(); } }
        if (NREP(1) > 1) { xcd_barrier(bar); E.atom_on = 0; pg8::gemm_phase<EpiP1, P1Order, true, true>(F.lds + RING_OFF, g, S, E); }
        if (BOTH(1)) xcd_barrier(bar);
    }
    if (IN(2)) {
        const float mref = moba_mref(F);
        p2_mixers<0>(F, args.in[5], args.in[10], args.in[11], args.in[19], args.in[21], CW_QUEUE, 0, P2_NITEMS, 15, mref);
        if (NREP(2) > 1) { xcd_barrier(bar); p2_mixers<P2_VAR>(F, args.in[5], args.in[10], args.in[11], args.in[19], args.in[21], CW_QUEUE + 1024, P2_LO, P2_HI, P2_TMASK, mref); }
        if (BOTH(2)) xcd_barrier(bar);
    }
    if (IN(3)) {
        P3Order S; S.init(F.G, (int)blockIdx.x, F.ws); EpiP3 E{(const bf16_t*)(F.ws + WS_GT), (bf16_t*)(F.ws + WS_Y)};
        pg9::gemm_phase<EpiP3, P3Order, false>(F.lds + RING_OFF, 512, 512, 512, S, E);
        if (NREP(3) > 1) pg9::gemm_phase<EpiP3, P3Order, false>(F.lds + RING_OFF, 512, 512, 512, S, E);
        if (BOTH(3)) xcd_barrier(bar);
    }
    if (IN(4)) {
        P4Order S; S.init(F.G, (int)blockIdx.x, F.ws); EpiP4 E{args.in[0], F.out};
        pg9::gemm_phase<EpiP4, P4Order, false>(F.lds + RING_OFF, 1024, 1024, 1024, S, E);
        if (NREP(4) > 1) pg9::gemm_phase<EpiP4, P4Order, false>(F.lds + RING_OFF, 1024, 1024, 1024, S, E);
        if (BOTH(4)) xcd_barrier(bar);
    }
    if (IN(5)) { p5_router(F, F.out, args.in[16], args.in[17], args.in[18], (int*)F.ctl + CW_COUNTS, (int*)(F.ws + WS_LISTS));
        if (NREP(5) > 1) p5_router(F, F.out, args.in[16], args.in[17], args.in[18], (int*)F.ctl + CW_COUNTS + 256, (int*)(F.ws + WS_RETST));
        if (BOTH(5)) xcd_barrier(bar); }
    if (IN(6)) {
        moe_tables(F);
        MoeOrder<3, WS_W1, 2048, 2, WS_XT> S; S.init(F.G, F.vcu, F.ws, (const LAS int*)(F.lds + TB_OFF));
        EpiMoe1 E{(const int*)(F.ws + WS_LISTS), args.in[20], (bf16_t*)(F.ws + WS_ACT), (int*)(F.ws + WS_SLOT)};
        pg9::gemm_phase<EpiMoe1, MoeOrder<3, WS_W1, 2048, 2, WS_XT>, true>(F.lds + RING_OFF, 1024, 1024, 1024, S, E);
        if (NREP(6) > 1) { xcd_barrier(bar); } if (NREP(6) > 1) pg9::gemm_phase<EpiMoe1, MoeOrder<3, WS_W1, 2048, 2, WS_XT>, true>(F.lds + RING_OFF, 1024, 1024, 1024, S, E);
        if (BOTH(6)) xcd_barrier(bar);
    }
    if (IN(7)) {
        moe_tables(F);
        Moe2SplitOrder S; S.init(F.G, F.vcu, F.ws, (const LAS int*)(F.lds + TB_OFF));
        EpiMoe2 E{args.in[22], F.ws};
        pg9::gemm_phase<EpiMoe2, Moe2SplitOrder, false>(F.lds + RING_OFF, 1024, 1024, 1024, S, E);
        if (NREP(7) > 1) { xcd_barrier(bar); } if (NREP(7) > 1) pg9::gemm_phase<EpiMoe2, Moe2SplitOrder, false>(F.lds + RING_OFF, 1024, 1024, 1024, S, E);
        if (BOTH(7)) xcd_barrier(bar);
    }
    if (IN(8)) { p8_combine(F, F.out, F.out); if (NREP(8) > 1) p8_combine(F, F.out, (float*)(F.ws + WS_HB)); }
    if (NREP(9) > 1) { for (int i = 0; i < 16; ++i) xcd_barrier(bar); }
#undef IN
#undef BOTH
}
#ifndef MK_ONE_LAUNCH
#define MK_ONE_LAUNCH 1
#endif
extern "C" void kernel_launch(void* const* d_in, const int* in_sizes, int n_in, void* d_out, int out_size, void* d_ws, size_t ws_size, hipStream_t stream) {
    if (ws_size < WS_END) { fprintf(stderr, "kernel_launch: ws too small %zu < %zu\n", ws_size, (size_t)WS_END); return; }
    unsigned char* ws = (unsigned char*)d_ws; float* out = (float*)d_out;
    static int grid = 0;
    if (grid == 0) {
        int dev = 0, cus = 0; if (hipGetDevice(&dev) != hipSuccess || hipDeviceGetAttribute(&cus, hipDeviceAttributeMultiprocessorCount, dev) != hipSuccess) { fprintf(stderr, "kernel_launch: device query failed\n"); grid = -1; return; }
        if (hipFuncSetAttribute((const void*)mega, hipFuncAttributeMaxDynamicSharedMemorySize, LDS_BYTES) != hipSuccess) { fprintf(stderr, "kernel_launch: hipFuncSetAttribute failed\n"); grid = -1; return; }
        (void)hipGetLastError(); grid = cus;
    }
    if (grid < 0) return;
    (void)hipMemsetAsync(ws + WS_CTL, 0, 1 * MiB, stream);
    Args a; memset(&a, 0, sizeof a); for (int i = 0; i < 23; ++i) a.in[i] = (const float*)d_in[i]; a.out = out; a.ws = ws; a.li = 0;
#if MK_ONE_LAUNCH
    a.ph_lo = 0; a.ph_hi = N_PHASES;
    hipLaunchKernelGGL(mega, dim3(grid), dim3(NWAVES * 64), LDS_BYTES, stream, a);
#else
    for (int p = 0; p < N_PHASES; ++p) { a.ph_lo = p; a.ph_hi = p + 1; hipLaunchKernelGGL(mega, dim3(grid), dim3(NWAVES * 64), LDS_BYTES, stream, a); }
#endif
}
```
